# Optimizing an MI355X kernel written in HIP

```python
import math
import jax
import jax.numpy as jnp
from jax import lax
import numpy as np

D_MODEL = 1024
BATCH = 4
SEQ = 4096
DEPTH = 1

GRID_W = 64
CTX_LEN = 256
D_MIX = D_MODEL
EPS = 1e-6
CONV_W = 5
NEG_BIG = -1e30

SSD_WIDTH = D_MIX // 2
SSD_HEADDIM = 64
SSD_HEADS = SSD_WIDTH // SSD_HEADDIM
SSD_GROUPS = 2
SSD_STATE = 128
SSD_CHUNK = 128
SSD_BC = SSD_GROUPS * SSD_STATE
SSD_CONV_DIM = SSD_WIDTH + 2 * SSD_BC
SSD_IN = SSD_WIDTH + SSD_CONV_DIM + 2 * SSD_HEADS

ML_WIDTH = D_MIX - SSD_WIDTH
ML_HEADS = 4
ML_HEADDIM = ML_WIDTH // ML_HEADS
ML_QK_BLOCK = 4
ML_CHUNK = 128
ML_IN = 3 * ML_WIDTH + 4 * ML_HEADS

D_IN = SSD_IN + ML_IN

MOE_GROUPS = 4
MOE_EXPERTS_PER_GROUP = 8
MOE_EXPERTS = MOE_GROUPS * MOE_EXPERTS_PER_GROUP
MOE_TOP_K = 2
D_EXPERT = D_MODEL // 4

kernel_name = "hymba_ssd_mlstm_hmoe_dit_block"


def rms_norm(t, w):
    tf = t.astype(jnp.float32)
    y = tf * lax.rsqrt(jnp.mean(tf * tf, axis=-1, keepdims=True) + EPS)
    return (y * w.astype(jnp.float32)).astype(t.dtype)


def modulate(t, shift, scale):
    return t * (1 + scale) + shift


def dwconv_centred(t, w, bias):
    pad = CONV_W // 2
    length = t.shape[1]
    tp = jnp.pad(t, ((0, 0), (pad, pad), (0, 0)))
    out = bias
    for tap in range(CONV_W):
        out = out + w[tap] * tp[:, tap:tap + length]
    return out


def to_col_major(t, rows):
    b, length, ch = t.shape
    return t.reshape(b, rows, GRID_W, ch).transpose(0, 2, 1, 3).reshape(b, length, ch)


def from_col_major(t, rows):
    b, length, ch = t.shape
    return t.reshape(b, GRID_W, rows, ch).transpose(0, 2, 1, 3).reshape(b, length, ch)


def segsum(a):
    size = a.shape[-1]
    cs = jnp.cumsum(a, axis=-1)
    mask = jnp.tril(jnp.ones((size, size), dtype=bool))
    return jnp.where(mask, cs[..., :, None] - cs[..., None, :], -jnp.inf)


def ssd_scan(xs, dt, a_neg, bm, cm, init_state):
    b, length, nh, hp = xs.shape
    nc = length // SSD_CHUNK
    rep = nh // SSD_GROUPS
    bh = jnp.repeat(bm, rep, axis=2)
    ch = jnp.repeat(cm, rep, axis=2)

    def chunk(t):
        return t.reshape((b, nc, SSD_CHUNK) + t.shape[2:])

    xc, bc, cc = chunk(xs * dt[..., None]), chunk(bh), chunk(ch)
    ac = chunk(dt * a_neg).transpose(0, 3, 1, 2)
    a_cs = jnp.cumsum(ac, axis=-1)
    l_mat = jnp.exp(segsum(ac))
    y_diag = jnp.einsum("bclhn,bcshn,bhcls,bcshp->bclhp", cc, bc, l_mat, xc)
    decay_states = jnp.exp(a_cs[..., -1:] - a_cs)
    states = jnp.einsum("bclhn,bhcl,bclhp->bchpn", bc, decay_states, xc)
    states = jnp.concatenate([init_state[:, None], states], axis=1)
    chunk_decay = jnp.exp(segsum(jnp.pad(a_cs[..., -1], ((0, 0), (0, 0), (1, 0)))))
    new_states = jnp.einsum("bhzc,bchpn->bzhpn", chunk_decay, states)
    prev_states, final_state = new_states[:, :-1], new_states[:, -1]
    y_off = jnp.einsum("bclhn,bchpn,bhcl->bclhp", cc, prev_states, jnp.exp(a_cs))
    return (y_diag + y_off).reshape(b, length, nh, hp), final_state


def ssd_group(p_lat, p_ctx, conv_w, conv_b, dt_bias, a_log, d_skip, norm_w):
    a_neg = -jnp.exp(a_log.astype(jnp.float32))

    def prep(p):
        b, length, _ = p.shape
        z = p[..., :SSD_WIDTH]
        xbc = jax.nn.silu(dwconv_centred(p[..., SSD_WIDTH:SSD_WIDTH + SSD_CONV_DIM], conv_w, conv_b)).astype(jnp.float32)
        dt_raw = p[..., SSD_WIDTH + SSD_CONV_DIM:].astype(jnp.float32).reshape(b, length, 2, SSD_HEADS)
        dt = jax.nn.softplus(dt_raw + dt_bias.astype(jnp.float32))
        xs = xbc[..., :SSD_WIDTH].reshape(b, length, SSD_HEADS, SSD_HEADDIM)
        bm = xbc[..., SSD_WIDTH:SSD_WIDTH + SSD_BC].reshape(b, length, SSD_GROUPS, SSD_STATE)
        cm = xbc[..., SSD_WIDTH + SSD_BC:].reshape(b, length, SSD_GROUPS, SSD_STATE)
        return z, xs, bm, cm, dt

    zl, xl, bl, cl, dtl = prep(p_lat)
    zc, xc, bc, cc, dtc = prep(p_ctx)
    s0 = jnp.zeros((xl.shape[0], SSD_HEADS, SSD_HEADDIM, SSD_STATE), jnp.float32)
    yc_f, s_f = ssd_scan(xc, dtc[:, :, 0], a_neg[0], bc, cc, s0)
    yl_f, _ = ssd_scan(xl, dtl[:, :, 0], a_neg[0], bl, cl, s_f)
    yc_b, s_b = ssd_scan(xc[:, ::-1], dtc[:, ::-1, 1], a_neg[1], bc[:, ::-1], cc[:, ::-1], s0)
    yl_b, _ = ssd_scan(xl[:, ::-1], dtl[:, ::-1, 1], a_neg[1], bl[:, ::-1], cl[:, ::-1], s_b)

    def finish(yf, yb, xs, z):
        b, length = xs.shape[:2]
        y = yf + yb[:, ::-1] + d_skip.astype(jnp.float32)[:, None] * xs
        y = y.reshape(b, length, SSD_WIDTH) * jax.nn.silu(z.astype(jnp.float32))
        return rms_norm(y, norm_w)

    return finish(yl_f, yl_b, xl, zl), finish(yc_f, yc_b, xc, zc)


def mlstm_scan(q, k, v, log_i, log_f, state):
    b, nh, length, dh = q.shape
    nc = length // ML_CHUNK

    def chunk(t):
        return t.reshape((b, nh, nc, ML_CHUNK) + t.shape[3:])

    qc, kc, vc = chunk(q), chunk(k), chunk(v)
    ic, fc = chunk(log_i), chunk(log_f)
    bcum = jnp.cumsum(fc, axis=-1)
    b_last = bcum[..., -1]
    a = b_last[..., None] - bcum + ic
    m_loc = jnp.max(a, axis=-1)
    wgt = jnp.exp(a - m_loc[..., None])
    c_loc = jnp.einsum("bhcs,bhcsd,bhcse->bhcde", wgt, vc, kc)
    n_loc = jnp.einsum("bhcs,bhcse->bhce", wgt, kc)

    def step(carry, inp):
        c_st, n_st, m_st = carry
        c_l, n_l, m_l, b_l = inp
        m_new = jnp.maximum(b_l + m_st, m_l)
        s_prev = jnp.exp(b_l + m_st - m_new)
        s_loc = jnp.exp(m_l - m_new)
        c_new = s_prev[..., None, None] * c_st + s_loc[..., None, None] * c_l
        n_new = s_prev[..., None] * n_st + s_loc[..., None] * n_l
        return (c_new, n_new, m_new), (c_st, n_st, m_st)

    final, prev = lax.scan(step, state, (jnp.moveaxis(c_loc, 2, 0), jnp.moveaxis(n_loc, 2, 0), jnp.moveaxis(m_loc, 2, 0), jnp.moveaxis(b_last, 2, 0)))
    c_prev = jnp.moveaxis(prev[0], 0, 2)
    n_prev = jnp.moveaxis(prev[1], 0, 2)
    m_prev = jnp.moveaxis(prev[2], 0, 2)
    mask = jnp.tril(jnp.ones((ML_CHUNK, ML_CHUNK), dtype=bool))
    d_log = jnp.where(mask, bcum[..., :, None] - bcum[..., None, :] + ic[..., None, :], -jnp.inf)
    g_inter = bcum + m_prev[..., None]
    m_out = jnp.maximum(g_inter, jnp.max(d_log, axis=-1))
    scores = jnp.einsum("bhctd,bhcsd->bhcts", qc, kc) * jnp.exp(d_log - m_out[..., None])
    w_inter = jnp.exp(g_inter - m_out)
    num = jnp.einsum("bhcts,bhcsd->bhctd", scores, vc) + w_inter[..., None] * jnp.einsum("bhcde,bhcte->bhctd", c_prev, qc)
    den = jnp.sum(scores, axis=-1) + w_inter * jnp.einsum("bhce,bhcte->bhct", n_prev, qc)
    h = num / jnp.maximum(jnp.abs(den), jnp.exp(-m_out))[..., None]
    return h.reshape(b, nh, length, dh), final


def mlstm_group(p_lat, p_ctx, conv_w, conv_b, w_qk, gate_b, norm_w, skip):
    def prep(p):
        b, length, _ = p.shape
        x_m = p[..., :ML_WIDTH]
        v = p[..., ML_WIDTH:2 * ML_WIDTH]
        o = p[..., 2 * ML_WIDTH:3 * ML_WIDTH]
        g = p[..., 3 * ML_WIDTH:]
        xconv = jax.nn.silu(dwconv_centred(x_m, conv_w, conv_b)).astype(jnp.float32)
        blocks = xconv.reshape(b, length, ML_WIDTH // ML_QK_BLOCK, ML_QK_BLOCK)
        qk = jnp.einsum("blnj,snjk->sblnk", blocks, w_qk.astype(jnp.float32))

        def heads(t):
            return t.reshape(b, length, ML_HEADS, ML_HEADDIM).transpose(0, 2, 1, 3)

        q = heads(qk[0])
        k = heads(qk[1]) * (ML_HEADDIM ** -0.5)
        vh = heads(v.astype(jnp.float32))
        gates = (g.astype(jnp.float32).reshape(b, length, 2, 2, ML_HEADS) + gate_b.astype(jnp.float32)).transpose(2, 3, 0, 4, 1)
        log_i = gates[0]
        log_f = jax.nn.log_sigmoid(gates[1])
        return xconv, o, q, k, vh, log_i, log_f

    xl, ol, ql, kl, vl, il, fl = prep(p_lat)
    xc, oc, qc, kc, vc, ic, fc = prep(p_ctx)
    b = ql.shape[0]
    state0 = (jnp.zeros((b, ML_HEADS, ML_HEADDIM, ML_HEADDIM), jnp.float32), jnp.zeros((b, ML_HEADS, ML_HEADDIM), jnp.float32), jnp.full((b, ML_HEADS), NEG_BIG, jnp.float32))
    hc_f, st_f = mlstm_scan(qc, kc, vc, ic[0], fc[0], state0)
    hl_f, _ = mlstm_scan(ql, kl, vl, il[0], fl[0], st_f)
    hc_b, st_b = mlstm_scan(qc[:, :, ::-1], kc[:, :, ::-1], vc[:, :, ::-1], ic[1][..., ::-1], fc[1][..., ::-1], state0)
    hl_b, _ = mlstm_scan(ql[:, :, ::-1], kl[:, :, ::-1], vl[:, :, ::-1], il[1][..., ::-1], fl[1][..., ::-1], st_b)

    def finish(hf, hb, xconv, o):
        bb, length = xconv.shape[:2]
        h = (hf + hb[:, :, ::-1]).transpose(0, 2, 1, 3)
        h = jax.nn.sigmoid(o.astype(jnp.float32)).reshape(bb, length, ML_HEADS, ML_HEADDIM) * h
        h = h * lax.rsqrt(jnp.mean(h * h, axis=-1, keepdims=True) + EPS)
        return h.reshape(bb, length, ML_WIDTH) * norm_w.astype(jnp.float32) + skip.astype(jnp.float32) * xconv

    return finish(hl_f, hl_b, xl, ol), finish(hc_f, hc_b, xc, oc)


def hmoe(t_in, rg_w, rg_b, re_w, re_b, w_gate, w_up, w_down):
    b, length, d = t_in.shape
    t = t_in.reshape(b * length, d)
    g_logits = (t @ rg_w + rg_b).astype(jnp.float32)
    g_prob = jax.nn.softmax(g_logits, axis=-1)
    g_sel = jnp.argmax(g_logits, axis=-1)
    p_group = jnp.take_along_axis(g_prob, g_sel[:, None], axis=-1)
    e_logits = (t @ re_w + re_b).astype(jnp.float32).reshape(-1, MOE_GROUPS, MOE_EXPERTS_PER_GROUP)
    e_logits = jnp.take_along_axis(e_logits, g_sel[:, None, None], axis=1)[:, 0]
    top_logit, top_idx = lax.top_k(e_logits, MOE_TOP_K)
    top_w = jax.nn.softmax(top_logit, axis=-1) * p_group
    w_in_group = jnp.einsum("tk,tke->te", top_w, jax.nn.one_hot(top_idx, MOE_EXPERTS_PER_GROUP, dtype=jnp.float32))
    combine = jax.nn.one_hot(g_sel, MOE_GROUPS, dtype=jnp.float32)[:, :, None] * w_in_group[:, None, :]
    y = jnp.zeros_like(t)
    for grp in range(MOE_GROUPS):
        lo = grp * MOE_EXPERTS_PER_GROUP
        hi = lo + MOE_EXPERTS_PER_GROUP
        hidden = jax.nn.silu(jnp.einsum("td,edf->tef", t, w_gate[lo:hi])) * jnp.einsum("td,edf->tef", t, w_up[lo:hi])
        hidden = hidden * combine[:, grp, :, None].astype(hidden.dtype)
        y = y + jnp.einsum("tef,efd->td", hidden, w_down[lo:hi])
    return y.reshape(b, length, d)


def setup_inputs(seed: int = 0) -> dict:
    key = jax.random.key(seed)
    ks = iter(jax.random.split(key, 40))
    f32 = jnp.float32

    def nrm(shape, scale):
        return scale * jax.random.normal(next(ks), shape, f32)

    def gain(shape):
        return 1.0 + 0.02 * jax.random.normal(next(ks), shape, f32)

    nl = DEPTH
    x = nrm((BATCH, SEQ, D_MODEL), 1.0)
    c = nrm((BATCH, D_MODEL), 1.0)
    ctx = nrm((BATCH, CTX_LEN, D_MODEL), 1.0)
    c_ctx = nrm((D_MODEL,), 1.0)
    w_mod = nrm((nl, D_MODEL, 6 * D_MODEL), 0.5 * D_MODEL ** -0.5)
    b_mod = nrm((nl, 6 * D_MODEL), 0.01)
    norm1_w = gain((nl, D_MODEL))
    w_in = nrm((nl, D_MODEL, D_IN), D_MODEL ** -0.5)
    ssd_conv_w = nrm((nl, CONV_W, SSD_CONV_DIM), CONV_W ** -0.5)
    ssd_conv_b = nrm((nl, SSD_CONV_DIM), 0.01)
    dt0 = jnp.exp(jax.random.uniform(next(ks), (nl, 2, SSD_HEADS), f32, math.log(1e-3), math.log(1e-1)))
    ssd_dt_bias = dt0 + jnp.log(-jnp.expm1(-dt0))
    ssd_a_log = jnp.log(jax.random.uniform(next(ks), (nl, 2, SSD_HEADS), f32, 1.0, 16.0))
    ssd_d = gain((nl, SSD_HEADS))
    ssd_norm_w = gain((nl, SSD_WIDTH))
    ml_conv_w = nrm((nl, CONV_W, ML_WIDTH), CONV_W ** -0.5)
    ml_conv_b = nrm((nl, ML_WIDTH), 0.01)
    ml_w_qk = nrm((nl, 2, ML_WIDTH // ML_QK_BLOCK, ML_QK_BLOCK, ML_QK_BLOCK), ML_QK_BLOCK ** -0.5)
    ml_gate_b = jnp.stack([nrm((nl, 2, ML_HEADS), 0.1), 3.0 + nrm((nl, 2, ML_HEADS), 0.5)], axis=1)
    ml_norm_w = gain((nl, ML_WIDTH))
    ml_skip = gain((nl, ML_WIDTH))
    w_out = nrm((nl, D_MIX, D_MODEL), D_MIX ** -0.5)
    norm2_w = gain((nl, D_MODEL))
    moe_rg_w = nrm((nl, D_MODEL, MOE_GROUPS), D_MODEL ** -0.5)
    moe_rg_b = nrm((nl, MOE_GROUPS), 0.01)
    moe_re_w = nrm((nl, D_MODEL, MOE_EXPERTS), D_MODEL ** -0.5)
    moe_re_b = nrm((nl, MOE_EXPERTS), 0.01)
    moe_w_gate = nrm((nl, MOE_EXPERTS, D_MODEL, D_EXPERT), D_MODEL ** -0.5)
    moe_w_up = nrm((nl, MOE_EXPERTS, D_MODEL, D_EXPERT), D_MODEL ** -0.5)
    moe_w_down = nrm((nl, MOE_EXPERTS, D_EXPERT, D_MODEL), D_EXPERT ** -0.5)
    final_norm_w = gain((D_MODEL,))
    return {"x": x, "c": c, "ctx": ctx, "c_ctx": c_ctx, "w_mod": w_mod, "b_mod": b_mod, "norm1_w": norm1_w, "w_in": w_in, "ssd_conv_w": ssd_conv_w, "ssd_conv_b": ssd_conv_b, "ssd_dt_bias": ssd_dt_bias, "ssd_a_log": ssd_a_log, "ssd_d": ssd_d, "ssd_norm_w": ssd_norm_w, "ml_conv_w": ml_conv_w, "ml_conv_b": ml_conv_b, "ml_w_qk": ml_w_qk, "ml_gate_b": ml_gate_b, "ml_norm_w": ml_norm_w, "ml_skip": ml_skip, "w_out": w_out, "norm2_w": norm2_w, "moe_rg_w": moe_rg_w, "moe_rg_b": moe_rg_b, "moe_re_w": moe_re_w, "moe_re_b": moe_re_b, "moe_w_gate": moe_w_gate, "moe_w_up": moe_w_up, "moe_w_down": moe_w_down, "final_norm_w": final_norm_w}


def reference(x, c, ctx, c_ctx, w_mod, b_mod, norm1_w, w_in, ssd_conv_w, ssd_conv_b, ssd_dt_bias, ssd_a_log, ssd_d, ssd_norm_w, ml_conv_w, ml_conv_b, ml_w_qk, ml_gate_b, ml_norm_w, ml_skip, w_out, norm2_w, moe_rg_w, moe_rg_b, moe_re_w, moe_re_b, moe_w_gate, moe_w_up, moe_w_down, final_norm_w):
    rows = x.shape[1] // GRID_W
    for layer in range(DEPTH):
        mod_lat = (jax.nn.silu(c) @ w_mod[layer] + b_mod[layer])[:, None, :]
        mod_ctx = jax.nn.silu(c_ctx) @ w_mod[layer] + b_mod[layer]
        sh1, sc1, g1, sh2, sc2, g2 = jnp.split(mod_lat, 6, axis=-1)
        csh1, csc1, cg1, csh2, csc2, cg2 = jnp.split(mod_ctx, 6, axis=-1)
        h_lat = modulate(rms_norm(x, norm1_w[layer]), sh1, sc1)
        h_ctx = modulate(rms_norm(ctx, norm1_w[layer]), csh1, csc1)
        p_lat = h_lat @ w_in[layer]
        p_ctx = h_ctx @ w_in[layer]
        y_ssd_lat, y_ssd_ctx = ssd_group(p_lat[..., :SSD_IN], p_ctx[..., :SSD_IN], ssd_conv_w[layer], ssd_conv_b[layer], ssd_dt_bias[layer], ssd_a_log[layer], ssd_d[layer], ssd_norm_w[layer])
        y_ml_lat, y_ml_ctx = mlstm_group(to_col_major(p_lat[..., SSD_IN:], rows), p_ctx[..., SSD_IN:], ml_conv_w[layer], ml_conv_b[layer], ml_w_qk[layer], ml_gate_b[layer], ml_norm_w[layer], ml_skip[layer])
        y_lat = jnp.concatenate([y_ssd_lat, from_col_major(y_ml_lat, rows)], axis=-1).astype(x.dtype)
        x = x + g1 * (y_lat @ w_out[layer])
        x = x + g2 * hmoe(modulate(rms_norm(x, norm2_w[layer]), sh2, sc2), moe_rg_w[layer], moe_rg_b[layer], moe_re_w[layer], moe_re_b[layer], moe_w_gate[layer], moe_w_up[layer], moe_w_down[layer])
        if layer < DEPTH - 1:
            y_ctx = jnp.concatenate([y_ssd_ctx, y_ml_ctx], axis=-1).astype(ctx.dtype)
            ctx = ctx + cg1 * (y_ctx @ w_out[layer])
            ctx = ctx + cg2 * hmoe(modulate(rms_norm(ctx, norm2_w[layer]), csh2, csc2), moe_rg_w[layer], moe_rg_b[layer], moe_re_w[layer], moe_re_b[layer], moe_w_gate[layer], moe_w_up[layer], moe_w_down[layer])
    return rms_norm(x, final_norm_w)
```

```cpp
#include <hip/hip_runtime.h>
#include <hip/hip_cooperative_groups.h>
#include <cstdio>
#include <cstdint>
namespace cg = cooperative_groups;

#ifndef ONE_LAUNCH
#define ONE_LAUNCH 1
#endif

typedef unsigned short u16;
typedef __attribute__((ext_vector_type(8))) short bf16x8;
typedef __attribute__((ext_vector_type(4))) float f32x4;

constexpr int NT = 256;
constexpr int MLAT = 16384, MALL = 17408;
constexpr int NCH = 34;
constexpr int LDS_BYTES = 75776;
constexpr int NPHASE = 12;

enum { I_X = 0, I_C, I_CTX, I_CCTX, I_WMOD, I_BMOD, I_N1W, I_WIN, I_SCW, I_SCB, I_DTB, I_ALOG, I_SSDD, I_SNW, I_MCW, I_MCB, I_WQK, I_GB,
       I_MNW, I_MSKIP, I_WOUT, I_N2W, I_RGW, I_RGB, I_REW, I_REB, I_WG, I_WU, I_WD, I_FNW };

constexpr size_t al(size_t x) { return (x + 255) & ~(size_t)255; }
constexpr size_t O_MOD = 0;
constexpr size_t O_SSQ = O_MOD + al(5 * 6144 * 4);
constexpr size_t O_CNT = O_SSQ + al(16384 * 16 * 4);
constexpr size_t O_PSD = O_CNT + 4096;
constexpr size_t O_PSG = O_PSD + al((size_t)MALL * 16 * 4);
constexpr size_t O_DT = O_PSG + al((size_t)MALL * 16 * 4);
constexpr size_t O_GI = O_DT + al((size_t)MALL * 16 * 4);
constexpr size_t O_GF = O_GI + al((size_t)MALL * 8 * 4);
constexpr size_t O_ACH = O_GF + al((size_t)MALL * 8 * 4);
constexpr size_t O_MLS = O_ACH + 16384;
constexpr size_t O_MLP = O_MLS + 16384;
constexpr size_t O_MLN = O_MLP + 16384;
constexpr size_t O_LIST = O_MLN + al(4 * 34 * 4 * 2 * 128 * 4);
constexpr size_t O_WTS = O_LIST + al(32 * 16384 * 4);
constexpr size_t O_WIN = O_WTS + al(16384 * 2 * 4);
constexpr size_t O_WOUT = O_WIN + al((size_t)3328 * 1024 * 2);
constexpr size_t O_A = O_WOUT + al((size_t)1024 * 1024 * 2);
constexpr size_t SZ_A = (size_t)MALL * 1024 * 2;
constexpr size_t O_PT = O_A + SZ_A;
constexpr size_t SZ_PT = (size_t)MALL * 1536 * 2;
constexpr size_t O_MLC1 = O_PT + SZ_PT;
constexpr size_t SZ_HALF = (size_t)MALL * 512 * 2;
constexpr size_t O_ZO = O_MLC1 + SZ_HALF;
constexpr size_t O_VT = O_ZO + SZ_A;
constexpr size_t O_BM = O_VT + SZ_HALF;
constexpr size_t SZ_Q = (size_t)MALL * 256 * 2;
constexpr size_t O_BT = O_BM + SZ_Q;
constexpr size_t O_CM = O_BT + SZ_Q;
constexpr size_t O_XT = O_CM + SZ_Q;
constexpr size_t O_KT = O_XT + SZ_HALF;
constexpr size_t O_XC = O_KT + SZ_HALF;
constexpr size_t WS_END = O_XC + SZ_HALF;
constexpr size_t O_XN = O_A, O_Q = O_A, O_K = O_A + SZ_HALF, O_T = O_A;
constexpr size_t O_ST = O_PT;
constexpr size_t O_MLC0 = O_PT + (size_t)4 * 34 * 8 * 2 * 8192 * 2;
constexpr size_t O_WGU = O_PT;
constexpr size_t O_WD = O_PT + (size_t)32 * 512 * 1024 * 2;
constexpr size_t O_SL = O_ZO;
constexpr size_t O_H = O_XT;
static_assert(O_WD + (size_t)32 * 1024 * 256 * 2 <= O_MLC1, "moe weights fit PT region");
static_assert(O_SL + (size_t)16384 * 2 * 1024 * 2 <= O_CM, "slots fit");
static_assert(WS_END <= (size_t)256 * 1024 * 1024, "workspace");
constexpr size_t TCTX512 = (size_t)4 * 512 * 4096;
constexpr size_t TCTX256 = (size_t)4 * 256 * 4096;

struct Params { const float* in[30]; float* out; unsigned char* ws; int lo, hi; };

__device__ __forceinline__ u16 f2bf(float f) { unsigned u = __float_as_uint(f); u += 0x7fffu + ((u >> 16) & 1u); return (u16)(u >> 16); }
__device__ __forceinline__ float bf2f(u16 h) { return __uint_as_float(((unsigned)h) << 16); }
__device__ __forceinline__ unsigned pack2(float a, float b) { return (unsigned)f2bf(a) | ((unsigned)f2bf(b) << 16); }
__device__ __forceinline__ float bflo(unsigned u) { return __uint_as_float(u << 16); }
__device__ __forceinline__ float bfhi(unsigned u) { return __uint_as_float(u & 0xffff0000u); }
__device__ __forceinline__ float siluf(float x) { return x / (1.f + __expf(-x)); }
__device__ __forceinline__ float sigmf(float x) { return 1.f / (1.f + __expf(-x)); }
__device__ __forceinline__ float softplusf(float x) { return x > 20.f ? x : log1pf(__expf(x)); }
__device__ __forceinline__ float wave_sum(float v) {
#pragma unroll
    for (int o = 32; o > 0; o >>= 1) v += __shfl_xor(v, o);
    return v;
}
__device__ __forceinline__ int swz256(int row, int chunk) { return row * 256 + ((chunk ^ (row & 15)) << 4); }
__device__ __forceinline__ int swz128(int row, int chunk) { return row * 128 + ((chunk ^ (row & 7)) << 4); }

__device__ __forceinline__ void load_tile128(char* lds, int lrow0, const u16* __restrict__ g, size_t ld, int rows) {
    const int t = threadIdx.x;
#pragma unroll 4
    for (int q = t; q < rows * 16; q += NT) {
        const int r = q >> 4, c = q & 15;
        const uint4 v = *(const uint4*)(g + (size_t)r * ld + c * 8);
        *(uint4*)(lds + swz256(lrow0 + r, c)) = v;
    }
}
__device__ __forceinline__ void load_tile128_scaled(char* lds, int lrow0, const u16* __restrict__ g, size_t ld, int rows, const float* w) {
    const int t = threadIdx.x;
#pragma unroll 2
    for (int q = t; q < rows * 16; q += NT) {
        const int r = q >> 4, c = q & 15;
        const uint4 v = *(const uint4*)(g + (size_t)r * ld + c * 8);
        const float* ww = w + c * 8;
        uint4 o;
        o.x = pack2(bflo(v.x) * ww[0], bfhi(v.x) * ww[1]);
        o.y = pack2(bflo(v.y) * ww[2], bfhi(v.y) * ww[3]);
        o.z = pack2(bflo(v.z) * ww[4], bfhi(v.z) * ww[5]);
        o.w = pack2(bflo(v.w) * ww[6], bfhi(v.w) * ww[7]);
        *(uint4*)(lds + swz256(lrow0 + r, c)) = o;
    }
}

__device__ __forceinline__ void load_tile128_rowscaled(char* lds, int lrow0, const u16* __restrict__ g, size_t ld, int rows, const float* rs) {
    const int t = threadIdx.x;
#pragma unroll 2
    for (int q = t; q < rows * 16; q += NT) {
        const int r = q >> 4, c = q & 15;
        const uint4 v = *(const uint4*)(g + (size_t)r * ld + c * 8);
        const float f = rs[r];
        uint4 o;
        o.x = pack2(bflo(v.x) * f, bfhi(v.x) * f);
        o.y = pack2(bflo(v.y) * f, bfhi(v.y) * f);
        o.z = pack2(bflo(v.z) * f, bfhi(v.z) * f);
        o.w = pack2(bflo(v.w) * f, bfhi(v.w) * f);
        *(uint4*)(lds + swz256(lrow0 + r, c)) = o;
    }
}

template <int MI, int NJ>
__device__ __forceinline__ void lds_mma(const char* A, const char* B, int arow0, int brow0, f32x4 (&acc)[MI][NJ], int lane) {
#pragma unroll 1
    for (int kk = 0; kk < 4; ++kk) {
        const int chunk = kk * 4 + (lane >> 4);
        bf16x8 a[MI], b[NJ];
#pragma unroll
        for (int i = 0; i < MI; ++i) { const int row = arow0 + i * 16 + (lane & 15); a[i] = *(const bf16x8*)(A + swz256(row, chunk)); }
#pragma unroll
        for (int j = 0; j < NJ; ++j) { const int row = brow0 + j * 16 + (lane & 15); b[j] = *(const bf16x8*)(B + swz256(row, chunk)); }
#pragma unroll
        for (int i = 0; i < MI; ++i)
#pragma unroll
            for (int j = 0; j < NJ; ++j) acc[i][j] = __builtin_amdgcn_mfma_f32_16x16x32_bf16(a[i], b[j], acc[i][j], 0, 0, 0);
    }
}
template <int MI, int NJ>
__device__ __forceinline__ void zero_acc(f32x4 (&acc)[MI][NJ]) {
#pragma unroll
    for (int i = 0; i < MI; ++i)
#pragma unroll
        for (int j = 0; j < NJ; ++j) acc[i][j] = f32x4{0.f, 0.f, 0.f, 0.f};
}

template <int OP>
__device__ __forceinline__ float scan_pair(float v, float* buf) {
    const int t = threadIdx.x, idx = t & 127, base = t & 128;
    buf[t] = v;
    __syncthreads();
#pragma unroll 1
    for (int off = 1; off < 128; off <<= 1) {
        const float o = (idx >= off) ? buf[base + idx - off] : (OP ? -INFINITY : 0.f);
        __syncthreads();
        v = OP ? fmaxf(v, o) : v + o;
        buf[t] = v;
        __syncthreads();
    }
    return v;
}

struct RowPtrs { const u16* a[4]; const u16* b[4]; };
#define GEMM_COMPUTE(cur)                                                                                                   \
    _Pragma("unroll") for (int kk = 0; kk < 2; ++kk) {                                                                      \
        const int chunk = kk * 4 + (lane >> 4);                                                                             \
        bf16x8 a[4], b[4];                                                                                                  \
        _Pragma("unroll") for (int i = 0; i < 4; ++i) { const int row = wm * 64 + i * 16 + (lane & 15); a[i] = *(const bf16x8*)((cur) + swz128(row, chunk)); } \
        _Pragma("unroll") for (int j = 0; j < 4; ++j) { const int row = wn * 64 + j * 16 + (lane & 15); b[j] = *(const bf16x8*)((cur) + 16384 + swz128(row, chunk)); } \
        _Pragma("unroll") for (int i = 0; i < 4; ++i)                                                                       \
            _Pragma("unroll") for (int j = 0; j < 4; ++j) acc[i][j] = __builtin_amdgcn_mfma_f32_16x16x32_bf16(a[i], b[j], acc[i][j], 0, 0, 0); \
    }
#define GEMM_MID()                                                                                                          \
    _Pragma("unroll") for (int i = 0; i < 4; ++i)                                                                           \
        _Pragma("unroll") for (int r = 0; r < 4; ++r) {                                                                     \
            const float s = rowscale[wm * 64 + i * 16 + (lane >> 4) * 4 + r];                                               \
            _Pragma("unroll") for (int j = 0; j < 4; ++j) acc[i][j][r] *= s;                                                \
        }
template <bool MID>
__device__ __forceinline__ void gemm_mainloop(char* lds, const u16* pa0, const u16* pa1, const u16* pa2, const u16* pa3,
                                              const u16* pb0, const u16* pb1, const u16* pb2, const u16* pb3,
                                              int K, f32x4 (&acc)[4][4], const float* rowscale  ) {
    const int t = threadIdx.x, lane = t & 63, w = t >> 6, wm = w >> 1, wn = w & 1;
    const int c = t & 7, r0 = t >> 3;
    const int nk = K >> 6;
    const int o0 = swz128(r0, c), o1 = swz128(r0 + 32, c), o2 = swz128(r0 + 64, c), o3 = swz128(r0 + 96, c);
    uint4 ra0 = *(const uint4*)(pa0 + c * 8), ra1 = *(const uint4*)(pa1 + c * 8), ra2 = *(const uint4*)(pa2 + c * 8), ra3 = *(const uint4*)(pa3 + c * 8);
    uint4 rb0 = *(const uint4*)(pb0 + c * 8), rb1 = *(const uint4*)(pb1 + c * 8), rb2 = *(const uint4*)(pb2 + c * 8), rb3 = *(const uint4*)(pb3 + c * 8);
    *(uint4*)(lds + o0) = ra0; *(uint4*)(lds + o1) = ra1; *(uint4*)(lds + o2) = ra2; *(uint4*)(lds + o3) = ra3;
    *(uint4*)(lds + 16384 + o0) = rb0; *(uint4*)(lds + 16384 + o1) = rb1; *(uint4*)(lds + 16384 + o2) = rb2; *(uint4*)(lds + 16384 + o3) = rb3;
    __syncthreads();
#pragma unroll 1
    for (int kt = 0; kt < nk - 1; ++kt) {
        char* cur = lds + (kt & 1) * 32768;
        char* nxt = lds + ((kt + 1) & 1) * 32768;
        const int k0 = (kt + 1) * 64 + c * 8;
        ra0 = *(const uint4*)(pa0 + k0); ra1 = *(const uint4*)(pa1 + k0); ra2 = *(const uint4*)(pa2 + k0); ra3 = *(const uint4*)(pa3 + k0);
        rb0 = *(const uint4*)(pb0 + k0); rb1 = *(const uint4*)(pb1 + k0); rb2 = *(const uint4*)(pb2 + k0); rb3 = *(const uint4*)(pb3 + k0);
        GEMM_COMPUTE(cur)
        if (MID && kt == 7) { GEMM_MID() }
        *(uint4*)(nxt + o0) = ra0; *(uint4*)(nxt + o1) = ra1; *(uint4*)(nxt + o2) = ra2; *(uint4*)(nxt + o3) = ra3;
        *(uint4*)(nxt + 16384 + o0) = rb0; *(uint4*)(nxt + 16384 + o1) = rb1; *(uint4*)(nxt + 16384 + o2) = rb2; *(uint4*)(nxt + 16384 + o3) = rb3;
        __syncthreads();
    }
    {
        char* cur = lds + ((nk - 1) & 1) * 32768;
        GEMM_COMPUTE(cur)
        __syncthreads();
    }
}

__device__ __forceinline__ void transpose_tile(float* tile, const float* __restrict__ src, int ld_src, int k0, int n0, int ncount,
                                               u16* dst, size_t dst_row0, int ld_dst, const float* __restrict__ scale, int scale_kmax) {
    const int t = threadIdx.x;
    const int n = t & 63, kq = t >> 6;
#pragma unroll 4
    for (int i = 0; i < 16; ++i) {
        const int k = i * 4 + kq;
        float v = 0.f;
        if (n < ncount) { v = src[(size_t)(k0 + k) * ld_src + n0 + n]; if (scale && (k0 + k) < scale_kmax) v *= scale[k0 + k]; }
        tile[k * 65 + n] = v;
    }
    __syncthreads();
#pragma unroll
    for (int i = 0; i < 2; ++i) {
        const int q = t + 256 * i, nn = q >> 3, kc = q & 7;
        if (nn < ncount) {
            const float* p = tile + (kc * 8) * 65 + nn;
            uint4 o;
            o.x = pack2(p[0], p[65]); o.y = pack2(p[130], p[195]); o.z = pack2(p[260], p[325]); o.w = pack2(p[390], p[455]);
            *(uint4*)(dst + (dst_row0 + nn) * (size_t)ld_dst + k0 + kc * 8) = o;
        }
    }
    __syncthreads();
}

__device__ void phase0(const Params& P, char* lds) {
    unsigned char* ws = P.ws;
    const int t = threadIdx.x;
    float* tile = (float*)lds;
    const int NU = 1056 + 7 + 192;
    for (int u = blockIdx.x; u < NU; u += gridDim.x) {
        if (u < 1056) {
            const float* src; int ld, k0, n0, ncount = 64; u16* dst; size_t drow; const float* scale = nullptr;
            if (u < 800) {
                src = P.in[I_WIN]; ld = 3104; dst = (u16*)(ws + O_WIN);
                if (u < 384) { const int nt = u >> 4; k0 = (u & 15) * 64; n0 = nt * 64; drow = nt * 64; }
                else if (u < 768) { const int v = u - 384, nt = v >> 4; k0 = (v & 15) * 64; n0 = 1552 + nt * 64; drow = 1536 + nt * 64; }
                else if (u < 784) { k0 = (u - 768) * 64; n0 = 1536; ncount = 16; drow = 3072; }
                else { k0 = (u - 784) * 64; n0 = 3088; ncount = 16; drow = 3200; }
            } else {
                const int v = u - 800, nt = v >> 4; k0 = (v & 15) * 64; n0 = nt * 64; drow = nt * 64;
                src = P.in[I_WOUT]; ld = 1024; dst = (u16*)(ws + O_WOUT); scale = P.in[I_SNW];
            }
            transpose_tile(tile, src, ld, k0, n0, ncount, dst, drow, 1024, scale, 512);
        } else if (u < 1063) {
            const int base = (u - 1056) * 4096;
            for (int i = 0; i < 16; ++i) {
                const int idx = base + t + 256 * i;
                if (idx < 224 * 128) {
                    const int row = idx >> 7, within = idx & 127;
                    const int ar = row < 112 ? 3088 + row : 3216 + (row - 112);
                    *(uint4*)(ws + O_WIN + ((size_t)ar * 1024 + within * 8) * 2) = make_uint4(0, 0, 0, 0);
                }
            }
        } else {
            const int c0 = (u - 1063) * 32;
            float* sc = (float*)lds;
            float* red = sc + 5 * 1024;
            for (int i = t; i < 5 * 1024; i += NT) {
                const int r = i >> 10, k = i & 1023;
                const float v = r < 4 ? P.in[I_C][r * 1024 + k] : P.in[I_CCTX][k];
                sc[i] = siluf(v);
            }
            __syncthreads();
            const int col = t & 31, kg = t >> 5;
            float a0 = 0, a1 = 0, a2 = 0, a3 = 0, a4 = 0;
            const float* wp = P.in[I_WMOD] + (size_t)(kg * 128) * 6144 + c0 + col;
#pragma unroll 8
            for (int k = 0; k < 128; ++k) {
                const float wv = wp[(size_t)k * 6144];
                const int kk = kg * 128 + k;
                a0 += sc[kk] * wv; a1 += sc[1024 + kk] * wv; a2 += sc[2048 + kk] * wv; a3 += sc[3072 + kk] * wv; a4 += sc[4096 + kk] * wv;
            }
            red[(kg * 5 + 0) * 32 + col] = a0; red[(kg * 5 + 1) * 32 + col] = a1; red[(kg * 5 + 2) * 32 + col] = a2;
            red[(kg * 5 + 3) * 32 + col] = a3; red[(kg * 5 + 4) * 32 + col] = a4;
            __syncthreads();
            if (t < 160) {
                const int r = t >> 5, cc = t & 31;
                float s = P.in[I_BMOD][c0 + cc];
#pragma unroll
                for (int g = 0; g < 8; ++g) s += red[(g * 5 + r) * 32 + cc];
                ((float*)(ws + O_MOD))[r * 6144 + c0 + cc] = s;
            }
            __syncthreads();
        }
    }
    if (blockIdx.x == 0 && t < 32) ((int*)(ws + O_CNT))[t] = 0;
}

__device__ void phase1(const Params& P) {
    unsigned char* ws = P.ws;
    const int lane = threadIdx.x & 63;
    const int gw = blockIdx.x * 4 + (threadIdx.x >> 6), nw = gridDim.x * 4;
    const float* mod = (const float*)(ws + O_MOD);
    u16* xn = (u16*)(ws + O_XN);
    for (int row = gw; row < MALL; row += nw) {
        const float* xr = row < MLAT ? P.in[I_X] + (size_t)row * 1024 : P.in[I_CTX] + (size_t)(row - MLAT) * 1024;
        const int mb = row < MLAT ? (row >> 12) : 4;
        float4 v[4]; float ss = 0.f;
#pragma unroll
        for (int j = 0; j < 4; ++j) { v[j] = ((const float4*)xr)[lane + 64 * j]; ss += v[j].x * v[j].x + v[j].y * v[j].y + v[j].z * v[j].z + v[j].w * v[j].w; }
        ss = wave_sum(ss);
        const float rstd = rsqrtf(ss * (1.f / 1024.f) + 1e-6f);
#pragma unroll
        for (int j = 0; j < 4; ++j) {
            const int k = (lane + 64 * j) * 4;
            const float4 nwv = *(const float4*)(P.in[I_N1W] + k);
            const float4 sh = *(const float4*)(mod + mb * 6144 + k);
            const float4 sc = *(const float4*)(mod + mb * 6144 + 1024 + k);
            const float h0 = v[j].x * rstd * nwv.x * (1.f + sc.x) + sh.x;
            const float h1 = v[j].y * rstd * nwv.y * (1.f + sc.y) + sh.y;
            const float h2 = v[j].z * rstd * nwv.z * (1.f + sc.z) + sh.z;
            const float h3 = v[j].w * rstd * nwv.w * (1.f + sc.w) + sh.w;
            uint2 o; o.x = pack2(h0, h1); o.y = pack2(h2, h3);
            *(uint2*)(xn + (size_t)row * 1024 + k) = o;
        }
    }
}

__device__ __forceinline__ int colmajor_src_row(int R) {
    if (R >= MLAT) return R;
    const int b = R >> 12, lp = R & 4095;
    return (b << 12) + ((lp & 63) << 6) + (lp >> 6);
}
__device__ void phase2(const Params& P, char* lds) {
    unsigned char* ws = P.ws;
    const int t = threadIdx.x, lane = t & 63, w = t >> 6, wm = w >> 1, wn = w & 1;
    const u16* xn = (const u16*)(ws + O_XN);
    const u16* wt = (const u16*)(ws + O_WIN);
    const int NU = 136 * 26;
    for (int u = blockIdx.x; u < NU; u += gridDim.x) {
        const int mt = u / 26, nt = u % 26;
        const bool cmaj = (nt >= 12 && nt < 20) || nt == 25;
        RowPtrs rp;
#pragma unroll
        for (int i = 0; i < 4; ++i) {
            const int r = (t >> 3) + 32 * i;
            const int R = mt * 128 + r;
            const int sr = cmaj ? colmajor_src_row(R) : R;
            rp.a[i] = xn + (size_t)sr * 1024;
            rp.b[i] = wt + (size_t)(nt * 128 + r) * 1024;
        }
        f32x4 acc[4][4]; zero_acc(acc);
        gemm_mainloop<false>(lds, rp.a[0], rp.a[1], rp.a[2], rp.a[3], rp.b[0], rp.b[1], rp.b[2], rp.b[3], 1024, acc, nullptr);
        const int colb = nt * 128 + wn * 64 + (lane & 15);
#pragma unroll
        for (int i = 0; i < 4; ++i) {
            const int R0 = mt * 128 + wm * 64 + i * 16 + (lane >> 4) * 4;
#pragma unroll
            for (int j = 0; j < 4; ++j) {
                const int col = colb + j * 16;
                const f32x4 a = acc[i][j];
                if (nt < 4) {
                    u16* d = (u16*)(ws + O_ZO) + (size_t)R0 * 1024 + col;
                    d[0] = f2bf(a[0]); d[1024] = f2bf(a[1]); d[2048] = f2bf(a[2]); d[3072] = f2bf(a[3]);
                } else if (nt < 12) {
                    u16* d = (u16*)(ws + O_PT) + (size_t)R0 * 1536 + (col - 512);
                    d[0] = f2bf(a[0]); d[1536] = f2bf(a[1]); d[3072] = f2bf(a[2]); d[4608] = f2bf(a[3]);
                } else if (nt < 16) {
                    u16* d = (u16*)(ws + O_PT) + (size_t)R0 * 1536 + 1024 + (col - 1536);
                    d[0] = f2bf(a[0]); d[1536] = f2bf(a[1]); d[3072] = f2bf(a[2]); d[4608] = f2bf(a[3]);
                } else if (nt < 20) {
                    const int ch = col - 2048;
                    u16* d;
                    if (R0 < MLAT) { const int b = R0 >> 12, lp = R0 & 4095; d = (u16*)(ws + O_VT) + ((size_t)(b * 512 + ch)) * 4096 + lp; }
                    else { const int Rc = R0 - MLAT, b = Rc >> 8, l = Rc & 255; d = (u16*)(ws + O_VT) + TCTX512 + ((size_t)(b * 512 + ch)) * 256 + l; }
                    uint2 o; o.x = pack2(a[0], a[1]); o.y = pack2(a[2], a[3]);
                    *(uint2*)d = o;
                } else if (nt < 24) {
                    u16* d = (u16*)(ws + O_ZO) + (size_t)R0 * 1024 + 512 + (col - 2560);
                    d[0] = f2bf(a[0]); d[1024] = f2bf(a[1]); d[2048] = f2bf(a[2]); d[3072] = f2bf(a[3]);
                } else {
                    const int cs = col - nt * 128;
                    if (cs < 16) {
                        float* d = (float*)(ws + (nt == 24 ? O_PSD : O_PSG)) + (size_t)R0 * 16 + cs;
                        d[0] = a[0]; d[16] = a[1]; d[32] = a[2]; d[48] = a[3];
                    }
                }
            }
        }
    }
}

__device__ void phase3(const Params& P, char* lds) {
    unsigned char* ws = P.ws;
    const int t = threadIdx.x;
    u16* raw = (u16*)lds;
    float* xcl = (float*)(lds + 132 * 128);
    const u16* pt = (const u16*)(ws + O_PT);
    const int NCONV = 136 * 24;
    const int NU = NCONV + 136;
    for (int u = blockIdx.x; u < NU; u += gridDim.x) {
        if (u >= NCONV) {
            const int ct = u - NCONV, b = ct / NCH, cc = ct % NCH;
            const int rb = cc < 2 ? MLAT + b * 256 + cc * 128 : b * 4096 + (cc - 2) * 128;
            const int row = rb + (t >> 1), half = t & 1;
            const float* psd = (const float*)(ws + O_PSD) + (size_t)row * 16 + half * 8;
            float* dt = (float*)(ws + O_DT) + (size_t)row * 16 + half * 8;
#pragma unroll
            for (int j = 0; j < 8; ++j) dt[j] = softplusf(psd[j] + P.in[I_DTB][half * 8 + j]);
            const float* psg = (const float*)(ws + O_PSG) + (size_t)row * 16;
            if (half == 0) {
                float* gi = (float*)(ws + O_GI) + (size_t)row * 8;
#pragma unroll
                for (int j = 0; j < 8; ++j) gi[j] = psg[j] + P.in[I_GB][j];
            } else {
                float* gf = (float*)(ws + O_GF) + (size_t)row * 8;
#pragma unroll
                for (int j = 0; j < 8; ++j) { const float xx = psg[8 + j] + P.in[I_GB][8 + j]; gf[j] = fminf(xx, 0.f) - log1pf(__expf(-fabsf(xx))); }
            }
            continue;
        }
        const int ct = u / 24, cgp = u % 24;
        const int b = ct / NCH, cc = ct % NCH;
        const bool isctx = cc < 2;
        const int L = isctx ? 256 : 4096;
        const int lpos = isctx ? cc * 128 : (cc - 2) * 128;
        const int rb = isctx ? MLAT + b * 256 + cc * 128 : b * 4096 + (cc - 2) * 128;
        const int sb = rb - lpos;
        const bool isml = cgp >= 16;
        const int pcol = isml ? 1024 + (cgp - 16) * 64 : cgp * 64;
        for (int q = t; q < 132 * 8; q += NT) {
            const int r = q >> 3, c = q & 7;
            const int l = lpos - 2 + r;
            uint4 v = make_uint4(0, 0, 0, 0);
            if (l >= 0 && l < L) v = *(const uint4*)(pt + (size_t)(sb + l) * 1536 + pcol + c * 8);
            *(uint4*)(raw + r * 64 + c * 8) = v;
        }
        __syncthreads();
        const int ch = t & 63, tg = t >> 6;
        const float* cw = isml ? P.in[I_MCW] + (cgp - 16) * 64 + ch : P.in[I_SCW] + cgp * 64 + ch;
        const int cwld = isml ? 512 : 1024;
        const float w0 = cw[0], w1 = cw[cwld], w2 = cw[2 * cwld], w3 = cw[3 * cwld], w4 = cw[4 * cwld];
        const float bias = isml ? P.in[I_MCB][(cgp - 16) * 64 + ch] : P.in[I_SCB][cgp * 64 + ch];
        const int tok0 = tg * 32;
        float x0 = bf2f(raw[(tok0 + 0) * 64 + ch]), x1 = bf2f(raw[(tok0 + 1) * 64 + ch]), x2 = bf2f(raw[(tok0 + 2) * 64 + ch]), x3 = bf2f(raw[(tok0 + 3) * 64 + ch]);
        if (!isml) {
            u16* tdst = nullptr; u16* ndst = nullptr;
            if (cgp < 8) {
                const int chg = cgp * 64 + ch;
                tdst = (u16*)(ws + O_XT) + (isctx ? TCTX512 + ((size_t)(b * 512 + chg)) * 256 : ((size_t)(b * 512 + chg)) * 4096) + lpos + tok0;
            } else if (cgp < 12) {
                const int gn = (cgp - 8) * 64 + ch;
                tdst = (u16*)(ws + O_BT) + (isctx ? TCTX256 + ((size_t)(b * 256 + gn)) * 256 : ((size_t)(b * 256 + gn)) * 4096) + lpos + tok0;
                ndst = (u16*)(ws + O_BM) + (size_t)(rb + tok0) * 256 + gn;
            } else {
                const int gn = (cgp - 12) * 64 + ch;
                ndst = (u16*)(ws + O_CM) + (size_t)(rb + tok0) * 256 + gn;
            }
#pragma unroll
            for (int o8 = 0; o8 < 4; ++o8) {
                float ov[8];
#pragma unroll
                for (int j = 0; j < 8; ++j) {
                    const int tok = tok0 + o8 * 8 + j;
                    const float x4 = bf2f(raw[(tok + 4) * 64 + ch]);
                    const float cv = bias + w0 * x0 + w1 * x1 + w2 * x2 + w3 * x3 + w4 * x4;
                    ov[j] = siluf(cv);
                    x0 = x1; x1 = x2; x2 = x3; x3 = x4;
                }
                if (tdst) { uint4 o; o.x = pack2(ov[0], ov[1]); o.y = pack2(ov[2], ov[3]); o.z = pack2(ov[4], ov[5]); o.w = pack2(ov[6], ov[7]); *(uint4*)(tdst + o8 * 8) = o; }
                if (ndst) {
#pragma unroll
                    for (int j = 0; j < 8; ++j) ndst[(size_t)(o8 * 8 + j) * 256] = f2bf(ov[j]);
                }
            }
            __syncthreads();
        } else {
            const int mg = cgp - 16;
            u16* xcd = (u16*)(ws + O_XC) + (size_t)(rb + tok0) * 512 + mg * 64 + ch;
#pragma unroll 8
            for (int j = 0; j < 32; ++j) {
                const int tok = tok0 + j;
                const float x4 = bf2f(raw[(tok + 4) * 64 + ch]);
                const float cv = bias + w0 * x0 + w1 * x1 + w2 * x2 + w3 * x3 + w4 * x4;
                const float sv = siluf(cv);
                xcl[tok * 64 + ch] = sv;
                xcd[(size_t)j * 512] = f2bf(sv);
                x0 = x1; x1 = x2; x2 = x3; x3 = x4;
            }
            __syncthreads();
            const int n = ch >> 2, kk = ch & 3, ng = mg * 16 + n;
            const float* wq = P.in[I_WQK] + ((size_t)(0 * 128 + ng) * 4) * 4 + kk;
            const float* wk = P.in[I_WQK] + ((size_t)(1 * 128 + ng) * 4) * 4 + kk;
            const float q0 = wq[0], q1 = wq[4], q2 = wq[8], q3 = wq[12];
            const float k0 = wk[0], k1 = wk[4], k2 = wk[8], k3 = wk[12];
            const int chg = mg * 64 + ch;
            u16* qd = (u16*)(ws + O_Q) + (size_t)(rb + tok0) * 512 + chg;
            u16* kd = (u16*)(ws + O_K) + (size_t)(rb + tok0) * 512 + chg;
            u16* ktd = (u16*)(ws + O_KT) + (isctx ? TCTX512 + ((size_t)(b * 512 + chg)) * 256 : ((size_t)(b * 512 + chg)) * 4096) + lpos + tok0;
#pragma unroll
            for (int o8 = 0; o8 < 4; ++o8) {
                float kv[8];
#pragma unroll
                for (int j = 0; j < 8; ++j) {
                    const int tok = tok0 + o8 * 8 + j;
                    const float4 xv = *(const float4*)(xcl + tok * 64 + n * 4);
                    const float qv = xv.x * q0 + xv.y * q1 + xv.z * q2 + xv.w * q3;
                    kv[j] = (xv.x * k0 + xv.y * k1 + xv.z * k2 + xv.w * k3) * 0.08838834764831845f;
                    qd[(size_t)(o8 * 8 + j) * 512] = f2bf(qv);
                    kd[(size_t)(o8 * 8 + j) * 512] = f2bf(kv[j]);
                }
                uint4 o; o.x = pack2(kv[0], kv[1]); o.y = pack2(kv[2], kv[3]); o.z = pack2(kv[4], kv[5]); o.w = pack2(kv[6], kv[7]);
                *(uint4*)(ktd + o8 * 8) = o;
            }
            __syncthreads();
        }
    }
}

__device__ void phase4(const Params& P, char* lds) {
    unsigned char* ws = P.ws;
    const int t = threadIdx.x, lane = t & 63, w = t >> 6, wm = w >> 1, wn = w & 1;
    char* T0 = lds; char* T1 = lds + 32768;
    float* sc = (float*)(lds + 65536);
    float* sbuf = sc;
    float* wA = sc + 256;
    float* wB = sc + 384;
    float* redm = sc + 512;
    const int NSSD = 4 * NCH * 8, NML = 4 * NCH * 4;
    for (int u = blockIdx.x; u < NSSD + NML; u += gridDim.x) {
        if (u < NSSD) {
            const int h = u & 7, ct = u >> 3, b = ct / NCH, cc = ct % NCH;
            const bool isctx = cc < 2;
            const int L = isctx ? 256 : 4096;
            const int lpos = isctx ? cc * 128 : (cc - 2) * 128;
            const int rb = isctx ? MLAT + b * 256 + cc * 128 : b * 4096 + (cc - 2) * 128;
            const int dir = t >> 7, idx = t & 127;
            const int l = dir ? 127 - idx : idx;
            const float dtv = ((const float*)(ws + O_DT))[(size_t)(rb + l) * 16 + dir * 8 + h];
            const float an = -__expf(P.in[I_ALOG][dir * 8 + h]);
            const float cs = scan_pair<0>(dtv * an, sbuf);
            const float tot = sbuf[dir * 128 + 127];
            const float wv = __expf(tot - cs) * dtv;
            if (dir == 0) wA[l] = wv; else wB[l] = wv;
            if (idx == 127) ((float*)(ws + O_ACH))[((size_t)(b * NCH + cc) * 8 + h) * 2 + dir] = cs;
            __syncthreads();
            const int g = h >> 2;
            const u16* xt = (const u16*)(ws + O_XT) + (isctx ? TCTX512 + ((size_t)(b * 512 + h * 64)) * 256 : ((size_t)(b * 512 + h * 64)) * 4096) + lpos;
            const u16* bt = (const u16*)(ws + O_BT) + (isctx ? TCTX256 + ((size_t)(b * 256 + g * 128)) * 256 : ((size_t)(b * 256 + g * 128)) * 4096) + lpos;
            load_tile128_scaled(T0, 0, xt, L, 64, wA);
            load_tile128_scaled(T0, 64, xt, L, 64, wB);
            load_tile128(T1, 0, bt, L, 128);
            __syncthreads();
            f32x4 acc[4][4]; zero_acc(acc);
            lds_mma<4, 4>(T0, T1, wm * 64, wn * 64, acc, lane);
            u16* st = (u16*)(ws + O_ST) + (((size_t)(b * NCH + cc) * 8 + h) * 2 + wm) * 8192 + ((lane >> 4) * 4) * 128 + wn * 64 + (lane & 15);
#pragma unroll
            for (int i = 0; i < 4; ++i)
#pragma unroll
                for (int j = 0; j < 4; ++j)
#pragma unroll
                    for (int r = 0; r < 4; ++r) st[(i * 16 + r) * 128 + j * 16] = f2bf(acc[i][j][r]);
            __syncthreads();
        } else {
            const int v = u - NSSD;
            const int h = v & 3, ct = v >> 2, b = ct / NCH, cc = ct % NCH;
            const bool isctx = cc < 2;
            const int L = isctx ? 256 : 4096;
            const int lpos = isctx ? cc * 128 : (cc - 2) * 128;
            const int rb = isctx ? MLAT + b * 256 + cc * 128 : b * 4096 + (cc - 2) * 128;
            const int dir = t >> 7, idx = t & 127;
            const int s = dir ? 127 - idx : idx;
            const float fv = ((const float*)(ws + O_GF))[(size_t)(rb + s) * 8 + dir * 4 + h];
            const float iv = ((const float*)(ws + O_GI))[(size_t)(rb + s) * 8 + dir * 4 + h];
            const float bc = scan_pair<0>(fv, sbuf);
            const float tot = sbuf[dir * 128 + 127];
            const float av = tot - bc + iv;
            __syncthreads();
            const float mx = scan_pair<1>(av, sbuf);
            (void)mx;
            const float mloc = sbuf[dir * 128 + 127];
            const float wv = __expf(av - mloc);
            if (dir == 0) wA[s] = wv; else wB[s] = wv;
            if (idx == 0) {
                float* mls = (float*)(ws + O_MLS) + (((size_t)(b * NCH + cc) * 4 + h) * 2 + dir) * 2;
                mls[0] = mloc; mls[1] = tot;
            }
            __syncthreads();
            const u16* vt = (const u16*)(ws + O_VT) + (isctx ? TCTX512 + ((size_t)(b * 512 + h * 128)) * 256 : ((size_t)(b * 512 + h * 128)) * 4096) + lpos;
            const u16* kt = (const u16*)(ws + O_KT) + (isctx ? TCTX512 + ((size_t)(b * 512 + h * 128)) * 256 : ((size_t)(b * 512 + h * 128)) * 4096) + lpos;
            load_tile128(T1, 0, kt, L, 128);
#pragma unroll 1
            for (int d2 = 0; d2 < 2; ++d2) {
                load_tile128_scaled(T0, 0, vt, L, 128, d2 ? wB : wA);
                __syncthreads();
                f32x4 acc[4][4]; zero_acc(acc);
                lds_mma<4, 4>(T0, T1, wm * 64, wn * 64, acc, lane);
                u16* cst = (u16*)(ws + (d2 ? O_MLC1 : O_MLC0)) + ((size_t)(b * NCH + cc) * 4 + h) * 16384 + (wm * 64 + (lane >> 4) * 4) * 128 + wn * 64 + (lane & 15);
#pragma unroll
                for (int i = 0; i < 4; ++i)
#pragma unroll
                    for (int j = 0; j < 4; ++j)
#pragma unroll
                        for (int r = 0; r < 4; ++r) cst[(i * 16 + r) * 128 + j * 16] = f2bf(acc[i][j][r]);
                if (d2 == 0) {
                    const float* wgt = dir ? wB : wA;
                    float nacc = 0.f;
#pragma unroll 4
                    for (int c = 0; c < 16; ++c) {
                        const uint4 kv = *(const uint4*)(T1 + swz256(idx, c));
                        const float* ww = wgt + c * 8;
                        nacc += bflo(kv.x) * ww[0] + bfhi(kv.x) * ww[1] + bflo(kv.y) * ww[2] + bfhi(kv.y) * ww[3]
                              + bflo(kv.z) * ww[4] + bfhi(kv.z) * ww[5] + bflo(kv.w) * ww[6] + bfhi(kv.w) * ww[7];
                    }
                    ((float*)(ws + O_MLN))[(((size_t)(b * NCH + cc) * 4 + h) * 2 + dir) * 128 + idx] = nacc;
                }
                __syncthreads();
            }
        }
    }
    (void)redm;
}

__device__ __forceinline__ int scan_cc(int dir, int step) { return dir == 0 ? step : (step < 2 ? 1 - step : 35 - step); }
__device__ void phase5(const Params& P) {
    unsigned char* ws = P.ws;
    const int t = threadIdx.x;
    for (int u = blockIdx.x; u < 256 + 256 + 32; u += gridDim.x) {
        if (u < 256) {
            const int chain = u >> 2, part = u & 3;
            const int b = chain >> 4, h = (chain >> 1) & 7, dir = chain & 1;
            const int off = part * 2048 + t * 8;
            float S[8];
#pragma unroll
            for (int j = 0; j < 8; ++j) S[j] = 0.f;
#pragma unroll 2
            for (int step = 0; step < NCH; ++step) {
                const int cc = scan_cc(dir, step);
                u16* p = (u16*)(ws + O_ST) + (((size_t)(b * NCH + cc) * 8 + h) * 2 + dir) * 8192 + off;
                const uint4 lv = *(const uint4*)p;
                const float dec = __expf(((const float*)(ws + O_ACH))[((size_t)(b * NCH + cc) * 8 + h) * 2 + dir]);
                uint4 o; o.x = pack2(S[0], S[1]); o.y = pack2(S[2], S[3]); o.z = pack2(S[4], S[5]); o.w = pack2(S[6], S[7]);
                *(uint4*)p = o;
                S[0] = dec * S[0] + bflo(lv.x); S[1] = dec * S[1] + bfhi(lv.x); S[2] = dec * S[2] + bflo(lv.y); S[3] = dec * S[3] + bfhi(lv.y);
                S[4] = dec * S[4] + bflo(lv.z); S[5] = dec * S[5] + bfhi(lv.z); S[6] = dec * S[6] + bflo(lv.w); S[7] = dec * S[7] + bfhi(lv.w);
            }
        } else if (u < 512) {
            const int v = u - 256;
            const int chain = v >> 3, part = v & 7;
            const int b = chain >> 3, h = (chain >> 1) & 3, dir = chain & 1;
            const int off = part * 2048 + t * 8;
            float S[8];
#pragma unroll
            for (int j = 0; j < 8; ++j) S[j] = 0.f;
            float m = -1e30f;
#pragma unroll 2
            for (int step = 0; step < NCH; ++step) {
                const int cc = scan_cc(dir, step);
                u16* p = (u16*)(ws + (dir ? O_MLC1 : O_MLC0)) + ((size_t)(b * NCH + cc) * 4 + h) * 16384 + off;
                const uint4 lv = *(const uint4*)p;
                const float* mls = (const float*)(ws + O_MLS) + (((size_t)(b * NCH + cc) * 4 + h) * 2 + dir) * 2;
                const float ml = mls[0], bl = mls[1];
                const float mn = fmaxf(bl + m, ml);
                const float sp = __expf(bl + m - mn), sl = __expf(ml - mn);
                if (part == 0 && t == 0) ((float*)(ws + O_MLP))[((size_t)(b * NCH + cc) * 4 + h) * 2 + dir] = m;
                uint4 o; o.x = pack2(S[0], S[1]); o.y = pack2(S[2], S[3]); o.z = pack2(S[4], S[5]); o.w = pack2(S[6], S[7]);
                *(uint4*)p = o;
                S[0] = sp * S[0] + sl * bflo(lv.x); S[1] = sp * S[1] + sl * bfhi(lv.x); S[2] = sp * S[2] + sl * bflo(lv.y); S[3] = sp * S[3] + sl * bfhi(lv.y);
                S[4] = sp * S[4] + sl * bflo(lv.z); S[5] = sp * S[5] + sl * bfhi(lv.z); S[6] = sp * S[6] + sl * bflo(lv.w); S[7] = sp * S[7] + sl * bfhi(lv.w);
                m = mn;
            }
        } else {
            const int chain = u - 512;
            const int b = chain >> 3, h = (chain >> 1) & 3, dir = chain & 1;
            if (t < 128) {
                float nS = 0.f, m = -1e30f;
                for (int step = 0; step < NCH; ++step) {
                    const int cc = scan_cc(dir, step);
                    float* p = (float*)(ws + O_MLN) + (((size_t)(b * NCH + cc) * 4 + h) * 2 + dir) * 128 + t;
                    const float lv = *p;
                    const float* mls = (const float*)(ws + O_MLS) + (((size_t)(b * NCH + cc) * 4 + h) * 2 + dir) * 2;
                    const float ml = mls[0], bl = mls[1];
                    const float mn = fmaxf(bl + m, ml);
                    const float sp = __expf(bl + m - mn), sl = __expf(ml - mn);
                    *p = nS;
                    nS = sp * nS + sl * lv;
                    m = mn;
                }
            }
        }
    }
}

__device__ void phase6(const Params& P, char* lds) {
    unsigned char* ws = P.ws;
    const int t = threadIdx.x;
    char* T0 = lds; char* T1 = lds + 32768;
    float* sc = (float*)(lds + 65536);
    float* sbuf = sc;
    float* a0 = sc + 256;
    float* a1 = sc + 384;
    float* a2 = sc + 512;
    float* a3 = sc + 640;
    float* a4 = sc + 768;
    float* a5 = sc + 896;
    float* rsA = sc + 1024;
    float* qn = sc + 1536;
    float* fac = sc + 1792;
    float* wfac = sc + 2048;
    const int NSSD = 4 * 32 * 8, NML = 4 * 32 * 4;
    for (int u = blockIdx.x; u < NSSD + NML; u += gridDim.x) {
        int tq = t; asm volatile("" : "+v"(tq));
        const int lane = tq & 63, w = tq >> 6, wm = w >> 1, wn = w & 1;
        if (u < NSSD) {
            const int h = u & 7, ct = u >> 3, b = ct >> 5, c = ct & 31, cc = c + 2;
            const int rb = b * 4096 + c * 128, lpos = c * 128, g = h >> 2;
            {
                const int dir = t >> 7, idx = t & 127;
                const int l = dir ? 127 - idx : idx;
                const float dtv = ((const float*)(ws + O_DT))[(size_t)(rb + l) * 16 + dir * 8 + h];
                const float an = -__expf(P.in[I_ALOG][dir * 8 + h]);
                const float cs = scan_pair<0>(dtv * an, sbuf);
                if (dir == 0) { a0[l] = cs; a2[l] = dtv; } else { a1[l] = cs; a3[l] = dtv; }
            }
            load_tile128(T0, 0, (const u16*)(ws + O_CM) + (size_t)rb * 256 + g * 128, 256, 128);
            {
                const u16* sf = (const u16*)(ws + O_ST) + (((size_t)(b * NCH + cc) * 8 + h) * 2 + 0) * 8192;
                load_tile128(T1, 0, sf, 128, 64);
                load_tile128(T1, 64, sf + 8192, 128, 64);
            }
            __syncthreads();
            f32x4 Y[4][2];
            {
                f32x4 aF[4][2], aB[4][2]; zero_acc(aF); zero_acc(aB);
                lds_mma<4, 2>(T0, T1, wm * 64, wn * 32, aF, lane);
                lds_mma<4, 2>(T0, T1, wm * 64, 64 + wn * 32, aB, lane);
#pragma unroll
                for (int i = 0; i < 4; ++i)
#pragma unroll
                    for (int r = 0; r < 4; ++r) {
                        const int l = wm * 64 + i * 16 + (lane >> 4) * 4 + r;
                        const float e0 = __expf(a0[l]), e1 = __expf(a1[l]);
#pragma unroll
                        for (int j = 0; j < 2; ++j) Y[i][j][r] = e0 * aF[i][j][r] + e1 * aB[i][j][r];
                    }
            }
            __syncthreads();
            load_tile128(T1, 0, (const u16*)(ws + O_BM) + (size_t)rb * 256 + g * 128, 256, 128);
            __syncthreads();
            f32x4 G[4][4]; zero_acc(G);
            lds_mma<4, 4>(T0, T1, wm * 64, wn * 64, G, lane);
            __syncthreads();
            float sv0[4], sv1[4], sv2[4], sv3[4];
            int dbase = wn * 64 + (lane & 15) - wm * 64 - (lane >> 4) * 4; asm volatile("" : "+v"(dbase));
#pragma unroll
            for (int j = 0; j < 4; ++j) { const int s = wn * 64 + j * 16 + (lane & 15); sv0[j] = a0[s]; sv1[j] = a1[s]; sv2[j] = a2[s]; sv3[j] = a3[s]; }
#pragma unroll
            for (int i = 0; i < 4; ++i)
#pragma unroll
                for (int r = 0; r < 4; ++r) {
                    const int l = wm * 64 + i * 16 + (lane >> 4) * 4 + r;
                    const float c0l = a0[l], r1l = a1[l];
#pragma unroll
                    for (int j = 0; j < 4; ++j) {
                        const int s = wn * 64 + j * 16 + (lane & 15);
                        const int diff = dbase + (j * 16 - i * 16 - r);
                        const float e0 = (diff <= 0) ? (c0l - sv0[j]) : -INFINITY;
                        const float e1 = (diff >= 0) ? (r1l - sv1[j]) : -INFINITY;
                        const float f = __expf(e0) * sv2[j] + __expf(e1) * sv3[j];
                        *(u16*)(T0 + swz256(l, s >> 3) + (s & 7) * 2) = f2bf(G[i][j][r] * f);
                    }
                }
            load_tile128(T1, 0, (const u16*)(ws + O_XT) + ((size_t)(b * 512 + h * 64)) * 4096 + lpos, 4096, 64);
            __syncthreads();
            lds_mma<4, 2>(T0, T1, wm * 64, wn * 32, Y, lane);
            const float Dh = P.in[I_SSDD][h];
            u16* zo = (u16*)(ws + O_ZO);
#pragma unroll
            for (int i = 0; i < 4; ++i)
#pragma unroll
                for (int r = 0; r < 4; ++r) {
                    const int l = wm * 64 + i * 16 + (lane >> 4) * 4 + r;
                    float ssq = 0.f;
#pragma unroll
                    for (int j = 0; j < 2; ++j) {
                        const int p = wn * 32 + j * 16 + (lane & 15);
                        const float xv = bf2f(*(const u16*)(T1 + swz256(p, l >> 3) + (l & 7) * 2));
                        u16* zp = zo + (size_t)(rb + l) * 1024 + h * 64 + p;
                        const float z = bf2f(*zp);
                        const float y = (Y[i][j][r] + Dh * xv) * siluf(z);
                        *zp = f2bf(y);
                        ssq += y * y;
                    }
                    ssq += __shfl_xor(ssq, 1); ssq += __shfl_xor(ssq, 2); ssq += __shfl_xor(ssq, 4); ssq += __shfl_xor(ssq, 8);
                    if ((lane & 15) == 0) ((float*)(ws + O_SSQ))[(size_t)(rb + l) * 16 + h * 2 + wn] = ssq;
                }
            __syncthreads();
        } else {
            const int v = u - NSSD;
            const int h = v & 3, ct = v >> 2, b = ct >> 5, c = ct & 31, cc = c + 2;
            const int rb = b * 4096 + c * 128, lpos = c * 128;
            const float mp0 = ((const float*)(ws + O_MLP))[((size_t)(b * NCH + cc) * 4 + h) * 2 + 0];
            const float mp1 = ((const float*)(ws + O_MLP))[((size_t)(b * NCH + cc) * 4 + h) * 2 + 1];
            {
                const int dir = t >> 7, idx = t & 127;
                const int s = dir ? 127 - idx : idx;
                const float fv = ((const float*)(ws + O_GF))[(size_t)(rb + s) * 8 + dir * 4 + h];
                const float iv = ((const float*)(ws + O_GI))[(size_t)(rb + s) * 8 + dir * 4 + h];
                const float bc = scan_pair<0>(fv, sbuf);
                const float uv = iv - bc;
                __syncthreads();
                const float mx = scan_pair<1>(uv, sbuf);
                const float mm = fmaxf(dir ? mp1 : mp0, mx);
                if (dir == 0) { a0[s] = bc; a2[s] = uv; a4[s] = mm; } else { a1[s] = bc; a3[s] = uv; a5[s] = mm; }
            }
            load_tile128(T0, 0, (const u16*)(ws + O_Q) + (size_t)rb * 512 + h * 128, 512, 128);
            load_tile128(T1, 0, (const u16*)(ws + O_K) + (size_t)rb * 512 + h * 128, 512, 128);
            __syncthreads();
            f32x4 S[4][4]; zero_acc(S);
            lds_mma<4, 4>(T0, T1, wm * 64, wn * 64, S, lane);
            {
                const int dir = t >> 7, idx = t & 127;
                const float* np = (const float*)(ws + O_MLN) + (((size_t)(b * NCH + cc) * 4 + h) * 2 + dir) * 128;
                float acc = 0.f;
#pragma unroll 4
                for (int cch = 0; cch < 16; ++cch) {
                    const uint4 qv = *(const uint4*)(T0 + swz256(idx, cch));
                    const float4 n0 = *(const float4*)(np + cch * 8), n1 = *(const float4*)(np + cch * 8 + 4);
                    acc += bflo(qv.x) * n0.x + bfhi(qv.x) * n0.y + bflo(qv.y) * n0.z + bfhi(qv.y) * n0.w
                         + bflo(qv.z) * n1.x + bfhi(qv.z) * n1.y + bflo(qv.w) * n1.z + bfhi(qv.w) * n1.w;
                }
                qn[dir * 128 + idx] = acc;
            }
            float su0[4], su1[4];
            int dbase = wn * 64 + (lane & 15) - wm * 64 - (lane >> 4) * 4; asm volatile("" : "+v"(dbase));
#pragma unroll
            for (int j = 0; j < 4; ++j) { const int s = wn * 64 + j * 16 + (lane & 15); su0[j] = a2[s]; su1[j] = a3[s]; }
#pragma unroll
            for (int i = 0; i < 4; ++i)
#pragma unroll
                for (int r = 0; r < 4; ++r) {
                    const int tt = wm * 64 + i * 16 + (lane >> 4) * 4 + r;
                    const float m0 = a4[tt], m1 = a5[tt];
                    float r0 = 0.f, r1 = 0.f;
#pragma unroll
                    for (int j = 0; j < 4; ++j) {
                        const int s = wn * 64 + j * 16 + (lane & 15);
                        const float sv = S[i][j][r];
                        const int diff = dbase + (j * 16 - i * 16 - r);
                        r0 += sv * __expf((diff <= 0) ? (su0[j] - m0) : -INFINITY);
                        r1 += sv * __expf((diff >= 0) ? (su1[j] - m1) : -INFINITY);
                    }
                    r0 += __shfl_xor(r0, 1); r0 += __shfl_xor(r0, 2); r0 += __shfl_xor(r0, 4); r0 += __shfl_xor(r0, 8);
                    r1 += __shfl_xor(r1, 1); r1 += __shfl_xor(r1, 2); r1 += __shfl_xor(r1, 4); r1 += __shfl_xor(r1, 8);
                    if ((lane & 15) == 0) { rsA[(0 * 2 + wn) * 128 + tt] = r0; rsA[(1 * 2 + wn) * 128 + tt] = r1; }
                }
            __syncthreads();
            {
                const int dir = t >> 7, tt = t & 127;
                const float rs = rsA[(dir * 2 + 0) * 128 + tt] + rsA[(dir * 2 + 1) * 128 + tt];
                const float mm = dir ? a5[tt] : a4[tt];
                const float wi = __expf((dir ? mp1 : mp0) - mm);
                const float den = rs + wi * qn[dir * 128 + tt];
                const float mout = (dir ? a1[tt] : a0[tt]) + mm;
                const float dn = fmaxf(fabsf(den), __expf(-mout));
                fac[dir * 128 + tt] = 1.f / dn;
                wfac[dir * 128 + tt] = wi / dn;
            }
            __syncthreads();
            load_tile128_rowscaled(T0, 0, (const u16*)(ws + O_Q) + (size_t)rb * 512 + h * 128, 512, 128, wfac);
            load_tile128(T1, 0, (const u16*)(ws + O_MLC0) + ((size_t)(b * NCH + cc) * 4 + h) * 16384, 128, 128);
            __syncthreads();
            f32x4 H[4][4]; zero_acc(H);
            lds_mma<4, 4>(T0, T1, wm * 64, wn * 64, H, lane);
            __syncthreads();
            load_tile128_rowscaled(T0, 0, (const u16*)(ws + O_Q) + (size_t)rb * 512 + h * 128, 512, 128, wfac + 128);
            load_tile128(T1, 0, (const u16*)(ws + O_MLC1) + ((size_t)(b * NCH + cc) * 4 + h) * 16384, 128, 128);
            __syncthreads();
            lds_mma<4, 4>(T0, T1, wm * 64, wn * 64, H, lane);
            __syncthreads();
            asm volatile("" : "+v"(dbase));
#pragma unroll
            for (int i = 0; i < 4; ++i)
#pragma unroll
                for (int r = 0; r < 4; ++r) {
                    const int tt = wm * 64 + i * 16 + (lane >> 4) * 4 + r;
                    const float m0 = a4[tt], m1 = a5[tt], f0 = fac[tt], f1 = fac[128 + tt];
#pragma unroll
                    for (int j = 0; j < 4; ++j) {
                        const int s = wn * 64 + j * 16 + (lane & 15);
                        const int diff = dbase + (j * 16 - i * 16 - r);
                        const float f = __expf((diff <= 0) ? (su0[j] - m0) : -INFINITY) * f0 + __expf((diff >= 0) ? (su1[j] - m1) : -INFINITY) * f1;
                        *(u16*)(T0 + swz256(tt, s >> 3) + (s & 7) * 2) = f2bf(S[i][j][r] * f);
                    }
                }
            load_tile128(T1, 0, (const u16*)(ws + O_VT) + ((size_t)(b * 512 + h * 128)) * 4096 + lpos, 4096, 128);
            __syncthreads();
            lds_mma<4, 4>(T0, T1, wm * 64, wn * 64, H, lane);
            const u16* zo = (const u16*)(ws + O_ZO);
#pragma unroll
            for (int i = 0; i < 4; ++i)
#pragma unroll
                for (int r = 0; r < 4; ++r) {
                    const int tt = wm * 64 + i * 16 + (lane >> 4) * 4 + r;
                    const int lp = lpos + tt;
                    const size_t rown = (size_t)b * 4096 + ((lp & 63) << 6) + (lp >> 6);
                    float ssq = 0.f;
#pragma unroll
                    for (int j = 0; j < 4; ++j) {
                        const int d = wn * 64 + j * 16 + (lane & 15);
                        const float o = bf2f(zo[rown * 1024 + 512 + h * 128 + d]);
                        const float hv = H[i][j][r] * sigmf(o);
                        H[i][j][r] = hv;
                        ssq += hv * hv;
                    }
                    ssq += __shfl_xor(ssq, 1); ssq += __shfl_xor(ssq, 2); ssq += __shfl_xor(ssq, 4); ssq += __shfl_xor(ssq, 8);
                    if ((lane & 15) == 0) rsA[wn * 128 + tt] = ssq;
                }
            __syncthreads();
            u16* zow = (u16*)(ws + O_ZO);
            const u16* xc = (const u16*)(ws + O_XC);
#pragma unroll
            for (int i = 0; i < 4; ++i)
#pragma unroll
                for (int r = 0; r < 4; ++r) {
                    const int tt = wm * 64 + i * 16 + (lane >> 4) * 4 + r;
                    const int lp = lpos + tt;
                    const size_t rown = (size_t)b * 4096 + ((lp & 63) << 6) + (lp >> 6);
                    const float rn = rsqrtf((rsA[tt] + rsA[128 + tt]) * (1.f / 128.f) + 1e-6f);
#pragma unroll
                    for (int j = 0; j < 4; ++j) {
                        const int d = wn * 64 + j * 16 + (lane & 15), chg = h * 128 + d;
                        const float y = H[i][j][r] * rn * P.in[I_MNW][chg] + P.in[I_MSKIP][chg] * bf2f(xc[(size_t)(rb + tt) * 512 + chg]);
                        zow[rown * 1024 + 512 + chg] = f2bf(y);
                    }
                }
            __syncthreads();
        }
    }
}

__device__ void phase7(const Params& P, char* lds) {
    unsigned char* ws = P.ws;
    const int t = threadIdx.x, lane = t & 63, w = t >> 6, wm = w >> 1, wn = w & 1;
    float* rowscale = (float*)(lds + 65536);
    const u16* A = (const u16*)(ws + O_ZO);
    const u16* B = (const u16*)(ws + O_WOUT);
    const float* mod = (const float*)(ws + O_MOD);
    for (int u = blockIdx.x; u < 128 * 8; u += gridDim.x) {
        const int mt = u >> 3, nt = u & 7;
        if (t < 128) {
            const float* sq = (const float*)(ws + O_SSQ) + (size_t)(mt * 128 + t) * 16;
            float s = 0.f;
#pragma unroll
            for (int q = 0; q < 16; ++q) s += sq[q];
            rowscale[t] = rsqrtf(s * (1.f / 512.f) + 1e-6f);
        }
        RowPtrs rp;
#pragma unroll
        for (int i = 0; i < 4; ++i) {
            const int r = (t >> 3) + 32 * i;
            rp.a[i] = A + (size_t)(mt * 128 + r) * 1024;
            rp.b[i] = B + (size_t)(nt * 128 + r) * 1024;
        }
        f32x4 acc[4][4]; zero_acc(acc);
        gemm_mainloop<true>(lds, rp.a[0], rp.a[1], rp.a[2], rp.a[3], rp.b[0], rp.b[1], rp.b[2], rp.b[3], 1024, acc, rowscale);
        const int b = mt >> 5;
#pragma unroll
        for (int i = 0; i < 4; ++i)
#pragma unroll
            for (int j = 0; j < 4; ++j) {
                const int col = nt * 128 + wn * 64 + j * 16 + (lane & 15);
                const float g1 = mod[b * 6144 + 2048 + col];
#pragma unroll
                for (int r = 0; r < 4; ++r) {
                    const size_t row = (size_t)mt * 128 + wm * 64 + i * 16 + (lane >> 4) * 4 + r;
                    P.out[row * 1024 + col] = P.in[I_X][row * 1024 + col] + g1 * acc[i][j][r];
                }
            }
        __syncthreads();
    }
}

__device__ void phase8(const Params& P, char* lds) {
    unsigned char* ws = P.ws;
    const int t = threadIdx.x, lane = t & 63, w = t >> 6;
    float* tt = (float*)lds;
    const float* mod = (const float*)(ws + O_MOD);
    const int NR = 1024, NTR = 6144;
    for (int u = blockIdx.x; u < NR + NTR; u += gridDim.x) {
        if (u < NR) {
            const int tk0 = u * 16;
            const int b = tk0 >> 12;
#pragma unroll 1
            for (int q = 0; q < 4; ++q) {
                const int tl = w * 4 + q;
                const float* xr = P.out + (size_t)(tk0 + tl) * 1024;
                float4 v[4]; float ss = 0.f;
#pragma unroll
                for (int j = 0; j < 4; ++j) { v[j] = ((const float4*)xr)[lane + 64 * j]; ss += v[j].x * v[j].x + v[j].y * v[j].y + v[j].z * v[j].z + v[j].w * v[j].w; }
                ss = wave_sum(ss);
                const float rstd = rsqrtf(ss * (1.f / 1024.f) + 1e-6f);
#pragma unroll
                for (int j = 0; j < 4; ++j) {
                    const int k = (lane + 64 * j) * 4;
                    const float4 nwv = *(const float4*)(P.in[I_N2W] + k);
                    const float4 sh = *(const float4*)(mod + b * 6144 + 3072 + k);
                    const float4 sc = *(const float4*)(mod + b * 6144 + 4096 + k);
                    float4 hh;
                    hh.x = v[j].x * rstd * nwv.x * (1.f + sc.x) + sh.x;
                    hh.y = v[j].y * rstd * nwv.y * (1.f + sc.y) + sh.y;
                    hh.z = v[j].z * rstd * nwv.z * (1.f + sc.z) + sh.z;
                    hh.w = v[j].w * rstd * nwv.w * (1.f + sc.w) + sh.w;
                    uint2 o; o.x = pack2(hh.x, hh.y); o.y = pack2(hh.z, hh.w);
                    *(uint2*)((u16*)(ws + O_T) + (size_t)(tk0 + tl) * 1024 + k) = o;
                    *(float4*)(tt + tl * 1028 + k) = hh;
                }
            }
            __syncthreads();
            f32x4 c0 = {0, 0, 0, 0}, c1 = {0, 0, 0, 0}, c2 = {0, 0, 0, 0};
            const int ti = lane & 15, kq = lane >> 4;
            const float* rew = P.in[I_REW];
            const float* rgw = P.in[I_RGW];
#pragma unroll 4
            for (int ks = 0; ks < 64; ++ks) {
                const int k = w * 256 + ks * 4 + kq;
                const float a = tt[ti * 1028 + k];
                const float b0 = rew[(size_t)k * 32 + ti];
                const float b1 = rew[(size_t)k * 32 + 16 + ti];
                const float b2 = ti < 4 ? rgw[(size_t)k * 4 + ti] : 0.f;
                c0 = __builtin_amdgcn_mfma_f32_16x16x4f32(a, b0, c0, 0, 0, 0);
                c1 = __builtin_amdgcn_mfma_f32_16x16x4f32(a, b1, c1, 0, 0, 0);
                c2 = __builtin_amdgcn_mfma_f32_16x16x4f32(a, b2, c2, 0, 0, 0);
            }
            __syncthreads();
            float* red = (float*)lds;
#pragma unroll
            for (int r = 0; r < 4; ++r) {
                const int row = kq * 4 + r;
                red[(w * 16 + row) * 48 + ti] = c0[r];
                red[(w * 16 + row) * 48 + 16 + ti] = c1[r];
                red[(w * 16 + row) * 48 + 32 + ti] = c2[r];
            }
            __syncthreads();
            if (t < 16) {
                float lg[36];
#pragma unroll
                for (int j = 0; j < 36; ++j) lg[j] = red[(0 * 16 + t) * 48 + j] + red[(1 * 16 + t) * 48 + j] + red[(2 * 16 + t) * 48 + j] + red[(3 * 16 + t) * 48 + j];
                float gl[4];
#pragma unroll
                for (int j = 0; j < 4; ++j) gl[j] = lg[32 + j] + P.in[I_RGB][j];
                int gs = 0; float gm = gl[0];
#pragma unroll
                for (int j = 1; j < 4; ++j) if (gl[j] > gm) { gm = gl[j]; gs = j; }
                float gsum = 0.f;
#pragma unroll
                for (int j = 0; j < 4; ++j) gsum += __expf(gl[j] - gm);
                const float pg = 1.f / gsum;
                float el[8];
#pragma unroll
                for (int j = 0; j < 8; ++j) {
                    float vsel = lg[j];
#pragma unroll
                    for (int g2 = 1; g2 < 4; ++g2) vsel = (gs == g2) ? lg[g2 * 8 + j] : vsel;
                    el[j] = vsel + P.in[I_REB][gs * 8 + j];
                }
                int i1 = 0; float m1 = el[0];
#pragma unroll
                for (int j = 1; j < 8; ++j) if (el[j] > m1) { m1 = el[j]; i1 = j; }
                int i2 = -1; float m2 = -INFINITY;
#pragma unroll
                for (int j = 0; j < 8; ++j) if (j != i1 && el[j] > m2) { m2 = el[j]; i2 = j; }
                const float e2 = __expf(m2 - m1);
                const float w1 = pg / (1.f + e2), w2 = pg * e2 / (1.f + e2);
                const int tok = tk0 + t;
                int* cnt = (int*)(ws + O_CNT);
                int* list = (int*)(ws + O_LIST);
                float* wts = (float*)(ws + O_WTS);
                const int ea = gs * 8 + i1, eb = gs * 8 + i2;
                const int pa = atomicAdd(&cnt[ea], 1);
                list[ea * 16384 + pa] = tok * 2;
                wts[tok * 2] = w1;
                const int pb = atomicAdd(&cnt[eb], 1);
                list[eb * 16384 + pb] = tok * 2 + 1;
                wts[tok * 2 + 1] = w2;
            }
            __syncthreads();
        } else {
            const int v = u - NR;
            float* tile = (float*)lds;
            if (v < 4096) {
                const bool up = v >= 2048;
                const int vv = v & 2047, e = vv >> 6, rem = vv & 63, nt = rem >> 4, kt = rem & 15;
                const float* src = P.in[up ? I_WU : I_WG] + (size_t)e * 1024 * 256;
                transpose_tile(tile, src, 256, kt * 64, nt * 64, 64, (u16*)(ws + O_WGU) + (size_t)e * 512 * 1024, (up ? 256 : 0) + nt * 64, 1024, nullptr, 0);
            } else {
                const int vv = v - 4096, e = vv >> 6, rem = vv & 63, nt = rem >> 2, kt = rem & 3;
                const float* src = P.in[I_WD] + (size_t)e * 256 * 1024;
                transpose_tile(tile, src, 1024, kt * 64, nt * 64, 64, (u16*)(ws + O_WD) + (size_t)e * 1024 * 256, nt * 64, 256, nullptr, 0);
            }
        }
    }
}

__device__ __forceinline__ void moe_prefix(const unsigned char* ws, int* pre_t, int* pre_c) {
    if (threadIdx.x == 0) {
        const int* cnt = (const int*)(ws + O_CNT);
        int at = 0, ac = 0;
        for (int e = 0; e < 32; ++e) { pre_t[e] = at; pre_c[e] = ac; const int c = cnt[e]; at += (c + 127) >> 7; ac += c; }
        pre_t[32] = at; pre_c[32] = ac;
    }
    __syncthreads();
}
__device__ void phase9(const Params& P, char* lds) {
    unsigned char* ws = P.ws;
    const int t = threadIdx.x, lane = t & 63, w = t >> 6, wm = w >> 1, wn = w & 1;
    int* pre_t = (int*)(lds + 65536); int* pre_c = pre_t + 40;
    moe_prefix(ws, pre_t, pre_c);
    const int total = pre_t[32] * 4;
    const int* list = (const int*)(ws + O_LIST);
    const u16* T = (const u16*)(ws + O_T);
    for (int u = blockIdx.x; u < total; u += gridDim.x) {
        const int mtg = u >> 2, nt = u & 3;
        int e = 0;
        while (pre_t[e + 1] <= mtg) ++e;
        const int mt = mtg - pre_t[e];
        const int cnt = pre_c[e + 1] - pre_c[e], base = pre_c[e];
        RowPtrs rp;
#pragma unroll
        for (int i = 0; i < 4; ++i) {
            const int r = (t >> 3) + 32 * i;
            const int idx = mt * 128 + r;
            const int tok = idx < cnt ? (list[e * 16384 + idx] >> 1) : 0;
            rp.a[i] = T + (size_t)tok * 1024;
            const int wnv = r >> 6, part = (r >> 5) & 1, cc = r & 31;
            rp.b[i] = (const u16*)(ws + O_WGU) + ((size_t)e * 512 + part * 256 + nt * 64 + wnv * 32 + cc) * 1024;
        }
        f32x4 acc[4][4]; zero_acc(acc);
        gemm_mainloop<false>(lds, rp.a[0], rp.a[1], rp.a[2], rp.a[3], rp.b[0], rp.b[1], rp.b[2], rp.b[3], 1024, acc, nullptr);
        u16* H = (u16*)(ws + O_H);
#pragma unroll
        for (int i = 0; i < 4; ++i)
#pragma unroll
            for (int r = 0; r < 4; ++r) {
                const int idx = mt * 128 + wm * 64 + i * 16 + (lane >> 4) * 4 + r;
                if (idx < cnt) {
#pragma unroll
                    for (int jj = 0; jj < 2; ++jj) {
                        const float g = acc[i][jj][r], uu = acc[i][jj + 2][r];
                        H[(size_t)(base + idx) * 256 + nt * 64 + wn * 32 + jj * 16 + (lane & 15)] = f2bf(siluf(g) * uu);
                    }
                }
            }
    }
}
__device__ void phase10(const Params& P, char* lds) {
    unsigned char* ws = P.ws;
    const int t = threadIdx.x, lane = t & 63, w = t >> 6, wm = w >> 1, wn = w & 1;
    int* pre_t = (int*)(lds + 65536); int* pre_c = pre_t + 40;
    moe_prefix(ws, pre_t, pre_c);
    const int total = pre_t[32] * 8;
    const int* list = (const int*)(ws + O_LIST);
    const float* wts = (const float*)(ws + O_WTS);
    const u16* H = (const u16*)(ws + O_H);
    u16* SL = (u16*)(ws + O_SL);
    for (int u = blockIdx.x; u < total; u += gridDim.x) {
        const int mtg = u >> 3, nt = u & 7;
        int e = 0;
        while (pre_t[e + 1] <= mtg) ++e;
        const int mt = mtg - pre_t[e];
        const int cnt = pre_c[e + 1] - pre_c[e], base = pre_c[e];
        RowPtrs rp;
#pragma unroll
        for (int i = 0; i < 4; ++i) {
            const int r = (t >> 3) + 32 * i;
            rp.a[i] = H + (size_t)(base + mt * 128 + r) * 256;
            rp.b[i] = (const u16*)(ws + O_WD) + ((size_t)e * 1024 + nt * 128 + r) * 256;
        }
        f32x4 acc[4][4]; zero_acc(acc);
        gemm_mainloop<false>(lds, rp.a[0], rp.a[1], rp.a[2], rp.a[3], rp.b[0], rp.b[1], rp.b[2], rp.b[3], 256, acc, nullptr);
#pragma unroll
        for (int i = 0; i < 4; ++i)
#pragma unroll
            for (int r = 0; r < 4; ++r) {
                const int idx = mt * 128 + wm * 64 + i * 16 + (lane >> 4) * 4 + r;
                if (idx < cnt) {
                    const int ent = list[e * 16384 + idx];
                    const float wg = wts[ent];
#pragma unroll
                    for (int j = 0; j < 4; ++j)
                        SL[(size_t)ent * 1024 + nt * 128 + wn * 64 + j * 16 + (lane & 15)] = f2bf(acc[i][j][r] * wg);
                }
            }
    }
}

__device__ void phase11(const Params& P) {
    unsigned char* ws = P.ws;
    const int lane = threadIdx.x & 63;
    const int gw = blockIdx.x * 4 + (threadIdx.x >> 6), nw = gridDim.x * 4;
    const float* mod = (const float*)(ws + O_MOD);
    const u16* SL = (const u16*)(ws + O_SL);
    for (int row = gw; row < MLAT; row += nw) {
        const int b = row >> 12;
        float* xr = P.out + (size_t)row * 1024;
        float4 v[4]; float ss = 0.f;
#pragma unroll
        for (int j = 0; j < 4; ++j) {
            const int k = (lane + 64 * j) * 4;
            v[j] = *(const float4*)(xr + k);
            const uint2 s0 = *(const uint2*)(SL + (size_t)(row * 2) * 1024 + k);
            const uint2 s1 = *(const uint2*)(SL + (size_t)(row * 2 + 1) * 1024 + k);
            const float4 g2 = *(const float4*)(mod + b * 6144 + 5120 + k);
            v[j].x += g2.x * (bflo(s0.x) + bflo(s1.x));
            v[j].y += g2.y * (bfhi(s0.x) + bfhi(s1.x));
            v[j].z += g2.z * (bflo(s0.y) + bflo(s1.y));
            v[j].w += g2.w * (bfhi(s0.y) + bfhi(s1.y));
            ss += v[j].x * v[j].x + v[j].y * v[j].y + v[j].z * v[j].z + v[j].w * v[j].w;
        }
        ss = wave_sum(ss);
        const float rstd = rsqrtf(ss * (1.f / 1024.f) + 1e-6f);
#pragma unroll
        for (int j = 0; j < 4; ++j) {
            const int k = (lane + 64 * j) * 4;
            const float4 fw = *(const float4*)(P.in[I_FNW] + k);
            float4 o; o.x = v[j].x * rstd * fw.x; o.y = v[j].y * rstd * fw.y; o.z = v[j].z * rstd * fw.z; o.w = v[j].w * rstd * fw.w;
            *(float4*)(xr + k) = o;
        }
    }
}

__global__ void __launch_bounds__(NT, 1) fwd_kernel(Params P) {
    extern __shared__ __attribute__((aligned(16))) char lds[];
#if ONE_LAUNCH
    cg::grid_group grid = cg::this_grid();
#define SYNC() grid.sync()
#else
#define SYNC() do {} while (0)
#endif
#define RUN_PHASE(k, call) do { if (P.lo <= (k) && (k) < P.hi) { call; if ((k) + 1 < P.hi) { SYNC(); } } } while (0)
    RUN_PHASE(0, phase0(P, lds));
    RUN_PHASE(1, phase1(P));
    RUN_PHASE(2, phase2(P, lds));
    RUN_PHASE(3, phase3(P, lds));
    RUN_PHASE(4, phase4(P, lds));
    RUN_PHASE(5, phase5(P));
    RUN_PHASE(6, phase6(P, lds));
    RUN_PHASE(7, phase7(P, lds));
    RUN_PHASE(8, phase8(P, lds));
    RUN_PHASE(9, phase9(P, lds));
    RUN_PHASE(10, phase10(P, lds));
    RUN_PHASE(11, phase11(P));
}

extern "C" void kernel_launch(void* const* d_in, const int* in_sizes, int n_in, void* d_out, int out_size, void* d_ws, size_t ws_size,
                              hipStream_t stream) {
    static int grid_blocks = 0;
    if (!grid_blocks) {
        int dev = 0, cus = 0, per_cu = 0;
        hipGetDevice(&dev);
        hipDeviceGetAttribute(&cus, hipDeviceAttributeMultiprocessorCount, dev);
        hipFuncSetAttribute((const void*)fwd_kernel, hipFuncAttributeMaxDynamicSharedMemorySize, LDS_BYTES);
        hipOccupancyMaxActiveBlocksPerMultiprocessor(&per_cu, (const void*)fwd_kernel, NT, LDS_BYTES);
        if (per_cu < 1) per_cu = 1;
        if (per_cu > 2) per_cu = 2;
        grid_blocks = cus * per_cu;
        if (ws_size < WS_END) fprintf(stderr, "workspace too small: %zu < %zu\n", ws_size, (size_t)WS_END);
    }
    Params p{};
    for (int i = 0; i < 30; ++i) p.in[i] = (const float*)d_in[i];
    p.out = (float*)d_out; p.ws = (unsigned char*)d_ws;
#if ONE_LAUNCH
    p.lo = 0; p.hi = NPHASE;
    void* args[] = {&p};
    hipError_t e = hipLaunchCooperativeKernel((const void*)fwd_kernel, dim3(grid_blocks), dim3(NT), args, LDS_BYTES, stream);
    if (e != hipSuccess) fprintf(stderr, "cooperative launch failed: %s (grid %d)\n", hipGetErrorString(e), grid_blocks);
#else
    for (int ph = 0; ph < NPHASE; ++ph) {
        p.lo = ph; p.hi = ph + 1;
        hipLaunchKernelGGL(fwd_kernel, dim3(grid_blocks), dim3(NT), LDS_BYTES, stream, p);
    }
#endif
}
```

```cpp
#include <hip/hip_runtime.h>
#include <hip/hip_cooperative_groups.h>
#include <cstdio>
#include <cstdint>
namespace cg = cooperative_groups;

#ifndef ONE_LAUNCH
#define ONE_LAUNCH 1
#endif

typedef unsigned short u16;
typedef __attribute__((ext_vector_type(8))) short bf16x8;
typedef __attribute__((ext_vector_type(4))) float f32x4;

constexpr int NT = 256;
constexpr int MLAT = 16384, MALL = 17408;
constexpr int NCH = 34;
constexpr int LDS_MAIN = 75776;
constexpr int LDS_BYTES = LDS_MAIN + 256;
constexpr int NPHASE = 12;

enum { I_X = 0, I_C, I_CTX, I_CCTX, I_WMOD, I_BMOD, I_N1W, I_WIN, I_SCW, I_SCB, I_DTB, I_ALOG, I_SSDD, I_SNW, I_MCW, I_MCB, I_WQK, I_GB,
       I_MNW, I_MSKIP, I_WOUT, I_N2W, I_RGW, I_RGB, I_REW, I_REB, I_WG, I_WU, I_WD, I_FNW };

constexpr size_t al(size_t x) { return (x + 255) & ~(size_t)255; }
constexpr size_t O_MOD = 0;
constexpr size_t O_SSQ = O_MOD + al(5 * 6144 * 4);
constexpr size_t O_CNT = O_SSQ + al(16384 * 16 * 4);
constexpr size_t O_BAR = O_CNT + 4096;
constexpr size_t O_PSD = O_BAR + 16384;
constexpr size_t O_PSG = O_PSD + al((size_t)MALL * 16 * 4);
constexpr size_t O_DT = O_PSG + al((size_t)MALL * 16 * 4);
constexpr size_t O_GI = O_DT + al((size_t)MALL * 16 * 4);
constexpr size_t O_GF = O_GI + al((size_t)MALL * 8 * 4);
constexpr size_t O_ACH = O_GF + al((size_t)MALL * 8 * 4);
constexpr size_t O_MLS = O_ACH + 16384;
constexpr size_t O_MLP = O_MLS + 16384;
constexpr size_t O_MLN = O_MLP + 16384;
constexpr size_t O_LIST = O_MLN + al(4 * 34 * 4 * 2 * 128 * 4);
constexpr size_t O_WTS = O_LIST + al(32 * 16384 * 4);
constexpr size_t O_WIN = O_WTS + al(16384 * 2 * 4);
constexpr size_t O_WOUT = O_WIN + al((size_t)3328 * 1024 * 2);
constexpr size_t O_A = O_WOUT + al((size_t)1024 * 1024 * 2);
constexpr size_t SZ_A = (size_t)MALL * 1024 * 2;
constexpr size_t O_PT = O_A + SZ_A;
constexpr size_t SZ_PT = (size_t)MALL * 1536 * 2;
constexpr size_t O_MLC1 = O_PT + SZ_PT;
constexpr size_t SZ_HALF = (size_t)MALL * 512 * 2;
constexpr size_t O_ZO = O_MLC1 + SZ_HALF;
constexpr size_t O_VT = O_ZO + SZ_A;
constexpr size_t O_BM = O_VT + SZ_HALF;
constexpr size_t SZ_Q = (size_t)MALL * 256 * 2;
constexpr size_t O_BT = O_BM + SZ_Q;
constexpr size_t O_CM = O_BT + SZ_Q;
constexpr size_t O_XT = O_CM + SZ_Q;
constexpr size_t O_KT = O_XT + SZ_HALF;
constexpr size_t O_XC = O_KT + SZ_HALF;
constexpr size_t WS_END = O_XC + SZ_HALF;
constexpr size_t O_XN = O_A, O_Q = O_A, O_K = O_A + SZ_HALF, O_T = O_A;
constexpr size_t O_ST = O_PT;
constexpr size_t O_MLC0 = O_PT + (size_t)4 * 34 * 8 * 2 * 8192 * 2;
constexpr size_t O_WGU = O_PT;
constexpr size_t O_WD = O_PT + (size_t)32 * 512 * 1024 * 2;
constexpr size_t O_SL = O_ZO;
constexpr size_t O_H = O_XT;
static_assert(O_WD + (size_t)32 * 1024 * 256 * 2 <= O_MLC1, "moe weights fit PT region");
static_assert(O_SL + (size_t)16384 * 2 * 1024 * 2 <= O_CM, "slots fit");
static_assert(WS_END <= (size_t)256 * 1024 * 1024, "workspace");
constexpr size_t TCTX512 = (size_t)4 * 512 * 4096;
constexpr size_t TCTX256 = (size_t)4 * 256 * 4096;

struct Params { const float* in[30]; float* out; unsigned char* ws; int lo, hi; };
#define XB_TMO      128
#define XB_XCNT(j)  (256  + 64 * (j))
#define XB_XSUB(j)  (1280 + 64 * (j))
#define XB_XGEN(j)  (2304 + 64 * (j))
#define XB_TOP      3328
#define XB_TOPGEN   3392
#define XCD_BAR_WORDS 3456
#define XB_SPIN_CAP (1u << 20)
#define LAS __attribute__((address_space(3)))
__device__ __forceinline__ unsigned xb_ld(unsigned* p)              { return __hip_atomic_load(p, __ATOMIC_RELAXED, __HIP_MEMORY_SCOPE_AGENT); }
__device__ __forceinline__ unsigned xb_add(unsigned* p, unsigned v) { return __hip_atomic_fetch_add(p, v, __ATOMIC_RELAXED, __HIP_MEMORY_SCOPE_AGENT); }
__device__ __forceinline__ unsigned xb_xcc_id() { return (unsigned)__builtin_amdgcn_s_getreg((3 << 11) | 20) & 0xFu; }
#define XB_SPIN(cond, bar) do { unsigned _sp = 0; while (cond) { __builtin_amdgcn_s_sleep(1); \
    if ((++_sp & 255u) == 0u) { if (xb_ld(&(bar)[XB_TMO])) break; if (_sp > XB_SPIN_CAP) { atomicAdd(&(bar)[XB_TMO], 1u); break; } } } } while (0)
struct XcdBarrier { unsigned* bar; unsigned x; volatile LAS unsigned* st; };
__device__ __forceinline__ XcdBarrier xcd_barrier_post(unsigned* bar, volatile LAS unsigned* st) {
    XcdBarrier b; b.bar = bar; b.x = xb_xcc_id(); b.st = st;
    if (threadIdx.x == 0) (void)xb_add(&bar[XB_XCNT(b.x)], 1u);
    return b;
}
__device__ __forceinline__ void xcd_barrier_complete(unsigned* bar, unsigned x, unsigned& nloc, unsigned& nx) {
    const unsigned G = gridDim.x * gridDim.y * gridDim.z;
    unsigned sum, cnt, mine, sp = 0u;
    for (;;) {
        sum = 0u; cnt = 0u; mine = 0u;
#pragma unroll
        for (unsigned j = 0; j < 16; ++j) { const unsigned c = xb_ld(&bar[XB_XCNT(j)]); sum += c; cnt += (c > 0u) ? 1u : 0u; mine = (j == x) ? c : mine; }
        if (sum == G) break;
        __builtin_amdgcn_s_sleep(1);
        if ((++sp & 255u) == 0u) { if (xb_ld(&bar[XB_TMO])) break; if (sp > XB_SPIN_CAP) { atomicAdd(&bar[XB_TMO], 1u); break; } }
    }
    nloc = mine > 0u ? mine : 1u; nx = cnt > 0u ? cnt : 1u;
}
__device__ __forceinline__ void xcd_barrier(const XcdBarrier& b) {
    asm volatile("s_waitcnt vmcnt(0)" ::: "memory");
    __syncthreads();
    if (threadIdx.x == 0) {
        unsigned* bar = b.bar;
        __builtin_amdgcn_s_waitcnt(0);
        unsigned nloc = b.st[0], nx = b.st[1];
        if (nloc == 0u) { xcd_barrier_complete(bar, b.x, nloc, nx); b.st[0] = nloc; b.st[1] = nx; }
        const unsigned old = xb_add(&bar[XB_XSUB(b.x)], 1u);
        const unsigned gen = old / nloc;
        if (old + 1u == (gen + 1u) * nloc) {
            __builtin_amdgcn_fence(__ATOMIC_RELEASE, "agent");
            asm volatile("s_waitcnt vmcnt(0)" ::: "memory");
            const unsigned og = xb_add(&bar[XB_TOP], 1u);
            const unsigned tg = og / nx;
            if (og + 1u == (tg + 1u) * nx) xb_add(&bar[XB_TOPGEN], 1u);
            else XB_SPIN(xb_ld(&bar[XB_TOPGEN]) == tg, bar);
            __builtin_amdgcn_fence(__ATOMIC_ACQUIRE, "agent");
            xb_add(&bar[XB_XGEN(b.x)], 1u);
            asm volatile("s_waitcnt vmcnt(0)" ::: "memory");
        } else {
            XB_SPIN(xb_ld(&bar[XB_XGEN(b.x)]) == gen, bar);
            __builtin_amdgcn_fence(__ATOMIC_ACQUIRE, "agent");
            asm volatile("s_waitcnt vmcnt(0)" ::: "memory");
        }
    }
    __syncthreads();
}


__device__ __forceinline__ u16 f2bf(float f) { unsigned u = __float_as_uint(f); u += 0x7fffu + ((u >> 16) & 1u); return (u16)(u >> 16); }
__device__ __forceinline__ float bf2f(u16 h) { return __uint_as_float(((unsigned)h) << 16); }
__device__ __forceinline__ unsigned pack2(float a, float b) { return (unsigned)f2bf(a) | ((unsigned)f2bf(b) << 16); }
__device__ __forceinline__ float bflo(unsigned u) { return __uint_as_float(u << 16); }
__device__ __forceinline__ float bfhi(unsigned u) { return __uint_as_float(u & 0xffff0000u); }
__device__ __forceinline__ float siluf(float x) { return x / (1.f + __expf(-x)); }
__device__ __forceinline__ float sigmf(float x) { return 1.f / (1.f + __expf(-x)); }
__device__ __forceinline__ float softplusf(float x) { return x > 20.f ? x : log1pf(__expf(x)); }
__device__ __forceinline__ float wave_sum(float v) {
#pragma unroll
    for (int o = 32; o > 0; o >>= 1) v += __shfl_xor(v, o);
    return v;
}
__device__ __forceinline__ int swz256(int row, int chunk) { return row * 256 + ((chunk ^ (row & 15)) << 4); }
__device__ __forceinline__ int swz128(int row, int chunk) { return row * 128 + ((chunk ^ (row & 7)) << 4); }

__device__ __forceinline__ void load_tile128(char* lds, int lrow0, const u16* __restrict__ g, size_t ld, int rows) {
    const int t = threadIdx.x;
#pragma unroll 4
    for (int q = t; q < rows * 16; q += NT) {
        const int r = q >> 4, c = q & 15;
        const uint4 v = *(const uint4*)(g + (size_t)r * ld + c * 8);
        *(uint4*)(lds + swz256(lrow0 + r, c)) = v;
    }
}
__device__ __forceinline__ void load_tile128_scaled(char* lds, int lrow0, const u16* __restrict__ g, size_t ld, int rows, const float* w) {
    const int t = threadIdx.x;
#pragma unroll 2
    for (int q = t; q < rows * 16; q += NT) {
        const int r = q >> 4, c = q & 15;
        const uint4 v = *(const uint4*)(g + (size_t)r * ld + c * 8);
        const float* ww = w + c * 8;
        uint4 o;
        o.x = pack2(bflo(v.x) * ww[0], bfhi(v.x) * ww[1]);
        o.y = pack2(bflo(v.y) * ww[2], bfhi(v.y) * ww[3]);
        o.z = pack2(bflo(v.z) * ww[4], bfhi(v.z) * ww[5]);
        o.w = pack2(bflo(v.w) * ww[6], bfhi(v.w) * ww[7]);
        *(uint4*)(lds + swz256(lrow0 + r, c)) = o;
    }
}

__device__ __forceinline__ void load_tile128_rowscaled(char* lds, int lrow0, const u16* __restrict__ g, size_t ld, int rows, const float* rs) {
    const int t = threadIdx.x;
#pragma unroll 2
    for (int q = t; q < rows * 16; q += NT) {
        const int r = q >> 4, c = q & 15;
        const uint4 v = *(const uint4*)(g + (size_t)r * ld + c * 8);
        const float f = rs[r];
        uint4 o;
        o.x = pack2(bflo(v.x) * f, bfhi(v.x) * f);
        o.y = pack2(bflo(v.y) * f, bfhi(v.y) * f);
        o.z = pack2(bflo(v.z) * f, bfhi(v.z) * f);
        o.w = pack2(bflo(v.w) * f, bfhi(v.w) * f);
        *(uint4*)(lds + swz256(lrow0 + r, c)) = o;
    }
}

template <int MI, int NJ>
__device__ __forceinline__ void lds_mma(const char* A, const char* B, int arow0, int brow0, f32x4 (&acc)[MI][NJ], int lane) {
#pragma unroll 1
    for (int kk = 0; kk < 4; ++kk) {
        const int chunk = kk * 4 + (lane >> 4);
        bf16x8 a[MI], b[NJ];
#pragma unroll
        for (int i = 0; i < MI; ++i) { const int row = arow0 + i * 16 + (lane & 15); a[i] = *(const bf16x8*)(A + swz256(row, chunk)); }
#pragma unroll
        for (int j = 0; j < NJ; ++j) { const int row = brow0 + j * 16 + (lane & 15); b[j] = *(const bf16x8*)(B + swz256(row, chunk)); }
#pragma unroll
        for (int i = 0; i < MI; ++i)
#pragma unroll
            for (int j = 0; j < NJ; ++j) acc[i][j] = __builtin_amdgcn_mfma_f32_16x16x32_bf16(a[i], b[j], acc[i][j], 0, 0, 0);
    }
}
template <int MI, int NJ>
__device__ __forceinline__ void zero_acc(f32x4 (&acc)[MI][NJ]) {
#pragma unroll
    for (int i = 0; i < MI; ++i)
#pragma unroll
        for (int j = 0; j < NJ; ++j) acc[i][j] = f32x4{0.f, 0.f, 0.f, 0.f};
}

template <int OP>
__device__ __forceinline__ float scan_pair(float v, float* buf) {
    const int t = threadIdx.x, idx = t & 127, base = t & 128;
    buf[t] = v;
    __syncthreads();
#pragma unroll 1
    for (int off = 1; off < 128; off <<= 1) {
        const float o = (idx >= off) ? buf[base + idx - off] : (OP ? -INFINITY : 0.f);
        __syncthreads();
        v = OP ? fmaxf(v, o) : v + o;
        buf[t] = v;
        __syncthreads();
    }
    return v;
}

struct RowPtrs { const u16* a[4]; const u16* b[4]; };
#define GEMM_COMPUTE(cur)                                                                                                   \
    _Pragma("unroll") for (int kk = 0; kk < 2; ++kk) {                                                                      \
        const int chunk = kk * 4 + (lane >> 4);                                                                             \
        bf16x8 a[4], b[4];                                                                                                  \
        _Pragma("unroll") for (int i = 0; i < 4; ++i) { const int row = wm * 64 + i * 16 + (lane & 15); a[i] = *(const bf16x8*)((cur) + swz128(row, chunk)); } \
        _Pragma("unroll") for (int j = 0; j < 4; ++j) { const int row = wn * 64 + j * 16 + (lane & 15); b[j] = *(const bf16x8*)((cur) + 16384 + swz128(row, chunk)); } \
        _Pragma("unroll") for (int i = 0; i < 4; ++i)                                                                       \
            _Pragma("unroll") for (int j = 0; j < 4; ++j) acc[i][j] = __builtin_amdgcn_mfma_f32_16x16x32_bf16(a[i], b[j], acc[i][j], 0, 0, 0); \
    }
#define GEMM_MID()                                                                                                          \
    _Pragma("unroll") for (int i = 0; i < 4; ++i)                                                                           \
        _Pragma("unroll") for (int r = 0; r < 4; ++r) {                                                                     \
            const float s = rowscale[wm * 64 + i * 16 + (lane >> 4) * 4 + r];                                               \
            _Pragma("unroll") for (int j = 0; j < 4; ++j) acc[i][j][r] *= s;                                                \
        }
template <bool MID>
__device__ __forceinline__ void gemm_mainloop(char* lds, const u16* pa0, const u16* pa1, const u16* pa2, const u16* pa3,
                                              const u16* pb0, const u16* pb1, const u16* pb2, const u16* pb3,
                                              int K, f32x4 (&acc)[4][4], const float* rowscale  ) {
    const int t = threadIdx.x, lane = t & 63, w = t >> 6, wm = w >> 1, wn = w & 1;
    const int c = t & 7, r0 = t >> 3;
    const int nk = K >> 6;
    const int o0 = swz128(r0, c), o1 = swz128(r0 + 32, c), o2 = swz128(r0 + 64, c), o3 = swz128(r0 + 96, c);
    uint4 ra0 = *(const uint4*)(pa0 + c * 8), ra1 = *(const uint4*)(pa1 + c * 8), ra2 = *(const uint4*)(pa2 + c * 8), ra3 = *(const uint4*)(pa3 + c * 8);
    uint4 rb0 = *(const uint4*)(pb0 + c * 8), rb1 = *(const uint4*)(pb1 + c * 8), rb2 = *(const uint4*)(pb2 + c * 8), rb3 = *(const uint4*)(pb3 + c * 8);
    *(uint4*)(lds + o0) = ra0; *(uint4*)(lds + o1) = ra1; *(uint4*)(lds + o2) = ra2; *(uint4*)(lds + o3) = ra3;
    *(uint4*)(lds + 16384 + o0) = rb0; *(uint4*)(lds + 16384 + o1) = rb1; *(uint4*)(lds + 16384 + o2) = rb2; *(uint4*)(lds + 16384 + o3) = rb3;
    __syncthreads();
#pragma unroll 1
    for (int kt = 0; kt < nk - 1; ++kt) {
        char* cur = lds + (kt & 1) * 32768;
        char* nxt = lds + ((kt + 1) & 1) * 32768;
        const int k0 = (kt + 1) * 64 + c * 8;
        ra0 = *(const uint4*)(pa0 + k0); ra1 = *(const uint4*)(pa1 + k0); ra2 = *(const uint4*)(pa2 + k0); ra3 = *(const uint4*)(pa3 + k0);
        rb0 = *(const uint4*)(pb0 + k0); rb1 = *(const uint4*)(pb1 + k0); rb2 = *(const uint4*)(pb2 + k0); rb3 = *(const uint4*)(pb3 + k0);
        GEMM_COMPUTE(cur)
        if (MID && kt == 7) { GEMM_MID() }
        *(uint4*)(nxt + o0) = ra0; *(uint4*)(nxt + o1) = ra1; *(uint4*)(nxt + o2) = ra2; *(uint4*)(nxt + o3) = ra3;
        *(uint4*)(nxt + 16384 + o0) = rb0; *(uint4*)(nxt + 16384 + o1) = rb1; *(uint4*)(nxt + 16384 + o2) = rb2; *(uint4*)(nxt + 16384 + o3) = rb3;
        __syncthreads();
    }
    {
        char* cur = lds + ((nk - 1) & 1) * 32768;
        GEMM_COMPUTE(cur)
        __syncthreads();
    }
}

__device__ __forceinline__ void transpose_tile(float* tile, const float* __restrict__ src, int ld_src, int k0, int n0, int ncount,
                                               u16* dst, size_t dst_row0, int ld_dst, const float* __restrict__ scale, int scale_kmax) {
    const int t = threadIdx.x;
    const int n = t & 63, kq = t >> 6;
#pragma unroll 4
    for (int i = 0; i < 16; ++i) {
        const int k = i * 4 + kq;
        float v = 0.f;
        if (n < ncount) { v = src[(size_t)(k0 + k) * ld_src + n0 + n]; if (scale && (k0 + k) < scale_kmax) v *= scale[k0 + k]; }
        tile[k * 65 + n] = v;
    }
    __syncthreads();
#pragma unroll
    for (int i = 0; i < 2; ++i) {
        const int q = t + 256 * i, nn = q >> 3, kc = q & 7;
        if (nn < ncount) {
            const float* p = tile + (kc * 8) * 65 + nn;
            uint4 o;
            o.x = pack2(p[0], p[65]); o.y = pack2(p[130], p[195]); o.z = pack2(p[260], p[325]); o.w = pack2(p[390], p[455]);
            *(uint4*)(dst + (dst_row0 + nn) * (size_t)ld_dst + k0 + kc * 8) = o;
        }
    }
    __syncthreads();
}

__device__ void phase0(const Params& P, char* lds) {
    unsigned char* ws = P.ws;
    const int t = threadIdx.x;
    float* tile = (float*)lds;
    const int NU = 1056 + 7 + 192;
    for (int u = blockIdx.x; u < NU; u += gridDim.x) {
        if (u < 1056) {
            const float* src; int ld, k0, n0, ncount = 64; u16* dst; size_t drow; const float* scale = nullptr;
            if (u < 800) {
                src = P.in[I_WIN]; ld = 3104; dst = (u16*)(ws + O_WIN);
                if (u < 384) { const int nt = u >> 4; k0 = (u & 15) * 64; n0 = nt * 64; drow = nt * 64; }
                else if (u < 768) { const int v = u - 384, nt = v >> 4; k0 = (v & 15) * 64; n0 = 1552 + nt * 64; drow = 1536 + nt * 64; }
                else if (u < 784) { k0 = (u - 768) * 64; n0 = 1536; ncount = 16; drow = 3072; }
                else { k0 = (u - 784) * 64; n0 = 3088; ncount = 16; drow = 3200; }
            } else {
                const int v = u - 800, nt = v >> 4; k0 = (v & 15) * 64; n0 = nt * 64; drow = nt * 64;
                src = P.in[I_WOUT]; ld = 1024; dst = (u16*)(ws + O_WOUT); scale = P.in[I_SNW];
            }
            transpose_tile(tile, src, ld, k0, n0, ncount, dst, drow, 1024, scale, 512);
        } else if (u < 1063) {
            const int base = (u - 1056) * 4096;
            for (int i = 0; i < 16; ++i) {
                const int idx = base + t + 256 * i;
                if (idx < 224 * 128) {
                    const int row = idx >> 7, within = idx & 127;
                    const int ar = row < 112 ? 3088 + row : 3216 + (row - 112);
                    *(uint4*)(ws + O_WIN + ((size_t)ar * 1024 + within * 8) * 2) = make_uint4(0, 0, 0, 0);
                }
            }
        } else {
            const int c0 = (u - 1063) * 32;
            float* sc = (float*)lds;
            float* red = sc + 5 * 1024;
            for (int i = t; i < 5 * 1024; i += NT) {
                const int r = i >> 10, k = i & 1023;
                const float v = r < 4 ? P.in[I_C][r * 1024 + k] : P.in[I_CCTX][k];
                sc[i] = siluf(v);
            }
            __syncthreads();
            const int col = t & 31, kg = t >> 5;
            float a0 = 0, a1 = 0, a2 = 0, a3 = 0, a4 = 0;
            const float* wp = P.in[I_WMOD] + (size_t)(kg * 128) * 6144 + c0 + col;
#pragma unroll 8
            for (int k = 0; k < 128; ++k) {
                const float wv = wp[(size_t)k * 6144];
                const int kk = kg * 128 + k;
                a0 += sc[kk] * wv; a1 += sc[1024 + kk] * wv; a2 += sc[2048 + kk] * wv; a3 += sc[3072 + kk] * wv; a4 += sc[4096 + kk] * wv;
            }
            red[(kg * 5 + 0) * 32 + col] = a0; red[(kg * 5 + 1) * 32 + col] = a1; red[(kg * 5 + 2) * 32 + col] = a2;
            red[(kg * 5 + 3) * 32 + col] = a3; red[(kg * 5 + 4) * 32 + col] = a4;
            __syncthreads();
            if (t < 160) {
                const int r = t >> 5, cc = t & 31;
                float s = P.in[I_BMOD][c0 + cc];
#pragma unroll
                for (int g = 0; g < 8; ++g) s += red[(g * 5 + r) * 32 + cc];
                ((float*)(ws + O_MOD))[r * 6144 + c0 + cc] = s;
            }
            __syncthreads();
        }
    }
    if (blockIdx.x == 0 && t < 32) ((int*)(ws + O_CNT))[t] = 0;
}

__device__ void phase1(const Params& P) {
    unsigned char* ws = P.ws;
    const int lane = threadIdx.x & 63;
    const int gw = blockIdx.x * 4 + (threadIdx.x >> 6), nw = gridDim.x * 4;
    const float* mod = (const float*)(ws + O_MOD);
    u16* xn = (u16*)(ws + O_XN);
    for (int row = gw; row < MALL; row += nw) {
        const float* xr = row < MLAT ? P.in[I_X] + (size_t)row * 1024 : P.in[I_CTX] + (size_t)(row - MLAT) * 1024;
        const int mb = row < MLAT ? (row >> 12) : 4;
        float4 v[4]; float ss = 0.f;
#pragma unroll
        for (int j = 0; j < 4; ++j) { v[j] = ((const float4*)xr)[lane + 64 * j]; ss += v[j].x * v[j].x + v[j].y * v[j].y + v[j].z * v[j].z + v[j].w * v[j].w; }
        ss = wave_sum(ss);
        const float rstd = rsqrtf(ss * (1.f / 1024.f) + 1e-6f);
#pragma unroll
        for (int j = 0; j < 4; ++j) {
            const int k = (lane + 64 * j) * 4;
            const float4 nwv = *(const float4*)(P.in[I_N1W] + k);
            const float4 sh = *(const float4*)(mod + mb * 6144 + k);
            const float4 sc = *(const float4*)(mod + mb * 6144 + 1024 + k);
            const float h0 = v[j].x * rstd * nwv.x * (1.f + sc.x) + sh.x;
            const float h1 = v[j].y * rstd * nwv.y * (1.f + sc.y) + sh.y;
            const float h2 = v[j].z * rstd * nwv.z * (1.f + sc.z) + sh.z;
            const float h3 = v[j].w * rstd * nwv.w * (1.f + sc.w) + sh.w;
            uint2 o; o.x = pack2(h0, h1); o.y = pack2(h2, h3);
            *(uint2*)(xn + (size_t)row * 1024 + k) = o;
        }
    }
}

__device__ __forceinline__ int colmajor_src_row(int R) {
    if (R >= MLAT) return R;
    const int b = R >> 12, lp = R & 4095;
    return (b << 12) + ((lp & 63) << 6) + (lp >> 6);
}
__device__ void phase2(const Params& P, char* lds) {
    unsigned char* ws = P.ws;
    const int t = threadIdx.x, lane = t & 63, w = t >> 6, wm = w >> 1, wn = w & 1;
    const u16* xn = (const u16*)(ws + O_XN);
    const u16* wt = (const u16*)(ws + O_WIN);
    const int NU = 136 * 26;
    for (int u = blockIdx.x; u < NU; u += gridDim.x) {
        const int mt = u / 26, nt = u % 26;
        const bool cmaj = (nt >= 12 && nt < 20) || nt == 25;
        RowPtrs rp;
#pragma unroll
        for (int i = 0; i < 4; ++i) {
            const int r = (t >> 3) + 32 * i;
            const int R = mt * 128 + r;
            const int sr = cmaj ? colmajor_src_row(R) : R;
            rp.a[i] = xn + (size_t)sr * 1024;
            rp.b[i] = wt + (size_t)(nt * 128 + r) * 1024;
        }
        f32x4 acc[4][4]; zero_acc(acc);
        gemm_mainloop<false>(lds, rp.a[0], rp.a[1], rp.a[2], rp.a[3], rp.b[0], rp.b[1], rp.b[2], rp.b[3], 1024, acc, nullptr);
        const int colb = nt * 128 + wn * 64 + (lane & 15);
#pragma unroll
        for (int i = 0; i < 4; ++i) {
            const int R0 = mt * 128 + wm * 64 + i * 16 + (lane >> 4) * 4;
#pragma unroll
            for (int j = 0; j < 4; ++j) {
                const int col = colb + j * 16;
                const f32x4 a = acc[i][j];
                if (nt < 4) {
                    u16* d = (u16*)(ws + O_ZO) + (size_t)R0 * 1024 + col;
                    d[0] = f2bf(a[0]); d[1024] = f2bf(a[1]); d[2048] = f2bf(a[2]); d[3072] = f2bf(a[3]);
                } else if (nt < 12) {
                    u16* d = (u16*)(ws + O_PT) + (size_t)R0 * 1536 + (col - 512);
                    d[0] = f2bf(a[0]); d[1536] = f2bf(a[1]); d[3072] = f2bf(a[2]); d[4608] = f2bf(a[3]);
                } else if (nt < 16) {
                    u16* d = (u16*)(ws + O_PT) + (size_t)R0 * 1536 + 1024 + (col - 1536);
                    d[0] = f2bf(a[0]); d[1536] = f2bf(a[1]); d[3072] = f2bf(a[2]); d[4608] = f2bf(a[3]);
                } else if (nt < 20) {
                    const int ch = col - 2048;
                    u16* d;
                    if (R0 < MLAT) { const int b = R0 >> 12, lp = R0 & 4095; d = (u16*)(ws + O_VT) + ((size_t)(b * 512 + ch)) * 4096 + lp; }
                    else { const int Rc = R0 - MLAT, b = Rc >> 8, l = Rc & 255; d = (u16*)(ws + O_VT) + TCTX512 + ((size_t)(b * 512 + ch)) * 256 + l; }
                    uint2 o; o.x = pack2(a[0], a[1]); o.y = pack2(a[2], a[3]);
                    *(uint2*)d = o;
                } else if (nt < 24) {
                    u16* d = (u16*)(ws + O_ZO) + (size_t)R0 * 1024 + 512 + (col - 2560);
                    d[0] = f2bf(a[0]); d[1024] = f2bf(a[1]); d[2048] = f2bf(a[2]); d[3072] = f2bf(a[3]);
                } else {
                    const int cs = col - nt * 128;
                    if (cs < 16) {
                        float* d = (float*)(ws + (nt == 24 ? O_PSD : O_PSG)) + (size_t)R0 * 16 + cs;
                        d[0] = a[0]; d[16] = a[1]; d[32] = a[2]; d[48] = a[3];
                    }
                }
            }
        }
    }
}

__device__ void phase3(const Params& P, char* lds) {
    unsigned char* ws = P.ws;
    const int t = threadIdx.x;
    u16* raw = (u16*)lds;
    float* xcl = (float*)(lds + 132 * 128);
    const u16* pt = (const u16*)(ws + O_PT);
    const int NCONV = 136 * 24;
    const int NU = NCONV + 136;
    for (int u = blockIdx.x; u < NU; u += gridDim.x) {
        if (u >= NCONV) {
            const int ct = u - NCONV, b = ct / NCH, cc = ct % NCH;
            const int rb = cc < 2 ? MLAT + b * 256 + cc * 128 : b * 4096 + (cc - 2) * 128;
            const int row = rb + (t >> 1), half = t & 1;
            const float* psd = (const float*)(ws + O_PSD) + (size_t)row * 16 + half * 8;
            float* dt = (float*)(ws + O_DT) + (size_t)row * 16 + half * 8;
#pragma unroll
            for (int j = 0; j < 8; ++j) dt[j] = softplusf(psd[j] + P.in[I_DTB][half * 8 + j]);
            const float* psg = (const float*)(ws + O_PSG) + (size_t)row * 16;
            if (half == 0) {
                float* gi = (float*)(ws + O_GI) + (size_t)row * 8;
#pragma unroll
                for (int j = 0; j < 8; ++j) gi[j] = psg[j] + P.in[I_GB][j];
            } else {
                float* gf = (float*)(ws + O_GF) + (size_t)row * 8;
#pragma unroll
                for (int j = 0; j < 8; ++j) { const float xx = psg[8 + j] + P.in[I_GB][8 + j]; gf[j] = fminf(xx, 0.f) - log1pf(__expf(-fabsf(xx))); }
            }
            continue;
        }
        const int ct = u / 24, cgp = u % 24;
        const int b = ct / NCH, cc = ct % NCH;
        const bool isctx = cc < 2;
        const int L = isctx ? 256 : 4096;
        const int lpos = isctx ? cc * 128 : (cc - 2) * 128;
        const int rb = isctx ? MLAT + b * 256 + cc * 128 : b * 4096 + (cc - 2) * 128;
        const int sb = rb - lpos;
        const bool isml = cgp >= 16;
        const int pcol = isml ? 1024 + (cgp - 16) * 64 : cgp * 64;
        for (int q = t; q < 132 * 8; q += NT) {
            const int r = q >> 3, c = q & 7;
            const int l = lpos - 2 + r;
            uint4 v = make_uint4(0, 0, 0, 0);
            if (l >= 0 && l < L) v = *(const uint4*)(pt + (size_t)(sb + l) * 1536 + pcol + c * 8);
            *(uint4*)(raw + r * 64 + c * 8) = v;
        }
        __syncthreads();
        const int ch = t & 63, tg = t >> 6;
        const float* cw = isml ? P.in[I_MCW] + (cgp - 16) * 64 + ch : P.in[I_SCW] + cgp * 64 + ch;
        const int cwld = isml ? 512 : 1024;
        const float w0 = cw[0], w1 = cw[cwld], w2 = cw[2 * cwld], w3 = cw[3 * cwld], w4 = cw[4 * cwld];
        const float bias = isml ? P.in[I_MCB][(cgp - 16) * 64 + ch] : P.in[I_SCB][cgp * 64 + ch];
        const int tok0 = tg * 32;
        float x0 = bf2f(raw[(tok0 + 0) * 64 + ch]), x1 = bf2f(raw[(tok0 + 1) * 64 + ch]), x2 = bf2f(raw[(tok0 + 2) * 64 + ch]), x3 = bf2f(raw[(tok0 + 3) * 64 + ch]);
        if (!isml) {
            u16* tdst = nullptr; u16* ndst = nullptr;
            if (cgp < 8) {
                const int chg = cgp * 64 + ch;
                tdst = (u16*)(ws + O_XT) + (isctx ? TCTX512 + ((size_t)(b * 512 + chg)) * 256 : ((size_t)(b * 512 + chg)) * 4096) + lpos + tok0;
            } else if (cgp < 12) {
                const int gn = (cgp - 8) * 64 + ch;
                tdst = (u16*)(ws + O_BT) + (isctx ? TCTX256 + ((size_t)(b * 256 + gn)) * 256 : ((size_t)(b * 256 + gn)) * 4096) + lpos + tok0;
                ndst = (u16*)(ws + O_BM) + (size_t)(rb + tok0) * 256 + gn;
            } else {
                const int gn = (cgp - 12) * 64 + ch;
                ndst = (u16*)(ws + O_CM) + (size_t)(rb + tok0) * 256 + gn;
            }
#pragma unroll
            for (int o8 = 0; o8 < 4; ++o8) {
                float ov[8];
#pragma unroll
                for (int j = 0; j < 8; ++j) {
                    const int tok = tok0 + o8 * 8 + j;
                    const float x4 = bf2f(raw[(tok + 4) * 64 + ch]);
                    const float cv = bias + w0 * x0 + w1 * x1 + w2 * x2 + w3 * x3 + w4 * x4;
                    ov[j] = siluf(cv);
                    x0 = x1; x1 = x2; x2 = x3; x3 = x4;
                }
                if (tdst) { uint4 o; o.x = pack2(ov[0], ov[1]); o.y = pack2(ov[2], ov[3]); o.z = pack2(ov[4], ov[5]); o.w = pack2(ov[6], ov[7]); *(uint4*)(tdst + o8 * 8) = o; }
                if (ndst) {
#pragma unroll
                    for (int j = 0; j < 8; ++j) ndst[(size_t)(o8 * 8 + j) * 256] = f2bf(ov[j]);
                }
            }
            __syncthreads();
        } else {
            const int mg = cgp - 16;
            u16* xcd = (u16*)(ws + O_XC) + (size_t)(rb + tok0) * 512 + mg * 64 + ch;
#pragma unroll 8
            for (int j = 0; j < 32; ++j) {
                const int tok = tok0 + j;
                const float x4 = bf2f(raw[(tok + 4) * 64 + ch]);
                const float cv = bias + w0 * x0 + w1 * x1 + w2 * x2 + w3 * x3 + w4 * x4;
                const float sv = siluf(cv);
                xcl[tok * 64 + ch] = sv;
                xcd[(size_t)j * 512] = f2bf(sv);
                x0 = x1; x1 = x2; x2 = x3; x3 = x4;
            }
            __syncthreads();
            const int n = ch >> 2, kk = ch & 3, ng = mg * 16 + n;
            const float* wq = P.in[I_WQK] + ((size_t)(0 * 128 + ng) * 4) * 4 + kk;
            const float* wk = P.in[I_WQK] + ((size_t)(1 * 128 + ng) * 4) * 4 + kk;
            const float q0 = wq[0], q1 = wq[4], q2 = wq[8], q3 = wq[12];
            const float k0 = wk[0], k1 = wk[4], k2 = wk[8], k3 = wk[12];
            const int chg = mg * 64 + ch;
            u16* qd = (u16*)(ws + O_Q) + (size_t)(rb + tok0) * 512 + chg;
            u16* kd = (u16*)(ws + O_K) + (size_t)(rb + tok0) * 512 + chg;
            u16* ktd = (u16*)(ws + O_KT) + (isctx ? TCTX512 + ((size_t)(b * 512 + chg)) * 256 : ((size_t)(b * 512 + chg)) * 4096) + lpos + tok0;
#pragma unroll
            for (int o8 = 0; o8 < 4; ++o8) {
                float kv[8];
#pragma unroll
                for (int j = 0; j < 8; ++j) {
                    const int tok = tok0 + o8 * 8 + j;
                    const float4 xv = *(const float4*)(xcl + tok * 64 + n * 4);
                    const float qv = xv.x * q0 + xv.y * q1 + xv.z * q2 + xv.w * q3;
                    kv[j] = (xv.x * k0 + xv.y * k1 + xv.z * k2 + xv.w * k3) * 0.08838834764831845f;
                    qd[(size_t)(o8 * 8 + j) * 512] = f2bf(qv);
                    kd[(size_t)(o8 * 8 + j) * 512] = f2bf(kv[j]);
                }
                uint4 o; o.x = pack2(kv[0], kv[1]); o.y = pack2(kv[2], kv[3]); o.z = pack2(kv[4], kv[5]); o.w = pack2(kv[6], kv[7]);
                *(uint4*)(ktd + o8 * 8) = o;
            }
            __syncthreads();
        }
    }
}

__device__ void phase4(const Params& P, char* lds) {
    unsigned char* ws = P.ws;
    const int t = threadIdx.x, lane = t & 63, w = t >> 6, wm = w >> 1, wn = w & 1;
    char* T0 = lds; char* T1 = lds + 32768;
    float* sc = (float*)(lds + 65536);
    float* sbuf = sc;
    float* wA = sc + 256;
    float* wB = sc + 384;
    float* redm = sc + 512;
    const int NSSD = 4 * NCH * 8, NML = 4 * NCH * 4;
    for (int u = blockIdx.x; u < NSSD + NML; u += gridDim.x) {
        if (u < NSSD) {
            const int h = u & 7, ct = u >> 3, b = ct / NCH, cc = ct % NCH;
            const bool isctx = cc < 2;
            const int L = isctx ? 256 : 4096;
            const int lpos = isctx ? cc * 128 : (cc - 2) * 128;
            const int rb = isctx ? MLAT + b * 256 + cc * 128 : b * 4096 + (cc - 2) * 128;
            const int dir = t >> 7, idx = t & 127;
            const int l = dir ? 127 - idx : idx;
            const float dtv = ((const float*)(ws + O_DT))[(size_t)(rb + l) * 16 + dir * 8 + h];
            const float an = -__expf(P.in[I_ALOG][dir * 8 + h]);
            const float cs = scan_pair<0>(dtv * an, sbuf);
            const float tot = sbuf[dir * 128 + 127];
            const float wv = __expf(tot - cs) * dtv;
            if (dir == 0) wA[l] = wv; else wB[l] = wv;
            if (idx == 127) ((float*)(ws + O_ACH))[((size_t)(b * NCH + cc) * 8 + h) * 2 + dir] = cs;
            __syncthreads();
            const int g = h >> 2;
            const u16* xt = (const u16*)(ws + O_XT) + (isctx ? TCTX512 + ((size_t)(b * 512 + h * 64)) * 256 : ((size_t)(b * 512 + h * 64)) * 4096) + lpos;
            const u16* bt = (const u16*)(ws + O_BT) + (isctx ? TCTX256 + ((size_t)(b * 256 + g * 128)) * 256 : ((size_t)(b * 256 + g * 128)) * 4096) + lpos;
            load_tile128_scaled(T0, 0, xt, L, 64, wA);
            load_tile128_scaled(T0, 64, xt, L, 64, wB);
            load_tile128(T1, 0, bt, L, 128);
            __syncthreads();
            f32x4 acc[4][4]; zero_acc(acc);
            lds_mma<4, 4>(T0, T1, wm * 64, wn * 64, acc, lane);
            u16* st = (u16*)(ws + O_ST) + (((size_t)(b * NCH + cc) * 8 + h) * 2 + wm) * 8192 + ((lane >> 4) * 4) * 128 + wn * 64 + (lane & 15);
#pragma unroll
            for (int i = 0; i < 4; ++i)
#pragma unroll
                for (int j = 0; j < 4; ++j)
#pragma unroll
                    for (int r = 0; r < 4; ++r) st[(i * 16 + r) * 128 + j * 16] = f2bf(acc[i][j][r]);
            __syncthreads();
        } else {
            const int v = u - NSSD;
            const int h = v & 3, ct = v >> 2, b = ct / NCH, cc = ct % NCH;
            const bool isctx = cc < 2;
            const int L = isctx ? 256 : 4096;
            const int lpos = isctx ? cc * 128 : (cc - 2) * 128;
            const int rb = isctx ? MLAT + b * 256 + cc * 128 : b * 4096 + (cc - 2) * 128;
            const int dir = t >> 7, idx = t & 127;
            const int s = dir ? 127 - idx : idx;
            const float fv = ((const float*)(ws + O_GF))[(size_t)(rb + s) * 8 + dir * 4 + h];
            const float iv = ((const float*)(ws + O_GI))[(size_t)(rb + s) * 8 + dir * 4 + h];
            const float bc = scan_pair<0>(fv, sbuf);
            const float tot = sbuf[dir * 128 + 127];
            const float av = tot - bc + iv;
            __syncthreads();
            const float mx = scan_pair<1>(av, sbuf);
            (void)mx;
            const float mloc = sbuf[dir * 128 + 127];
            const float wv = __expf(av - mloc);
            if (dir == 0) wA[s] = wv; else wB[s] = wv;
            if (idx == 0) {
                float* mls = (float*)(ws + O_MLS) + (((size_t)(b * NCH + cc) * 4 + h) * 2 + dir) * 2;
                mls[0] = mloc; mls[1] = tot;
            }
            __syncthreads();
            const u16* vt = (const u16*)(ws + O_VT) + (isctx ? TCTX512 + ((size_t)(b * 512 + h * 128)) * 256 : ((size_t)(b * 512 + h * 128)) * 4096) + lpos;
            const u16* kt = (const u16*)(ws + O_KT) + (isctx ? TCTX512 + ((size_t)(b * 512 + h * 128)) * 256 : ((size_t)(b * 512 + h * 128)) * 4096) + lpos;
            load_tile128(T1, 0, kt, L, 128);
#pragma unroll 1
            for (int d2 = 0; d2 < 2; ++d2) {
                load_tile128_scaled(T0, 0, vt, L, 128, d2 ? wB : wA);
                __syncthreads();
                f32x4 acc[4][4]; zero_acc(acc);
                lds_mma<4, 4>(T0, T1, wm * 64, wn * 64, acc, lane);
                u16* cst = (u16*)(ws + (d2 ? O_MLC1 : O_MLC0)) + ((size_t)(b * NCH + cc) * 4 + h) * 16384 + (wm * 64 + (lane >> 4) * 4) * 128 + wn * 64 + (lane & 15);
#pragma unroll
                for (int i = 0; i < 4; ++i)
#pragma unroll
                    for (int j = 0; j < 4; ++j)
#pragma unroll
                        for (int r = 0; r < 4; ++r) cst[(i * 16 + r) * 128 + j * 16] = f2bf(acc[i][j][r]);
                if (d2 == 0) {
                    const float* wgt = dir ? wB : wA;
                    float nacc = 0.f;
#pragma unroll 4
                    for (int c = 0; c < 16; ++c) {
                        const uint4 kv = *(const uint4*)(T1 + swz256(idx, c));
                        const float* ww = wgt + c * 8;
                        nacc += bflo(kv.x) * ww[0] + bfhi(kv.x) * ww[1] + bflo(kv.y) * ww[2] + bfhi(kv.y) * ww[3]
                              + bflo(kv.z) * ww[4] + bfhi(kv.z) * ww[5] + bflo(kv.w) * ww[6] + bfhi(kv.w) * ww[7];
                    }
                    ((float*)(ws + O_MLN))[(((size_t)(b * NCH + cc) * 4 + h) * 2 + dir) * 128 + idx] = nacc;
                }
                __syncthreads();
            }
        }
    }
    (void)redm;
}

__device__ __forceinline__ int scan_cc(int dir, int step) { return dir == 0 ? step : (step < 2 ? 1 - step : 35 - step); }
__device__ void phase5(const Params& P) {
    unsigned char* ws = P.ws;
    const int t = threadIdx.x;
    for (int u = blockIdx.x; u < 256 + 256 + 32; u += gridDim.x) {
        if (u < 256) {
            const int chain = u >> 2, part = u & 3;
            const int b = chain >> 4, h = (chain >> 1) & 7, dir = chain & 1;
            const int off = part * 2048 + t * 8;
            float S[8];
#pragma unroll
            for (int j = 0; j < 8; ++j) S[j] = 0.f;
#pragma unroll 2
            for (int step = 0; step < NCH; ++step) {
                const int cc = scan_cc(dir, step);
                u16* p = (u16*)(ws + O_ST) + (((size_t)(b * NCH + cc) * 8 + h) * 2 + dir) * 8192 + off;
                const uint4 lv = *(const uint4*)p;
                const float dec = __expf(((const float*)(ws + O_ACH))[((size_t)(b * NCH + cc) * 8 + h) * 2 + dir]);
                uint4 o; o.x = pack2(S[0], S[1]); o.y = pack2(S[2], S[3]); o.z = pack2(S[4], S[5]); o.w = pack2(S[6], S[7]);
                *(uint4*)p = o;
                S[0] = dec * S[0] + bflo(lv.x); S[1] = dec * S[1] + bfhi(lv.x); S[2] = dec * S[2] + bflo(lv.y); S[3] = dec * S[3] + bfhi(lv.y);
                S[4] = dec * S[4] + bflo(lv.z); S[5] = dec * S[5] + bfhi(lv.z); S[6] = dec * S[6] + bflo(lv.w); S[7] = dec * S[7] + bfhi(lv.w);
            }
        } else if (u < 512) {
            const int v = u - 256;
            const int chain = v >> 3, part = v & 7;
            const int b = chain >> 3, h = (chain >> 1) & 3, dir = chain & 1;
            const int off = part * 2048 + t * 8;
            float S[8];
#pragma unroll
            for (int j = 0; j < 8; ++j) S[j] = 0.f;
            float m = -1e30f;
#pragma unroll 2
            for (int step = 0; step < NCH; ++step) {
                const int cc = scan_cc(dir, step);
                u16* p = (u16*)(ws + (dir ? O_MLC1 : O_MLC0)) + ((size_t)(b * NCH + cc) * 4 + h) * 16384 + off;
                const uint4 lv = *(const uint4*)p;
                const float* mls = (const float*)(ws + O_MLS) + (((size_t)(b * NCH + cc) * 4 + h) * 2 + dir) * 2;
                const float ml = mls[0], bl = mls[1];
                const float mn = fmaxf(bl + m, ml);
                const float sp = __expf(bl + m - mn), sl = __expf(ml - mn);
                if (part == 0 && t == 0) ((float*)(ws + O_MLP))[((size_t)(b * NCH + cc) * 4 + h) * 2 + dir] = m;
                uint4 o; o.x = pack2(S[0], S[1]); o.y = pack2(S[2], S[3]); o.z = pack2(S[4], S[5]); o.w = pack2(S[6], S[7]);
                *(uint4*)p = o;
                S[0] = sp * S[0] + sl * bflo(lv.x); S[1] = sp * S[1] + sl * bfhi(lv.x); S[2] = sp * S[2] + sl * bflo(lv.y); S[3] = sp * S[3] + sl * bfhi(lv.y);
                S[4] = sp * S[4] + sl * bflo(lv.z); S[5] = sp * S[5] + sl * bfhi(lv.z); S[6] = sp * S[6] + sl * bflo(lv.w); S[7] = sp * S[7] + sl * bfhi(lv.w);
                m = mn;
            }
        } else {
            const int chain = u - 512;
            const int b = chain >> 3, h = (chain >> 1) & 3, dir = chain & 1;
            if (t < 128) {
                float nS = 0.f, m = -1e30f;
                for (int step = 0; step < NCH; ++step) {
                    const int cc = scan_cc(dir, step);
                    float* p = (float*)(ws + O_MLN) + (((size_t)(b * NCH + cc) * 4 + h) * 2 + dir) * 128 + t;
                    const float lv = *p;
                    const float* mls = (const float*)(ws + O_MLS) + (((size_t)(b * NCH + cc) * 4 + h) * 2 + dir) * 2;
                    const float ml = mls[0], bl = mls[1];
                    const float mn = fmaxf(bl + m, ml);
                    const float sp = __expf(bl + m - mn), sl = __expf(ml - mn);
                    *p = nS;
                    nS = sp * nS + sl * lv;
                    m = mn;
                }
            }
        }
    }
}

__device__ void phase6(const Params& P, char* lds) {
    unsigned char* ws = P.ws;
    const int t = threadIdx.x;
    char* T0 = lds; char* T1 = lds + 32768;
    float* sc = (float*)(lds + 65536);
    float* sbuf = sc;
    float* a0 = sc + 256;
    float* a1 = sc + 384;
    float* a2 = sc + 512;
    float* a3 = sc + 640;
    float* a4 = sc + 768;
    float* a5 = sc + 896;
    float* rsA = sc + 1024;
    float* qn = sc + 1536;
    float* fac = sc + 1792;
    float* wfac = sc + 2048;
    const int NSSD = 4 * 32 * 8, NML = 4 * 32 * 4;
    for (int u = blockIdx.x; u < NSSD + NML; u += gridDim.x) {
        int tq = t; asm volatile("" : "+v"(tq));
        const int lane = tq & 63, w = tq >> 6, wm = w >> 1, wn = w & 1;
        if (u < NSSD) {
            const int h = u & 7, ct = u >> 3, b = ct >> 5, c = ct & 31, cc = c + 2;
            const int rb = b * 4096 + c * 128, lpos = c * 128, g = h >> 2;
            {
                const int dir = t >> 7, idx = t & 127;
                const int l = dir ? 127 - idx : idx;
                const float dtv = ((const float*)(ws + O_DT))[(size_t)(rb + l) * 16 + dir * 8 + h];
                const float an = -__expf(P.in[I_ALOG][dir * 8 + h]);
                const float cs = scan_pair<0>(dtv * an, sbuf);
                if (dir == 0) { a0[l] = cs; a2[l] = dtv; } else { a1[l] = cs; a3[l] = dtv; }
            }
            load_tile128(T0, 0, (const u16*)(ws + O_CM) + (size_t)rb * 256 + g * 128, 256, 128);
            {
                const u16* sf = (const u16*)(ws + O_ST) + (((size_t)(b * NCH + cc) * 8 + h) * 2 + 0) * 8192;
                load_tile128(T1, 0, sf, 128, 64);
                load_tile128(T1, 64, sf + 8192, 128, 64);
            }
            __syncthreads();
            f32x4 Y[4][2];
            {
                f32x4 aF[4][2], aB[4][2]; zero_acc(aF); zero_acc(aB);
                lds_mma<4, 2>(T0, T1, wm * 64, wn * 32, aF, lane);
                lds_mma<4, 2>(T0, T1, wm * 64, 64 + wn * 32, aB, lane);
#pragma unroll
                for (int i = 0; i < 4; ++i)
#pragma unroll
                    for (int r = 0; r < 4; ++r) {
                        const int l = wm * 64 + i * 16 + (lane >> 4) * 4 + r;
                        const float e0 = __expf(a0[l]), e1 = __expf(a1[l]);
#pragma unroll
                        for (int j = 0; j < 2; ++j) Y[i][j][r] = e0 * aF[i][j][r] + e1 * aB[i][j][r];
                    }
            }
            __syncthreads();
            load_tile128(T1, 0, (const u16*)(ws + O_BM) + (size_t)rb * 256 + g * 128, 256, 128);
            __syncthreads();
            f32x4 G[4][4]; zero_acc(G);
            lds_mma<4, 4>(T0, T1, wm * 64, wn * 64, G, lane);
            __syncthreads();
            float sv0[4], sv1[4], sv2[4], sv3[4];
            int dbase = wn * 64 + (lane & 15) - wm * 64 - (lane >> 4) * 4; asm volatile("" : "+v"(dbase));
#pragma unroll
            for (int j = 0; j < 4; ++j) { const int s = wn * 64 + j * 16 + (lane & 15); sv0[j] = a0[s]; sv1[j] = a1[s]; sv2[j] = a2[s]; sv3[j] = a3[s]; }
#pragma unroll
            for (int i = 0; i < 4; ++i)
#pragma unroll
                for (int r = 0; r < 4; ++r) {
                    const int l = wm * 64 + i * 16 + (lane >> 4) * 4 + r;
                    const float c0l = a0[l], r1l = a1[l];
#pragma unroll
                    for (int j = 0; j < 4; ++j) {
                        const int s = wn * 64 + j * 16 + (lane & 15);
                        const int diff = dbase + (j * 16 - i * 16 - r);
                        const float e0 = (diff <= 0) ? (c0l - sv0[j]) : -INFINITY;
                        const float e1 = (diff >= 0) ? (r1l - sv1[j]) : -INFINITY;
                        const float f = __expf(e0) * sv2[j] + __expf(e1) * sv3[j];
                        *(u16*)(T0 + swz256(l, s >> 3) + (s & 7) * 2) = f2bf(G[i][j][r] * f);
                    }
                }
            load_tile128(T1, 0, (const u16*)(ws + O_XT) + ((size_t)(b * 512 + h * 64)) * 4096 + lpos, 4096, 64);
            __syncthreads();
            lds_mma<4, 2>(T0, T1, wm * 64, wn * 32, Y, lane);
            const float Dh = P.in[I_SSDD][h];
            u16* zo = (u16*)(ws + O_ZO);
#pragma unroll
            for (int i = 0; i < 4; ++i)
#pragma unroll
                for (int r = 0; r < 4; ++r) {
                    const int l = wm * 64 + i * 16 + (lane >> 4) * 4 + r;
                    float ssq = 0.f;
#pragma unroll
                    for (int j = 0; j < 2; ++j) {
                        const int p = wn * 32 + j * 16 + (lane & 15);
                        const float xv = bf2f(*(const u16*)(T1 + swz256(p, l >> 3) + (l & 7) * 2));
                        u16* zp = zo + (size_t)(rb + l) * 1024 + h * 64 + p;
                        const float z = bf2f(*zp);
                        const float y = (Y[i][j][r] + Dh * xv) * siluf(z);
                        *zp = f2bf(y);
                        ssq += y * y;
                    }
                    ssq += __shfl_xor(ssq, 1); ssq += __shfl_xor(ssq, 2); ssq += __shfl_xor(ssq, 4); ssq += __shfl_xor(ssq, 8);
                    if ((lane & 15) == 0) ((float*)(ws + O_SSQ))[(size_t)(rb + l) * 16 + h * 2 + wn] = ssq;
                }
            __syncthreads();
        } else {
            const int v = u - NSSD;
            const int h = v & 3, ct = v >> 2, b = ct >> 5, c = ct & 31, cc = c + 2;
            const int rb = b * 4096 + c * 128, lpos = c * 128;
            const float mp0 = ((const float*)(ws + O_MLP))[((size_t)(b * NCH + cc) * 4 + h) * 2 + 0];
            const float mp1 = ((const float*)(ws + O_MLP))[((size_t)(b * NCH + cc) * 4 + h) * 2 + 1];
            {
                const int dir = t >> 7, idx = t & 127;
                const int s = dir ? 127 - idx : idx;
                const float fv = ((const float*)(ws + O_GF))[(size_t)(rb + s) * 8 + dir * 4 + h];
                const float iv = ((const float*)(ws + O_GI))[(size_t)(rb + s) * 8 + dir * 4 + h];
                const float bc = scan_pair<0>(fv, sbuf);
                const float uv = iv - bc;
                __syncthreads();
                const float mx = scan_pair<1>(uv, sbuf);
                const float mm = fmaxf(dir ? mp1 : mp0, mx);
                if (dir == 0) { a0[s] = bc; a2[s] = uv; a4[s] = mm; } else { a1[s] = bc; a3[s] = uv; a5[s] = mm; }
            }
            load_tile128(T0, 0, (const u16*)(ws + O_Q) + (size_t)rb * 512 + h * 128, 512, 128);
            load_tile128(T1, 0, (const u16*)(ws + O_K) + (size_t)rb * 512 + h * 128, 512, 128);
            __syncthreads();
            f32x4 S[4][4]; zero_acc(S);
            lds_mma<4, 4>(T0, T1, wm * 64, wn * 64, S, lane);
            {
                const int dir = t >> 7, idx = t & 127;
                const float* np = (const float*)(ws + O_MLN) + (((size_t)(b * NCH + cc) * 4 + h) * 2 + dir) * 128;
                float acc = 0.f;
#pragma unroll 4
                for (int cch = 0; cch < 16; ++cch) {
                    const uint4 qv = *(const uint4*)(T0 + swz256(idx, cch));
                    const float4 n0 = *(const float4*)(np + cch * 8), n1 = *(const float4*)(np + cch * 8 + 4);
                    acc += bflo(qv.x) * n0.x + bfhi(qv.x) * n0.y + bflo(qv.y) * n0.z + bfhi(qv.y) * n0.w
                         + bflo(qv.z) * n1.x + bfhi(qv.z) * n1.y + bflo(qv.w) * n1.z + bfhi(qv.w) * n1.w;
                }
                qn[dir * 128 + idx] = acc;
            }
            float su0[4], su1[4];
            int dbase = wn * 64 + (lane & 15) - wm * 64 - (lane >> 4) * 4; asm volatile("" : "+v"(dbase));
#pragma unroll
            for (int j = 0; j < 4; ++j) { const int s = wn * 64 + j * 16 + (lane & 15); su0[j] = a2[s]; su1[j] = a3[s]; }
#pragma unroll
            for (int i = 0; i < 4; ++i)
#pragma unroll
                for (int r = 0; r < 4; ++r) {
                    const int tt = wm * 64 + i * 16 + (lane >> 4) * 4 + r;
                    const float m0 = a4[tt], m1 = a5[tt];
                    float r0 = 0.f, r1 = 0.f;
#pragma unroll
                    for (int j = 0; j < 4; ++j) {
                        const int s = wn * 64 + j * 16 + (lane & 15);
                        const float sv = S[i][j][r];
                        const int diff = dbase + (j * 16 - i * 16 - r);
                        r0 += sv * __expf((diff <= 0) ? (su0[j] - m0) : -INFINITY);
                        r1 += sv * __expf((diff >= 0) ? (su1[j] - m1) : -INFINITY);
                    }
                    r0 += __shfl_xor(r0, 1); r0 += __shfl_xor(r0, 2); r0 += __shfl_xor(r0, 4); r0 += __shfl_xor(r0, 8);
                    r1 += __shfl_xor(r1, 1); r1 += __shfl_xor(r1, 2); r1 += __shfl_xor(r1, 4); r1 += __shfl_xor(r1, 8);
                    if ((lane & 15) == 0) { rsA[(0 * 2 + wn) * 128 + tt] = r0; rsA[(1 * 2 + wn) * 128 + tt] = r1; }
                }
            __syncthreads();
            {
                const int dir = t >> 7, tt = t & 127;
                const float rs = rsA[(dir * 2 + 0) * 128 + tt] + rsA[(dir * 2 + 1) * 128 + tt];
                const float mm = dir ? a5[tt] : a4[tt];
                const float wi = __expf((dir ? mp1 : mp0) - mm);
                const float den = rs + wi * qn[dir * 128 + tt];
                const float mout = (dir ? a1[tt] : a0[tt]) + mm;
                const float dn = fmaxf(fabsf(den), __expf(-mout));
                fac[dir * 128 + tt] = 1.f / dn;
                wfac[dir * 128 + tt] = wi / dn;
            }
            __syncthreads();
            load_tile128_rowscaled(T0, 0, (const u16*)(ws + O_Q) + (size_t)rb * 512 + h * 128, 512, 128, wfac);
            load_tile128(T1, 0, (const u16*)(ws + O_MLC0) + ((size_t)(b * NCH + cc) * 4 + h) * 16384, 128, 128);
            __syncthreads();
            f32x4 H[4][4]; zero_acc(H);
            lds_mma<4, 4>(T0, T1, wm * 64, wn * 64, H, lane);
            __syncthreads();
            load_tile128_rowscaled(T0, 0, (const u16*)(ws + O_Q) + (size_t)rb * 512 + h * 128, 512, 128, wfac + 128);
            load_tile128(T1, 0, (const u16*)(ws + O_MLC1) + ((size_t)(b * NCH + cc) * 4 + h) * 16384, 128, 128);
            __syncthreads();
            lds_mma<4, 4>(T0, T1, wm * 64, wn * 64, H, lane);
            __syncthreads();
            asm volatile("" : "+v"(dbase));
#pragma unroll
            for (int i = 0; i < 4; ++i)
#pragma unroll
                for (int r = 0; r < 4; ++r) {
                    const int tt = wm * 64 + i * 16 + (lane >> 4) * 4 + r;
                    const float m0 = a4[tt], m1 = a5[tt], f0 = fac[tt], f1 = fac[128 + tt];
#pragma unroll
                    for (int j = 0; j < 4; ++j) {
                        const int s = wn * 64 + j * 16 + (lane & 15);
                        const int diff = dbase + (j * 16 - i * 16 - r);
                        const float f = __expf((diff <= 0) ? (su0[j] - m0) : -INFINITY) * f0 + __expf((diff >= 0) ? (su1[j] - m1) : -INFINITY) * f1;
                        *(u16*)(T0 + swz256(tt, s >> 3) + (s & 7) * 2) = f2bf(S[i][j][r] * f);
                    }
                }
            load_tile128(T1, 0, (const u16*)(ws + O_VT) + ((size_t)(b * 512 + h * 128)) * 4096 + lpos, 4096, 128);
            __syncthreads();
            lds_mma<4, 4>(T0, T1, wm * 64, wn * 64, H, lane);
            const u16* zo = (const u16*)(ws + O_ZO);
#pragma unroll
            for (int i = 0; i < 4; ++i)
#pragma unroll
                for (int r = 0; r < 4; ++r) {
                    const int tt = wm * 64 + i * 16 + (lane >> 4) * 4 + r;
                    const int lp = lpos + tt;
                    const size_t rown = (size_t)b * 4096 + ((lp & 63) << 6) + (lp >> 6);
                    float ssq = 0.f;
#pragma unroll
                    for (int j = 0; j < 4; ++j) {
                        const int d = wn * 64 + j * 16 + (lane & 15);
                        const float o = bf2f(zo[rown * 1024 + 512 + h * 128 + d]);
                        const float hv = H[i][j][r] * sigmf(o);
                        H[i][j][r] = hv;
                        ssq += hv * hv;
                    }
                    ssq += __shfl_xor(ssq, 1); ssq += __shfl_xor(ssq, 2); ssq += __shfl_xor(ssq, 4); ssq += __shfl_xor(ssq, 8);
                    if ((lane & 15) == 0) rsA[wn * 128 + tt] = ssq;
                }
            __syncthreads();
            u16* zow = (u16*)(ws + O_ZO);
            const u16* xc = (const u16*)(ws + O_XC);
#pragma unroll
            for (int i = 0; i < 4; ++i)
#pragma unroll
                for (int r = 0; r < 4; ++r) {
                    const int tt = wm * 64 + i * 16 + (lane >> 4) * 4 + r;
                    const int lp = lpos + tt;
                    const size_t rown = (size_t)b * 4096 + ((lp & 63) << 6) + (lp >> 6);
                    const float rn = rsqrtf((rsA[tt] + rsA[128 + tt]) * (1.f / 128.f) + 1e-6f);
#pragma unroll
                    for (int j = 0; j < 4; ++j) {
                        const int d = wn * 64 + j * 16 + (lane & 15), chg = h * 128 + d;
                        const float y = H[i][j][r] * rn * P.in[I_MNW][chg] + P.in[I_MSKIP][chg] * bf2f(xc[(size_t)(rb + tt) * 512 + chg]);
                        zow[rown * 1024 + 512 + chg] = f2bf(y);
                    }
                }
            __syncthreads();
        }
    }
}

__device__ void phase7(const Params& P, char* lds) {
    unsigned char* ws = P.ws;
    const int t = threadIdx.x, lane = t & 63, w = t >> 6, wm = w >> 1, wn = w & 1;
    float* rowscale = (float*)(lds + 65536);
    const u16* A = (const u16*)(ws + O_ZO);
    const u16* B = (const u16*)(ws + O_WOUT);
    const float* mod = (const float*)(ws + O_MOD);
    for (int u = blockIdx.x; u < 128 * 8; u += gridDim.x) {
        const int mt = u >> 3, nt = u & 7;
        if (t < 128) {
            const float* sq = (const float*)(ws + O_SSQ) + (size_t)(mt * 128 + t) * 16;
            float s = 0.f;
#pragma unroll
            for (int q = 0; q < 16; ++q) s += sq[q];
            rowscale[t] = rsqrtf(s * (1.f / 512.f) + 1e-6f);
        }
        RowPtrs rp;
#pragma unroll
        for (int i = 0; i < 4; ++i) {
            const int r = (t >> 3) + 32 * i;
            rp.a[i] = A + (size_t)(mt * 128 + r) * 1024;
            rp.b[i] = B + (size_t)(nt * 128 + r) * 1024;
        }
        f32x4 acc[4][4]; zero_acc(acc);
        gemm_mainloop<true>(lds, rp.a[0], rp.a[1], rp.a[2], rp.a[3], rp.b[0], rp.b[1], rp.b[2], rp.b[3], 1024, acc, rowscale);
        const int b = mt >> 5;
#pragma unroll
        for (int i = 0; i < 4; ++i)
#pragma unroll
            for (int j = 0; j < 4; ++j) {
                const int col = nt * 128 + wn * 64 + j * 16 + (lane & 15);
                const float g1 = mod[b * 6144 + 2048 + col];
#pragma unroll
                for (int r = 0; r < 4; ++r) {
                    const size_t row = (size_t)mt * 128 + wm * 64 + i * 16 + (lane >> 4) * 4 + r;
                    P.out[row * 1024 + col] = P.in[I_X][row * 1024 + col] + g1 * acc[i][j][r];
                }
            }
        __syncthreads();
    }
}

__device__ void phase8(const Params& P, char* lds) {
    unsigned char* ws = P.ws;
    const int t = threadIdx.x, lane = t & 63, w = t >> 6;
    float* tt = (float*)lds;
    const float* mod = (const float*)(ws + O_MOD);
    const int NR = 1024, NTR = 6144;
    for (int u = blockIdx.x; u < NR + NTR; u += gridDim.x) {
        if (u < NR) {
            const int tk0 = u * 16;
            const int b = tk0 >> 12;
#pragma unroll 1
            for (int q = 0; q < 4; ++q) {
                const int tl = w * 4 + q;
                const float* xr = P.out + (size_t)(tk0 + tl) * 1024;
                float4 v[4]; float ss = 0.f;
#pragma unroll
                for (int j = 0; j < 4; ++j) { v[j] = ((const float4*)xr)[lane + 64 * j]; ss += v[j].x * v[j].x + v[j].y * v[j].y + v[j].z * v[j].z + v[j].w * v[j].w; }
                ss = wave_sum(ss);
                const float rstd = rsqrtf(ss * (1.f / 1024.f) + 1e-6f);
#pragma unroll
                for (int j = 0; j < 4; ++j) {
                    const int k = (lane + 64 * j) * 4;
                    const float4 nwv = *(const float4*)(P.in[I_N2W] + k);
                    const float4 sh = *(const float4*)(mod + b * 6144 + 3072 + k);
                    const float4 sc = *(const float4*)(mod + b * 6144 + 4096 + k);
                    float4 hh;
                    hh.x = v[j].x * rstd * nwv.x * (1.f + sc.x) + sh.x;
                    hh.y = v[j].y * rstd * nwv.y * (1.f + sc.y) + sh.y;
                    hh.z = v[j].z * rstd * nwv.z * (1.f + sc.z) + sh.z;
                    hh.w = v[j].w * rstd * nwv.w * (1.f + sc.w) + sh.w;
                    uint2 o; o.x = pack2(hh.x, hh.y); o.y = pack2(hh.z, hh.w);
                    *(uint2*)((u16*)(ws + O_T) + (size_t)(tk0 + tl) * 1024 + k) = o;
                    *(float4*)(tt + tl * 1028 + k) = hh;
                }
            }
            __syncthreads();
            f32x4 c0 = {0, 0, 0, 0}, c1 = {0, 0, 0, 0}, c2 = {0, 0, 0, 0};
            const int ti = lane & 15, kq = lane >> 4;
            const float* rew = P.in[I_REW];
            const float* rgw = P.in[I_RGW];
#pragma unroll 4
            for (int ks = 0; ks < 64; ++ks) {
                const int k = w * 256 + ks * 4 + kq;
                const float a = tt[ti * 1028 + k];
                const float b0 = rew[(size_t)k * 32 + ti];
                const float b1 = rew[(size_t)k * 32 + 16 + ti];
                const float b2 = ti < 4 ? rgw[(size_t)k * 4 + ti] : 0.f;
                c0 = __builtin_amdgcn_mfma_f32_16x16x4f32(a, b0, c0, 0, 0, 0);
                c1 = __builtin_amdgcn_mfma_f32_16x16x4f32(a, b1, c1, 0, 0, 0);
                c2 = __builtin_amdgcn_mfma_f32_16x16x4f32(a, b2, c2, 0, 0, 0);
            }
            __syncthreads();
            float* red = (float*)lds;
#pragma unroll
            for (int r = 0; r < 4; ++r) {
                const int row = kq * 4 + r;
                red[(w * 16 + row) * 48 + ti] = c0[r];
                red[(w * 16 + row) * 48 + 16 + ti] = c1[r];
                red[(w * 16 + row) * 48 + 32 + ti] = c2[r];
            }
            __syncthreads();
            if (t < 16) {
                float lg[36];
#pragma unroll
                for (int j = 0; j < 36; ++j) lg[j] = red[(0 * 16 + t) * 48 + j] + red[(1 * 16 + t) * 48 + j] + red[(2 * 16 + t) * 48 + j] + red[(3 * 16 + t) * 48 + j];
                float gl[4];
#pragma unroll
                for (int j = 0; j < 4; ++j) gl[j] = lg[32 + j] + P.in[I_RGB][j];
                int gs = 0; float gm = gl[0];
#pragma unroll
                for (int j = 1; j < 4; ++j) if (gl[j] > gm) { gm = gl[j]; gs = j; }
                float gsum = 0.f;
#pragma unroll
                for (int j = 0; j < 4; ++j) gsum += __expf(gl[j] - gm);
                const float pg = 1.f / gsum;
                float el[8];
#pragma unroll
                for (int j = 0; j < 8; ++j) {
                    float vsel = lg[j];
#pragma unroll
                    for (int g2 = 1; g2 < 4; ++g2) vsel = (gs == g2) ? lg[g2 * 8 + j] : vsel;
                    el[j] = vsel + P.in[I_REB][gs * 8 + j];
                }
                int i1 = 0; float m1 = el[0];
#pragma unroll
                for (int j = 1; j < 8; ++j) if (el[j] > m1) { m1 = el[j]; i1 = j; }
                int i2 = -1; float m2 = -INFINITY;
#pragma unroll
                for (int j = 0; j < 8; ++j) if (j != i1 && el[j] > m2) { m2 = el[j]; i2 = j; }
                const float e2 = __expf(m2 - m1);
                const float w1 = pg / (1.f + e2), w2 = pg * e2 / (1.f + e2);
                const int tok = tk0 + t;
                int* cnt = (int*)(ws + O_CNT);
                int* list = (int*)(ws + O_LIST);
                float* wts = (float*)(ws + O_WTS);
                const int ea = gs * 8 + i1, eb = gs * 8 + i2;
                const int pa = atomicAdd(&cnt[ea], 1);
                list[ea * 16384 + pa] = tok * 2;
                wts[tok * 2] = w1;
                const int pb = atomicAdd(&cnt[eb], 1);
                list[eb * 16384 + pb] = tok * 2 + 1;
                wts[tok * 2 + 1] = w2;
            }
            __syncthreads();
        } else {
            const int v = u - NR;
            float* tile = (float*)lds;
            if (v < 4096) {
                const bool up = v >= 2048;
                const int vv = v & 2047, e = vv >> 6, rem = vv & 63, nt = rem >> 4, kt = rem & 15;
                const float* src = P.in[up ? I_WU : I_WG] + (size_t)e * 1024 * 256;
                transpose_tile(tile, src, 256, kt * 64, nt * 64, 64, (u16*)(ws + O_WGU) + (size_t)e * 512 * 1024, (up ? 256 : 0) + nt * 64, 1024, nullptr, 0);
            } else {
                const int vv = v - 4096, e = vv >> 6, rem = vv & 63, nt = rem >> 2, kt = rem & 3;
                const float* src = P.in[I_WD] + (size_t)e * 256 * 1024;
                transpose_tile(tile, src, 1024, kt * 64, nt * 64, 64, (u16*)(ws + O_WD) + (size_t)e * 1024 * 256, nt * 64, 256, nullptr, 0);
            }
        }
    }
}

__device__ __forceinline__ void moe_prefix(const unsigned char* ws, int* pre_t, int* pre_c) {
    if (threadIdx.x == 0) {
        const int* cnt = (const int*)(ws + O_CNT);
        int at = 0, ac = 0;
        for (int e = 0; e < 32; ++e) { pre_t[e] = at; pre_c[e] = ac; const int c = cnt[e]; at += (c + 127) >> 7; ac += c; }
        pre_t[32] = at; pre_c[32] = ac;
    }
    __syncthreads();
}
__device__ void phase9(const Params& P, char* lds) {
    unsigned char* ws = P.ws;
    const int t = threadIdx.x, lane = t & 63, w = t >> 6, wm = w >> 1, wn = w & 1;
    int* pre_t = (int*)(lds + 65536); int* pre_c = pre_t + 40;
    moe_prefix(ws, pre_t, pre_c);
    const int total = pre_t[32] * 4;
    const int* list = (const int*)(ws + O_LIST);
    const u16* T = (const u16*)(ws + O_T);
    for (int u = blockIdx.x; u < total; u += gridDim.x) {
        const int mtg = u >> 2, nt = u & 3;
        int e = 0;
        while (pre_t[e + 1] <= mtg) ++e;
        const int mt = mtg - pre_t[e];
        const int cnt = pre_c[e + 1] - pre_c[e], base = pre_c[e];
        RowPtrs rp;
#pragma unroll
        for (int i = 0; i < 4; ++i) {
            const int r = (t >> 3) + 32 * i;
            const int idx = mt * 128 + r;
            const int tok = idx < cnt ? (list[e * 16384 + idx] >> 1) : 0;
            rp.a[i] = T + (size_t)tok * 1024;
            const int wnv = r >> 6, part = (r >> 5) & 1, cc = r & 31;
            rp.b[i] = (const u16*)(ws + O_WGU) + ((size_t)e * 512 + part * 256 + nt * 64 + wnv * 32 + cc) * 1024;
        }
        f32x4 acc[4][4]; zero_acc(acc);
        gemm_mainloop<false>(lds, rp.a[0], rp.a[1], rp.a[2], rp.a[3], rp.b[0], rp.b[1], rp.b[2], rp.b[3], 1024, acc, nullptr);
        u16* H = (u16*)(ws + O_H);
#pragma unroll
        for (int i = 0; i < 4; ++i)
#pragma unroll
            for (int r = 0; r < 4; ++r) {
                const int idx = mt * 128 + wm * 64 + i * 16 + (lane >> 4) * 4 + r;
                if (idx < cnt) {
#pragma unroll
                    for (int jj = 0; jj < 2; ++jj) {
                        const float g = acc[i][jj][r], uu = acc[i][jj + 2][r];
                        H[(size_t)(base + idx) * 256 + nt * 64 + wn * 32 + jj * 16 + (lane & 15)] = f2bf(siluf(g) * uu);
                    }
                }
            }
    }
}
__device__ void phase10(const Params& P, char* lds) {
    unsigned char* ws = P.ws;
    const int t = threadIdx.x, lane = t & 63, w = t >> 6, wm = w >> 1, wn = w & 1;
    int* pre_t = (int*)(lds + 65536); int* pre_c = pre_t + 40;
    moe_prefix(ws, pre_t, pre_c);
    const int total = pre_t[32] * 8;
    const int* list = (const int*)(ws + O_LIST);
    const float* wts = (const float*)(ws + O_WTS);
    const u16* H = (const u16*)(ws + O_H);
    u16* SL = (u16*)(ws + O_SL);
    for (int u = blockIdx.x; u < total; u += gridDim.x) {
        const int mtg = u >> 3, nt = u & 7;
        int e = 0;
        while (pre_t[e + 1] <= mtg) ++e;
        const int mt = mtg - pre_t[e];
        const int cnt = pre_c[e + 1] - pre_c[e], base = pre_c[e];
        RowPtrs rp;
#pragma unroll
        for (int i = 0; i < 4; ++i) {
            const int r = (t >> 3) + 32 * i;
            rp.a[i] = H + (size_t)(base + mt * 128 + r) * 256;
            rp.b[i] = (const u16*)(ws + O_WD) + ((size_t)e * 1024 + nt * 128 + r) * 256;
        }
        f32x4 acc[4][4]; zero_acc(acc);
        gemm_mainloop<false>(lds, rp.a[0], rp.a[1], rp.a[2], rp.a[3], rp.b[0], rp.b[1], rp.b[2], rp.b[3], 256, acc, nullptr);
#pragma unroll
        for (int i = 0; i < 4; ++i)
#pragma unroll
            for (int r = 0; r < 4; ++r) {
                const int idx = mt * 128 + wm * 64 + i * 16 + (lane >> 4) * 4 + r;
                if (idx < cnt) {
                    const int ent = list[e * 16384 + idx];
                    const float wg = wts[ent];
#pragma unroll
                    for (int j = 0; j < 4; ++j)
                        SL[(size_t)ent * 1024 + nt * 128 + wn * 64 + j * 16 + (lane & 15)] = f2bf(acc[i][j][r] * wg);
                }
            }
    }
}

__device__ void phase11(const Params& P) {
    unsigned char* ws = P.ws;
    const int lane = threadIdx.x & 63;
    const int gw = blockIdx.x * 4 + (threadIdx.x >> 6), nw = gridDim.x * 4;
    const float* mod = (const float*)(ws + O_MOD);
    const u16* SL = (const u16*)(ws + O_SL);
    for (int row = gw; row < MLAT; row += nw) {
        const int b = row >> 12;
        float* xr = P.out + (size_t)row * 1024;
        float4 v[4]; float ss = 0.f;
#pragma unroll
        for (int j = 0; j < 4; ++j) {
            const int k = (lane + 64 * j) * 4;
            v[j] = *(const float4*)(xr + k);
            const uint2 s0 = *(const uint2*)(SL + (size_t)(row * 2) * 1024 + k);
            const uint2 s1 = *(const uint2*)(SL + (size_t)(row * 2 + 1) * 1024 + k);
            const float4 g2 = *(const float4*)(mod + b * 6144 + 5120 + k);
            v[j].x += g2.x * (bflo(s0.x) + bflo(s1.x));
            v[j].y += g2.y * (bfhi(s0.x) + bfhi(s1.x));
            v[j].z += g2.z * (bflo(s0.y) + bflo(s1.y));
            v[j].w += g2.w * (bfhi(s0.y) + bfhi(s1.y));
            ss += v[j].x * v[j].x + v[j].y * v[j].y + v[j].z * v[j].z + v[j].w * v[j].w;
        }
        ss = wave_sum(ss);
        const float rstd = rsqrtf(ss * (1.f / 1024.f) + 1e-6f);
#pragma unroll
        for (int j = 0; j < 4; ++j) {
            const int k = (lane + 64 * j) * 4;
            const float4 fw = *(const float4*)(P.in[I_FNW] + k);
            float4 o; o.x = v[j].x * rstd * fw.x; o.y = v[j].y * rstd * fw.y; o.z = v[j].z * rstd * fw.z; o.w = v[j].w * rstd * fw.w;
            *(float4*)(xr + k) = o;
        }
    }
}

__global__ void __launch_bounds__(NT, 1) fwd_kernel(Params P) {
    extern __shared__ __attribute__((aligned(16))) char lds[];
#if ONE_LAUNCH
    if (threadIdx.x < 4) ((volatile LAS unsigned*)(lds + LDS_MAIN))[threadIdx.x] = 0u;
    __syncthreads();
    XcdBarrier xbar = xcd_barrier_post((unsigned*)(P.ws + O_BAR), (volatile LAS unsigned*)(lds + LDS_MAIN));
#define SYNC() xcd_barrier(xbar)
#else
#define SYNC() do {} while (0)
#endif
#define RUN_PHASE(k, call) do { if (P.lo <= (k) && (k) < P.hi) { call; if ((k) + 1 < P.hi) { SYNC(); } } } while (0)
    RUN_PHASE(0, phase0(P, lds));
    RUN_PHASE(1, phase1(P));
    RUN_PHASE(2, phase2(P, lds));
    RUN_PHASE(3, phase3(P, lds));
    RUN_PHASE(4, phase4(P, lds));
    RUN_PHASE(5, phase5(P));
    RUN_PHASE(6, phase6(P, lds));
    RUN_PHASE(7, phase7(P, lds));
    RUN_PHASE(8, phase8(P, lds));
    RUN_PHASE(9, phase9(P, lds));
    RUN_PHASE(10, phase10(P, lds));
    RUN_PHASE(11, phase11(P));
}

extern "C" void kernel_launch(void* const* d_in, const int* in_sizes, int n_in, void* d_out, int out_size, void* d_ws, size_t ws_size,
                              hipStream_t stream) {
    static int grid_blocks = 0;
    if (!grid_blocks) {
        int dev = 0, cus = 0, per_cu = 0;
        hipGetDevice(&dev);
        hipDeviceGetAttribute(&cus, hipDeviceAttributeMultiprocessorCount, dev);
        hipFuncSetAttribute((const void*)fwd_kernel, hipFuncAttributeMaxDynamicSharedMemorySize, LDS_BYTES);
        hipOccupancyMaxActiveBlocksPerMultiprocessor(&per_cu, (const void*)fwd_kernel, NT, LDS_BYTES);
        if (per_cu < 1) per_cu = 1;
        if (per_cu > 2) per_cu = 2;
        grid_blocks = cus * per_cu;
        if (ws_size < WS_END) fprintf(stderr, "workspace too small: %zu < %zu\n", ws_size, (size_t)WS_END);
    }
    Params p{};
    for (int i = 0; i < 30; ++i) p.in[i] = (const float*)d_in[i];
    p.out = (float*)d_out; p.ws = (unsigned char*)d_ws;
#if ONE_LAUNCH
    p.lo = 0; p.hi = NPHASE;
    (void)hipMemsetAsync((char*)d_ws + O_BAR, 0, XCD_BAR_WORDS * 4, stream);
    void* args[] = {&p};
    hipError_t e = hipLaunchCooperativeKernel((const void*)fwd_kernel, dim3(grid_blocks), dim3(NT), args, LDS_BYTES, stream);
    if (e != hipSuccess) fprintf(stderr, "cooperative launch failed: %s (grid %d)\n", hipGetErrorString(e), grid_blocks);
#else
    for (int ph = 0; ph < NPHASE; ++ph) {
        p.lo = ph; p.hi = ph + 1;
        hipLaunchKernelGGL(fwd_kernel, dim3(grid_blocks), dim3(NT), LDS_BYTES, stream, p);
    }
#endif
}
```

```cpp
#include <hip/hip_runtime.h>
#include <cstdio>
#include <cstdint>

typedef unsigned short u16;
typedef __attribute__((ext_vector_type(8))) short bf16x8;
typedef __attribute__((ext_vector_type(4))) float f32x4;
typedef __attribute__((ext_vector_type(4))) unsigned u32x4;
#define LAS __attribute__((address_space(3)))

constexpr int NTB = 512;
constexpr int VLDS = 75776;
constexpr int LDS_MAIN = 2 * VLDS;
constexpr int LDS_BYTES = LDS_MAIN + 256;
constexpr int MLAT = 16384, MALL = 17408;
constexpr int NCH = 34;
constexpr int NPHASE = 12;

enum { I_X = 0, I_C, I_CTX, I_CCTX, I_WMOD, I_BMOD, I_N1W, I_WIN, I_SCW, I_SCB, I_DTB, I_ALOG, I_SSDD, I_SNW, I_MCW, I_MCB, I_WQK, I_GB,
       I_MNW, I_MSKIP, I_WOUT, I_N2W, I_RGW, I_RGB, I_REW, I_REB, I_WG, I_WU, I_WD, I_FNW };

constexpr size_t al(size_t x) { return (x + 255) & ~(size_t)255; }
constexpr size_t O_MOD = 0;
constexpr size_t O_SSQ = O_MOD + al(5 * 6144 * 4);
constexpr size_t O_CNT = O_SSQ + al(16384 * 16 * 4);
constexpr size_t O_BAR = O_CNT + 4096;
constexpr size_t O_PSD = O_BAR + 16384;
constexpr size_t O_PSG = O_PSD + al((size_t)MALL * 16 * 4);
constexpr size_t O_DT = O_PSG + al((size_t)MALL * 16 * 4);
constexpr size_t O_GI = O_DT + al((size_t)MALL * 16 * 4);
constexpr size_t O_GF = O_GI + al((size_t)MALL * 8 * 4);
constexpr size_t O_ACH = O_GF + al((size_t)MALL * 8 * 4);
constexpr size_t O_MLS = O_ACH + 16384;
constexpr size_t O_MLP = O_MLS + 16384;
constexpr size_t O_MLN = O_MLP + 16384;
constexpr size_t O_LIST = O_MLN + al(4 * 34 * 4 * 2 * 128 * 4);
constexpr size_t O_WTS = O_LIST + al(32 * 16384 * 4);
constexpr size_t O_WIN = O_WTS + al(16384 * 2 * 4);
constexpr size_t O_WOUT = O_WIN + al((size_t)3328 * 1024 * 2);
constexpr size_t O_A = O_WOUT + al((size_t)1024 * 1024 * 2);
constexpr size_t SZ_A = (size_t)MALL * 1024 * 2;
constexpr size_t O_PT = O_A + SZ_A;
constexpr size_t SZ_PT = (size_t)MALL * 1536 * 2;
constexpr size_t O_MLC1 = O_PT + SZ_PT;
constexpr size_t SZ_HALF = (size_t)MALL * 512 * 2;
constexpr size_t O_ZO = O_MLC1 + SZ_HALF;
constexpr size_t O_VT = O_ZO + SZ_A;
constexpr size_t O_BM = O_VT + SZ_HALF;
constexpr size_t SZ_Q = (size_t)MALL * 256 * 2;
constexpr size_t O_BT = O_BM + SZ_Q;
constexpr size_t O_CM = O_BT + SZ_Q;
constexpr size_t O_XT = O_CM + SZ_Q;
constexpr size_t O_KT = O_XT + SZ_HALF;
constexpr size_t O_XC = O_KT + SZ_HALF;
constexpr size_t WS_END = O_XC + SZ_HALF;
constexpr size_t O_XN = O_A, O_Q = O_A, O_K = O_A + SZ_HALF, O_T = O_A;
constexpr size_t O_ST = O_PT;
constexpr size_t O_MLC0 = O_PT + (size_t)4 * 34 * 8 * 2 * 8192 * 2;
constexpr size_t O_WGU = O_PT;
constexpr size_t O_WD = O_PT + (size_t)32 * 512 * 1024 * 2;
constexpr size_t O_SL = O_ZO;
constexpr size_t O_H = O_XT;
static_assert(O_WD + (size_t)32 * 1024 * 256 * 2 <= O_MLC1, "moe weights fit PT region");
static_assert(O_SL + (size_t)16384 * 2 * 1024 * 2 <= O_CM, "slots fit");
static_assert((size_t)(32768 + 256) * 256 * 2 <= SZ_HALF, "H fits");
static_assert(WS_END <= (size_t)256 * 1024 * 1024, "workspace");
constexpr size_t TCTX512 = (size_t)4 * 512 * 4096;
constexpr size_t TCTX256 = (size_t)4 * 256 * 4096;

struct Params { const float* in[30]; float* out; unsigned char* ws; int lo, hi; };

#define XB_TMO      128
#define XB_XCNT(j)  (256  + 64 * (j))
#define XB_XSUB(j)  (1280 + 64 * (j))
#define XB_XGEN(j)  (2304 + 64 * (j))
#define XB_TOP      3328
#define XB_TOPGEN   3392
#define XCD_BAR_WORDS 3456
#define XB_SPIN_CAP (1u << 20)
__device__ __forceinline__ unsigned xb_ld(unsigned* p)              { return __hip_atomic_load(p, __ATOMIC_RELAXED, __HIP_MEMORY_SCOPE_AGENT); }
__device__ __forceinline__ unsigned xb_add(unsigned* p, unsigned v) { return __hip_atomic_fetch_add(p, v, __ATOMIC_RELAXED, __HIP_MEMORY_SCOPE_AGENT); }
__device__ __forceinline__ unsigned xb_xcc_id() { return (unsigned)__builtin_amdgcn_s_getreg((3 << 11) | 20) & 0xFu; }
#define XB_SPIN(cond, bar) do { unsigned _sp = 0; while (cond) { __builtin_amdgcn_s_sleep(1); \
    if ((++_sp & 255u) == 0u) { if (xb_ld(&(bar)[XB_TMO])) break; if (_sp > XB_SPIN_CAP) { atomicAdd(&(bar)[XB_TMO], 1u); break; } } } } while (0)
struct XcdBarrier { unsigned* bar; unsigned x; volatile LAS unsigned* st; };
__device__ __forceinline__ XcdBarrier xcd_barrier_post(unsigned* bar, volatile LAS unsigned* st) {
    XcdBarrier b; b.bar = bar; b.x = xb_xcc_id(); b.st = st;
    if (threadIdx.x == 0) (void)xb_add(&bar[XB_XCNT(b.x)], 1u);
    return b;
}
__device__ __forceinline__ void xcd_barrier_complete(unsigned* bar, unsigned x, unsigned& nloc, unsigned& nx) {
    const unsigned G = gridDim.x * gridDim.y * gridDim.z;
    unsigned sum, cnt, mine, sp = 0u;
    for (;;) {
        sum = 0u; cnt = 0u; mine = 0u;
#pragma unroll
        for (unsigned j = 0; j < 16; ++j) { const unsigned c = xb_ld(&bar[XB_XCNT(j)]); sum += c; cnt += (c > 0u) ? 1u : 0u; mine = (j == x) ? c : mine; }
        if (sum == G) break;
        __builtin_amdgcn_s_sleep(1);
        if ((++sp & 255u) == 0u) { if (xb_ld(&bar[XB_TMO])) break; if (sp > XB_SPIN_CAP) { atomicAdd(&bar[XB_TMO], 1u); break; } }
    }
    nloc = mine > 0u ? mine : 1u; nx = cnt > 0u ? cnt : 1u;
}
__device__ __forceinline__ void xcd_barrier(const XcdBarrier& b) {
    asm volatile("s_waitcnt vmcnt(0)" ::: "memory");
    __syncthreads();
    if (threadIdx.x == 0) {
        unsigned* bar = b.bar;
        __builtin_amdgcn_s_waitcnt(0);
        unsigned nloc = b.st[0], nx = b.st[1];
        if (nloc == 0u) { xcd_barrier_complete(bar, b.x, nloc, nx); b.st[0] = nloc; b.st[1] = nx; }
        const unsigned old = xb_add(&bar[XB_XSUB(b.x)], 1u);
        const unsigned gen = old / nloc;
        if (old + 1u == (gen + 1u) * nloc) {
            __builtin_amdgcn_fence(__ATOMIC_RELEASE, "agent");
            asm volatile("s_waitcnt vmcnt(0)" ::: "memory");
            const unsigned og = xb_add(&bar[XB_TOP], 1u);
            const unsigned tg = og / nx;
            if (og + 1u == (tg + 1u) * nx) xb_add(&bar[XB_TOPGEN], 1u);
            else XB_SPIN(xb_ld(&bar[XB_TOPGEN]) == tg, bar);
            __builtin_amdgcn_fence(__ATOMIC_ACQUIRE, "agent");
            xb_add(&bar[XB_XGEN(b.x)], 1u);
            asm volatile("s_waitcnt vmcnt(0)" ::: "memory");
        } else {
            XB_SPIN(xb_ld(&bar[XB_XGEN(b.x)]) == gen, bar);
            __builtin_amdgcn_fence(__ATOMIC_ACQUIRE, "agent");
            asm volatile("s_waitcnt vmcnt(0)" ::: "memory");
        }
    }
    __syncthreads();
}

__device__ __forceinline__ u16 f2bf(float f) { unsigned u = __float_as_uint(f); u += 0x7fffu + ((u >> 16) & 1u); return (u16)(u >> 16); }
__device__ __forceinline__ float bf2f(u16 h) { return __uint_as_float(((unsigned)h) << 16); }
__device__ __forceinline__ unsigned pack2(float a, float b) { return (unsigned)f2bf(a) | ((unsigned)f2bf(b) << 16); }
__device__ __forceinline__ float bflo(unsigned u) { return __uint_as_float(u << 16); }
__device__ __forceinline__ float bfhi(unsigned u) { return __uint_as_float(u & 0xffff0000u); }
__device__ __forceinline__ float siluf(float x) { return x / (1.f + __expf(-x)); }
__device__ __forceinline__ float sigmf(float x) { return 1.f / (1.f + __expf(-x)); }
__device__ __forceinline__ float softplusf(float x) { return x > 20.f ? x : log1pf(__expf(x)); }
__device__ __forceinline__ float wave_sum(float v) {
#pragma unroll
    for (int o = 32; o > 0; o >>= 1) v += __shfl_xor(v, o);
    return v;
}
__device__ __forceinline__ int swz256(int row, int chunk) { return row * 256 + ((chunk ^ (row & 15)) << 4); }
__device__ __forceinline__ int colmajor_src_row(int R) {
    if (R >= MLAT) return R;
    const int b = R >> 12, lp = R & 4095;
    return (b << 12) + ((lp & 63) << 6) + (lp >> 6);
}

__device__ __forceinline__ void load_tile128(char* lds, int lrow0, const u16* __restrict__ g, size_t ld, int rows, int t, int nthr) {
#pragma unroll 4
    for (int q = t; q < rows * 16; q += nthr) {
        const int r = q >> 4, c = q & 15;
        const uint4 v = *(const uint4*)(g + (size_t)r * ld + c * 8);
        *(uint4*)(lds + swz256(lrow0 + r, c)) = v;
    }
}
__device__ __forceinline__ void load_tile128_scaled(char* lds, int lrow0, const u16* __restrict__ g, size_t ld, int rows, const float* w, int t, int nthr) {
#pragma unroll 2
    for (int q = t; q < rows * 16; q += nthr) {
        const int r = q >> 4, c = q & 15;
        const uint4 v = *(const uint4*)(g + (size_t)r * ld + c * 8);
        const float* ww = w + c * 8;
        uint4 o;
        o.x = pack2(bflo(v.x) * ww[0], bfhi(v.x) * ww[1]);
        o.y = pack2(bflo(v.y) * ww[2], bfhi(v.y) * ww[3]);
        o.z = pack2(bflo(v.z) * ww[4], bfhi(v.z) * ww[5]);
        o.w = pack2(bflo(v.w) * ww[6], bfhi(v.w) * ww[7]);
        *(uint4*)(lds + swz256(lrow0 + r, c)) = o;
    }
}
template <int MI, int NJ>
__device__ __forceinline__ void lds_mma(const char* A, const char* B, int arow0, int brow0, f32x4 (&acc)[MI][NJ], int lane) {
#pragma unroll 1
    for (int kk = 0; kk < 4; ++kk) {
        const int chunk = kk * 4 + (lane >> 4);
        bf16x8 a[MI], b[NJ];
#pragma unroll
        for (int i = 0; i < MI; ++i) { const int row = arow0 + i * 16 + (lane & 15); a[i] = *(const bf16x8*)(A + swz256(row, chunk)); }
#pragma unroll
        for (int j = 0; j < NJ; ++j) { const int row = brow0 + j * 16 + (lane & 15); b[j] = *(const bf16x8*)(B + swz256(row, chunk)); }
#pragma unroll
        for (int i = 0; i < MI; ++i)
#pragma unroll
            for (int j = 0; j < NJ; ++j) acc[i][j] = __builtin_amdgcn_mfma_f32_16x16x32_bf16(a[i], b[j], acc[i][j], 0, 0, 0);
    }
}
template <int MI, int NJ>
__device__ __forceinline__ void zero_acc(f32x4 (&acc)[MI][NJ]) {
#pragma unroll
    for (int i = 0; i < MI; ++i)
#pragma unroll
        for (int j = 0; j < NJ; ++j) acc[i][j] = f32x4{0.f, 0.f, 0.f, 0.f};
}
template <int OP>
__device__ __forceinline__ float scan_pair(float v, float* buf, int t) {
    const int idx = t & 127, base = t & 128;
    const bool act = t < 256;
    if (act) buf[t] = v;
    __syncthreads();
#pragma unroll 1
    for (int off = 1; off < 128; off <<= 1) {
        float o = OP ? -INFINITY : 0.f;
        if (act && idx >= off) o = buf[base + idx - off];
        __syncthreads();
        v = OP ? fmaxf(v, o) : v + o;
        if (act) buf[t] = v;
        __syncthreads();
    }
    return v;
}

__device__ __forceinline__ void transpose_tile(float* tile, const float* __restrict__ src, int ld_src, int k0, int n0, int ncount,
                                               u16* dst, size_t dst_row0, int ld_dst, const float* __restrict__ scale, int scale_kmax, int t) {
    const int n = t & 63, kq = t >> 6;
#pragma unroll 4
    for (int i = 0; i < 16; ++i) {
        const int k = i * 4 + kq;
        float v = 0.f;
        if (n < ncount) { v = src[(size_t)(k0 + k) * ld_src + n0 + n]; if (scale && (k0 + k) < scale_kmax) v *= scale[k0 + k]; }
        tile[k * 65 + n] = v;
    }
    __syncthreads();
#pragma unroll
    for (int i = 0; i < 2; ++i) {
        const int q = t + 256 * i, nn = q >> 3, kc = q & 7;
        if (nn < ncount) {
            const float* p = tile + (kc * 8) * 65 + nn;
            uint4 o;
            o.x = pack2(p[0], p[65]); o.y = pack2(p[130], p[195]); o.z = pack2(p[260], p[325]); o.w = pack2(p[390], p[455]);
            *(uint4*)(dst + (dst_row0 + nn) * (size_t)ld_dst + k0 + kc * 8) = o;
        }
    }
    __syncthreads();
}

namespace g8 {
constexpr int BM = 256, BK = 64, HALF = 128, HTB = HALF * BK * 2, STAGE_BYTES = 8 * HTB;
__device__ __forceinline__ int lds_byte(int r, int c) { const int st = (r >> 4) * 2 + (c >> 5), rr = r & 15, cc = c & 31, ob = rr * 64 + cc * 2; return st * 1024 + (ob ^ (((ob >> 9) & 1) << 5)); }
__device__ __forceinline__ void stage_rc(int b, int& R, int& C) { const int st = b / 1024, sb = b % 1024, swz = sb ^ (((sb >> 9) & 1) << 5); R = (st >> 1) * 16 + swz / 64; C = (st & 1) * 32 + (swz % 64) / 2; }
__device__ __forceinline__ int perm32(int rho) { const int n = rho >> 4, i = rho & 15; return 8 * (i >> 2) + 4 * n + (i & 3); }
__device__ __forceinline__ unsigned cvt_pk_bf16(float lo, float hi) { unsigned r; asm volatile("v_cvt_pk_bf16_f32 %0, %1, %2" : "=v"(r) : "v"(lo), "v"(hi)); return r; }
typedef f32x4 Acc[2][2][4][2];

template <class Prob>
__device__ __forceinline__ void gemm_phase(LAS unsigned char* lds, const Prob& S) {
    const int tid = threadIdx.x, wid = __builtin_amdgcn_readfirstlane(tid >> 6), lane = tid & 63, wr = wid >> 2, wc = wid & 3, fr = lane & 15, fq = lane >> 4;
    constexpr int nt = Prob::K / BK;
    int R[2], C[2];
#pragma unroll
    for (int i = 0; i < 2; ++i) stage_rc(tid * 16 + i * 8192, R[i], C[i]);
    const size_t kstep = (size_t)(BK * 2);
    const unsigned ldsw = (unsigned)wid * 1024u;
    const int aoff = lds_byte(wr * 64 + fr, fq * 8), boff = lds_byte(wc * 32 + fr, fq * 8);
#define G8_SA(b, h) (((b) * 2 + (h)) * HTB)
#define G8_SB(b, h) ((4 + (b) * 2 + (h)) * HTB)
#define G8_STAGE(bufoff, gbase, voff) do { _Pragma("unroll") for (int _i = 0; _i < 2; ++_i) \
        __builtin_amdgcn_global_load_lds((const unsigned*)((const char*)(gbase) + (voff)[_i]), (LAS unsigned*)(lds + (bufoff) + ldsw + _i * 8192), 16, 0, 0); } while (0)
#define G8_LDA(dst, b, h) do { _Pragma("unroll") for (int m = 0; m < 4; ++m) _Pragma("unroll") for (int k = 0; k < 2; ++k) dst[m][k] = *(const LAS bf16x8*)(lds + G8_SA(b, h) + aoff + m * 2048 + k * 1024); } while (0)
#define G8_LDB(dst, b, h) do { _Pragma("unroll") for (int n = 0; n < 2; ++n) _Pragma("unroll") for (int k = 0; k < 2; ++k) dst[n][k] = *(const LAS bf16x8*)(lds + G8_SB(b, h) + boff + n * 2048 + k * 1024); } while (0)
#define G8_MMA(ai, bj, At, Bt) do { __builtin_amdgcn_s_setprio(1); _Pragma("unroll") for (int m = 0; m < 4; ++m) _Pragma("unroll") for (int n = 0; n < 2; ++n) _Pragma("unroll") for (int k = 0; k < 2; ++k) \
        acc[ai][bj][m][n] = __builtin_amdgcn_mfma_f32_16x16x32_bf16(Bt[n][k], At[m][k], acc[ai][bj][m][n], 0, 0, 0); __builtin_amdgcn_s_setprio(0); } while (0)
#define G8_WAIT_V(n) asm volatile("s_waitcnt vmcnt(" #n ")" ::: "memory")
#define G8_WAIT_L(n) asm volatile("s_waitcnt lgkmcnt(" #n ")" ::: "memory")
#define G8_BAR __builtin_amdgcn_s_barrier()
#define G8_SCHED __builtin_amdgcn_sched_barrier(0)
    typename Prob::Unit cur, nxt; int ui = 0;
    if (!S.next(0, cur)) return;
    Acc acc;
#pragma unroll
    for (int a = 0; a < 2; ++a)
#pragma unroll
        for (int b = 0; b < 2; ++b)
#pragma unroll
            for (int m = 0; m < 4; ++m)
#pragma unroll
                for (int n = 0; n < 2; ++n) acc[a][b][m][n] = (f32x4){0.f, 0.f, 0.f, 0.f};
    bf16x8 At[4][2], B0[2][2], B1[2][2];
    unsigned cOA[2][2], cOB[2][2], nOA[2][2], nOB[2][2];
    S.offs(cur, R, C, cOA, cOB);
    const char* cA = S.baseA(cur); const char* cB = S.baseB(cur);
    G8_STAGE(G8_SB(0, 0), cB, cOB[0]); G8_STAGE(G8_SA(0, 0), cA, cOA[0]); G8_STAGE(G8_SB(0, 1), cB, cOB[1]); G8_STAGE(G8_SA(0, 1), cA, cOA[1]);
    if (wr == 1) G8_BAR;
    G8_WAIT_V(4); G8_BAR;
    G8_STAGE(G8_SB(1, 0), cB + kstep, cOB[0]); G8_STAGE(G8_SA(1, 0), cA + kstep, cOA[0]); G8_STAGE(G8_SB(1, 1), cB + kstep, cOB[1]);
    G8_WAIT_V(6); G8_BAR;
    for (;;) {
        const bool has_next = S.next(ui + 1, nxt);
        const char* nA = cA; const char* nB = cB;
#pragma unroll
        for (int h = 0; h < 2; ++h)
#pragma unroll
            for (int i = 0; i < 2; ++i) { nOA[h][i] = cOA[h][i]; nOB[h][i] = cOB[h][i]; }
        if (has_next) { S.offs(nxt, R, C, nOA, nOB); nA = S.baseA(nxt); nB = S.baseB(nxt); }
#pragma unroll 1
        for (int t = 0; t < nt; t += 2) {
            const bool last = (t == nt - 2);
            if (Prob::MIDT > 0 && t == Prob::MIDT) S.mid(acc, cur, wr, fr);
            const char* a1 = cA + (size_t)(t + 1) * kstep;
            const char* a2 = last ? nA : cA + (size_t)(t + 2) * kstep; const char* b2 = last ? nB : cB + (size_t)(t + 2) * kstep;
            const char* a3 = a2 + kstep; const char* b3 = b2 + kstep;
            unsigned xA[2][2], xB[2][2];
#pragma unroll
            for (int h = 0; h < 2; ++h)
#pragma unroll
                for (int i = 0; i < 2; ++i) { xA[h][i] = last ? nOA[h][i] : cOA[h][i]; xB[h][i] = last ? nOB[h][i] : cOB[h][i]; }
            G8_LDB(B0, 0, 0); G8_SCHED; G8_LDA(At, 0, 0); G8_STAGE(G8_SA(1, 1), a1, cOA[1]);
            G8_WAIT_L(8); G8_BAR; G8_WAIT_L(0); G8_MMA(0, 0, At, B0); G8_BAR; G8_SCHED;
            G8_LDB(B1, 0, 1); G8_STAGE(G8_SB(0, 0), b2, xB[0]);
            G8_BAR; G8_WAIT_L(0); G8_MMA(0, 1, At, B1); G8_BAR;
            G8_LDA(At, 0, 1); G8_STAGE(G8_SA(0, 0), a2, xA[0]);
            G8_BAR; G8_WAIT_L(0); G8_MMA(1, 0, At, B0); G8_BAR; G8_SCHED;
            G8_STAGE(G8_SB(0, 1), b2, xB[1]);
            G8_WAIT_V(6); G8_BAR; G8_MMA(1, 1, At, B1); G8_BAR;
            G8_LDB(B0, 1, 0); G8_SCHED; G8_LDA(At, 1, 0); G8_STAGE(G8_SA(0, 1), a2, xA[1]);
            G8_WAIT_L(8); G8_BAR; G8_WAIT_L(0); G8_MMA(0, 0, At, B0); G8_BAR; G8_SCHED;
            G8_LDB(B1, 1, 1); G8_STAGE(G8_SB(1, 0), b3, xB[0]);
            G8_BAR; G8_WAIT_L(0); G8_MMA(0, 1, At, B1); G8_BAR;
            G8_LDA(At, 1, 1); G8_STAGE(G8_SA(1, 0), a3, xA[0]);
            G8_BAR; G8_WAIT_L(0); G8_MMA(1, 0, At, B0); G8_BAR; G8_SCHED;
            G8_STAGE(G8_SB(1, 1), b3, xB[1]);
            G8_WAIT_V(6); G8_BAR; G8_MMA(1, 1, At, B1); G8_BAR;
        }
        S.epi(acc, cur, wr, wc, fr, fq);
        if (!has_next) break;
#pragma unroll
        for (int a = 0; a < 2; ++a)
#pragma unroll
            for (int b = 0; b < 2; ++b)
#pragma unroll
                for (int m = 0; m < 4; ++m)
#pragma unroll
                    for (int n = 0; n < 2; ++n) acc[a][b][m][n] = (f32x4){0.f, 0.f, 0.f, 0.f};
        cur = nxt; cA = nA; cB = nB; ++ui;
#pragma unroll
        for (int h = 0; h < 2; ++h)
#pragma unroll
            for (int i = 0; i < 2; ++i) { cOA[h][i] = nOA[h][i]; cOB[h][i] = nOB[h][i]; }
    }
    G8_WAIT_V(0);
    if (wr == 0) G8_BAR;
    G8_BAR;
#undef G8_SA
#undef G8_SB
#undef G8_STAGE
#undef G8_LDA
#undef G8_LDB
#undef G8_MMA
#undef G8_WAIT_V
#undef G8_WAIT_L
#undef G8_BAR
#undef G8_SCHED
}
__device__ __forceinline__ void dense_unit(int wgid, int nM, int nN, int& pm, int& pn) {
    const int nwg = nM * nN, NXCD = 8, WGM = 8;
    { const int q = nwg / NXCD, r = nwg % NXCD, xcd = wgid % NXCD, off = wgid / NXCD; wgid = (xcd < r ? xcd * (q + 1) : r * (q + 1) + (xcd - r) * q) + off; }
    const int nig = WGM * nN, gid = wgid / nig, fm = gid * WGM, gsz = (nM - fm) < WGM ? (nM - fm) : WGM;
    pm = fm + ((wgid % nig) % gsz); pn = (wgid % nig) / gsz;
}
}

__device__ void phase0(const Params& P, char* lds_all) {
    unsigned char* ws = P.ws;
    const int vb = threadIdx.x >> 8, t = threadIdx.x & 255;
    char* lds = lds_all + vb * VLDS;
    float* tile = (float*)lds;
    const int NU = 1056 + 8 + 192;
    for (int u = blockIdx.x * 2 + vb; u < NU; u += gridDim.x * 2) {
        if (u < 1056) {
            const float* src; int ld, k0, n0, ncount = 64; u16* dst; size_t drow; const float* scale = nullptr;
            if (u < 800) {
                src = P.in[I_WIN]; ld = 3104; dst = (u16*)(ws + O_WIN);
                if (u < 384) { const int nt = u >> 4; k0 = (u & 15) * 64; n0 = nt * 64; drow = nt * 64; }
                else if (u < 512) { const int v = u - 384, nt = v >> 4; k0 = (v & 15) * 64; n0 = 1552 + nt * 64; drow = 1536 + nt * 64; }
                else if (u < 640) { const int v = u - 512, nt = v >> 4; k0 = (v & 15) * 64; n0 = 2576 + nt * 64; drow = 2048 + nt * 64; }
                else if (u < 768) { const int v = u - 640, nt = v >> 4; k0 = (v & 15) * 64; n0 = 2064 + nt * 64; drow = 2816 + nt * 64; }
                else if (u < 784) { k0 = (u - 768) * 64; n0 = 1536; ncount = 16; drow = 2560; }
                else { k0 = (u - 784) * 64; n0 = 3088; ncount = 16; drow = 2576; }
            } else {
                const int v = u - 800, nt = v >> 4; k0 = (v & 15) * 64; n0 = nt * 64; drow = nt * 64;
                src = P.in[I_WOUT]; ld = 1024; dst = (u16*)(ws + O_WOUT); scale = P.in[I_SNW];
            }
            transpose_tile(tile, src, ld, k0, n0, ncount, dst, drow, 1024, scale, 512, t);
        } else if (u < 1064) {
            const int base = (u - 1056) * 4096;
            for (int i = 0; i < 16; ++i) {
                const int idx = base + t + 256 * i;
                if (idx < 224 * 128) *(uint4*)(ws + O_WIN + ((size_t)(2592 + (idx >> 7)) * 1024 + (idx & 127) * 8) * 2) = make_uint4(0, 0, 0, 0);
            }
        } else {
            const int c0 = (u - 1064) * 32;
            float* sc = (float*)lds;
            float* red = sc + 5 * 1024;
            for (int i = t; i < 5 * 1024; i += 256) {
                const int r = i >> 10, k = i & 1023;
                const float v = r < 4 ? P.in[I_C][r * 1024 + k] : P.in[I_CCTX][k];
                sc[i] = siluf(v);
            }
            __syncthreads();
            const int col = t & 31, kg = t >> 5;
            float a0 = 0, a1 = 0, a2 = 0, a3 = 0, a4 = 0;
            const float* wp = P.in[I_WMOD] + (size_t)(kg * 128) * 6144 + c0 + col;
#pragma unroll 8
            for (int k = 0; k < 128; ++k) {
                const float wv = wp[(size_t)k * 6144];
                const int kk = kg * 128 + k;
                a0 += sc[kk] * wv; a1 += sc[1024 + kk] * wv; a2 += sc[2048 + kk] * wv; a3 += sc[3072 + kk] * wv; a4 += sc[4096 + kk] * wv;
            }
            red[(kg * 5 + 0) * 32 + col] = a0; red[(kg * 5 + 1) * 32 + col] = a1; red[(kg * 5 + 2) * 32 + col] = a2;
            red[(kg * 5 + 3) * 32 + col] = a3; red[(kg * 5 + 4) * 32 + col] = a4;
            __syncthreads();
            if (t < 160) {
                const int r = t >> 5, cc = t & 31;
                float s = P.in[I_BMOD][c0 + cc];
#pragma unroll
                for (int g = 0; g < 8; ++g) s += red[(g * 5 + r) * 32 + cc];
                ((float*)(ws + O_MOD))[r * 6144 + c0 + cc] = s;
            }
            __syncthreads();
        }
    }
    if (blockIdx.x == 0 && threadIdx.x < 32) ((int*)(ws + O_CNT))[threadIdx.x] = 0;
}

__device__ void phase1(const Params& P) {
    unsigned char* ws = P.ws;
    const int lane = threadIdx.x & 63;
    const int gw = blockIdx.x * 8 + (threadIdx.x >> 6), nw = gridDim.x * 8;
    const float* mod = (const float*)(ws + O_MOD);
    u16* xn = (u16*)(ws + O_XN);
    for (int row = gw; row < MALL; row += nw) {
        const float* xr = row < MLAT ? P.in[I_X] + (size_t)row * 1024 : P.in[I_CTX] + (size_t)(row - MLAT) * 1024;
        const int mb = row < MLAT ? (row >> 12) : 4;
        float4 v[4]; float ss = 0.f;
#pragma unroll
        for (int j = 0; j < 4; ++j) { v[j] = ((const float4*)xr)[lane + 64 * j]; ss += v[j].x * v[j].x + v[j].y * v[j].y + v[j].z * v[j].z + v[j].w * v[j].w; }
        ss = wave_sum(ss);
        const float rstd = rsqrtf(ss * (1.f / 1024.f) + 1e-6f);
#pragma unroll
        for (int j = 0; j < 4; ++j) {
            const int k = (lane + 64 * j) * 4;
            const float4 nwv = *(const float4*)(P.in[I_N1W] + k);
            const float4 sh = *(const float4*)(mod + mb * 6144 + k);
            const float4 sc = *(const float4*)(mod + mb * 6144 + 1024 + k);
            const float h0 = v[j].x * rstd * nwv.x * (1.f + sc.x) + sh.x;
            const float h1 = v[j].y * rstd * nwv.y * (1.f + sc.y) + sh.y;
            const float h2 = v[j].z * rstd * nwv.z * (1.f + sc.z) + sh.z;
            const float h3 = v[j].w * rstd * nwv.w * (1.f + sc.w) + sh.w;
            uint2 o; o.x = pack2(h0, h1); o.y = pack2(h2, h3);
            *(uint2*)(xn + (size_t)row * 1024 + k) = o;
        }
    }
}

struct InProj {
    static constexpr int K = 1024; static constexpr bool PERM = true; static constexpr int MIDT = 0;
    struct Unit { int pm, pn, vt; };
    const unsigned char* ws; int G, c;
    __device__ __forceinline__ bool next(int i, Unit& u) const {
        const int L = i * G + c;
        if (L >= 884) return false;
        if (L < 748) { u.vt = 0; g8::dense_unit(L, 68, 11, u.pm, u.pn); }
        else { const int v = L - 748; u.vt = 1; u.pm = v / 68; u.pn = v % 68; }
        return true;
    }
    __device__ __forceinline__ const char* baseA(const Unit& u) const { return (const char*)(ws + (u.vt ? O_WIN : O_XN)); }
    __device__ __forceinline__ const char* baseB(const Unit& u) const { return (const char*)(ws + (u.vt ? O_XN : O_WIN)); }
    __device__ __forceinline__ void offs(const Unit& u, const int (&R)[2], const int (&C)[2], unsigned (&oa)[2][2], unsigned (&ob)[2][2]) const {
#pragma unroll
        for (int h = 0; h < 2; ++h)
#pragma unroll
            for (int i = 0; i < 2; ++i) {
                const int Rb = (R[i] & ~31) + g8::perm32(R[i] & 31);
                if (!u.vt) {
                    int ar = u.pm * 256 + h * 128 + R[i];
                    if (u.pn == 6 || u.pn == 7) ar = colmajor_src_row(ar);
                    oa[h][i] = (unsigned)(ar * 1024 + C[i]) * 2u;
                    ob[h][i] = (unsigned)((u.pn * 256 + h * 128 + Rb) * 1024 + C[i]) * 2u;
                } else {
                    oa[h][i] = (unsigned)((2816 + u.pm * 256 + h * 128 + R[i]) * 1024 + C[i]) * 2u;
                    ob[h][i] = (unsigned)(colmajor_src_row(u.pn * 256 + h * 128 + Rb) * 1024 + C[i]) * 2u;
                }
            }
    }
    __device__ __forceinline__ void mid(g8::Acc&, const Unit&, int, int) const {}
    __device__ __forceinline__ void epi(g8::Acc& acc, const Unit& u, int wr, int wc, int fr, int fq) const {
        unsigned char* w = (unsigned char*)ws;
        const int row0 = u.pm * 256 + wr * 64 + fr;
        const int col0 = wc * 32 + 8 * fq;
        if (u.vt) {
            const int tok0 = u.pn * 256 + col0;
#pragma unroll
            for (int ai = 0; ai < 2; ++ai)
#pragma unroll
                for (int m = 0; m < 4; ++m) {
                    const int ch = row0 + ai * 128 + m * 16;
#pragma unroll
                    for (int bj = 0; bj < 2; ++bj) {
                        const int tk = tok0 + bj * 128;
                        u16* d;
                        if (tk < MLAT) d = (u16*)(w + O_VT) + ((size_t)((tk >> 12) * 512 + ch)) * 4096 + (tk & 4095);
                        else { const int tc = tk - MLAT; d = (u16*)(w + O_VT) + TCTX512 + ((size_t)((tc >> 8) * 512 + ch)) * 256 + (tc & 255); }
                        const f32x4 v0 = acc[ai][bj][m][0], v1 = acc[ai][bj][m][1];
                        u32x4 o; o.x = g8::cvt_pk_bf16(v0[0], v0[1]); o.y = g8::cvt_pk_bf16(v0[2], v0[3]); o.z = g8::cvt_pk_bf16(v1[0], v1[1]); o.w = g8::cvt_pk_bf16(v1[2], v1[3]);
                        *(u32x4*)d = o;
                    }
                }
            return;
        }
        if (u.pn == 10) {
            if (wc == 0) {
                float* dst = (float*)(w + (fq < 2 ? O_PSD : O_PSG)) + (fq & 1) * 8;
#pragma unroll
                for (int ai = 0; ai < 2; ++ai)
#pragma unroll
                    for (int m = 0; m < 4; ++m) {
                        float* d = dst + (size_t)(row0 + ai * 128 + m * 16) * 16;
                        *(f32x4*)d = acc[ai][0][m][0];
                        *(f32x4*)(d + 4) = acc[ai][0][m][1];
                    }
            }
            return;
        }
        u16* base; int ld;
        if (u.pn < 2) { base = (u16*)(w + O_ZO) + u.pn * 256; ld = 1024; }
        else if (u.pn < 6) { base = (u16*)(w + O_PT) + (u.pn - 2) * 256; ld = 1536; }
        else if (u.pn < 8) { base = (u16*)(w + O_PT) + 1024 + (u.pn - 6) * 256; ld = 1536; }
        else { base = (u16*)(w + O_ZO) + 512 + (u.pn - 8) * 256; ld = 1024; }
#pragma unroll
        for (int ai = 0; ai < 2; ++ai)
#pragma unroll
            for (int m = 0; m < 4; ++m) {
                u16* rowp = base + (size_t)(row0 + ai * 128 + m * 16) * ld + col0;
#pragma unroll
                for (int bj = 0; bj < 2; ++bj) {
                    const f32x4 v0 = acc[ai][bj][m][0], v1 = acc[ai][bj][m][1];
                    u32x4 o; o.x = g8::cvt_pk_bf16(v0[0], v0[1]); o.y = g8::cvt_pk_bf16(v0[2], v0[3]); o.z = g8::cvt_pk_bf16(v1[0], v1[1]); o.w = g8::cvt_pk_bf16(v1[2], v1[3]);
                    *(u32x4*)(rowp + bj * 128) = o;
                }
            }
    }
};

__device__ void phase3(const Params& P, char* lds_all) {
    unsigned char* ws = P.ws;
    const int vb = threadIdx.x >> 8, t = threadIdx.x & 255;
    char* lds = lds_all + vb * VLDS;
    u16* raw = (u16*)lds;
    float* xcl = (float*)(lds + 132 * 128);
    const u16* pt = (const u16*)(ws + O_PT);
    const int NCONV = 136 * 24;
    const int NU = NCONV + 136;
    for (int u = blockIdx.x * 2 + vb; u < NU; u += gridDim.x * 2) {
        if (u >= NCONV) {
            const int ct = u - NCONV, b = ct / NCH, cc = ct % NCH;
            const int rb = cc < 2 ? MLAT + b * 256 + cc * 128 : b * 4096 + (cc - 2) * 128;
            const int row = rb + (t >> 1), half = t & 1;
            const float* psd = (const float*)(ws + O_PSD) + (size_t)row * 16 + half * 8;
            float* dt = (float*)(ws + O_DT) + (size_t)row * 16 + half * 8;
#pragma unroll
            for (int j = 0; j < 8; ++j) dt[j] = softplusf(psd[j] + P.in[I_DTB][half * 8 + j]);
            const float* psg = (const float*)(ws + O_PSG) + (size_t)colmajor_src_row(row) * 16;
            if (half == 0) {
                float* gi = (float*)(ws + O_GI) + (size_t)row * 8;
#pragma unroll
                for (int j = 0; j < 8; ++j) gi[j] = psg[j] + P.in[I_GB][j];
            } else {
                float* gf = (float*)(ws + O_GF) + (size_t)row * 8;
#pragma unroll
                for (int j = 0; j < 8; ++j) { const float xx = psg[8 + j] + P.in[I_GB][8 + j]; gf[j] = fminf(xx, 0.f) - log1pf(__expf(-fabsf(xx))); }
            }
            continue;
        }
        const int ct = u / 24, cgp = u % 24;
        const int b = ct / NCH, cc = ct % NCH;
        const bool isctx = cc < 2;
        const int L = isctx ? 256 : 4096;
        const int lpos = isctx ? cc * 128 : (cc - 2) * 128;
        const int rb = isctx ? MLAT + b * 256 + cc * 128 : b * 4096 + (cc - 2) * 128;
        const int sb = rb - lpos;
        const bool isml = cgp >= 16;
        const int pcol = isml ? 1024 + (cgp - 16) * 64 : cgp * 64;
        for (int q = t; q < 132 * 8; q += 256) {
            const int r = q >> 3, c = q & 7;
            const int l = lpos - 2 + r;
            uint4 v = make_uint4(0, 0, 0, 0);
            if (l >= 0 && l < L) v = *(const uint4*)(pt + (size_t)(sb + l) * 1536 + pcol + c * 8);
            *(uint4*)(raw + r * 64 + c * 8) = v;
        }
        __syncthreads();
        const int ch = t & 63, tg = t >> 6;
        const float* cw = isml ? P.in[I_MCW] + (cgp - 16) * 64 + ch : P.in[I_SCW] + cgp * 64 + ch;
        const int cwld = isml ? 512 : 1024;
        const float w0 = cw[0], w1 = cw[cwld], w2 = cw[2 * cwld], w3 = cw[3 * cwld], w4 = cw[4 * cwld];
        const float bias = isml ? P.in[I_MCB][(cgp - 16) * 64 + ch] : P.in[I_SCB][cgp * 64 + ch];
        const int tok0 = tg * 32;
        float x0 = bf2f(raw[(tok0 + 0) * 64 + ch]), x1 = bf2f(raw[(tok0 + 1) * 64 + ch]), x2 = bf2f(raw[(tok0 + 2) * 64 + ch]), x3 = bf2f(raw[(tok0 + 3) * 64 + ch]);
        if (!isml) {
            u16* tdst = nullptr; u16* ndst = nullptr;
            if (cgp < 8) {
                const int chg = cgp * 64 + ch;
                tdst = (u16*)(ws + O_XT) + (isctx ? TCTX512 + ((size_t)(b * 512 + chg)) * 256 : ((size_t)(b * 512 + chg)) * 4096) + lpos + tok0;
            } else if (cgp < 12) {
                const int gn = (cgp - 8) * 64 + ch;
                tdst = (u16*)(ws + O_BT) + (isctx ? TCTX256 + ((size_t)(b * 256 + gn)) * 256 : ((size_t)(b * 256 + gn)) * 4096) + lpos + tok0;
                ndst = (u16*)(ws + O_BM) + (size_t)(rb + tok0) * 256 + gn;
            } else {
                const int gn = (cgp - 12) * 64 + ch;
                ndst = (u16*)(ws + O_CM) + (size_t)(rb + tok0) * 256 + gn;
            }
#pragma unroll
            for (int o8 = 0; o8 < 4; ++o8) {
                float ov[8];
#pragma unroll
                for (int j = 0; j < 8; ++j) {
                    const int tok = tok0 + o8 * 8 + j;
                    const float x4 = bf2f(raw[(tok + 4) * 64 + ch]);
                    const float cv = bias + w0 * x0 + w1 * x1 + w2 * x2 + w3 * x3 + w4 * x4;
                    ov[j] = siluf(cv);
                    x0 = x1; x1 = x2; x2 = x3; x3 = x4;
                }
                if (tdst) { uint4 o; o.x = pack2(ov[0], ov[1]); o.y = pack2(ov[2], ov[3]); o.z = pack2(ov[4], ov[5]); o.w = pack2(ov[6], ov[7]); *(uint4*)(tdst + o8 * 8) = o; }
                if (ndst) {
#pragma unroll
                    for (int j = 0; j < 8; ++j) ndst[(size_t)(o8 * 8 + j) * 256] = f2bf(ov[j]);
                }
            }
            __syncthreads();
        } else {
            const int mg = cgp - 16;
            u16* xcd = (u16*)(ws + O_XC) + (size_t)(rb + tok0) * 512 + mg * 64 + ch;
#pragma unroll 8
            for (int j = 0; j < 32; ++j) {
                const int tok = tok0 + j;
                const float x4 = bf2f(raw[(tok + 4) * 64 + ch]);
                const float cv = bias + w0 * x0 + w1 * x1 + w2 * x2 + w3 * x3 + w4 * x4;
                const float sv = siluf(cv);
                xcl[tok * 64 + ch] = sv;
                xcd[(size_t)j * 512] = f2bf(sv);
                x0 = x1; x1 = x2; x2 = x3; x3 = x4;
            }
            __syncthreads();
            const int n = ch >> 2, kk = ch & 3, ng = mg * 16 + n;
            const float* wq = P.in[I_WQK] + ((size_t)(0 * 128 + ng) * 4) * 4 + kk;
            const float* wk = P.in[I_WQK] + ((size_t)(1 * 128 + ng) * 4) * 4 + kk;
            const float q0 = wq[0], q1 = wq[4], q2 = wq[8], q3 = wq[12];
            const float k0 = wk[0], k1 = wk[4], k2 = wk[8], k3 = wk[12];
            const int chg = mg * 64 + ch;
            u16* qd = (u16*)(ws + O_Q) + (size_t)(rb + tok0) * 512 + chg;
            u16* kd = (u16*)(ws + O_K) + (size_t)(rb + tok0) * 512 + chg;
            u16* ktd = (u16*)(ws + O_KT) + (isctx ? TCTX512 + ((size_t)(b * 512 + chg)) * 256 : ((size_t)(b * 512 + chg)) * 4096) + lpos + tok0;
#pragma unroll
            for (int o8 = 0; o8 < 4; ++o8) {
                float kv[8];
#pragma unroll
                for (int j = 0; j < 8; ++j) {
                    const int tok = tok0 + o8 * 8 + j;
                    const float4 xv = *(const float4*)(xcl + tok * 64 + n * 4);
                    const float qv = xv.x * q0 + xv.y * q1 + xv.z * q2 + xv.w * q3;
                    kv[j] = (xv.x * k0 + xv.y * k1 + xv.z * k2 + xv.w * k3) * 0.08838834764831845f;
                    qd[(size_t)(o8 * 8 + j) * 512] = f2bf(qv);
                    kd[(size_t)(o8 * 8 + j) * 512] = f2bf(kv[j]);
                }
                uint4 o; o.x = pack2(kv[0], kv[1]); o.y = pack2(kv[2], kv[3]); o.z = pack2(kv[4], kv[5]); o.w = pack2(kv[6], kv[7]);
                *(uint4*)(ktd + o8 * 8) = o;
            }
            __syncthreads();
        }
    }
}

__device__ void phase4(const Params& P, char* lds_all) {
    unsigned char* ws = P.ws;
    const int vb = threadIdx.x >> 8, t0 = threadIdx.x & 255;
    char* lds = lds_all + vb * VLDS;
    char* T0 = lds; char* T1 = lds + 32768;
    float* sc = (float*)(lds + 65536);
    float* sbuf = sc;
    float* wA = sc + 256;
    float* wB = sc + 384;
    const int NSSD = 4 * NCH * 8, NML = 4 * NCH * 4;
    for (int u = blockIdx.x * 2 + vb; u < NSSD + NML; u += gridDim.x * 2) {
        int t = t0; asm volatile("" : "+v"(t));
        const int lane = t & 63, w = t >> 6, wm = w >> 1, wn = w & 1;
        if (u < NSSD) {
            const int h = u & 7, ct = u >> 3, b = ct / NCH, cc = ct % NCH;
            const bool isctx = cc < 2;
            const int L = isctx ? 256 : 4096;
            const int lpos = isctx ? cc * 128 : (cc - 2) * 128;
            const int rb = isctx ? MLAT + b * 256 + cc * 128 : b * 4096 + (cc - 2) * 128;
            const int dir = t >> 7, idx = t & 127;
            const int l = dir ? 127 - idx : idx;
            const float dtv = ((const float*)(ws + O_DT))[(size_t)(rb + l) * 16 + dir * 8 + h];
            const float an = -__expf(P.in[I_ALOG][dir * 8 + h]);
            const float cs = scan_pair<0>(dtv * an, sbuf, t);
            const float tot = sbuf[dir * 128 + 127];
            const float wv = __expf(tot - cs) * dtv;
            if (dir == 0) wA[l] = wv; else wB[l] = wv;
            if (idx == 127) ((float*)(ws + O_ACH))[((size_t)(b * NCH + cc) * 8 + h) * 2 + dir] = cs;
            __syncthreads();
            const int g = h >> 2;
            const u16* xt = (const u16*)(ws + O_XT) + (isctx ? TCTX512 + ((size_t)(b * 512 + h * 64)) * 256 : ((size_t)(b * 512 + h * 64)) * 4096) + lpos;
            const u16* bt = (const u16*)(ws + O_BT) + (isctx ? TCTX256 + ((size_t)(b * 256 + g * 128)) * 256 : ((size_t)(b * 256 + g * 128)) * 4096) + lpos;
            load_tile128_scaled(T0, 0, xt, L, 64, wA, t, 256);
            load_tile128_scaled(T0, 64, xt, L, 64, wB, t, 256);
            load_tile128(T1, 0, bt, L, 128, t, 256);
            __syncthreads();
            f32x4 acc[4][4]; zero_acc(acc);
            lds_mma<4, 4>(T0, T1, wm * 64, wn * 64, acc, lane);
            u16* st = (u16*)(ws + O_ST) + (((size_t)(b * NCH + cc) * 8 + h) * 2 + wm) * 8192 + ((lane >> 4) * 4) * 128 + wn * 64 + (lane & 15);
#pragma unroll
            for (int i = 0; i < 4; ++i)
#pragma unroll
                for (int j = 0; j < 4; ++j)
#pragma unroll
                    for (int r = 0; r < 4; ++r) st[(i * 16 + r) * 128 + j * 16] = f2bf(acc[i][j][r]);
            __syncthreads();
        } else {
            const int v = u - NSSD;
            const int h = v & 3, ct = v >> 2, b = ct / NCH, cc = ct % NCH;
            const bool isctx = cc < 2;
            const int L = isctx ? 256 : 4096;
            const int lpos = isctx ? cc * 128 : (cc - 2) * 128;
            const int rb = isctx ? MLAT + b * 256 + cc * 128 : b * 4096 + (cc - 2) * 128;
            const int dir = t >> 7, idx = t & 127;
            const int s = dir ? 127 - idx : idx;
            const float fv = ((const float*)(ws + O_GF))[(size_t)(rb + s) * 8 + dir * 4 + h];
            const float iv = ((const float*)(ws + O_GI))[(size_t)(rb + s) * 8 + dir * 4 + h];
            const float bc = scan_pair<0>(fv, sbuf, t);
            const float tot = sbuf[dir * 128 + 127];
            const float av = tot - bc + iv;
            __syncthreads();
            (void)scan_pair<1>(av, sbuf, t);
            const float mloc = sbuf[dir * 128 + 127];
            const float wv = __expf(av - mloc);
            if (dir == 0) wA[s] = wv; else wB[s] = wv;
            if (idx == 0) {
                float* mls = (float*)(ws + O_MLS) + (((size_t)(b * NCH + cc) * 4 + h) * 2 + dir) * 2;
                mls[0] = mloc; mls[1] = tot;
            }
            __syncthreads();
            const u16* vt = (const u16*)(ws + O_VT) + (isctx ? TCTX512 + ((size_t)(b * 512 + h * 128)) * 256 : ((size_t)(b * 512 + h * 128)) * 4096) + lpos;
            const u16* kt = (const u16*)(ws + O_KT) + (isctx ? TCTX512 + ((size_t)(b * 512 + h * 128)) * 256 : ((size_t)(b * 512 + h * 128)) * 4096) + lpos;
            load_tile128(T1, 0, kt, L, 128, t, 256);
#pragma unroll 1
            for (int d2 = 0; d2 < 2; ++d2) {
                load_tile128_scaled(T0, 0, vt, L, 128, d2 ? wB : wA, t, 256);
                __syncthreads();
                f32x4 acc[4][4]; zero_acc(acc);
                lds_mma<4, 4>(T0, T1, wm * 64, wn * 64, acc, lane);
                u16* cst = (u16*)(ws + (d2 ? O_MLC1 : O_MLC0)) + ((size_t)(b * NCH + cc) * 4 + h) * 16384 + (wm * 64 + (lane >> 4) * 4) * 128 + wn * 64 + (lane & 15);
#pragma unroll
                for (int i = 0; i < 4; ++i)
#pragma unroll
                    for (int j = 0; j < 4; ++j)
#pragma unroll
                        for (int r = 0; r < 4; ++r) cst[(i * 16 + r) * 128 + j * 16] = f2bf(acc[i][j][r]);
                if (d2 == 0) {
                    const float* wgt = dir ? wB : wA;
                    float nacc = 0.f;
#pragma unroll 4
                    for (int c = 0; c < 16; ++c) {
                        const uint4 kv = *(const uint4*)(T1 + swz256(idx, c));
                        const float* ww = wgt + c * 8;
                        nacc += bflo(kv.x) * ww[0] + bfhi(kv.x) * ww[1] + bflo(kv.y) * ww[2] + bfhi(kv.y) * ww[3]
                              + bflo(kv.z) * ww[4] + bfhi(kv.z) * ww[5] + bflo(kv.w) * ww[6] + bfhi(kv.w) * ww[7];
                    }
                    ((float*)(ws + O_MLN))[(((size_t)(b * NCH + cc) * 4 + h) * 2 + dir) * 128 + idx] = nacc;
                }
                __syncthreads();
            }
        }
    }
}

__device__ __forceinline__ int scan_cc(int dir, int step) { return dir == 0 ? step : (step < 2 ? 1 - step : 35 - step); }
__device__ void phase5(const Params& P) {
    unsigned char* ws = P.ws;
    const int vb = threadIdx.x >> 8, t = threadIdx.x & 255;
    for (int u = blockIdx.x * 2 + vb; u < 256 + 256 + 32; u += gridDim.x * 2) {
        if (u < 256) {
            const int chain = u >> 2, part = u & 3;
            const int b = chain >> 4, h = (chain >> 1) & 7, dir = chain & 1;
            const int off = part * 2048 + t * 8;
            float S[8];
#pragma unroll
            for (int j = 0; j < 8; ++j) S[j] = 0.f;
#pragma unroll 2
            for (int step = 0; step < NCH; ++step) {
                const int cc = scan_cc(dir, step);
                u16* p = (u16*)(ws + O_ST) + (((size_t)(b * NCH + cc) * 8 + h) * 2 + dir) * 8192 + off;
                const uint4 lv = *(const uint4*)p;
                const float dec = __expf(((const float*)(ws + O_ACH))[((size_t)(b * NCH + cc) * 8 + h) * 2 + dir]);
                uint4 o; o.x = pack2(S[0], S[1]); o.y = pack2(S[2], S[3]); o.z = pack2(S[4], S[5]); o.w = pack2(S[6], S[7]);
                *(uint4*)p = o;
                S[0] = dec * S[0] + bflo(lv.x); S[1] = dec * S[1] + bfhi(lv.x); S[2] = dec * S[2] + bflo(lv.y); S[3] = dec * S[3] + bfhi(lv.y);
                S[4] = dec * S[4] + bflo(lv.z); S[5] = dec * S[5] + bfhi(lv.z); S[6] = dec * S[6] + bflo(lv.w); S[7] = dec * S[7] + bfhi(lv.w);
            }
        } else if (u < 512) {
            const int v = u - 256;
            const int chain = v >> 3, part = v & 7;
            const int b = chain >> 3, h = (chain >> 1) & 3, dir = chain & 1;
            const int off = part * 2048 + t * 8;
            float S[8];
#pragma unroll
            for (int j = 0; j < 8; ++j) S[j] = 0.f;
            float m = -1e30f;
#pragma unroll 2
            for (int step = 0; step < NCH; ++step) {
                const int cc = scan_cc(dir, step);
                u16* p = (u16*)(ws + (dir ? O_MLC1 : O_MLC0)) + ((size_t)(b * NCH + cc) * 4 + h) * 16384 + off;
                const uint4 lv = *(const uint4*)p;
                const float* mls = (const float*)(ws + O_MLS) + (((size_t)(b * NCH + cc) * 4 + h) * 2 + dir) * 2;
                const float ml = mls[0], bl = mls[1];
                const float mn = fmaxf(bl + m, ml);
                const float sp = __expf(bl + m - mn), sl = __expf(ml - mn);
                if (part == 0 && t == 0) ((float*)(ws + O_MLP))[((size_t)(b * NCH + cc) * 4 + h) * 2 + dir] = m;
                uint4 o; o.x = pack2(S[0], S[1]); o.y = pack2(S[2], S[3]); o.z = pack2(S[4], S[5]); o.w = pack2(S[6], S[7]);
                *(uint4*)p = o;
                S[0] = sp * S[0] + sl * bflo(lv.x); S[1] = sp * S[1] + sl * bfhi(lv.x); S[2] = sp * S[2] + sl * bflo(lv.y); S[3] = sp * S[3] + sl * bfhi(lv.y);
                S[4] = sp * S[4] + sl * bflo(lv.z); S[5] = sp * S[5] + sl * bfhi(lv.z); S[6] = sp * S[6] + sl * bflo(lv.w); S[7] = sp * S[7] + sl * bfhi(lv.w);
                m = mn;
            }
        } else {
            const int chain = u - 512;
            const int b = chain >> 3, h = (chain >> 1) & 3, dir = chain & 1;
            if (t < 128) {
                float nS = 0.f, m = -1e30f;
                for (int step = 0; step < NCH; ++step) {
                    const int cc = scan_cc(dir, step);
                    float* p = (float*)(ws + O_MLN) + (((size_t)(b * NCH + cc) * 4 + h) * 2 + dir) * 128 + t;
                    const float lv = *p;
                    const float* mls = (const float*)(ws + O_MLS) + (((size_t)(b * NCH + cc) * 4 + h) * 2 + dir) * 2;
                    const float ml = mls[0], bl = mls[1];
                    const float mn = fmaxf(bl + m, ml);
                    const float sp = __expf(bl + m - mn), sl = __expf(ml - mn);
                    *p = nS;
                    nS = sp * nS + sl * lv;
                    m = mn;
                }
            }
        }
    }
}

__device__ void phase6(const Params& P, char* lds) {
    unsigned char* ws = P.ws;
    char* T0 = lds; char* T1 = lds + 32768; char* T2 = lds + 65536; char* T3 = lds + 98304;
    float* sc = (float*)(lds + 131072);
    float* sbuf = sc;
    float* a0 = sc + 256;
    float* a1 = sc + 384;
    float* a2 = sc + 512;
    float* a3 = sc + 640;
    float* a4 = sc + 768;
    float* a5 = sc + 896;
    float* rsA = sc + 1024;
    float* qn = sc + 1536;
    float* fac = sc + 1792;
    float* wfac = sc + 2048;
    const int NSSD = 4 * 32 * 8, NML = 4 * 32 * 4;
    for (int u = blockIdx.x; u < NSSD + NML; u += gridDim.x) {
        int t = threadIdx.x; asm volatile("" : "+v"(t));
        const int lane = t & 63, w = t >> 6, wm = w >> 1, wn = w & 1;
        if (u < NSSD) {
            const int h = u & 7, ct = u >> 3, b = ct >> 5, c = ct & 31, cc = c + 2;
            const int rb = b * 4096 + c * 128, lpos = c * 128, g = h >> 2;
            {
                const int dir = (t >> 7) & 1, idx = t & 127;
                const int l = dir ? 127 - idx : idx;
                float dtv = 0.f, an = 0.f;
                if (t < 256) { dtv = ((const float*)(ws + O_DT))[(size_t)(rb + l) * 16 + dir * 8 + h]; an = -__expf(P.in[I_ALOG][dir * 8 + h]); }
                const float cs = scan_pair<0>(dtv * an, sbuf, t);
                if (t < 256) { if (dir == 0) { a0[l] = cs; a2[l] = dtv; } else { a1[l] = cs; a3[l] = dtv; } }
            }
            load_tile128(T0, 0, (const u16*)(ws + O_CM) + (size_t)rb * 256 + g * 128, 256, 128, t, 512);
            load_tile128(T1, 0, (const u16*)(ws + O_BM) + (size_t)rb * 256 + g * 128, 256, 128, t, 512);
            {
                const u16* sf = (const u16*)(ws + O_ST) + (((size_t)(b * NCH + cc) * 8 + h) * 2 + 0) * 8192;
                load_tile128(T2, 0, sf, 128, 128, t, 512);
            }
            load_tile128(T3, 0, (const u16*)(ws + O_XT) + ((size_t)(b * 512 + h * 64)) * 4096 + lpos, 4096, 64, t, 512);
            __syncthreads();
            f32x4 Y[2][2];
            {
                f32x4 aF[2][2], aB[2][2]; zero_acc(aF); zero_acc(aB);
                lds_mma<2, 2>(T0, T2, wm * 32, wn * 32, aF, lane);
                lds_mma<2, 2>(T0, T2, wm * 32, 64 + wn * 32, aB, lane);
#pragma unroll
                for (int i = 0; i < 2; ++i)
#pragma unroll
                    for (int r = 0; r < 4; ++r) {
                        const int l = wm * 32 + i * 16 + (lane >> 4) * 4 + r;
                        const float e0 = __expf(a0[l]), e1 = __expf(a1[l]);
#pragma unroll
                        for (int j = 0; j < 2; ++j) Y[i][j][r] = e0 * aF[i][j][r] + e1 * aB[i][j][r];
                    }
            }
            f32x4 G[2][4]; zero_acc(G);
            lds_mma<2, 4>(T0, T1, wm * 32, wn * 64, G, lane);
            __syncthreads();
            {
                float sv0[4], sv1[4], sv2[4], sv3[4];
                int dbase = wn * 64 + (lane & 15) - wm * 32 - (lane >> 4) * 4; asm volatile("" : "+v"(dbase));
#pragma unroll
                for (int j = 0; j < 4; ++j) { const int s = wn * 64 + j * 16 + (lane & 15); sv0[j] = a0[s]; sv1[j] = a1[s]; sv2[j] = a2[s]; sv3[j] = a3[s]; }
#pragma unroll
                for (int i = 0; i < 2; ++i)
#pragma unroll
                    for (int r = 0; r < 4; ++r) {
                        const int l = wm * 32 + i * 16 + (lane >> 4) * 4 + r;
                        const float c0l = a0[l], r1l = a1[l];
#pragma unroll
                        for (int j = 0; j < 4; ++j) {
                            const int s = wn * 64 + j * 16 + (lane & 15);
                            const int diff = dbase + (j * 16 - i * 16 - r);
                            const float e0 = (diff <= 0) ? (c0l - sv0[j]) : -INFINITY;
                            const float e1 = (diff >= 0) ? (r1l - sv1[j]) : -INFINITY;
                            const float f = __expf(e0) * sv2[j] + __expf(e1) * sv3[j];
                            *(u16*)(T1 + swz256(l, s >> 3) + (s & 7) * 2) = f2bf(G[i][j][r] * f);
                        }
                    }
            }
            __syncthreads();
            lds_mma<2, 2>(T1, T3, wm * 32, wn * 32, Y, lane);
            const float Dh = P.in[I_SSDD][h];
            u16* zo = (u16*)(ws + O_ZO);
#pragma unroll
            for (int i = 0; i < 2; ++i)
#pragma unroll
                for (int r = 0; r < 4; ++r) {
                    const int l = wm * 32 + i * 16 + (lane >> 4) * 4 + r;
                    float ssq = 0.f;
#pragma unroll
                    for (int j = 0; j < 2; ++j) {
                        const int p = wn * 32 + j * 16 + (lane & 15);
                        const float xv = bf2f(*(const u16*)(T3 + swz256(p, l >> 3) + (l & 7) * 2));
                        u16* zp = zo + (size_t)(rb + l) * 1024 + h * 64 + p;
                        const float z = bf2f(*zp);
                        const float y = (Y[i][j][r] + Dh * xv) * siluf(z);
                        *zp = f2bf(y);
                        ssq += y * y;
                    }
                    ssq += __shfl_xor(ssq, 1); ssq += __shfl_xor(ssq, 2); ssq += __shfl_xor(ssq, 4); ssq += __shfl_xor(ssq, 8);
                    if ((lane & 15) == 0) ((float*)(ws + O_SSQ))[(size_t)(rb + l) * 16 + h * 2 + wn] = ssq;
                }
            __syncthreads();
        } else {
            const int v = u - NSSD;
            const int h = v & 3, ct = v >> 2, b = ct >> 5, c = ct & 31, cc = c + 2;
            const int rb = b * 4096 + c * 128, lpos = c * 128;
            const float mp0 = ((const float*)(ws + O_MLP))[((size_t)(b * NCH + cc) * 4 + h) * 2 + 0];
            const float mp1 = ((const float*)(ws + O_MLP))[((size_t)(b * NCH + cc) * 4 + h) * 2 + 1];
            {
                const int dir = (t >> 7) & 1, idx = t & 127;
                const int s = dir ? 127 - idx : idx;
                float fv = 0.f, iv = 0.f;
                if (t < 256) { fv = ((const float*)(ws + O_GF))[(size_t)(rb + s) * 8 + dir * 4 + h]; iv = ((const float*)(ws + O_GI))[(size_t)(rb + s) * 8 + dir * 4 + h]; }
                const float bc = scan_pair<0>(fv, sbuf, t);
                const float uv = iv - bc;
                __syncthreads();
                const float mx = scan_pair<1>(uv, sbuf, t);
                const float mm = fmaxf(dir ? mp1 : mp0, mx);
                if (t < 256) { if (dir == 0) { a0[s] = bc; a2[s] = uv; a4[s] = mm; } else { a1[s] = bc; a3[s] = uv; a5[s] = mm; } }
            }
            load_tile128(T0, 0, (const u16*)(ws + O_Q) + (size_t)rb * 512 + h * 128, 512, 128, t, 512);
            load_tile128(T1, 0, (const u16*)(ws + O_K) + (size_t)rb * 512 + h * 128, 512, 128, t, 512);
            load_tile128(T2, 0, (const u16*)(ws + O_MLC0) + ((size_t)(b * NCH + cc) * 4 + h) * 16384, 128, 128, t, 512);
            load_tile128(T3, 0, (const u16*)(ws + O_MLC1) + ((size_t)(b * NCH + cc) * 4 + h) * 16384, 128, 128, t, 512);
            __syncthreads();
            f32x4 S[2][4]; zero_acc(S);
            lds_mma<2, 4>(T0, T1, wm * 32, wn * 64, S, lane);
            if (t < 256) {
                const int dir = t >> 7, idx = t & 127;
                const float* np = (const float*)(ws + O_MLN) + (((size_t)(b * NCH + cc) * 4 + h) * 2 + dir) * 128;
                float acc = 0.f;
#pragma unroll 4
                for (int cch = 0; cch < 16; ++cch) {
                    const uint4 qv = *(const uint4*)(T0 + swz256(idx, cch));
                    const float4 n0 = *(const float4*)(np + cch * 8), n1 = *(const float4*)(np + cch * 8 + 4);
                    acc += bflo(qv.x) * n0.x + bfhi(qv.x) * n0.y + bflo(qv.y) * n0.z + bfhi(qv.y) * n0.w
                         + bflo(qv.z) * n1.x + bfhi(qv.z) * n1.y + bflo(qv.w) * n1.z + bfhi(qv.w) * n1.w;
                }
                qn[dir * 128 + idx] = acc;
            }
            float su0[4], su1[4];
            int dbase = wn * 64 + (lane & 15) - wm * 32 - (lane >> 4) * 4; asm volatile("" : "+v"(dbase));
#pragma unroll
            for (int j = 0; j < 4; ++j) { const int s = wn * 64 + j * 16 + (lane & 15); su0[j] = a2[s]; su1[j] = a3[s]; }
#pragma unroll
            for (int i = 0; i < 2; ++i)
#pragma unroll
                for (int r = 0; r < 4; ++r) {
                    const int tt = wm * 32 + i * 16 + (lane >> 4) * 4 + r;
                    const float m0 = a4[tt], m1 = a5[tt];
                    float r0 = 0.f, r1 = 0.f;
#pragma unroll
                    for (int j = 0; j < 4; ++j) {
                        const float sv = S[i][j][r];
                        const int diff = dbase + (j * 16 - i * 16 - r);
                        r0 += sv * __expf((diff <= 0) ? (su0[j] - m0) : -INFINITY);
                        r1 += sv * __expf((diff >= 0) ? (su1[j] - m1) : -INFINITY);
                    }
                    r0 += __shfl_xor(r0, 1); r0 += __shfl_xor(r0, 2); r0 += __shfl_xor(r0, 4); r0 += __shfl_xor(r0, 8);
                    r1 += __shfl_xor(r1, 1); r1 += __shfl_xor(r1, 2); r1 += __shfl_xor(r1, 4); r1 += __shfl_xor(r1, 8);
                    if ((lane & 15) == 0) { rsA[(0 * 2 + wn) * 128 + tt] = r0; rsA[(1 * 2 + wn) * 128 + tt] = r1; }
                }
            __syncthreads();
            if (t < 256) {
                const int dir = t >> 7, tt = t & 127;
                const float rs = rsA[(dir * 2 + 0) * 128 + tt] + rsA[(dir * 2 + 1) * 128 + tt];
                const float mm = dir ? a5[tt] : a4[tt];
                const float wi = __expf((dir ? mp1 : mp0) - mm);
                const float den = rs + wi * qn[dir * 128 + tt];
                const float mout = (dir ? a1[tt] : a0[tt]) + mm;
                const float dn = fmaxf(fabsf(den), __expf(-mout));
                fac[dir * 128 + tt] = 1.f / dn;
                wfac[dir * 128 + tt] = wi / dn;
            }
            __syncthreads();
            f32x4 H[2][4];
            {
                f32x4 A0[2][4]; zero_acc(A0);
                lds_mma<2, 4>(T0, T2, wm * 32, wn * 64, A0, lane);
#pragma unroll
                for (int i = 0; i < 2; ++i)
#pragma unroll
                    for (int r = 0; r < 4; ++r) {
                        const float f = wfac[wm * 32 + i * 16 + (lane >> 4) * 4 + r];
#pragma unroll
                        for (int j = 0; j < 4; ++j) H[i][j][r] = f * A0[i][j][r];
                    }
            }
            {
                f32x4 A1[2][4]; zero_acc(A1);
                lds_mma<2, 4>(T0, T3, wm * 32, wn * 64, A1, lane);
#pragma unroll
                for (int i = 0; i < 2; ++i)
#pragma unroll
                    for (int r = 0; r < 4; ++r) {
                        const float f = wfac[128 + wm * 32 + i * 16 + (lane >> 4) * 4 + r];
#pragma unroll
                        for (int j = 0; j < 4; ++j) H[i][j][r] += f * A1[i][j][r];
                    }
            }
            __syncthreads();
            asm volatile("" : "+v"(dbase));
#pragma unroll
            for (int i = 0; i < 2; ++i)
#pragma unroll
                for (int r = 0; r < 4; ++r) {
                    const int tt = wm * 32 + i * 16 + (lane >> 4) * 4 + r;
                    const float m0 = a4[tt], m1 = a5[tt], f0 = fac[tt], f1 = fac[128 + tt];
#pragma unroll
                    for (int j = 0; j < 4; ++j) {
                        const int s = wn * 64 + j * 16 + (lane & 15);
                        const int diff = dbase + (j * 16 - i * 16 - r);
                        const float f = __expf((diff <= 0) ? (su0[j] - m0) : -INFINITY) * f0 + __expf((diff >= 0) ? (su1[j] - m1) : -INFINITY) * f1;
                        *(u16*)(T1 + swz256(tt, s >> 3) + (s & 7) * 2) = f2bf(S[i][j][r] * f);
                    }
                }
            load_tile128(T2, 0, (const u16*)(ws + O_VT) + ((size_t)(b * 512 + h * 128)) * 4096 + lpos, 4096, 128, t, 512);
            __syncthreads();
            lds_mma<2, 4>(T1, T2, wm * 32, wn * 64, H, lane);
            const u16* zo = (const u16*)(ws + O_ZO);
#pragma unroll
            for (int i = 0; i < 2; ++i)
#pragma unroll
                for (int r = 0; r < 4; ++r) {
                    const int tt = wm * 32 + i * 16 + (lane >> 4) * 4 + r;
                    const int lp = lpos + tt;
                    const size_t rown = (size_t)b * 4096 + ((lp & 63) << 6) + (lp >> 6);
                    float ssq = 0.f;
#pragma unroll
                    for (int j = 0; j < 4; ++j) {
                        const int d = wn * 64 + j * 16 + (lane & 15);
                        const float o = bf2f(zo[rown * 1024 + 512 + h * 128 + d]);
                        const float hv = H[i][j][r] * sigmf(o);
                        H[i][j][r] = hv;
                        ssq += hv * hv;
                    }
                    ssq += __shfl_xor(ssq, 1); ssq += __shfl_xor(ssq, 2); ssq += __shfl_xor(ssq, 4); ssq += __shfl_xor(ssq, 8);
                    if ((lane & 15) == 0) rsA[wn * 128 + tt] = ssq;
                }
            __syncthreads();
            u16* zow = (u16*)(ws + O_ZO);
            const u16* xc = (const u16*)(ws + O_XC);
#pragma unroll
            for (int i = 0; i < 2; ++i)
#pragma unroll
                for (int r = 0; r < 4; ++r) {
                    const int tt = wm * 32 + i * 16 + (lane >> 4) * 4 + r;
                    const int lp = lpos + tt;
                    const size_t rown = (size_t)b * 4096 + ((lp & 63) << 6) + (lp >> 6);
                    const float rn = rsqrtf((rsA[tt] + rsA[128 + tt]) * (1.f / 128.f) + 1e-6f);
#pragma unroll
                    for (int j = 0; j < 4; ++j) {
                        const int d = wn * 64 + j * 16 + (lane & 15), chg = h * 128 + d;
                        const float y = H[i][j][r] * rn * P.in[I_MNW][chg] + P.in[I_MSKIP][chg] * bf2f(xc[(size_t)(rb + tt) * 512 + chg]);
                        zow[rown * 1024 + 512 + chg] = f2bf(y);
                    }
                }
            __syncthreads();
        }
    }
}

struct OutProj {
    static constexpr int K = 1024; static constexpr bool PERM = false; static constexpr int MIDT = 8;
    struct Unit { int pm, pn, slot; };
    const Params* P; const float* rs; int G, c;
    __device__ __forceinline__ bool next(int i, Unit& u) const {
        const int L = i * G + c;
        if (L >= 256) return false;
        g8::dense_unit(L, 64, 4, u.pm, u.pn); u.slot = i & 3;
        return true;
    }
    __device__ __forceinline__ const char* baseA(const Unit&) const { return (const char*)(P->ws + O_ZO); }
    __device__ __forceinline__ const char* baseB(const Unit&) const { return (const char*)(P->ws + O_WOUT); }
    __device__ __forceinline__ void offs(const Unit& u, const int (&R)[2], const int (&C)[2], unsigned (&oa)[2][2], unsigned (&ob)[2][2]) const {
#pragma unroll
        for (int h = 0; h < 2; ++h)
#pragma unroll
            for (int i = 0; i < 2; ++i) {
                oa[h][i] = (unsigned)((u.pm * 256 + h * 128 + R[i]) * 1024 + C[i]) * 2u;
                ob[h][i] = (unsigned)((u.pn * 256 + h * 128 + R[i]) * 1024 + C[i]) * 2u;
            }
    }
    __device__ __forceinline__ void mid(g8::Acc& acc, const Unit& u, int wr, int fr) const {
#pragma unroll
        for (int ai = 0; ai < 2; ++ai)
#pragma unroll
            for (int m = 0; m < 4; ++m) {
                const float s = rs[u.slot * 256 + ai * 128 + wr * 64 + m * 16 + fr];
#pragma unroll
                for (int bj = 0; bj < 2; ++bj)
#pragma unroll
                    for (int n = 0; n < 2; ++n) acc[ai][bj][m][n] *= s;
            }
    }
    __device__ __forceinline__ void epi(g8::Acc& acc, const Unit& u, int wr, int wc, int fr, int fq) const {
        const int row0 = u.pm * 256 + wr * 64 + fr, col0 = u.pn * 256 + wc * 32 + 4 * fq;
        const int b = u.pm >> 4;
        const float* mod = (const float*)(P->ws + O_MOD) + b * 6144 + 2048;
        f32x4 g1[2][2];
#pragma unroll
        for (int bj = 0; bj < 2; ++bj)
#pragma unroll
            for (int n = 0; n < 2; ++n) g1[bj][n] = *(const f32x4*)(mod + col0 + bj * 128 + n * 16);
#pragma unroll
        for (int ai = 0; ai < 2; ++ai)
#pragma unroll
            for (int m = 0; m < 4; ++m) {
                const size_t ro = (size_t)(row0 + ai * 128 + m * 16) * 1024 + col0;
#pragma unroll
                for (int bj = 0; bj < 2; ++bj)
#pragma unroll
                    for (int n = 0; n < 2; ++n) {
                        const f32x4 xv = *(const f32x4*)(P->in[I_X] + ro + bj * 128 + n * 16);
                        *(f32x4*)(P->out + ro + bj * 128 + n * 16) = xv + g1[bj][n] * acc[ai][bj][m][n];
                    }
            }
    }
};
__device__ void phase7(const Params& P, char* lds) {
    float* rs = (float*)(lds + g8::STAGE_BYTES);
    OutProj S; S.P = &P; S.rs = rs; S.G = gridDim.x; S.c = blockIdx.x;
    for (int i = 0; i < 4; ++i) {
        OutProj::Unit u;
        if (!S.next(i, u)) break;
        if (threadIdx.x < 256) {
            const float* sq = (const float*)(P.ws + O_SSQ) + (size_t)(u.pm * 256 + threadIdx.x) * 16;
            float s = 0.f;
#pragma unroll
            for (int q = 0; q < 16; ++q) s += sq[q];
            rs[i * 256 + threadIdx.x] = rsqrtf(s * (1.f / 512.f) + 1e-6f);
        }
    }
    __syncthreads();
    g8::gemm_phase<OutProj>((LAS unsigned char*)lds, S);
}

__device__ void phase8(const Params& P, char* lds_all) {
    unsigned char* ws = P.ws;
    const int vb = threadIdx.x >> 8, t = threadIdx.x & 255, lane = t & 63, w = t >> 6;
    char* lds = lds_all + vb * VLDS;
    float* tt = (float*)lds;
    const float* mod = (const float*)(ws + O_MOD);
    const int NR = 1024, NTR = 6144;
    for (int u = blockIdx.x * 2 + vb; u < NR + NTR; u += gridDim.x * 2) {
        if (u < NR) {
            const int tk0 = u * 16;
            const int b = tk0 >> 12;
#pragma unroll 1
            for (int q = 0; q < 4; ++q) {
                const int tl = w * 4 + q;
                const float* xr = P.out + (size_t)(tk0 + tl) * 1024;
                float4 v[4]; float ss = 0.f;
#pragma unroll
                for (int j = 0; j < 4; ++j) { v[j] = ((const float4*)xr)[lane + 64 * j]; ss += v[j].x * v[j].x + v[j].y * v[j].y + v[j].z * v[j].z + v[j].w * v[j].w; }
                ss = wave_sum(ss);
                const float rstd = rsqrtf(ss * (1.f / 1024.f) + 1e-6f);
#pragma unroll
                for (int j = 0; j < 4; ++j) {
                    const int k = (lane + 64 * j) * 4;
                    const float4 nwv = *(const float4*)(P.in[I_N2W] + k);
                    const float4 sh = *(const float4*)(mod + b * 6144 + 3072 + k);
                    const float4 sc = *(const float4*)(mod + b * 6144 + 4096 + k);
                    float4 hh;
                    hh.x = v[j].x * rstd * nwv.x * (1.f + sc.x) + sh.x;
                    hh.y = v[j].y * rstd * nwv.y * (1.f + sc.y) + sh.y;
                    hh.z = v[j].z * rstd * nwv.z * (1.f + sc.z) + sh.z;
                    hh.w = v[j].w * rstd * nwv.w * (1.f + sc.w) + sh.w;
                    uint2 o; o.x = pack2(hh.x, hh.y); o.y = pack2(hh.z, hh.w);
                    *(uint2*)((u16*)(ws + O_T) + (size_t)(tk0 + tl) * 1024 + k) = o;
                    *(float4*)(tt + tl * 1028 + k) = hh;
                }
            }
            __syncthreads();
            f32x4 c0 = {0, 0, 0, 0}, c1 = {0, 0, 0, 0}, c2 = {0, 0, 0, 0};
            const int ti = lane & 15, kq = lane >> 4;
            const float* rew = P.in[I_REW];
            const float* rgw = P.in[I_RGW];
#pragma unroll 4
            for (int ks = 0; ks < 64; ++ks) {
                const int k = w * 256 + ks * 4 + kq;
                const float a = tt[ti * 1028 + k];
                const float b0 = rew[(size_t)k * 32 + ti];
                const float b1 = rew[(size_t)k * 32 + 16 + ti];
                const float b2 = ti < 4 ? rgw[(size_t)k * 4 + ti] : 0.f;
                c0 = __builtin_amdgcn_mfma_f32_16x16x4f32(a, b0, c0, 0, 0, 0);
                c1 = __builtin_amdgcn_mfma_f32_16x16x4f32(a, b1, c1, 0, 0, 0);
                c2 = __builtin_amdgcn_mfma_f32_16x16x4f32(a, b2, c2, 0, 0, 0);
            }
            __syncthreads();
            float* red = (float*)lds;
#pragma unroll
            for (int r = 0; r < 4; ++r) {
                const int row = kq * 4 + r;
                red[(w * 16 + row) * 48 + ti] = c0[r];
                red[(w * 16 + row) * 48 + 16 + ti] = c1[r];
                red[(w * 16 + row) * 48 + 32 + ti] = c2[r];
            }
            __syncthreads();
            if (t < 16) {
                float lg[36];
#pragma unroll
                for (int j = 0; j < 36; ++j) lg[j] = red[(0 * 16 + t) * 48 + j] + red[(1 * 16 + t) * 48 + j] + red[(2 * 16 + t) * 48 + j] + red[(3 * 16 + t) * 48 + j];
                float gl[4];
#pragma unroll
                for (int j = 0; j < 4; ++j) gl[j] = lg[32 + j] + P.in[I_RGB][j];
                int gs = 0; float gm = gl[0];
#pragma unroll
                for (int j = 1; j < 4; ++j) if (gl[j] > gm) { gm = gl[j]; gs = j; }
                float gsum = 0.f;
#pragma unroll
                for (int j = 0; j < 4; ++j) gsum += __expf(gl[j] - gm);
                const float pg = 1.f / gsum;
                float el[8];
#pragma unroll
                for (int j = 0; j < 8; ++j) {
                    float vsel = lg[j];
#pragma unroll
                    for (int g2 = 1; g2 < 4; ++g2) vsel = (gs == g2) ? lg[g2 * 8 + j] : vsel;
                    el[j] = vsel + P.in[I_REB][gs * 8 + j];
                }
                int i1 = 0; float m1 = el[0];
#pragma unroll
                for (int j = 1; j < 8; ++j) if (el[j] > m1) { m1 = el[j]; i1 = j; }
                int i2 = -1; float m2 = -INFINITY;
#pragma unroll
                for (int j = 0; j < 8; ++j) if (j != i1 && el[j] > m2) { m2 = el[j]; i2 = j; }
                const float e2 = __expf(m2 - m1);
                const float w1 = pg / (1.f + e2), w2 = pg * e2 / (1.f + e2);
                const int tok = tk0 + t;
                int* cnt = (int*)(ws + O_CNT);
                int* list = (int*)(ws + O_LIST);
                float* wts = (float*)(ws + O_WTS);
                const int ea = gs * 8 + i1, eb = gs * 8 + i2;
                const int pa = atomicAdd(&cnt[ea], 1);
                list[ea * 16384 + pa] = tok * 2;
                wts[tok * 2] = w1;
                const int pb = atomicAdd(&cnt[eb], 1);
                list[eb * 16384 + pb] = tok * 2 + 1;
                wts[tok * 2 + 1] = w2;
            }
            __syncthreads();
        } else {
            const int v = u - NR;
            float* tile = (float*)lds;
            if (v < 4096) {
                const bool up = v >= 2048;
                const int vv = v & 2047, e = vv >> 6, rem = vv & 63, nt = rem >> 4, kt = rem & 15;
                const float* src = P.in[up ? I_WU : I_WG] + (size_t)e * 1024 * 256;
                transpose_tile(tile, src, 256, kt * 64, nt * 64, 64, (u16*)(ws + O_WGU) + (size_t)e * 512 * 1024, (up ? 256 : 0) + nt * 64, 1024, nullptr, 0, t);
            } else {
                const int vv = v - 4096, e = vv >> 6, rem = vv & 63, nt = rem >> 2, kt = rem & 3;
                const float* src = P.in[I_WD] + (size_t)e * 256 * 1024;
                transpose_tile(tile, src, 1024, kt * 64, nt * 64, 64, (u16*)(ws + O_WD) + (size_t)e * 1024 * 256, nt * 64, 256, nullptr, 0, t);
            }
        }
    }
}

__device__ __forceinline__ void moe_prefix(const unsigned char* ws, int* pre_t, int* pre_c) {
    if (threadIdx.x == 0) {
        const int* cnt = (const int*)(ws + O_CNT);
        int at = 0, ac = 0;
        for (int e = 0; e < 32; ++e) { pre_t[e] = at; pre_c[e] = ac; const int c = cnt[e]; at += (c + 255) >> 8; ac += c; }
        pre_t[32] = at; pre_c[32] = ac;
    }
    __syncthreads();
}
struct MoeUnit { int e, mt, pn, cnt, base; };
template <int NPN>
__device__ __forceinline__ bool moe_next(const int* pre_t, const int* pre_c, int L, MoeUnit& u) {
    if (L >= pre_t[32] * NPN) return false;
    const int mtg = L / NPN; u.pn = L % NPN;
    int e = 0;
    while (pre_t[e + 1] <= mtg) ++e;
    u.e = e; u.mt = mtg - pre_t[e]; u.cnt = pre_c[e + 1] - pre_c[e]; u.base = pre_c[e];
    return true;
}
struct GateUp {
    static constexpr int K = 1024; static constexpr bool PERM = true; static constexpr int MIDT = 0;
    typedef MoeUnit Unit;
    const unsigned char* ws; const int* pre_t; const int* pre_c; int G, c;
    __device__ __forceinline__ bool next(int i, Unit& u) const { return moe_next<2>(pre_t, pre_c, i * G + c, u); }
    __device__ __forceinline__ const char* baseA(const Unit&) const { return (const char*)(ws + O_T); }
    __device__ __forceinline__ const char* baseB(const Unit& u) const { return (const char*)(ws + O_WGU) + (size_t)u.e * 512 * 1024 * 2; }
    __device__ __forceinline__ void offs(const Unit& u, const int (&R)[2], const int (&C)[2], unsigned (&oa)[2][2], unsigned (&ob)[2][2]) const {
        const int* list = (const int*)(ws + O_LIST) + u.e * 16384;
#pragma unroll
        for (int h = 0; h < 2; ++h)
#pragma unroll
            for (int i = 0; i < 2; ++i) {
                const int idx = u.mt * 256 + h * 128 + R[i];
                const int tok = idx < u.cnt ? (list[idx] >> 1) : 0;
                oa[h][i] = (unsigned)(tok * 1024 + C[i]) * 2u;
                const int Rb = (R[i] & ~31) + g8::perm32(R[i] & 31);
                ob[h][i] = (unsigned)((h * 256 + u.pn * 128 + Rb) * 1024 + C[i]) * 2u;
            }
    }
    __device__ __forceinline__ void mid(g8::Acc&, const Unit&, int, int) const {}
    __device__ __forceinline__ void epi(g8::Acc& acc, const Unit& u, int wr, int wc, int fr, int fq) const {
        u16* H = (u16*)((unsigned char*)ws + O_H);
#pragma unroll
        for (int ai = 0; ai < 2; ++ai)
#pragma unroll
            for (int m = 0; m < 4; ++m) {
                const int idx = u.mt * 256 + ai * 128 + wr * 64 + m * 16 + fr;
                if (idx < u.cnt) {
                    const f32x4 g0 = acc[ai][0][m][0], g1 = acc[ai][0][m][1], u0 = acc[ai][1][m][0], u1 = acc[ai][1][m][1];
                    u32x4 o;
                    o.x = g8::cvt_pk_bf16(siluf(g0[0]) * u0[0], siluf(g0[1]) * u0[1]); o.y = g8::cvt_pk_bf16(siluf(g0[2]) * u0[2], siluf(g0[3]) * u0[3]);
                    o.z = g8::cvt_pk_bf16(siluf(g1[0]) * u1[0], siluf(g1[1]) * u1[1]); o.w = g8::cvt_pk_bf16(siluf(g1[2]) * u1[2], siluf(g1[3]) * u1[3]);
                    *(u32x4*)(H + (size_t)(u.base + idx) * 256 + u.pn * 128 + wc * 32 + 8 * fq) = o;
                }
            }
    }
};
struct Down {
    static constexpr int K = 256; static constexpr bool PERM = true; static constexpr int MIDT = 0;
    typedef MoeUnit Unit;
    const unsigned char* ws; const int* pre_t; const int* pre_c; int G, c;
    __device__ __forceinline__ bool next(int i, Unit& u) const { return moe_next<4>(pre_t, pre_c, i * G + c, u); }
    __device__ __forceinline__ const char* baseA(const Unit& u) const { return (const char*)(ws + O_H) + (size_t)(u.base + u.mt * 256) * 256 * 2; }
    __device__ __forceinline__ const char* baseB(const Unit& u) const { return (const char*)(ws + O_WD) + ((size_t)u.e * 1024 + u.pn * 256) * 256 * 2; }
    __device__ __forceinline__ void offs(const Unit&, const int (&R)[2], const int (&C)[2], unsigned (&oa)[2][2], unsigned (&ob)[2][2]) const {
#pragma unroll
        for (int h = 0; h < 2; ++h)
#pragma unroll
            for (int i = 0; i < 2; ++i) {
                oa[h][i] = (unsigned)((h * 128 + R[i]) * 256 + C[i]) * 2u;
                const int Rb = (R[i] & ~31) + g8::perm32(R[i] & 31);
                ob[h][i] = (unsigned)((h * 128 + Rb) * 256 + C[i]) * 2u;
            }
    }
    __device__ __forceinline__ void mid(g8::Acc&, const Unit&, int, int) const {}
    __device__ __forceinline__ void epi(g8::Acc& acc, const Unit& u, int wr, int wc, int fr, int fq) const {
        const int* list = (const int*)(ws + O_LIST) + u.e * 16384;
        const float* wts = (const float*)(ws + O_WTS);
        u16* SL = (u16*)((unsigned char*)ws + O_SL);
#pragma unroll
        for (int ai = 0; ai < 2; ++ai)
#pragma unroll
            for (int m = 0; m < 4; ++m) {
                const int idx = u.mt * 256 + ai * 128 + wr * 64 + m * 16 + fr;
                if (idx < u.cnt) {
                    const int ent = list[idx];
                    const float wg = wts[ent];
                    u16* rowp = SL + (size_t)ent * 1024 + u.pn * 256 + wc * 32 + 8 * fq;
#pragma unroll
                    for (int bj = 0; bj < 2; ++bj) {
                        const f32x4 v0 = acc[ai][bj][m][0] * wg, v1 = acc[ai][bj][m][1] * wg;
                        u32x4 o; o.x = g8::cvt_pk_bf16(v0[0], v0[1]); o.y = g8::cvt_pk_bf16(v0[2], v0[3]); o.z = g8::cvt_pk_bf16(v1[0], v1[1]); o.w = g8::cvt_pk_bf16(v1[2], v1[3]);
                        *(u32x4*)(rowp + bj * 128) = o;
                    }
                }
            }
    }
};
__device__ void phase9(const Params& P, char* lds) {
    int* pre_t = (int*)(lds + g8::STAGE_BYTES); int* pre_c = pre_t + 40;
    moe_prefix(P.ws, pre_t, pre_c);
    GateUp S; S.ws = P.ws; S.pre_t = pre_t; S.pre_c = pre_c; S.G = gridDim.x; S.c = blockIdx.x;
    g8::gemm_phase<GateUp>((LAS unsigned char*)lds, S);
}
__device__ void phase10(const Params& P, char* lds) {
    int* pre_t = (int*)(lds + g8::STAGE_BYTES); int* pre_c = pre_t + 40;
    moe_prefix(P.ws, pre_t, pre_c);
    Down S; S.ws = P.ws; S.pre_t = pre_t; S.pre_c = pre_c; S.G = gridDim.x; S.c = blockIdx.x;
    g8::gemm_phase<Down>((LAS unsigned char*)lds, S);
}

__device__ void phase11(const Params& P) {
    unsigned char* ws = P.ws;
    const int lane = threadIdx.x & 63;
    const int gw = blockIdx.x * 8 + (threadIdx.x >> 6), nw = gridDim.x * 8;
    const float* mod = (const float*)(ws + O_MOD);
    const u16* SL = (const u16*)(ws + O_SL);
    for (int row = gw; row < MLAT; row += nw) {
        const int b = row >> 12;
        float* xr = P.out + (size_t)row * 1024;
        float4 v[4]; float ss = 0.f;
#pragma unroll
        for (int j = 0; j < 4; ++j) {
            const int k = (lane + 64 * j) * 4;
            v[j] = *(const float4*)(xr + k);
            const uint2 s0 = *(const uint2*)(SL + (size_t)(row * 2) * 1024 + k);
            const uint2 s1 = *(const uint2*)(SL + (size_t)(row * 2 + 1) * 1024 + k);
            const float4 g2 = *(const float4*)(mod + b * 6144 + 5120 + k);
            v[j].x += g2.x * (bflo(s0.x) + bflo(s1.x));
            v[j].y += g2.y * (bfhi(s0.x) + bfhi(s1.x));
            v[j].z += g2.z * (bflo(s0.y) + bflo(s1.y));
            v[j].w += g2.w * (bfhi(s0.y) + bfhi(s1.y));
            ss += v[j].x * v[j].x + v[j].y * v[j].y + v[j].z * v[j].z + v[j].w * v[j].w;
        }
        ss = wave_sum(ss);
        const float rstd = rsqrtf(ss * (1.f / 1024.f) + 1e-6f);
#pragma unroll
        for (int j = 0; j < 4; ++j) {
            const int k = (lane + 64 * j) * 4;
            const float4 fw = *(const float4*)(P.in[I_FNW] + k);
            float4 o; o.x = v[j].x * rstd * fw.x; o.y = v[j].y * rstd * fw.y; o.z = v[j].z * rstd * fw.z; o.w = v[j].w * rstd * fw.w;
            *(float4*)(xr + k) = o;
        }
    }
}

__global__ void __launch_bounds__(NTB, 2) fwd_kernel(Params P) {
    extern __shared__ __attribute__((aligned(16))) char lds[];
    if (threadIdx.x < 4) ((volatile LAS unsigned*)(lds + LDS_MAIN))[threadIdx.x] = 0u;
    __syncthreads();
    XcdBarrier xbar = xcd_barrier_post((unsigned*)(P.ws + O_BAR), (volatile LAS unsigned*)(lds + LDS_MAIN));
#define SYNC() xcd_barrier(xbar)
#ifdef ONLY_PH
#define RUN_PHASE(k, call) do { if ((k) == ONLY_PH) { call; } } while (0)
#else
#define RUN_PHASE(k, call) do { if (P.lo <= (k) && (k) < P.hi) { call; if ((k) + 1 < P.hi) { SYNC(); } } } while (0)
#endif
    RUN_PHASE(0, phase0(P, lds));
    RUN_PHASE(1, phase1(P));
    RUN_PHASE(2, { InProj S; S.ws = P.ws; S.G = gridDim.x; S.c = blockIdx.x; g8::gemm_phase<InProj>((LAS unsigned char*)lds, S); });
    RUN_PHASE(3, phase3(P, lds));
    RUN_PHASE(4, phase4(P, lds));
    RUN_PHASE(5, phase5(P));
    RUN_PHASE(6, phase6(P, lds));
    RUN_PHASE(7, phase7(P, lds));
    RUN_PHASE(8, phase8(P, lds));
    RUN_PHASE(9, phase9(P, lds));
    RUN_PHASE(10, phase10(P, lds));
    RUN_PHASE(11, phase11(P));
}

extern "C" void kernel_launch(void* const* d_in, const int* in_sizes, int n_in, void* d_out, int out_size, void* d_ws, size_t ws_size,
                              hipStream_t stream) {
    static int grid_blocks = 0;
    if (!grid_blocks) {
        int dev = 0, cus = 0, per_cu = 0;
        (void)hipGetDevice(&dev);
        (void)hipDeviceGetAttribute(&cus, hipDeviceAttributeMultiprocessorCount, dev);
        (void)hipFuncSetAttribute((const void*)fwd_kernel, hipFuncAttributeMaxDynamicSharedMemorySize, LDS_BYTES);
        (void)hipOccupancyMaxActiveBlocksPerMultiprocessor(&per_cu, (const void*)fwd_kernel, NTB, LDS_BYTES);
        if (per_cu < 1) fprintf(stderr, "occupancy query says %d blocks per CU\n", per_cu);
        grid_blocks = cus;
        if (ws_size < WS_END) fprintf(stderr, "workspace too small: %zu < %zu\n", ws_size, (size_t)WS_END);
    }
    Params p{};
    for (int i = 0; i < 30; ++i) p.in[i] = (const float*)d_in[i];
    p.out = (float*)d_out; p.ws = (unsigned char*)d_ws;
    p.lo = 0; p.hi = NPHASE;
    (void)hipMemsetAsync((char*)d_ws + O_BAR, 0, XCD_BAR_WORDS * 4, stream);
    void* args[] = {&p};
    hipError_t e = hipLaunchCooperativeKernel((const void*)fwd_kernel, dim3(grid_blocks), dim3(NTB), args, LDS_BYTES, stream);
    if (e != hipSuccess) fprintf(stderr, "cooperative launch failed: %s (grid %d)\n", hipGetErrorString(e), grid_blocks);
}
```

```cpp
#include <hip/hip_runtime.h>
#include <cstdio>
#include <cstdint>

typedef unsigned short u16;
typedef __attribute__((ext_vector_type(8))) short bf16x8;
typedef __attribute__((ext_vector_type(4))) float f32x4;
typedef __attribute__((ext_vector_type(4))) unsigned u32x4;
#define LAS __attribute__((address_space(3)))

constexpr int NTB = 512;
constexpr int VLDS = 75776;
constexpr int LDS_MAIN = 2 * VLDS;
constexpr int LDS_BYTES = LDS_MAIN + 256;
constexpr int MLAT = 16384, MALL = 17408;
constexpr int NCH = 34;
constexpr int NPHASE = 12;

enum { I_X = 0, I_C, I_CTX, I_CCTX, I_WMOD, I_BMOD, I_N1W, I_WIN, I_SCW, I_SCB, I_DTB, I_ALOG, I_SSDD, I_SNW, I_MCW, I_MCB, I_WQK, I_GB,
       I_MNW, I_MSKIP, I_WOUT, I_N2W, I_RGW, I_RGB, I_REW, I_REB, I_WG, I_WU, I_WD, I_FNW };

constexpr size_t al(size_t x) { return (x + 255) & ~(size_t)255; }
constexpr size_t O_MOD = 0;
constexpr size_t O_SSQ = O_MOD + al(5 * 6144 * 4);
constexpr size_t O_CNT = O_SSQ + al(16384 * 16 * 4);
constexpr size_t O_BAR = O_CNT + 4096;
constexpr size_t O_PSD = O_BAR + 16384;
constexpr size_t O_PSG = O_PSD + al((size_t)MALL * 16 * 4);
constexpr size_t O_DT = O_PSG + al((size_t)MALL * 16 * 4);
constexpr size_t O_GI = O_DT + al((size_t)MALL * 16 * 4);
constexpr size_t O_GF = O_GI + al((size_t)MALL * 8 * 4);
constexpr size_t O_ACH = O_GF + al((size_t)MALL * 8 * 4);
constexpr size_t O_MLS = O_ACH + 16384;
constexpr size_t O_MLP = O_MLS + 16384;
constexpr size_t O_MLN = O_MLP + 16384;
constexpr size_t O_LIST = O_MLN + al(4 * 34 * 4 * 2 * 128 * 4);
constexpr size_t O_WTS = O_LIST + al(32 * 16384 * 4);
constexpr size_t O_WIN = O_WTS + al(16384 * 2 * 4);
constexpr size_t O_WOUT = O_WIN + al((size_t)3328 * 1024 * 2);
constexpr size_t O_A = O_WOUT + al((size_t)1024 * 1024 * 2);
constexpr size_t SZ_A = (size_t)MALL * 1024 * 2;
constexpr size_t O_PT = O_A + SZ_A;
constexpr size_t SZ_PT = (size_t)MALL * 1536 * 2;
constexpr size_t O_MLC1 = O_PT + SZ_PT;
constexpr size_t SZ_HALF = (size_t)MALL * 512 * 2;
constexpr size_t O_ZO = O_MLC1 + SZ_HALF;
constexpr size_t O_VT = O_ZO + SZ_A;
constexpr size_t O_BM = O_VT + SZ_HALF;
constexpr size_t SZ_Q = (size_t)MALL * 256 * 2;
constexpr size_t O_BT = O_BM + SZ_Q;
constexpr size_t O_CM = O_BT + SZ_Q;
constexpr size_t O_XT = O_CM + SZ_Q;
constexpr size_t O_KT = O_XT + SZ_HALF;
constexpr size_t O_XC = O_KT + SZ_HALF;
constexpr size_t WS_END = O_XC + SZ_HALF;
constexpr size_t O_XN = O_A, O_Q = O_A, O_K = O_A + SZ_HALF, O_T = O_A;
constexpr size_t O_ST = O_PT;
constexpr size_t O_MLC0 = O_PT + (size_t)4 * 34 * 8 * 2 * 8192 * 2;
constexpr size_t O_WGU = O_PT;
constexpr size_t O_WD = O_PT + (size_t)32 * 512 * 1024 * 2;
constexpr size_t O_SL = O_ZO;
constexpr size_t O_H = O_XT;
static_assert(O_WD + (size_t)32 * 1024 * 256 * 2 <= O_MLC1, "moe weights fit PT region");
static_assert(O_SL + (size_t)16384 * 2 * 1024 * 2 <= O_CM, "slots fit");
static_assert((size_t)(32768 + 256) * 256 * 2 <= SZ_HALF, "H fits");
static_assert(WS_END <= (size_t)256 * 1024 * 1024, "workspace");
constexpr size_t TCTX512 = (size_t)4 * 512 * 4096;
constexpr size_t TCTX256 = (size_t)4 * 256 * 4096;

struct Params { const float* in[30]; float* out; unsigned char* ws; int lo, hi; };

#define XB_TMO      128
#define XB_XCNT(j)  (256  + 64 * (j))
#define XB_XSUB(j)  (1280 + 64 * (j))
#define XB_XGEN(j)  (2304 + 64 * (j))
#define XB_TOP      3328
#define XB_TOPGEN   3392
#define XCD_BAR_WORDS 3456
#define XB_SPIN_CAP (1u << 20)
__device__ __forceinline__ unsigned xb_ld(unsigned* p)              { return __hip_atomic_load(p, __ATOMIC_RELAXED, __HIP_MEMORY_SCOPE_AGENT); }
__device__ __forceinline__ unsigned xb_add(unsigned* p, unsigned v) { return __hip_atomic_fetch_add(p, v, __ATOMIC_RELAXED, __HIP_MEMORY_SCOPE_AGENT); }
__device__ __forceinline__ unsigned xb_xcc_id() { return (unsigned)__builtin_amdgcn_s_getreg((3 << 11) | 20) & 0xFu; }
#define XB_SPIN(cond, bar) do { unsigned _sp = 0; while (cond) { __builtin_amdgcn_s_sleep(1); \
    if ((++_sp & 255u) == 0u) { if (xb_ld(&(bar)[XB_TMO])) break; if (_sp > XB_SPIN_CAP) { atomicAdd(&(bar)[XB_TMO], 1u); break; } } } } while (0)
struct XcdBarrier { unsigned* bar; unsigned x; volatile LAS unsigned* st; };
__device__ __forceinline__ XcdBarrier xcd_barrier_post(unsigned* bar, volatile LAS unsigned* st) {
    XcdBarrier b; b.bar = bar; b.x = xb_xcc_id(); b.st = st;
    if (threadIdx.x == 0) (void)xb_add(&bar[XB_XCNT(b.x)], 1u);
    return b;
}
__device__ __forceinline__ void xcd_barrier_complete(unsigned* bar, unsigned x, unsigned& nloc, unsigned& nx) {
    const unsigned G = gridDim.x * gridDim.y * gridDim.z;
    unsigned sum, cnt, mine, sp = 0u;
    for (;;) {
        sum = 0u; cnt = 0u; mine = 0u;
#pragma unroll
        for (unsigned j = 0; j < 16; ++j) { const unsigned c = xb_ld(&bar[XB_XCNT(j)]); sum += c; cnt += (c > 0u) ? 1u : 0u; mine = (j == x) ? c : mine; }
        if (sum == G) break;
        __builtin_amdgcn_s_sleep(1);
        if ((++sp & 255u) == 0u) { if (xb_ld(&bar[XB_TMO])) break; if (sp > XB_SPIN_CAP) { atomicAdd(&bar[XB_TMO], 1u); break; } }
    }
    nloc = mine > 0u ? mine : 1u; nx = cnt > 0u ? cnt : 1u;
}
__device__ __forceinline__ void xcd_barrier(const XcdBarrier& b) {
    asm volatile("s_waitcnt vmcnt(0)" ::: "memory");
    __syncthreads();
    if (threadIdx.x == 0) {
        unsigned* bar = b.bar;
        __builtin_amdgcn_s_waitcnt(0);
        unsigned nloc = b.st[0], nx = b.st[1];
        if (nloc == 0u) { xcd_barrier_complete(bar, b.x, nloc, nx); b.st[0] = nloc; b.st[1] = nx; }
        const unsigned old = xb_add(&bar[XB_XSUB(b.x)], 1u);
        const unsigned gen = old / nloc;
        if (old + 1u == (gen + 1u) * nloc) {
            __builtin_amdgcn_fence(__ATOMIC_RELEASE, "agent");
            asm volatile("s_waitcnt vmcnt(0)" ::: "memory");
            const unsigned og = xb_add(&bar[XB_TOP], 1u);
            const unsigned tg = og / nx;
            if (og + 1u == (tg + 1u) * nx) xb_add(&bar[XB_TOPGEN], 1u);
            else XB_SPIN(xb_ld(&bar[XB_TOPGEN]) == tg, bar);
            __builtin_amdgcn_fence(__ATOMIC_ACQUIRE, "agent");
            xb_add(&bar[XB_XGEN(b.x)], 1u);
            asm volatile("s_waitcnt vmcnt(0)" ::: "memory");
        } else {
            XB_SPIN(xb_ld(&bar[XB_XGEN(b.x)]) == gen, bar);
            __builtin_amdgcn_fence(__ATOMIC_ACQUIRE, "agent");
            asm volatile("s_waitcnt vmcnt(0)" ::: "memory");
        }
    }
    __syncthreads();
}

__device__ __forceinline__ u16 f2bf(float f) { unsigned u = __float_as_uint(f); u += 0x7fffu + ((u >> 16) & 1u); return (u16)(u >> 16); }
__device__ __forceinline__ float bf2f(u16 h) { return __uint_as_float(((unsigned)h) << 16); }
__device__ __forceinline__ unsigned pack2(float a, float b) { return (unsigned)f2bf(a) | ((unsigned)f2bf(b) << 16); }
__device__ __forceinline__ float bflo(unsigned u) { return __uint_as_float(u << 16); }
__device__ __forceinline__ float bfhi(unsigned u) { return __uint_as_float(u & 0xffff0000u); }
__device__ __forceinline__ float siluf(float x) { return x / (1.f + __expf(-x)); }
__device__ __forceinline__ float sigmf(float x) { return 1.f / (1.f + __expf(-x)); }
__device__ __forceinline__ float softplusf(float x) { return x > 20.f ? x : log1pf(__expf(x)); }
__device__ __forceinline__ float wave_sum(float v) {
#pragma unroll
    for (int o = 32; o > 0; o >>= 1) v += __shfl_xor(v, o);
    return v;
}
__device__ __forceinline__ int swz256(int row, int chunk) { return row * 256 + ((chunk ^ (row & 15)) << 4); }
__device__ __forceinline__ int colmajor_src_row(int R) {
    if (R >= MLAT) return R;
    const int b = R >> 12, lp = R & 4095;
    return (b << 12) + ((lp & 63) << 6) + (lp >> 6);
}

__device__ __forceinline__ void load_tile128(char* lds, int lrow0, const u16* __restrict__ g, size_t ld, int rows, int t, int nthr) {
#pragma unroll 4
    for (int q = t; q < rows * 16; q += nthr) {
        const int r = q >> 4, c = q & 15;
        const uint4 v = *(const uint4*)(g + (size_t)r * ld + c * 8);
        *(uint4*)(lds + swz256(lrow0 + r, c)) = v;
    }
}
__device__ __forceinline__ void load_tile128_scaled(char* lds, int lrow0, const u16* __restrict__ g, size_t ld, int rows, const float* w, int t, int nthr) {
#pragma unroll 2
    for (int q = t; q < rows * 16; q += nthr) {
        const int r = q >> 4, c = q & 15;
        const uint4 v = *(const uint4*)(g + (size_t)r * ld + c * 8);
        const float* ww = w + c * 8;
        uint4 o;
        o.x = pack2(bflo(v.x) * ww[0], bfhi(v.x) * ww[1]);
        o.y = pack2(bflo(v.y) * ww[2], bfhi(v.y) * ww[3]);
        o.z = pack2(bflo(v.z) * ww[4], bfhi(v.z) * ww[5]);
        o.w = pack2(bflo(v.w) * ww[6], bfhi(v.w) * ww[7]);
        *(uint4*)(lds + swz256(lrow0 + r, c)) = o;
    }
}
template <int MI, int NJ>
__device__ __forceinline__ void lds_mma(const char* A, const char* B, int arow0, int brow0, f32x4 (&acc)[MI][NJ], int lane) {
#pragma unroll 1
    for (int kk = 0; kk < 4; ++kk) {
        const int chunk = kk * 4 + (lane >> 4);
        bf16x8 a[MI], b[NJ];
#pragma unroll
        for (int i = 0; i < MI; ++i) { const int row = arow0 + i * 16 + (lane & 15); a[i] = *(const bf16x8*)(A + swz256(row, chunk)); }
#pragma unroll
        for (int j = 0; j < NJ; ++j) { const int row = brow0 + j * 16 + (lane & 15); b[j] = *(const bf16x8*)(B + swz256(row, chunk)); }
#pragma unroll
        for (int i = 0; i < MI; ++i)
#pragma unroll
            for (int j = 0; j < NJ; ++j) acc[i][j] = __builtin_amdgcn_mfma_f32_16x16x32_bf16(a[i], b[j], acc[i][j], 0, 0, 0);
    }
}
template <int MI, int NJ>
__device__ __forceinline__ void zero_acc(f32x4 (&acc)[MI][NJ]) {
#pragma unroll
    for (int i = 0; i < MI; ++i)
#pragma unroll
        for (int j = 0; j < NJ; ++j) acc[i][j] = f32x4{0.f, 0.f, 0.f, 0.f};
}
template <int OP>
__device__ __forceinline__ float scan_pair(float v, float* buf, int t) {
    const int idx = t & 127, base = t & 128;
    const bool act = t < 256;
    if (act) buf[t] = v;
    __syncthreads();
#pragma unroll 1
    for (int off = 1; off < 128; off <<= 1) {
        float o = OP ? -INFINITY : 0.f;
        if (act && idx >= off) o = buf[base + idx - off];
        __syncthreads();
        v = OP ? fmaxf(v, o) : v + o;
        if (act) buf[t] = v;
        __syncthreads();
    }
    return v;
}

__device__ __forceinline__ void transpose_tile(float* tile, const float* __restrict__ src, int ld_src, int k0, int n0, int ncount,
                                               u16* dst, size_t dst_row0, int ld_dst, const float* __restrict__ scale, int scale_kmax, int t) {
    const int n = t & 63, kq = t >> 6;
#pragma unroll 4
    for (int i = 0; i < 16; ++i) {
        const int k = i * 4 + kq;
        float v = 0.f;
        if (n < ncount) { v = src[(size_t)(k0 + k) * ld_src + n0 + n]; if (scale && (k0 + k) < scale_kmax) v *= scale[k0 + k]; }
        tile[k * 65 + n] = v;
    }
    __syncthreads();
#pragma unroll
    for (int i = 0; i < 2; ++i) {
        const int q = t + 256 * i, nn = q >> 3, kc = q & 7;
        if (nn < ncount) {
            const float* p = tile + (kc * 8) * 65 + nn;
            uint4 o;
            o.x = pack2(p[0], p[65]); o.y = pack2(p[130], p[195]); o.z = pack2(p[260], p[325]); o.w = pack2(p[390], p[455]);
            *(uint4*)(dst + (dst_row0 + nn) * (size_t)ld_dst + k0 + kc * 8) = o;
        }
    }
    __syncthreads();
}

__device__ __forceinline__ void transpose_tile_w(float* tile, const float* __restrict__ src, int ld_src, int k0, int n0,
                                                 u16* dst, size_t dst_row0, int ld_dst, const float* __restrict__ scale, int scale_kmax, int t) {
    float4 v[8];
#pragma unroll
    for (int i = 0; i < 8; ++i) { const int q = t + 256 * i, kr = q >> 5, nq = q & 31; v[i] = *(const float4*)(src + (size_t)(k0 + kr) * ld_src + n0 + nq * 4); }
#pragma unroll
    for (int i = 0; i < 8; ++i) {
        const int q = t + 256 * i, kr = q >> 5, nq = q & 31;
        float sc = 1.f;
        if (scale && (k0 + kr) < scale_kmax) sc = scale[k0 + kr];
        float* p = tile + kr * 129 + nq * 4;
        p[0] = v[i].x * sc; p[1] = v[i].y * sc; p[2] = v[i].z * sc; p[3] = v[i].w * sc;
    }
    __syncthreads();
#pragma unroll
    for (int i = 0; i < 4; ++i) {
        const int q = t + 256 * i, nn = q >> 3, kc = q & 7;
        const float* p = tile + (kc * 8) * 129 + nn;
        uint4 o;
        o.x = pack2(p[0], p[129]); o.y = pack2(p[258], p[387]); o.z = pack2(p[516], p[645]); o.w = pack2(p[774], p[903]);
        *(uint4*)(dst + (dst_row0 + nn) * (size_t)ld_dst + k0 + kc * 8) = o;
    }
    __syncthreads();
}

namespace g8 {
constexpr int BM = 256, BK = 64, HALF = 128, HTB = HALF * BK * 2, STAGE_BYTES = 8 * HTB;
__device__ __forceinline__ int lds_byte(int r, int c) { const int st = (r >> 4) * 2 + (c >> 5), rr = r & 15, cc = c & 31, ob = rr * 64 + cc * 2; return st * 1024 + (ob ^ (((ob >> 9) & 1) << 5)); }
__device__ __forceinline__ void stage_rc(int b, int& R, int& C) { const int st = b / 1024, sb = b % 1024, swz = sb ^ (((sb >> 9) & 1) << 5); R = (st >> 1) * 16 + swz / 64; C = (st & 1) * 32 + (swz % 64) / 2; }
__device__ __forceinline__ int perm32(int rho) { const int n = rho >> 4, i = rho & 15; return 8 * (i >> 2) + 4 * n + (i & 3); }
__device__ __forceinline__ unsigned cvt_pk_bf16(float lo, float hi) { unsigned r; asm volatile("v_cvt_pk_bf16_f32 %0, %1, %2" : "=v"(r) : "v"(lo), "v"(hi)); return r; }
typedef f32x4 Acc[2][2][4][2];

template <class Prob>
__device__ __forceinline__ void gemm_phase(LAS unsigned char* lds, const Prob& S) {
    const int tid = threadIdx.x, wid = __builtin_amdgcn_readfirstlane(tid >> 6), lane = tid & 63, wr = wid >> 2, wc = wid & 3, fr = lane & 15, fq = lane >> 4;
    constexpr int nt = Prob::K / BK;
    const size_t kstep = (size_t)(BK * 2);
    const unsigned ldsw = (unsigned)wid * 1024u;
    const int aoff = lds_byte(wr * 64 + fr, fq * 8), boff = lds_byte(wc * 32 + fr, fq * 8);
#define G8_SA(b, h) (((b) * 2 + (h)) * HTB)
#define G8_SB(b, h) ((4 + (b) * 2 + (h)) * HTB)
#define G8_STAGE(bufoff, gbase, voff) do { _Pragma("unroll") for (int _i = 0; _i < 2; ++_i) \
        __builtin_amdgcn_global_load_lds((const unsigned*)((const char*)(gbase) + (voff)[_i]), (LAS unsigned*)(lds + (bufoff) + ldsw + _i * 8192), 16, 0, 0); } while (0)
#define G8_LDA(dst, b, h) do { _Pragma("unroll") for (int m = 0; m < 4; ++m) _Pragma("unroll") for (int k = 0; k < 2; ++k) dst[m][k] = *(const LAS bf16x8*)(lds + G8_SA(b, h) + aoff + m * 2048 + k * 1024); } while (0)
#define G8_LDB(dst, b, h) do { _Pragma("unroll") for (int n = 0; n < 2; ++n) _Pragma("unroll") for (int k = 0; k < 2; ++k) dst[n][k] = *(const LAS bf16x8*)(lds + G8_SB(b, h) + boff + n * 2048 + k * 1024); } while (0)
#define G8_MMA(ai, bj, At, Bt) do { __builtin_amdgcn_s_setprio(1); _Pragma("unroll") for (int m = 0; m < 4; ++m) _Pragma("unroll") for (int n = 0; n < 2; ++n) _Pragma("unroll") for (int k = 0; k < 2; ++k) \
        acc[ai][bj][m][n] = __builtin_amdgcn_mfma_f32_16x16x32_bf16(Bt[n][k], At[m][k], acc[ai][bj][m][n], 0, 0, 0); __builtin_amdgcn_s_setprio(0); } while (0)
#define G8_WAIT_V(n) asm volatile("s_waitcnt vmcnt(" #n ")" ::: "memory")
#define G8_WAIT_L(n) asm volatile("s_waitcnt lgkmcnt(" #n ")" ::: "memory")
#define G8_BAR __builtin_amdgcn_s_barrier()
#define G8_SCHED __builtin_amdgcn_sched_barrier(0)
    typename Prob::Unit cur, nxt; int ui = 0;
    if (!S.next(0, cur)) return;
    Acc acc;
#pragma unroll
    for (int a = 0; a < 2; ++a)
#pragma unroll
        for (int b = 0; b < 2; ++b)
#pragma unroll
            for (int m = 0; m < 4; ++m)
#pragma unroll
                for (int n = 0; n < 2; ++n) acc[a][b][m][n] = (f32x4){0.f, 0.f, 0.f, 0.f};
    bf16x8 At[4][2], B0[2][2], B1[2][2];
    unsigned cOA[2][2], cOB[2][2], nOA[2][2], nOB[2][2];
    S.offs(cur, tid, cOA, cOB);
    const char* cA = S.baseA(cur); const char* cB = S.baseB(cur);
    G8_STAGE(G8_SB(0, 0), cB, cOB[0]); G8_STAGE(G8_SA(0, 0), cA, cOA[0]); G8_STAGE(G8_SB(0, 1), cB, cOB[1]); G8_STAGE(G8_SA(0, 1), cA, cOA[1]);
    if (wr == 1) G8_BAR;
    G8_WAIT_V(4); G8_BAR;
    G8_STAGE(G8_SB(1, 0), cB + kstep, cOB[0]); G8_STAGE(G8_SA(1, 0), cA + kstep, cOA[0]); G8_STAGE(G8_SB(1, 1), cB + kstep, cOB[1]);
    G8_WAIT_V(6); G8_BAR;
    for (;;) {
        const bool has_next = S.next(ui + 1, nxt);
        const char* nA = cA; const char* nB = cB;
#pragma unroll
        for (int h = 0; h < 2; ++h)
#pragma unroll
            for (int i = 0; i < 2; ++i) { nOA[h][i] = cOA[h][i]; nOB[h][i] = cOB[h][i]; }
        if (has_next) { S.offs(nxt, tid, nOA, nOB); nA = S.baseA(nxt); nB = S.baseB(nxt); }
#pragma unroll 1
        for (int t = 0; t < nt; t += 2) {
            const bool last = (t == nt - 2);
            if (Prob::MIDT > 0 && t == Prob::MIDT) S.mid(acc, cur, wr, fr);
            const char* a1 = cA + (size_t)(t + 1) * kstep;
            const char* a2 = last ? nA : cA + (size_t)(t + 2) * kstep; const char* b2 = last ? nB : cB + (size_t)(t + 2) * kstep;
            const char* a3 = a2 + kstep; const char* b3 = b2 + kstep;
            unsigned xA[2][2], xB[2][2];
#pragma unroll
            for (int h = 0; h < 2; ++h)
#pragma unroll
                for (int i = 0; i < 2; ++i) { xA[h][i] = last ? nOA[h][i] : cOA[h][i]; xB[h][i] = last ? nOB[h][i] : cOB[h][i]; }
            G8_LDB(B0, 0, 0); G8_SCHED; G8_LDA(At, 0, 0); G8_STAGE(G8_SA(1, 1), a1, cOA[1]);
            G8_WAIT_L(8); G8_BAR; G8_WAIT_L(0); G8_MMA(0, 0, At, B0); G8_BAR; G8_SCHED;
            G8_LDB(B1, 0, 1); G8_STAGE(G8_SB(0, 0), b2, xB[0]);
            G8_BAR; G8_WAIT_L(0); G8_MMA(0, 1, At, B1); G8_BAR;
            G8_LDA(At, 0, 1); G8_STAGE(G8_SA(0, 0), a2, xA[0]);
            G8_BAR; G8_WAIT_L(0); G8_MMA(1, 0, At, B0); G8_BAR; G8_SCHED;
            G8_STAGE(G8_SB(0, 1), b2, xB[1]);
            G8_WAIT_V(6); G8_BAR; G8_MMA(1, 1, At, B1); G8_BAR;
            G8_LDB(B0, 1, 0); G8_SCHED; G8_LDA(At, 1, 0); G8_STAGE(G8_SA(0, 1), a2, xA[1]);
            G8_WAIT_L(8); G8_BAR; G8_WAIT_L(0); G8_MMA(0, 0, At, B0); G8_BAR; G8_SCHED;
            G8_LDB(B1, 1, 1); G8_STAGE(G8_SB(1, 0), b3, xB[0]);
            G8_BAR; G8_WAIT_L(0); G8_MMA(0, 1, At, B1); G8_BAR;
            G8_LDA(At, 1, 1); G8_STAGE(G8_SA(1, 0), a3, xA[0]);
            G8_BAR; G8_WAIT_L(0); G8_MMA(1, 0, At, B0); G8_BAR; G8_SCHED;
            G8_STAGE(G8_SB(1, 1), b3, xB[1]);
            G8_WAIT_V(6); G8_BAR; G8_MMA(1, 1, At, B1); G8_BAR;
        }
        S.epi(acc, cur, wr, wc, fr, fq);
        if (!has_next) break;
#pragma unroll
        for (int a = 0; a < 2; ++a)
#pragma unroll
            for (int b = 0; b < 2; ++b)
#pragma unroll
                for (int m = 0; m < 4; ++m)
#pragma unroll
                    for (int n = 0; n < 2; ++n) acc[a][b][m][n] = (f32x4){0.f, 0.f, 0.f, 0.f};
        cur = nxt; cA = nA; cB = nB; ++ui;
#pragma unroll
        for (int h = 0; h < 2; ++h)
#pragma unroll
            for (int i = 0; i < 2; ++i) { cOA[h][i] = nOA[h][i]; cOB[h][i] = nOB[h][i]; }
    }
    G8_WAIT_V(0);
    if (wr == 0) G8_BAR;
    G8_BAR;
#undef G8_SA
#undef G8_SB
#undef G8_STAGE
#undef G8_LDA
#undef G8_LDB
#undef G8_MMA
#undef G8_WAIT_V
#undef G8_WAIT_L
#undef G8_BAR
#undef G8_SCHED
}
__device__ __forceinline__ void dense_unit(int wgid, int nM, int nN, int& pm, int& pn) {
    const int nwg = nM * nN, NXCD = 8, WGM = 8;
    { const int q = nwg / NXCD, r = nwg % NXCD, xcd = wgid % NXCD, off = wgid / NXCD; wgid = (xcd < r ? xcd * (q + 1) : r * (q + 1) + (xcd - r) * q) + off; }
    const int nig = WGM * nN, gid = wgid / nig, fm = gid * WGM, gsz = (nM - fm) < WGM ? (nM - fm) : WGM;
    pm = fm + ((wgid % nig) % gsz); pn = (wgid % nig) / gsz;
}
}

__device__ void phase0(const Params& P, char* lds_all) {
    unsigned char* ws = P.ws;
    const int vb = threadIdx.x >> 8, t = threadIdx.x & 255;
    char* lds = lds_all + vb * VLDS;
    float* tile = (float*)lds;
    const int NU = 744;
    for (int u = blockIdx.x * 2 + vb; u < NU; u += gridDim.x * 2) {
        if (u < 384) {
            int nt, v, n0b, drb;
            if (u < 192) { v = u; n0b = 0; drb = 0; }
            else if (u < 256) { v = u - 192; n0b = 1552; drb = 1536; }
            else if (u < 320) { v = u - 256; n0b = 2576; drb = 2048; }
            else { v = u - 320; n0b = 2064; drb = 2816; }
            nt = v >> 4;
            transpose_tile_w(tile, P.in[I_WIN], 3104, (v & 15) * 64, n0b + nt * 128, (u16*)(ws + O_WIN), drb + nt * 128, 1024, nullptr, 0, t);
        } else if (u < 416) {
            const int v = u - 384;
            if (v < 16) transpose_tile(tile, P.in[I_WIN], 3104, v * 64, 1536, 16, (u16*)(ws + O_WIN), 2560, 1024, nullptr, 0, t);
            else transpose_tile(tile, P.in[I_WIN], 3104, (v - 16) * 64, 3088, 16, (u16*)(ws + O_WIN), 2576, 1024, nullptr, 0, t);
        } else if (u < 544) {
            const int v = u - 416, nt = v >> 4;
            transpose_tile_w(tile, P.in[I_WOUT], 1024, (v & 15) * 64, nt * 128, (u16*)(ws + O_WOUT), nt * 128, 1024, P.in[I_SNW], 512, t);
        } else if (u < 552) {
            const int base = (u - 544) * 4096;
            for (int i = 0; i < 16; ++i) {
                const int idx = base + t + 256 * i;
                if (idx < 224 * 128) *(uint4*)(ws + O_WIN + ((size_t)(2592 + (idx >> 7)) * 1024 + (idx & 127) * 8) * 2) = make_uint4(0, 0, 0, 0);
            }
        } else {
            const int c0 = (u - 552) * 32;
            float* sc = (float*)lds;
            float* red = sc + 5 * 1024;
            for (int i = t; i < 5 * 1024; i += 256) {
                const int r = i >> 10, k = i & 1023;
                const float v = r < 4 ? P.in[I_C][r * 1024 + k] : P.in[I_CCTX][k];
                sc[i] = siluf(v);
            }
            __syncthreads();
            const int cq = t & 7, kg = t >> 3;
            float4 a0 = {0, 0, 0, 0}, a1 = a0, a2 = a0, a3 = a0, a4 = a0;
            const float* wp = P.in[I_WMOD] + (size_t)(kg * 32) * 6144 + c0 + cq * 4;
#pragma unroll 16
            for (int k = 0; k < 32; ++k) {
                const float4 wv = *(const float4*)(wp + (size_t)k * 6144);
                const int kk = kg * 32 + k;
                const float s0 = sc[kk], s1 = sc[1024 + kk], s2 = sc[2048 + kk], s3 = sc[3072 + kk], s4 = sc[4096 + kk];
                a0.x += s0 * wv.x; a0.y += s0 * wv.y; a0.z += s0 * wv.z; a0.w += s0 * wv.w;
                a1.x += s1 * wv.x; a1.y += s1 * wv.y; a1.z += s1 * wv.z; a1.w += s1 * wv.w;
                a2.x += s2 * wv.x; a2.y += s2 * wv.y; a2.z += s2 * wv.z; a2.w += s2 * wv.w;
                a3.x += s3 * wv.x; a3.y += s3 * wv.y; a3.z += s3 * wv.z; a3.w += s3 * wv.w;
                a4.x += s4 * wv.x; a4.y += s4 * wv.y; a4.z += s4 * wv.z; a4.w += s4 * wv.w;
            }
            *(float4*)(red + ((kg * 5 + 0) * 32) + cq * 4) = a0; *(float4*)(red + ((kg * 5 + 1) * 32) + cq * 4) = a1;
            *(float4*)(red + ((kg * 5 + 2) * 32) + cq * 4) = a2; *(float4*)(red + ((kg * 5 + 3) * 32) + cq * 4) = a3;
            *(float4*)(red + ((kg * 5 + 4) * 32) + cq * 4) = a4;
            __syncthreads();
            if (t < 160) {
                const int r = t >> 5, cc = t & 31;
                float s = P.in[I_BMOD][c0 + cc];
#pragma unroll
                for (int g = 0; g < 32; ++g) s += red[(g * 5 + r) * 32 + cc];
                ((float*)(ws + O_MOD))[r * 6144 + c0 + cc] = s;
            }
            __syncthreads();
        }
    }
    if (blockIdx.x == 0 && threadIdx.x < 32) ((int*)(ws + O_CNT))[threadIdx.x] = 0;
}

__device__ void phase1(const Params& P) {
    unsigned char* ws = P.ws;
    const int lane = threadIdx.x & 63;
    const int gw = blockIdx.x * 8 + (threadIdx.x >> 6), nw = gridDim.x * 8;
    const float* mod = (const float*)(ws + O_MOD);
    u16* xn = (u16*)(ws + O_XN);
    for (int row = gw; row < MALL; row += nw) {
        const float* xr = row < MLAT ? P.in[I_X] + (size_t)row * 1024 : P.in[I_CTX] + (size_t)(row - MLAT) * 1024;
        const int mb = row < MLAT ? (row >> 12) : 4;
        float4 v[4]; float ss = 0.f;
#pragma unroll
        for (int j = 0; j < 4; ++j) { v[j] = ((const float4*)xr)[lane + 64 * j]; ss += v[j].x * v[j].x + v[j].y * v[j].y + v[j].z * v[j].z + v[j].w * v[j].w; }
        ss = wave_sum(ss);
        const float rstd = rsqrtf(ss * (1.f / 1024.f) + 1e-6f);
#pragma unroll
        for (int j = 0; j < 4; ++j) {
            const int k = (lane + 64 * j) * 4;
            const float4 nwv = *(const float4*)(P.in[I_N1W] + k);
            const float4 sh = *(const float4*)(mod + mb * 6144 + k);
            const float4 sc = *(const float4*)(mod + mb * 6144 + 1024 + k);
            const float h0 = v[j].x * rstd * nwv.x * (1.f + sc.x) + sh.x;
            const float h1 = v[j].y * rstd * nwv.y * (1.f + sc.y) + sh.y;
            const float h2 = v[j].z * rstd * nwv.z * (1.f + sc.z) + sh.z;
            const float h3 = v[j].w * rstd * nwv.w * (1.f + sc.w) + sh.w;
            uint2 o; o.x = pack2(h0, h1); o.y = pack2(h2, h3);
            *(uint2*)(xn + (size_t)row * 1024 + k) = o;
        }
    }
}

struct InProj {
    static constexpr int K = 1024; static constexpr bool PERM = true; static constexpr int MIDT = 0;
    struct Unit { int pm, pn, vt; };
    const unsigned char* ws; int G, c;
    __device__ __forceinline__ bool next(int i, Unit& u) const {
        const int L = i * G + c;
        if (L >= 884) return false;
        if (L < 748) { u.vt = 0; g8::dense_unit(L, 68, 11, u.pm, u.pn); }
        else { const int v = L - 748; u.vt = 1; u.pm = v / 68; u.pn = v % 68; }
        return true;
    }
    __device__ __forceinline__ const char* baseA(const Unit& u) const { return (const char*)(ws + (u.vt ? O_WIN : O_XN)); }
    __device__ __forceinline__ const char* baseB(const Unit& u) const { return (const char*)(ws + (u.vt ? O_XN : O_WIN)); }
    __device__ __forceinline__ void offs(const Unit& u, int tid_, unsigned (&oa)[2][2], unsigned (&ob)[2][2]) const {
        int R[2], C[2];
        { int tq = tid_; asm volatile("" : "+v"(tq)); g8::stage_rc(tq * 16, R[0], C[0]); g8::stage_rc(tq * 16 + 8192, R[1], C[1]); }
#pragma unroll
        for (int h = 0; h < 2; ++h)
#pragma unroll
            for (int i = 0; i < 2; ++i) {
                const int Rb = (R[i] & ~31) + g8::perm32(R[i] & 31);
                if (!u.vt) {
                    int ar = u.pm * 256 + h * 128 + R[i];
                    if (u.pn == 6 || u.pn == 7) ar = colmajor_src_row(ar);
                    oa[h][i] = (unsigned)(ar * 1024 + C[i]) * 2u;
                    ob[h][i] = (unsigned)((u.pn * 256 + h * 128 + Rb) * 1024 + C[i]) * 2u;
                } else {
                    oa[h][i] = (unsigned)((2816 + u.pm * 256 + h * 128 + R[i]) * 1024 + C[i]) * 2u;
                    ob[h][i] = (unsigned)(colmajor_src_row(u.pn * 256 + h * 128 + Rb) * 1024 + C[i]) * 2u;
                }
            }
    }
    __device__ __forceinline__ void mid(g8::Acc&, const Unit&, int, int) const {}
    __device__ __forceinline__ void epi(g8::Acc& acc, const Unit& u, int wr, int wc, int fr, int fq) const {
        unsigned char* w = (unsigned char*)ws;
        const int row0 = u.pm * 256 + wr * 64 + fr;
        const int col0 = wc * 32 + 8 * fq;
        if (u.vt) {
            const int tok0 = u.pn * 256 + col0;
#pragma unroll
            for (int ai = 0; ai < 2; ++ai)
#pragma unroll
                for (int m = 0; m < 4; ++m) {
                    const int ch = row0 + ai * 128 + m * 16;
#pragma unroll
                    for (int bj = 0; bj < 2; ++bj) {
                        const int tk = tok0 + bj * 128;
                        u16* d;
                        if (tk < MLAT) d = (u16*)(w + O_VT) + ((size_t)((tk >> 12) * 512 + ch)) * 4096 + (tk & 4095);
                        else { const int tc = tk - MLAT; d = (u16*)(w + O_VT) + TCTX512 + ((size_t)((tc >> 8) * 512 + ch)) * 256 + (tc & 255); }
                        const f32x4 v0 = acc[ai][bj][m][0], v1 = acc[ai][bj][m][1];
                        u32x4 o; o.x = g8::cvt_pk_bf16(v0[0], v0[1]); o.y = g8::cvt_pk_bf16(v0[2], v0[3]); o.z = g8::cvt_pk_bf16(v1[0], v1[1]); o.w = g8::cvt_pk_bf16(v1[2], v1[3]);
                        *(u32x4*)d = o;
                    }
                }
            return;
        }
        if (u.pn == 10) {
            if (wc == 0) {
                float* dst = (float*)(w + (fq < 2 ? O_PSD : O_PSG)) + (fq & 1) * 8;
#pragma unroll
                for (int ai = 0; ai < 2; ++ai)
#pragma unroll
                    for (int m = 0; m < 4; ++m) {
                        float* d = dst + (size_t)(row0 + ai * 128 + m * 16) * 16;
                        *(f32x4*)d = acc[ai][0][m][0];
                        *(f32x4*)(d + 4) = acc[ai][0][m][1];
                    }
            }
            return;
        }
        u16* base; int ld;
        if (u.pn < 2) { base = (u16*)(w + O_ZO) + u.pn * 256; ld = 1024; }
        else if (u.pn < 6) { base = (u16*)(w + O_PT) + (u.pn - 2) * 256; ld = 1536; }
        else if (u.pn < 8) { base = (u16*)(w + O_PT) + 1024 + (u.pn - 6) * 256; ld = 1536; }
        else { base = (u16*)(w + O_ZO) + 512 + (u.pn - 8) * 256; ld = 1024; }
#pragma unroll
        for (int ai = 0; ai < 2; ++ai)
#pragma unroll
            for (int m = 0; m < 4; ++m) {
                u16* rowp = base + (size_t)(row0 + ai * 128 + m * 16) * ld + col0;
#pragma unroll
                for (int bj = 0; bj < 2; ++bj) {
                    const f32x4 v0 = acc[ai][bj][m][0], v1 = acc[ai][bj][m][1];
                    u32x4 o; o.x = g8::cvt_pk_bf16(v0[0], v0[1]); o.y = g8::cvt_pk_bf16(v0[2], v0[3]); o.z = g8::cvt_pk_bf16(v1[0], v1[1]); o.w = g8::cvt_pk_bf16(v1[2], v1[3]);
                    *(u32x4*)(rowp + bj * 128) = o;
                }
            }
    }
};

__device__ void phase3(const Params& P, char* lds_all) {
    unsigned char* ws = P.ws;
    const int vb = threadIdx.x >> 8, t = threadIdx.x & 255;
    char* lds = lds_all + vb * VLDS;
    u16* raw = (u16*)lds;
    float* xcl = (float*)(lds + 132 * 128);
    const u16* pt = (const u16*)(ws + O_PT);
    const int NCONV = 136 * 24;
    const int NU = NCONV + 136;
    for (int u = blockIdx.x * 2 + vb; u < NU; u += gridDim.x * 2) {
        if (u >= NCONV) {
            const int ct = u - NCONV, b = ct / NCH, cc = ct % NCH;
            const int rb = cc < 2 ? MLAT + b * 256 + cc * 128 : b * 4096 + (cc - 2) * 128;
            const int row = rb + (t >> 1), half = t & 1;
            const float* psd = (const float*)(ws + O_PSD) + (size_t)row * 16 + half * 8;
            float* dt = (float*)(ws + O_DT) + (size_t)row * 16 + half * 8;
#pragma unroll
            for (int j = 0; j < 8; ++j) dt[j] = softplusf(psd[j] + P.in[I_DTB][half * 8 + j]);
            const float* psg = (const float*)(ws + O_PSG) + (size_t)colmajor_src_row(row) * 16;
            if (half == 0) {
                float* gi = (float*)(ws + O_GI) + (size_t)row * 8;
#pragma unroll
                for (int j = 0; j < 8; ++j) gi[j] = psg[j] + P.in[I_GB][j];
            } else {
                float* gf = (float*)(ws + O_GF) + (size_t)row * 8;
#pragma unroll
                for (int j = 0; j < 8; ++j) { const float xx = psg[8 + j] + P.in[I_GB][8 + j]; gf[j] = fminf(xx, 0.f) - log1pf(__expf(-fabsf(xx))); }
            }
            continue;
        }
        const int ct = u / 24, cgp = u % 24;
        const int b = ct / NCH, cc = ct % NCH;
        const bool isctx = cc < 2;
        const int L = isctx ? 256 : 4096;
        const int lpos = isctx ? cc * 128 : (cc - 2) * 128;
        const int rb = isctx ? MLAT + b * 256 + cc * 128 : b * 4096 + (cc - 2) * 128;
        const int sb = rb - lpos;
        const bool isml = cgp >= 16;
        const int pcol = isml ? 1024 + (cgp - 16) * 64 : cgp * 64;
        for (int q = t; q < 132 * 8; q += 256) {
            const int r = q >> 3, c = q & 7;
            const int l = lpos - 2 + r;
            uint4 v = make_uint4(0, 0, 0, 0);
            if (l >= 0 && l < L) v = *(const uint4*)(pt + (size_t)(sb + l) * 1536 + pcol + c * 8);
            *(uint4*)(raw + r * 64 + c * 8) = v;
        }
        __syncthreads();
        const int ch = t & 63, tg = t >> 6;
        const float* cw = isml ? P.in[I_MCW] + (cgp - 16) * 64 + ch : P.in[I_SCW] + cgp * 64 + ch;
        const int cwld = isml ? 512 : 1024;
        const float w0 = cw[0], w1 = cw[cwld], w2 = cw[2 * cwld], w3 = cw[3 * cwld], w4 = cw[4 * cwld];
        const float bias = isml ? P.in[I_MCB][(cgp - 16) * 64 + ch] : P.in[I_SCB][cgp * 64 + ch];
        const int tok0 = tg * 32;
        float x0 = bf2f(raw[(tok0 + 0) * 64 + ch]), x1 = bf2f(raw[(tok0 + 1) * 64 + ch]), x2 = bf2f(raw[(tok0 + 2) * 64 + ch]), x3 = bf2f(raw[(tok0 + 3) * 64 + ch]);
        if (!isml) {
            u16* tdst = nullptr; u16* ndst = nullptr;
            if (cgp < 8) {
                const int chg = cgp * 64 + ch;
                tdst = (u16*)(ws + O_XT) + (isctx ? TCTX512 + ((size_t)(b * 512 + chg)) * 256 : ((size_t)(b * 512 + chg)) * 4096) + lpos + tok0;
            } else if (cgp < 12) {
                const int gn = (cgp - 8) * 64 + ch;
                tdst = (u16*)(ws + O_BT) + (isctx ? TCTX256 + ((size_t)(b * 256 + gn)) * 256 : ((size_t)(b * 256 + gn)) * 4096) + lpos + tok0;
                ndst = (u16*)(ws + O_BM) + (size_t)(rb + tok0) * 256 + gn;
            } else {
                const int gn = (cgp - 12) * 64 + ch;
                ndst = (u16*)(ws + O_CM) + (size_t)(rb + tok0) * 256 + gn;
            }
#pragma unroll
            for (int o8 = 0; o8 < 4; ++o8) {
                float ov[8];
#pragma unroll
                for (int j = 0; j < 8; ++j) {
                    const int tok = tok0 + o8 * 8 + j;
                    const float x4 = bf2f(raw[(tok + 4) * 64 + ch]);
                    const float cv = bias + w0 * x0 + w1 * x1 + w2 * x2 + w3 * x3 + w4 * x4;
                    ov[j] = siluf(cv);
                    x0 = x1; x1 = x2; x2 = x3; x3 = x4;
                }
                if (tdst) { uint4 o; o.x = pack2(ov[0], ov[1]); o.y = pack2(ov[2], ov[3]); o.z = pack2(ov[4], ov[5]); o.w = pack2(ov[6], ov[7]); *(uint4*)(tdst + o8 * 8) = o; }
                if (ndst) {
#pragma unroll
                    for (int j = 0; j < 8; ++j) ndst[(size_t)(o8 * 8 + j) * 256] = f2bf(ov[j]);
                }
            }
            __syncthreads();
        } else {
            const int mg = cgp - 16;
            u16* xcd = (u16*)(ws + O_XC) + (size_t)(rb + tok0) * 512 + mg * 64 + ch;
#pragma unroll 8
            for (int j = 0; j < 32; ++j) {
                const int tok = tok0 + j;
                const float x4 = bf2f(raw[(tok + 4) * 64 + ch]);
                const float cv = bias + w0 * x0 + w1 * x1 + w2 * x2 + w3 * x3 + w4 * x4;
                const float sv = siluf(cv);
                xcl[tok * 64 + ch] = sv;
                xcd[(size_t)j * 512] = f2bf(sv);
                x0 = x1; x1 = x2; x2 = x3; x3 = x4;
            }
            __syncthreads();
            const int n = ch >> 2, kk = ch & 3, ng = mg * 16 + n;
            const float* wq = P.in[I_WQK] + ((size_t)(0 * 128 + ng) * 4) * 4 + kk;
            const float* wk = P.in[I_WQK] + ((size_t)(1 * 128 + ng) * 4) * 4 + kk;
            const float q0 = wq[0], q1 = wq[4], q2 = wq[8], q3 = wq[12];
            const float k0 = wk[0], k1 = wk[4], k2 = wk[8], k3 = wk[12];
            const int chg = mg * 64 + ch;
            u16* qd = (u16*)(ws + O_Q) + (size_t)(rb + tok0) * 512 + chg;
            u16* kd = (u16*)(ws + O_K) + (size_t)(rb + tok0) * 512 + chg;
            u16* ktd = (u16*)(ws + O_KT) + (isctx ? TCTX512 + ((size_t)(b * 512 + chg)) * 256 : ((size_t)(b * 512 + chg)) * 4096) + lpos + tok0;
#pragma unroll
            for (int o8 = 0; o8 < 4; ++o8) {
                float kv[8];
#pragma unroll
                for (int j = 0; j < 8; ++j) {
                    const int tok = tok0 + o8 * 8 + j;
                    const float4 xv = *(const float4*)(xcl + tok * 64 + n * 4);
                    const float qv = xv.x * q0 + xv.y * q1 + xv.z * q2 + xv.w * q3;
                    kv[j] = (xv.x * k0 + xv.y * k1 + xv.z * k2 + xv.w * k3) * 0.08838834764831845f;
                    qd[(size_t)(o8 * 8 + j) * 512] = f2bf(qv);
                    kd[(size_t)(o8 * 8 + j) * 512] = f2bf(kv[j]);
                }
                uint4 o; o.x = pack2(kv[0], kv[1]); o.y = pack2(kv[2], kv[3]); o.z = pack2(kv[4], kv[5]); o.w = pack2(kv[6], kv[7]);
                *(uint4*)(ktd + o8 * 8) = o;
            }
            __syncthreads();
        }
    }
}

__device__ void phase4(const Params& P, char* lds_all) {
    unsigned char* ws = P.ws;
    const int vb = threadIdx.x >> 8, t0 = threadIdx.x & 255;
    char* lds = lds_all + vb * VLDS;
    char* T0 = lds; char* T1 = lds + 32768;
    float* sc = (float*)(lds + 65536);
    float* sbuf = sc;
    float* wA = sc + 256;
    float* wB = sc + 384;
    const int NSSD = 4 * NCH * 8, NML = 4 * NCH * 4;
    for (int u = blockIdx.x * 2 + vb; u < NSSD + NML; u += gridDim.x * 2) {
        int t = t0; asm volatile("" : "+v"(t));
        const int lane = t & 63, w = t >> 6, wm = w >> 1, wn = w & 1;
        if (u < NSSD) {
            const int h = u & 7, ct = u >> 3, b = ct / NCH, cc = ct % NCH;
            const bool isctx = cc < 2;
            const int L = isctx ? 256 : 4096;
            const int lpos = isctx ? cc * 128 : (cc - 2) * 128;
            const int rb = isctx ? MLAT + b * 256 + cc * 128 : b * 4096 + (cc - 2) * 128;
            const int dir = t >> 7, idx = t & 127;
            const int l = dir ? 127 - idx : idx;
            const float dtv = ((const float*)(ws + O_DT))[(size_t)(rb + l) * 16 + dir * 8 + h];
            const float an = -__expf(P.in[I_ALOG][dir * 8 + h]);
            const float cs = scan_pair<0>(dtv * an, sbuf, t);
            const float tot = sbuf[dir * 128 + 127];
            const float wv = __expf(tot - cs) * dtv;
            if (dir == 0) wA[l] = wv; else wB[l] = wv;
            if (idx == 127) ((float*)(ws + O_ACH))[((size_t)(b * NCH + cc) * 8 + h) * 2 + dir] = cs;
            __syncthreads();
            const int g = h >> 2;
            const u16* xt = (const u16*)(ws + O_XT) + (isctx ? TCTX512 + ((size_t)(b * 512 + h * 64)) * 256 : ((size_t)(b * 512 + h * 64)) * 4096) + lpos;
            const u16* bt = (const u16*)(ws + O_BT) + (isctx ? TCTX256 + ((size_t)(b * 256 + g * 128)) * 256 : ((size_t)(b * 256 + g * 128)) * 4096) + lpos;
            load_tile128_scaled(T0, 0, xt, L, 64, wA, t, 256);
            load_tile128_scaled(T0, 64, xt, L, 64, wB, t, 256);
            load_tile128(T1, 0, bt, L, 128, t, 256);
            __syncthreads();
            f32x4 acc[4][4]; zero_acc(acc);
            lds_mma<4, 4>(T0, T1, wm * 64, wn * 64, acc, lane);
            u16* st = (u16*)(ws + O_ST) + (((size_t)(b * NCH + cc) * 8 + h) * 2 + wm) * 8192 + ((lane >> 4) * 4) * 128 + wn * 64 + (lane & 15);
#pragma unroll
            for (int i = 0; i < 4; ++i)
#pragma unroll
                for (int j = 0; j < 4; ++j)
#pragma unroll
                    for (int r = 0; r < 4; ++r) st[(i * 16 + r) * 128 + j * 16] = f2bf(acc[i][j][r]);
            __syncthreads();
        } else {
            const int v = u - NSSD;
            const int h = v & 3, ct = v >> 2, b = ct / NCH, cc = ct % NCH;
            const bool isctx = cc < 2;
            const int L = isctx ? 256 : 4096;
            const int lpos = isctx ? cc * 128 : (cc - 2) * 128;
            const int rb = isctx ? MLAT + b * 256 + cc * 128 : b * 4096 + (cc - 2) * 128;
            const int dir = t >> 7, idx = t & 127;
            const int s = dir ? 127 - idx : idx;
            const float fv = ((const float*)(ws + O_GF))[(size_t)(rb + s) * 8 + dir * 4 + h];
            const float iv = ((const float*)(ws + O_GI))[(size_t)(rb + s) * 8 + dir * 4 + h];
            const float bc = scan_pair<0>(fv, sbuf, t);
            const float tot = sbuf[dir * 128 + 127];
            const float av = tot - bc + iv;
            __syncthreads();
            (void)scan_pair<1>(av, sbuf, t);
            const float mloc = sbuf[dir * 128 + 127];
            const float wv = __expf(av - mloc);
            if (dir == 0) wA[s] = wv; else wB[s] = wv;
            if (idx == 0) {
                float* mls = (float*)(ws + O_MLS) + (((size_t)(b * NCH + cc) * 4 + h) * 2 + dir) * 2;
                mls[0] = mloc; mls[1] = tot;
            }
            __syncthreads();
            const u16* vt = (const u16*)(ws + O_VT) + (isctx ? TCTX512 + ((size_t)(b * 512 + h * 128)) * 256 : ((size_t)(b * 512 + h * 128)) * 4096) + lpos;
            const u16* kt = (const u16*)(ws + O_KT) + (isctx ? TCTX512 + ((size_t)(b * 512 + h * 128)) * 256 : ((size_t)(b * 512 + h * 128)) * 4096) + lpos;
            load_tile128(T1, 0, kt, L, 128, t, 256);
#pragma unroll 1
            for (int d2 = 0; d2 < 2; ++d2) {
                load_tile128_scaled(T0, 0, vt, L, 128, d2 ? wB : wA, t, 256);
                __syncthreads();
                f32x4 acc[4][4]; zero_acc(acc);
                lds_mma<4, 4>(T0, T1, wm * 64, wn * 64, acc, lane);
                u16* cst = (u16*)(ws + (d2 ? O_MLC1 : O_MLC0)) + ((size_t)(b * NCH + cc) * 4 + h) * 16384 + (wm * 64 + (lane >> 4) * 4) * 128 + wn * 64 + (lane & 15);
#pragma unroll
                for (int i = 0; i < 4; ++i)
#pragma unroll
                    for (int j = 0; j < 4; ++j)
#pragma unroll
                        for (int r = 0; r < 4; ++r) cst[(i * 16 + r) * 128 + j * 16] = f2bf(acc[i][j][r]);
                if (d2 == 0) {
                    const float* wgt = dir ? wB : wA;
                    float nacc = 0.f;
#pragma unroll 4
                    for (int c = 0; c < 16; ++c) {
                        const uint4 kv = *(const uint4*)(T1 + swz256(idx, c));
                        const float* ww = wgt + c * 8;
                        nacc += bflo(kv.x) * ww[0] + bfhi(kv.x) * ww[1] + bflo(kv.y) * ww[2] + bfhi(kv.y) * ww[3]
                              + bflo(kv.z) * ww[4] + bfhi(kv.z) * ww[5] + bflo(kv.w) * ww[6] + bfhi(kv.w) * ww[7];
                    }
                    ((float*)(ws + O_MLN))[(((size_t)(b * NCH + cc) * 4 + h) * 2 + dir) * 128 + idx] = nacc;
                }
                __syncthreads();
            }
        }
    }
}

__device__ __forceinline__ int scan_cc(int dir, int step) { return dir == 0 ? step : (step < 2 ? 1 - step : 35 - step); }
__device__ void phase5(const Params& P) {
    unsigned char* ws = P.ws;
    const int vb = threadIdx.x >> 8, t = threadIdx.x & 255;
    for (int u = blockIdx.x * 2 + vb; u < 256 + 256 + 32; u += gridDim.x * 2) {
        if (u < 256) {
            const int chain = u >> 2, part = u & 3;
            const int b = chain >> 4, h = (chain >> 1) & 7, dir = chain & 1;
            const int off = part * 2048 + t * 8;
            float S[8];
#pragma unroll
            for (int j = 0; j < 8; ++j) S[j] = 0.f;
#pragma unroll 2
            for (int step = 0; step < NCH; ++step) {
                const int cc = scan_cc(dir, step);
                u16* p = (u16*)(ws + O_ST) + (((size_t)(b * NCH + cc) * 8 + h) * 2 + dir) * 8192 + off;
                const uint4 lv = *(const uint4*)p;
                const float dec = __expf(((const float*)(ws + O_ACH))[((size_t)(b * NCH + cc) * 8 + h) * 2 + dir]);
                uint4 o; o.x = pack2(S[0], S[1]); o.y = pack2(S[2], S[3]); o.z = pack2(S[4], S[5]); o.w = pack2(S[6], S[7]);
                *(uint4*)p = o;
                S[0] = dec * S[0] + bflo(lv.x); S[1] = dec * S[1] + bfhi(lv.x); S[2] = dec * S[2] + bflo(lv.y); S[3] = dec * S[3] + bfhi(lv.y);
                S[4] = dec * S[4] + bflo(lv.z); S[5] = dec * S[5] + bfhi(lv.z); S[6] = dec * S[6] + bflo(lv.w); S[7] = dec * S[7] + bfhi(lv.w);
            }
        } else if (u < 512) {
            const int v = u - 256;
            const int chain = v >> 3, part = v & 7;
            const int b = chain >> 3, h = (chain >> 1) & 3, dir = chain & 1;
            const int off = part * 2048 + t * 8;
            float S[8];
#pragma unroll
            for (int j = 0; j < 8; ++j) S[j] = 0.f;
            float m = -1e30f;
#pragma unroll 2
            for (int step = 0; step < NCH; ++step) {
                const int cc = scan_cc(dir, step);
                u16* p = (u16*)(ws + (dir ? O_MLC1 : O_MLC0)) + ((size_t)(b * NCH + cc) * 4 + h) * 16384 + off;
                const uint4 lv = *(const uint4*)p;
                const float* mls = (const float*)(ws + O_MLS) + (((size_t)(b * NCH + cc) * 4 + h) * 2 + dir) * 2;
                const float ml = mls[0], bl = mls[1];
                const float mn = fmaxf(bl + m, ml);
                const float sp = __expf(bl + m - mn), sl = __expf(ml - mn);
                if (part == 0 && t == 0) ((float*)(ws + O_MLP))[((size_t)(b * NCH + cc) * 4 + h) * 2 + dir] = m;
                uint4 o; o.x = pack2(S[0], S[1]); o.y = pack2(S[2], S[3]); o.z = pack2(S[4], S[5]); o.w = pack2(S[6], S[7]);
                *(uint4*)p = o;
                S[0] = sp * S[0] + sl * bflo(lv.x); S[1] = sp * S[1] + sl * bfhi(lv.x); S[2] = sp * S[2] + sl * bflo(lv.y); S[3] = sp * S[3] + sl * bfhi(lv.y);
                S[4] = sp * S[4] + sl * bflo(lv.z); S[5] = sp * S[5] + sl * bfhi(lv.z); S[6] = sp * S[6] + sl * bflo(lv.w); S[7] = sp * S[7] + sl * bfhi(lv.w);
                m = mn;
            }
        } else {
            const int chain = u - 512;
            const int b = chain >> 3, h = (chain >> 1) & 3, dir = chain & 1;
            if (t < 128) {
                float nS = 0.f, m = -1e30f;
                for (int step = 0; step < NCH; ++step) {
                    const int cc = scan_cc(dir, step);
                    float* p = (float*)(ws + O_MLN) + (((size_t)(b * NCH + cc) * 4 + h) * 2 + dir) * 128 + t;
                    const float lv = *p;
                    const float* mls = (const float*)(ws + O_MLS) + (((size_t)(b * NCH + cc) * 4 + h) * 2 + dir) * 2;
                    const float ml = mls[0], bl = mls[1];
                    const float mn = fmaxf(bl + m, ml);
                    const float sp = __expf(bl + m - mn), sl = __expf(ml - mn);
                    *p = nS;
                    nS = sp * nS + sl * lv;
                    m = mn;
                }
            }
        }
    }
}

__device__ void phase6(const Params& P, char* lds) {
    unsigned char* ws = P.ws;
    char* T0 = lds; char* T1 = lds + 32768; char* T2 = lds + 65536; char* T3 = lds + 98304;
    float* sc = (float*)(lds + 131072);
    float* sbuf = sc;
    float* a0 = sc + 256;
    float* a1 = sc + 384;
    float* a2 = sc + 512;
    float* a3 = sc + 640;
    float* a4 = sc + 768;
    float* a5 = sc + 896;
    float* rsA = sc + 1024;
    float* qn = sc + 1536;
    float* fac = sc + 1792;
    float* wfac = sc + 2048;
    const int NSSD = 4 * 32 * 8, NML = 4 * 32 * 4;
    for (int u = blockIdx.x; u < NSSD + NML; u += gridDim.x) {
        int t = threadIdx.x; asm volatile("" : "+v"(t));
        const int lane = t & 63, w = t >> 6, wm = w >> 1, wn = w & 1;
        if (u < NSSD) {
            const int h = u & 7, ct = u >> 3, b = ct >> 5, c = ct & 31, cc = c + 2;
            const int rb = b * 4096 + c * 128, lpos = c * 128, g = h >> 2;
            {
                const int dir = (t >> 7) & 1, idx = t & 127;
                const int l = dir ? 127 - idx : idx;
                float dtv = 0.f, an = 0.f;
                if (t < 256) { dtv = ((const float*)(ws + O_DT))[(size_t)(rb + l) * 16 + dir * 8 + h]; an = -__expf(P.in[I_ALOG][dir * 8 + h]); }
                const float cs = scan_pair<0>(dtv * an, sbuf, t);
                if (t < 256) { if (dir == 0) { a0[l] = cs; a2[l] = dtv; } else { a1[l] = cs; a3[l] = dtv; } }
            }
            load_tile128(T0, 0, (const u16*)(ws + O_CM) + (size_t)rb * 256 + g * 128, 256, 128, t, 512);
            load_tile128(T1, 0, (const u16*)(ws + O_BM) + (size_t)rb * 256 + g * 128, 256, 128, t, 512);
            {
                const u16* sf = (const u16*)(ws + O_ST) + (((size_t)(b * NCH + cc) * 8 + h) * 2 + 0) * 8192;
                load_tile128(T2, 0, sf, 128, 128, t, 512);
            }
            load_tile128(T3, 0, (const u16*)(ws + O_XT) + ((size_t)(b * 512 + h * 64)) * 4096 + lpos, 4096, 64, t, 512);
            __syncthreads();
            f32x4 Y[2][2];
            {
                f32x4 aF[2][2], aB[2][2]; zero_acc(aF); zero_acc(aB);
                lds_mma<2, 2>(T0, T2, wm * 32, wn * 32, aF, lane);
                lds_mma<2, 2>(T0, T2, wm * 32, 64 + wn * 32, aB, lane);
#pragma unroll
                for (int i = 0; i < 2; ++i)
#pragma unroll
                    for (int r = 0; r < 4; ++r) {
                        const int l = wm * 32 + i * 16 + (lane >> 4) * 4 + r;
                        const float e0 = __expf(a0[l]), e1 = __expf(a1[l]);
#pragma unroll
                        for (int j = 0; j < 2; ++j) Y[i][j][r] = e0 * aF[i][j][r] + e1 * aB[i][j][r];
                    }
            }
            f32x4 G[2][4]; zero_acc(G);
            lds_mma<2, 4>(T0, T1, wm * 32, wn * 64, G, lane);
            __syncthreads();
            {
                float sv0[4], sv1[4], sv2[4], sv3[4];
                int dbase = wn * 64 + (lane & 15) - wm * 32 - (lane >> 4) * 4; asm volatile("" : "+v"(dbase));
#pragma unroll
                for (int j = 0; j < 4; ++j) { const int s = wn * 64 + j * 16 + (lane & 15); sv0[j] = a0[s]; sv1[j] = a1[s]; sv2[j] = a2[s]; sv3[j] = a3[s]; }
#pragma unroll
                for (int i = 0; i < 2; ++i)
#pragma unroll
                    for (int r = 0; r < 4; ++r) {
                        const int l = wm * 32 + i * 16 + (lane >> 4) * 4 + r;
                        const float c0l = a0[l], r1l = a1[l];
#pragma unroll
                        for (int j = 0; j < 4; ++j) {
                            const int s = wn * 64 + j * 16 + (lane & 15);
                            const int diff = dbase + (j * 16 - i * 16 - r);
                            const float e0 = (diff <= 0) ? (c0l - sv0[j]) : -INFINITY;
                            const float e1 = (diff >= 0) ? (r1l - sv1[j]) : -INFINITY;
                            const float f = __expf(e0) * sv2[j] + __expf(e1) * sv3[j];
                            *(u16*)(T1 + swz256(l, s >> 3) + (s & 7) * 2) = f2bf(G[i][j][r] * f);
                        }
                    }
            }
            __syncthreads();
            lds_mma<2, 2>(T1, T3, wm * 32, wn * 32, Y, lane);
            const float Dh = P.in[I_SSDD][h];
            u16* zo = (u16*)(ws + O_ZO);
#pragma unroll
            for (int i = 0; i < 2; ++i)
#pragma unroll
                for (int r = 0; r < 4; ++r) {
                    const int l = wm * 32 + i * 16 + (lane >> 4) * 4 + r;
                    float ssq = 0.f;
#pragma unroll
                    for (int j = 0; j < 2; ++j) {
                        const int p = wn * 32 + j * 16 + (lane & 15);
                        const float xv = bf2f(*(const u16*)(T3 + swz256(p, l >> 3) + (l & 7) * 2));
                        u16* zp = zo + (size_t)(rb + l) * 1024 + h * 64 + p;
                        const float z = bf2f(*zp);
                        const float y = (Y[i][j][r] + Dh * xv) * siluf(z);
                        *zp = f2bf(y);
                        ssq += y * y;
                    }
                    ssq += __shfl_xor(ssq, 1); ssq += __shfl_xor(ssq, 2); ssq += __shfl_xor(ssq, 4); ssq += __shfl_xor(ssq, 8);
                    if ((lane & 15) == 0) ((float*)(ws + O_SSQ))[(size_t)(rb + l) * 16 + h * 2 + wn] = ssq;
                }
            __syncthreads();
        } else {
            const int v = u - NSSD;
            const int h = v & 3, ct = v >> 2, b = ct >> 5, c = ct & 31, cc = c + 2;
            const int rb = b * 4096 + c * 128, lpos = c * 128;
            const float mp0 = ((const float*)(ws + O_MLP))[((size_t)(b * NCH + cc) * 4 + h) * 2 + 0];
            const float mp1 = ((const float*)(ws + O_MLP))[((size_t)(b * NCH + cc) * 4 + h) * 2 + 1];
            {
                const int dir = (t >> 7) & 1, idx = t & 127;
                const int s = dir ? 127 - idx : idx;
                float fv = 0.f, iv = 0.f;
                if (t < 256) { fv = ((const float*)(ws + O_GF))[(size_t)(rb + s) * 8 + dir * 4 + h]; iv = ((const float*)(ws + O_GI))[(size_t)(rb + s) * 8 + dir * 4 + h]; }
                const float bc = scan_pair<0>(fv, sbuf, t);
                const float uv = iv - bc;
                __syncthreads();
                const float mx = scan_pair<1>(uv, sbuf, t);
                const float mm = fmaxf(dir ? mp1 : mp0, mx);
                if (t < 256) { if (dir == 0) { a0[s] = bc; a2[s] = uv; a4[s] = mm; } else { a1[s] = bc; a3[s] = uv; a5[s] = mm; } }
            }
            load_tile128(T0, 0, (const u16*)(ws + O_Q) + (size_t)rb * 512 + h * 128, 512, 128, t, 512);
            load_tile128(T1, 0, (const u16*)(ws + O_K) + (size_t)rb * 512 + h * 128, 512, 128, t, 512);
            load_tile128(T2, 0, (const u16*)(ws + O_MLC0) + ((size_t)(b * NCH + cc) * 4 + h) * 16384, 128, 128, t, 512);
            load_tile128(T3, 0, (const u16*)(ws + O_MLC1) + ((size_t)(b * NCH + cc) * 4 + h) * 16384, 128, 128, t, 512);
            __syncthreads();
            f32x4 S[2][4]; zero_acc(S);
            lds_mma<2, 4>(T0, T1, wm * 32, wn * 64, S, lane);
            if (t < 256) {
                const int dir = t >> 7, idx = t & 127;
                const float* np = (const float*)(ws + O_MLN) + (((size_t)(b * NCH + cc) * 4 + h) * 2 + dir) * 128;
                float acc = 0.f;
#pragma unroll 4
                for (int cch = 0; cch < 16; ++cch) {
                    const uint4 qv = *(const uint4*)(T0 + swz256(idx, cch));
                    const float4 n0 = *(const float4*)(np + cch * 8), n1 = *(const float4*)(np + cch * 8 + 4);
                    acc += bflo(qv.x) * n0.x + bfhi(qv.x) * n0.y + bflo(qv.y) * n0.z + bfhi(qv.y) * n0.w
                         + bflo(qv.z) * n1.x + bfhi(qv.z) * n1.y + bflo(qv.w) * n1.z + bfhi(qv.w) * n1.w;
                }
                qn[dir * 128 + idx] = acc;
            }
            float su0[4], su1[4];
            int dbase = wn * 64 + (lane & 15) - wm * 32 - (lane >> 4) * 4; asm volatile("" : "+v"(dbase));
#pragma unroll
            for (int j = 0; j < 4; ++j) { const int s = wn * 64 + j * 16 + (lane & 15); su0[j] = a2[s]; su1[j] = a3[s]; }
#pragma unroll
            for (int i = 0; i < 2; ++i)
#pragma unroll
                for (int r = 0; r < 4; ++r) {
                    const int tt = wm * 32 + i * 16 + (lane >> 4) * 4 + r;
                    const float m0 = a4[tt], m1 = a5[tt];
                    float r0 = 0.f, r1 = 0.f;
#pragma unroll
                    for (int j = 0; j < 4; ++j) {
                        const float sv = S[i][j][r];
                        const int diff = dbase + (j * 16 - i * 16 - r);
                        r0 += sv * __expf((diff <= 0) ? (su0[j] - m0) : -INFINITY);
                        r1 += sv * __expf((diff >= 0) ? (su1[j] - m1) : -INFINITY);
                    }
                    r0 += __shfl_xor(r0, 1); r0 += __shfl_xor(r0, 2); r0 += __shfl_xor(r0, 4); r0 += __shfl_xor(r0, 8);
                    r1 += __shfl_xor(r1, 1); r1 += __shfl_xor(r1, 2); r1 += __shfl_xor(r1, 4); r1 += __shfl_xor(r1, 8);
                    if ((lane & 15) == 0) { rsA[(0 * 2 + wn) * 128 + tt] = r0; rsA[(1 * 2 + wn) * 128 + tt] = r1; }
                }
            __syncthreads();
            if (t < 256) {
                const int dir = t >> 7, tt = t & 127;
                const float rs = rsA[(dir * 2 + 0) * 128 + tt] + rsA[(dir * 2 + 1) * 128 + tt];
                const float mm = dir ? a5[tt] : a4[tt];
                const float wi = __expf((dir ? mp1 : mp0) - mm);
                const float den = rs + wi * qn[dir * 128 + tt];
                const float mout = (dir ? a1[tt] : a0[tt]) + mm;
                const float dn = fmaxf(fabsf(den), __expf(-mout));
                fac[dir * 128 + tt] = 1.f / dn;
                wfac[dir * 128 + tt] = wi / dn;
            }
            __syncthreads();
            f32x4 H[2][4];
            {
                f32x4 A0[2][4]; zero_acc(A0);
                lds_mma<2, 4>(T0, T2, wm * 32, wn * 64, A0, lane);
#pragma unroll
                for (int i = 0; i < 2; ++i)
#pragma unroll
                    for (int r = 0; r < 4; ++r) {
                        const float f = wfac[wm * 32 + i * 16 + (lane >> 4) * 4 + r];
#pragma unroll
                        for (int j = 0; j < 4; ++j) H[i][j][r] = f * A0[i][j][r];
                    }
            }
            {
                f32x4 A1[2][4]; zero_acc(A1);
                lds_mma<2, 4>(T0, T3, wm * 32, wn * 64, A1, lane);
#pragma unroll
                for (int i = 0; i < 2; ++i)
#pragma unroll
                    for (int r = 0; r < 4; ++r) {
                        const float f = wfac[128 + wm * 32 + i * 16 + (lane >> 4) * 4 + r];
#pragma unroll
                        for (int j = 0; j < 4; ++j) H[i][j][r] += f * A1[i][j][r];
                    }
            }
            __syncthreads();
            asm volatile("" : "+v"(dbase));
#pragma unroll
            for (int i = 0; i < 2; ++i)
#pragma unroll
                for (int r = 0; r < 4; ++r) {
                    const int tt = wm * 32 + i * 16 + (lane >> 4) * 4 + r;
                    const float m0 = a4[tt], m1 = a5[tt], f0 = fac[tt], f1 = fac[128 + tt];
#pragma unroll
                    for (int j = 0; j < 4; ++j) {
                        const int s = wn * 64 + j * 16 + (lane & 15);
                        const int diff = dbase + (j * 16 - i * 16 - r);
                        const float f = __expf((diff <= 0) ? (su0[j] - m0) : -INFINITY) * f0 + __expf((diff >= 0) ? (su1[j] - m1) : -INFINITY) * f1;
                        *(u16*)(T1 + swz256(tt, s >> 3) + (s & 7) * 2) = f2bf(S[i][j][r] * f);
                    }
                }
            load_tile128(T2, 0, (const u16*)(ws + O_VT) + ((size_t)(b * 512 + h * 128)) * 4096 + lpos, 4096, 128, t, 512);
            __syncthreads();
            lds_mma<2, 4>(T1, T2, wm * 32, wn * 64, H, lane);
            const u16* zo = (const u16*)(ws + O_ZO);
#pragma unroll
            for (int i = 0; i < 2; ++i)
#pragma unroll
                for (int r = 0; r < 4; ++r) {
                    const int tt = wm * 32 + i * 16 + (lane >> 4) * 4 + r;
                    const int lp = lpos + tt;
                    const size_t rown = (size_t)b * 4096 + ((lp & 63) << 6) + (lp >> 6);
                    float ssq = 0.f;
#pragma unroll
                    for (int j = 0; j < 4; ++j) {
                        const int d = wn * 64 + j * 16 + (lane & 15);
                        const float o = bf2f(zo[rown * 1024 + 512 + h * 128 + d]);
                        const float hv = H[i][j][r] * sigmf(o);
                        H[i][j][r] = hv;
                        ssq += hv * hv;
                    }
                    ssq += __shfl_xor(ssq, 1); ssq += __shfl_xor(ssq, 2); ssq += __shfl_xor(ssq, 4); ssq += __shfl_xor(ssq, 8);
                    if ((lane & 15) == 0) rsA[wn * 128 + tt] = ssq;
                }
            __syncthreads();
            u16* zow = (u16*)(ws + O_ZO);
            const u16* xc = (const u16*)(ws + O_XC);
#pragma unroll
            for (int i = 0; i < 2; ++i)
#pragma unroll
                for (int r = 0; r < 4; ++r) {
                    const int tt = wm * 32 + i * 16 + (lane >> 4) * 4 + r;
                    const int lp = lpos + tt;
                    const size_t rown = (size_t)b * 4096 + ((lp & 63) << 6) + (lp >> 6);
                    const float rn = rsqrtf((rsA[tt] + rsA[128 + tt]) * (1.f / 128.f) + 1e-6f);
#pragma unroll
                    for (int j = 0; j < 4; ++j) {
                        const int d = wn * 64 + j * 16 + (lane & 15), chg = h * 128 + d;
                        const float y = H[i][j][r] * rn * P.in[I_MNW][chg] + P.in[I_MSKIP][chg] * bf2f(xc[(size_t)(rb + tt) * 512 + chg]);
                        zow[rown * 1024 + 512 + chg] = f2bf(y);
                    }
                }
            __syncthreads();
        }
    }
}

struct OutProj {
    static constexpr int K = 1024; static constexpr bool PERM = false; static constexpr int MIDT = 8;
    struct Unit { int pm, pn, slot; };
    const Params* P; const float* rs; int G, c;
    __device__ __forceinline__ bool next(int i, Unit& u) const {
        const int L = i * G + c;
        if (L >= 256) return false;
        g8::dense_unit(L, 64, 4, u.pm, u.pn); u.slot = i & 3;
        return true;
    }
    __device__ __forceinline__ const char* baseA(const Unit&) const { return (const char*)(P->ws + O_ZO); }
    __device__ __forceinline__ const char* baseB(const Unit&) const { return (const char*)(P->ws + O_WOUT); }
    __device__ __forceinline__ void offs(const Unit& u, int tid_, unsigned (&oa)[2][2], unsigned (&ob)[2][2]) const {
        int R[2], C[2];
        { int tq = tid_; asm volatile("" : "+v"(tq)); g8::stage_rc(tq * 16, R[0], C[0]); g8::stage_rc(tq * 16 + 8192, R[1], C[1]); }
#pragma unroll
        for (int h = 0; h < 2; ++h)
#pragma unroll
            for (int i = 0; i < 2; ++i) {
                oa[h][i] = (unsigned)((u.pm * 256 + h * 128 + R[i]) * 1024 + C[i]) * 2u;
                ob[h][i] = (unsigned)((u.pn * 256 + h * 128 + R[i]) * 1024 + C[i]) * 2u;
            }
    }
    __device__ __forceinline__ void mid(g8::Acc& acc, const Unit& u, int wr, int fr) const {
#pragma unroll
        for (int ai = 0; ai < 2; ++ai)
#pragma unroll
            for (int m = 0; m < 4; ++m) {
                const float s = rs[u.slot * 256 + ai * 128 + wr * 64 + m * 16 + fr];
#pragma unroll
                for (int bj = 0; bj < 2; ++bj)
#pragma unroll
                    for (int n = 0; n < 2; ++n) acc[ai][bj][m][n] *= s;
            }
    }
    __device__ __forceinline__ void epi(g8::Acc& acc, const Unit& u, int wr, int wc, int fr, int fq) const {
        const int row0 = u.pm * 256 + wr * 64 + fr, col0 = u.pn * 256 + wc * 32 + 4 * fq;
        const int b = u.pm >> 4;
        const float* mod = (const float*)(P->ws + O_MOD) + b * 6144 + 2048;
        f32x4 g1[2][2];
#pragma unroll
        for (int bj = 0; bj < 2; ++bj)
#pragma unroll
            for (int n = 0; n < 2; ++n) g1[bj][n] = *(const f32x4*)(mod + col0 + bj * 128 + n * 16);
#pragma unroll
        for (int ai = 0; ai < 2; ++ai)
#pragma unroll
            for (int m = 0; m < 4; ++m) {
                const size_t ro = (size_t)(row0 + ai * 128 + m * 16) * 1024 + col0;
#pragma unroll
                for (int bj = 0; bj < 2; ++bj)
#pragma unroll
                    for (int n = 0; n < 2; ++n) {
                        const f32x4 xv = *(const f32x4*)(P->in[I_X] + ro + bj * 128 + n * 16);
                        *(f32x4*)(P->out + ro + bj * 128 + n * 16) = xv + g1[bj][n] * acc[ai][bj][m][n];
                    }
            }
    }
};
__device__ void phase7(const Params& P, char* lds) {
    float* rs = (float*)(lds + g8::STAGE_BYTES);
    OutProj S; S.P = &P; S.rs = rs; S.G = gridDim.x; S.c = blockIdx.x;
    for (int i = 0; i < 4; ++i) {
        OutProj::Unit u;
        if (!S.next(i, u)) break;
        if (threadIdx.x < 256) {
            const float* sq = (const float*)(P.ws + O_SSQ) + (size_t)(u.pm * 256 + threadIdx.x) * 16;
            float s = 0.f;
#pragma unroll
            for (int q = 0; q < 16; ++q) s += sq[q];
            rs[i * 256 + threadIdx.x] = rsqrtf(s * (1.f / 512.f) + 1e-6f);
        }
    }
    __syncthreads();
    g8::gemm_phase<OutProj>((LAS unsigned char*)lds, S);
}

__device__ void phase8(const Params& P, char* lds_all) {
    unsigned char* ws = P.ws;
    const float* mod = (const float*)(ws + O_MOD);
    {
        const int t = threadIdx.x, lane = t & 63, w = t >> 6;
        float* tt = (float*)lds_all;
        for (int u = blockIdx.x; u < 512; u += gridDim.x) {
            const int tk0 = u * 32;
            const int b = tk0 >> 12;
            {
                float4 v[4][4]; float ss[4];
#pragma unroll
                for (int q = 0; q < 4; ++q) {
                    const float* xr = P.out + (size_t)(tk0 + w * 4 + q) * 1024;
                    ss[q] = 0.f;
#pragma unroll
                    for (int j = 0; j < 4; ++j) { v[q][j] = ((const float4*)xr)[lane + 64 * j]; }
                }
#pragma unroll
                for (int q = 0; q < 4; ++q) {
#pragma unroll
                    for (int j = 0; j < 4; ++j) ss[q] += v[q][j].x * v[q][j].x + v[q][j].y * v[q][j].y + v[q][j].z * v[q][j].z + v[q][j].w * v[q][j].w;
                    ss[q] = rsqrtf(wave_sum(ss[q]) * (1.f / 1024.f) + 1e-6f);
                }
#pragma unroll
                for (int j = 0; j < 4; ++j) {
                    const int k = (lane + 64 * j) * 4;
                    const float4 nwv = *(const float4*)(P.in[I_N2W] + k);
                    const float4 sh = *(const float4*)(mod + b * 6144 + 3072 + k);
                    const float4 sc = *(const float4*)(mod + b * 6144 + 4096 + k);
                    const float m0 = nwv.x * (1.f + sc.x), m1 = nwv.y * (1.f + sc.y), m2 = nwv.z * (1.f + sc.z), m3 = nwv.w * (1.f + sc.w);
#pragma unroll
                    for (int q = 0; q < 4; ++q) {
                        const int tl = w * 4 + q;
                        float4 hh;
                        hh.x = v[q][j].x * ss[q] * m0 + sh.x; hh.y = v[q][j].y * ss[q] * m1 + sh.y;
                        hh.z = v[q][j].z * ss[q] * m2 + sh.z; hh.w = v[q][j].w * ss[q] * m3 + sh.w;
                        uint2 o; o.x = pack2(hh.x, hh.y); o.y = pack2(hh.z, hh.w);
                        *(uint2*)((u16*)(ws + O_T) + (size_t)(tk0 + tl) * 1024 + k) = o;
                        *(float4*)(tt + tl * 1028 + k) = hh;
                    }
                }
            }
            __syncthreads();
            f32x4 c[2][3];
#pragma unroll
            for (int a = 0; a < 2; ++a)
#pragma unroll
                for (int f = 0; f < 3; ++f) c[a][f] = f32x4{0, 0, 0, 0};
            const int ti = lane & 15, kq = lane >> 4;
            const float* rew = P.in[I_REW];
            const float* rgw = P.in[I_RGW];
#pragma unroll 8
            for (int ks = 0; ks < 32; ++ks) {
                const int k = w * 128 + ks * 4 + kq;
                const float a0 = tt[ti * 1028 + k], a1 = tt[(16 + ti) * 1028 + k];
                const float b0 = rew[(size_t)k * 32 + ti];
                const float b1 = rew[(size_t)k * 32 + 16 + ti];
                const float b2 = ti < 4 ? rgw[(size_t)k * 4 + ti] : 0.f;
                c[0][0] = __builtin_amdgcn_mfma_f32_16x16x4f32(a0, b0, c[0][0], 0, 0, 0);
                c[0][1] = __builtin_amdgcn_mfma_f32_16x16x4f32(a0, b1, c[0][1], 0, 0, 0);
                c[0][2] = __builtin_amdgcn_mfma_f32_16x16x4f32(a0, b2, c[0][2], 0, 0, 0);
                c[1][0] = __builtin_amdgcn_mfma_f32_16x16x4f32(a1, b0, c[1][0], 0, 0, 0);
                c[1][1] = __builtin_amdgcn_mfma_f32_16x16x4f32(a1, b1, c[1][1], 0, 0, 0);
                c[1][2] = __builtin_amdgcn_mfma_f32_16x16x4f32(a1, b2, c[1][2], 0, 0, 0);
            }
            __syncthreads();
            float* red = (float*)lds_all;
#pragma unroll
            for (int a = 0; a < 2; ++a)
#pragma unroll
                for (int r = 0; r < 4; ++r) {
                    const int row = a * 16 + kq * 4 + r;
                    red[(w * 32 + row) * 48 + ti] = c[a][0][r];
                    red[(w * 32 + row) * 48 + 16 + ti] = c[a][1][r];
                    red[(w * 32 + row) * 48 + 32 + ti] = c[a][2][r];
                }
            __syncthreads();
            if (t < 32) {
                float gl[4];
#pragma unroll
                for (int j = 0; j < 4; ++j) {
                    float sacc = P.in[I_RGB][j];
#pragma unroll
                    for (int ww = 0; ww < 8; ++ww) sacc += red[(ww * 32 + t) * 48 + 32 + j];
                    gl[j] = sacc;
                }
                int gs = 0; float gm = gl[0];
#pragma unroll
                for (int j = 1; j < 4; ++j) if (gl[j] > gm) { gm = gl[j]; gs = j; }
                float gsum = 0.f;
#pragma unroll
                for (int j = 0; j < 4; ++j) gsum += __expf(gl[j] - gm);
                const float pg = 1.f / gsum;
                float el[8];
#pragma unroll
                for (int j = 0; j < 8; ++j) {
                    float sacc = P.in[I_REB][gs * 8 + j];
#pragma unroll
                    for (int ww = 0; ww < 8; ++ww) sacc += red[(ww * 32 + t) * 48 + gs * 8 + j];
                    el[j] = sacc;
                }
                int i1 = 0; float m1 = el[0];
#pragma unroll
                for (int j = 1; j < 8; ++j) if (el[j] > m1) { m1 = el[j]; i1 = j; }
                int i2 = -1; float m2 = -INFINITY;
#pragma unroll
                for (int j = 0; j < 8; ++j) if (j != i1 && el[j] > m2) { m2 = el[j]; i2 = j; }
                const float e2 = __expf(m2 - m1);
                const float w1 = pg / (1.f + e2), w2 = pg * e2 / (1.f + e2);
                const int tok = tk0 + t;
                int* cnt = (int*)(ws + O_CNT);
                int* list = (int*)(ws + O_LIST);
                float* wts = (float*)(ws + O_WTS);
                const int ea = gs * 8 + i1, eb = gs * 8 + i2;
                const int pa = atomicAdd(&cnt[ea], 1);
                const int pb = atomicAdd(&cnt[eb], 1);
                list[ea * 16384 + pa] = tok * 2;
                wts[tok * 2] = w1;
                list[eb * 16384 + pb] = tok * 2 + 1;
                wts[tok * 2 + 1] = w2;
            }
            __syncthreads();
        }
    }
    const int vb = threadIdx.x >> 8, t = threadIdx.x & 255;
    char* lds = lds_all + vb * VLDS;
    const int NTR = 3072;
    for (int u = blockIdx.x * 2 + vb; u < NTR; u += gridDim.x * 2) {
        {
            const int v = u;
            float* tile = (float*)lds;
            if (v < 2048) {
                const bool up = v >= 1024;
                const int vv = v & 1023, e = vv >> 5, rem = vv & 31, nt = rem >> 4, kt = rem & 15;
                const float* src = P.in[up ? I_WU : I_WG] + (size_t)e * 1024 * 256;
                transpose_tile_w(tile, src, 256, kt * 64, nt * 128, (u16*)(ws + O_WGU) + (size_t)e * 512 * 1024, (up ? 256 : 0) + nt * 128, 1024, nullptr, 0, t);
            } else {
                const int vv = v - 2048, e = vv >> 5, rem = vv & 31, nt = rem >> 2, kt = rem & 3;
                const float* src = P.in[I_WD] + (size_t)e * 256 * 1024;
                transpose_tile_w(tile, src, 1024, kt * 64, nt * 128, (u16*)(ws + O_WD) + (size_t)e * 1024 * 256, nt * 128, 256, nullptr, 0, t);
            }
        }
    }
}

__device__ __forceinline__ void moe_prefix(const unsigned char* ws, int* pre_t, int* pre_c) {
    if (threadIdx.x == 0) {
        const int* cnt = (const int*)(ws + O_CNT);
        int at = 0, ac = 0;
        for (int e = 0; e < 32; ++e) { pre_t[e] = at; pre_c[e] = ac; const int c = cnt[e]; at += (c + 255) >> 8; ac += c; }
        pre_t[32] = at; pre_c[32] = ac;
    }
    __syncthreads();
}
struct MoeUnit { int e, mt, pn, cnt, base; };
template <int NPN>
__device__ __forceinline__ bool moe_next(const int* pre_t, const int* pre_c, int L, MoeUnit& u) {
    if (L >= pre_t[32] * NPN) return false;
    const int mtg = L / NPN; u.pn = L % NPN;
    int e = 0;
    while (pre_t[e + 1] <= mtg) ++e;
    u.e = e; u.mt = mtg - pre_t[e]; u.cnt = pre_c[e + 1] - pre_c[e]; u.base = pre_c[e];
    return true;
}
struct GateUp {
    static constexpr int K = 1024; static constexpr bool PERM = true; static constexpr int MIDT = 0;
    typedef MoeUnit Unit;
    const unsigned char* ws; const int* pre_t; const int* pre_c; int G, c;
    __device__ __forceinline__ bool next(int i, Unit& u) const { return moe_next<2>(pre_t, pre_c, i * G + c, u); }
    __device__ __forceinline__ const char* baseA(const Unit&) const { return (const char*)(ws + O_T); }
    __device__ __forceinline__ const char* baseB(const Unit& u) const { return (const char*)(ws + O_WGU) + (size_t)u.e * 512 * 1024 * 2; }
    __device__ __forceinline__ void offs(const Unit& u, int tid_, unsigned (&oa)[2][2], unsigned (&ob)[2][2]) const {
        int R[2], C[2];
        { int tq = tid_; asm volatile("" : "+v"(tq)); g8::stage_rc(tq * 16, R[0], C[0]); g8::stage_rc(tq * 16 + 8192, R[1], C[1]); }
        const int* list = (const int*)(ws + O_LIST) + u.e * 16384;
#pragma unroll
        for (int h = 0; h < 2; ++h)
#pragma unroll
            for (int i = 0; i < 2; ++i) {
                const int idx = u.mt * 256 + h * 128 + R[i];
                const int tok = idx < u.cnt ? (list[idx] >> 1) : 0;
                oa[h][i] = (unsigned)(tok * 1024 + C[i]) * 2u;
                const int Rb = (R[i] & ~31) + g8::perm32(R[i] & 31);
                ob[h][i] = (unsigned)((h * 256 + u.pn * 128 + Rb) * 1024 + C[i]) * 2u;
            }
    }
    __device__ __forceinline__ void mid(g8::Acc&, const Unit&, int, int) const {}
    __device__ __forceinline__ void epi(g8::Acc& acc, const Unit& u, int wr, int wc, int fr, int fq) const {
        u16* H = (u16*)((unsigned char*)ws + O_H);
#pragma unroll
        for (int ai = 0; ai < 2; ++ai)
#pragma unroll
            for (int m = 0; m < 4; ++m) {
                const int idx = u.mt * 256 + ai * 128 + wr * 64 + m * 16 + fr;
                if (idx < u.cnt) {
                    const f32x4 g0 = acc[ai][0][m][0], g1 = acc[ai][0][m][1], u0 = acc[ai][1][m][0], u1 = acc[ai][1][m][1];
                    u32x4 o;
                    o.x = g8::cvt_pk_bf16(siluf(g0[0]) * u0[0], siluf(g0[1]) * u0[1]); o.y = g8::cvt_pk_bf16(siluf(g0[2]) * u0[2], siluf(g0[3]) * u0[3]);
                    o.z = g8::cvt_pk_bf16(siluf(g1[0]) * u1[0], siluf(g1[1]) * u1[1]); o.w = g8::cvt_pk_bf16(siluf(g1[2]) * u1[2], siluf(g1[3]) * u1[3]);
                    *(u32x4*)(H + (size_t)(u.base + idx) * 256 + u.pn * 128 + wc * 32 + 8 * fq) = o;
                }
            }
    }
};
struct Down {
    static constexpr int K = 256; static constexpr bool PERM = true; static constexpr int MIDT = 0;
    typedef MoeUnit Unit;
    const unsigned char* ws; const int* pre_t; const int* pre_c; int G, c;
    __device__ __forceinline__ bool next(int i, Unit& u) const { return moe_next<4>(pre_t, pre_c, i * G + c, u); }
    __device__ __forceinline__ const char* baseA(const Unit& u) const { return (const char*)(ws + O_H) + (size_t)(u.base + u.mt * 256) * 256 * 2; }
    __device__ __forceinline__ const char* baseB(const Unit& u) const { return (const char*)(ws + O_WD) + ((size_t)u.e * 1024 + u.pn * 256) * 256 * 2; }
    __device__ __forceinline__ void offs(const Unit&, int tid_, unsigned (&oa)[2][2], unsigned (&ob)[2][2]) const {
        int R[2], C[2];
        { int tq = tid_; asm volatile("" : "+v"(tq)); g8::stage_rc(tq * 16, R[0], C[0]); g8::stage_rc(tq * 16 + 8192, R[1], C[1]); }
#pragma unroll
        for (int h = 0; h < 2; ++h)
#pragma unroll
            for (int i = 0; i < 2; ++i) {
                oa[h][i] = (unsigned)((h * 128 + R[i]) * 256 + C[i]) * 2u;
                const int Rb = (R[i] & ~31) + g8::perm32(R[i] & 31);
                ob[h][i] = (unsigned)((h * 128 + Rb) * 256 + C[i]) * 2u;
            }
    }
    __device__ __forceinline__ void mid(g8::Acc&, const Unit&, int, int) const {}
    __device__ __forceinline__ void epi(g8::Acc& acc, const Unit& u, int wr, int wc, int fr, int fq) const {
        const int* list = (const int*)(ws + O_LIST) + u.e * 16384;
        const float* wts = (const float*)(ws + O_WTS);
        u16* SL = (u16*)((unsigned char*)ws + O_SL);
#pragma unroll
        for (int ai = 0; ai < 2; ++ai)
#pragma unroll
            for (int m = 0; m < 4; ++m) {
                const int idx = u.mt * 256 + ai * 128 + wr * 64 + m * 16 + fr;
                if (idx < u.cnt) {
                    const int ent = list[idx];
                    const float wg = wts[ent];
                    u16* rowp = SL + (size_t)ent * 1024 + u.pn * 256 + wc * 32 + 8 * fq;
#pragma unroll
                    for (int bj = 0; bj < 2; ++bj) {
                        const f32x4 v0 = acc[ai][bj][m][0] * wg, v1 = acc[ai][bj][m][1] * wg;
                        u32x4 o; o.x = g8::cvt_pk_bf16(v0[0], v0[1]); o.y = g8::cvt_pk_bf16(v0[2], v0[3]); o.z = g8::cvt_pk_bf16(v1[0], v1[1]); o.w = g8::cvt_pk_bf16(v1[2], v1[3]);
                        *(u32x4*)(rowp + bj * 128) = o;
                    }
                }
            }
    }
};
__device__ void phase9(const Params& P, char* lds) {
    int* pre_t = (int*)(lds + g8::STAGE_BYTES); int* pre_c = pre_t + 40;
    moe_prefix(P.ws, pre_t, pre_c);
    GateUp S; S.ws = P.ws; S.pre_t = pre_t; S.pre_c = pre_c; S.G = gridDim.x; S.c = blockIdx.x;
    g8::gemm_phase<GateUp>((LAS unsigned char*)lds, S);
}
__device__ void phase10(const Params& P, char* lds) {
    int* pre_t = (int*)(lds + g8::STAGE_BYTES); int* pre_c = pre_t + 40;
    moe_prefix(P.ws, pre_t, pre_c);
    Down S; S.ws = P.ws; S.pre_t = pre_t; S.pre_c = pre_c; S.G = gridDim.x; S.c = blockIdx.x;
    g8::gemm_phase<Down>((LAS unsigned char*)lds, S);
}

__device__ void phase11(const Params& P) {
    unsigned char* ws = P.ws;
    const int lane = threadIdx.x & 63;
    const int gw = blockIdx.x * 8 + (threadIdx.x >> 6), nw = gridDim.x * 8;
    const float* mod = (const float*)(ws + O_MOD);
    const u16* SL = (const u16*)(ws + O_SL);
    for (int row = gw; row < MLAT; row += nw) {
        const int b = row >> 12;
        float* xr = P.out + (size_t)row * 1024;
        float4 v[4]; float ss = 0.f;
#pragma unroll
        for (int j = 0; j < 4; ++j) {
            const int k = (lane + 64 * j) * 4;
            v[j] = *(const float4*)(xr + k);
            const uint2 s0 = *(const uint2*)(SL + (size_t)(row * 2) * 1024 + k);
            const uint2 s1 = *(const uint2*)(SL + (size_t)(row * 2 + 1) * 1024 + k);
            const float4 g2 = *(const float4*)(mod + b * 6144 + 5120 + k);
            v[j].x += g2.x * (bflo(s0.x) + bflo(s1.x));
            v[j].y += g2.y * (bfhi(s0.x) + bfhi(s1.x));
            v[j].z += g2.z * (bflo(s0.y) + bflo(s1.y));
            v[j].w += g2.w * (bfhi(s0.y) + bfhi(s1.y));
            ss += v[j].x * v[j].x + v[j].y * v[j].y + v[j].z * v[j].z + v[j].w * v[j].w;
        }
        ss = wave_sum(ss);
        const float rstd = rsqrtf(ss * (1.f / 1024.f) + 1e-6f);
#pragma unroll
        for (int j = 0; j < 4; ++j) {
            const int k = (lane + 64 * j) * 4;
            const float4 fw = *(const float4*)(P.in[I_FNW] + k);
            float4 o; o.x = v[j].x * rstd * fw.x; o.y = v[j].y * rstd * fw.y; o.z = v[j].z * rstd * fw.z; o.w = v[j].w * rstd * fw.w;
            *(float4*)(xr + k) = o;
        }
    }
}

__global__ void __launch_bounds__(NTB, 2) fwd_kernel(Params P) {
    extern __shared__ __attribute__((aligned(16))) char lds[];
    if (threadIdx.x < 4) ((volatile LAS unsigned*)(lds + LDS_MAIN))[threadIdx.x] = 0u;
    __syncthreads();
    XcdBarrier xbar = xcd_barrier_post((unsigned*)(P.ws + O_BAR), (volatile LAS unsigned*)(lds + LDS_MAIN));
#define SYNC() xcd_barrier(xbar)
#ifdef ONLY_PH
#define RUN_PHASE(k, call) do { if ((k) == ONLY_PH) { call; } } while (0)
#else
#define RUN_PHASE(k, call) do { if (P.lo <= (k) && (k) < P.hi) { call; if ((k) + 1 < P.hi) { SYNC(); } } } while (0)
#endif
    RUN_PHASE(0, phase0(P, lds));
    RUN_PHASE(1, phase1(P));
    RUN_PHASE(2, { InProj S; S.ws = P.ws; S.G = gridDim.x; S.c = blockIdx.x; g8::gemm_phase<InProj>((LAS unsigned char*)lds, S); });
    RUN_PHASE(3, phase3(P, lds));
    RUN_PHASE(4, phase4(P, lds));
    RUN_PHASE(5, phase5(P));
    RUN_PHASE(6, phase6(P, lds));
    RUN_PHASE(7, phase7(P, lds));
    RUN_PHASE(8, phase8(P, lds));
    RUN_PHASE(9, phase9(P, lds));
    RUN_PHASE(10, phase10(P, lds));
    RUN_PHASE(11, phase11(P));
}

extern "C" void kernel_launch(void* const* d_in, const int* in_sizes, int n_in, void* d_out, int out_size, void* d_ws, size_t ws_size,
                              hipStream_t stream) {
    static int grid_blocks = 0;
    if (!grid_blocks) {
        int dev = 0, cus = 0, per_cu = 0;
        (void)hipGetDevice(&dev);
        (void)hipDeviceGetAttribute(&cus, hipDeviceAttributeMultiprocessorCount, dev);
        (void)hipFuncSetAttribute((const void*)fwd_kernel, hipFuncAttributeMaxDynamicSharedMemorySize, LDS_BYTES);
        (void)hipOccupancyMaxActiveBlocksPerMultiprocessor(&per_cu, (const void*)fwd_kernel, NTB, LDS_BYTES);
        if (per_cu < 1) fprintf(stderr, "occupancy query says %d blocks per CU\n", per_cu);
        grid_blocks = cus;
        if (ws_size < WS_END) fprintf(stderr, "workspace too small: %zu < %zu\n", ws_size, (size_t)WS_END);
    }
    Params p{};
    for (int i = 0; i < 30; ++i) p.in[i] = (const float*)d_in[i];
    p.out = (float*)d_out; p.ws = (unsigned char*)d_ws;
    p.lo = 0; p.hi = NPHASE;
    (void)hipMemsetAsync((char*)d_ws + O_BAR, 0, XCD_BAR_WORDS * 4, stream);
    void* args[] = {&p};
    hipError_t e = hipLaunchCooperativeKernel((const void*)fwd_kernel, dim3(grid_blocks), dim3(NTB), args, LDS_BYTES, stream);
    if (e != hipSuccess) fprintf(stderr, "cooperative launch failed: %s (grid %d)\n", hipGetErrorString(e), grid_blocks);
}
```

```cpp
#include <hip/hip_runtime.h>
#include <cstdio>
#include <cstdint>

typedef unsigned short u16;
typedef __attribute__((ext_vector_type(8))) short bf16x8;
typedef __attribute__((ext_vector_type(4))) float f32x4;
typedef __attribute__((ext_vector_type(4))) unsigned u32x4;
#define LAS __attribute__((address_space(3)))

constexpr int NTB = 512;
constexpr int VLDS = 75776;
constexpr int LDS_MAIN = 2 * VLDS;
constexpr int LDS_BYTES = LDS_MAIN + 256;
constexpr int MLAT = 16384, MALL = 17408;
constexpr int NCH = 34;
constexpr int NPHASE = 12;

enum { I_X = 0, I_C, I_CTX, I_CCTX, I_WMOD, I_BMOD, I_N1W, I_WIN, I_SCW, I_SCB, I_DTB, I_ALOG, I_SSDD, I_SNW, I_MCW, I_MCB, I_WQK, I_GB,
       I_MNW, I_MSKIP, I_WOUT, I_N2W, I_RGW, I_RGB, I_REW, I_REB, I_WG, I_WU, I_WD, I_FNW };

constexpr size_t al(size_t x) { return (x + 255) & ~(size_t)255; }
constexpr size_t O_MOD = 0;
constexpr size_t O_SSQ = O_MOD + al(5 * 6144 * 4);
constexpr size_t O_CNT = O_SSQ + al(16384 * 16 * 4);
constexpr size_t O_BAR = O_CNT + 8192;
constexpr size_t O_PSD = O_BAR + 16384;
constexpr size_t O_PSG = O_PSD + al((size_t)MALL * 16 * 4);
constexpr size_t O_DT = O_PSG + al((size_t)MALL * 16 * 4);
constexpr size_t O_GI = O_DT + al((size_t)MALL * 16 * 4);
constexpr size_t O_GF = O_GI + al((size_t)MALL * 8 * 4);
constexpr size_t O_ACH = O_GF + al((size_t)MALL * 8 * 4);
constexpr size_t O_MLS = O_ACH + 16384;
constexpr size_t O_MLP = O_MLS + 16384;
constexpr size_t O_MLN = O_MLP + 16384;
constexpr size_t O_LIST = O_MLN + al(4 * 34 * 4 * 2 * 128 * 4);
constexpr size_t O_WTS = O_LIST + al(32 * 16384 * 4);
constexpr size_t O_WIN = O_WTS + al(16384 * 2 * 4);
constexpr size_t O_WOUT = O_WIN + al((size_t)3328 * 1024 * 2);
constexpr size_t O_A = O_WOUT + al((size_t)1024 * 1024 * 2);
constexpr size_t SZ_A = (size_t)MALL * 1024 * 2;
constexpr size_t O_PT = O_A + SZ_A;
constexpr size_t SZ_PT = (size_t)MALL * 1536 * 2;
constexpr size_t O_MLC1 = O_PT + SZ_PT;
constexpr size_t SZ_HALF = (size_t)MALL * 512 * 2;
constexpr size_t O_ZO = O_MLC1 + SZ_HALF;
constexpr size_t O_VT = O_ZO + SZ_A;
constexpr size_t O_BM = O_VT + SZ_HALF;
constexpr size_t SZ_Q = (size_t)MALL * 256 * 2;
constexpr size_t O_BT = O_BM + SZ_Q;
constexpr size_t O_CM = O_BT + SZ_Q;
constexpr size_t O_XT = O_CM + SZ_Q;
constexpr size_t O_KT = O_XT + SZ_HALF;
constexpr size_t O_XC = O_KT + SZ_HALF;
constexpr size_t WS_END = O_XC + SZ_HALF;
constexpr size_t O_XN = O_A, O_Q = O_A, O_K = O_A + SZ_HALF, O_T = O_A;
constexpr size_t O_ST = O_PT;
constexpr size_t O_MLC0 = O_PT + (size_t)4 * 34 * 8 * 2 * 8192 * 2;
constexpr size_t O_WGU = O_PT;
constexpr size_t O_WD = O_PT + (size_t)32 * 512 * 1024 * 2;
constexpr size_t O_SL = O_ZO;
constexpr size_t O_H = O_XT;
static_assert(O_WD + (size_t)32 * 1024 * 256 * 2 <= O_MLC1, "moe weights fit PT region");
static_assert(O_SL + (size_t)16384 * 2 * 1024 * 2 <= O_CM, "slots fit");
static_assert((size_t)(32768 + 256) * 256 * 2 <= SZ_HALF, "H fits");
static_assert(WS_END <= (size_t)256 * 1024 * 1024, "workspace");
constexpr size_t TCTX512 = (size_t)4 * 512 * 4096;
constexpr size_t TCTX256 = (size_t)4 * 256 * 4096;

struct Params { const float* in[30]; float* out; unsigned char* ws; int lo, hi; };

#define XB_TMO      128
#define XB_XCNT(j)  (256  + 64 * (j))
#define XB_XSUB(j)  (1280 + 64 * (j))
#define XB_XGEN(j)  (2304 + 64 * (j))
#define XB_TOP      3328
#define XB_TOPGEN   3392
#define XCD_BAR_WORDS 3456
#define XB_SPIN_CAP (1u << 20)
__device__ __forceinline__ unsigned xb_ld(unsigned* p)              { return __hip_atomic_load(p, __ATOMIC_RELAXED, __HIP_MEMORY_SCOPE_AGENT); }
__device__ __forceinline__ unsigned xb_add(unsigned* p, unsigned v) { return __hip_atomic_fetch_add(p, v, __ATOMIC_RELAXED, __HIP_MEMORY_SCOPE_AGENT); }
__device__ __forceinline__ unsigned xb_xcc_id() { return (unsigned)__builtin_amdgcn_s_getreg((3 << 11) | 20) & 0xFu; }
#define XB_SPIN(cond, bar) do { unsigned _sp = 0; while (cond) { __builtin_amdgcn_s_sleep(1); \
    if ((++_sp & 255u) == 0u) { if (xb_ld(&(bar)[XB_TMO])) break; if (_sp > XB_SPIN_CAP) { atomicAdd(&(bar)[XB_TMO], 1u); break; } } } } while (0)
struct XcdBarrier { unsigned* bar; unsigned x; volatile LAS unsigned* st; };
__device__ __forceinline__ XcdBarrier xcd_barrier_post(unsigned* bar, volatile LAS unsigned* st) {
    XcdBarrier b; b.bar = bar; b.x = xb_xcc_id(); b.st = st;
    if (threadIdx.x == 0) (void)xb_add(&bar[XB_XCNT(b.x)], 1u);
    return b;
}
__device__ __forceinline__ void xcd_barrier_complete(unsigned* bar, unsigned x, unsigned& nloc, unsigned& nx) {
    const unsigned G = gridDim.x * gridDim.y * gridDim.z;
    unsigned sum, cnt, mine, sp = 0u;
    for (;;) {
        sum = 0u; cnt = 0u; mine = 0u;
#pragma unroll
        for (unsigned j = 0; j < 16; ++j) { const unsigned c = xb_ld(&bar[XB_XCNT(j)]); sum += c; cnt += (c > 0u) ? 1u : 0u; mine = (j == x) ? c : mine; }
        if (sum == G) break;
        __builtin_amdgcn_s_sleep(1);
        if ((++sp & 255u) == 0u) { if (xb_ld(&bar[XB_TMO])) break; if (sp > XB_SPIN_CAP) { atomicAdd(&bar[XB_TMO], 1u); break; } }
    }
    nloc = mine > 0u ? mine : 1u; nx = cnt > 0u ? cnt : 1u;
}
__device__ __forceinline__ void xcd_barrier(const XcdBarrier& b) {
    asm volatile("s_waitcnt vmcnt(0)" ::: "memory");
    __syncthreads();
    if (threadIdx.x == 0) {
        unsigned* bar = b.bar;
        __builtin_amdgcn_s_waitcnt(0);
        unsigned nloc = b.st[0], nx = b.st[1];
        if (nloc == 0u) { xcd_barrier_complete(bar, b.x, nloc, nx); b.st[0] = nloc; b.st[1] = nx; }
        const unsigned old = xb_add(&bar[XB_XSUB(b.x)], 1u);
        const unsigned gen = old / nloc;
        if (old + 1u == (gen + 1u) * nloc) {
            __builtin_amdgcn_fence(__ATOMIC_RELEASE, "agent");
            asm volatile("s_waitcnt vmcnt(0)" ::: "memory");
            const unsigned og = xb_add(&bar[XB_TOP], 1u);
            const unsigned tg = og / nx;
            if (og + 1u == (tg + 1u) * nx) xb_add(&bar[XB_TOPGEN], 1u);
            else XB_SPIN(xb_ld(&bar[XB_TOPGEN]) == tg, bar);
            __builtin_amdgcn_fence(__ATOMIC_ACQUIRE, "agent");
            xb_add(&bar[XB_XGEN(b.x)], 1u);
            asm volatile("s_waitcnt vmcnt(0)" ::: "memory");
        } else {
            XB_SPIN(xb_ld(&bar[XB_XGEN(b.x)]) == gen, bar);
            __builtin_amdgcn_fence(__ATOMIC_ACQUIRE, "agent");
            asm volatile("s_waitcnt vmcnt(0)" ::: "memory");
        }
    }
    __syncthreads();
}

__device__ __forceinline__ u16 f2bf(float f) { unsigned u = __float_as_uint(f); u += 0x7fffu + ((u >> 16) & 1u); return (u16)(u >> 16); }
__device__ __forceinline__ float bf2f(u16 h) { return __uint_as_float(((unsigned)h) << 16); }
__device__ __forceinline__ unsigned pack2(float a, float b) { return (unsigned)f2bf(a) | ((unsigned)f2bf(b) << 16); }
__device__ __forceinline__ float bflo(unsigned u) { return __uint_as_float(u << 16); }
__device__ __forceinline__ float bfhi(unsigned u) { return __uint_as_float(u & 0xffff0000u); }
__device__ __forceinline__ float siluf(float x) { return x / (1.f + __expf(-x)); }
__device__ __forceinline__ float sigmf(float x) { return 1.f / (1.f + __expf(-x)); }
__device__ __forceinline__ float softplusf(float x) { return x > 20.f ? x : log1pf(__expf(x)); }
__device__ __forceinline__ float wave_sum(float v) {
#pragma unroll
    for (int o = 32; o > 0; o >>= 1) v += __shfl_xor(v, o);
    return v;
}
__device__ __forceinline__ int swz256(int row, int chunk) { return row * 256 + ((chunk ^ (row & 15)) << 4); }
__device__ __forceinline__ int colmajor_src_row(int R) {
    if (R >= MLAT) return R;
    const int b = R >> 12, lp = R & 4095;
    return (b << 12) + ((lp & 63) << 6) + (lp >> 6);
}

__device__ __forceinline__ void load_tile128(char* lds, int lrow0, const u16* __restrict__ g, size_t ld, int rows, int t, int nthr) {
#pragma unroll 4
    for (int q = t; q < rows * 16; q += nthr) {
        const int r = q >> 4, c = q & 15;
        const uint4 v = *(const uint4*)(g + (size_t)r * ld + c * 8);
        *(uint4*)(lds + swz256(lrow0 + r, c)) = v;
    }
}
__device__ __forceinline__ void load_tile128_scaled(char* lds, int lrow0, const u16* __restrict__ g, size_t ld, int rows, const float* w, int t, int nthr) {
#pragma unroll 2
    for (int q = t; q < rows * 16; q += nthr) {
        const int r = q >> 4, c = q & 15;
        const uint4 v = *(const uint4*)(g + (size_t)r * ld + c * 8);
        const float* ww = w + c * 8;
        uint4 o;
        o.x = pack2(bflo(v.x) * ww[0], bfhi(v.x) * ww[1]);
        o.y = pack2(bflo(v.y) * ww[2], bfhi(v.y) * ww[3]);
        o.z = pack2(bflo(v.z) * ww[4], bfhi(v.z) * ww[5]);
        o.w = pack2(bflo(v.w) * ww[6], bfhi(v.w) * ww[7]);
        *(uint4*)(lds + swz256(lrow0 + r, c)) = o;
    }
}
template <int MI, int NJ>
__device__ __forceinline__ void lds_mma(const char* A, const char* B, int arow0, int brow0, f32x4 (&acc)[MI][NJ], int lane) {
#pragma unroll 1
    for (int kk = 0; kk < 4; ++kk) {
        const int chunk = kk * 4 + (lane >> 4);
        bf16x8 a[MI], b[NJ];
#pragma unroll
        for (int i = 0; i < MI; ++i) { const int row = arow0 + i * 16 + (lane & 15); a[i] = *(const bf16x8*)(A + swz256(row, chunk)); }
#pragma unroll
        for (int j = 0; j < NJ; ++j) { const int row = brow0 + j * 16 + (lane & 15); b[j] = *(const bf16x8*)(B + swz256(row, chunk)); }
#pragma unroll
        for (int i = 0; i < MI; ++i)
#pragma unroll
            for (int j = 0; j < NJ; ++j) acc[i][j] = __builtin_amdgcn_mfma_f32_16x16x32_bf16(a[i], b[j], acc[i][j], 0, 0, 0);
    }
}
template <int MI, int NJ>
__device__ __forceinline__ void zero_acc(f32x4 (&acc)[MI][NJ]) {
#pragma unroll
    for (int i = 0; i < MI; ++i)
#pragma unroll
        for (int j = 0; j < NJ; ++j) acc[i][j] = f32x4{0.f, 0.f, 0.f, 0.f};
}
template <int OP>
__device__ __forceinline__ float scan_pair(float v, float* buf, int t) {
    const int idx = t & 127, base = t & 128;
    const bool act = t < 256;
    if (act) buf[t] = v;
    __syncthreads();
#pragma unroll 1
    for (int off = 1; off < 128; off <<= 1) {
        float o = OP ? -INFINITY : 0.f;
        if (act && idx >= off) o = buf[base + idx - off];
        __syncthreads();
        v = OP ? fmaxf(v, o) : v + o;
        if (act) buf[t] = v;
        __syncthreads();
    }
    return v;
}

__device__ __forceinline__ void transpose_tile(float* tile, const float* __restrict__ src, int ld_src, int k0, int n0, int ncount,
                                               u16* dst, size_t dst_row0, int ld_dst, const float* __restrict__ scale, int scale_kmax, int t) {
    const int n = t & 63, kq = t >> 6;
#pragma unroll 4
    for (int i = 0; i < 16; ++i) {
        const int k = i * 4 + kq;
        float v = 0.f;
        if (n < ncount) { v = src[(size_t)(k0 + k) * ld_src + n0 + n]; if (scale && (k0 + k) < scale_kmax) v *= scale[k0 + k]; }
        tile[k * 65 + n] = v;
    }
    __syncthreads();
#pragma unroll
    for (int i = 0; i < 2; ++i) {
        const int q = t + 256 * i, nn = q >> 3, kc = q & 7;
        if (nn < ncount) {
            const float* p = tile + (kc * 8) * 65 + nn;
            uint4 o;
            o.x = pack2(p[0], p[65]); o.y = pack2(p[130], p[195]); o.z = pack2(p[260], p[325]); o.w = pack2(p[390], p[455]);
            *(uint4*)(dst + (dst_row0 + nn) * (size_t)ld_dst + k0 + kc * 8) = o;
        }
    }
    __syncthreads();
}

__device__ __forceinline__ void transpose_tile_w(float* tile, const float* __restrict__ src, int ld_src, int k0, int n0,
                                                 u16* dst, size_t dst_row0, int ld_dst, const float* __restrict__ scale, int scale_kmax, int t) {
    float4 v[8];
#pragma unroll
    for (int i = 0; i < 8; ++i) { const int q = t + 256 * i, kr = q >> 5, nq = q & 31; v[i] = *(const float4*)(src + (size_t)(k0 + kr) * ld_src + n0 + nq * 4); }
#pragma unroll
    for (int i = 0; i < 8; ++i) {
        const int q = t + 256 * i, kr = q >> 5, nq = q & 31;
        float sc = 1.f;
        if (scale && (k0 + kr) < scale_kmax) sc = scale[k0 + kr];
        float* p = tile + kr * 129 + nq * 4;
        p[0] = v[i].x * sc; p[1] = v[i].y * sc; p[2] = v[i].z * sc; p[3] = v[i].w * sc;
    }
    __syncthreads();
#pragma unroll
    for (int i = 0; i < 4; ++i) {
        const int q = t + 256 * i, nn = q >> 3, kc = q & 7;
        const float* p = tile + (kc * 8) * 129 + nn;
        uint4 o;
        o.x = pack2(p[0], p[129]); o.y = pack2(p[258], p[387]); o.z = pack2(p[516], p[645]); o.w = pack2(p[774], p[903]);
        *(uint4*)(dst + (dst_row0 + nn) * (size_t)ld_dst + k0 + kc * 8) = o;
    }
    __syncthreads();
}

namespace g8 {
constexpr int BM = 256, BK = 64, HALF = 128, HTB = HALF * BK * 2, STAGE_BYTES = 8 * HTB;
__device__ __forceinline__ int lds_byte(int r, int c) { const int st = (r >> 4) * 2 + (c >> 5), rr = r & 15, cc = c & 31, ob = rr * 64 + cc * 2; return st * 1024 + (ob ^ (((ob >> 9) & 1) << 5)); }
__device__ __forceinline__ void stage_rc(int b, int& R, int& C) { const int st = b / 1024, sb = b % 1024, swz = sb ^ (((sb >> 9) & 1) << 5); R = (st >> 1) * 16 + swz / 64; C = (st & 1) * 32 + (swz % 64) / 2; }
__device__ __forceinline__ int perm32(int rho) { const int n = rho >> 4, i = rho & 15; return 8 * (i >> 2) + 4 * n + (i & 3); }
__device__ __forceinline__ unsigned cvt_pk_bf16(float lo, float hi) { unsigned r; asm volatile("v_cvt_pk_bf16_f32 %0, %1, %2" : "=v"(r) : "v"(lo), "v"(hi)); return r; }
typedef f32x4 Acc[2][2][4][2];

template <class Prob>
__device__ __forceinline__ void gemm_phase(LAS unsigned char* lds, const Prob& S) {
    const int tid = threadIdx.x, wid = __builtin_amdgcn_readfirstlane(tid >> 6), lane = tid & 63, wr = wid >> 2, wc = wid & 3, fr = lane & 15, fq = lane >> 4;
    constexpr int nt = Prob::K / BK;
    const size_t kstep = (size_t)(BK * 2);
    const unsigned ldsw = (unsigned)wid * 1024u;
    const int aoff = lds_byte(wr * 64 + fr, fq * 8), boff = lds_byte(wc * 32 + fr, fq * 8);
#define G8_SA(b, h) (((b) * 2 + (h)) * HTB)
#define G8_SB(b, h) ((4 + (b) * 2 + (h)) * HTB)
#define G8_STAGE(bufoff, gbase, voff) do { _Pragma("unroll") for (int _i = 0; _i < 2; ++_i) \
        __builtin_amdgcn_global_load_lds((const unsigned*)((const char*)(gbase) + (voff)[_i]), (LAS unsigned*)(lds + (bufoff) + ldsw + _i * 8192), 16, 0, 0); } while (0)
#define G8_LDA(dst, b, h) do { _Pragma("unroll") for (int m = 0; m < 4; ++m) _Pragma("unroll") for (int k = 0; k < 2; ++k) dst[m][k] = *(const LAS bf16x8*)(lds + G8_SA(b, h) + aoff + m * 2048 + k * 1024); } while (0)
#define G8_LDB(dst, b, h) do { _Pragma("unroll") for (int n = 0; n < 2; ++n) _Pragma("unroll") for (int k = 0; k < 2; ++k) dst[n][k] = *(const LAS bf16x8*)(lds + G8_SB(b, h) + boff + n * 2048 + k * 1024); } while (0)
#define G8_MMA(ai, bj, At, Bt) do { __builtin_amdgcn_s_setprio(1); _Pragma("unroll") for (int m = 0; m < 4; ++m) _Pragma("unroll") for (int n = 0; n < 2; ++n) _Pragma("unroll") for (int k = 0; k < 2; ++k) \
        acc[ai][bj][m][n] = __builtin_amdgcn_mfma_f32_16x16x32_bf16(Bt[n][k], At[m][k], acc[ai][bj][m][n], 0, 0, 0); __builtin_amdgcn_s_setprio(0); } while (0)
#define G8_WAIT_V(n) asm volatile("s_waitcnt vmcnt(" #n ")" ::: "memory")
#define G8_WAIT_L(n) asm volatile("s_waitcnt lgkmcnt(" #n ")" ::: "memory")
#define G8_BAR __builtin_amdgcn_s_barrier()
#define G8_SCHED __builtin_amdgcn_sched_barrier(0)
    typename Prob::Unit cur, nxt; int ui = 0;
    if (!S.next(0, cur)) return;
    Acc acc;
#pragma unroll
    for (int a = 0; a < 2; ++a)
#pragma unroll
        for (int b = 0; b < 2; ++b)
#pragma unroll
            for (int m = 0; m < 4; ++m)
#pragma unroll
                for (int n = 0; n < 2; ++n) acc[a][b][m][n] = (f32x4){0.f, 0.f, 0.f, 0.f};
    bf16x8 At[4][2], B0[2][2], B1[2][2];
    unsigned cOA[2][2], cOB[2][2], nOA[2][2], nOB[2][2];
    S.offs(cur, tid, cOA, cOB);
    const char* cA = S.baseA(cur); const char* cB = S.baseB(cur);
    G8_STAGE(G8_SB(0, 0), cB, cOB[0]); G8_STAGE(G8_SA(0, 0), cA, cOA[0]); G8_STAGE(G8_SB(0, 1), cB, cOB[1]); G8_STAGE(G8_SA(0, 1), cA, cOA[1]);
    if (wr == 1) G8_BAR;
    G8_WAIT_V(4); G8_BAR;
    G8_STAGE(G8_SB(1, 0), cB + kstep, cOB[0]); G8_STAGE(G8_SA(1, 0), cA + kstep, cOA[0]); G8_STAGE(G8_SB(1, 1), cB + kstep, cOB[1]);
    G8_WAIT_V(6); G8_BAR;
    for (;;) {
        const bool has_next = S.next(ui + 1, nxt);
        const char* nA = cA; const char* nB = cB;
#pragma unroll
        for (int h = 0; h < 2; ++h)
#pragma unroll
            for (int i = 0; i < 2; ++i) { nOA[h][i] = cOA[h][i]; nOB[h][i] = cOB[h][i]; }
        if (has_next) { S.offs(nxt, tid, nOA, nOB); nA = S.baseA(nxt); nB = S.baseB(nxt); }
#pragma unroll 1
        for (int t = 0; t < nt; t += 2) {
            const bool last = (t == nt - 2);
            if (Prob::MIDT > 0 && t == Prob::MIDT) S.mid(acc, cur, wr, fr);
            const char* a1 = cA + (size_t)(t + 1) * kstep;
            const char* a2 = last ? nA : cA + (size_t)(t + 2) * kstep; const char* b2 = last ? nB : cB + (size_t)(t + 2) * kstep;
            const char* a3 = a2 + kstep; const char* b3 = b2 + kstep;
            unsigned xA[2][2], xB[2][2];
#pragma unroll
            for (int h = 0; h < 2; ++h)
#pragma unroll
                for (int i = 0; i < 2; ++i) { xA[h][i] = last ? nOA[h][i] : cOA[h][i]; xB[h][i] = last ? nOB[h][i] : cOB[h][i]; }
            G8_LDB(B0, 0, 0); G8_SCHED; G8_LDA(At, 0, 0); G8_STAGE(G8_SA(1, 1), a1, cOA[1]);
            G8_WAIT_L(8); G8_BAR; G8_WAIT_L(0); G8_MMA(0, 0, At, B0); G8_BAR; G8_SCHED;
            G8_LDB(B1, 0, 1); G8_STAGE(G8_SB(0, 0), b2, xB[0]);
            G8_BAR; G8_WAIT_L(0); G8_MMA(0, 1, At, B1); G8_BAR;
            G8_LDA(At, 0, 1); G8_STAGE(G8_SA(0, 0), a2, xA[0]);
            G8_BAR; G8_WAIT_L(0); G8_MMA(1, 0, At, B0); G8_BAR; G8_SCHED;
            G8_STAGE(G8_SB(0, 1), b2, xB[1]);
            G8_WAIT_V(6); G8_BAR; G8_MMA(1, 1, At, B1); G8_BAR;
            G8_LDB(B0, 1, 0); G8_SCHED; G8_LDA(At, 1, 0); G8_STAGE(G8_SA(0, 1), a2, xA[1]);
            G8_WAIT_L(8); G8_BAR; G8_WAIT_L(0); G8_MMA(0, 0, At, B0); G8_BAR; G8_SCHED;
            G8_LDB(B1, 1, 1); G8_STAGE(G8_SB(1, 0), b3, xB[0]);
            G8_BAR; G8_WAIT_L(0); G8_MMA(0, 1, At, B1); G8_BAR;
            G8_LDA(At, 1, 1); G8_STAGE(G8_SA(1, 0), a3, xA[0]);
            G8_BAR; G8_WAIT_L(0); G8_MMA(1, 0, At, B0); G8_BAR; G8_SCHED;
            G8_STAGE(G8_SB(1, 1), b3, xB[1]);
            G8_WAIT_V(6); G8_BAR; G8_MMA(1, 1, At, B1); G8_BAR;
        }
        S.epi(acc, cur, wr, wc, fr, fq);
        if (!has_next) break;
#pragma unroll
        for (int a = 0; a < 2; ++a)
#pragma unroll
            for (int b = 0; b < 2; ++b)
#pragma unroll
                for (int m = 0; m < 4; ++m)
#pragma unroll
                    for (int n = 0; n < 2; ++n) acc[a][b][m][n] = (f32x4){0.f, 0.f, 0.f, 0.f};
        cur = nxt; cA = nA; cB = nB; ++ui;
#pragma unroll
        for (int h = 0; h < 2; ++h)
#pragma unroll
            for (int i = 0; i < 2; ++i) { cOA[h][i] = nOA[h][i]; cOB[h][i] = nOB[h][i]; }
    }
    G8_WAIT_V(0);
    if (wr == 0) G8_BAR;
    G8_BAR;
#undef G8_SA
#undef G8_SB
#undef G8_STAGE
#undef G8_LDA
#undef G8_LDB
#undef G8_MMA
#undef G8_WAIT_V
#undef G8_WAIT_L
#undef G8_BAR
#undef G8_SCHED
}
__device__ __forceinline__ void dense_unit(int wgid, int nM, int nN, int& pm, int& pn) {
    const int nwg = nM * nN, NXCD = 8, WGM = 8;
    { const int q = nwg / NXCD, r = nwg % NXCD, xcd = wgid % NXCD, off = wgid / NXCD; wgid = (xcd < r ? xcd * (q + 1) : r * (q + 1) + (xcd - r) * q) + off; }
    const int nig = WGM * nN, gid = wgid / nig, fm = gid * WGM, gsz = (nM - fm) < WGM ? (nM - fm) : WGM;
    pm = fm + ((wgid % nig) % gsz); pn = (wgid % nig) / gsz;
}
}

__device__ void phase0(const Params& P, char* lds_all) {
    unsigned char* ws = P.ws;
    const int vb = threadIdx.x >> 8, t = threadIdx.x & 255;
    char* lds = lds_all + vb * VLDS;
    float* tile = (float*)lds;
    const int NU = 744;
    for (int u = blockIdx.x * 2 + vb; u < NU; u += gridDim.x * 2) {
        if (u < 384) {
            int nt, v, n0b, drb;
            if (u < 192) { v = u; n0b = 0; drb = 0; }
            else if (u < 256) { v = u - 192; n0b = 1552; drb = 1536; }
            else if (u < 320) { v = u - 256; n0b = 2576; drb = 2048; }
            else { v = u - 320; n0b = 2064; drb = 2816; }
            nt = v >> 4;
            transpose_tile_w(tile, P.in[I_WIN], 3104, (v & 15) * 64, n0b + nt * 128, (u16*)(ws + O_WIN), drb + nt * 128, 1024, nullptr, 0, t);
        } else if (u < 416) {
            const int v = u - 384;
            if (v < 16) transpose_tile(tile, P.in[I_WIN], 3104, v * 64, 1536, 16, (u16*)(ws + O_WIN), 2560, 1024, nullptr, 0, t);
            else transpose_tile(tile, P.in[I_WIN], 3104, (v - 16) * 64, 3088, 16, (u16*)(ws + O_WIN), 2576, 1024, nullptr, 0, t);
        } else if (u < 544) {
            const int v = u - 416, nt = v >> 4;
            transpose_tile_w(tile, P.in[I_WOUT], 1024, (v & 15) * 64, nt * 128, (u16*)(ws + O_WOUT), nt * 128, 1024, P.in[I_SNW], 512, t);
        } else if (u < 552) {
            const int base = (u - 544) * 4096;
            for (int i = 0; i < 16; ++i) {
                const int idx = base + t + 256 * i;
                if (idx < 224 * 128) *(uint4*)(ws + O_WIN + ((size_t)(2592 + (idx >> 7)) * 1024 + (idx & 127) * 8) * 2) = make_uint4(0, 0, 0, 0);
            }
        } else {
            const int c0 = (u - 552) * 32;
            float* sc = (float*)lds;
            float* red = sc + 5 * 1024;
            for (int i = t; i < 5 * 1024; i += 256) {
                const int r = i >> 10, k = i & 1023;
                const float v = r < 4 ? P.in[I_C][r * 1024 + k] : P.in[I_CCTX][k];
                sc[i] = siluf(v);
            }
            __syncthreads();
            const int cq = t & 7, kg = t >> 3;
            float4 a0 = {0, 0, 0, 0}, a1 = a0, a2 = a0, a3 = a0, a4 = a0;
            const float* wp = P.in[I_WMOD] + (size_t)(kg * 32) * 6144 + c0 + cq * 4;
#pragma unroll 16
            for (int k = 0; k < 32; ++k) {
                const float4 wv = *(const float4*)(wp + (size_t)k * 6144);
                const int kk = kg * 32 + k;
                const float s0 = sc[kk], s1 = sc[1024 + kk], s2 = sc[2048 + kk], s3 = sc[3072 + kk], s4 = sc[4096 + kk];
                a0.x += s0 * wv.x; a0.y += s0 * wv.y; a0.z += s0 * wv.z; a0.w += s0 * wv.w;
                a1.x += s1 * wv.x; a1.y += s1 * wv.y; a1.z += s1 * wv.z; a1.w += s1 * wv.w;
                a2.x += s2 * wv.x; a2.y += s2 * wv.y; a2.z += s2 * wv.z; a2.w += s2 * wv.w;
                a3.x += s3 * wv.x; a3.y += s3 * wv.y; a3.z += s3 * wv.z; a3.w += s3 * wv.w;
                a4.x += s4 * wv.x; a4.y += s4 * wv.y; a4.z += s4 * wv.z; a4.w += s4 * wv.w;
            }
            *(float4*)(red + ((kg * 5 + 0) * 32) + cq * 4) = a0; *(float4*)(red + ((kg * 5 + 1) * 32) + cq * 4) = a1;
            *(float4*)(red + ((kg * 5 + 2) * 32) + cq * 4) = a2; *(float4*)(red + ((kg * 5 + 3) * 32) + cq * 4) = a3;
            *(float4*)(red + ((kg * 5 + 4) * 32) + cq * 4) = a4;
            __syncthreads();
            if (t < 160) {
                const int r = t >> 5, cc = t & 31;
                float s = P.in[I_BMOD][c0 + cc];
#pragma unroll
                for (int g = 0; g < 32; ++g) s += red[(g * 5 + r) * 32 + cc];
                ((float*)(ws + O_MOD))[r * 6144 + c0 + cc] = s;
            }
            __syncthreads();
        }
    }
    if (blockIdx.x == 0 && threadIdx.x < 32) ((int*)(ws + O_CNT))[threadIdx.x * 64] = 0;
}

__device__ void phase1(const Params& P) {
    unsigned char* ws = P.ws;
    const int lane = threadIdx.x & 63;
    const int gw = blockIdx.x * 8 + (threadIdx.x >> 6), nw = gridDim.x * 8;
    const float* mod = (const float*)(ws + O_MOD);
    u16* xn = (u16*)(ws + O_XN);
    for (int row = gw; row < MALL; row += nw) {
        const float* xr = row < MLAT ? P.in[I_X] + (size_t)row * 1024 : P.in[I_CTX] + (size_t)(row - MLAT) * 1024;
        const int mb = row < MLAT ? (row >> 12) : 4;
        float4 v[4]; float ss = 0.f;
#pragma unroll
        for (int j = 0; j < 4; ++j) { v[j] = ((const float4*)xr)[lane + 64 * j]; ss += v[j].x * v[j].x + v[j].y * v[j].y + v[j].z * v[j].z + v[j].w * v[j].w; }
        ss = wave_sum(ss);
        const float rstd = rsqrtf(ss * (1.f / 1024.f) + 1e-6f);
#pragma unroll
        for (int j = 0; j < 4; ++j) {
            const int k = (lane + 64 * j) * 4;
            const float4 nwv = *(const float4*)(P.in[I_N1W] + k);
            const float4 sh = *(const float4*)(mod + mb * 6144 + k);
            const float4 sc = *(const float4*)(mod + mb * 6144 + 1024 + k);
            const float h0 = v[j].x * rstd * nwv.x * (1.f + sc.x) + sh.x;
            const float h1 = v[j].y * rstd * nwv.y * (1.f + sc.y) + sh.y;
            const float h2 = v[j].z * rstd * nwv.z * (1.f + sc.z) + sh.z;
            const float h3 = v[j].w * rstd * nwv.w * (1.f + sc.w) + sh.w;
            uint2 o; o.x = pack2(h0, h1); o.y = pack2(h2, h3);
            *(uint2*)(xn + (size_t)row * 1024 + k) = o;
        }
    }
}

struct InProj {
    static constexpr int K = 1024; static constexpr bool PERM = true; static constexpr int MIDT = 0;
    struct Unit { int pm, pn, vt; };
    const unsigned char* ws; int G, c;
    __device__ __forceinline__ bool next(int i, Unit& u) const {
        const int L = i * G + c;
        if (L >= 884) return false;
        if (L < 748) { u.vt = 0; g8::dense_unit(L, 68, 11, u.pm, u.pn); }
        else { const int v = L - 748; u.vt = 1; u.pm = v / 68; u.pn = v % 68; }
        return true;
    }
    __device__ __forceinline__ const char* baseA(const Unit& u) const { return (const char*)(ws + (u.vt ? O_WIN : O_XN)); }
    __device__ __forceinline__ const char* baseB(const Unit& u) const { return (const char*)(ws + (u.vt ? O_XN : O_WIN)); }
    __device__ __forceinline__ void offs(const Unit& u, int tid_, unsigned (&oa)[2][2], unsigned (&ob)[2][2]) const {
        int R[2], C[2];
        { int tq = tid_; asm volatile("" : "+v"(tq)); g8::stage_rc(tq * 16, R[0], C[0]); g8::stage_rc(tq * 16 + 8192, R[1], C[1]); }
#pragma unroll
        for (int h = 0; h < 2; ++h)
#pragma unroll
            for (int i = 0; i < 2; ++i) {
                const int Rb = (R[i] & ~31) + g8::perm32(R[i] & 31);
                if (!u.vt) {
                    int ar = u.pm * 256 + h * 128 + R[i];
                    if (u.pn == 6 || u.pn == 7) ar = colmajor_src_row(ar);
                    oa[h][i] = (unsigned)(ar * 1024 + C[i]) * 2u;
                    ob[h][i] = (unsigned)((u.pn * 256 + h * 128 + Rb) * 1024 + C[i]) * 2u;
                } else {
                    oa[h][i] = (unsigned)((2816 + u.pm * 256 + h * 128 + R[i]) * 1024 + C[i]) * 2u;
                    ob[h][i] = (unsigned)(colmajor_src_row(u.pn * 256 + h * 128 + Rb) * 1024 + C[i]) * 2u;
                }
            }
    }
    __device__ __forceinline__ void mid(g8::Acc&, const Unit&, int, int) const {}
    __device__ __forceinline__ void epi(g8::Acc& acc, const Unit& u, int wr, int wc, int fr, int fq) const {
        unsigned char* w = (unsigned char*)ws;
        const int row0 = u.pm * 256 + wr * 64 + fr;
        const int col0 = wc * 32 + 8 * fq;
        if (u.vt) {
            const int tok0 = u.pn * 256 + col0;
#pragma unroll
            for (int ai = 0; ai < 2; ++ai)
#pragma unroll
                for (int m = 0; m < 4; ++m) {
                    const int ch = row0 + ai * 128 + m * 16;
#pragma unroll
                    for (int bj = 0; bj < 2; ++bj) {
                        const int tk = tok0 + bj * 128;
                        u16* d;
                        if (tk < MLAT) d = (u16*)(w + O_VT) + ((size_t)((tk >> 12) * 512 + ch)) * 4096 + (tk & 4095);
                        else { const int tc = tk - MLAT; d = (u16*)(w + O_VT) + TCTX512 + ((size_t)((tc >> 8) * 512 + ch)) * 256 + (tc & 255); }
                        const f32x4 v0 = acc[ai][bj][m][0], v1 = acc[ai][bj][m][1];
                        u32x4 o; o.x = g8::cvt_pk_bf16(v0[0], v0[1]); o.y = g8::cvt_pk_bf16(v0[2], v0[3]); o.z = g8::cvt_pk_bf16(v1[0], v1[1]); o.w = g8::cvt_pk_bf16(v1[2], v1[3]);
                        *(u32x4*)d = o;
                    }
                }
            return;
        }
        if (u.pn == 10) {
            if (wc == 0) {
                float* dst = (float*)(w + (fq < 2 ? O_PSD : O_PSG)) + (fq & 1) * 8;
#pragma unroll
                for (int ai = 0; ai < 2; ++ai)
#pragma unroll
                    for (int m = 0; m < 4; ++m) {
                        float* d = dst + (size_t)(row0 + ai * 128 + m * 16) * 16;
                        *(f32x4*)d = acc[ai][0][m][0];
                        *(f32x4*)(d + 4) = acc[ai][0][m][1];
                    }
            }
            return;
        }
        u16* base; int ld;
        if (u.pn < 2) { base = (u16*)(w + O_ZO) + u.pn * 256; ld = 1024; }
        else if (u.pn < 6) { base = (u16*)(w + O_PT) + (u.pn - 2) * 256; ld = 1536; }
        else if (u.pn < 8) { base = (u16*)(w + O_PT) + 1024 + (u.pn - 6) * 256; ld = 1536; }
        else { base = (u16*)(w + O_ZO) + 512 + (u.pn - 8) * 256; ld = 1024; }
#pragma unroll
        for (int ai = 0; ai < 2; ++ai)
#pragma unroll
            for (int m = 0; m < 4; ++m) {
                u16* rowp = base + (size_t)(row0 + ai * 128 + m * 16) * ld + col0;
#pragma unroll
                for (int bj = 0; bj < 2; ++bj) {
                    const f32x4 v0 = acc[ai][bj][m][0], v1 = acc[ai][bj][m][1];
                    u32x4 o; o.x = g8::cvt_pk_bf16(v0[0], v0[1]); o.y = g8::cvt_pk_bf16(v0[2], v0[3]); o.z = g8::cvt_pk_bf16(v1[0], v1[1]); o.w = g8::cvt_pk_bf16(v1[2], v1[3]);
                    *(u32x4*)(rowp + bj * 128) = o;
                }
            }
    }
};

__device__ void phase3(const Params& P, char* lds_all) {
    unsigned char* ws = P.ws;
    const int vb = threadIdx.x >> 8, t = threadIdx.x & 255;
    char* lds = lds_all + vb * VLDS;
    u16* raw = (u16*)lds;
    float* xcl = (float*)(lds + 132 * 128);
    const u16* pt = (const u16*)(ws + O_PT);
    const int NCONV = 136 * 24;
    const int NU = NCONV + 136;
    for (int u = blockIdx.x * 2 + vb; u < NU; u += gridDim.x * 2) {
        if (u >= NCONV) {
            const int ct = u - NCONV, b = ct / NCH, cc = ct % NCH;
            const int rb = cc < 2 ? MLAT + b * 256 + cc * 128 : b * 4096 + (cc - 2) * 128;
            const int row = rb + (t >> 1), half = t & 1;
            const float* psd = (const float*)(ws + O_PSD) + (size_t)row * 16 + half * 8;
            float* dt = (float*)(ws + O_DT) + (size_t)row * 16 + half * 8;
#pragma unroll
            for (int j = 0; j < 8; ++j) dt[j] = softplusf(psd[j] + P.in[I_DTB][half * 8 + j]);
            const float* psg = (const float*)(ws + O_PSG) + (size_t)colmajor_src_row(row) * 16;
            if (half == 0) {
                float* gi = (float*)(ws + O_GI) + (size_t)row * 8;
#pragma unroll
                for (int j = 0; j < 8; ++j) gi[j] = psg[j] + P.in[I_GB][j];
            } else {
                float* gf = (float*)(ws + O_GF) + (size_t)row * 8;
#pragma unroll
                for (int j = 0; j < 8; ++j) { const float xx = psg[8 + j] + P.in[I_GB][8 + j]; gf[j] = fminf(xx, 0.f) - log1pf(__expf(-fabsf(xx))); }
            }
            continue;
        }
        const int ct = u / 24, cgp = u % 24;
        const int b = ct / NCH, cc = ct % NCH;
        const bool isctx = cc < 2;
        const int L = isctx ? 256 : 4096;
        const int lpos = isctx ? cc * 128 : (cc - 2) * 128;
        const int rb = isctx ? MLAT + b * 256 + cc * 128 : b * 4096 + (cc - 2) * 128;
        const int sb = rb - lpos;
        const bool isml = cgp >= 16;
        const int pcol = isml ? 1024 + (cgp - 16) * 64 : cgp * 64;
        for (int q = t; q < 132 * 8; q += 256) {
            const int r = q >> 3, c = q & 7;
            const int l = lpos - 2 + r;
            const int lc = l < 0 ? 0 : (l >= L ? L - 1 : l);
            uint4 v = *(const uint4*)(pt + (size_t)(sb + lc) * 1536 + pcol + c * 8);
            if (l != lc) v = make_uint4(0, 0, 0, 0);
            *(uint4*)(raw + r * 64 + c * 8) = v;
        }
        __syncthreads();
        const int ch = t & 63, tg = t >> 6;
        const float* cw = isml ? P.in[I_MCW] + (cgp - 16) * 64 + ch : P.in[I_SCW] + cgp * 64 + ch;
        const int cwld = isml ? 512 : 1024;
        const float w0 = cw[0], w1 = cw[cwld], w2 = cw[2 * cwld], w3 = cw[3 * cwld], w4 = cw[4 * cwld];
        const float bias = isml ? P.in[I_MCB][(cgp - 16) * 64 + ch] : P.in[I_SCB][cgp * 64 + ch];
        const int tok0 = tg * 32;
        float x0 = bf2f(raw[(tok0 + 0) * 64 + ch]), x1 = bf2f(raw[(tok0 + 1) * 64 + ch]), x2 = bf2f(raw[(tok0 + 2) * 64 + ch]), x3 = bf2f(raw[(tok0 + 3) * 64 + ch]);
        if (!isml) {
            u16* tdst = nullptr; u16* ndst = nullptr;
            if (cgp < 8) {
                const int chg = cgp * 64 + ch;
                tdst = (u16*)(ws + O_XT) + (isctx ? TCTX512 + ((size_t)(b * 512 + chg)) * 256 : ((size_t)(b * 512 + chg)) * 4096) + lpos + tok0;
            } else if (cgp < 12) {
                const int gn = (cgp - 8) * 64 + ch;
                tdst = (u16*)(ws + O_BT) + (isctx ? TCTX256 + ((size_t)(b * 256 + gn)) * 256 : ((size_t)(b * 256 + gn)) * 4096) + lpos + tok0;
                ndst = (u16*)(ws + O_BM) + (size_t)(rb + tok0) * 256 + gn;
            } else {
                const int gn = (cgp - 12) * 64 + ch;
                ndst = (u16*)(ws + O_CM) + (size_t)(rb + tok0) * 256 + gn;
            }
#pragma unroll
            for (int o8 = 0; o8 < 4; ++o8) {
                float ov[8];
#pragma unroll
                for (int j = 0; j < 8; ++j) {
                    const int tok = tok0 + o8 * 8 + j;
                    const float x4 = bf2f(raw[(tok + 4) * 64 + ch]);
                    const float cv = bias + w0 * x0 + w1 * x1 + w2 * x2 + w3 * x3 + w4 * x4;
                    ov[j] = siluf(cv);
                    x0 = x1; x1 = x2; x2 = x3; x3 = x4;
                }
                if (tdst) { uint4 o; o.x = pack2(ov[0], ov[1]); o.y = pack2(ov[2], ov[3]); o.z = pack2(ov[4], ov[5]); o.w = pack2(ov[6], ov[7]); *(uint4*)(tdst + o8 * 8) = o; }
                if (ndst) {
#pragma unroll
                    for (int j = 0; j < 8; ++j) ndst[(size_t)(o8 * 8 + j) * 256] = f2bf(ov[j]);
                }
            }
            __syncthreads();
        } else {
            const int mg = cgp - 16;
            u16* xcd = (u16*)(ws + O_XC) + (size_t)(rb + tok0) * 512 + mg * 64 + ch;
#pragma unroll 8
            for (int j = 0; j < 32; ++j) {
                const int tok = tok0 + j;
                const float x4 = bf2f(raw[(tok + 4) * 64 + ch]);
                const float cv = bias + w0 * x0 + w1 * x1 + w2 * x2 + w3 * x3 + w4 * x4;
                const float sv = siluf(cv);
                xcl[tok * 64 + ch] = sv;
                xcd[(size_t)j * 512] = f2bf(sv);
                x0 = x1; x1 = x2; x2 = x3; x3 = x4;
            }
            __syncthreads();
            const int n = ch >> 2, kk = ch & 3, ng = mg * 16 + n;
            const float* wq = P.in[I_WQK] + ((size_t)(0 * 128 + ng) * 4) * 4 + kk;
            const float* wk = P.in[I_WQK] + ((size_t)(1 * 128 + ng) * 4) * 4 + kk;
            const float q0 = wq[0], q1 = wq[4], q2 = wq[8], q3 = wq[12];
            const float k0 = wk[0], k1 = wk[4], k2 = wk[8], k3 = wk[12];
            const int chg = mg * 64 + ch;
            u16* qd = (u16*)(ws + O_Q) + (size_t)(rb + tok0) * 512 + chg;
            u16* kd = (u16*)(ws + O_K) + (size_t)(rb + tok0) * 512 + chg;
            u16* ktd = (u16*)(ws + O_KT) + (isctx ? TCTX512 + ((size_t)(b * 512 + chg)) * 256 : ((size_t)(b * 512 + chg)) * 4096) + lpos + tok0;
#pragma unroll
            for (int o8 = 0; o8 < 4; ++o8) {
                float kv[8];
#pragma unroll
                for (int j = 0; j < 8; ++j) {
                    const int tok = tok0 + o8 * 8 + j;
                    const float4 xv = *(const float4*)(xcl + tok * 64 + n * 4);
                    const float qv = xv.x * q0 + xv.y * q1 + xv.z * q2 + xv.w * q3;
                    kv[j] = (xv.x * k0 + xv.y * k1 + xv.z * k2 + xv.w * k3) * 0.08838834764831845f;
                    qd[(size_t)(o8 * 8 + j) * 512] = f2bf(qv);
                    kd[(size_t)(o8 * 8 + j) * 512] = f2bf(kv[j]);
                }
                uint4 o; o.x = pack2(kv[0], kv[1]); o.y = pack2(kv[2], kv[3]); o.z = pack2(kv[4], kv[5]); o.w = pack2(kv[6], kv[7]);
                *(uint4*)(ktd + o8 * 8) = o;
            }
            __syncthreads();
        }
    }
}

__device__ void phase4(const Params& P, char* lds_all) {
    unsigned char* ws = P.ws;
    const int vb = threadIdx.x >> 8, t0 = threadIdx.x & 255;
    char* lds = lds_all + vb * VLDS;
    char* T0 = lds; char* T1 = lds + 32768;
    float* sc = (float*)(lds + 65536);
    float* sbuf = sc;
    float* wA = sc + 256;
    float* wB = sc + 384;
    const int NSSD = 4 * NCH * 8, NML = 4 * NCH * 4;
    for (int u = blockIdx.x * 2 + vb; u < NSSD + NML; u += gridDim.x * 2) {
        int t = t0; asm volatile("" : "+v"(t));
        const int lane = t & 63, w = t >> 6, wm = w >> 1, wn = w & 1;
        if (u < NSSD) {
            const int h = u & 7, ct = u >> 3, b = ct / NCH, cc = ct % NCH;
            const bool isctx = cc < 2;
            const int L = isctx ? 256 : 4096;
            const int lpos = isctx ? cc * 128 : (cc - 2) * 128;
            const int rb = isctx ? MLAT + b * 256 + cc * 128 : b * 4096 + (cc - 2) * 128;
            const int dir = t >> 7, idx = t & 127;
            const int l = dir ? 127 - idx : idx;
            const float dtv = ((const float*)(ws + O_DT))[(size_t)(rb + l) * 16 + dir * 8 + h];
            const float an = -__expf(P.in[I_ALOG][dir * 8 + h]);
            const float cs = scan_pair<0>(dtv * an, sbuf, t);
            const float tot = sbuf[dir * 128 + 127];
            const float wv = __expf(tot - cs) * dtv;
            if (dir == 0) wA[l] = wv; else wB[l] = wv;
            if (idx == 127) ((float*)(ws + O_ACH))[((size_t)(b * NCH + cc) * 8 + h) * 2 + dir] = cs;
            __syncthreads();
            const int g = h >> 2;
            const u16* xt = (const u16*)(ws + O_XT) + (isctx ? TCTX512 + ((size_t)(b * 512 + h * 64)) * 256 : ((size_t)(b * 512 + h * 64)) * 4096) + lpos;
            const u16* bt = (const u16*)(ws + O_BT) + (isctx ? TCTX256 + ((size_t)(b * 256 + g * 128)) * 256 : ((size_t)(b * 256 + g * 128)) * 4096) + lpos;
            load_tile128_scaled(T0, 0, xt, L, 64, wA, t, 256);
            load_tile128_scaled(T0, 64, xt, L, 64, wB, t, 256);
            load_tile128(T1, 0, bt, L, 128, t, 256);
            __syncthreads();
            f32x4 acc[4][4]; zero_acc(acc);
            lds_mma<4, 4>(T0, T1, wm * 64, wn * 64, acc, lane);
            u16* st = (u16*)(ws + O_ST) + (((size_t)(b * NCH + cc) * 8 + h) * 2 + wm) * 8192 + ((lane >> 4) * 4) * 128 + wn * 64 + (lane & 15);
#pragma unroll
            for (int i = 0; i < 4; ++i)
#pragma unroll
                for (int j = 0; j < 4; ++j)
#pragma unroll
                    for (int r = 0; r < 4; ++r) st[(i * 16 + r) * 128 + j * 16] = f2bf(acc[i][j][r]);
            __syncthreads();
        } else {
            const int v = u - NSSD;
            const int h = v & 3, ct = v >> 2, b = ct / NCH, cc = ct % NCH;
            const bool isctx = cc < 2;
            const int L = isctx ? 256 : 4096;
            const int lpos = isctx ? cc * 128 : (cc - 2) * 128;
            const int rb = isctx ? MLAT + b * 256 + cc * 128 : b * 4096 + (cc - 2) * 128;
            const int dir = t >> 7, idx = t & 127;
            const int s = dir ? 127 - idx : idx;
            const float fv = ((const float*)(ws + O_GF))[(size_t)(rb + s) * 8 + dir * 4 + h];
            const float iv = ((const float*)(ws + O_GI))[(size_t)(rb + s) * 8 + dir * 4 + h];
            const float bc = scan_pair<0>(fv, sbuf, t);
            const float tot = sbuf[dir * 128 + 127];
            const float av = tot - bc + iv;
            __syncthreads();
            (void)scan_pair<1>(av, sbuf, t);
            const float mloc = sbuf[dir * 128 + 127];
            const float wv = __expf(av - mloc);
            if (dir == 0) wA[s] = wv; else wB[s] = wv;
            if (idx == 0) {
                float* mls = (float*)(ws + O_MLS) + (((size_t)(b * NCH + cc) * 4 + h) * 2 + dir) * 2;
                mls[0] = mloc; mls[1] = tot;
            }
            __syncthreads();
            const u16* vt = (const u16*)(ws + O_VT) + (isctx ? TCTX512 + ((size_t)(b * 512 + h * 128)) * 256 : ((size_t)(b * 512 + h * 128)) * 4096) + lpos;
            const u16* kt = (const u16*)(ws + O_KT) + (isctx ? TCTX512 + ((size_t)(b * 512 + h * 128)) * 256 : ((size_t)(b * 512 + h * 128)) * 4096) + lpos;
            load_tile128(T1, 0, kt, L, 128, t, 256);
#pragma unroll 1
            for (int d2 = 0; d2 < 2; ++d2) {
                load_tile128_scaled(T0, 0, vt, L, 128, d2 ? wB : wA, t, 256);
                __syncthreads();
                f32x4 acc[4][4]; zero_acc(acc);
                lds_mma<4, 4>(T0, T1, wm * 64, wn * 64, acc, lane);
                u16* cst = (u16*)(ws + (d2 ? O_MLC1 : O_MLC0)) + ((size_t)(b * NCH + cc) * 4 + h) * 16384 + (wm * 64 + (lane >> 4) * 4) * 128 + wn * 64 + (lane & 15);
#pragma unroll
                for (int i = 0; i < 4; ++i)
#pragma unroll
                    for (int j = 0; j < 4; ++j)
#pragma unroll
                        for (int r = 0; r < 4; ++r) cst[(i * 16 + r) * 128 + j * 16] = f2bf(acc[i][j][r]);
                if (d2 == 0) {
                    const float* wgt = dir ? wB : wA;
                    float nacc = 0.f;
#pragma unroll 4
                    for (int c = 0; c < 16; ++c) {
                        const uint4 kv = *(const uint4*)(T1 + swz256(idx, c));
                        const float* ww = wgt + c * 8;
                        nacc += bflo(kv.x) * ww[0] + bfhi(kv.x) * ww[1] + bflo(kv.y) * ww[2] + bfhi(kv.y) * ww[3]
                              + bflo(kv.z) * ww[4] + bfhi(kv.z) * ww[5] + bflo(kv.w) * ww[6] + bfhi(kv.w) * ww[7];
                    }
                    ((float*)(ws + O_MLN))[(((size_t)(b * NCH + cc) * 4 + h) * 2 + dir) * 128 + idx] = nacc;
                }
                __syncthreads();
            }
        }
    }
}

__device__ __forceinline__ int scan_cc(int dir, int step) { return dir == 0 ? step : (step < 2 ? 1 - step : 35 - step); }
__device__ void phase5(const Params& P) {
    unsigned char* ws = P.ws;
    const int vb = threadIdx.x >> 8, t = threadIdx.x & 255;
    for (int u = blockIdx.x * 2 + vb; u < 256 + 256 + 32; u += gridDim.x * 2) {
        if (u < 256) {
            const int chain = u >> 2, part = u & 3;
            const int b = chain >> 4, h = (chain >> 1) & 7, dir = chain & 1;
            const int off = part * 2048 + t * 8;
            float S[8];
#pragma unroll
            for (int j = 0; j < 8; ++j) S[j] = 0.f;
#pragma unroll 2
            for (int step = 0; step < NCH; ++step) {
                const int cc = scan_cc(dir, step);
                u16* p = (u16*)(ws + O_ST) + (((size_t)(b * NCH + cc) * 8 + h) * 2 + dir) * 8192 + off;
                const uint4 lv = *(const uint4*)p;
                const float dec = __expf(((const float*)(ws + O_ACH))[((size_t)(b * NCH + cc) * 8 + h) * 2 + dir]);
                uint4 o; o.x = pack2(S[0], S[1]); o.y = pack2(S[2], S[3]); o.z = pack2(S[4], S[5]); o.w = pack2(S[6], S[7]);
                *(uint4*)p = o;
                S[0] = dec * S[0] + bflo(lv.x); S[1] = dec * S[1] + bfhi(lv.x); S[2] = dec * S[2] + bflo(lv.y); S[3] = dec * S[3] + bfhi(lv.y);
                S[4] = dec * S[4] + bflo(lv.z); S[5] = dec * S[5] + bfhi(lv.z); S[6] = dec * S[6] + bflo(lv.w); S[7] = dec * S[7] + bfhi(lv.w);
            }
        } else if (u < 512) {
            const int v = u - 256;
            const int chain = v >> 3, part = v & 7;
            const int b = chain >> 3, h = (chain >> 1) & 3, dir = chain & 1;
            const int off = part * 2048 + t * 8;
            float S[8];
#pragma unroll
            for (int j = 0; j < 8; ++j) S[j] = 0.f;
            float m = -1e30f;
#pragma unroll 2
            for (int step = 0; step < NCH; ++step) {
                const int cc = scan_cc(dir, step);
                u16* p = (u16*)(ws + (dir ? O_MLC1 : O_MLC0)) + ((size_t)(b * NCH + cc) * 4 + h) * 16384 + off;
                const uint4 lv = *(const uint4*)p;
                const float* mls = (const float*)(ws + O_MLS) + (((size_t)(b * NCH + cc) * 4 + h) * 2 + dir) * 2;
                const float ml = mls[0], bl = mls[1];
                const float mn = fmaxf(bl + m, ml);
                const float sp = __expf(bl + m - mn), sl = __expf(ml - mn);
                if (part == 0 && t == 0) ((float*)(ws + O_MLP))[((size_t)(b * NCH + cc) * 4 + h) * 2 + dir] = m;
                uint4 o; o.x = pack2(S[0], S[1]); o.y = pack2(S[2], S[3]); o.z = pack2(S[4], S[5]); o.w = pack2(S[6], S[7]);
                *(uint4*)p = o;
                S[0] = sp * S[0] + sl * bflo(lv.x); S[1] = sp * S[1] + sl * bfhi(lv.x); S[2] = sp * S[2] + sl * bflo(lv.y); S[3] = sp * S[3] + sl * bfhi(lv.y);
                S[4] = sp * S[4] + sl * bflo(lv.z); S[5] = sp * S[5] + sl * bfhi(lv.z); S[6] = sp * S[6] + sl * bflo(lv.w); S[7] = sp * S[7] + sl * bfhi(lv.w);
                m = mn;
            }
        } else {
            const int chain = u - 512;
            const int b = chain >> 3, h = (chain >> 1) & 3, dir = chain & 1;
            if (t < 128) {
                float nS = 0.f, m = -1e30f;
                for (int step = 0; step < NCH; ++step) {
                    const int cc = scan_cc(dir, step);
                    float* p = (float*)(ws + O_MLN) + (((size_t)(b * NCH + cc) * 4 + h) * 2 + dir) * 128 + t;
                    const float lv = *p;
                    const float* mls = (const float*)(ws + O_MLS) + (((size_t)(b * NCH + cc) * 4 + h) * 2 + dir) * 2;
                    const float ml = mls[0], bl = mls[1];
                    const float mn = fmaxf(bl + m, ml);
                    const float sp = __expf(bl + m - mn), sl = __expf(ml - mn);
                    *p = nS;
                    nS = sp * nS + sl * lv;
                    m = mn;
                }
            }
        }
    }
}

__device__ void phase6(const Params& P, char* lds) {
    unsigned char* ws = P.ws;
    char* T0 = lds; char* T1 = lds + 32768; char* T2 = lds + 65536; char* T3 = lds + 98304;
    float* sc = (float*)(lds + 131072);
    float* sbuf = sc;
    float* a0 = sc + 256;
    float* a1 = sc + 384;
    float* a2 = sc + 512;
    float* a3 = sc + 640;
    float* a4 = sc + 768;
    float* a5 = sc + 896;
    float* rsA = sc + 1024;
    float* qn = sc + 1536;
    float* fac = sc + 1792;
    float* wfac = sc + 2048;
    const int NSSD = 4 * 32 * 8, NML = 4 * 32 * 4;
    for (int u = blockIdx.x; u < NSSD + NML; u += gridDim.x) {
        int t = threadIdx.x; asm volatile("" : "+v"(t));
        const int lane = t & 63, w = t >> 6, wm = w >> 1, wn = w & 1;
        if (u < NSSD) {
            const int h = u & 7, ct = u >> 3, b = ct >> 5, c = ct & 31, cc = c + 2;
            const int rb = b * 4096 + c * 128, lpos = c * 128, g = h >> 2;
            {
                const int dir = (t >> 7) & 1, idx = t & 127;
                const int l = dir ? 127 - idx : idx;
                float dtv = 0.f, an = 0.f;
                if (t < 256) { dtv = ((const float*)(ws + O_DT))[(size_t)(rb + l) * 16 + dir * 8 + h]; an = -__expf(P.in[I_ALOG][dir * 8 + h]); }
                const float cs = scan_pair<0>(dtv * an, sbuf, t);
                if (t < 256) { if (dir == 0) { a0[l] = cs; a2[l] = dtv; } else { a1[l] = cs; a3[l] = dtv; } }
            }
            load_tile128(T0, 0, (const u16*)(ws + O_CM) + (size_t)rb * 256 + g * 128, 256, 128, t, 512);
            load_tile128(T1, 0, (const u16*)(ws + O_BM) + (size_t)rb * 256 + g * 128, 256, 128, t, 512);
            {
                const u16* sf = (const u16*)(ws + O_ST) + (((size_t)(b * NCH + cc) * 8 + h) * 2 + 0) * 8192;
                load_tile128(T2, 0, sf, 128, 128, t, 512);
            }
            load_tile128(T3, 0, (const u16*)(ws + O_XT) + ((size_t)(b * 512 + h * 64)) * 4096 + lpos, 4096, 64, t, 512);
            __syncthreads();
            f32x4 Y[2][2];
            {
                f32x4 aF[2][2], aB[2][2]; zero_acc(aF); zero_acc(aB);
                lds_mma<2, 2>(T0, T2, wm * 32, wn * 32, aF, lane);
                lds_mma<2, 2>(T0, T2, wm * 32, 64 + wn * 32, aB, lane);
#pragma unroll
                for (int i = 0; i < 2; ++i)
#pragma unroll
                    for (int r = 0; r < 4; ++r) {
                        const int l = wm * 32 + i * 16 + (lane >> 4) * 4 + r;
                        const float e0 = __expf(a0[l]), e1 = __expf(a1[l]);
#pragma unroll
                        for (int j = 0; j < 2; ++j) Y[i][j][r] = e0 * aF[i][j][r] + e1 * aB[i][j][r];
                    }
            }
            f32x4 G[2][4]; zero_acc(G);
            lds_mma<2, 4>(T0, T1, wm * 32, wn * 64, G, lane);
            __syncthreads();
            {
                float sv0[4], sv1[4], sv2[4], sv3[4];
                int dbase = wn * 64 + (lane & 15) - wm * 32 - (lane >> 4) * 4; asm volatile("" : "+v"(dbase));
#pragma unroll
                for (int j = 0; j < 4; ++j) { const int s = wn * 64 + j * 16 + (lane & 15); sv0[j] = a0[s]; sv1[j] = a1[s]; sv2[j] = a2[s]; sv3[j] = a3[s]; }
#pragma unroll
                for (int i = 0; i < 2; ++i)
#pragma unroll
                    for (int r = 0; r < 4; ++r) {
                        const int l = wm * 32 + i * 16 + (lane >> 4) * 4 + r;
                        const float c0l = a0[l], r1l = a1[l];
#pragma unroll
                        for (int j = 0; j < 4; ++j) {
                            const int s = wn * 64 + j * 16 + (lane & 15);
                            const int diff = dbase + (j * 16 - i * 16 - r);
                            const float e0 = (diff <= 0) ? (c0l - sv0[j]) : -INFINITY;
                            const float e1 = (diff >= 0) ? (r1l - sv1[j]) : -INFINITY;
                            const float f = __expf(e0) * sv2[j] + __expf(e1) * sv3[j];
                            *(u16*)(T1 + swz256(l, s >> 3) + (s & 7) * 2) = f2bf(G[i][j][r] * f);
                        }
                    }
            }
            __syncthreads();
            lds_mma<2, 2>(T1, T3, wm * 32, wn * 32, Y, lane);
            const float Dh = P.in[I_SSDD][h];
            u16* zo = (u16*)(ws + O_ZO);
#pragma unroll
            for (int i = 0; i < 2; ++i)
#pragma unroll
                for (int r = 0; r < 4; ++r) {
                    const int l = wm * 32 + i * 16 + (lane >> 4) * 4 + r;
                    float ssq = 0.f;
#pragma unroll
                    for (int j = 0; j < 2; ++j) {
                        const int p = wn * 32 + j * 16 + (lane & 15);
                        const float xv = bf2f(*(const u16*)(T3 + swz256(p, l >> 3) + (l & 7) * 2));
                        u16* zp = zo + (size_t)(rb + l) * 1024 + h * 64 + p;
                        const float z = bf2f(*zp);
                        const float y = (Y[i][j][r] + Dh * xv) * siluf(z);
                        *zp = f2bf(y);
                        ssq += y * y;
                    }
                    ssq += __shfl_xor(ssq, 1); ssq += __shfl_xor(ssq, 2); ssq += __shfl_xor(ssq, 4); ssq += __shfl_xor(ssq, 8);
                    if ((lane & 15) == 0) ((float*)(ws + O_SSQ))[(size_t)(rb + l) * 16 + h * 2 + wn] = ssq;
                }
            __syncthreads();
        } else {
            const int v = u - NSSD;
            const int h = v & 3, ct = v >> 2, b = ct >> 5, c = ct & 31, cc = c + 2;
            const int rb = b * 4096 + c * 128, lpos = c * 128;
            const float mp0 = ((const float*)(ws + O_MLP))[((size_t)(b * NCH + cc) * 4 + h) * 2 + 0];
            const float mp1 = ((const float*)(ws + O_MLP))[((size_t)(b * NCH + cc) * 4 + h) * 2 + 1];
            {
                const int dir = (t >> 7) & 1, idx = t & 127;
                const int s = dir ? 127 - idx : idx;
                float fv = 0.f, iv = 0.f;
                if (t < 256) { fv = ((const float*)(ws + O_GF))[(size_t)(rb + s) * 8 + dir * 4 + h]; iv = ((const float*)(ws + O_GI))[(size_t)(rb + s) * 8 + dir * 4 + h]; }
                const float bc = scan_pair<0>(fv, sbuf, t);
                const float uv = iv - bc;
                __syncthreads();
                const float mx = scan_pair<1>(uv, sbuf, t);
                const float mm = fmaxf(dir ? mp1 : mp0, mx);
                if (t < 256) { if (dir == 0) { a0[s] = bc; a2[s] = uv; a4[s] = mm; } else { a1[s] = bc; a3[s] = uv; a5[s] = mm; } }
            }
            load_tile128(T0, 0, (const u16*)(ws + O_Q) + (size_t)rb * 512 + h * 128, 512, 128, t, 512);
            load_tile128(T1, 0, (const u16*)(ws + O_K) + (size_t)rb * 512 + h * 128, 512, 128, t, 512);
            load_tile128(T2, 0, (const u16*)(ws + O_MLC0) + ((size_t)(b * NCH + cc) * 4 + h) * 16384, 128, 128, t, 512);
            load_tile128(T3, 0, (const u16*)(ws + O_MLC1) + ((size_t)(b * NCH + cc) * 4 + h) * 16384, 128, 128, t, 512);
            __syncthreads();
            f32x4 S[2][4]; zero_acc(S);
            lds_mma<2, 4>(T0, T1, wm * 32, wn * 64, S, lane);
            if (t < 256) {
                const int dir = t >> 7, idx = t & 127;
                const float* np = (const float*)(ws + O_MLN) + (((size_t)(b * NCH + cc) * 4 + h) * 2 + dir) * 128;
                float acc = 0.f;
#pragma unroll 4
                for (int cch = 0; cch < 16; ++cch) {
                    const uint4 qv = *(const uint4*)(T0 + swz256(idx, cch));
                    const float4 n0 = *(const float4*)(np + cch * 8), n1 = *(const float4*)(np + cch * 8 + 4);
                    acc += bflo(qv.x) * n0.x + bfhi(qv.x) * n0.y + bflo(qv.y) * n0.z + bfhi(qv.y) * n0.w
                         + bflo(qv.z) * n1.x + bfhi(qv.z) * n1.y + bflo(qv.w) * n1.z + bfhi(qv.w) * n1.w;
                }
                qn[dir * 128 + idx] = acc;
            }
            float su0[4], su1[4];
            int dbase = wn * 64 + (lane & 15) - wm * 32 - (lane >> 4) * 4; asm volatile("" : "+v"(dbase));
#pragma unroll
            for (int j = 0; j < 4; ++j) { const int s = wn * 64 + j * 16 + (lane & 15); su0[j] = a2[s]; su1[j] = a3[s]; }
#pragma unroll
            for (int i = 0; i < 2; ++i)
#pragma unroll
                for (int r = 0; r < 4; ++r) {
                    const int tt = wm * 32 + i * 16 + (lane >> 4) * 4 + r;
                    const float m0 = a4[tt], m1 = a5[tt];
                    float r0 = 0.f, r1 = 0.f;
#pragma unroll
                    for (int j = 0; j < 4; ++j) {
                        const float sv = S[i][j][r];
                        const int diff = dbase + (j * 16 - i * 16 - r);
                        r0 += sv * __expf((diff <= 0) ? (su0[j] - m0) : -INFINITY);
                        r1 += sv * __expf((diff >= 0) ? (su1[j] - m1) : -INFINITY);
                    }
                    r0 += __shfl_xor(r0, 1); r0 += __shfl_xor(r0, 2); r0 += __shfl_xor(r0, 4); r0 += __shfl_xor(r0, 8);
                    r1 += __shfl_xor(r1, 1); r1 += __shfl_xor(r1, 2); r1 += __shfl_xor(r1, 4); r1 += __shfl_xor(r1, 8);
                    if ((lane & 15) == 0) { rsA[(0 * 2 + wn) * 128 + tt] = r0; rsA[(1 * 2 + wn) * 128 + tt] = r1; }
                }
            __syncthreads();
            if (t < 256) {
                const int dir = t >> 7, tt = t & 127;
                const float rs = rsA[(dir * 2 + 0) * 128 + tt] + rsA[(dir * 2 + 1) * 128 + tt];
                const float mm = dir ? a5[tt] : a4[tt];
                const float wi = __expf((dir ? mp1 : mp0) - mm);
                const float den = rs + wi * qn[dir * 128 + tt];
                const float mout = (dir ? a1[tt] : a0[tt]) + mm;
                const float dn = fmaxf(fabsf(den), __expf(-mout));
                fac[dir * 128 + tt] = 1.f / dn;
                wfac[dir * 128 + tt] = wi / dn;
            }
            __syncthreads();
            f32x4 H[2][4];
            {
                f32x4 A0[2][4]; zero_acc(A0);
                lds_mma<2, 4>(T0, T2, wm * 32, wn * 64, A0, lane);
#pragma unroll
                for (int i = 0; i < 2; ++i)
#pragma unroll
                    for (int r = 0; r < 4; ++r) {
                        const float f = wfac[wm * 32 + i * 16 + (lane >> 4) * 4 + r];
#pragma unroll
                        for (int j = 0; j < 4; ++j) H[i][j][r] = f * A0[i][j][r];
                    }
            }
            {
                f32x4 A1[2][4]; zero_acc(A1);
                lds_mma<2, 4>(T0, T3, wm * 32, wn * 64, A1, lane);
#pragma unroll
                for (int i = 0; i < 2; ++i)
#pragma unroll
                    for (int r = 0; r < 4; ++r) {
                        const float f = wfac[128 + wm * 32 + i * 16 + (lane >> 4) * 4 + r];
#pragma unroll
                        for (int j = 0; j < 4; ++j) H[i][j][r] += f * A1[i][j][r];
                    }
            }
            __syncthreads();
            asm volatile("" : "+v"(dbase));
#pragma unroll
            for (int i = 0; i < 2; ++i)
#pragma unroll
                for (int r = 0; r < 4; ++r) {
                    const int tt = wm * 32 + i * 16 + (lane >> 4) * 4 + r;
                    const float m0 = a4[tt], m1 = a5[tt], f0 = fac[tt], f1 = fac[128 + tt];
#pragma unroll
                    for (int j = 0; j < 4; ++j) {
                        const int s = wn * 64 + j * 16 + (lane & 15);
                        const int diff = dbase + (j * 16 - i * 16 - r);
                        const float f = __expf((diff <= 0) ? (su0[j] - m0) : -INFINITY) * f0 + __expf((diff >= 0) ? (su1[j] - m1) : -INFINITY) * f1;
                        *(u16*)(T1 + swz256(tt, s >> 3) + (s & 7) * 2) = f2bf(S[i][j][r] * f);
                    }
                }
            load_tile128(T2, 0, (const u16*)(ws + O_VT) + ((size_t)(b * 512 + h * 128)) * 4096 + lpos, 4096, 128, t, 512);
            __syncthreads();
            lds_mma<2, 4>(T1, T2, wm * 32, wn * 64, H, lane);
            const u16* zo = (const u16*)(ws + O_ZO);
#pragma unroll
            for (int i = 0; i < 2; ++i)
#pragma unroll
                for (int r = 0; r < 4; ++r) {
                    const int tt = wm * 32 + i * 16 + (lane >> 4) * 4 + r;
                    const int lp = lpos + tt;
                    const size_t rown = (size_t)b * 4096 + ((lp & 63) << 6) + (lp >> 6);
                    float ssq = 0.f;
#pragma unroll
                    for (int j = 0; j < 4; ++j) {
                        const int d = wn * 64 + j * 16 + (lane & 15);
                        const float o = bf2f(zo[rown * 1024 + 512 + h * 128 + d]);
                        const float hv = H[i][j][r] * sigmf(o);
                        H[i][j][r] = hv;
                        ssq += hv * hv;
                    }
                    ssq += __shfl_xor(ssq, 1); ssq += __shfl_xor(ssq, 2); ssq += __shfl_xor(ssq, 4); ssq += __shfl_xor(ssq, 8);
                    if ((lane & 15) == 0) rsA[wn * 128 + tt] = ssq;
                }
            __syncthreads();
            u16* zow = (u16*)(ws + O_ZO);
            const u16* xc = (const u16*)(ws + O_XC);
#pragma unroll
            for (int i = 0; i < 2; ++i)
#pragma unroll
                for (int r = 0; r < 4; ++r) {
                    const int tt = wm * 32 + i * 16 + (lane >> 4) * 4 + r;
                    const int lp = lpos + tt;
                    const size_t rown = (size_t)b * 4096 + ((lp & 63) << 6) + (lp >> 6);
                    const float rn = rsqrtf((rsA[tt] + rsA[128 + tt]) * (1.f / 128.f) + 1e-6f);
#pragma unroll
                    for (int j = 0; j < 4; ++j) {
                        const int d = wn * 64 + j * 16 + (lane & 15), chg = h * 128 + d;
                        const float y = H[i][j][r] * rn * P.in[I_MNW][chg] + P.in[I_MSKIP][chg] * bf2f(xc[(size_t)(rb + tt) * 512 + chg]);
                        zow[rown * 1024 + 512 + chg] = f2bf(y);
                    }
                }
            __syncthreads();
        }
    }
}

struct OutProj {
    static constexpr int K = 1024; static constexpr bool PERM = false; static constexpr int MIDT = 8;
    struct Unit { int pm, pn, slot; };
    const Params* P; const float* rs; int G, c;
    __device__ __forceinline__ bool next(int i, Unit& u) const {
        const int L = i * G + c;
        if (L >= 256) return false;
        g8::dense_unit(L, 64, 4, u.pm, u.pn); u.slot = i & 3;
        return true;
    }
    __device__ __forceinline__ const char* baseA(const Unit&) const { return (const char*)(P->ws + O_ZO); }
    __device__ __forceinline__ const char* baseB(const Unit&) const { return (const char*)(P->ws + O_WOUT); }
    __device__ __forceinline__ void offs(const Unit& u, int tid_, unsigned (&oa)[2][2], unsigned (&ob)[2][2]) const {
        int R[2], C[2];
        { int tq = tid_; asm volatile("" : "+v"(tq)); g8::stage_rc(tq * 16, R[0], C[0]); g8::stage_rc(tq * 16 + 8192, R[1], C[1]); }
#pragma unroll
        for (int h = 0; h < 2; ++h)
#pragma unroll
            for (int i = 0; i < 2; ++i) {
                oa[h][i] = (unsigned)((u.pm * 256 + h * 128 + R[i]) * 1024 + C[i]) * 2u;
                ob[h][i] = (unsigned)((u.pn * 256 + h * 128 + R[i]) * 1024 + C[i]) * 2u;
            }
    }
    __device__ __forceinline__ void mid(g8::Acc& acc, const Unit& u, int wr, int fr) const {
#pragma unroll
        for (int ai = 0; ai < 2; ++ai)
#pragma unroll
            for (int m = 0; m < 4; ++m) {
                const float s = rs[u.slot * 256 + ai * 128 + wr * 64 + m * 16 + fr];
#pragma unroll
                for (int bj = 0; bj < 2; ++bj)
#pragma unroll
                    for (int n = 0; n < 2; ++n) acc[ai][bj][m][n] *= s;
            }
    }
    __device__ __forceinline__ void epi(g8::Acc& acc, const Unit& u, int wr, int wc, int fr, int fq) const {
        const int row0 = u.pm * 256 + wr * 64 + fr, col0 = u.pn * 256 + wc * 32 + 4 * fq;
        const int b = u.pm >> 4;
        const float* mod = (const float*)(P->ws + O_MOD) + b * 6144 + 2048;
        f32x4 g1[2][2];
#pragma unroll
        for (int bj = 0; bj < 2; ++bj)
#pragma unroll
            for (int n = 0; n < 2; ++n) g1[bj][n] = *(const f32x4*)(mod + col0 + bj * 128 + n * 16);
#pragma unroll
        for (int ai = 0; ai < 2; ++ai)
#pragma unroll
            for (int m = 0; m < 4; ++m) {
                const size_t ro = (size_t)(row0 + ai * 128 + m * 16) * 1024 + col0;
#pragma unroll
                for (int bj = 0; bj < 2; ++bj)
#pragma unroll
                    for (int n = 0; n < 2; ++n) {
                        const f32x4 xv = *(const f32x4*)(P->in[I_X] + ro + bj * 128 + n * 16);
                        *(f32x4*)(P->out + ro + bj * 128 + n * 16) = xv + g1[bj][n] * acc[ai][bj][m][n];
                    }
            }
    }
};
__device__ void phase7(const Params& P, char* lds) {
    float* rs = (float*)(lds + g8::STAGE_BYTES);
    OutProj S; S.P = &P; S.rs = rs; S.G = gridDim.x; S.c = blockIdx.x;
    for (int i = 0; i < 4; ++i) {
        OutProj::Unit u;
        if (!S.next(i, u)) break;
        if (threadIdx.x < 256) {
            const float* sq = (const float*)(P.ws + O_SSQ) + (size_t)(u.pm * 256 + threadIdx.x) * 16;
            float s = 0.f;
#pragma unroll
            for (int q = 0; q < 16; ++q) s += sq[q];
            rs[i * 256 + threadIdx.x] = rsqrtf(s * (1.f / 512.f) + 1e-6f);
        }
    }
    __syncthreads();
    g8::gemm_phase<OutProj>((LAS unsigned char*)lds, S);
}

__device__ void phase8(const Params& P, char* lds_all) {
    unsigned char* ws = P.ws;
    const float* mod = (const float*)(ws + O_MOD);
    {
        const int t = threadIdx.x, lane = t & 63, w = t >> 6;
        float* tt = (float*)lds_all;
        float bw[32][3];
        {
            const int ti = lane & 15, kq = lane >> 4;
#pragma unroll
            for (int ks = 0; ks < 32; ++ks) {
                const int k = w * 128 + ks * 4 + kq;
                bw[ks][0] = P.in[I_REW][(size_t)k * 32 + ti];
                bw[ks][1] = P.in[I_REW][(size_t)k * 32 + 16 + ti];
                const float b2r = P.in[I_RGW][(size_t)k * 4 + (ti & 3)];
                bw[ks][2] = ti < 4 ? b2r : 0.f;
            }
        }
        for (int u = blockIdx.x; u < 512; u += gridDim.x) {
            const int tk0 = u * 32;
            const int b = tk0 >> 12;
#pragma unroll 1
            for (int qh = 0; qh < 2; ++qh) {
                float4 v[2][4]; float ss[2];
#pragma unroll
                for (int q = 0; q < 2; ++q) {
                    const float* xr = P.out + (size_t)(tk0 + w * 4 + qh * 2 + q) * 1024;
#pragma unroll
                    for (int j = 0; j < 4; ++j) { v[q][j] = ((const float4*)xr)[lane + 64 * j]; }
                }
#pragma unroll
                for (int q = 0; q < 2; ++q) {
                    ss[q] = 0.f;
#pragma unroll
                    for (int j = 0; j < 4; ++j) ss[q] += v[q][j].x * v[q][j].x + v[q][j].y * v[q][j].y + v[q][j].z * v[q][j].z + v[q][j].w * v[q][j].w;
                    ss[q] = rsqrtf(wave_sum(ss[q]) * (1.f / 1024.f) + 1e-6f);
                }
#pragma unroll
                for (int j = 0; j < 4; ++j) {
                    const int k = (lane + 64 * j) * 4;
                    const float4 nwv = *(const float4*)(P.in[I_N2W] + k);
                    const float4 sh = *(const float4*)(mod + b * 6144 + 3072 + k);
                    const float4 sc = *(const float4*)(mod + b * 6144 + 4096 + k);
                    const float m0 = nwv.x * (1.f + sc.x), m1 = nwv.y * (1.f + sc.y), m2 = nwv.z * (1.f + sc.z), m3 = nwv.w * (1.f + sc.w);
#pragma unroll
                    for (int q = 0; q < 2; ++q) {
                        const int tl = w * 4 + qh * 2 + q;
                        float4 hh;
                        hh.x = v[q][j].x * ss[q] * m0 + sh.x; hh.y = v[q][j].y * ss[q] * m1 + sh.y;
                        hh.z = v[q][j].z * ss[q] * m2 + sh.z; hh.w = v[q][j].w * ss[q] * m3 + sh.w;
                        uint2 o; o.x = pack2(hh.x, hh.y); o.y = pack2(hh.z, hh.w);
                        *(uint2*)((u16*)(ws + O_T) + (size_t)(tk0 + tl) * 1024 + k) = o;
                        *(float4*)(tt + tl * 1028 + k) = hh;
                    }
                }
            }
            __syncthreads();
            f32x4 c[2][3];
#pragma unroll
            for (int a = 0; a < 2; ++a)
#pragma unroll
                for (int f = 0; f < 3; ++f) c[a][f] = f32x4{0, 0, 0, 0};
            const int ti = lane & 15, kq = lane >> 4;
#pragma unroll
            for (int ks = 0; ks < 32; ++ks) {
                const int k = w * 128 + ks * 4 + kq;
                const float a0 = tt[ti * 1028 + k], a1 = tt[(16 + ti) * 1028 + k];
                c[0][0] = __builtin_amdgcn_mfma_f32_16x16x4f32(a0, bw[ks][0], c[0][0], 0, 0, 0);
                c[0][1] = __builtin_amdgcn_mfma_f32_16x16x4f32(a0, bw[ks][1], c[0][1], 0, 0, 0);
                c[0][2] = __builtin_amdgcn_mfma_f32_16x16x4f32(a0, bw[ks][2], c[0][2], 0, 0, 0);
                c[1][0] = __builtin_amdgcn_mfma_f32_16x16x4f32(a1, bw[ks][0], c[1][0], 0, 0, 0);
                c[1][1] = __builtin_amdgcn_mfma_f32_16x16x4f32(a1, bw[ks][1], c[1][1], 0, 0, 0);
                c[1][2] = __builtin_amdgcn_mfma_f32_16x16x4f32(a1, bw[ks][2], c[1][2], 0, 0, 0);
            }
            __syncthreads();
            float* red = (float*)lds_all;
#pragma unroll
            for (int a = 0; a < 2; ++a)
#pragma unroll
                for (int r = 0; r < 4; ++r) {
                    const int row = a * 16 + kq * 4 + r;
                    red[(w * 32 + row) * 48 + ti] = c[a][0][r];
                    red[(w * 32 + row) * 48 + 16 + ti] = c[a][1][r];
                    red[(w * 32 + row) * 48 + 32 + ti] = c[a][2][r];
                }
            __syncthreads();
            int* lcnt = (int*)(lds_all + 65536);
            if (t < 64) lcnt[t] = 0;
            __syncthreads();
            int ea = 0, eb = 0, ra = 0, rb = 0; float w1 = 0.f, w2 = 0.f;
            if (t < 32) {
                float gl[4];
#pragma unroll
                for (int j = 0; j < 4; ++j) {
                    float sacc = P.in[I_RGB][j];
#pragma unroll
                    for (int ww = 0; ww < 8; ++ww) sacc += red[(ww * 32 + t) * 48 + 32 + j];
                    gl[j] = sacc;
                }
                int gs = 0; float gm = gl[0];
#pragma unroll
                for (int j = 1; j < 4; ++j) if (gl[j] > gm) { gm = gl[j]; gs = j; }
                float gsum = 0.f;
#pragma unroll
                for (int j = 0; j < 4; ++j) gsum += __expf(gl[j] - gm);
                const float pg = 1.f / gsum;
                float el[8];
#pragma unroll
                for (int j = 0; j < 8; ++j) {
                    float sacc = P.in[I_REB][gs * 8 + j];
#pragma unroll
                    for (int ww = 0; ww < 8; ++ww) sacc += red[(ww * 32 + t) * 48 + gs * 8 + j];
                    el[j] = sacc;
                }
                int i1 = 0; float m1 = el[0];
#pragma unroll
                for (int j = 1; j < 8; ++j) if (el[j] > m1) { m1 = el[j]; i1 = j; }
                int i2 = -1; float m2 = -INFINITY;
#pragma unroll
                for (int j = 0; j < 8; ++j) if (j != i1 && el[j] > m2) { m2 = el[j]; i2 = j; }
                const float e2 = __expf(m2 - m1);
                w1 = pg / (1.f + e2); w2 = pg * e2 / (1.f + e2);
                ea = gs * 8 + i1; eb = gs * 8 + i2;
                ra = atomicAdd(&lcnt[ea], 1);
                rb = atomicAdd(&lcnt[eb], 1);
            }
            __syncthreads();
            if (t < 32) {
                const int n = lcnt[t];
                lcnt[32 + t] = n > 0 ? atomicAdd((int*)(ws + O_CNT) + t * 64, n) : 0;
            }
            __syncthreads();
            if (t < 32) {
                const int tok = tk0 + t;
                int* list = (int*)(ws + O_LIST);
                float* wts = (float*)(ws + O_WTS);
                list[ea * 16384 + lcnt[32 + ea] + ra] = tok * 2;
                wts[tok * 2] = w1;
                list[eb * 16384 + lcnt[32 + eb] + rb] = tok * 2 + 1;
                wts[tok * 2 + 1] = w2;
            }
            __syncthreads();
        }
    }
    const int vb = threadIdx.x >> 8, t = threadIdx.x & 255;
    char* lds = lds_all + vb * VLDS;
    const int NTR = 3072;
    for (int u = blockIdx.x * 2 + vb; u < NTR; u += gridDim.x * 2) {
        {
            const int v = u;
            float* tile = (float*)lds;
            if (v < 2048) {
                const bool up = v >= 1024;
                const int vv = v & 1023, e = vv >> 5, rem = vv & 31, nt = rem >> 4, kt = rem & 15;
                const float* src = P.in[up ? I_WU : I_WG] + (size_t)e * 1024 * 256;
                transpose_tile_w(tile, src, 256, kt * 64, nt * 128, (u16*)(ws + O_WGU) + (size_t)e * 512 * 1024, (up ? 256 : 0) + nt * 128, 1024, nullptr, 0, t);
            } else {
                const int vv = v - 2048, e = vv >> 5, rem = vv & 31, nt = rem >> 2, kt = rem & 3;
                const float* src = P.in[I_WD] + (size_t)e * 256 * 1024;
                transpose_tile_w(tile, src, 1024, kt * 64, nt * 128, (u16*)(ws + O_WD) + (size_t)e * 1024 * 256, nt * 128, 256, nullptr, 0, t);
            }
        }
    }
}

__device__ __forceinline__ void moe_prefix(const unsigned char* ws, int* pre_t, int* pre_c) {
    if (threadIdx.x == 0) {
        const int* cnt = (const int*)(ws + O_CNT);
        int at = 0, ac = 0;
        for (int e = 0; e < 32; ++e) { pre_t[e] = at; pre_c[e] = ac; const int c = cnt[e * 64]; at += (c + 255) >> 8; ac += c; }
        pre_t[32] = at; pre_c[32] = ac;
    }
    __syncthreads();
}
struct MoeUnit { int e, mt, pn, cnt, base; };
template <int NPN>
__device__ __forceinline__ bool moe_next(const int* pre_t, const int* pre_c, int L, MoeUnit& u) {
    if (L >= pre_t[32] * NPN) return false;
    const int mtg = L / NPN; u.pn = L % NPN;
    int e = 0;
    while (pre_t[e + 1] <= mtg) ++e;
    u.e = e; u.mt = mtg - pre_t[e]; u.cnt = pre_c[e + 1] - pre_c[e]; u.base = pre_c[e];
    return true;
}
struct GateUp {
    static constexpr int K = 1024; static constexpr bool PERM = true; static constexpr int MIDT = 0;
    typedef MoeUnit Unit;
    const unsigned char* ws; const int* pre_t; const int* pre_c; int G, c;
    __device__ __forceinline__ bool next(int i, Unit& u) const { return moe_next<2>(pre_t, pre_c, i * G + c, u); }
    __device__ __forceinline__ const char* baseA(const Unit&) const { return (const char*)(ws + O_T); }
    __device__ __forceinline__ const char* baseB(const Unit& u) const { return (const char*)(ws + O_WGU) + (size_t)u.e * 512 * 1024 * 2; }
    __device__ __forceinline__ void offs(const Unit& u, int tid_, unsigned (&oa)[2][2], unsigned (&ob)[2][2]) const {
        int R[2], C[2];
        { int tq = tid_; asm volatile("" : "+v"(tq)); g8::stage_rc(tq * 16, R[0], C[0]); g8::stage_rc(tq * 16 + 8192, R[1], C[1]); }
        const int* list = (const int*)(ws + O_LIST) + u.e * 16384;
#pragma unroll
        for (int h = 0; h < 2; ++h)
#pragma unroll
            for (int i = 0; i < 2; ++i) {
                const int idx = u.mt * 256 + h * 128 + R[i];
                const int tok = list[idx < u.cnt ? idx : u.cnt - 1] >> 1;
                oa[h][i] = (unsigned)(tok * 1024 + C[i]) * 2u;
                const int Rb = (R[i] & ~31) + g8::perm32(R[i] & 31);
                ob[h][i] = (unsigned)((h * 256 + u.pn * 128 + Rb) * 1024 + C[i]) * 2u;
            }
    }
    __device__ __forceinline__ void mid(g8::Acc&, const Unit&, int, int) const {}
    __device__ __forceinline__ void epi(g8::Acc& acc, const Unit& u, int wr, int wc, int fr, int fq) const {
        u16* H = (u16*)((unsigned char*)ws + O_H);
#pragma unroll
        for (int ai = 0; ai < 2; ++ai)
#pragma unroll
            for (int m = 0; m < 4; ++m) {
                const int idx = u.mt * 256 + ai * 128 + wr * 64 + m * 16 + fr;
                if (idx < u.cnt) {
                    const f32x4 g0 = acc[ai][0][m][0], g1 = acc[ai][0][m][1], u0 = acc[ai][1][m][0], u1 = acc[ai][1][m][1];
                    u32x4 o;
                    o.x = g8::cvt_pk_bf16(siluf(g0[0]) * u0[0], siluf(g0[1]) * u0[1]); o.y = g8::cvt_pk_bf16(siluf(g0[2]) * u0[2], siluf(g0[3]) * u0[3]);
                    o.z = g8::cvt_pk_bf16(siluf(g1[0]) * u1[0], siluf(g1[1]) * u1[1]); o.w = g8::cvt_pk_bf16(siluf(g1[2]) * u1[2], siluf(g1[3]) * u1[3]);
                    *(u32x4*)(H + (size_t)(u.base + idx) * 256 + u.pn * 128 + wc * 32 + 8 * fq) = o;
                }
            }
    }
};
struct Down {
    static constexpr int K = 256; static constexpr bool PERM = true; static constexpr int MIDT = 0;
    typedef MoeUnit Unit;
    const unsigned char* ws; const int* pre_t; const int* pre_c; int G, c;
    __device__ __forceinline__ bool next(int i, Unit& u) const { return moe_next<4>(pre_t, pre_c, i * G + c, u); }
    __device__ __forceinline__ const char* baseA(const Unit& u) const { return (const char*)(ws + O_H) + (size_t)(u.base + u.mt * 256) * 256 * 2; }
    __device__ __forceinline__ const char* baseB(const Unit& u) const { return (const char*)(ws + O_WD) + ((size_t)u.e * 1024 + u.pn * 256) * 256 * 2; }
    __device__ __forceinline__ void offs(const Unit&, int tid_, unsigned (&oa)[2][2], unsigned (&ob)[2][2]) const {
        int R[2], C[2];
        { int tq = tid_; asm volatile("" : "+v"(tq)); g8::stage_rc(tq * 16, R[0], C[0]); g8::stage_rc(tq * 16 + 8192, R[1], C[1]); }
#pragma unroll
        for (int h = 0; h < 2; ++h)
#pragma unroll
            for (int i = 0; i < 2; ++i) {
                oa[h][i] = (unsigned)((h * 128 + R[i]) * 256 + C[i]) * 2u;
                const int Rb = (R[i] & ~31) + g8::perm32(R[i] & 31);
                ob[h][i] = (unsigned)((h * 128 + Rb) * 256 + C[i]) * 2u;
            }
    }
    __device__ __forceinline__ void mid(g8::Acc&, const Unit&, int, int) const {}
    __device__ __forceinline__ void epi(g8::Acc& acc, const Unit& u, int wr, int wc, int fr, int fq) const {
        const int* list = (const int*)(ws + O_LIST) + u.e * 16384;
        const float* wts = (const float*)(ws + O_WTS);
        u16* SL = (u16*)((unsigned char*)ws + O_SL);
        int ent[2][4]; float wg[2][4];
#pragma unroll
        for (int ai = 0; ai < 2; ++ai)
#pragma unroll
            for (int m = 0; m < 4; ++m) {
                const int idx = u.mt * 256 + ai * 128 + wr * 64 + m * 16 + fr;
                ent[ai][m] = list[idx < u.cnt ? idx : u.cnt - 1];
            }
#pragma unroll
        for (int ai = 0; ai < 2; ++ai)
#pragma unroll
            for (int m = 0; m < 4; ++m) wg[ai][m] = wts[ent[ai][m]];
#pragma unroll
        for (int ai = 0; ai < 2; ++ai)
#pragma unroll
            for (int m = 0; m < 4; ++m) {
                const int idx = u.mt * 256 + ai * 128 + wr * 64 + m * 16 + fr;
                if (idx < u.cnt) {
                    u16* rowp = SL + (size_t)ent[ai][m] * 1024 + u.pn * 256 + wc * 32 + 8 * fq;
#pragma unroll
                    for (int bj = 0; bj < 2; ++bj) {
                        const f32x4 v0 = acc[ai][bj][m][0] * wg[ai][m], v1 = acc[ai][bj][m][1] * wg[ai][m];
                        u32x4 o; o.x = g8::cvt_pk_bf16(v0[0], v0[1]); o.y = g8::cvt_pk_bf16(v0[2], v0[3]); o.z = g8::cvt_pk_bf16(v1[0], v1[1]); o.w = g8::cvt_pk_bf16(v1[2], v1[3]);
                        *(u32x4*)(rowp + bj * 128) = o;
                    }
                }
            }
    }
};
__device__ void phase9(const Params& P, char* lds) {
    int* pre_t = (int*)(lds + g8::STAGE_BYTES); int* pre_c = pre_t + 40;
    moe_prefix(P.ws, pre_t, pre_c);
    GateUp S; S.ws = P.ws; S.pre_t = pre_t; S.pre_c = pre_c; S.G = gridDim.x; S.c = blockIdx.x;
    g8::gemm_phase<GateUp>((LAS unsigned char*)lds, S);
}
__device__ void phase10(const Params& P, char* lds) {
    int* pre_t = (int*)(lds + g8::STAGE_BYTES); int* pre_c = pre_t + 40;
    moe_prefix(P.ws, pre_t, pre_c);
    Down S; S.ws = P.ws; S.pre_t = pre_t; S.pre_c = pre_c; S.G = gridDim.x; S.c = blockIdx.x;
    g8::gemm_phase<Down>((LAS unsigned char*)lds, S);
}

__device__ void phase11(const Params& P) {
    unsigned char* ws = P.ws;
    const int lane = threadIdx.x & 63;
    const int gw = blockIdx.x * 8 + (threadIdx.x >> 6), nw = gridDim.x * 8;
    const float* mod = (const float*)(ws + O_MOD);
    const u16* SL = (const u16*)(ws + O_SL);
    for (int row = gw; row < MLAT; row += nw) {
        const int b = row >> 12;
        float* xr = P.out + (size_t)row * 1024;
        float4 v[4]; float ss = 0.f;
#pragma unroll
        for (int j = 0; j < 4; ++j) {
            const int k = (lane + 64 * j) * 4;
            v[j] = *(const float4*)(xr + k);
            const uint2 s0 = *(const uint2*)(SL + (size_t)(row * 2) * 1024 + k);
            const uint2 s1 = *(const uint2*)(SL + (size_t)(row * 2 + 1) * 1024 + k);
            const float4 g2 = *(const float4*)(mod + b * 6144 + 5120 + k);
            v[j].x += g2.x * (bflo(s0.x) + bflo(s1.x));
            v[j].y += g2.y * (bfhi(s0.x) + bfhi(s1.x));
            v[j].z += g2.z * (bflo(s0.y) + bflo(s1.y));
            v[j].w += g2.w * (bfhi(s0.y) + bfhi(s1.y));
            ss += v[j].x * v[j].x + v[j].y * v[j].y + v[j].z * v[j].z + v[j].w * v[j].w;
        }
        ss = wave_sum(ss);
        const float rstd = rsqrtf(ss * (1.f / 1024.f) + 1e-6f);
#pragma unroll
        for (int j = 0; j < 4; ++j) {
            const int k = (lane + 64 * j) * 4;
            const float4 fw = *(const float4*)(P.in[I_FNW] + k);
            float4 o; o.x = v[j].x * rstd * fw.x; o.y = v[j].y * rstd * fw.y; o.z = v[j].z * rstd * fw.z; o.w = v[j].w * rstd * fw.w;
            *(float4*)(xr + k) = o;
        }
    }
}

__global__ void __launch_bounds__(NTB, 2) fwd_kernel(Params P) {
    extern __shared__ __attribute__((aligned(16))) char lds[];
    if (threadIdx.x < 4) ((volatile LAS unsigned*)(lds + LDS_MAIN))[threadIdx.x] = 0u;
    __syncthreads();
    XcdBarrier xbar = xcd_barrier_post((unsigned*)(P.ws + O_BAR), (volatile LAS unsigned*)(lds + LDS_MAIN));
#define SYNC() xcd_barrier(xbar)
#ifdef ONLY_PH
#define RUN_PHASE(k, call) do { if ((k) == ONLY_PH) { call; } } while (0)
#else
#define RUN_PHASE(k, call) do { if (P.lo <= (k) && (k) < P.hi) { call; if ((k) + 1 < P.hi) { SYNC(); } } } while (0)
#endif
    RUN_PHASE(0, phase0(P, lds));
    RUN_PHASE(1, phase1(P));
    RUN_PHASE(2, { InProj S; S.ws = P.ws; S.G = gridDim.x; S.c = blockIdx.x; g8::gemm_phase<InProj>((LAS unsigned char*)lds, S); });
    RUN_PHASE(3, phase3(P, lds));
    RUN_PHASE(4, phase4(P, lds));
    RUN_PHASE(5, phase5(P));
    RUN_PHASE(6, phase6(P, lds));
    RUN_PHASE(7, phase7(P, lds));
    RUN_PHASE(8, phase8(P, lds));
    RUN_PHASE(9, phase9(P, lds));
    RUN_PHASE(10, phase10(P, lds));
    RUN_PHASE(11, phase11(P));
}

extern "C" void kernel_launch(void* const* d_in, const int* in_sizes, int n_in, void* d_out, int out_size, void* d_ws, size_t ws_size,
                              hipStream_t stream) {
    static int grid_blocks = 0;
    if (!grid_blocks) {
        int dev = 0, cus = 0, per_cu = 0;
        (void)hipGetDevice(&dev);
        (void)hipDeviceGetAttribute(&cus, hipDeviceAttributeMultiprocessorCount, dev);
        (void)hipFuncSetAttribute((const void*)fwd_kernel, hipFuncAttributeMaxDynamicSharedMemorySize, LDS_BYTES);
        (void)hipOccupancyMaxActiveBlocksPerMultiprocessor(&per_cu, (const void*)fwd_kernel, NTB, LDS_BYTES);
        if (per_cu < 1) fprintf(stderr, "occupancy query says %d blocks per CU\n", per_cu);
        grid_blocks = cus;
        if (ws_size < WS_END) fprintf(stderr, "workspace too small: %zu < %zu\n", ws_size, (size_t)WS_END);
    }
    Params p{};
    for (int i = 0; i < 30; ++i) p.in[i] = (const float*)d_in[i];
    p.out = (float*)d_out; p.ws = (unsigned char*)d_ws;
    p.lo = 0; p.hi = NPHASE;
    (void)hipMemsetAsync((char*)d_ws + O_BAR, 0, XCD_BAR_WORDS * 4, stream);
    void* args[] = {&p};
    hipError_t e = hipLaunchCooperativeKernel((const void*)fwd_kernel, dim3(grid_blocks), dim3(NTB), args, LDS_BYTES, stream);
    if (e != hipSuccess) fprintf(stderr, "cooperative launch failed: %s (grid %d)\n", hipGetErrorString(e), grid_blocks);
}
```

```cpp
#include <hip/hip_runtime.h>
#include <cstdio>
#include <cstdint>

typedef unsigned short u16;
typedef __attribute__((ext_vector_type(8))) short bf16x8;
typedef __attribute__((ext_vector_type(4))) float f32x4;
typedef __attribute__((ext_vector_type(4))) unsigned u32x4;
#define LAS __attribute__((address_space(3)))

constexpr int NTB = 512;
constexpr int VLDS = 75776;
constexpr int LDS_MAIN = 2 * VLDS;
constexpr int LDS_BYTES = LDS_MAIN + 256;
constexpr int MLAT = 16384, MALL = 17408;
constexpr int NCH = 34;
constexpr int NPHASE = 12;

enum { I_X = 0, I_C, I_CTX, I_CCTX, I_WMOD, I_BMOD, I_N1W, I_WIN, I_SCW, I_SCB, I_DTB, I_ALOG, I_SSDD, I_SNW, I_MCW, I_MCB, I_WQK, I_GB,
       I_MNW, I_MSKIP, I_WOUT, I_N2W, I_RGW, I_RGB, I_REW, I_REB, I_WG, I_WU, I_WD, I_FNW };

constexpr size_t al(size_t x) { return (x + 255) & ~(size_t)255; }
constexpr size_t O_MOD = 0;
constexpr size_t O_SSQ = O_MOD + al(5 * 6144 * 4);
constexpr size_t O_CNT = O_SSQ + al(16384 * 16 * 4);
constexpr size_t O_BAR = O_CNT + 8192;
constexpr size_t O_RDY = O_BAR + 16384;
constexpr size_t O_PSD = O_RDY + 40960;
constexpr size_t O_PSG = O_PSD + al((size_t)MALL * 16 * 4);
constexpr size_t O_DT = O_PSG + al((size_t)MALL * 16 * 4);
constexpr size_t O_GI = O_DT + al((size_t)MALL * 16 * 4);
constexpr size_t O_GF = O_GI + al((size_t)MALL * 8 * 4);
constexpr size_t O_ACH = O_GF + al((size_t)MALL * 8 * 4);
constexpr size_t O_MLS = O_ACH + 16384;
constexpr size_t O_MLP = O_MLS + 16384;
constexpr size_t O_MLN = O_MLP + 16384;
constexpr size_t O_LIST = O_MLN + al(4 * 34 * 4 * 2 * 128 * 4);
constexpr size_t O_WTS = O_LIST + al(32 * 16384 * 4);
constexpr size_t O_WIN = O_WTS + al(16384 * 2 * 4);
constexpr size_t O_WOUT = O_WIN + al((size_t)3328 * 1024 * 2);
constexpr size_t O_A = O_WOUT + al((size_t)1024 * 1024 * 2);
constexpr size_t SZ_A = (size_t)MALL * 1024 * 2;
constexpr size_t O_PT = O_A + SZ_A;
constexpr size_t SZ_PT = (size_t)MALL * 1536 * 2;
constexpr size_t O_MLC1 = O_PT + SZ_PT;
constexpr size_t SZ_HALF = (size_t)MALL * 512 * 2;
constexpr size_t O_ZO = O_MLC1 + SZ_HALF;
constexpr size_t O_VT = O_ZO + SZ_A;
constexpr size_t O_BM = O_VT + SZ_HALF;
constexpr size_t SZ_Q = (size_t)MALL * 256 * 2;
constexpr size_t O_BT = O_BM + SZ_Q;
constexpr size_t O_CM = O_BT + SZ_Q;
constexpr size_t O_XT = O_CM + SZ_Q;
constexpr size_t O_KT = O_XT + SZ_HALF;
constexpr size_t O_XC = O_KT + SZ_HALF;
constexpr size_t WS_END = O_XC + SZ_HALF;
constexpr size_t O_XN = O_A, O_Q = O_A, O_K = O_A + SZ_HALF, O_T = O_A;
constexpr size_t O_ST = O_PT;
constexpr size_t O_MLC0 = O_PT + (size_t)4 * 34 * 8 * 2 * 8192 * 2;
constexpr size_t O_WGU = O_PT;
constexpr size_t O_WD = O_PT + (size_t)32 * 512 * 1024 * 2;
constexpr size_t O_SL = O_ZO;
constexpr size_t O_H = O_XT;
static_assert(O_WD + (size_t)32 * 1024 * 256 * 2 <= O_MLC1, "moe weights fit PT region");
static_assert(O_SL + (size_t)16384 * 2 * 1024 * 2 <= O_CM, "slots fit");
static_assert((size_t)(32768 + 256) * 256 * 2 <= SZ_HALF, "H fits");
static_assert(WS_END <= (size_t)256 * 1024 * 1024, "workspace");
constexpr size_t TCTX512 = (size_t)4 * 512 * 4096;
constexpr size_t TCTX256 = (size_t)4 * 256 * 4096;

struct Params { const float* in[30]; float* out; unsigned char* ws; int lo, hi; };

#define XB_TMO      128
#define XB_XCNT(j)  (256  + 64 * (j))
#define XB_XSUB(j)  (1280 + 64 * (j))
#define XB_XGEN(j)  (2304 + 64 * (j))
#define XB_TOP      3328
#define XB_TOPGEN   3392
#define XCD_BAR_WORDS 3456
#define XB_SPIN_CAP (1u << 20)
__device__ __forceinline__ unsigned xb_ld(unsigned* p)              { return __hip_atomic_load(p, __ATOMIC_RELAXED, __HIP_MEMORY_SCOPE_AGENT); }
__device__ __forceinline__ unsigned xb_add(unsigned* p, unsigned v) { return __hip_atomic_fetch_add(p, v, __ATOMIC_RELAXED, __HIP_MEMORY_SCOPE_AGENT); }
__device__ __forceinline__ unsigned xb_xcc_id() { return (unsigned)__builtin_amdgcn_s_getreg((3 << 11) | 20) & 0xFu; }
#define XB_SPIN(cond, bar) do { unsigned _sp = 0; while (cond) { __builtin_amdgcn_s_sleep(1); \
    if ((++_sp & 255u) == 0u) { if (xb_ld(&(bar)[XB_TMO])) break; if (_sp > XB_SPIN_CAP) { atomicAdd(&(bar)[XB_TMO], 1u); break; } } } } while (0)
struct XcdBarrier { unsigned* bar; unsigned x; volatile LAS unsigned* st; };
__device__ __forceinline__ XcdBarrier xcd_barrier_post(unsigned* bar, volatile LAS unsigned* st) {
    XcdBarrier b; b.bar = bar; b.x = xb_xcc_id(); b.st = st;
    if (threadIdx.x == 0) (void)xb_add(&bar[XB_XCNT(b.x)], 1u);
    return b;
}
__device__ __forceinline__ void xcd_barrier_complete(unsigned* bar, unsigned x, unsigned& nloc, unsigned& nx) {
    const unsigned G = gridDim.x * gridDim.y * gridDim.z;
    unsigned sum, cnt, mine, sp = 0u;
    for (;;) {
        sum = 0u; cnt = 0u; mine = 0u;
#pragma unroll
        for (unsigned j = 0; j < 16; ++j) { const unsigned c = xb_ld(&bar[XB_XCNT(j)]); sum += c; cnt += (c > 0u) ? 1u : 0u; mine = (j == x) ? c : mine; }
        if (sum == G) break;
        __builtin_amdgcn_s_sleep(1);
        if ((++sp & 255u) == 0u) { if (xb_ld(&bar[XB_TMO])) break; if (sp > XB_SPIN_CAP) { atomicAdd(&bar[XB_TMO], 1u); break; } }
    }
    nloc = mine > 0u ? mine : 1u; nx = cnt > 0u ? cnt : 1u;
}
__device__ __forceinline__ void xcd_barrier(const XcdBarrier& b) {
    asm volatile("s_waitcnt vmcnt(0)" ::: "memory");
    __syncthreads();
    if (threadIdx.x == 0) {
        unsigned* bar = b.bar;
        __builtin_amdgcn_s_waitcnt(0);
        unsigned nloc = b.st[0], nx = b.st[1];
        if (nloc == 0u) { xcd_barrier_complete(bar, b.x, nloc, nx); b.st[0] = nloc; b.st[1] = nx; }
        const unsigned old = xb_add(&bar[XB_XSUB(b.x)], 1u);
        const unsigned gen = old / nloc;
        if (old + 1u == (gen + 1u) * nloc) {
            __builtin_amdgcn_fence(__ATOMIC_RELEASE, "agent");
            asm volatile("s_waitcnt vmcnt(0)" ::: "memory");
            const unsigned og = xb_add(&bar[XB_TOP], 1u);
            const unsigned tg = og / nx;
            if (og + 1u == (tg + 1u) * nx) xb_add(&bar[XB_TOPGEN], 1u);
            else XB_SPIN(xb_ld(&bar[XB_TOPGEN]) == tg, bar);
            __builtin_amdgcn_fence(__ATOMIC_ACQUIRE, "agent");
            xb_add(&bar[XB_XGEN(b.x)], 1u);
            asm volatile("s_waitcnt vmcnt(0)" ::: "memory");
        } else {
            XB_SPIN(xb_ld(&bar[XB_XGEN(b.x)]) == gen, bar);
            __builtin_amdgcn_fence(__ATOMIC_ACQUIRE, "agent");
            asm volatile("s_waitcnt vmcnt(0)" ::: "memory");
        }
    }
    __syncthreads();
}

__device__ __forceinline__ u16 f2bf(float f) { unsigned u = __float_as_uint(f); u += 0x7fffu + ((u >> 16) & 1u); return (u16)(u >> 16); }
__device__ __forceinline__ float bf2f(u16 h) { return __uint_as_float(((unsigned)h) << 16); }
__device__ __forceinline__ unsigned pack2(float a, float b) { return (unsigned)f2bf(a) | ((unsigned)f2bf(b) << 16); }
__device__ __forceinline__ float bflo(unsigned u) { return __uint_as_float(u << 16); }
__device__ __forceinline__ float bfhi(unsigned u) { return __uint_as_float(u & 0xffff0000u); }
__device__ __forceinline__ float siluf(float x) { return x / (1.f + __expf(-x)); }
__device__ __forceinline__ float sigmf(float x) { return 1.f / (1.f + __expf(-x)); }
__device__ __forceinline__ float softplusf(float x) { return x > 20.f ? x : log1pf(__expf(x)); }
__device__ __forceinline__ float wave_sum(float v) {
#pragma unroll
    for (int o = 32; o > 0; o >>= 1) v += __shfl_xor(v, o);
    return v;
}
__device__ __forceinline__ int swz256(int row, int chunk) { return row * 256 + ((chunk ^ (row & 15)) << 4); }
__device__ __forceinline__ int colmajor_src_row(int R) {
    if (R >= MLAT) return R;
    const int b = R >> 12, lp = R & 4095;
    return (b << 12) + ((lp & 63) << 6) + (lp >> 6);
}

__device__ __forceinline__ void load_tile128(char* lds, int lrow0, const u16* __restrict__ g, size_t ld, int rows, int t, int nthr) {
#pragma unroll 4
    for (int q = t; q < rows * 16; q += nthr) {
        const int r = q >> 4, c = q & 15;
        const uint4 v = *(const uint4*)(g + (size_t)r * ld + c * 8);
        *(uint4*)(lds + swz256(lrow0 + r, c)) = v;
    }
}
__device__ __forceinline__ void load_tile128_scaled(char* lds, int lrow0, const u16* __restrict__ g, size_t ld, int rows, const float* w, int t, int nthr) {
#pragma unroll 2
    for (int q = t; q < rows * 16; q += nthr) {
        const int r = q >> 4, c = q & 15;
        const uint4 v = *(const uint4*)(g + (size_t)r * ld + c * 8);
        const float* ww = w + c * 8;
        uint4 o;
        o.x = pack2(bflo(v.x) * ww[0], bfhi(v.x) * ww[1]);
        o.y = pack2(bflo(v.y) * ww[2], bfhi(v.y) * ww[3]);
        o.z = pack2(bflo(v.z) * ww[4], bfhi(v.z) * ww[5]);
        o.w = pack2(bflo(v.w) * ww[6], bfhi(v.w) * ww[7]);
        *(uint4*)(lds + swz256(lrow0 + r, c)) = o;
    }
}
template <int MI, int NJ>
__device__ __forceinline__ void lds_mma(const char* A, const char* B, int arow0, int brow0, f32x4 (&acc)[MI][NJ], int lane) {
#pragma unroll 1
    for (int kk = 0; kk < 4; ++kk) {
        const int chunk = kk * 4 + (lane >> 4);
        bf16x8 a[MI], b[NJ];
#pragma unroll
        for (int i = 0; i < MI; ++i) { const int row = arow0 + i * 16 + (lane & 15); a[i] = *(const bf16x8*)(A + swz256(row, chunk)); }
#pragma unroll
        for (int j = 0; j < NJ; ++j) { const int row = brow0 + j * 16 + (lane & 15); b[j] = *(const bf16x8*)(B + swz256(row, chunk)); }
#pragma unroll
        for (int i = 0; i < MI; ++i)
#pragma unroll
            for (int j = 0; j < NJ; ++j) acc[i][j] = __builtin_amdgcn_mfma_f32_16x16x32_bf16(a[i], b[j], acc[i][j], 0, 0, 0);
    }
}
template <int MI, int NJ>
__device__ __forceinline__ void lds_mma_t(const char* A, const char* B, int arow0, int brow0, f32x4 (&acc)[MI][NJ], int lane) {
#pragma unroll 1
    for (int kk = 0; kk < 4; ++kk) {
        const int chunk = kk * 4 + (lane >> 4);
        bf16x8 a[MI], b[NJ];
#pragma unroll
        for (int i = 0; i < MI; ++i) { const int row = arow0 + i * 16 + (lane & 15); a[i] = *(const bf16x8*)(A + swz256(row, chunk)); }
#pragma unroll
        for (int j = 0; j < NJ; ++j) { const int row = brow0 + j * 16 + (lane & 15); b[j] = *(const bf16x8*)(B + swz256(row, chunk)); }
#pragma unroll
        for (int i = 0; i < MI; ++i)
#pragma unroll
            for (int j = 0; j < NJ; ++j) acc[i][j] = __builtin_amdgcn_mfma_f32_16x16x32_bf16(b[j], a[i], acc[i][j], 0, 0, 0);
    }
}
template <int MI, int NJ>
__device__ __forceinline__ void zero_acc(f32x4 (&acc)[MI][NJ]) {
#pragma unroll
    for (int i = 0; i < MI; ++i)
#pragma unroll
        for (int j = 0; j < NJ; ++j) acc[i][j] = f32x4{0.f, 0.f, 0.f, 0.f};
}
template <int OP>
__device__ __forceinline__ float scan_pair(float v, float* buf, int t) {
    const int idx = t & 127, base = t & 128;
    const bool act = t < 256;
    if (act) buf[t] = v;
    __syncthreads();
#pragma unroll 1
    for (int off = 1; off < 128; off <<= 1) {
        float o = OP ? -INFINITY : 0.f;
        if (act && idx >= off) o = buf[base + idx - off];
        __syncthreads();
        v = OP ? fmaxf(v, o) : v + o;
        if (act) buf[t] = v;
        __syncthreads();
    }
    return v;
}

__device__ __forceinline__ float wave_scan_sum(float v, int lane) {
#pragma unroll
    for (int off = 1; off < 64; off <<= 1) { const float o = __shfl_up(v, off); if (lane >= off) v += o; }
    return v;
}
__device__ __forceinline__ float wave_scan_max(float v, int lane) {
#pragma unroll
    for (int off = 1; off < 64; off <<= 1) { const float o = __shfl_up(v, off); if (lane >= off) v = fmaxf(v, o); }
    return v;
}
__device__ __forceinline__ float wave_max(float v) {
#pragma unroll
    for (int o = 32; o > 0; o >>= 1) v = fmaxf(v, __shfl_xor(v, o));
    return v;
}
__device__ __forceinline__ void transpose_tile(float* tile, const float* __restrict__ src, int ld_src, int k0, int n0, int ncount,
                                               u16* dst, size_t dst_row0, int ld_dst, const float* __restrict__ scale, int scale_kmax, int t) {
    const int n = t & 63, kq = t >> 6;
    const int nc = n < ncount ? n : ncount - 1;
    float vv[16];
#pragma unroll
    for (int i = 0; i < 16; ++i) vv[i] = src[(size_t)(k0 + i * 4 + kq) * ld_src + n0 + nc];
#pragma unroll
    for (int i = 0; i < 16; ++i) {
        const int k = i * 4 + kq;
        float v = vv[i];
        if (scale && (k0 + k) < scale_kmax) v *= scale[k0 + k];
        tile[k * 65 + n] = n < ncount ? v : 0.f;
    }
    __syncthreads();
#pragma unroll
    for (int i = 0; i < 2; ++i) {
        const int q = t + 256 * i, nn = q >> 3, kc = q & 7;
        if (nn < ncount) {
            const float* p = tile + (kc * 8) * 65 + nn;
            uint4 o;
            o.x = pack2(p[0], p[65]); o.y = pack2(p[130], p[195]); o.z = pack2(p[260], p[325]); o.w = pack2(p[390], p[455]);
            *(uint4*)(dst + (dst_row0 + nn) * (size_t)ld_dst + k0 + kc * 8) = o;
        }
    }
    __syncthreads();
}

__device__ __forceinline__ void transpose_tile_w(float* tile, const float* __restrict__ src, int ld_src, int k0, int n0,
                                                 u16* dst, size_t dst_row0, int ld_dst, const float* __restrict__ scale, int scale_kmax, int t) {
    float4 v[8];
#pragma unroll
    for (int i = 0; i < 8; ++i) { const int q = t + 256 * i, kr = q >> 5, nq = q & 31; v[i] = *(const float4*)(src + (size_t)(k0 + kr) * ld_src + n0 + nq * 4); }
#pragma unroll
    for (int i = 0; i < 8; ++i) {
        const int q = t + 256 * i, kr = q >> 5, nq = q & 31;
        float sc = 1.f;
        if (scale && (k0 + kr) < scale_kmax) sc = scale[k0 + kr];
        float* p = tile + kr * 129 + nq * 4;
        p[0] = v[i].x * sc; p[1] = v[i].y * sc; p[2] = v[i].z * sc; p[3] = v[i].w * sc;
    }
    __syncthreads();
#pragma unroll
    for (int i = 0; i < 4; ++i) {
        const int q = t + 256 * i, nn = q >> 3, kc = q & 7;
        const float* p = tile + (kc * 8) * 129 + nn;
        uint4 o;
        o.x = pack2(p[0], p[129]); o.y = pack2(p[258], p[387]); o.z = pack2(p[516], p[645]); o.w = pack2(p[774], p[903]);
        *(uint4*)(dst + (dst_row0 + nn) * (size_t)ld_dst + k0 + kc * 8) = o;
    }
    __syncthreads();
}

namespace g8 {
constexpr int BM = 256, BK = 64, HALF = 128, HTB = HALF * BK * 2, STAGE_BYTES = 8 * HTB;
__device__ __forceinline__ int lds_byte(int r, int c) { const int st = (r >> 4) * 2 + (c >> 5), rr = r & 15, cc = c & 31, ob = rr * 64 + cc * 2; return st * 1024 + (ob ^ (((ob >> 9) & 1) << 5)); }
__device__ __forceinline__ void stage_rc(int b, int& R, int& C) { const int st = b / 1024, sb = b % 1024, swz = sb ^ (((sb >> 9) & 1) << 5); R = (st >> 1) * 16 + swz / 64; C = (st & 1) * 32 + (swz % 64) / 2; }
__device__ __forceinline__ int perm32(int rho) { const int n = rho >> 4, i = rho & 15; return 8 * (i >> 2) + 4 * n + (i & 3); }
__device__ __forceinline__ unsigned cvt_pk_bf16(float lo, float hi) { unsigned r; asm volatile("v_cvt_pk_bf16_f32 %0, %1, %2" : "=v"(r) : "v"(lo), "v"(hi)); return r; }
typedef f32x4 Acc[2][2][4][2];

template <class Prob>
__device__ __forceinline__ int gemm_phase(LAS unsigned char* lds, const Prob& S, int i0 = 0) {
    const int tid = threadIdx.x, wid = __builtin_amdgcn_readfirstlane(tid >> 6), lane = tid & 63, wr = wid >> 2, wc = wid & 3, fr = lane & 15, fq = lane >> 4;
    int nt = 0;
    const size_t kstep = (size_t)(BK * 2);
    const unsigned ldsw = (unsigned)wid * 1024u;
    const int aoff = lds_byte(wr * 64 + fr, fq * 8), boff = lds_byte(wc * 32 + fr, fq * 8);
#define G8_SA(b, h) (((b) * 2 + (h)) * HTB)
#define G8_SB(b, h) ((4 + (b) * 2 + (h)) * HTB)
#define G8_STAGE(bufoff, gbase, voff) do { _Pragma("unroll") for (int _i = 0; _i < 2; ++_i) \
        __builtin_amdgcn_global_load_lds((const unsigned*)((const char*)(gbase) + (voff)[_i]), (LAS unsigned*)(lds + (bufoff) + ldsw + _i * 8192), 16, 0, 0); } while (0)
#define G8_LDA(dst, b, h) do { _Pragma("unroll") for (int m = 0; m < 4; ++m) _Pragma("unroll") for (int k = 0; k < 2; ++k) dst[m][k] = *(const LAS bf16x8*)(lds + G8_SA(b, h) + aoff + m * 2048 + k * 1024); } while (0)
#define G8_LDB(dst, b, h) do { _Pragma("unroll") for (int n = 0; n < 2; ++n) _Pragma("unroll") for (int k = 0; k < 2; ++k) dst[n][k] = *(const LAS bf16x8*)(lds + G8_SB(b, h) + boff + n * 2048 + k * 1024); } while (0)
#define G8_MMA(ai, bj, At, Bt) do { __builtin_amdgcn_s_setprio(1); _Pragma("unroll") for (int m = 0; m < 4; ++m) _Pragma("unroll") for (int n = 0; n < 2; ++n) _Pragma("unroll") for (int k = 0; k < 2; ++k) \
        acc[ai][bj][m][n] = __builtin_amdgcn_mfma_f32_16x16x32_bf16(Bt[n][k], At[m][k], acc[ai][bj][m][n], 0, 0, 0); __builtin_amdgcn_s_setprio(0); } while (0)
#define G8_WAIT_V(n) asm volatile("s_waitcnt vmcnt(" #n ")" ::: "memory")
#define G8_WAIT_L(n) asm volatile("s_waitcnt lgkmcnt(" #n ")" ::: "memory")
#define G8_BAR __builtin_amdgcn_s_barrier()
#define G8_SCHED __builtin_amdgcn_sched_barrier(0)
    typename Prob::Unit cur, nxt; int ui = i0; bool stopped = false;
    if (!S.next(i0, cur)) return -1;
    nt = S.nt(cur);
    S.a_ready(cur);
    Acc acc;
#pragma unroll
    for (int a = 0; a < 2; ++a)
#pragma unroll
        for (int b = 0; b < 2; ++b)
#pragma unroll
            for (int m = 0; m < 4; ++m)
#pragma unroll
                for (int n = 0; n < 2; ++n) acc[a][b][m][n] = (f32x4){0.f, 0.f, 0.f, 0.f};
    bf16x8 At[4][2], B0[2][2], B1[2][2];
    unsigned cOA[2][2], cOB[2][2], nOA[2][2], nOB[2][2];
    S.offs(cur, tid, cOA, cOB);
    const char* cA = S.baseA(cur); const char* cB = S.baseB(cur);
    G8_STAGE(G8_SB(0, 0), cB, cOB[0]); G8_STAGE(G8_SA(0, 0), cA, cOA[0]); G8_STAGE(G8_SB(0, 1), cB, cOB[1]); G8_STAGE(G8_SA(0, 1), cA, cOA[1]);
    if (wr == 1) G8_BAR;
    G8_WAIT_V(4); G8_BAR;
    G8_STAGE(G8_SB(1, 0), cB + kstep, cOB[0]); G8_STAGE(G8_SA(1, 0), cA + kstep, cOA[0]); G8_STAGE(G8_SB(1, 1), cB + kstep, cOB[1]);
    G8_WAIT_V(6); G8_BAR;
    for (;;) {
        bool has_next = S.next(ui + 1, nxt);
        if (has_next && S.brk(cur, nxt)) { has_next = false; stopped = true; }
        const char* nA = cA; const char* nB = cB;
#pragma unroll
        for (int h = 0; h < 2; ++h)
#pragma unroll
            for (int i = 0; i < 2; ++i) { nOA[h][i] = cOA[h][i]; nOB[h][i] = cOB[h][i]; }
        if (has_next) { S.offs(nxt, tid, nOA, nOB); nA = S.baseA(nxt); nB = S.baseB(nxt); }
#pragma unroll 1
        for (int t = 0; t < nt; t += 2) {
            const bool last = (t == nt - 2);
            if (Prob::MIDT > 0 && t == Prob::MIDT) S.mid(acc, cur, wr, fr);
            if (last && has_next) S.a_ready(nxt);
            const char* a1 = cA + (size_t)(t + 1) * kstep;
            const char* a2 = last ? nA : cA + (size_t)(t + 2) * kstep; const char* b2 = last ? nB : cB + (size_t)(t + 2) * kstep;
            const char* a3 = a2 + kstep; const char* b3 = b2 + kstep;
            unsigned xA[2][2], xB[2][2];
#pragma unroll
            for (int h = 0; h < 2; ++h)
#pragma unroll
                for (int i = 0; i < 2; ++i) { xA[h][i] = last ? nOA[h][i] : cOA[h][i]; xB[h][i] = last ? nOB[h][i] : cOB[h][i]; }
            G8_LDB(B0, 0, 0); G8_SCHED; G8_LDA(At, 0, 0); G8_STAGE(G8_SA(1, 1), a1, cOA[1]);
            G8_WAIT_L(8); G8_BAR; G8_WAIT_L(0); G8_MMA(0, 0, At, B0); G8_BAR; G8_SCHED;
            G8_LDB(B1, 0, 1); G8_STAGE(G8_SB(0, 0), b2, xB[0]);
            G8_BAR; G8_WAIT_L(0); G8_MMA(0, 1, At, B1); G8_BAR;
            G8_LDA(At, 0, 1); G8_STAGE(G8_SA(0, 0), a2, xA[0]);
            G8_BAR; G8_WAIT_L(0); G8_MMA(1, 0, At, B0); G8_BAR; G8_SCHED;
            G8_STAGE(G8_SB(0, 1), b2, xB[1]);
            G8_WAIT_V(6); G8_BAR; G8_MMA(1, 1, At, B1); G8_BAR;
            G8_LDB(B0, 1, 0); G8_SCHED; G8_LDA(At, 1, 0); G8_STAGE(G8_SA(0, 1), a2, xA[1]);
            G8_WAIT_L(8); G8_BAR; G8_WAIT_L(0); G8_MMA(0, 0, At, B0); G8_BAR; G8_SCHED;
            G8_LDB(B1, 1, 1); G8_STAGE(G8_SB(1, 0), b3, xB[0]);
            G8_BAR; G8_WAIT_L(0); G8_MMA(0, 1, At, B1); G8_BAR;
            G8_LDA(At, 1, 1); G8_STAGE(G8_SA(1, 0), a3, xA[0]);
            G8_BAR; G8_WAIT_L(0); G8_MMA(1, 0, At, B0); G8_BAR; G8_SCHED;
            G8_STAGE(G8_SB(1, 1), b3, xB[1]);
            G8_WAIT_V(6); G8_BAR; G8_MMA(1, 1, At, B1); G8_BAR;
        }
        S.epi(acc, cur, wr, wc, fr, fq);
        S.done(cur);
        if (!has_next) break;
#pragma unroll
        for (int a = 0; a < 2; ++a)
#pragma unroll
            for (int b = 0; b < 2; ++b)
#pragma unroll
                for (int m = 0; m < 4; ++m)
#pragma unroll
                    for (int n = 0; n < 2; ++n) acc[a][b][m][n] = (f32x4){0.f, 0.f, 0.f, 0.f};
        cur = nxt; cA = nA; cB = nB; ++ui; nt = S.nt(cur);
#pragma unroll
        for (int h = 0; h < 2; ++h)
#pragma unroll
            for (int i = 0; i < 2; ++i) { cOA[h][i] = nOA[h][i]; cOB[h][i] = nOB[h][i]; }
    }
    G8_WAIT_V(0);
    if (wr == 0) G8_BAR;
    G8_BAR;
    const int ret_next = stopped ? ui + 1 : -1;
#undef G8_SA
#undef G8_SB
#undef G8_STAGE
#undef G8_LDA
#undef G8_LDB
#undef G8_MMA
#undef G8_WAIT_V
#undef G8_WAIT_L
#undef G8_BAR
#undef G8_SCHED
    return ret_next;
}
__device__ __forceinline__ void dense_unit(int wgid, int nM, int nN, int& pm, int& pn) {
    const int nwg = nM * nN, NXCD = 8, WGM = 8;
    { const int q = nwg / NXCD, r = nwg % NXCD, xcd = wgid % NXCD, off = wgid / NXCD; wgid = (xcd < r ? xcd * (q + 1) : r * (q + 1) + (xcd - r) * q) + off; }
    const int nig = WGM * nN, gid = wgid / nig, fm = gid * WGM, gsz = (nM - fm) < WGM ? (nM - fm) : WGM;
    pm = fm + ((wgid % nig) % gsz); pn = (wgid % nig) / gsz;
}
}

__device__ void phase0(const Params& P, char* lds_all) {
    unsigned char* ws = P.ws;
    const int vb = threadIdx.x >> 8, t = threadIdx.x & 255;
    char* lds = lds_all + vb * VLDS;
    float* tile = (float*)lds;
    const int NU = 744;
    for (int u = blockIdx.x * 2 + vb; u < NU; u += gridDim.x * 2) {
        if (u < 384) {
            int nt, v, n0b, drb;
            if (u < 192) { v = u; n0b = 0; drb = 0; }
            else if (u < 256) { v = u - 192; n0b = 1552; drb = 1536; }
            else if (u < 320) { v = u - 256; n0b = 2576; drb = 2048; }
            else { v = u - 320; n0b = 2064; drb = 2816; }
            nt = v >> 4;
            transpose_tile_w(tile, P.in[I_WIN], 3104, (v & 15) * 64, n0b + nt * 128, (u16*)(ws + O_WIN), drb + nt * 128, 1024, nullptr, 0, t);
        } else if (u < 416) {
            const int v = u - 384;
            if (v < 16) transpose_tile(tile, P.in[I_WIN], 3104, v * 64, 1536, 16, (u16*)(ws + O_WIN), 2560, 1024, nullptr, 0, t);
            else transpose_tile(tile, P.in[I_WIN], 3104, (v - 16) * 64, 3088, 16, (u16*)(ws + O_WIN), 2576, 1024, nullptr, 0, t);
        } else if (u < 544) {
            const int v = u - 416, nt = v >> 4;
            transpose_tile_w(tile, P.in[I_WOUT], 1024, (v & 15) * 64, nt * 128, (u16*)(ws + O_WOUT), nt * 128, 1024, P.in[I_SNW], 512, t);
        } else if (u < 552) {
            const int base = (u - 544) * 4096;
            for (int i = 0; i < 16; ++i) {
                const int idx = base + t + 256 * i;
                if (idx < 224 * 128) *(uint4*)(ws + O_WIN + ((size_t)(2592 + (idx >> 7)) * 1024 + (idx & 127) * 8) * 2) = make_uint4(0, 0, 0, 0);
            }
        } else {
            const int c0 = (u - 552) * 32;
            float* sc = (float*)lds;
            float* red = sc + 5 * 1024;
            for (int i = t; i < 5 * 1024; i += 256) {
                const int r = i >> 10, k = i & 1023;
                const float v = r < 4 ? P.in[I_C][r * 1024 + k] : P.in[I_CCTX][k];
                sc[i] = siluf(v);
            }
            __syncthreads();
            const int cq = t & 7, kg = t >> 3;
            float4 a0 = {0, 0, 0, 0}, a1 = a0, a2 = a0, a3 = a0, a4 = a0;
            const float* wp = P.in[I_WMOD] + (size_t)(kg * 32) * 6144 + c0 + cq * 4;
#pragma unroll 16
            for (int k = 0; k < 32; ++k) {
                const float4 wv = *(const float4*)(wp + (size_t)k * 6144);
                const int kk = kg * 32 + k;
                const float s0 = sc[kk], s1 = sc[1024 + kk], s2 = sc[2048 + kk], s3 = sc[3072 + kk], s4 = sc[4096 + kk];
                a0.x += s0 * wv.x; a0.y += s0 * wv.y; a0.z += s0 * wv.z; a0.w += s0 * wv.w;
                a1.x += s1 * wv.x; a1.y += s1 * wv.y; a1.z += s1 * wv.z; a1.w += s1 * wv.w;
                a2.x += s2 * wv.x; a2.y += s2 * wv.y; a2.z += s2 * wv.z; a2.w += s2 * wv.w;
                a3.x += s3 * wv.x; a3.y += s3 * wv.y; a3.z += s3 * wv.z; a3.w += s3 * wv.w;
                a4.x += s4 * wv.x; a4.y += s4 * wv.y; a4.z += s4 * wv.z; a4.w += s4 * wv.w;
            }
            *(float4*)(red + ((kg * 5 + 0) * 32) + cq * 4) = a0; *(float4*)(red + ((kg * 5 + 1) * 32) + cq * 4) = a1;
            *(float4*)(red + ((kg * 5 + 2) * 32) + cq * 4) = a2; *(float4*)(red + ((kg * 5 + 3) * 32) + cq * 4) = a3;
            *(float4*)(red + ((kg * 5 + 4) * 32) + cq * 4) = a4;
            __syncthreads();
            if (t < 160) {
                const int r = t >> 5, cc = t & 31;
                float s = P.in[I_BMOD][c0 + cc];
#pragma unroll
                for (int g = 0; g < 32; ++g) s += red[(g * 5 + r) * 32 + cc];
                ((float*)(ws + O_MOD))[r * 6144 + c0 + cc] = s;
            }
            __syncthreads();
        }
    }
    if (blockIdx.x == 0 && threadIdx.x < 32) ((int*)(ws + O_CNT))[threadIdx.x * 64] = 0;
}

__device__ void phase1(const Params& P) {
    unsigned char* ws = P.ws;
    const int lane = threadIdx.x & 63;
    const int gw = blockIdx.x * 8 + (threadIdx.x >> 6), nw = gridDim.x * 8;
    const float* mod = (const float*)(ws + O_MOD);
    u16* xn = (u16*)(ws + O_XN);
    const int r_lo = (int)(((long long)gw * MALL) / nw), r_hi = (int)(((long long)(gw + 1) * MALL) / nw);
    float4 mul[4], sh[4];
    int cur_mb = -1;
    for (int row = r_lo; row < r_hi; row += 2) {
        const bool two = row + 1 < r_hi;
        const int row1 = two ? row + 1 : row;
        const float* x0 = row < MLAT ? P.in[I_X] + (size_t)row * 1024 : P.in[I_CTX] + (size_t)(row - MLAT) * 1024;
        const float* x1 = row1 < MLAT ? P.in[I_X] + (size_t)row1 * 1024 : P.in[I_CTX] + (size_t)(row1 - MLAT) * 1024;
        float4 v0[4], v1[4];
#pragma unroll
        for (int j = 0; j < 4; ++j) { v0[j] = ((const float4*)x0)[lane + 64 * j]; v1[j] = ((const float4*)x1)[lane + 64 * j]; }
        const int mb0 = row < MLAT ? (row >> 12) : 4, mb1 = row1 < MLAT ? (row1 >> 12) : 4;
        float s0 = 0.f, s1 = 0.f;
#pragma unroll
        for (int j = 0; j < 4; ++j) {
            s0 += v0[j].x * v0[j].x + v0[j].y * v0[j].y + v0[j].z * v0[j].z + v0[j].w * v0[j].w;
            s1 += v1[j].x * v1[j].x + v1[j].y * v1[j].y + v1[j].z * v1[j].z + v1[j].w * v1[j].w;
        }
        s0 = rsqrtf(wave_sum(s0) * (1.f / 1024.f) + 1e-6f);
        s1 = rsqrtf(wave_sum(s1) * (1.f / 1024.f) + 1e-6f);
#pragma unroll 1
        for (int rr = 0; rr < 2; ++rr) {
            const int mb = rr ? mb1 : mb0;
            if (mb != cur_mb) {
                cur_mb = mb;
#pragma unroll
                for (int j = 0; j < 4; ++j) {
                    const int k = (lane + 64 * j) * 4;
                    const float4 nwv = *(const float4*)(P.in[I_N1W] + k);
                    const float4 sc = *(const float4*)(mod + mb * 6144 + 1024 + k);
                    sh[j] = *(const float4*)(mod + mb * 6144 + k);
                    mul[j].x = nwv.x * (1.f + sc.x); mul[j].y = nwv.y * (1.f + sc.y); mul[j].z = nwv.z * (1.f + sc.z); mul[j].w = nwv.w * (1.f + sc.w);
                }
            }
            if (rr == 1 && !two) break;
            const float rstd = rr ? s1 : s0;
            const int orow = rr ? row1 : row;
#pragma unroll
            for (int j = 0; j < 4; ++j) {
                const int k = (lane + 64 * j) * 4;
                const float4 vv = rr ? v1[j] : v0[j];
                uint2 o;
                o.x = pack2(vv.x * rstd * mul[j].x + sh[j].x, vv.y * rstd * mul[j].y + sh[j].y);
                o.y = pack2(vv.z * rstd * mul[j].z + sh[j].z, vv.w * rstd * mul[j].w + sh[j].w);
                *(uint2*)(xn + (size_t)orow * 1024 + k) = o;
            }
        }
    }
}

struct InProj {
    static constexpr int K = 1024; static constexpr bool PERM = true; static constexpr int MIDT = 0;
    struct Unit { int pm, pn, vt; };
    const unsigned char* ws; int G, c;
    __device__ __forceinline__ bool next(int i, Unit& u) const {
        const int L = i * G + c;
        if (L >= 884) return false;
        if (L < 748) { u.vt = 0; g8::dense_unit(L, 68, 11, u.pm, u.pn); }
        else { const int v = L - 748; u.vt = 1; u.pm = v / 68; u.pn = v % 68; }
        return true;
    }
    __device__ __forceinline__ const char* baseA(const Unit& u) const { return (const char*)(ws + (u.vt ? O_WIN : O_XN)); }
    __device__ __forceinline__ const char* baseB(const Unit& u) const { return (const char*)(ws + (u.vt ? O_XN : O_WIN)); }
    __device__ __forceinline__ void offs(const Unit& u, int tid_, unsigned (&oa)[2][2], unsigned (&ob)[2][2]) const {
        int R[2], C[2];
        { int tq = tid_; asm volatile("" : "+v"(tq)); g8::stage_rc(tq * 16, R[0], C[0]); g8::stage_rc(tq * 16 + 8192, R[1], C[1]); }
#pragma unroll
        for (int h = 0; h < 2; ++h)
#pragma unroll
            for (int i = 0; i < 2; ++i) {
                const int Rb = (R[i] & ~31) + g8::perm32(R[i] & 31);
                if (!u.vt) {
                    int ar = u.pm * 256 + h * 128 + R[i];
                    if (u.pn == 6 || u.pn == 7) ar = colmajor_src_row(ar);
                    oa[h][i] = (unsigned)(ar * 1024 + C[i]) * 2u;
                    ob[h][i] = (unsigned)((u.pn * 256 + h * 128 + Rb) * 1024 + C[i]) * 2u;
                } else {
                    oa[h][i] = (unsigned)((2816 + u.pm * 256 + h * 128 + R[i]) * 1024 + C[i]) * 2u;
                    ob[h][i] = (unsigned)(colmajor_src_row(u.pn * 256 + h * 128 + Rb) * 1024 + C[i]) * 2u;
                }
            }
    }
    __device__ __forceinline__ void mid(g8::Acc&, const Unit&, int, int) const {}
    __device__ __forceinline__ int nt(const Unit&) const { return 16; }
    __device__ __forceinline__ bool brk(const Unit&, const Unit&) const { return false; }
    __device__ __forceinline__ void a_ready(const Unit&) const {}
    __device__ __forceinline__ void done(const Unit&) const {}
    __device__ __forceinline__ void epi(g8::Acc& acc, const Unit& u, int wr, int wc, int fr, int fq) const {
        unsigned char* w = (unsigned char*)ws;
        const int row0 = u.pm * 256 + wr * 64 + fr;
        const int col0 = wc * 32 + 8 * fq;
        if (u.vt) {
            const int tok0 = u.pn * 256 + col0;
#pragma unroll
            for (int ai = 0; ai < 2; ++ai)
#pragma unroll
                for (int m = 0; m < 4; ++m) {
                    const int ch = row0 + ai * 128 + m * 16;
#pragma unroll
                    for (int bj = 0; bj < 2; ++bj) {
                        const int tk = tok0 + bj * 128;
                        u16* d;
                        int ctile, lw;
                        if (tk < MLAT) { ctile = (tk >> 12) * NCH + 2 + ((tk & 4095) >> 7); lw = tk & 127; }
                        else { const int tc = tk - MLAT; ctile = (tc >> 8) * NCH + ((tc & 255) >> 7); lw = tc & 127; }
                        d = (u16*)(w + O_VT) + ((size_t)ctile * 512 + ch) * 128 + lw;
                        const f32x4 v0 = acc[ai][bj][m][0], v1 = acc[ai][bj][m][1];
                        u32x4 o; o.x = g8::cvt_pk_bf16(v0[0], v0[1]); o.y = g8::cvt_pk_bf16(v0[2], v0[3]); o.z = g8::cvt_pk_bf16(v1[0], v1[1]); o.w = g8::cvt_pk_bf16(v1[2], v1[3]);
                        *(u32x4*)d = o;
                    }
                }
            return;
        }
        if (u.pn == 10) {
            if (wc == 0) {
                float* dst = (float*)(w + (fq < 2 ? O_PSD : O_PSG)) + (fq & 1) * 8;
#pragma unroll
                for (int ai = 0; ai < 2; ++ai)
#pragma unroll
                    for (int m = 0; m < 4; ++m) {
                        float* d = dst + (size_t)(row0 + ai * 128 + m * 16) * 16;
                        *(f32x4*)d = acc[ai][0][m][0];
                        *(f32x4*)(d + 4) = acc[ai][0][m][1];
                    }
            }
            return;
        }
        u16* base; size_t ld, bjstep;
        if (u.pn < 2) { base = (u16*)(w + O_ZO) + u.pn * 256 + col0; ld = 1024; bjstep = 128; }
        else if (u.pn < 8) {
            const int cg0 = (u.pn - 2) * 4 + (col0 >> 6);
            base = (u16*)(w + O_PT) + (size_t)cg0 * MALL * 64 + (col0 & 63); ld = 64; bjstep = (size_t)2 * MALL * 64;
        }
        else { base = (u16*)(w + O_ZO) + 512 + (u.pn - 8) * 256 + col0; ld = 1024; bjstep = 128; }
#pragma unroll
        for (int ai = 0; ai < 2; ++ai)
#pragma unroll
            for (int m = 0; m < 4; ++m) {
                u16* rowp = base + (size_t)(row0 + ai * 128 + m * 16) * ld;
#pragma unroll
                for (int bj = 0; bj < 2; ++bj) {
                    const f32x4 v0 = acc[ai][bj][m][0], v1 = acc[ai][bj][m][1];
                    u32x4 o; o.x = g8::cvt_pk_bf16(v0[0], v0[1]); o.y = g8::cvt_pk_bf16(v0[2], v0[3]); o.z = g8::cvt_pk_bf16(v1[0], v1[1]); o.w = g8::cvt_pk_bf16(v1[2], v1[3]);
                    *(u32x4*)(rowp + bj * bjstep) = o;
                }
            }
    }
};

__device__ void phase3(const Params& P, char* lds_all) {
    unsigned char* ws = P.ws;
    const int vb = threadIdx.x >> 8, t = threadIdx.x & 255;
    char* lds = lds_all + vb * VLDS;
    u16* raw = (u16*)lds;
    float* xcl = (float*)(lds + 132 * 128);
    const u16* pt = (const u16*)(ws + O_PT);
    const int NCONV = 136 * 24;
    const int NU = NCONV + 136;
    for (int u = blockIdx.x * 2 + vb; u < NU; u += gridDim.x * 2) {
        if (u >= NCONV) {
            const int ct = u - NCONV, b = ct / NCH, cc = ct % NCH;
            const int rb = cc < 2 ? MLAT + b * 256 + cc * 128 : b * 4096 + (cc - 2) * 128;
            const int row = rb + (t >> 1), half = t & 1;
            const float* psd = (const float*)(ws + O_PSD) + (size_t)row * 16 + half * 8;
            float* dt = (float*)(ws + O_DT) + (size_t)row * 16 + half * 8;
#pragma unroll
            for (int j = 0; j < 8; ++j) dt[j] = softplusf(psd[j] + P.in[I_DTB][half * 8 + j]);
            const float* psg = (const float*)(ws + O_PSG) + (size_t)colmajor_src_row(row) * 16;
            if (half == 0) {
                float* gi = (float*)(ws + O_GI) + (size_t)row * 8;
#pragma unroll
                for (int j = 0; j < 8; ++j) gi[j] = psg[j] + P.in[I_GB][j];
            } else {
                float* gf = (float*)(ws + O_GF) + (size_t)row * 8;
#pragma unroll
                for (int j = 0; j < 8; ++j) { const float xx = psg[8 + j] + P.in[I_GB][8 + j]; gf[j] = fminf(xx, 0.f) - log1pf(__expf(-fabsf(xx))); }
            }
            continue;
        }
        const int ct = u / 24, cgp = u % 24;
        const int b = ct / NCH, cc = ct % NCH;
        const bool isctx = cc < 2;
        const int L = isctx ? 256 : 4096;
        const int lpos = isctx ? cc * 128 : (cc - 2) * 128;
        const int rb = isctx ? MLAT + b * 256 + cc * 128 : b * 4096 + (cc - 2) * 128;
        const int sb = rb - lpos;
        const bool isml = cgp >= 16;
        const int pcol = isml ? 1024 + (cgp - 16) * 64 : cgp * 64;
        for (int q = t; q < 132 * 8; q += 256) {
            const int r = q >> 3, c = q & 7;
            const int l = lpos - 2 + r;
            const int lc = l < 0 ? 0 : (l >= L ? L - 1 : l);
            uint4 v = *(const uint4*)(pt + ((size_t)cgp * MALL + sb + lc) * 64 + c * 8);
            if (l != lc) v = make_uint4(0, 0, 0, 0);
            *(uint4*)(raw + r * 64 + c * 8) = v;
        }
        __syncthreads();
        const int ch = t & 63, tg = t >> 6;
        const float* cw = isml ? P.in[I_MCW] + (cgp - 16) * 64 + ch : P.in[I_SCW] + cgp * 64 + ch;
        const int cwld = isml ? 512 : 1024;
        const float w0 = cw[0], w1 = cw[cwld], w2 = cw[2 * cwld], w3 = cw[3 * cwld], w4 = cw[4 * cwld];
        const float bias = isml ? P.in[I_MCB][(cgp - 16) * 64 + ch] : P.in[I_SCB][cgp * 64 + ch];
        const int tok0 = tg * 32;
        float x0 = bf2f(raw[(tok0 + 0) * 64 + ch]), x1 = bf2f(raw[(tok0 + 1) * 64 + ch]), x2 = bf2f(raw[(tok0 + 2) * 64 + ch]), x3 = bf2f(raw[(tok0 + 3) * 64 + ch]);
        if (!isml) {
            u16* tdst = nullptr; u16* ndst = nullptr;
            if (cgp < 8) {
                const int chg = cgp * 64 + ch;
                tdst = (u16*)(ws + O_XT) + ((size_t)ct * 512 + chg) * 128 + tok0;
            } else if (cgp < 12) {
                const int gn = (cgp - 8) * 64 + ch;
                tdst = (u16*)(ws + O_BT) + ((size_t)ct * 256 + gn) * 128 + tok0;
                ndst = (u16*)(ws + O_BM) + ((size_t)ct * 2 + (gn >> 7)) * 16384 + (size_t)tok0 * 128 + (gn & 127);
            } else {
                const int gn = (cgp - 12) * 64 + ch;
                ndst = (u16*)(ws + O_CM) + ((size_t)ct * 2 + (gn >> 7)) * 16384 + (size_t)tok0 * 128 + (gn & 127);
            }
#pragma unroll
            for (int o8 = 0; o8 < 4; ++o8) {
                float ov[8];
#pragma unroll
                for (int j = 0; j < 8; ++j) {
                    const int tok = tok0 + o8 * 8 + j;
                    const float x4 = bf2f(raw[(tok + 4) * 64 + ch]);
                    const float cv = bias + w0 * x0 + w1 * x1 + w2 * x2 + w3 * x3 + w4 * x4;
                    ov[j] = siluf(cv);
                    x0 = x1; x1 = x2; x2 = x3; x3 = x4;
                }
                if (tdst) { uint4 o; o.x = pack2(ov[0], ov[1]); o.y = pack2(ov[2], ov[3]); o.z = pack2(ov[4], ov[5]); o.w = pack2(ov[6], ov[7]); *(uint4*)(tdst + o8 * 8) = o; }
                if (ndst) {
#pragma unroll
                    for (int j = 0; j < 8; ++j) ndst[(size_t)(o8 * 8 + j) * 128] = f2bf(ov[j]);
                }
            }
            __syncthreads();
        } else {
            const int mg = cgp - 16;
            u16* xcd = (u16*)(ws + O_XC) + ((size_t)ct * 4 + (mg >> 1)) * 16384 + (size_t)tok0 * 128 + (mg & 1) * 64 + ch;
#pragma unroll 8
            for (int j = 0; j < 32; ++j) {
                const int tok = tok0 + j;
                const float x4 = bf2f(raw[(tok + 4) * 64 + ch]);
                const float cv = bias + w0 * x0 + w1 * x1 + w2 * x2 + w3 * x3 + w4 * x4;
                const float sv = siluf(cv);
                xcl[tok * 64 + ch] = sv;
                xcd[(size_t)j * 128] = f2bf(sv);
                x0 = x1; x1 = x2; x2 = x3; x3 = x4;
            }
            __syncthreads();
            const int n = ch >> 2, kk = ch & 3, ng = mg * 16 + n;
            const float* wq = P.in[I_WQK] + ((size_t)(0 * 128 + ng) * 4) * 4 + kk;
            const float* wk = P.in[I_WQK] + ((size_t)(1 * 128 + ng) * 4) * 4 + kk;
            const float q0 = wq[0], q1 = wq[4], q2 = wq[8], q3 = wq[12];
            const float k0 = wk[0], k1 = wk[4], k2 = wk[8], k3 = wk[12];
            const int chg = mg * 64 + ch;
            const size_t hoff = ((size_t)ct * 4 + (mg >> 1)) * 16384 + (size_t)tok0 * 128 + (mg & 1) * 64 + ch;
            u16* qd = (u16*)(ws + O_Q) + hoff;
            u16* kd = (u16*)(ws + O_K) + hoff;
            u16* ktd = (u16*)(ws + O_KT) + ((size_t)ct * 512 + chg) * 128 + tok0;
#pragma unroll
            for (int o8 = 0; o8 < 4; ++o8) {
                float kv[8];
#pragma unroll
                for (int j = 0; j < 8; ++j) {
                    const int tok = tok0 + o8 * 8 + j;
                    const float4 xv = *(const float4*)(xcl + tok * 64 + n * 4);
                    const float qv = xv.x * q0 + xv.y * q1 + xv.z * q2 + xv.w * q3;
                    kv[j] = (xv.x * k0 + xv.y * k1 + xv.z * k2 + xv.w * k3) * 0.08838834764831845f;
                    qd[(size_t)(o8 * 8 + j) * 128] = f2bf(qv);
                    kd[(size_t)(o8 * 8 + j) * 128] = f2bf(kv[j]);
                }
                uint4 o; o.x = pack2(kv[0], kv[1]); o.y = pack2(kv[2], kv[3]); o.z = pack2(kv[4], kv[5]); o.w = pack2(kv[6], kv[7]);
                *(uint4*)(ktd + o8 * 8) = o;
            }
            __syncthreads();
        }
    }
}

__device__ __forceinline__ u32x4 scale8(const u32x4 v, const float* ww) {
    u32x4 o;
    o.x = pack2(bflo(v.x) * ww[0], bfhi(v.x) * ww[1]); o.y = pack2(bflo(v.y) * ww[2], bfhi(v.y) * ww[3]);
    o.z = pack2(bflo(v.z) * ww[4], bfhi(v.z) * ww[5]); o.w = pack2(bflo(v.w) * ww[6], bfhi(v.w) * ww[7]);
    return o;
}
__device__ void phase4(const Params& P, char* lds_all) {
    unsigned char* ws = P.ws;
    const int vb = threadIdx.x >> 8, t0 = threadIdx.x & 255;
    char* lds = lds_all + vb * VLDS;
    char* T0 = lds; char* T1 = lds + 32768;
    float* sc = (float*)(lds + 65536);
    float* wA = sc + 256;
    float* wB = sc + 384;
    const int NSSD = 4 * NCH * 8, NML = 4 * NCH * 4;
    for (int u = blockIdx.x * 2 + vb; u < NSSD + NML; u += gridDim.x * 2) {
        int t = t0; asm volatile("" : "+v"(t));
        const int lane = t & 63, w = t >> 6, wm = w >> 1, wn = w & 1, lr = lane & 15, lq = lane >> 4;
        if (u < NSSD) {
            const int h = u & 7, ct = u >> 3, b = ct / NCH, cc = ct % NCH;
            const bool isctx = cc < 2;
            const int L = isctx ? 256 : 4096;
            const int lpos = isctx ? cc * 128 : (cc - 2) * 128;
            const int rb = isctx ? MLAT + b * 256 + cc * 128 : b * 4096 + (cc - 2) * 128;
            const int g = h >> 2;
            const u16* xt = (const u16*)(ws + O_XT) + ((size_t)ct * 512 + h * 64) * 128;
            const u16* bt = (const u16*)(ws + O_BT) + ((size_t)ct * 256 + g * 128) * 128;
            u32x4 rx[4], rbv[8];
#pragma unroll
            for (int i = 0; i < 4; ++i) { const int q = t + 256 * i, r = q >> 4, c = q & 15; rx[i] = *(const u32x4*)(xt + (size_t)r * 128 + c * 8); }
#pragma unroll
            for (int i = 0; i < 8; ++i) { const int q = t + 256 * i, r = q >> 4, c = q & 15; rbv[i] = *(const u32x4*)(bt + (size_t)r * 128 + c * 8); }
            if (w < 2) {
                const int dir = w;
                const int l0 = dir ? 127 - 2 * lane : 2 * lane, l1 = dir ? 126 - 2 * lane : 2 * lane + 1;
                const float* dtp = (const float*)(ws + O_DT) + (size_t)rb * 16 + dir * 8 + h;
                const float d0 = dtp[l0 * 16], d1 = dtp[l1 * 16];
                const float an = -__expf(P.in[I_ALOG][dir * 8 + h]);
                const float p0 = d0 * an, p1 = p0 + d1 * an;
                const float inc = wave_scan_sum(p1, lane);
                const float ex = inc - p1;
                const float tot = __shfl(inc, 63);
                float* wd = dir ? wB : wA;
                wd[l0] = __expf(tot - (ex + p0)) * d0; wd[l1] = __expf(tot - (ex + p1)) * d1;
                if (lane == 0) ((float*)(ws + O_ACH))[((size_t)(b * NCH + cc) * 8 + h) * 2 + dir] = tot;
            }
            __syncthreads();
#pragma unroll
            for (int i = 0; i < 4; ++i) {
                const int q = t + 256 * i, r = q >> 4, c = q & 15;
                *(u32x4*)(T0 + swz256(r, c)) = scale8(rx[i], wA + c * 8); *(u32x4*)(T0 + swz256(64 + r, c)) = scale8(rx[i], wB + c * 8);
            }
#pragma unroll
            for (int i = 0; i < 8; ++i) { const int q = t + 256 * i, r = q >> 4, c = q & 15; *(u32x4*)(T1 + swz256(r, c)) = rbv[i]; }
            __syncthreads();
            f32x4 acc[4][4]; zero_acc(acc);
            lds_mma_t<4, 4>(T0, T1, wm * 64, wn * 64, acc, lane);
            u16* st = (u16*)(ws + O_ST) + (((size_t)(b * NCH + cc) * 8 + h) * 2 + wm) * 8192 + lr * 128 + wn * 64 + lq * 4;
#pragma unroll
            for (int i = 0; i < 4; ++i)
#pragma unroll
                for (int j = 0; j < 4; ++j) {
                    uint2 o; o.x = pack2(acc[i][j][0], acc[i][j][1]); o.y = pack2(acc[i][j][2], acc[i][j][3]);
                    *(uint2*)(st + (i * 16) * 128 + j * 16) = o;
                }
            __syncthreads();
        } else {
            const int v = u - NSSD;
            const int h = v & 3, ct = v >> 2, b = ct / NCH, cc = ct % NCH;
            const bool isctx = cc < 2;
            const int L = isctx ? 256 : 4096;
            const int lpos = isctx ? cc * 128 : (cc - 2) * 128;
            const int rb = isctx ? MLAT + b * 256 + cc * 128 : b * 4096 + (cc - 2) * 128;
            const u16* vt = (const u16*)(ws + O_VT) + ((size_t)ct * 512 + h * 128) * 128;
            const u16* kt = (const u16*)(ws + O_KT) + ((size_t)ct * 512 + h * 128) * 128;
            u32x4 rv[8], rk[8];
#pragma unroll
            for (int i = 0; i < 8; ++i) {
                const int q = t + 256 * i, r = q >> 4, c = q & 15;
                rv[i] = *(const u32x4*)(vt + (size_t)r * 128 + c * 8);
                rk[i] = *(const u32x4*)(kt + (size_t)r * 128 + c * 8);
            }
            if (w < 2) {
                const int dir = w;
                const int s0 = dir ? 127 - 2 * lane : 2 * lane, s1 = dir ? 126 - 2 * lane : 2 * lane + 1;
                const float* gfp = (const float*)(ws + O_GF) + (size_t)rb * 8 + dir * 4 + h;
                const float* gip = (const float*)(ws + O_GI) + (size_t)rb * 8 + dir * 4 + h;
                const float f0 = gfp[s0 * 8], f1 = gfp[s1 * 8], i0 = gip[s0 * 8], i1 = gip[s1 * 8];
                const float p1 = f0 + f1;
                const float inc = wave_scan_sum(p1, lane);
                const float ex = inc - p1;
                const float tot = __shfl(inc, 63);
                const float av0 = tot - (ex + f0) + i0, av1 = tot - (ex + p1) + i1;
                const float mloc = wave_max(fmaxf(av0, av1));
                float* wd = dir ? wB : wA;
                wd[s0] = __expf(av0 - mloc); wd[s1] = __expf(av1 - mloc);
                if (lane == 0) {
                    float* mls = (float*)(ws + O_MLS) + (((size_t)(b * NCH + cc) * 4 + h) * 2 + dir) * 2;
                    mls[0] = mloc; mls[1] = tot;
                }
            }
            const int dir = t >> 7, idx = t & 127;
            __syncthreads();
#pragma unroll
            for (int d2 = 0; d2 < 2; ++d2) {
                const float* wsel = d2 ? wB : wA;
#pragma unroll
                for (int i = 0; i < 8; ++i) { const int q = t + 256 * i, r = q >> 4, c = q & 15; *(u32x4*)(T0 + swz256(r, c)) = scale8(rv[i], wsel + c * 8); }
                if (d2 == 0) {
#pragma unroll
                    for (int i = 0; i < 8; ++i) { const int q = t + 256 * i, r = q >> 4, c = q & 15; *(u32x4*)(T1 + swz256(r, c)) = rk[i]; }
                }
                __syncthreads();
                f32x4 acc[4][4]; zero_acc(acc);
                lds_mma_t<4, 4>(T0, T1, wm * 64, wn * 64, acc, lane);
                u16* cst = (u16*)(ws + (d2 ? O_MLC1 : O_MLC0)) + ((size_t)(b * NCH + cc) * 4 + h) * 16384 + (wm * 64 + lr) * 128 + wn * 64 + lq * 4;
#pragma unroll
                for (int i = 0; i < 4; ++i)
#pragma unroll
                    for (int j = 0; j < 4; ++j) {
                        uint2 o; o.x = pack2(acc[i][j][0], acc[i][j][1]); o.y = pack2(acc[i][j][2], acc[i][j][3]);
                        *(uint2*)(cst + (i * 16) * 128 + j * 16) = o;
                    }
                if (d2 == 0) {
                    const float* wgt = dir ? wB : wA;
                    float nacc = 0.f;
#pragma unroll 4
                    for (int c = 0; c < 16; ++c) {
                        const uint4 kv = *(const uint4*)(T1 + swz256(idx, c));
                        const float* ww = wgt + c * 8;
                        nacc += bflo(kv.x) * ww[0] + bfhi(kv.x) * ww[1] + bflo(kv.y) * ww[2] + bfhi(kv.y) * ww[3]
                              + bflo(kv.z) * ww[4] + bfhi(kv.z) * ww[5] + bflo(kv.w) * ww[6] + bfhi(kv.w) * ww[7];
                    }
                    ((float*)(ws + O_MLN))[(((size_t)(b * NCH + cc) * 4 + h) * 2 + dir) * 128 + idx] = nacc;
                }
                __syncthreads();
            }
        }
    }
}

__device__ __forceinline__ int scan_cc(int dir, int step) { return dir == 0 ? step : (step < 2 ? 1 - step : 35 - step); }
__device__ void phase5(const Params& P) {
    unsigned char* ws = P.ws;
    const int vb = threadIdx.x >> 8, t = threadIdx.x & 255;
    for (int u = blockIdx.x * 2 + vb; u < 256 + 256 + 32; u += gridDim.x * 2) {
        if (u < 256) {
            const int chain = u >> 2, part = u & 3;
            const int b = chain >> 4, h = (chain >> 1) & 7, dir = chain & 1;
            const int off = part * 2048 + t * 8;
            float S[8];
#pragma unroll
            for (int j = 0; j < 8; ++j) S[j] = 0.f;
#pragma unroll 2
            for (int step = 0; step < NCH; ++step) {
                const int cc = scan_cc(dir, step);
                u16* p = (u16*)(ws + O_ST) + (((size_t)(b * NCH + cc) * 8 + h) * 2 + dir) * 8192 + off;
                const uint4 lv = *(const uint4*)p;
                const float dec = __expf(((const float*)(ws + O_ACH))[((size_t)(b * NCH + cc) * 8 + h) * 2 + dir]);
                uint4 o; o.x = pack2(S[0], S[1]); o.y = pack2(S[2], S[3]); o.z = pack2(S[4], S[5]); o.w = pack2(S[6], S[7]);
                *(uint4*)p = o;
                S[0] = dec * S[0] + bflo(lv.x); S[1] = dec * S[1] + bfhi(lv.x); S[2] = dec * S[2] + bflo(lv.y); S[3] = dec * S[3] + bfhi(lv.y);
                S[4] = dec * S[4] + bflo(lv.z); S[5] = dec * S[5] + bfhi(lv.z); S[6] = dec * S[6] + bflo(lv.w); S[7] = dec * S[7] + bfhi(lv.w);
            }
        } else if (u < 512) {
            const int v = u - 256;
            const int chain = v >> 3, part = v & 7;
            const int b = chain >> 3, h = (chain >> 1) & 3, dir = chain & 1;
            const int off = part * 2048 + t * 8;
            float S[8];
#pragma unroll
            for (int j = 0; j < 8; ++j) S[j] = 0.f;
            float m = -1e30f;
#pragma unroll 2
            for (int step = 0; step < NCH; ++step) {
                const int cc = scan_cc(dir, step);
                u16* p = (u16*)(ws + (dir ? O_MLC1 : O_MLC0)) + ((size_t)(b * NCH + cc) * 4 + h) * 16384 + off;
                const uint4 lv = *(const uint4*)p;
                const float* mls = (const float*)(ws + O_MLS) + (((size_t)(b * NCH + cc) * 4 + h) * 2 + dir) * 2;
                const float ml = mls[0], bl = mls[1];
                const float mn = fmaxf(bl + m, ml);
                const float sp = __expf(bl + m - mn), sl = __expf(ml - mn);
                if (part == 0 && t == 0) ((float*)(ws + O_MLP))[((size_t)(b * NCH + cc) * 4 + h) * 2 + dir] = m;
                uint4 o; o.x = pack2(S[0], S[1]); o.y = pack2(S[2], S[3]); o.z = pack2(S[4], S[5]); o.w = pack2(S[6], S[7]);
                *(uint4*)p = o;
                S[0] = sp * S[0] + sl * bflo(lv.x); S[1] = sp * S[1] + sl * bfhi(lv.x); S[2] = sp * S[2] + sl * bflo(lv.y); S[3] = sp * S[3] + sl * bfhi(lv.y);
                S[4] = sp * S[4] + sl * bflo(lv.z); S[5] = sp * S[5] + sl * bfhi(lv.z); S[6] = sp * S[6] + sl * bflo(lv.w); S[7] = sp * S[7] + sl * bfhi(lv.w);
                m = mn;
            }
        } else {
            const int chain = u - 512;
            const int b = chain >> 3, h = (chain >> 1) & 3, dir = chain & 1;
            if (t < 128) {
                float nS = 0.f, m = -1e30f;
                for (int step = 0; step < NCH; ++step) {
                    const int cc = scan_cc(dir, step);
                    float* p = (float*)(ws + O_MLN) + (((size_t)(b * NCH + cc) * 4 + h) * 2 + dir) * 128 + t;
                    const float lv = *p;
                    const float* mls = (const float*)(ws + O_MLS) + (((size_t)(b * NCH + cc) * 4 + h) * 2 + dir) * 2;
                    const float ml = mls[0], bl = mls[1];
                    const float mn = fmaxf(bl + m, ml);
                    const float sp = __expf(bl + m - mn), sl = __expf(ml - mn);
                    *p = nS;
                    nS = sp * nS + sl * lv;
                    m = mn;
                }
            }
        }
    }
}

__device__ void phase6(const Params& P, char* lds) {
    unsigned char* ws = P.ws;
    char* T0 = lds; char* T1 = lds + 32768; char* T2 = lds + 65536; char* T3 = lds + 98304;
    float* sc = (float*)(lds + 131072);
    float* sbuf = sc;
    float* a0 = sc + 256;
    float* a1 = sc + 384;
    float* a2 = sc + 512;
    float* a3 = sc + 640;
    float* a4 = sc + 768;
    float* a5 = sc + 896;
    float* rsA = sc + 1024;
    float* qn = sc + 1536;
    float* fac = sc + 1792;
    float* wfac = sc + 2048;
    const int NSSD = 4 * 32 * 8, NML = 4 * 32 * 4, NU6 = NSSD + NML;
    u32x4 R0[4], R1[4], R2[4], R3[4];
    float ps0 = 0.f, ps1 = 0.f, ps2 = 0.f, ps3 = 0.f;
#define P6_PREFETCH(uu) do { \
        const int _u = (uu); const bool _ssd = _u < NSSD; const int _v = _ssd ? _u : _u - NSSD; \
        const int _h = _ssd ? (_v & 7) : (_v & 3), _ct = _ssd ? (_v >> 3) : (_v >> 2), _b = _ct >> 5, _c = _ct & 31, _cc = _c + 2; \
        const size_t _ctile = (size_t)(_b * NCH + _cc); const int _rb = _b * 4096 + _c * 128; \
        const u16 *_p0, *_p1, *_p2, *_p3; \
        if (_ssd) { const int _g = _h >> 2; _p0 = (const u16*)(ws + O_CM) + (_ctile * 2 + _g) * 16384; _p1 = (const u16*)(ws + O_BM) + (_ctile * 2 + _g) * 16384; \
                    _p2 = (const u16*)(ws + O_ST) + ((_ctile * 8 + _h) * 2) * 8192; _p3 = (const u16*)(ws + O_XT) + (_ctile * 512 + _h * 64) * 128; } \
        else { _p0 = (const u16*)(ws + O_Q) + (_ctile * 4 + _h) * 16384; _p1 = (const u16*)(ws + O_K) + (_ctile * 4 + _h) * 16384; \
               _p2 = (const u16*)(ws + O_MLC0) + (_ctile * 4 + _h) * 16384; _p3 = (const u16*)(ws + O_MLC1) + (_ctile * 4 + _h) * 16384; } \
        _Pragma("unroll") for (int _i = 0; _i < 4; ++_i) { const int _q = (int)threadIdx.x + 512 * _i; const size_t _o = (size_t)(_q >> 4) * 128 + (_q & 15) * 8; \
            R0[_i] = *(const u32x4*)(_p0 + _o); R1[_i] = *(const u32x4*)(_p1 + _o); R2[_i] = *(const u32x4*)(_p2 + _o); R3[_i] = *(const u32x4*)(_p3 + _o); } \
        if (threadIdx.x < 128) { const int _dir = threadIdx.x >> 6, _ln = threadIdx.x & 63; \
            const int _l0 = _dir ? 127 - 2 * _ln : 2 * _ln, _l1 = _dir ? 126 - 2 * _ln : 2 * _ln + 1; \
            if (_ssd) { const float* _dp = (const float*)(ws + O_DT) + (size_t)_rb * 16 + _dir * 8 + _h; ps0 = _dp[_l0 * 16]; ps1 = _dp[_l1 * 16]; } \
            else { const float* _gf = (const float*)(ws + O_GF) + (size_t)_rb * 8 + _dir * 4 + _h; const float* _gi = (const float*)(ws + O_GI) + (size_t)_rb * 8 + _dir * 4 + _h; \
                   ps0 = _gf[_l0 * 8]; ps1 = _gf[_l1 * 8]; ps2 = _gi[_l0 * 8]; ps3 = _gi[_l1 * 8]; } } \
    } while (0)
    if ((int)blockIdx.x < NU6) P6_PREFETCH(blockIdx.x);
    for (int u = blockIdx.x; u < NU6; u += gridDim.x) {
        int t = threadIdx.x; asm volatile("" : "+v"(t));
        const int lane = t & 63, w = t >> 6, wm = w >> 1, wn = w & 1;
        const bool isssd = u < NSSD;
        const int v = isssd ? u : u - NSSD;
        const int h = isssd ? (v & 7) : (v & 3), ct = isssd ? (v >> 3) : (v >> 2), b = ct >> 5, c = ct & 31, cc = c + 2;
        const int rb = b * 4096 + c * 128, lpos = c * 128;
        const float mp0 = isssd ? 0.f : ((const float*)(ws + O_MLP))[((size_t)(b * NCH + cc) * 4 + h) * 2 + 0];
        const float mp1 = isssd ? 0.f : ((const float*)(ws + O_MLP))[((size_t)(b * NCH + cc) * 4 + h) * 2 + 1];
        if (w < 2) {
            const int dir = w;
            const int l0 = dir ? 127 - 2 * lane : 2 * lane, l1 = dir ? 126 - 2 * lane : 2 * lane + 1;
            if (isssd) {
                const float d0 = ps0, d1 = ps1;
                const float an = -__expf(P.in[I_ALOG][dir * 8 + h]);
                const float p0 = d0 * an, p1 = p0 + d1 * an;
                const float inc = wave_scan_sum(p1, lane);
                const float ex = inc - p1;
                float* ca = dir ? a1 : a0; float* da = dir ? a3 : a2;
                ca[l0] = ex + p0; ca[l1] = ex + p1; da[l0] = d0; da[l1] = d1;
            } else {
                const float f0 = ps0, f1 = ps1, i0 = ps2, i1 = ps3;
                const float p1 = f0 + f1;
                const float inc = wave_scan_sum(p1, lane);
                const float ex = inc - p1;
                const float bc0 = ex + f0, bc1 = ex + p1;
                const float u0 = i0 - bc0, u1 = i1 - bc1;
                const float q1 = fmaxf(u0, u1);
                const float incm = wave_scan_max(q1, lane);
                float exm = __shfl_up(incm, 1); if (lane == 0) exm = -INFINITY;
                const float mp = dir ? mp1 : mp0;
                float* ab = dir ? a1 : a0; float* au = dir ? a3 : a2; float* am = dir ? a5 : a4;
                ab[l0] = bc0; ab[l1] = bc1; au[l0] = u0; au[l1] = u1;
                am[l0] = fmaxf(mp, fmaxf(exm, u0)); am[l1] = fmaxf(mp, fmaxf(exm, q1));
            }
        }
#pragma unroll
        for (int i = 0; i < 4; ++i) {
            const int q = t + 512 * i, r = q >> 4, cq = q & 15;
            *(u32x4*)(T0 + swz256(r, cq)) = R0[i];
            *(u32x4*)(T1 + swz256(r, cq)) = R1[i];
            *(u32x4*)(T2 + swz256(r, cq)) = R2[i];
            if (!isssd || i < 2) *(u32x4*)(T3 + swz256(r, cq)) = R3[i];
        }
        __syncthreads();
        if (u + (int)gridDim.x < NU6) P6_PREFETCH(u + gridDim.x);
        if (isssd) {
            const int g = h >> 2; (void)g;
            const int lr = lane & 15, lq = lane >> 4;
            f32x4 Y[2][2];
            {
                f32x4 aF[2][2], aB[2][2]; zero_acc(aF); zero_acc(aB);
                lds_mma_t<2, 2>(T0, T2, wm * 32, wn * 32, aF, lane);
                lds_mma_t<2, 2>(T0, T2, wm * 32, 64 + wn * 32, aB, lane);
#pragma unroll
                for (int i = 0; i < 2; ++i) {
                    const int l = wm * 32 + i * 16 + lr;
                    const float e0 = __expf(a0[l]), e1 = __expf(a1[l]);
#pragma unroll
                    for (int j = 0; j < 2; ++j) Y[i][j] = e0 * aF[i][j] + e1 * aB[i][j];
                }
            }
            f32x4 G[2][4]; zero_acc(G);
            lds_mma_t<2, 4>(T0, T1, wm * 32, wn * 64, G, lane);
            __syncthreads();
            {
                const float Dh = P.in[I_SSDD][h];
                int dbase = wn * 64 + lq * 4 - wm * 32 - lr; asm volatile("" : "+v"(dbase));
#pragma unroll
                for (int j = 0; j < 4; ++j) {
                    const int s0 = wn * 64 + j * 16 + lq * 4;
                    const float4 c0s = *(const float4*)(a0 + s0), r1s = *(const float4*)(a1 + s0), d0s = *(const float4*)(a2 + s0), d1s = *(const float4*)(a3 + s0);
                    const float c0v[4] = {c0s.x, c0s.y, c0s.z, c0s.w}, r1v[4] = {r1s.x, r1s.y, r1s.z, r1s.w};
                    const float d0v[4] = {d0s.x, d0s.y, d0s.z, d0s.w}, d1v[4] = {d1s.x, d1s.y, d1s.z, d1s.w};
#pragma unroll
                    for (int i = 0; i < 2; ++i) {
                        const int l = wm * 32 + i * 16 + lr;
                        const float c0l = a0[l], r1l = a1[l];
                        float mv[4];
#pragma unroll
                        for (int r = 0; r < 4; ++r) {
                            const int diff = dbase + (j * 16 - i * 16 + r);
                            const float e0 = (diff <= 0) ? (c0l - c0v[r]) : -INFINITY;
                            const float e1 = (diff >= 0) ? (r1l - r1v[r]) : -INFINITY;
                            mv[r] = G[i][j][r] * (__expf(e0) * d0v[r] + __expf(e1) * d1v[r]) + (diff == 0 ? Dh : 0.f);
                        }
                        uint2 o; o.x = pack2(mv[0], mv[1]); o.y = pack2(mv[2], mv[3]);
                        *(uint2*)(T1 + swz256(l, s0 >> 3) + (s0 & 7) * 2) = o;
                    }
                }
            }
            __syncthreads();
            lds_mma_t<2, 2>(T1, T3, wm * 32, wn * 32, Y, lane);
            u16* zo = (u16*)(ws + O_ZO);
#pragma unroll
            for (int i = 0; i < 2; ++i) {
                const int l = wm * 32 + i * 16 + lr;
                float ssq = 0.f;
#pragma unroll
                for (int j = 0; j < 2; ++j) {
                    const int p = wn * 32 + j * 16 + lq * 4;
                    u16* zp = zo + (size_t)(rb + l) * 1024 + h * 64 + p;
                    const uint2 zv = *(const uint2*)zp;
                    const float y0 = Y[i][j][0] * siluf(bflo(zv.x)), y1 = Y[i][j][1] * siluf(bfhi(zv.x));
                    const float y2 = Y[i][j][2] * siluf(bflo(zv.y)), y3 = Y[i][j][3] * siluf(bfhi(zv.y));
                    uint2 o; o.x = pack2(y0, y1); o.y = pack2(y2, y3);
                    *(uint2*)zp = o;
                    ssq += y0 * y0 + y1 * y1 + y2 * y2 + y3 * y3;
                }
                ssq += __shfl_xor(ssq, 16); ssq += __shfl_xor(ssq, 32);
                if (lq == 0) ((float*)(ws + O_SSQ))[(size_t)(rb + l) * 16 + h * 2 + wn] = ssq;
            }
            __syncthreads();
        } else {
            const int lr = lane & 15, lq = lane >> 4;
            f32x4 S[2][4]; zero_acc(S);
            lds_mma_t<2, 4>(T0, T1, wm * 32, wn * 64, S, lane);
            if (t < 256) {
                const int dir = t >> 7, idx = t & 127;
                const float* np = (const float*)(ws + O_MLN) + (((size_t)(b * NCH + cc) * 4 + h) * 2 + dir) * 128;
                float acc = 0.f;
#pragma unroll 4
                for (int cch = 0; cch < 16; ++cch) {
                    const uint4 qv = *(const uint4*)(T0 + swz256(idx, cch));
                    const float4 n0 = *(const float4*)(np + cch * 8), n1 = *(const float4*)(np + cch * 8 + 4);
                    acc += bflo(qv.x) * n0.x + bfhi(qv.x) * n0.y + bflo(qv.y) * n0.z + bfhi(qv.y) * n0.w
                         + bflo(qv.z) * n1.x + bfhi(qv.z) * n1.y + bflo(qv.w) * n1.z + bfhi(qv.w) * n1.w;
                }
                qn[dir * 128 + idx] = acc;
            }
            int dbase = wn * 64 + lq * 4 - wm * 32 - lr; asm volatile("" : "+v"(dbase));
            {
                float r0[2] = {0.f, 0.f}, r1[2] = {0.f, 0.f};
#pragma unroll
                for (int j = 0; j < 4; ++j) {
                    const int s0 = wn * 64 + j * 16 + lq * 4;
                    const float4 u0s = *(const float4*)(a2 + s0), u1s = *(const float4*)(a3 + s0);
                    const float u0v[4] = {u0s.x, u0s.y, u0s.z, u0s.w}, u1v[4] = {u1s.x, u1s.y, u1s.z, u1s.w};
#pragma unroll
                    for (int i = 0; i < 2; ++i) {
                        const int tt = wm * 32 + i * 16 + lr;
                        const float m0 = a4[tt], m1 = a5[tt];
#pragma unroll
                        for (int r = 0; r < 4; ++r) {
                            const int diff = dbase + (j * 16 - i * 16 + r);
                            r0[i] += S[i][j][r] * __expf((diff <= 0) ? (u0v[r] - m0) : -INFINITY);
                            r1[i] += S[i][j][r] * __expf((diff >= 0) ? (u1v[r] - m1) : -INFINITY);
                        }
                    }
                }
#pragma unroll
                for (int i = 0; i < 2; ++i) {
                    const int tt = wm * 32 + i * 16 + lr;
                    float x0 = r0[i], x1 = r1[i];
                    x0 += __shfl_xor(x0, 16); x0 += __shfl_xor(x0, 32);
                    x1 += __shfl_xor(x1, 16); x1 += __shfl_xor(x1, 32);
                    if (lq == 0) { rsA[(0 * 2 + wn) * 128 + tt] = x0; rsA[(1 * 2 + wn) * 128 + tt] = x1; }
                }
            }
            __syncthreads();
            if (t < 256) {
                const int dir = t >> 7, tt = t & 127;
                const float rs = rsA[(dir * 2 + 0) * 128 + tt] + rsA[(dir * 2 + 1) * 128 + tt];
                const float mm = dir ? a5[tt] : a4[tt];
                const float wi = __expf((dir ? mp1 : mp0) - mm);
                const float den = rs + wi * qn[dir * 128 + tt];
                const float mout = (dir ? a1[tt] : a0[tt]) + mm;
                const float dn = fmaxf(fabsf(den), __expf(-mout));
                fac[dir * 128 + tt] = 1.f / dn;
                wfac[dir * 128 + tt] = wi / dn;
            }
            __syncthreads();
            f32x4 H[2][4];
            {
                f32x4 A0[2][4]; zero_acc(A0);
                lds_mma_t<2, 4>(T0, T2, wm * 32, wn * 64, A0, lane);
#pragma unroll
                for (int i = 0; i < 2; ++i) {
                    const float f = wfac[wm * 32 + i * 16 + lr];
#pragma unroll
                    for (int j = 0; j < 4; ++j) H[i][j] = f * A0[i][j];
                }
            }
            {
                f32x4 A1[2][4]; zero_acc(A1);
                lds_mma_t<2, 4>(T0, T3, wm * 32, wn * 64, A1, lane);
#pragma unroll
                for (int i = 0; i < 2; ++i) {
                    const float f = wfac[128 + wm * 32 + i * 16 + lr];
#pragma unroll
                    for (int j = 0; j < 4; ++j) H[i][j] += f * A1[i][j];
                }
            }
            __syncthreads();
            asm volatile("" : "+v"(dbase));
#pragma unroll
            for (int j = 0; j < 4; ++j) {
                const int s0 = wn * 64 + j * 16 + lq * 4;
                const float4 u0s = *(const float4*)(a2 + s0), u1s = *(const float4*)(a3 + s0);
                const float u0v[4] = {u0s.x, u0s.y, u0s.z, u0s.w}, u1v[4] = {u1s.x, u1s.y, u1s.z, u1s.w};
#pragma unroll
                for (int i = 0; i < 2; ++i) {
                    const int tt = wm * 32 + i * 16 + lr;
                    const float m0 = a4[tt], m1 = a5[tt], f0 = fac[tt], f1 = fac[128 + tt];
                    float pv[4];
#pragma unroll
                    for (int r = 0; r < 4; ++r) {
                        const int diff = dbase + (j * 16 - i * 16 + r);
                        pv[r] = S[i][j][r] * (__expf((diff <= 0) ? (u0v[r] - m0) : -INFINITY) * f0 + __expf((diff >= 0) ? (u1v[r] - m1) : -INFINITY) * f1);
                    }
                    uint2 o; o.x = pack2(pv[0], pv[1]); o.y = pack2(pv[2], pv[3]);
                    *(uint2*)(T1 + swz256(tt, s0 >> 3) + (s0 & 7) * 2) = o;
                }
            }
            load_tile128(T2, 0, (const u16*)(ws + O_VT) + ((size_t)(b * NCH + cc) * 512 + h * 128) * 128, 128, 128, t, 512);
            __syncthreads();
            lds_mma_t<2, 4>(T1, T2, wm * 32, wn * 64, H, lane);
            u16* zo = (u16*)(ws + O_ZO);
            size_t rown[2];
#pragma unroll
            for (int i = 0; i < 2; ++i) {
                const int tt = wm * 32 + i * 16 + lr;
                const int lp = lpos + tt;
                rown[i] = (size_t)b * 4096 + ((lp & 63) << 6) + (lp >> 6);
                float ssq = 0.f;
#pragma unroll
                for (int j = 0; j < 4; ++j) {
                    const int d = wn * 64 + j * 16 + lq * 4;
                    const uint2 ov = *(const uint2*)(zo + rown[i] * 1024 + 512 + h * 128 + d);
                    H[i][j][0] *= sigmf(bflo(ov.x)); H[i][j][1] *= sigmf(bfhi(ov.x)); H[i][j][2] *= sigmf(bflo(ov.y)); H[i][j][3] *= sigmf(bfhi(ov.y));
                    ssq += H[i][j][0] * H[i][j][0] + H[i][j][1] * H[i][j][1] + H[i][j][2] * H[i][j][2] + H[i][j][3] * H[i][j][3];
                }
                ssq += __shfl_xor(ssq, 16); ssq += __shfl_xor(ssq, 32);
                if (lq == 0) rsA[wn * 128 + tt] = ssq;
            }
            __syncthreads();
            const u16* xc = (const u16*)(ws + O_XC);
#pragma unroll
            for (int j = 0; j < 4; ++j) {
                const int d = wn * 64 + j * 16 + lq * 4, chg = h * 128 + d;
                const float4 nw4 = *(const float4*)(P.in[I_MNW] + chg), sk4 = *(const float4*)(P.in[I_MSKIP] + chg);
#pragma unroll
                for (int i = 0; i < 2; ++i) {
                    const int tt = wm * 32 + i * 16 + lr;
                    const float rn = rsqrtf((rsA[tt] + rsA[128 + tt]) * (1.f / 128.f) + 1e-6f);
                    const uint2 xv = *(const uint2*)(xc + ((size_t)(b * NCH + cc) * 4 + h) * 16384 + (size_t)tt * 128 + d);
                    const float y0 = H[i][j][0] * rn * nw4.x + sk4.x * bflo(xv.x), y1 = H[i][j][1] * rn * nw4.y + sk4.y * bfhi(xv.x);
                    const float y2 = H[i][j][2] * rn * nw4.z + sk4.z * bflo(xv.y), y3 = H[i][j][3] * rn * nw4.w + sk4.w * bfhi(xv.y);
                    uint2 o; o.x = pack2(y0, y1); o.y = pack2(y2, y3);
                    *(uint2*)(zo + rown[i] * 1024 + 512 + chg) = o;
                }
            }
            __syncthreads();
        }
    }
}

struct OutProj {
    static constexpr int K = 1024; static constexpr bool PERM = false; static constexpr int MIDT = 8;
    struct Unit { int pm, pn, slot; };
    const Params* P; const float* rs; int G, c;
    __device__ __forceinline__ bool next(int i, Unit& u) const {
        const int L = i * G + c;
        if (L >= 256) return false;
        g8::dense_unit(L, 64, 4, u.pm, u.pn); u.slot = i & 3;
        return true;
    }
    __device__ __forceinline__ const char* baseA(const Unit&) const { return (const char*)(P->ws + O_ZO); }
    __device__ __forceinline__ const char* baseB(const Unit&) const { return (const char*)(P->ws + O_WOUT); }
    __device__ __forceinline__ void offs(const Unit& u, int tid_, unsigned (&oa)[2][2], unsigned (&ob)[2][2]) const {
        int R[2], C[2];
        { int tq = tid_; asm volatile("" : "+v"(tq)); g8::stage_rc(tq * 16, R[0], C[0]); g8::stage_rc(tq * 16 + 8192, R[1], C[1]); }
#pragma unroll
        for (int h = 0; h < 2; ++h)
#pragma unroll
            for (int i = 0; i < 2; ++i) {
                oa[h][i] = (unsigned)((u.pm * 256 + h * 128 + R[i]) * 1024 + C[i]) * 2u;
                ob[h][i] = (unsigned)((u.pn * 256 + h * 128 + R[i]) * 1024 + C[i]) * 2u;
            }
    }
    __device__ __forceinline__ int nt(const Unit&) const { return 16; }
    __device__ __forceinline__ bool brk(const Unit&, const Unit&) const { return false; }
    __device__ __forceinline__ void a_ready(const Unit&) const {}
    __device__ __forceinline__ void done(const Unit&) const {}
    __device__ __forceinline__ void mid(g8::Acc& acc, const Unit& u, int wr, int fr) const {
#pragma unroll
        for (int ai = 0; ai < 2; ++ai)
#pragma unroll
            for (int m = 0; m < 4; ++m) {
                const float s = rs[u.slot * 256 + ai * 128 + wr * 64 + m * 16 + fr];
#pragma unroll
                for (int bj = 0; bj < 2; ++bj)
#pragma unroll
                    for (int n = 0; n < 2; ++n) acc[ai][bj][m][n] *= s;
            }
    }
    __device__ __forceinline__ void epi(g8::Acc& acc, const Unit& u, int wr, int wc, int fr, int fq) const {
        const int row0 = u.pm * 256 + wr * 64 + fr, col0 = u.pn * 256 + wc * 32 + 4 * fq;
        const int b = u.pm >> 4;
        const float* mod = (const float*)(P->ws + O_MOD) + b * 6144 + 2048;
        f32x4 g1[2][2];
#pragma unroll
        for (int bj = 0; bj < 2; ++bj)
#pragma unroll
            for (int n = 0; n < 2; ++n) g1[bj][n] = *(const f32x4*)(mod + col0 + bj * 128 + n * 16);
#pragma unroll
        for (int ai = 0; ai < 2; ++ai)
#pragma unroll
            for (int mp = 0; mp < 2; ++mp) {
                f32x4 xv[2][2][2];
#pragma unroll
                for (int mm = 0; mm < 2; ++mm)
#pragma unroll
                    for (int bj = 0; bj < 2; ++bj)
#pragma unroll
                        for (int n = 0; n < 2; ++n)
                            xv[mm][bj][n] = *(const f32x4*)(P->in[I_X] + (size_t)(row0 + ai * 128 + (mp * 2 + mm) * 16) * 1024 + col0 + bj * 128 + n * 16);
                __builtin_amdgcn_sched_barrier(0);
#pragma unroll
                for (int mm = 0; mm < 2; ++mm)
#pragma unroll
                    for (int bj = 0; bj < 2; ++bj)
#pragma unroll
                        for (int n = 0; n < 2; ++n)
                            *(f32x4*)(P->out + (size_t)(row0 + ai * 128 + (mp * 2 + mm) * 16) * 1024 + col0 + bj * 128 + n * 16) = xv[mm][bj][n] + g1[bj][n] * acc[ai][bj][mp * 2 + mm][n];
                __builtin_amdgcn_sched_barrier(0);
            }
    }
};
__device__ void phase7(const Params& P, char* lds) {
    float* rs = (float*)(lds + g8::STAGE_BYTES);
    OutProj S; S.P = &P; S.rs = rs; S.G = gridDim.x; S.c = blockIdx.x;
    for (int i = 0; i < 4; ++i) {
        OutProj::Unit u;
        if (!S.next(i, u)) break;
        if (threadIdx.x < 256) {
            const float* sq = (const float*)(P.ws + O_SSQ) + (size_t)(u.pm * 256 + threadIdx.x) * 16;
            float s = 0.f;
#pragma unroll
            for (int q = 0; q < 16; ++q) s += sq[q];
            rs[i * 256 + threadIdx.x] = rsqrtf(s * (1.f / 512.f) + 1e-6f);
        }
    }
    __syncthreads();
    g8::gemm_phase<OutProj>((LAS unsigned char*)lds, S);
}

__device__ void phase8(const Params& P, char* lds_all) {
    unsigned char* ws = P.ws;
    const float* mod = (const float*)(ws + O_MOD);
    {
        const int t = threadIdx.x, lane = t & 63, w = t >> 6;
        float* tt = (float*)lds_all;
        float bw[32][3];
        {
            const int ti = lane & 15, kq = lane >> 4;
#pragma unroll
            for (int ks = 0; ks < 32; ++ks) {
                const int k = w * 128 + ks * 4 + kq;
                bw[ks][0] = P.in[I_REW][(size_t)k * 32 + ti];
                bw[ks][1] = P.in[I_REW][(size_t)k * 32 + 16 + ti];
                const float b2r = P.in[I_RGW][(size_t)k * 4 + (ti & 3)];
                bw[ks][2] = ti < 4 ? b2r : 0.f;
            }
        }
        for (int u = blockIdx.x; u < 512; u += gridDim.x) {
            const int tk0 = u * 32;
            const int b = tk0 >> 12;
#pragma unroll 1
            for (int qh = 0; qh < 2; ++qh) {
                float4 v[2][4]; float ss[2];
#pragma unroll
                for (int q = 0; q < 2; ++q) {
                    const float* xr = P.out + (size_t)(tk0 + w * 4 + qh * 2 + q) * 1024;
#pragma unroll
                    for (int j = 0; j < 4; ++j) { v[q][j] = ((const float4*)xr)[lane + 64 * j]; }
                }
#pragma unroll
                for (int q = 0; q < 2; ++q) {
                    ss[q] = 0.f;
#pragma unroll
                    for (int j = 0; j < 4; ++j) ss[q] += v[q][j].x * v[q][j].x + v[q][j].y * v[q][j].y + v[q][j].z * v[q][j].z + v[q][j].w * v[q][j].w;
                    ss[q] = rsqrtf(wave_sum(ss[q]) * (1.f / 1024.f) + 1e-6f);
                }
#pragma unroll
                for (int j = 0; j < 4; ++j) {
                    const int k = (lane + 64 * j) * 4;
                    const float4 nwv = *(const float4*)(P.in[I_N2W] + k);
                    const float4 sh = *(const float4*)(mod + b * 6144 + 3072 + k);
                    const float4 sc = *(const float4*)(mod + b * 6144 + 4096 + k);
                    const float m0 = nwv.x * (1.f + sc.x), m1 = nwv.y * (1.f + sc.y), m2 = nwv.z * (1.f + sc.z), m3 = nwv.w * (1.f + sc.w);
#pragma unroll
                    for (int q = 0; q < 2; ++q) {
                        const int tl = w * 4 + qh * 2 + q;
                        float4 hh;
                        hh.x = v[q][j].x * ss[q] * m0 + sh.x; hh.y = v[q][j].y * ss[q] * m1 + sh.y;
                        hh.z = v[q][j].z * ss[q] * m2 + sh.z; hh.w = v[q][j].w * ss[q] * m3 + sh.w;
                        uint2 o; o.x = pack2(hh.x, hh.y); o.y = pack2(hh.z, hh.w);
                        *(uint2*)((u16*)(ws + O_T) + (size_t)(tk0 + tl) * 1024 + k) = o;
                        *(float4*)(tt + tl * 1028 + k) = hh;
                    }
                }
            }
            __syncthreads();
            f32x4 c[2][3];
#pragma unroll
            for (int a = 0; a < 2; ++a)
#pragma unroll
                for (int f = 0; f < 3; ++f) c[a][f] = f32x4{0, 0, 0, 0};
            const int ti = lane & 15, kq = lane >> 4;
#pragma unroll
            for (int ks = 0; ks < 32; ++ks) {
                const int k = w * 128 + ks * 4 + kq;
                const float a0 = tt[ti * 1028 + k], a1 = tt[(16 + ti) * 1028 + k];
                c[0][0] = __builtin_amdgcn_mfma_f32_16x16x4f32(a0, bw[ks][0], c[0][0], 0, 0, 0);
                c[0][1] = __builtin_amdgcn_mfma_f32_16x16x4f32(a0, bw[ks][1], c[0][1], 0, 0, 0);
                c[0][2] = __builtin_amdgcn_mfma_f32_16x16x4f32(a0, bw[ks][2], c[0][2], 0, 0, 0);
                c[1][0] = __builtin_amdgcn_mfma_f32_16x16x4f32(a1, bw[ks][0], c[1][0], 0, 0, 0);
                c[1][1] = __builtin_amdgcn_mfma_f32_16x16x4f32(a1, bw[ks][1], c[1][1], 0, 0, 0);
                c[1][2] = __builtin_amdgcn_mfma_f32_16x16x4f32(a1, bw[ks][2], c[1][2], 0, 0, 0);
            }
            __syncthreads();
            float* red = (float*)lds_all;
#pragma unroll
            for (int a = 0; a < 2; ++a)
#pragma unroll
                for (int r = 0; r < 4; ++r) {
                    const int row = a * 16 + kq * 4 + r;
                    red[(w * 32 + row) * 48 + ti] = c[a][0][r];
                    red[(w * 32 + row) * 48 + 16 + ti] = c[a][1][r];
                    red[(w * 32 + row) * 48 + 32 + ti] = c[a][2][r];
                }
            __syncthreads();
            int* lcnt = (int*)(lds_all + 65536);
            if (t < 64) lcnt[t] = 0;
            __syncthreads();
            int ea = 0, eb = 0, ra = 0, rb = 0; float w1 = 0.f, w2 = 0.f;
            if (t < 32) {
                float gl[4];
#pragma unroll
                for (int j = 0; j < 4; ++j) {
                    float sacc = P.in[I_RGB][j];
#pragma unroll
                    for (int ww = 0; ww < 8; ++ww) sacc += red[(ww * 32 + t) * 48 + 32 + j];
                    gl[j] = sacc;
                }
                int gs = 0; float gm = gl[0];
#pragma unroll
                for (int j = 1; j < 4; ++j) if (gl[j] > gm) { gm = gl[j]; gs = j; }
                float gsum = 0.f;
#pragma unroll
                for (int j = 0; j < 4; ++j) gsum += __expf(gl[j] - gm);
                const float pg = 1.f / gsum;
                float el[8];
#pragma unroll
                for (int j = 0; j < 8; ++j) {
                    float sacc = P.in[I_REB][gs * 8 + j];
#pragma unroll
                    for (int ww = 0; ww < 8; ++ww) sacc += red[(ww * 32 + t) * 48 + gs * 8 + j];
                    el[j] = sacc;
                }
                int i1 = 0; float m1 = el[0];
#pragma unroll
                for (int j = 1; j < 8; ++j) if (el[j] > m1) { m1 = el[j]; i1 = j; }
                int i2 = -1; float m2 = -INFINITY;
#pragma unroll
                for (int j = 0; j < 8; ++j) if (j != i1 && el[j] > m2) { m2 = el[j]; i2 = j; }
                const float e2 = __expf(m2 - m1);
                w1 = pg / (1.f + e2); w2 = pg * e2 / (1.f + e2);
                ea = gs * 8 + i1; eb = gs * 8 + i2;
                ra = atomicAdd(&lcnt[ea], 1);
                rb = atomicAdd(&lcnt[eb], 1);
            }
            __syncthreads();
            if (t < 32) {
                const int n = lcnt[t];
                lcnt[32 + t] = n > 0 ? atomicAdd((int*)(ws + O_CNT) + t * 64, n) : 0;
            }
            __syncthreads();
            if (t < 32) {
                const int tok = tk0 + t;
                int* list = (int*)(ws + O_LIST);
                float* wts = (float*)(ws + O_WTS);
                list[ea * 16384 + lcnt[32 + ea] + ra] = tok * 2;
                wts[tok * 2] = w1;
                list[eb * 16384 + lcnt[32 + eb] + rb] = tok * 2 + 1;
                wts[tok * 2 + 1] = w2;
            }
            __syncthreads();
        }
    }
    const int vb = threadIdx.x >> 8, t = threadIdx.x & 255;
    char* lds = lds_all + vb * VLDS;
    const int NTR = 3072;
    for (int u = blockIdx.x * 2 + vb; u < NTR; u += gridDim.x * 2) {
        {
            const int v = u;
            float* tile = (float*)lds;
            if (v < 2048) {
                const bool up = v >= 1024;
                const int vv = v & 1023, e = vv >> 5, rem = vv & 31, nt = rem >> 4, kt = rem & 15;
                const float* src = P.in[up ? I_WU : I_WG] + (size_t)e * 1024 * 256;
                transpose_tile_w(tile, src, 256, kt * 64, nt * 128, (u16*)(ws + O_WGU) + (size_t)e * 512 * 1024, (up ? 256 : 0) + nt * 128, 1024, nullptr, 0, t);
            } else {
                const int vv = v - 2048, e = vv >> 5, rem = vv & 31, nt = rem >> 2, kt = rem & 3;
                const float* src = P.in[I_WD] + (size_t)e * 256 * 1024;
                transpose_tile_w(tile, src, 1024, kt * 64, nt * 128, (u16*)(ws + O_WD) + (size_t)e * 1024 * 256, nt * 128, 256, nullptr, 0, t);
            }
        }
    }
}

__device__ __forceinline__ void moe_prefix(const unsigned char* ws, int* pre_t, int* pre_c) {
    if (threadIdx.x == 0) {
        const int* cnt = (const int*)(ws + O_CNT);
        int at = 0, ac = 0;
        for (int e = 0; e < 32; ++e) { pre_t[e] = at; pre_c[e] = ac; const int c = cnt[e * 64]; at += (c + 255) >> 8; ac += c; }
        pre_t[32] = at; pre_c[32] = ac;
    }
    __syncthreads();
}
struct MoeUnit { int type, e, mt, pn, cnt, base, mtg; };
struct Moe {
    static constexpr int K = 0; static constexpr bool PERM = true; static constexpr int MIDT = 0;
    typedef MoeUnit Unit;
    const unsigned char* ws; const int* pre_t; const int* pre_c; int G, c;
    __device__ __forceinline__ bool next(int i, Unit& u) const {
        int type, m, pn, e, mt;
        if ((G & 7) == 0) {
            const int x = c & 7, s = c >> 3, nb = G >> 3;
            const int n0 = pre_t[x + 1] - pre_t[x], n1 = pre_t[x + 9] - pre_t[x + 8], n2 = pre_t[x + 17] - pre_t[x + 16], n3 = pre_t[x + 25] - pre_t[x + 24];
            const int MTx = n0 + n1 + n2 + n3;
            const int Lx = i * nb + s;
            if (Lx < MTx * 2) { type = 0; m = Lx >> 1; pn = Lx & 1; }
            else if (Lx < MTx * 6) { const int j = Lx - MTx * 2; type = 1; m = j >> 2; pn = j & 3; }
            else return false;
            if (m < n0) { e = x; mt = m; }
            else if (m < n0 + n1) { e = x + 8; mt = m - n0; }
            else if (m < n0 + n1 + n2) { e = x + 16; mt = m - n0 - n1; }
            else { e = x + 24; mt = m - n0 - n1 - n2; }
        } else {
            const int L = i * G + c, MT = pre_t[32];
            if (L < MT * 2) { type = 0; m = L >> 1; pn = L & 1; }
            else if (L < MT * 6) { const int j = L - MT * 2; type = 1; m = j >> 2; pn = j & 3; }
            else return false;
            e = 0;
            while (pre_t[e + 1] <= m) ++e;
            mt = m - pre_t[e];
        }
        u.e = __builtin_amdgcn_readfirstlane(e); u.mt = __builtin_amdgcn_readfirstlane(mt);
        u.cnt = __builtin_amdgcn_readfirstlane(pre_c[e + 1] - pre_c[e]); u.base = __builtin_amdgcn_readfirstlane(pre_c[e]);
        u.mtg = __builtin_amdgcn_readfirstlane(pre_t[e] + mt); u.pn = __builtin_amdgcn_readfirstlane(pn); u.type = __builtin_amdgcn_readfirstlane(type);
        return true;
    }
    __device__ __forceinline__ int nt(const Unit& u) const { return u.type ? 4 : 16; }
    __device__ __forceinline__ bool brk(const Unit& a, const Unit& b) const { return a.type == 0 && b.type == 1; }
    __device__ __forceinline__ const char* baseA(const Unit& u) const {
        return u.type ? (const char*)(ws + O_H) + (size_t)(u.base + u.mt * 256) * 256 * 2 : (const char*)(ws + O_T);
    }
    __device__ __forceinline__ const char* baseB(const Unit& u) const {
        return u.type ? (const char*)(ws + O_WD) + ((size_t)u.e * 1024 + u.pn * 256) * 256 * 2 : (const char*)(ws + O_WGU) + (size_t)u.e * 512 * 1024 * 2;
    }
    __device__ __forceinline__ void offs(const Unit& u, int tid_, unsigned (&oa)[2][2], unsigned (&ob)[2][2]) const {
        int R[2], C[2];
        { int tq = tid_; asm volatile("" : "+v"(tq)); g8::stage_rc(tq * 16, R[0], C[0]); g8::stage_rc(tq * 16 + 8192, R[1], C[1]); }
        const int* list = (const int*)(ws + O_LIST) + u.e * 16384;
#pragma unroll
        for (int h = 0; h < 2; ++h)
#pragma unroll
            for (int i = 0; i < 2; ++i) {
                const int Rb = (R[i] & ~31) + g8::perm32(R[i] & 31);
                const int idx = u.mt * 256 + h * 128 + R[i];
                const int tok = list[idx < u.cnt ? idx : u.cnt - 1] >> 1;
                if (u.type == 0) {
                    oa[h][i] = (unsigned)(tok * 1024 + C[i]) * 2u;
                    ob[h][i] = (unsigned)((h * 256 + u.pn * 128 + Rb) * 1024 + C[i]) * 2u;
                } else {
                    oa[h][i] = (unsigned)((h * 128 + R[i]) * 256 + C[i]) * 2u;
                    ob[h][i] = (unsigned)((h * 128 + Rb) * 256 + C[i]) * 2u;
                }
            }
    }
    __device__ __forceinline__ void mid(g8::Acc&, const Unit&, int, int) const {}
    __device__ __forceinline__ void a_ready(const Unit& u) const {
        if (u.type == 0) return;
        if (threadIdx.x < 64) {
            unsigned* rdy = (unsigned*)(ws + O_RDY) + u.mtg * 64;
            unsigned spins = 0;
            while ((unsigned)__builtin_amdgcn_readfirstlane(__hip_atomic_load(rdy, __ATOMIC_RELAXED, __HIP_MEMORY_SCOPE_AGENT)) < 16u) {
                __builtin_amdgcn_s_sleep(2);
                if (++spins > (1u << 22)) break;
            }
            __builtin_amdgcn_fence(__ATOMIC_ACQUIRE, "agent");
            asm volatile("s_waitcnt vmcnt(0)" ::: "memory");
        }
        asm volatile("" ::: "memory"); __builtin_amdgcn_s_barrier(); asm volatile("" ::: "memory");
    }
    __device__ __forceinline__ void done(const Unit& u) const {
        if (u.type != 0) return;
        asm volatile("s_waitcnt vmcnt(0)" ::: "memory");
        if ((threadIdx.x & 63) == 0) __hip_atomic_fetch_add((unsigned*)(ws + O_RDY) + u.mtg * 64, 1u, __ATOMIC_RELAXED, __HIP_MEMORY_SCOPE_AGENT);
    }
    __device__ __forceinline__ void epi(g8::Acc& acc, const Unit& u, int wr, int wc, int fr, int fq) const {
        if (u.type == 0) {
            __amdgpu_buffer_rsrc_t rs = __builtin_amdgcn_make_buffer_rsrc((void*)(ws + O_H), 0, (int)((32768 + 256) * 256 * 2), 0x00020000);
#pragma unroll
            for (int ai = 0; ai < 2; ++ai)
#pragma unroll
                for (int m = 0; m < 4; ++m) {
                    const int idx = u.mt * 256 + ai * 128 + wr * 64 + m * 16 + fr;
                    if (idx < u.cnt) {
                        const f32x4 g0 = acc[ai][0][m][0], g1 = acc[ai][0][m][1], u0 = acc[ai][1][m][0], u1 = acc[ai][1][m][1];
                        u32x4 o;
                        o.x = g8::cvt_pk_bf16(siluf(g0[0]) * u0[0], siluf(g0[1]) * u0[1]); o.y = g8::cvt_pk_bf16(siluf(g0[2]) * u0[2], siluf(g0[3]) * u0[3]);
                        o.z = g8::cvt_pk_bf16(siluf(g1[0]) * u1[0], siluf(g1[1]) * u1[1]); o.w = g8::cvt_pk_bf16(siluf(g1[2]) * u1[2], siluf(g1[3]) * u1[3]);
                        const unsigned off = ((unsigned)(u.base + idx) * 256u + (unsigned)(u.pn * 128 + wc * 32 + 8 * fq)) * 2u;
                        __builtin_amdgcn_raw_buffer_store_b128(o, rs, off, 0, 16);
                    }
                }
            return;
        }
        const int* list = (const int*)(ws + O_LIST) + u.e * 16384;
        const float* wts = (const float*)(ws + O_WTS);
        u16* SL = (u16*)((unsigned char*)ws + O_SL);
        int ent[2][4]; float wg[2][4];
#pragma unroll
        for (int ai = 0; ai < 2; ++ai)
#pragma unroll
            for (int m = 0; m < 4; ++m) {
                const int idx = u.mt * 256 + ai * 128 + wr * 64 + m * 16 + fr;
                ent[ai][m] = list[idx < u.cnt ? idx : u.cnt - 1];
            }
#pragma unroll
        for (int ai = 0; ai < 2; ++ai)
#pragma unroll
            for (int m = 0; m < 4; ++m) wg[ai][m] = wts[ent[ai][m]];
#pragma unroll
        for (int ai = 0; ai < 2; ++ai)
#pragma unroll
            for (int m = 0; m < 4; ++m) {
                const int idx = u.mt * 256 + ai * 128 + wr * 64 + m * 16 + fr;
                if (idx < u.cnt) {
                    u16* rowp = SL + (size_t)ent[ai][m] * 1024 + u.pn * 256 + wc * 32 + 8 * fq;
#pragma unroll
                    for (int bj = 0; bj < 2; ++bj) {
                        const f32x4 v0 = acc[ai][bj][m][0] * wg[ai][m], v1 = acc[ai][bj][m][1] * wg[ai][m];
                        u32x4 o; o.x = g8::cvt_pk_bf16(v0[0], v0[1]); o.y = g8::cvt_pk_bf16(v0[2], v0[3]); o.z = g8::cvt_pk_bf16(v1[0], v1[1]); o.w = g8::cvt_pk_bf16(v1[2], v1[3]);
                        *(u32x4*)(rowp + bj * 128) = o;
                    }
                }
            }
    }
};
__device__ void phase9(const Params& P, char* lds) {
    int* pre_t = (int*)(lds + g8::STAGE_BYTES); int* pre_c = pre_t + 40;
    moe_prefix(P.ws, pre_t, pre_c);
    Moe S; S.ws = P.ws; S.pre_t = pre_t; S.pre_c = pre_c; S.G = gridDim.x; S.c = blockIdx.x;
    int i = 0;
    while (i >= 0) i = g8::gemm_phase<Moe>((LAS unsigned char*)lds, S, i);
}

__device__ void phase11(const Params& P) {
    unsigned char* ws = P.ws;
    const int lane = threadIdx.x & 63;
    const int gw = blockIdx.x * 8 + (threadIdx.x >> 6), nw = gridDim.x * 8;
    const float* mod = (const float*)(ws + O_MOD);
    const u16* SL = (const u16*)(ws + O_SL);
    const int r_lo = (int)(((long long)gw * MLAT) / nw), r_hi = (int)(((long long)(gw + 1) * MLAT) / nw);
    float4 g2[4], fw[4];
    int cur_b = -1;
#pragma unroll
    for (int j = 0; j < 4; ++j) fw[j] = *(const float4*)(P.in[I_FNW] + (lane + 64 * j) * 4);
    for (int row = r_lo; row < r_hi; row += 2) {
        const bool two = row + 1 < r_hi;
        const int row1 = two ? row + 1 : row;
        float4 v0[4], v1[4]; uint2 a0[4], a1[4], b0[4], b1[4];
#pragma unroll
        for (int j = 0; j < 4; ++j) {
            const int k = (lane + 64 * j) * 4;
            v0[j] = *(const float4*)(P.out + (size_t)row * 1024 + k);
            v1[j] = *(const float4*)(P.out + (size_t)row1 * 1024 + k);
            a0[j] = *(const uint2*)(SL + (size_t)(row * 2) * 1024 + k);
            a1[j] = *(const uint2*)(SL + (size_t)(row * 2 + 1) * 1024 + k);
            b0[j] = *(const uint2*)(SL + (size_t)(row1 * 2) * 1024 + k);
            b1[j] = *(const uint2*)(SL + (size_t)(row1 * 2 + 1) * 1024 + k);
        }
#pragma unroll 1
        for (int rr = 0; rr < 2; ++rr) {
            const int orow = rr ? row1 : row;
            const int b = orow >> 12;
            if (b != cur_b) {
                cur_b = b;
#pragma unroll
                for (int j = 0; j < 4; ++j) g2[j] = *(const float4*)(mod + b * 6144 + 5120 + (lane + 64 * j) * 4);
            }
            if (rr == 1 && !two) break;
            float4 x[4]; float ss = 0.f;
#pragma unroll
            for (int j = 0; j < 4; ++j) {
                const float4 vv = rr ? v1[j] : v0[j];
                const uint2 s0 = rr ? b0[j] : a0[j], s1 = rr ? b1[j] : a1[j];
                x[j].x = vv.x + g2[j].x * (bflo(s0.x) + bflo(s1.x));
                x[j].y = vv.y + g2[j].y * (bfhi(s0.x) + bfhi(s1.x));
                x[j].z = vv.z + g2[j].z * (bflo(s0.y) + bflo(s1.y));
                x[j].w = vv.w + g2[j].w * (bfhi(s0.y) + bfhi(s1.y));
                ss += x[j].x * x[j].x + x[j].y * x[j].y + x[j].z * x[j].z + x[j].w * x[j].w;
            }
            const float rstd = rsqrtf(wave_sum(ss) * (1.f / 1024.f) + 1e-6f);
#pragma unroll
            for (int j = 0; j < 4; ++j) {
                float4 o; o.x = x[j].x * rstd * fw[j].x; o.y = x[j].y * rstd * fw[j].y; o.z = x[j].z * rstd * fw[j].z; o.w = x[j].w * rstd * fw[j].w;
                *(float4*)(P.out + (size_t)orow * 1024 + (lane + 64 * j) * 4) = o;
            }
        }
    }
}

__global__ void __launch_bounds__(NTB, 2) fwd_kernel(Params P) {
    extern __shared__ __attribute__((aligned(16))) char lds[];
    if (threadIdx.x < 4) ((volatile LAS unsigned*)(lds + LDS_MAIN))[threadIdx.x] = 0u;
    __syncthreads();
    XcdBarrier xbar = xcd_barrier_post((unsigned*)(P.ws + O_BAR), (volatile LAS unsigned*)(lds + LDS_MAIN));
#define SYNC() xcd_barrier(xbar)
#ifdef ONLY_PH
#define RUN_PHASE(k, call) do { if ((k) == ONLY_PH) { call; } } while (0)
#else
#define RUN_PHASE(k, call) do { if (P.lo <= (k) && (k) < P.hi) { call; if ((k) + 1 < P.hi) { SYNC(); } } } while (0)
#endif
    RUN_PHASE(0, phase0(P, lds));
    RUN_PHASE(1, phase1(P));
    RUN_PHASE(2, { InProj S; S.ws = P.ws; S.G = gridDim.x; S.c = blockIdx.x; g8::gemm_phase<InProj>((LAS unsigned char*)lds, S); });
    RUN_PHASE(3, phase3(P, lds));
    RUN_PHASE(4, phase4(P, lds));
    RUN_PHASE(5, phase5(P));
    RUN_PHASE(6, phase6(P, lds));
    RUN_PHASE(7, phase7(P, lds));
    RUN_PHASE(8, phase8(P, lds));
    RUN_PHASE(9, phase9(P, lds));
    RUN_PHASE(11, phase11(P));
}

extern "C" void kernel_launch(void* const* d_in, const int* in_sizes, int n_in, void* d_out, int out_size, void* d_ws, size_t ws_size,
                              hipStream_t stream) {
    static int grid_blocks = 0;
    if (!grid_blocks) {
        int dev = 0, cus = 0, per_cu = 0;
        (void)hipGetDevice(&dev);
        (void)hipDeviceGetAttribute(&cus, hipDeviceAttributeMultiprocessorCount, dev);
        (void)hipFuncSetAttribute((const void*)fwd_kernel, hipFuncAttributeMaxDynamicSharedMemorySize, LDS_BYTES);
        (void)hipOccupancyMaxActiveBlocksPerMultiprocessor(&per_cu, (const void*)fwd_kernel, NTB, LDS_BYTES);
        if (per_cu < 1) fprintf(stderr, "occupancy query says %d blocks per CU\n", per_cu);
        grid_blocks = cus;
        if (ws_size < WS_END) fprintf(stderr, "workspace too small: %zu < %zu\n", ws_size, (size_t)WS_END);
    }
    Params p{};
    for (int i = 0; i < 30; ++i) p.in[i] = (const float*)d_in[i];
    p.out = (float*)d_out; p.ws = (unsigned char*)d_ws;
    p.lo = 0; p.hi = NPHASE;
    (void)hipMemsetAsync((char*)d_ws + O_BAR, 0, 16384 + 40960, stream);
    void* args[] = {&p};
    hipError_t e = hipLaunchCooperativeKernel((const void*)fwd_kernel, dim3(grid_blocks), dim3(NTB), args, LDS_BYTES, stream);
    if (e != hipSuccess) fprintf(stderr, "cooperative launch failed: %s (grid %d)\n", hipGetErrorString(e), grid_blocks);
}
```

```cpp
#include <hip/hip_runtime.h>
#include <cstdio>
#include <cstdint>

typedef unsigned short u16;
typedef __attribute__((ext_vector_type(8))) short bf16x8;
typedef __attribute__((ext_vector_type(4))) float f32x4;
typedef __attribute__((ext_vector_type(4))) unsigned u32x4;
#define LAS __attribute__((address_space(3)))

constexpr int NTB = 512;
constexpr int VLDS = 75776;
constexpr int LDS_MAIN = 2 * VLDS;
constexpr int LDS_BYTES = LDS_MAIN + 256;
constexpr int MLAT = 16384, MALL = 17408;
constexpr int NCH = 34;
constexpr int NPHASE = 12;

enum { I_X = 0, I_C, I_CTX, I_CCTX, I_WMOD, I_BMOD, I_N1W, I_WIN, I_SCW, I_SCB, I_DTB, I_ALOG, I_SSDD, I_SNW, I_MCW, I_MCB, I_WQK, I_GB,
       I_MNW, I_MSKIP, I_WOUT, I_N2W, I_RGW, I_RGB, I_REW, I_REB, I_WG, I_WU, I_WD, I_FNW };

constexpr size_t al(size_t x) { return (x + 255) & ~(size_t)255; }
constexpr size_t O_MOD = 0;
constexpr size_t O_SSQ = O_MOD + al(5 * 6144 * 4);
constexpr size_t O_CNT = O_SSQ + al(16384 * 16 * 4);
constexpr size_t O_BAR = O_CNT + 8192;
constexpr size_t O_RDY = O_BAR + 16384;
constexpr size_t O_PSD = O_RDY + 40960;
constexpr size_t O_PSG = O_PSD + al((size_t)MALL * 16 * 4);
constexpr size_t O_DT = O_PSG + al((size_t)MALL * 16 * 4);
constexpr size_t O_GI = O_DT + al((size_t)MALL * 16 * 4);
constexpr size_t O_GF = O_GI + al((size_t)MALL * 8 * 4);
constexpr size_t O_ACH = O_GF + al((size_t)MALL * 8 * 4);
constexpr size_t O_MLS = O_ACH + 16384;
constexpr size_t O_MLP = O_MLS + 16384;
constexpr size_t O_MLN = O_MLP + 16384;
constexpr size_t O_LIST = O_MLN + al(4 * 34 * 4 * 2 * 128 * 4);
constexpr size_t O_WTS = O_LIST + al(32 * 16384 * 4);
constexpr size_t O_WIN = O_WTS + al(16384 * 2 * 4);
constexpr size_t O_WOUT = O_WIN + al((size_t)3328 * 1024 * 2);
constexpr size_t O_A = O_WOUT + al((size_t)1024 * 1024 * 2);
constexpr size_t SZ_A = (size_t)MALL * 1024 * 2;
constexpr size_t O_PT = O_A + SZ_A;
constexpr size_t SZ_PT = (size_t)MALL * 1536 * 2;
constexpr size_t O_MLC1 = O_PT + SZ_PT;
constexpr size_t SZ_HALF = (size_t)MALL * 512 * 2;
constexpr size_t O_ZO = O_MLC1 + SZ_HALF;
constexpr size_t O_VT = O_ZO + SZ_A;
constexpr size_t O_BM = O_VT + SZ_HALF;
constexpr size_t SZ_Q = (size_t)MALL * 256 * 2;
constexpr size_t O_BT = O_BM + SZ_Q;
constexpr size_t O_CM = O_BT + SZ_Q;
constexpr size_t O_XT = O_CM + SZ_Q;
constexpr size_t O_KT = O_XT + SZ_HALF;
constexpr size_t O_XC = O_KT + SZ_HALF;
constexpr size_t WS_END = O_XC + SZ_HALF;
constexpr size_t O_XN = O_A, O_Q = O_A, O_K = O_A + SZ_HALF, O_T = O_A;
constexpr size_t O_ST = O_PT;
constexpr size_t O_MLC0 = O_PT + (size_t)4 * 34 * 8 * 2 * 8192 * 2;
constexpr size_t O_WGU = O_PT;
constexpr size_t O_WD = O_PT + (size_t)32 * 512 * 1024 * 2;
constexpr size_t O_SL = O_ZO;
constexpr size_t O_H = O_XT;
static_assert(O_WD + (size_t)32 * 1024 * 256 * 2 <= O_MLC1, "moe weights fit PT region");
static_assert(O_SL + (size_t)16384 * 2 * 1024 * 2 <= O_CM, "slots fit");
static_assert((size_t)(32768 + 256) * 256 * 2 <= SZ_HALF, "H fits");
static_assert(WS_END <= (size_t)256 * 1024 * 1024, "workspace");
constexpr size_t TCTX512 = (size_t)4 * 512 * 4096;
constexpr size_t TCTX256 = (size_t)4 * 256 * 4096;

struct Params { const float* in[30]; float* out; unsigned char* ws; int lo, hi; };

#define XB_TMO      128
#define XB_XCNT(j)  (256  + 64 * (j))
#define XB_XSUB(j)  (1280 + 64 * (j))
#define XB_XGEN(j)  (2304 + 64 * (j))
#define XB_TOP      3328
#define XB_TOPGEN   3392
#define XCD_BAR_WORDS 3456
#define XB_SPIN_CAP (1u << 20)
__device__ __forceinline__ unsigned xb_ld(unsigned* p)              { return __hip_atomic_load(p, __ATOMIC_RELAXED, __HIP_MEMORY_SCOPE_AGENT); }
__device__ __forceinline__ unsigned xb_add(unsigned* p, unsigned v) { return __hip_atomic_fetch_add(p, v, __ATOMIC_RELAXED, __HIP_MEMORY_SCOPE_AGENT); }
__device__ __forceinline__ unsigned xb_xcc_id() { return (unsigned)__builtin_amdgcn_s_getreg((3 << 11) | 20) & 0xFu; }
#define XB_SPIN(cond, bar) do { unsigned _sp = 0; while (cond) { __builtin_amdgcn_s_sleep(1); \
    if ((++_sp & 255u) == 0u) { if (xb_ld(&(bar)[XB_TMO])) break; if (_sp > XB_SPIN_CAP) { atomicAdd(&(bar)[XB_TMO], 1u); break; } } } } while (0)
struct XcdBarrier { unsigned* bar; unsigned x; volatile LAS unsigned* st; };
__device__ __forceinline__ XcdBarrier xcd_barrier_post(unsigned* bar, volatile LAS unsigned* st) {
    XcdBarrier b; b.bar = bar; b.x = xb_xcc_id(); b.st = st;
    if (threadIdx.x == 0) (void)xb_add(&bar[XB_XCNT(b.x)], 1u);
    return b;
}
__device__ __forceinline__ void xcd_barrier_complete(unsigned* bar, unsigned x, unsigned& nloc, unsigned& nx) {
    const unsigned G = gridDim.x * gridDim.y * gridDim.z;
    unsigned sum, cnt, mine, sp = 0u;
    for (;;) {
        sum = 0u; cnt = 0u; mine = 0u;
#pragma unroll
        for (unsigned j = 0; j < 16; ++j) { const unsigned c = xb_ld(&bar[XB_XCNT(j)]); sum += c; cnt += (c > 0u) ? 1u : 0u; mine = (j == x) ? c : mine; }
        if (sum == G) break;
        __builtin_amdgcn_s_sleep(1);
        if ((++sp & 255u) == 0u) { if (xb_ld(&bar[XB_TMO])) break; if (sp > XB_SPIN_CAP) { atomicAdd(&bar[XB_TMO], 1u); break; } }
    }
    nloc = mine > 0u ? mine : 1u; nx = cnt > 0u ? cnt : 1u;
}
__device__ __forceinline__ void xcd_barrier(const XcdBarrier& b) {
    asm volatile("s_waitcnt vmcnt(0)" ::: "memory");
    __syncthreads();
    if (threadIdx.x == 0) {
        unsigned* bar = b.bar;
        __builtin_amdgcn_s_waitcnt(0);
        unsigned nloc = b.st[0], nx = b.st[1];
        if (nloc == 0u) { xcd_barrier_complete(bar, b.x, nloc, nx); b.st[0] = nloc; b.st[1] = nx; }
        const unsigned old = xb_add(&bar[XB_XSUB(b.x)], 1u);
        const unsigned gen = old / nloc;
        if (old + 1u == (gen + 1u) * nloc) {
            __builtin_amdgcn_fence(__ATOMIC_RELEASE, "agent");
            asm volatile("s_waitcnt vmcnt(0)" ::: "memory");
            const unsigned og = xb_add(&bar[XB_TOP], 1u);
            const unsigned tg = og / nx;
            if (og + 1u == (tg + 1u) * nx) xb_add(&bar[XB_TOPGEN], 1u);
            else XB_SPIN(xb_ld(&bar[XB_TOPGEN]) == tg, bar);
            __builtin_amdgcn_fence(__ATOMIC_ACQUIRE, "agent");
            xb_add(&bar[XB_XGEN(b.x)], 1u);
            asm volatile("s_waitcnt vmcnt(0)" ::: "memory");
        } else {
            XB_SPIN(xb_ld(&bar[XB_XGEN(b.x)]) == gen, bar);
            __builtin_amdgcn_fence(__ATOMIC_ACQUIRE, "agent");
            asm volatile("s_waitcnt vmcnt(0)" ::: "memory");
        }
    }
    __syncthreads();
}

__device__ __forceinline__ u16 f2bf(float f) { unsigned u = __float_as_uint(f); u += 0x7fffu + ((u >> 16) & 1u); return (u16)(u >> 16); }
__device__ __forceinline__ float bf2f(u16 h) { return __uint_as_float(((unsigned)h) << 16); }
__device__ __forceinline__ unsigned pack2(float a, float b) { return (unsigned)f2bf(a) | ((unsigned)f2bf(b) << 16); }
__device__ __forceinline__ float bflo(unsigned u) { return __uint_as_float(u << 16); }
__device__ __forceinline__ float bfhi(unsigned u) { return __uint_as_float(u & 0xffff0000u); }
__device__ __forceinline__ float siluf(float x) { return x / (1.f + __expf(-x)); }
__device__ __forceinline__ float sigmf(float x) { return 1.f / (1.f + __expf(-x)); }
__device__ __forceinline__ float softplusf(float x) { return x > 20.f ? x : log1pf(__expf(x)); }
__device__ __forceinline__ float wave_sum(float v) {
#pragma unroll
    for (int o = 32; o > 0; o >>= 1) v += __shfl_xor(v, o);
    return v;
}
__device__ __forceinline__ int swz256(int row, int chunk) { return row * 256 + ((chunk ^ (row & 15)) << 4); }
__device__ __forceinline__ int colmajor_src_row(int R) {
    if (R >= MLAT) return R;
    const int b = R >> 12, lp = R & 4095;
    return (b << 12) + ((lp & 63) << 6) + (lp >> 6);
}

__device__ __forceinline__ void load_tile128(char* lds, int lrow0, const u16* __restrict__ g, size_t ld, int rows, int t, int nthr) {
#pragma unroll 4
    for (int q = t; q < rows * 16; q += nthr) {
        const int r = q >> 4, c = q & 15;
        const uint4 v = *(const uint4*)(g + (size_t)r * ld + c * 8);
        *(uint4*)(lds + swz256(lrow0 + r, c)) = v;
    }
}
__device__ __forceinline__ void load_tile128_scaled(char* lds, int lrow0, const u16* __restrict__ g, size_t ld, int rows, const float* w, int t, int nthr) {
#pragma unroll 2
    for (int q = t; q < rows * 16; q += nthr) {
        const int r = q >> 4, c = q & 15;
        const uint4 v = *(const uint4*)(g + (size_t)r * ld + c * 8);
        const float* ww = w + c * 8;
        uint4 o;
        o.x = pack2(bflo(v.x) * ww[0], bfhi(v.x) * ww[1]);
        o.y = pack2(bflo(v.y) * ww[2], bfhi(v.y) * ww[3]);
        o.z = pack2(bflo(v.z) * ww[4], bfhi(v.z) * ww[5]);
        o.w = pack2(bflo(v.w) * ww[6], bfhi(v.w) * ww[7]);
        *(uint4*)(lds + swz256(lrow0 + r, c)) = o;
    }
}
template <int MI, int NJ>
__device__ __forceinline__ void lds_mma(const char* A, const char* B, int arow0, int brow0, f32x4 (&acc)[MI][NJ], int lane) {
#pragma unroll 1
    for (int kk = 0; kk < 4; ++kk) {
        const int chunk = kk * 4 + (lane >> 4);
        bf16x8 a[MI], b[NJ];
#pragma unroll
        for (int i = 0; i < MI; ++i) { const int row = arow0 + i * 16 + (lane & 15); a[i] = *(const bf16x8*)(A + swz256(row, chunk)); }
#pragma unroll
        for (int j = 0; j < NJ; ++j) { const int row = brow0 + j * 16 + (lane & 15); b[j] = *(const bf16x8*)(B + swz256(row, chunk)); }
#pragma unroll
        for (int i = 0; i < MI; ++i)
#pragma unroll
            for (int j = 0; j < NJ; ++j) acc[i][j] = __builtin_amdgcn_mfma_f32_16x16x32_bf16(a[i], b[j], acc[i][j], 0, 0, 0);
    }
}
template <int MI, int NJ>
__device__ __forceinline__ void lds_mma_t(const char* A, const char* B, int arow0, int brow0, f32x4 (&acc)[MI][NJ], int lane) {
#pragma unroll 1
    for (int kk = 0; kk < 4; ++kk) {
        const int chunk = kk * 4 + (lane >> 4);
        bf16x8 a[MI], b[NJ];
#pragma unroll
        for (int i = 0; i < MI; ++i) { const int row = arow0 + i * 16 + (lane & 15); a[i] = *(const bf16x8*)(A + swz256(row, chunk)); }
#pragma unroll
        for (int j = 0; j < NJ; ++j) { const int row = brow0 + j * 16 + (lane & 15); b[j] = *(const bf16x8*)(B + swz256(row, chunk)); }
#pragma unroll
        for (int i = 0; i < MI; ++i)
#pragma unroll
            for (int j = 0; j < NJ; ++j) acc[i][j] = __builtin_amdgcn_mfma_f32_16x16x32_bf16(b[j], a[i], acc[i][j], 0, 0, 0);
    }
}
template <int MI, int NJ>
__device__ __forceinline__ void zero_acc(f32x4 (&acc)[MI][NJ]) {
#pragma unroll
    for (int i = 0; i < MI; ++i)
#pragma unroll
        for (int j = 0; j < NJ; ++j) acc[i][j] = f32x4{0.f, 0.f, 0.f, 0.f};
}
template <int OP>
__device__ __forceinline__ float scan_pair(float v, float* buf, int t) {
    const int idx = t & 127, base = t & 128;
    const bool act = t < 256;
    if (act) buf[t] = v;
    __syncthreads();
#pragma unroll 1
    for (int off = 1; off < 128; off <<= 1) {
        float o = OP ? -INFINITY : 0.f;
        if (act && idx >= off) o = buf[base + idx - off];
        __syncthreads();
        v = OP ? fmaxf(v, o) : v + o;
        if (act) buf[t] = v;
        __syncthreads();
    }
    return v;
}

__device__ __forceinline__ float wave_scan_sum(float v, int lane) {
#pragma unroll
    for (int off = 1; off < 64; off <<= 1) { const float o = __shfl_up(v, off); if (lane >= off) v += o; }
    return v;
}
__device__ __forceinline__ float wave_scan_max(float v, int lane) {
#pragma unroll
    for (int off = 1; off < 64; off <<= 1) { const float o = __shfl_up(v, off); if (lane >= off) v = fmaxf(v, o); }
    return v;
}
__device__ __forceinline__ float wave_max(float v) {
#pragma unroll
    for (int o = 32; o > 0; o >>= 1) v = fmaxf(v, __shfl_xor(v, o));
    return v;
}
__device__ __forceinline__ void transpose_tile(float* tile, const float* __restrict__ src, int ld_src, int k0, int n0, int ncount,
                                               u16* dst, size_t dst_row0, int ld_dst, const float* __restrict__ scale, int scale_kmax, int t) {
    const int n = t & 63, kq = t >> 6;
    const int nc = n < ncount ? n : ncount - 1;
    float vv[16];
#pragma unroll
    for (int i = 0; i < 16; ++i) vv[i] = src[(size_t)(k0 + i * 4 + kq) * ld_src + n0 + nc];
#pragma unroll
    for (int i = 0; i < 16; ++i) {
        const int k = i * 4 + kq;
        float v = vv[i];
        if (scale && (k0 + k) < scale_kmax) v *= scale[k0 + k];
        tile[k * 65 + n] = n < ncount ? v : 0.f;
    }
    __syncthreads();
#pragma unroll
    for (int i = 0; i < 2; ++i) {
        const int q = t + 256 * i, nn = q >> 3, kc = q & 7;
        if (nn < ncount) {
            const float* p = tile + (kc * 8) * 65 + nn;
            uint4 o;
            o.x = pack2(p[0], p[65]); o.y = pack2(p[130], p[195]); o.z = pack2(p[260], p[325]); o.w = pack2(p[390], p[455]);
            *(uint4*)(dst + (dst_row0 + nn) * (size_t)ld_dst + k0 + kc * 8) = o;
        }
    }
    __syncthreads();
}

__device__ __forceinline__ void transpose_tile_w(float* tile, const float* __restrict__ src, int ld_src, int k0, int n0,
                                                 u16* dst, size_t dst_row0, int ld_dst, const float* __restrict__ scale, int scale_kmax, int t) {
    float4 v[8];
#pragma unroll
    for (int i = 0; i < 8; ++i) { const int q = t + 256 * i, kr = q >> 5, nq = q & 31; v[i] = *(const float4*)(src + (size_t)(k0 + kr) * ld_src + n0 + nq * 4); }
#pragma unroll
    for (int i = 0; i < 8; ++i) {
        const int q = t + 256 * i, kr = q >> 5, nq = q & 31;
        float sc = 1.f;
        if (scale && (k0 + kr) < scale_kmax) sc = scale[k0 + kr];
        float* p = tile + kr * 129 + nq * 4;
        p[0] = v[i].x * sc; p[1] = v[i].y * sc; p[2] = v[i].z * sc; p[3] = v[i].w * sc;
    }
    __syncthreads();
#pragma unroll
    for (int i = 0; i < 4; ++i) {
        const int q = t + 256 * i, nn = q >> 3, kc = q & 7;
        const float* p = tile + (kc * 8) * 129 + nn;
        uint4 o;
        o.x = pack2(p[0], p[129]); o.y = pack2(p[258], p[387]); o.z = pack2(p[516], p[645]); o.w = pack2(p[774], p[903]);
        *(uint4*)(dst + (dst_row0 + nn) * (size_t)ld_dst + k0 + kc * 8) = o;
    }
    __syncthreads();
}

namespace g8 {
constexpr int BM = 256, BK = 64, HALF = 128, HTB = HALF * BK * 2, STAGE_BYTES = 8 * HTB;
__device__ __forceinline__ int lds_byte(int r, int c) { const int st = (r >> 4) * 2 + (c >> 5), rr = r & 15, cc = c & 31, ob = rr * 64 + cc * 2; return st * 1024 + (ob ^ (((ob >> 9) & 1) << 5)); }
__device__ __forceinline__ void stage_rc(int b, int& R, int& C) { const int st = b / 1024, sb = b % 1024, swz = sb ^ (((sb >> 9) & 1) << 5); R = (st >> 1) * 16 + swz / 64; C = (st & 1) * 32 + (swz % 64) / 2; }
__device__ __forceinline__ int perm32(int rho) { const int n = rho >> 4, i = rho & 15; return 8 * (i >> 2) + 4 * n + (i & 3); }
__device__ __forceinline__ unsigned cvt_pk_bf16(float lo, float hi) { unsigned r; asm volatile("v_cvt_pk_bf16_f32 %0, %1, %2" : "=v"(r) : "v"(lo), "v"(hi)); return r; }
typedef f32x4 Acc[2][2][4][2];

template <class Prob>
__device__ __forceinline__ int gemm_phase(LAS unsigned char* lds, const Prob& S, int i0 = 0) {
    const int tid = threadIdx.x, wid = __builtin_amdgcn_readfirstlane(tid >> 6), lane = tid & 63, wr = wid >> 2, wc = wid & 3, fr = lane & 15, fq = lane >> 4;
    int nt = 0;
    const size_t kstep = (size_t)(BK * 2);
    const unsigned ldsw = (unsigned)wid * 1024u;
    const int aoff = lds_byte(wr * 64 + fr, fq * 8), boff = lds_byte(wc * 32 + fr, fq * 8);
#define G8_SA(b, h) (((b) * 2 + (h)) * HTB)
#define G8_SB(b, h) ((4 + (b) * 2 + (h)) * HTB)
#define G8_STAGE(bufoff, gbase, voff) do { _Pragma("unroll") for (int _i = 0; _i < 2; ++_i) \
        __builtin_amdgcn_global_load_lds((const unsigned*)((const char*)(gbase) + (voff)[_i]), (LAS unsigned*)(lds + (bufoff) + ldsw + _i * 8192), 16, 0, 0); } while (0)
#define G8_LDA(dst, b, h) do { _Pragma("unroll") for (int m = 0; m < 4; ++m) _Pragma("unroll") for (int k = 0; k < 2; ++k) dst[m][k] = *(const LAS bf16x8*)(lds + G8_SA(b, h) + aoff + m * 2048 + k * 1024); } while (0)
#define G8_LDB(dst, b, h) do { _Pragma("unroll") for (int n = 0; n < 2; ++n) _Pragma("unroll") for (int k = 0; k < 2; ++k) dst[n][k] = *(const LAS bf16x8*)(lds + G8_SB(b, h) + boff + n * 2048 + k * 1024); } while (0)
#define G8_MMA(ai, bj, At, Bt) do { __builtin_amdgcn_s_setprio(1); _Pragma("unroll") for (int m = 0; m < 4; ++m) _Pragma("unroll") for (int n = 0; n < 2; ++n) _Pragma("unroll") for (int k = 0; k < 2; ++k) \
        acc[ai][bj][m][n] = __builtin_amdgcn_mfma_f32_16x16x32_bf16(Bt[n][k], At[m][k], acc[ai][bj][m][n], 0, 0, 0); __builtin_amdgcn_s_setprio(0); } while (0)
#define G8_WAIT_V(n) asm volatile("s_waitcnt vmcnt(" #n ")" ::: "memory")
#define G8_WAIT_L(n) asm volatile("s_waitcnt lgkmcnt(" #n ")" ::: "memory")
#define G8_BAR __builtin_amdgcn_s_barrier()
#define G8_SCHED __builtin_amdgcn_sched_barrier(0)
    typename Prob::Unit cur, nxt; int ui = i0; bool stopped = false;
    if (!S.next(i0, cur)) return -1;
    nt = S.nt(cur);
    S.a_ready(cur);
    Acc acc;
#pragma unroll
    for (int a = 0; a < 2; ++a)
#pragma unroll
        for (int b = 0; b < 2; ++b)
#pragma unroll
            for (int m = 0; m < 4; ++m)
#pragma unroll
                for (int n = 0; n < 2; ++n) acc[a][b][m][n] = (f32x4){0.f, 0.f, 0.f, 0.f};
    bf16x8 At[4][2], B0[2][2], B1[2][2];
    unsigned cOA[2][2], cOB[2][2], nOA[2][2], nOB[2][2];
    S.offs(cur, tid, cOA, cOB);
    const char* cA = S.baseA(cur); const char* cB = S.baseB(cur);
    G8_STAGE(G8_SB(0, 0), cB, cOB[0]); G8_STAGE(G8_SA(0, 0), cA, cOA[0]); G8_STAGE(G8_SB(0, 1), cB, cOB[1]); G8_STAGE(G8_SA(0, 1), cA, cOA[1]);
    if (wr == 1) G8_BAR;
    G8_WAIT_V(4); G8_BAR;
    G8_STAGE(G8_SB(1, 0), cB + kstep, cOB[0]); G8_STAGE(G8_SA(1, 0), cA + kstep, cOA[0]); G8_STAGE(G8_SB(1, 1), cB + kstep, cOB[1]);
    G8_WAIT_V(6); G8_BAR;
    for (;;) {
        bool has_next = S.next(ui + 1, nxt);
        if (has_next && S.brk(cur, nxt)) { has_next = false; stopped = true; }
        const char* nA = cA; const char* nB = cB;
#pragma unroll
        for (int h = 0; h < 2; ++h)
#pragma unroll
            for (int i = 0; i < 2; ++i) { nOA[h][i] = cOA[h][i]; nOB[h][i] = cOB[h][i]; }
        if (has_next) { S.offs(nxt, tid, nOA, nOB); nA = S.baseA(nxt); nB = S.baseB(nxt); }
#pragma unroll 1
        for (int t = 0; t < nt; t += 2) {
            const bool last = (t == nt - 2);
            if (Prob::MIDT > 0 && t == Prob::MIDT) S.mid(acc, cur, wr, fr);
            if (last && has_next) S.a_ready(nxt);
            const char* a1 = cA + (size_t)(t + 1) * kstep;
            const char* a2 = last ? nA : cA + (size_t)(t + 2) * kstep; const char* b2 = last ? nB : cB + (size_t)(t + 2) * kstep;
            const char* a3 = a2 + kstep; const char* b3 = b2 + kstep;
            unsigned xA[2][2], xB[2][2];
#pragma unroll
            for (int h = 0; h < 2; ++h)
#pragma unroll
                for (int i = 0; i < 2; ++i) { xA[h][i] = last ? nOA[h][i] : cOA[h][i]; xB[h][i] = last ? nOB[h][i] : cOB[h][i]; }
            G8_LDB(B0, 0, 0); G8_SCHED; G8_LDA(At, 0, 0); G8_STAGE(G8_SA(1, 1), a1, cOA[1]);
            G8_WAIT_L(8); G8_BAR; G8_WAIT_L(0); G8_MMA(0, 0, At, B0); G8_BAR; G8_SCHED;
            G8_LDB(B1, 0, 1); G8_STAGE(G8_SB(0, 0), b2, xB[0]);
            G8_BAR; G8_WAIT_L(0); G8_MMA(0, 1, At, B1); G8_BAR;
            G8_LDA(At, 0, 1); G8_STAGE(G8_SA(0, 0), a2, xA[0]);
            G8_BAR; G8_WAIT_L(0); G8_MMA(1, 0, At, B0); G8_BAR; G8_SCHED;
            G8_STAGE(G8_SB(0, 1), b2, xB[1]);
            G8_WAIT_V(6); G8_BAR; G8_MMA(1, 1, At, B1); G8_BAR;
            G8_LDB(B0, 1, 0); G8_SCHED; G8_LDA(At, 1, 0); G8_STAGE(G8_SA(0, 1), a2, xA[1]);
            G8_WAIT_L(8); G8_BAR; G8_WAIT_L(0); G8_MMA(0, 0, At, B0); G8_BAR; G8_SCHED;
            G8_LDB(B1, 1, 1); G8_STAGE(G8_SB(1, 0), b3, xB[0]);
            G8_BAR; G8_WAIT_L(0); G8_MMA(0, 1, At, B1); G8_BAR;
            G8_LDA(At, 1, 1); G8_STAGE(G8_SA(1, 0), a3, xA[0]);
            G8_BAR; G8_WAIT_L(0); G8_MMA(1, 0, At, B0); G8_BAR; G8_SCHED;
            G8_STAGE(G8_SB(1, 1), b3, xB[1]);
            G8_WAIT_V(6); G8_BAR; G8_MMA(1, 1, At, B1); G8_BAR;
        }
        S.epi(acc, cur, wr, wc, fr, fq);
        S.done(cur);
        if (!has_next) break;
#pragma unroll
        for (int a = 0; a < 2; ++a)
#pragma unroll
            for (int b = 0; b < 2; ++b)
#pragma unroll
                for (int m = 0; m < 4; ++m)
#pragma unroll
                    for (int n = 0; n < 2; ++n) acc[a][b][m][n] = (f32x4){0.f, 0.f, 0.f, 0.f};
        cur = nxt; cA = nA; cB = nB; ++ui; nt = S.nt(cur);
#pragma unroll
        for (int h = 0; h < 2; ++h)
#pragma unroll
            for (int i = 0; i < 2; ++i) { cOA[h][i] = nOA[h][i]; cOB[h][i] = nOB[h][i]; }
    }
    G8_WAIT_V(0);
    if (wr == 0) G8_BAR;
    G8_BAR;
    const int ret_next = stopped ? ui + 1 : -1;
#undef G8_SA
#undef G8_SB
#undef G8_STAGE
#undef G8_LDA
#undef G8_LDB
#undef G8_MMA
#undef G8_WAIT_V
#undef G8_WAIT_L
#undef G8_BAR
#undef G8_SCHED
    return ret_next;
}
__device__ __forceinline__ void dense_unit(int wgid, int nM, int nN, int& pm, int& pn) {
    const int nwg = nM * nN, NXCD = 8, WGM = 8;
    { const int q = nwg / NXCD, r = nwg % NXCD, xcd = wgid % NXCD, off = wgid / NXCD; wgid = (xcd < r ? xcd * (q + 1) : r * (q + 1) + (xcd - r) * q) + off; }
    const int nig = WGM * nN, gid = wgid / nig, fm = gid * WGM, gsz = (nM - fm) < WGM ? (nM - fm) : WGM;
    pm = fm + ((wgid % nig) % gsz); pn = (wgid % nig) / gsz;
}
}

__device__ void phase0(const Params& P, char* lds_all) {
    unsigned char* ws = P.ws;
    const int vb = threadIdx.x >> 8, t = threadIdx.x & 255;
    char* lds = lds_all + vb * VLDS;
    float* tile = (float*)lds;
    const int NU = 744;
    for (int u = blockIdx.x * 2 + vb; u < NU; u += gridDim.x * 2) {
        if (u < 384) {
            int nt, v, n0b, drb;
            if (u < 192) { v = u; n0b = 0; drb = 0; }
            else if (u < 256) { v = u - 192; n0b = 1552; drb = 1536; }
            else if (u < 320) { v = u - 256; n0b = 2576; drb = 2048; }
            else { v = u - 320; n0b = 2064; drb = 2816; }
            nt = v >> 4;
            transpose_tile_w(tile, P.in[I_WIN], 3104, (v & 15) * 64, n0b + nt * 128, (u16*)(ws + O_WIN), drb + nt * 128, 1024, nullptr, 0, t);
        } else if (u < 416) {
            const int v = u - 384;
            if (v < 16) transpose_tile(tile, P.in[I_WIN], 3104, v * 64, 1536, 16, (u16*)(ws + O_WIN), 2560, 1024, nullptr, 0, t);
            else transpose_tile(tile, P.in[I_WIN], 3104, (v - 16) * 64, 3088, 16, (u16*)(ws + O_WIN), 2576, 1024, nullptr, 0, t);
        } else if (u < 544) {
            const int v = u - 416, nt = v >> 4;
            transpose_tile_w(tile, P.in[I_WOUT], 1024, (v & 15) * 64, nt * 128, (u16*)(ws + O_WOUT), nt * 128, 1024, P.in[I_SNW], 512, t);
        } else if (u < 552) {
            const int base = (u - 544) * 4096;
            for (int i = 0; i < 16; ++i) {
                const int idx = base + t + 256 * i;
                if (idx < 224 * 128) *(uint4*)(ws + O_WIN + ((size_t)(2592 + (idx >> 7)) * 1024 + (idx & 127) * 8) * 2) = make_uint4(0, 0, 0, 0);
            }
        } else {
            const int c0 = (u - 552) * 32;
            float* sc = (float*)lds;
            float* red = sc + 5 * 1024;
            for (int i = t; i < 5 * 1024; i += 256) {
                const int r = i >> 10, k = i & 1023;
                const float v = r < 4 ? P.in[I_C][r * 1024 + k] : P.in[I_CCTX][k];
                sc[i] = siluf(v);
            }
            __syncthreads();
            const int cq = t & 7, kg = t >> 3;
            float4 a0 = {0, 0, 0, 0}, a1 = a0, a2 = a0, a3 = a0, a4 = a0;
            const float* wp = P.in[I_WMOD] + (size_t)(kg * 32) * 6144 + c0 + cq * 4;
#pragma unroll 16
            for (int k = 0; k < 32; ++k) {
                const float4 wv = *(const float4*)(wp + (size_t)k * 6144);
                const int kk = kg * 32 + k;
                const float s0 = sc[kk], s1 = sc[1024 + kk], s2 = sc[2048 + kk], s3 = sc[3072 + kk], s4 = sc[4096 + kk];
                a0.x += s0 * wv.x; a0.y += s0 * wv.y; a0.z += s0 * wv.z; a0.w += s0 * wv.w;
                a1.x += s1 * wv.x; a1.y += s1 * wv.y; a1.z += s1 * wv.z; a1.w += s1 * wv.w;
                a2.x += s2 * wv.x; a2.y += s2 * wv.y; a2.z += s2 * wv.z; a2.w += s2 * wv.w;
                a3.x += s3 * wv.x; a3.y += s3 * wv.y; a3.z += s3 * wv.z; a3.w += s3 * wv.w;
                a4.x += s4 * wv.x; a4.y += s4 * wv.y; a4.z += s4 * wv.z; a4.w += s4 * wv.w;
            }
            *(float4*)(red + ((kg * 5 + 0) * 32) + cq * 4) = a0; *(float4*)(red + ((kg * 5 + 1) * 32) + cq * 4) = a1;
            *(float4*)(red + ((kg * 5 + 2) * 32) + cq * 4) = a2; *(float4*)(red + ((kg * 5 + 3) * 32) + cq * 4) = a3;
            *(float4*)(red + ((kg * 5 + 4) * 32) + cq * 4) = a4;
            __syncthreads();
            if (t < 160) {
                const int r = t >> 5, cc = t & 31;
                float s = P.in[I_BMOD][c0 + cc];
#pragma unroll
                for (int g = 0; g < 32; ++g) s += red[(g * 5 + r) * 32 + cc];
                ((float*)(ws + O_MOD))[r * 6144 + c0 + cc] = s;
            }
            __syncthreads();
        }
    }
    if (blockIdx.x == 0 && threadIdx.x < 32) ((int*)(ws + O_CNT))[threadIdx.x * 64] = 0;
}

__device__ void phase1(const Params& P) {
    unsigned char* ws = P.ws;
    const int lane = threadIdx.x & 63;
    const int gw = blockIdx.x * 8 + (threadIdx.x >> 6), nw = gridDim.x * 8;
    const float* mod = (const float*)(ws + O_MOD);
    u16* xn = (u16*)(ws + O_XN);
    const int r_lo = (int)(((long long)gw * MALL) / nw), r_hi = (int)(((long long)(gw + 1) * MALL) / nw);
    float4 mul[4], sh[4];
    int cur_mb = -1;
    for (int row = r_lo; row < r_hi; row += 2) {
        const bool two = row + 1 < r_hi;
        const int row1 = two ? row + 1 : row;
        const float* x0 = row < MLAT ? P.in[I_X] + (size_t)row * 1024 : P.in[I_CTX] + (size_t)(row - MLAT) * 1024;
        const float* x1 = row1 < MLAT ? P.in[I_X] + (size_t)row1 * 1024 : P.in[I_CTX] + (size_t)(row1 - MLAT) * 1024;
        float4 v0[4], v1[4];
#pragma unroll
        for (int j = 0; j < 4; ++j) { v0[j] = ((const float4*)x0)[lane + 64 * j]; v1[j] = ((const float4*)x1)[lane + 64 * j]; }
        const int mb0 = row < MLAT ? (row >> 12) : 4, mb1 = row1 < MLAT ? (row1 >> 12) : 4;
        float s0 = 0.f, s1 = 0.f;
#pragma unroll
        for (int j = 0; j < 4; ++j) {
            s0 += v0[j].x * v0[j].x + v0[j].y * v0[j].y + v0[j].z * v0[j].z + v0[j].w * v0[j].w;
            s1 += v1[j].x * v1[j].x + v1[j].y * v1[j].y + v1[j].z * v1[j].z + v1[j].w * v1[j].w;
        }
        s0 = rsqrtf(wave_sum(s0) * (1.f / 1024.f) + 1e-6f);
        s1 = rsqrtf(wave_sum(s1) * (1.f / 1024.f) + 1e-6f);
#pragma unroll 1
        for (int rr = 0; rr < 2; ++rr) {
            const int mb = rr ? mb1 : mb0;
            if (mb != cur_mb) {
                cur_mb = mb;
#pragma unroll
                for (int j = 0; j < 4; ++j) {
                    const int k = (lane + 64 * j) * 4;
                    const float4 nwv = *(const float4*)(P.in[I_N1W] + k);
                    const float4 sc = *(const float4*)(mod + mb * 6144 + 1024 + k);
                    sh[j] = *(const float4*)(mod + mb * 6144 + k);
                    mul[j].x = nwv.x * (1.f + sc.x); mul[j].y = nwv.y * (1.f + sc.y); mul[j].z = nwv.z * (1.f + sc.z); mul[j].w = nwv.w * (1.f + sc.w);
                }
            }
            if (rr == 1 && !two) break;
            const float rstd = rr ? s1 : s0;
            const int orow = rr ? row1 : row;
#pragma unroll
            for (int j = 0; j < 4; ++j) {
                const int k = (lane + 64 * j) * 4;
                const float4 vv = rr ? v1[j] : v0[j];
                uint2 o;
                o.x = pack2(vv.x * rstd * mul[j].x + sh[j].x, vv.y * rstd * mul[j].y + sh[j].y);
                o.y = pack2(vv.z * rstd * mul[j].z + sh[j].z, vv.w * rstd * mul[j].w + sh[j].w);
                *(uint2*)(xn + (size_t)orow * 1024 + k) = o;
            }
        }
    }
}

struct InProj {
    static constexpr int K = 1024; static constexpr bool PERM = true; static constexpr int MIDT = 0;
    struct Unit { int pm, pn, vt; };
    const unsigned char* ws; int G, c;
    __device__ __forceinline__ bool next(int i, Unit& u) const {
        const int L = i * G + c;
        if (L >= 884) return false;
        if (L < 748) { u.vt = 0; g8::dense_unit(L, 68, 11, u.pm, u.pn); }
        else { const int v = L - 748; u.vt = 1; u.pm = v / 68; u.pn = v % 68; }
        return true;
    }
    __device__ __forceinline__ const char* baseA(const Unit& u) const { return (const char*)(ws + (u.vt ? O_WIN : O_XN)); }
    __device__ __forceinline__ const char* baseB(const Unit& u) const { return (const char*)(ws + (u.vt ? O_XN : O_WIN)); }
    __device__ __forceinline__ void offs(const Unit& u, int tid_, unsigned (&oa)[2][2], unsigned (&ob)[2][2]) const {
        int R[2], C[2];
        { int tq = tid_; asm volatile("" : "+v"(tq)); g8::stage_rc(tq * 16, R[0], C[0]); g8::stage_rc(tq * 16 + 8192, R[1], C[1]); }
#pragma unroll
        for (int h = 0; h < 2; ++h)
#pragma unroll
            for (int i = 0; i < 2; ++i) {
                const int Rb = (R[i] & ~31) + g8::perm32(R[i] & 31);
                if (!u.vt) {
                    int ar = u.pm * 256 + h * 128 + R[i];
                    if (u.pn == 6 || u.pn == 7) ar = colmajor_src_row(ar);
                    oa[h][i] = (unsigned)(ar * 1024 + C[i]) * 2u;
                    ob[h][i] = (unsigned)((u.pn * 256 + h * 128 + Rb) * 1024 + C[i]) * 2u;
                } else {
                    oa[h][i] = (unsigned)((2816 + u.pm * 256 + h * 128 + R[i]) * 1024 + C[i]) * 2u;
                    ob[h][i] = (unsigned)(colmajor_src_row(u.pn * 256 + h * 128 + Rb) * 1024 + C[i]) * 2u;
                }
            }
    }
    __device__ __forceinline__ void mid(g8::Acc&, const Unit&, int, int) const {}
    __device__ __forceinline__ int nt(const Unit&) const { return 16; }
    __device__ __forceinline__ bool brk(const Unit&, const Unit&) const { return false; }
    __device__ __forceinline__ void a_ready(const Unit&) const {}
    __device__ __forceinline__ void done(const Unit&) const {}
    __device__ __forceinline__ void epi(g8::Acc& acc, const Unit& u, int wr, int wc, int fr, int fq) const {
        unsigned char* w = (unsigned char*)ws;
        const int row0 = u.pm * 256 + wr * 64 + fr;
        const int col0 = wc * 32 + 8 * fq;
        if (u.vt) {
            const int tok0 = u.pn * 256 + col0;
#pragma unroll
            for (int ai = 0; ai < 2; ++ai)
#pragma unroll
                for (int m = 0; m < 4; ++m) {
                    const int ch = row0 + ai * 128 + m * 16;
#pragma unroll
                    for (int bj = 0; bj < 2; ++bj) {
                        const int tk = tok0 + bj * 128;
                        u16* d;
                        int ctile, lw;
                        if (tk < MLAT) { ctile = (tk >> 12) * NCH + 2 + ((tk & 4095) >> 7); lw = tk & 127; }
                        else { const int tc = tk - MLAT; ctile = (tc >> 8) * NCH + ((tc & 255) >> 7); lw = tc & 127; }
                        d = (u16*)(w + O_VT) + ((size_t)ctile * 512 + ch) * 128 + lw;
                        const f32x4 v0 = acc[ai][bj][m][0], v1 = acc[ai][bj][m][1];
                        u32x4 o; o.x = g8::cvt_pk_bf16(v0[0], v0[1]); o.y = g8::cvt_pk_bf16(v0[2], v0[3]); o.z = g8::cvt_pk_bf16(v1[0], v1[1]); o.w = g8::cvt_pk_bf16(v1[2], v1[3]);
                        *(u32x4*)d = o;
                    }
                }
            return;
        }
        if (u.pn == 10) {
            if (wc == 0) {
                float* dst = (float*)(w + (fq < 2 ? O_PSD : O_PSG)) + (fq & 1) * 8;
#pragma unroll
                for (int ai = 0; ai < 2; ++ai)
#pragma unroll
                    for (int m = 0; m < 4; ++m) {
                        float* d = dst + (size_t)(row0 + ai * 128 + m * 16) * 16;
                        *(f32x4*)d = acc[ai][0][m][0];
                        *(f32x4*)(d + 4) = acc[ai][0][m][1];
                    }
            }
            return;
        }
        u16* base; size_t ld, bjstep;
        if (u.pn < 2) { base = (u16*)(w + O_ZO) + u.pn * 256 + col0; ld = 1024; bjstep = 128; }
        else if (u.pn < 8) {
            const int cg0 = (u.pn - 2) * 4 + (col0 >> 6);
            base = (u16*)(w + O_PT) + (size_t)cg0 * MALL * 64 + (col0 & 63); ld = 64; bjstep = (size_t)2 * MALL * 64;
        }
        else { base = (u16*)(w + O_ZO) + 512 + (u.pn - 8) * 256 + col0; ld = 1024; bjstep = 128; }
#pragma unroll
        for (int ai = 0; ai < 2; ++ai)
#pragma unroll
            for (int m = 0; m < 4; ++m) {
                u16* rowp = base + (size_t)(row0 + ai * 128 + m * 16) * ld;
#pragma unroll
                for (int bj = 0; bj < 2; ++bj) {
                    const f32x4 v0 = acc[ai][bj][m][0], v1 = acc[ai][bj][m][1];
                    u32x4 o; o.x = g8::cvt_pk_bf16(v0[0], v0[1]); o.y = g8::cvt_pk_bf16(v0[2], v0[3]); o.z = g8::cvt_pk_bf16(v1[0], v1[1]); o.w = g8::cvt_pk_bf16(v1[2], v1[3]);
                    *(u32x4*)(rowp + bj * bjstep) = o;
                }
            }
    }
};

__device__ void phase3(const Params& P, char* lds_all) {
    unsigned char* ws = P.ws;
    const int vb = threadIdx.x >> 8, t = threadIdx.x & 255;
    char* lds = lds_all + vb * VLDS;
    u16* raw = (u16*)lds;
    float* xcl = (float*)(lds + 132 * 128);
    const u16* pt = (const u16*)(ws + O_PT);
    const int NCONV = 136 * 24;
    for (int ct = blockIdx.x * 2 + vb; ct < 136; ct += gridDim.x * 2) {
        const int b = ct / NCH, cc = ct % NCH;
        const int rb = cc < 2 ? MLAT + b * 256 + cc * 128 : b * 4096 + (cc - 2) * 128;
        const int row = rb + (t >> 1), half = t & 1;
        const float* psd = (const float*)(ws + O_PSD) + (size_t)row * 16 + half * 8;
        float* dt = (float*)(ws + O_DT) + (size_t)row * 16 + half * 8;
        const float4 pa = *(const float4*)psd, pb = *(const float4*)(psd + 4);
        const float* psg = (const float*)(ws + O_PSG) + (size_t)colmajor_src_row(row) * 16 + half * 8;
        const float4 ga = *(const float4*)psg, gb = *(const float4*)(psg + 4);
        const float pv[8] = {pa.x, pa.y, pa.z, pa.w, pb.x, pb.y, pb.z, pb.w}, gv[8] = {ga.x, ga.y, ga.z, ga.w, gb.x, gb.y, gb.z, gb.w};
#pragma unroll
        for (int j = 0; j < 8; ++j) dt[j] = softplusf(pv[j] + P.in[I_DTB][half * 8 + j]);
        if (half == 0) {
            float* gi = (float*)(ws + O_GI) + (size_t)row * 8;
#pragma unroll
            for (int j = 0; j < 8; ++j) gi[j] = gv[j] + P.in[I_GB][j];
        } else {
            float* gf = (float*)(ws + O_GF) + (size_t)row * 8;
#pragma unroll
            for (int j = 0; j < 8; ++j) { const float xx = gv[j] + P.in[I_GB][8 + j]; gf[j] = fminf(xx, 0.f) - log1pf(__expf(-fabsf(xx))); }
        }
    }
    u32x4 rr[5];
#define P3_PREFETCH(uu) do { \
        const int _u = (uu), _ct = _u / 24, _cg = _u % 24, _b = _ct / NCH, _cc = _ct % NCH; const bool _ctx = _cc < 2; \
        const int _L = _ctx ? 256 : 4096, _lpos = _ctx ? _cc * 128 : (_cc - 2) * 128, _rb = _ctx ? MLAT + _b * 256 + _cc * 128 : _b * 4096 + (_cc - 2) * 128, _sb = _rb - _lpos; \
        _Pragma("unroll") for (int _i = 0; _i < 5; ++_i) { const int _q = t + 256 * _i, _r = (_q >> 3) < 132 ? (_q >> 3) : 131, _c = _q & 7; \
            const int _l = _lpos - 2 + _r, _lc = _l < 0 ? 0 : (_l >= _L ? _L - 1 : _l); \
            u32x4 _v = *(const u32x4*)(pt + ((size_t)_cg * MALL + _sb + _lc) * 64 + _c * 8); \
            if (_l != _lc) _v = (u32x4){0u, 0u, 0u, 0u}; \
            rr[_i] = _v; } \
    } while (0)
    if ((int)(blockIdx.x * 2 + vb) < NCONV) P3_PREFETCH(blockIdx.x * 2 + vb);
    for (int u = blockIdx.x * 2 + vb; u < NCONV; u += gridDim.x * 2) {
        const int ct = u / 24, cgp = u % 24;
        const int b = ct / NCH, cc = ct % NCH;
        const bool isctx = cc < 2;
        const int rb = isctx ? MLAT + b * 256 + cc * 128 : b * 4096 + (cc - 2) * 128;
        const bool isml = cgp >= 16;
#pragma unroll
        for (int i = 0; i < 5; ++i) { const int q = t + 256 * i; if (q < 132 * 8) *(u32x4*)(raw + (q >> 3) * 64 + (q & 7) * 8) = rr[i]; }
        __syncthreads();
        if (u + (int)gridDim.x * 2 < NCONV) P3_PREFETCH(u + gridDim.x * 2);
        const int ch = t & 63, tg = t >> 6;
        const float* cw = isml ? P.in[I_MCW] + (cgp - 16) * 64 + ch : P.in[I_SCW] + cgp * 64 + ch;
        const int cwld = isml ? 512 : 1024;
        const float w0 = cw[0], w1 = cw[cwld], w2 = cw[2 * cwld], w3 = cw[3 * cwld], w4 = cw[4 * cwld];
        const float bias = isml ? P.in[I_MCB][(cgp - 16) * 64 + ch] : P.in[I_SCB][cgp * 64 + ch];
        const int tok0 = tg * 32;
        float x0 = bf2f(raw[(tok0 + 0) * 64 + ch]), x1 = bf2f(raw[(tok0 + 1) * 64 + ch]), x2 = bf2f(raw[(tok0 + 2) * 64 + ch]), x3 = bf2f(raw[(tok0 + 3) * 64 + ch]);
        if (!isml) {
            u16* tdst = nullptr; u16* ndst = nullptr;
            if (cgp < 8) {
                const int chg = cgp * 64 + ch;
                tdst = (u16*)(ws + O_XT) + ((size_t)ct * 512 + chg) * 128 + tok0;
            } else if (cgp < 12) {
                const int gn = (cgp - 8) * 64 + ch;
                tdst = (u16*)(ws + O_BT) + ((size_t)ct * 256 + gn) * 128 + tok0;
                ndst = (u16*)(ws + O_BM) + ((size_t)ct * 2 + (gn >> 7)) * 16384 + (size_t)tok0 * 128 + (gn & 127);
            } else {
                const int gn = (cgp - 12) * 64 + ch;
                ndst = (u16*)(ws + O_CM) + ((size_t)ct * 2 + (gn >> 7)) * 16384 + (size_t)tok0 * 128 + (gn & 127);
            }
#pragma unroll
            for (int o8 = 0; o8 < 4; ++o8) {
                float ov[8];
#pragma unroll
                for (int j = 0; j < 8; ++j) {
                    const int tok = tok0 + o8 * 8 + j;
                    const float x4 = bf2f(raw[(tok + 4) * 64 + ch]);
                    const float cv = bias + w0 * x0 + w1 * x1 + w2 * x2 + w3 * x3 + w4 * x4;
                    ov[j] = siluf(cv);
                    x0 = x1; x1 = x2; x2 = x3; x3 = x4;
                }
                if (tdst) { uint4 o; o.x = pack2(ov[0], ov[1]); o.y = pack2(ov[2], ov[3]); o.z = pack2(ov[4], ov[5]); o.w = pack2(ov[6], ov[7]); *(uint4*)(tdst + o8 * 8) = o; }
                if (ndst) {
#pragma unroll
                    for (int j = 0; j < 8; ++j) ndst[(size_t)(o8 * 8 + j) * 128] = f2bf(ov[j]);
                }
            }
            __syncthreads();
        } else {
            const int mg = cgp - 16;
            u16* xcd = (u16*)(ws + O_XC) + ((size_t)ct * 4 + (mg >> 1)) * 16384 + (size_t)tok0 * 128 + (mg & 1) * 64 + ch;
#pragma unroll 8
            for (int j = 0; j < 32; ++j) {
                const int tok = tok0 + j;
                const float x4 = bf2f(raw[(tok + 4) * 64 + ch]);
                const float cv = bias + w0 * x0 + w1 * x1 + w2 * x2 + w3 * x3 + w4 * x4;
                const float sv = siluf(cv);
                xcl[tok * 64 + ch] = sv;
                xcd[(size_t)j * 128] = f2bf(sv);
                x0 = x1; x1 = x2; x2 = x3; x3 = x4;
            }
            __syncthreads();
            const int n = ch >> 2, kk = ch & 3, ng = mg * 16 + n;
            const float* wq = P.in[I_WQK] + ((size_t)(0 * 128 + ng) * 4) * 4 + kk;
            const float* wk = P.in[I_WQK] + ((size_t)(1 * 128 + ng) * 4) * 4 + kk;
            const float q0 = wq[0], q1 = wq[4], q2 = wq[8], q3 = wq[12];
            const float k0 = wk[0], k1 = wk[4], k2 = wk[8], k3 = wk[12];
            const int chg = mg * 64 + ch;
            const size_t hoff = ((size_t)ct * 4 + (mg >> 1)) * 16384 + (size_t)tok0 * 128 + (mg & 1) * 64 + ch;
            u16* qd = (u16*)(ws + O_Q) + hoff;
            u16* kd = (u16*)(ws + O_K) + hoff;
            u16* ktd = (u16*)(ws + O_KT) + ((size_t)ct * 512 + chg) * 128 + tok0;
#pragma unroll
            for (int o8 = 0; o8 < 4; ++o8) {
                float kv[8];
#pragma unroll
                for (int j = 0; j < 8; ++j) {
                    const int tok = tok0 + o8 * 8 + j;
                    const float4 xv = *(const float4*)(xcl + tok * 64 + n * 4);
                    const float qv = xv.x * q0 + xv.y * q1 + xv.z * q2 + xv.w * q3;
                    kv[j] = (xv.x * k0 + xv.y * k1 + xv.z * k2 + xv.w * k3) * 0.08838834764831845f;
                    qd[(size_t)(o8 * 8 + j) * 128] = f2bf(qv);
                    kd[(size_t)(o8 * 8 + j) * 128] = f2bf(kv[j]);
                }
                uint4 o; o.x = pack2(kv[0], kv[1]); o.y = pack2(kv[2], kv[3]); o.z = pack2(kv[4], kv[5]); o.w = pack2(kv[6], kv[7]);
                *(uint4*)(ktd + o8 * 8) = o;
            }
            __syncthreads();
        }
    }
}

__device__ __forceinline__ u32x4 scale8(const u32x4 v, const float* ww) {
    u32x4 o;
    o.x = pack2(bflo(v.x) * ww[0], bfhi(v.x) * ww[1]); o.y = pack2(bflo(v.y) * ww[2], bfhi(v.y) * ww[3]);
    o.z = pack2(bflo(v.z) * ww[4], bfhi(v.z) * ww[5]); o.w = pack2(bflo(v.w) * ww[6], bfhi(v.w) * ww[7]);
    return o;
}
__device__ void phase4(const Params& P, char* lds) {
    unsigned char* ws = P.ws;
    char* T0 = lds; char* T1 = lds + 32768;
    float* sc = (float*)(lds + 65536);
    float* wA = sc + 256;
    float* wB = sc + 384;
    const int NSSD = 4 * NCH * 8, NML = 4 * NCH * 4, NU4 = NSSD + NML;
    u32x4 RA[4], RB[4];
    float ps0 = 0.f, ps1 = 0.f, ps2 = 0.f, ps3 = 0.f;
#define P4_PREFETCH(uu) do { \
        const int _u = (uu); const bool _ssd = _u < NSSD; const int _v = _ssd ? _u : _u - NSSD; \
        const int _h = _ssd ? (_v & 7) : (_v & 3), _ct = _ssd ? (_v >> 3) : (_v >> 2), _b = _ct / NCH, _cc = _ct % NCH; \
        const int _rb = _cc < 2 ? MLAT + _b * 256 + _cc * 128 : _b * 4096 + (_cc - 2) * 128; \
        const u16* _pa = _ssd ? (const u16*)(ws + O_XT) + ((size_t)_ct * 512 + _h * 64) * 128 : (const u16*)(ws + O_VT) + ((size_t)_ct * 512 + _h * 128) * 128; \
        const u16* _pb = _ssd ? (const u16*)(ws + O_BT) + ((size_t)_ct * 256 + (_h >> 2) * 128) * 128 : (const u16*)(ws + O_KT) + ((size_t)_ct * 512 + _h * 128) * 128; \
        _Pragma("unroll") for (int _i = 0; _i < 4; ++_i) { const int _q = (int)threadIdx.x + 512 * _i; const size_t _o = (size_t)(_q >> 4) * 128 + (_q & 15) * 8; \
            RA[_i] = *(const u32x4*)(_pa + _o); RB[_i] = *(const u32x4*)(_pb + _o); } \
        if (threadIdx.x < 128) { const int _dir = threadIdx.x >> 6, _ln = threadIdx.x & 63; const int _l0 = _dir ? 127 - 2 * _ln : 2 * _ln, _l1 = _dir ? 126 - 2 * _ln : 2 * _ln + 1; \
            if (_ssd) { const float* _dp = (const float*)(ws + O_DT) + (size_t)_rb * 16 + _dir * 8 + _h; ps0 = _dp[_l0 * 16]; ps1 = _dp[_l1 * 16]; } \
            else { const float* _gf = (const float*)(ws + O_GF) + (size_t)_rb * 8 + _dir * 4 + _h; const float* _gi = (const float*)(ws + O_GI) + (size_t)_rb * 8 + _dir * 4 + _h; \
                   ps0 = _gf[_l0 * 8]; ps1 = _gf[_l1 * 8]; ps2 = _gi[_l0 * 8]; ps3 = _gi[_l1 * 8]; } } \
    } while (0)
    if ((int)blockIdx.x < NU4) P4_PREFETCH(blockIdx.x);
    for (int u = blockIdx.x; u < NU4; u += gridDim.x) {
        int t = threadIdx.x; asm volatile("" : "+v"(t));
        const int lane = t & 63, w = t >> 6, wm = w >> 1, wn = w & 1, lr = lane & 15, lq = lane >> 4;
        const bool isssd = u < NSSD;
        const int v = isssd ? u : u - NSSD;
        const int h = isssd ? (v & 7) : (v & 3), ct = isssd ? (v >> 3) : (v >> 2), b = ct / NCH, cc = ct % NCH;
        const int un = u + (int)gridDim.x;
        if (isssd) {
            if (w < 2) {
                const int dir = w;
                const int l0 = dir ? 127 - 2 * lane : 2 * lane, l1 = dir ? 126 - 2 * lane : 2 * lane + 1;
                const float d0 = ps0, d1 = ps1;
                const float an = -__expf(P.in[I_ALOG][dir * 8 + h]);
                const float p0 = d0 * an, p1 = p0 + d1 * an;
                const float inc = wave_scan_sum(p1, lane);
                const float ex = inc - p1;
                const float tot = __shfl(inc, 63);
                float* wd = dir ? wB : wA;
                wd[l0] = __expf(tot - (ex + p0)) * d0; wd[l1] = __expf(tot - (ex + p1)) * d1;
                if (lane == 0) ((float*)(ws + O_ACH))[((size_t)(b * NCH + cc) * 8 + h) * 2 + dir] = tot;
            }
            __syncthreads();
#pragma unroll
            for (int i = 0; i < 2; ++i) {
                const int q = t + 512 * i, r = q >> 4, c = q & 15;
                *(u32x4*)(T0 + swz256(r, c)) = scale8(RA[i], wA + c * 8); *(u32x4*)(T0 + swz256(64 + r, c)) = scale8(RA[i], wB + c * 8);
            }
#pragma unroll
            for (int i = 0; i < 4; ++i) { const int q = t + 512 * i, r = q >> 4, c = q & 15; *(u32x4*)(T1 + swz256(r, c)) = RB[i]; }
            __syncthreads();
            if (un < NU4) P4_PREFETCH(un);
            f32x4 acc[2][4]; zero_acc(acc);
            lds_mma_t<2, 4>(T0, T1, wm * 32, wn * 64, acc, lane);
            u16* st = (u16*)(ws + O_ST) + (((size_t)(b * NCH + cc) * 8 + h) * 2 + (wm >> 1)) * 8192 + ((wm & 1) * 32 + lr) * 128 + wn * 64 + lq * 4;
#pragma unroll
            for (int i = 0; i < 2; ++i)
#pragma unroll
                for (int j = 0; j < 4; ++j) {
                    uint2 o; o.x = pack2(acc[i][j][0], acc[i][j][1]); o.y = pack2(acc[i][j][2], acc[i][j][3]);
                    *(uint2*)(st + (i * 16) * 128 + j * 16) = o;
                }
            __syncthreads();
        } else {
            if (w < 2) {
                const int dir = w;
                const int s0 = dir ? 127 - 2 * lane : 2 * lane, s1 = dir ? 126 - 2 * lane : 2 * lane + 1;
                const float f0 = ps0, f1 = ps1, i0 = ps2, i1 = ps3;
                const float p1 = f0 + f1;
                const float inc = wave_scan_sum(p1, lane);
                const float ex = inc - p1;
                const float tot = __shfl(inc, 63);
                const float av0 = tot - (ex + f0) + i0, av1 = tot - (ex + p1) + i1;
                const float mloc = wave_max(fmaxf(av0, av1));
                float* wd = dir ? wB : wA;
                wd[s0] = __expf(av0 - mloc); wd[s1] = __expf(av1 - mloc);
                if (lane == 0) {
                    float* mls = (float*)(ws + O_MLS) + (((size_t)(b * NCH + cc) * 4 + h) * 2 + dir) * 2;
                    mls[0] = mloc; mls[1] = tot;
                }
            }
            __syncthreads();
#pragma unroll
            for (int d2 = 0; d2 < 2; ++d2) {
                const float* wsel = d2 ? wB : wA;
#pragma unroll
                for (int i = 0; i < 4; ++i) { const int q = t + 512 * i, r = q >> 4, c = q & 15; *(u32x4*)(T0 + swz256(r, c)) = scale8(RA[i], wsel + c * 8); }
                if (d2 == 0) {
#pragma unroll
                    for (int i = 0; i < 4; ++i) { const int q = t + 512 * i, r = q >> 4, c = q & 15; *(u32x4*)(T1 + swz256(r, c)) = RB[i]; }
                }
                __syncthreads();
                if (d2 == 1 && un < NU4) P4_PREFETCH(un);
                f32x4 acc[2][4]; zero_acc(acc);
                lds_mma_t<2, 4>(T0, T1, wm * 32, wn * 64, acc, lane);
                u16* cst = (u16*)(ws + (d2 ? O_MLC1 : O_MLC0)) + ((size_t)(b * NCH + cc) * 4 + h) * 16384 + (wm * 32 + lr) * 128 + wn * 64 + lq * 4;
#pragma unroll
                for (int i = 0; i < 2; ++i)
#pragma unroll
                    for (int j = 0; j < 4; ++j) {
                        uint2 o; o.x = pack2(acc[i][j][0], acc[i][j][1]); o.y = pack2(acc[i][j][2], acc[i][j][3]);
                        *(uint2*)(cst + (i * 16) * 128 + j * 16) = o;
                    }
                if (d2 == 0 && t < 256) {
                    const int dir = t >> 7, idx = t & 127;
                    const float* wgt = dir ? wB : wA;
                    float nacc = 0.f;
#pragma unroll 4
                    for (int c = 0; c < 16; ++c) {
                        const uint4 kv = *(const uint4*)(T1 + swz256(idx, c));
                        const float* ww = wgt + c * 8;
                        nacc += bflo(kv.x) * ww[0] + bfhi(kv.x) * ww[1] + bflo(kv.y) * ww[2] + bfhi(kv.y) * ww[3]
                              + bflo(kv.z) * ww[4] + bfhi(kv.z) * ww[5] + bflo(kv.w) * ww[6] + bfhi(kv.w) * ww[7];
                    }
                    ((float*)(ws + O_MLN))[(((size_t)(b * NCH + cc) * 4 + h) * 2 + dir) * 128 + idx] = nacc;
                }
                __syncthreads();
            }
        }
    }
}

__device__ __forceinline__ int scan_cc(int dir, int step) { return dir == 0 ? step : (step < 2 ? 1 - step : 35 - step); }
__device__ void phase5(const Params& P) {
    unsigned char* ws = P.ws;
    const int vb = threadIdx.x >> 8, t = threadIdx.x & 255;
    for (int u = blockIdx.x * 2 + vb; u < 256 + 256 + 32; u += gridDim.x * 2) {
        if (u < 256) {
            const int chain = u >> 2, part = u & 3;
            const int b = chain >> 4, h = (chain >> 1) & 7, dir = chain & 1;
            const int off = part * 2048 + t * 8;
            float S[8];
#pragma unroll
            for (int j = 0; j < 8; ++j) S[j] = 0.f;
#pragma unroll 2
            for (int step = 0; step < NCH; ++step) {
                const int cc = scan_cc(dir, step);
                u16* p = (u16*)(ws + O_ST) + (((size_t)(b * NCH + cc) * 8 + h) * 2 + dir) * 8192 + off;
                const uint4 lv = *(const uint4*)p;
                const float dec = __expf(((const float*)(ws + O_ACH))[((size_t)(b * NCH + cc) * 8 + h) * 2 + dir]);
                uint4 o; o.x = pack2(S[0], S[1]); o.y = pack2(S[2], S[3]); o.z = pack2(S[4], S[5]); o.w = pack2(S[6], S[7]);
                *(uint4*)p = o;
                S[0] = dec * S[0] + bflo(lv.x); S[1] = dec * S[1] + bfhi(lv.x); S[2] = dec * S[2] + bflo(lv.y); S[3] = dec * S[3] + bfhi(lv.y);
                S[4] = dec * S[4] + bflo(lv.z); S[5] = dec * S[5] + bfhi(lv.z); S[6] = dec * S[6] + bflo(lv.w); S[7] = dec * S[7] + bfhi(lv.w);
            }
        } else if (u < 512) {
            const int v = u - 256;
            const int chain = v >> 3, part = v & 7;
            const int b = chain >> 3, h = (chain >> 1) & 3, dir = chain & 1;
            const int off = part * 2048 + t * 8;
            float S[8];
#pragma unroll
            for (int j = 0; j < 8; ++j) S[j] = 0.f;
            float m = -1e30f;
#pragma unroll 2
            for (int step = 0; step < NCH; ++step) {
                const int cc = scan_cc(dir, step);
                u16* p = (u16*)(ws + (dir ? O_MLC1 : O_MLC0)) + ((size_t)(b * NCH + cc) * 4 + h) * 16384 + off;
                const uint4 lv = *(const uint4*)p;
                const float* mls = (const float*)(ws + O_MLS) + (((size_t)(b * NCH + cc) * 4 + h) * 2 + dir) * 2;
                const float ml = mls[0], bl = mls[1];
                const float mn = fmaxf(bl + m, ml);
                const float sp = __expf(bl + m - mn), sl = __expf(ml - mn);
                if (part == 0 && t == 0) ((float*)(ws + O_MLP))[((size_t)(b * NCH + cc) * 4 + h) * 2 + dir] = m;
                uint4 o; o.x = pack2(S[0], S[1]); o.y = pack2(S[2], S[3]); o.z = pack2(S[4], S[5]); o.w = pack2(S[6], S[7]);
                *(uint4*)p = o;
                S[0] = sp * S[0] + sl * bflo(lv.x); S[1] = sp * S[1] + sl * bfhi(lv.x); S[2] = sp * S[2] + sl * bflo(lv.y); S[3] = sp * S[3] + sl * bfhi(lv.y);
                S[4] = sp * S[4] + sl * bflo(lv.z); S[5] = sp * S[5] + sl * bfhi(lv.z); S[6] = sp * S[6] + sl * bflo(lv.w); S[7] = sp * S[7] + sl * bfhi(lv.w);
                m = mn;
            }
        } else {
            const int chain = u - 512;
            const int b = chain >> 3, h = (chain >> 1) & 3, dir = chain & 1;
            if (t < 128) {
                float nS = 0.f, m = -1e30f;
                for (int step = 0; step < NCH; ++step) {
                    const int cc = scan_cc(dir, step);
                    float* p = (float*)(ws + O_MLN) + (((size_t)(b * NCH + cc) * 4 + h) * 2 + dir) * 128 + t;
                    const float lv = *p;
                    const float* mls = (const float*)(ws + O_MLS) + (((size_t)(b * NCH + cc) * 4 + h) * 2 + dir) * 2;
                    const float ml = mls[0], bl = mls[1];
                    const float mn = fmaxf(bl + m, ml);
                    const float sp = __expf(bl + m - mn), sl = __expf(ml - mn);
                    *p = nS;
                    nS = sp * nS + sl * lv;
                    m = mn;
                }
            }
        }
    }
}

__device__ void phase6(const Params& P, char* lds) {
    unsigned char* ws = P.ws;
    char* T0 = lds; char* T1 = lds + 32768; char* T2 = lds + 65536; char* T3 = lds + 98304;
    float* sc = (float*)(lds + 131072);
    float* sbuf = sc;
    float* a0 = sc + 256;
    float* a1 = sc + 384;
    float* a2 = sc + 512;
    float* a3 = sc + 640;
    float* a4 = sc + 768;
    float* a5 = sc + 896;
    float* rsA = sc + 1024;
    float* qn = sc + 1536;
    float* fac = sc + 1792;
    float* wfac = sc + 2048;
    const int NSSD = 4 * 32 * 8, NML = 4 * 32 * 4, NU6 = NSSD + NML;
    u32x4 R0[4], R1[4], R2[4], R3[4];
    float ps0 = 0.f, ps1 = 0.f, ps2 = 0.f, ps3 = 0.f;
#define P6_PREFETCH(uu) do { \
        const int _u = (uu); const bool _ssd = _u < NSSD; const int _v = _ssd ? _u : _u - NSSD; \
        const int _h = _ssd ? (_v & 7) : (_v & 3), _ct = _ssd ? (_v >> 3) : (_v >> 2), _b = _ct >> 5, _c = _ct & 31, _cc = _c + 2; \
        const size_t _ctile = (size_t)(_b * NCH + _cc); const int _rb = _b * 4096 + _c * 128; \
        const u16 *_p0, *_p1, *_p2, *_p3; \
        if (_ssd) { const int _g = _h >> 2; _p0 = (const u16*)(ws + O_CM) + (_ctile * 2 + _g) * 16384; _p1 = (const u16*)(ws + O_BM) + (_ctile * 2 + _g) * 16384; \
                    _p2 = (const u16*)(ws + O_ST) + ((_ctile * 8 + _h) * 2) * 8192; _p3 = (const u16*)(ws + O_XT) + (_ctile * 512 + _h * 64) * 128; } \
        else { _p0 = (const u16*)(ws + O_Q) + (_ctile * 4 + _h) * 16384; _p1 = (const u16*)(ws + O_K) + (_ctile * 4 + _h) * 16384; \
               _p2 = (const u16*)(ws + O_MLC0) + (_ctile * 4 + _h) * 16384; _p3 = (const u16*)(ws + O_MLC1) + (_ctile * 4 + _h) * 16384; } \
        _Pragma("unroll") for (int _i = 0; _i < 4; ++_i) { const int _q = (int)threadIdx.x + 512 * _i; const size_t _o = (size_t)(_q >> 4) * 128 + (_q & 15) * 8; \
            R0[_i] = *(const u32x4*)(_p0 + _o); R1[_i] = *(const u32x4*)(_p1 + _o); R2[_i] = *(const u32x4*)(_p2 + _o); R3[_i] = *(const u32x4*)(_p3 + _o); } \
        if (threadIdx.x < 128) { const int _dir = threadIdx.x >> 6, _ln = threadIdx.x & 63; \
            const int _l0 = _dir ? 127 - 2 * _ln : 2 * _ln, _l1 = _dir ? 126 - 2 * _ln : 2 * _ln + 1; \
            if (_ssd) { const float* _dp = (const float*)(ws + O_DT) + (size_t)_rb * 16 + _dir * 8 + _h; ps0 = _dp[_l0 * 16]; ps1 = _dp[_l1 * 16]; } \
            else { const float* _gf = (const float*)(ws + O_GF) + (size_t)_rb * 8 + _dir * 4 + _h; const float* _gi = (const float*)(ws + O_GI) + (size_t)_rb * 8 + _dir * 4 + _h; \
                   ps0 = _gf[_l0 * 8]; ps1 = _gf[_l1 * 8]; ps2 = _gi[_l0 * 8]; ps3 = _gi[_l1 * 8]; } } \
    } while (0)
    if ((int)blockIdx.x < NU6) P6_PREFETCH(blockIdx.x);
    for (int u = blockIdx.x; u < NU6; u += gridDim.x) {
        int t = threadIdx.x; asm volatile("" : "+v"(t));
        const int lane = t & 63, w = t >> 6, wm = w >> 1, wn = w & 1;
        const bool isssd = u < NSSD;
        const int v = isssd ? u : u - NSSD;
        const int h = isssd ? (v & 7) : (v & 3), ct = isssd ? (v >> 3) : (v >> 2), b = ct >> 5, c = ct & 31, cc = c + 2;
        const int rb = b * 4096 + c * 128, lpos = c * 128;
        const float mp0 = isssd ? 0.f : ((const float*)(ws + O_MLP))[((size_t)(b * NCH + cc) * 4 + h) * 2 + 0];
        const float mp1 = isssd ? 0.f : ((const float*)(ws + O_MLP))[((size_t)(b * NCH + cc) * 4 + h) * 2 + 1];
        if (w < 2) {
            const int dir = w;
            const int l0 = dir ? 127 - 2 * lane : 2 * lane, l1 = dir ? 126 - 2 * lane : 2 * lane + 1;
            if (isssd) {
                const float d0 = ps0, d1 = ps1;
                const float an = -__expf(P.in[I_ALOG][dir * 8 + h]);
                const float p0 = d0 * an, p1 = p0 + d1 * an;
                const float inc = wave_scan_sum(p1, lane);
                const float ex = inc - p1;
                float* ca = dir ? a1 : a0; float* da = dir ? a3 : a2;
                ca[l0] = ex + p0; ca[l1] = ex + p1; da[l0] = d0; da[l1] = d1;
            } else {
                const float f0 = ps0, f1 = ps1, i0 = ps2, i1 = ps3;
                const float p1 = f0 + f1;
                const float inc = wave_scan_sum(p1, lane);
                const float ex = inc - p1;
                const float bc0 = ex + f0, bc1 = ex + p1;
                const float u0 = i0 - bc0, u1 = i1 - bc1;
                const float q1 = fmaxf(u0, u1);
                const float incm = wave_scan_max(q1, lane);
                float exm = __shfl_up(incm, 1); if (lane == 0) exm = -INFINITY;
                const float mp = dir ? mp1 : mp0;
                float* ab = dir ? a1 : a0; float* au = dir ? a3 : a2; float* am = dir ? a5 : a4;
                ab[l0] = bc0; ab[l1] = bc1; au[l0] = u0; au[l1] = u1;
                am[l0] = fmaxf(mp, fmaxf(exm, u0)); am[l1] = fmaxf(mp, fmaxf(exm, q1));
            }
        }
#pragma unroll
        for (int i = 0; i < 4; ++i) {
            const int q = t + 512 * i, r = q >> 4, cq = q & 15;
            *(u32x4*)(T0 + swz256(r, cq)) = R0[i];
            *(u32x4*)(T1 + swz256(r, cq)) = R1[i];
            *(u32x4*)(T2 + swz256(r, cq)) = R2[i];
            if (!isssd || i < 2) *(u32x4*)(T3 + swz256(r, cq)) = R3[i];
        }
        __syncthreads();
        if (u + (int)gridDim.x < NU6) P6_PREFETCH(u + gridDim.x);
        if (isssd) {
            const int g = h >> 2; (void)g;
            const int lr = lane & 15, lq = lane >> 4;
            f32x4 Y[2][2];
            {
                f32x4 aF[2][2], aB[2][2]; zero_acc(aF); zero_acc(aB);
                lds_mma_t<2, 2>(T0, T2, wm * 32, wn * 32, aF, lane);
                lds_mma_t<2, 2>(T0, T2, wm * 32, 64 + wn * 32, aB, lane);
#pragma unroll
                for (int i = 0; i < 2; ++i) {
                    const int l = wm * 32 + i * 16 + lr;
                    const float e0 = __expf(a0[l]), e1 = __expf(a1[l]);
#pragma unroll
                    for (int j = 0; j < 2; ++j) Y[i][j] = e0 * aF[i][j] + e1 * aB[i][j];
                }
            }
            f32x4 G[2][4]; zero_acc(G);
            lds_mma_t<2, 4>(T0, T1, wm * 32, wn * 64, G, lane);
            __syncthreads();
            {
                const float Dh = P.in[I_SSDD][h];
                int dbase = wn * 64 + lq * 4 - wm * 32 - lr; asm volatile("" : "+v"(dbase));
#pragma unroll
                for (int j = 0; j < 4; ++j) {
                    const int s0 = wn * 64 + j * 16 + lq * 4;
                    const float4 c0s = *(const float4*)(a0 + s0), r1s = *(const float4*)(a1 + s0), d0s = *(const float4*)(a2 + s0), d1s = *(const float4*)(a3 + s0);
                    const float c0v[4] = {c0s.x, c0s.y, c0s.z, c0s.w}, r1v[4] = {r1s.x, r1s.y, r1s.z, r1s.w};
                    const float d0v[4] = {d0s.x, d0s.y, d0s.z, d0s.w}, d1v[4] = {d1s.x, d1s.y, d1s.z, d1s.w};
#pragma unroll
                    for (int i = 0; i < 2; ++i) {
                        const int l = wm * 32 + i * 16 + lr;
                        const float c0l = a0[l], r1l = a1[l];
                        float mv[4];
#pragma unroll
                        for (int r = 0; r < 4; ++r) {
                            const int diff = dbase + (j * 16 - i * 16 + r);
                            const float e0 = (diff <= 0) ? (c0l - c0v[r]) : -INFINITY;
                            const float e1 = (diff >= 0) ? (r1l - r1v[r]) : -INFINITY;
                            mv[r] = G[i][j][r] * (__expf(e0) * d0v[r] + __expf(e1) * d1v[r]) + (diff == 0 ? Dh : 0.f);
                        }
                        uint2 o; o.x = pack2(mv[0], mv[1]); o.y = pack2(mv[2], mv[3]);
                        *(uint2*)(T1 + swz256(l, s0 >> 3) + (s0 & 7) * 2) = o;
                    }
                }
            }
            __syncthreads();
            lds_mma_t<2, 2>(T1, T3, wm * 32, wn * 32, Y, lane);
            u16* zo = (u16*)(ws + O_ZO);
#pragma unroll
            for (int i = 0; i < 2; ++i) {
                const int l = wm * 32 + i * 16 + lr;
                float ssq = 0.f;
#pragma unroll
                for (int j = 0; j < 2; ++j) {
                    const int p = wn * 32 + j * 16 + lq * 4;
                    u16* zp = zo + (size_t)(rb + l) * 1024 + h * 64 + p;
                    const uint2 zv = *(const uint2*)zp;
                    const float y0 = Y[i][j][0] * siluf(bflo(zv.x)), y1 = Y[i][j][1] * siluf(bfhi(zv.x));
                    const float y2 = Y[i][j][2] * siluf(bflo(zv.y)), y3 = Y[i][j][3] * siluf(bfhi(zv.y));
                    uint2 o; o.x = pack2(y0, y1); o.y = pack2(y2, y3);
                    *(uint2*)zp = o;
                    ssq += y0 * y0 + y1 * y1 + y2 * y2 + y3 * y3;
                }
                ssq += __shfl_xor(ssq, 16); ssq += __shfl_xor(ssq, 32);
                if (lq == 0) ((float*)(ws + O_SSQ))[(size_t)(rb + l) * 16 + h * 2 + wn] = ssq;
            }
            __syncthreads();
        } else {
            const int lr = lane & 15, lq = lane >> 4;
            f32x4 S[2][4]; zero_acc(S);
            lds_mma_t<2, 4>(T0, T1, wm * 32, wn * 64, S, lane);
            if (t < 256) {
                const int dir = t >> 7, idx = t & 127;
                const float* np = (const float*)(ws + O_MLN) + (((size_t)(b * NCH + cc) * 4 + h) * 2 + dir) * 128;
                float acc = 0.f;
#pragma unroll 4
                for (int cch = 0; cch < 16; ++cch) {
                    const uint4 qv = *(const uint4*)(T0 + swz256(idx, cch));
                    const float4 n0 = *(const float4*)(np + cch * 8), n1 = *(const float4*)(np + cch * 8 + 4);
                    acc += bflo(qv.x) * n0.x + bfhi(qv.x) * n0.y + bflo(qv.y) * n0.z + bfhi(qv.y) * n0.w
                         + bflo(qv.z) * n1.x + bfhi(qv.z) * n1.y + bflo(qv.w) * n1.z + bfhi(qv.w) * n1.w;
                }
                qn[dir * 128 + idx] = acc;
            }
            int dbase = wn * 64 + lq * 4 - wm * 32 - lr; asm volatile("" : "+v"(dbase));
            {
                float r0[2] = {0.f, 0.f}, r1[2] = {0.f, 0.f};
#pragma unroll
                for (int j = 0; j < 4; ++j) {
                    const int s0 = wn * 64 + j * 16 + lq * 4;
                    const float4 u0s = *(const float4*)(a2 + s0), u1s = *(const float4*)(a3 + s0);
                    const float u0v[4] = {u0s.x, u0s.y, u0s.z, u0s.w}, u1v[4] = {u1s.x, u1s.y, u1s.z, u1s.w};
#pragma unroll
                    for (int i = 0; i < 2; ++i) {
                        const int tt = wm * 32 + i * 16 + lr;
                        const float m0 = a4[tt], m1 = a5[tt];
#pragma unroll
                        for (int r = 0; r < 4; ++r) {
                            const int diff = dbase + (j * 16 - i * 16 + r);
                            r0[i] += S[i][j][r] * __expf((diff <= 0) ? (u0v[r] - m0) : -INFINITY);
                            r1[i] += S[i][j][r] * __expf((diff >= 0) ? (u1v[r] - m1) : -INFINITY);
                        }
                    }
                }
#pragma unroll
                for (int i = 0; i < 2; ++i) {
                    const int tt = wm * 32 + i * 16 + lr;
                    float x0 = r0[i], x1 = r1[i];
                    x0 += __shfl_xor(x0, 16); x0 += __shfl_xor(x0, 32);
                    x1 += __shfl_xor(x1, 16); x1 += __shfl_xor(x1, 32);
                    if (lq == 0) { rsA[(0 * 2 + wn) * 128 + tt] = x0; rsA[(1 * 2 + wn) * 128 + tt] = x1; }
                }
            }
            __syncthreads();
            if (t < 256) {
                const int dir = t >> 7, tt = t & 127;
                const float rs = rsA[(dir * 2 + 0) * 128 + tt] + rsA[(dir * 2 + 1) * 128 + tt];
                const float mm = dir ? a5[tt] : a4[tt];
                const float wi = __expf((dir ? mp1 : mp0) - mm);
                const float den = rs + wi * qn[dir * 128 + tt];
                const float mout = (dir ? a1[tt] : a0[tt]) + mm;
                const float dn = fmaxf(fabsf(den), __expf(-mout));
                fac[dir * 128 + tt] = 1.f / dn;
                wfac[dir * 128 + tt] = wi / dn;
            }
            __syncthreads();
            f32x4 H[2][4];
            {
                f32x4 A0[2][4]; zero_acc(A0);
                lds_mma_t<2, 4>(T0, T2, wm * 32, wn * 64, A0, lane);
#pragma unroll
                for (int i = 0; i < 2; ++i) {
                    const float f = wfac[wm * 32 + i * 16 + lr];
#pragma unroll
                    for (int j = 0; j < 4; ++j) H[i][j] = f * A0[i][j];
                }
            }
            {
                f32x4 A1[2][4]; zero_acc(A1);
                lds_mma_t<2, 4>(T0, T3, wm * 32, wn * 64, A1, lane);
#pragma unroll
                for (int i = 0; i < 2; ++i) {
                    const float f = wfac[128 + wm * 32 + i * 16 + lr];
#pragma unroll
                    for (int j = 0; j < 4; ++j) H[i][j] += f * A1[i][j];
                }
            }
            __syncthreads();
            asm volatile("" : "+v"(dbase));
#pragma unroll
            for (int j = 0; j < 4; ++j) {
                const int s0 = wn * 64 + j * 16 + lq * 4;
                const float4 u0s = *(const float4*)(a2 + s0), u1s = *(const float4*)(a3 + s0);
                const float u0v[4] = {u0s.x, u0s.y, u0s.z, u0s.w}, u1v[4] = {u1s.x, u1s.y, u1s.z, u1s.w};
#pragma unroll
                for (int i = 0; i < 2; ++i) {
                    const int tt = wm * 32 + i * 16 + lr;
                    const float m0 = a4[tt], m1 = a5[tt], f0 = fac[tt], f1 = fac[128 + tt];
                    float pv[4];
#pragma unroll
                    for (int r = 0; r < 4; ++r) {
                        const int diff = dbase + (j * 16 - i * 16 + r);
                        pv[r] = S[i][j][r] * (__expf((diff <= 0) ? (u0v[r] - m0) : -INFINITY) * f0 + __expf((diff >= 0) ? (u1v[r] - m1) : -INFINITY) * f1);
                    }
                    uint2 o; o.x = pack2(pv[0], pv[1]); o.y = pack2(pv[2], pv[3]);
                    *(uint2*)(T1 + swz256(tt, s0 >> 3) + (s0 & 7) * 2) = o;
                }
            }
            load_tile128(T2, 0, (const u16*)(ws + O_VT) + ((size_t)(b * NCH + cc) * 512 + h * 128) * 128, 128, 128, t, 512);
            __syncthreads();
            lds_mma_t<2, 4>(T1, T2, wm * 32, wn * 64, H, lane);
            u16* zo = (u16*)(ws + O_ZO);
            size_t rown[2];
#pragma unroll
            for (int i = 0; i < 2; ++i) {
                const int tt = wm * 32 + i * 16 + lr;
                const int lp = lpos + tt;
                rown[i] = (size_t)b * 4096 + ((lp & 63) << 6) + (lp >> 6);
                float ssq = 0.f;
#pragma unroll
                for (int j = 0; j < 4; ++j) {
                    const int d = wn * 64 + j * 16 + lq * 4;
                    const uint2 ov = *(const uint2*)(zo + rown[i] * 1024 + 512 + h * 128 + d);
                    H[i][j][0] *= sigmf(bflo(ov.x)); H[i][j][1] *= sigmf(bfhi(ov.x)); H[i][j][2] *= sigmf(bflo(ov.y)); H[i][j][3] *= sigmf(bfhi(ov.y));
                    ssq += H[i][j][0] * H[i][j][0] + H[i][j][1] * H[i][j][1] + H[i][j][2] * H[i][j][2] + H[i][j][3] * H[i][j][3];
                }
                ssq += __shfl_xor(ssq, 16); ssq += __shfl_xor(ssq, 32);
                if (lq == 0) rsA[wn * 128 + tt] = ssq;
            }
            __syncthreads();
            const u16* xc = (const u16*)(ws + O_XC);
#pragma unroll
            for (int j = 0; j < 4; ++j) {
                const int d = wn * 64 + j * 16 + lq * 4, chg = h * 128 + d;
                const float4 nw4 = *(const float4*)(P.in[I_MNW] + chg), sk4 = *(const float4*)(P.in[I_MSKIP] + chg);
#pragma unroll
                for (int i = 0; i < 2; ++i) {
                    const int tt = wm * 32 + i * 16 + lr;
                    const float rn = rsqrtf((rsA[tt] + rsA[128 + tt]) * (1.f / 128.f) + 1e-6f);
                    const uint2 xv = *(const uint2*)(xc + ((size_t)(b * NCH + cc) * 4 + h) * 16384 + (size_t)tt * 128 + d);
                    const float y0 = H[i][j][0] * rn * nw4.x + sk4.x * bflo(xv.x), y1 = H[i][j][1] * rn * nw4.y + sk4.y * bfhi(xv.x);
                    const float y2 = H[i][j][2] * rn * nw4.z + sk4.z * bflo(xv.y), y3 = H[i][j][3] * rn * nw4.w + sk4.w * bfhi(xv.y);
                    uint2 o; o.x = pack2(y0, y1); o.y = pack2(y2, y3);
                    *(uint2*)(zo + rown[i] * 1024 + 512 + chg) = o;
                }
            }
            __syncthreads();
        }
    }
}

struct OutProj {
    static constexpr int K = 1024; static constexpr bool PERM = false; static constexpr int MIDT = 8;
    struct Unit { int pm, pn, slot; };
    const Params* P; const float* rs; int G, c;
    __device__ __forceinline__ bool next(int i, Unit& u) const {
        const int L = i * G + c;
        if (L >= 256) return false;
        g8::dense_unit(L, 64, 4, u.pm, u.pn); u.slot = i & 3;
        return true;
    }
    __device__ __forceinline__ const char* baseA(const Unit&) const { return (const char*)(P->ws + O_ZO); }
    __device__ __forceinline__ const char* baseB(const Unit&) const { return (const char*)(P->ws + O_WOUT); }
    __device__ __forceinline__ void offs(const Unit& u, int tid_, unsigned (&oa)[2][2], unsigned (&ob)[2][2]) const {
        int R[2], C[2];
        { int tq = tid_; asm volatile("" : "+v"(tq)); g8::stage_rc(tq * 16, R[0], C[0]); g8::stage_rc(tq * 16 + 8192, R[1], C[1]); }
#pragma unroll
        for (int h = 0; h < 2; ++h)
#pragma unroll
            for (int i = 0; i < 2; ++i) {
                oa[h][i] = (unsigned)((u.pm * 256 + h * 128 + R[i]) * 1024 + C[i]) * 2u;
                ob[h][i] = (unsigned)((u.pn * 256 + h * 128 + R[i]) * 1024 + C[i]) * 2u;
            }
    }
    __device__ __forceinline__ int nt(const Unit&) const { return 16; }
    __device__ __forceinline__ bool brk(const Unit&, const Unit&) const { return false; }
    __device__ __forceinline__ void a_ready(const Unit&) const {}
    __device__ __forceinline__ void done(const Unit&) const {}
    __device__ __forceinline__ void mid(g8::Acc& acc, const Unit& u, int wr, int fr) const {
#pragma unroll
        for (int ai = 0; ai < 2; ++ai)
#pragma unroll
            for (int m = 0; m < 4; ++m) {
                const float s = rs[u.slot * 256 + ai * 128 + wr * 64 + m * 16 + fr];
#pragma unroll
                for (int bj = 0; bj < 2; ++bj)
#pragma unroll
                    for (int n = 0; n < 2; ++n) acc[ai][bj][m][n] *= s;
            }
    }
    __device__ __forceinline__ void epi(g8::Acc& acc, const Unit& u, int wr, int wc, int fr, int fq) const {
        const int row0 = u.pm * 256 + wr * 64 + fr, col0 = u.pn * 256 + wc * 32 + 4 * fq;
        const int b = u.pm >> 4;
        const float* mod = (const float*)(P->ws + O_MOD) + b * 6144 + 2048;
        f32x4 g1[2][2];
#pragma unroll
        for (int bj = 0; bj < 2; ++bj)
#pragma unroll
            for (int n = 0; n < 2; ++n) g1[bj][n] = *(const f32x4*)(mod + col0 + bj * 128 + n * 16);
#pragma unroll
        for (int ai = 0; ai < 2; ++ai)
#pragma unroll
            for (int mp = 0; mp < 2; ++mp) {
                f32x4 xv[2][2][2];
#pragma unroll
                for (int mm = 0; mm < 2; ++mm)
#pragma unroll
                    for (int bj = 0; bj < 2; ++bj)
#pragma unroll
                        for (int n = 0; n < 2; ++n)
                            xv[mm][bj][n] = *(const f32x4*)(P->in[I_X] + (size_t)(row0 + ai * 128 + (mp * 2 + mm) * 16) * 1024 + col0 + bj * 128 + n * 16);
                __builtin_amdgcn_sched_barrier(0);
#pragma unroll
                for (int mm = 0; mm < 2; ++mm)
#pragma unroll
                    for (int bj = 0; bj < 2; ++bj)
#pragma unroll
                        for (int n = 0; n < 2; ++n)
                            *(f32x4*)(P->out + (size_t)(row0 + ai * 128 + (mp * 2 + mm) * 16) * 1024 + col0 + bj * 128 + n * 16) = xv[mm][bj][n] + g1[bj][n] * acc[ai][bj][mp * 2 + mm][n];
                __builtin_amdgcn_sched_barrier(0);
            }
    }
};
__device__ void phase7(const Params& P, char* lds) {
    float* rs = (float*)(lds + g8::STAGE_BYTES);
    OutProj S; S.P = &P; S.rs = rs; S.G = gridDim.x; S.c = blockIdx.x;
    for (int i = 0; i < 4; ++i) {
        OutProj::Unit u;
        if (!S.next(i, u)) break;
        if (threadIdx.x < 256) {
            const float* sq = (const float*)(P.ws + O_SSQ) + (size_t)(u.pm * 256 + threadIdx.x) * 16;
            float s = 0.f;
#pragma unroll
            for (int q = 0; q < 16; ++q) s += sq[q];
            rs[i * 256 + threadIdx.x] = rsqrtf(s * (1.f / 512.f) + 1e-6f);
        }
    }
    __syncthreads();
    g8::gemm_phase<OutProj>((LAS unsigned char*)lds, S);
}

__device__ void phase8(const Params& P, char* lds_all) {
    unsigned char* ws = P.ws;
    const float* mod = (const float*)(ws + O_MOD);
    {
        const int t = threadIdx.x, lane = t & 63, w = t >> 6;
        float* tt = (float*)lds_all;
        float bw[32][3];
        {
            const int ti = lane & 15, kq = lane >> 4;
#pragma unroll
            for (int ks = 0; ks < 32; ++ks) {
                const int k = w * 128 + ks * 4 + kq;
                bw[ks][0] = P.in[I_REW][(size_t)k * 32 + ti];
                bw[ks][1] = P.in[I_REW][(size_t)k * 32 + 16 + ti];
                const float b2r = P.in[I_RGW][(size_t)k * 4 + (ti & 3)];
                bw[ks][2] = ti < 4 ? b2r : 0.f;
            }
        }
        for (int u = blockIdx.x; u < 512; u += gridDim.x) {
            const int tk0 = u * 32;
            const int b = tk0 >> 12;
#pragma unroll 1
            for (int qh = 0; qh < 2; ++qh) {
                float4 v[2][4]; float ss[2];
#pragma unroll
                for (int q = 0; q < 2; ++q) {
                    const float* xr = P.out + (size_t)(tk0 + w * 4 + qh * 2 + q) * 1024;
#pragma unroll
                    for (int j = 0; j < 4; ++j) { v[q][j] = ((const float4*)xr)[lane + 64 * j]; }
                }
#pragma unroll
                for (int q = 0; q < 2; ++q) {
                    ss[q] = 0.f;
#pragma unroll
                    for (int j = 0; j < 4; ++j) ss[q] += v[q][j].x * v[q][j].x + v[q][j].y * v[q][j].y + v[q][j].z * v[q][j].z + v[q][j].w * v[q][j].w;
                    ss[q] = rsqrtf(wave_sum(ss[q]) * (1.f / 1024.f) + 1e-6f);
                }
#pragma unroll
                for (int j = 0; j < 4; ++j) {
                    const int k = (lane + 64 * j) * 4;
                    const float4 nwv = *(const float4*)(P.in[I_N2W] + k);
                    const float4 sh = *(const float4*)(mod + b * 6144 + 3072 + k);
                    const float4 sc = *(const float4*)(mod + b * 6144 + 4096 + k);
                    const float m0 = nwv.x * (1.f + sc.x), m1 = nwv.y * (1.f + sc.y), m2 = nwv.z * (1.f + sc.z), m3 = nwv.w * (1.f + sc.w);
#pragma unroll
                    for (int q = 0; q < 2; ++q) {
                        const int tl = w * 4 + qh * 2 + q;
                        float4 hh;
                        hh.x = v[q][j].x * ss[q] * m0 + sh.x; hh.y = v[q][j].y * ss[q] * m1 + sh.y;
                        hh.z = v[q][j].z * ss[q] * m2 + sh.z; hh.w = v[q][j].w * ss[q] * m3 + sh.w;
                        uint2 o; o.x = pack2(hh.x, hh.y); o.y = pack2(hh.z, hh.w);
                        *(uint2*)((u16*)(ws + O_T) + (size_t)(tk0 + tl) * 1024 + k) = o;
                        *(float4*)(tt + tl * 1028 + k) = hh;
                    }
                }
            }
            __syncthreads();
            f32x4 c[2][3];
#pragma unroll
            for (int a = 0; a < 2; ++a)
#pragma unroll
                for (int f = 0; f < 3; ++f) c[a][f] = f32x4{0, 0, 0, 0};
            const int ti = lane & 15, kq = lane >> 4;
#pragma unroll
            for (int ks = 0; ks < 32; ++ks) {
                const int k = w * 128 + ks * 4 + kq;
                const float a0 = tt[ti * 1028 + k], a1 = tt[(16 + ti) * 1028 + k];
                c[0][0] = __builtin_amdgcn_mfma_f32_16x16x4f32(a0, bw[ks][0], c[0][0], 0, 0, 0);
                c[0][1] = __builtin_amdgcn_mfma_f32_16x16x4f32(a0, bw[ks][1], c[0][1], 0, 0, 0);
                c[0][2] = __builtin_amdgcn_mfma_f32_16x16x4f32(a0, bw[ks][2], c[0][2], 0, 0, 0);
                c[1][0] = __builtin_amdgcn_mfma_f32_16x16x4f32(a1, bw[ks][0], c[1][0], 0, 0, 0);
                c[1][1] = __builtin_amdgcn_mfma_f32_16x16x4f32(a1, bw[ks][1], c[1][1], 0, 0, 0);
                c[1][2] = __builtin_amdgcn_mfma_f32_16x16x4f32(a1, bw[ks][2], c[1][2], 0, 0, 0);
            }
            __syncthreads();
            float* red = (float*)lds_all;
#pragma unroll
            for (int a = 0; a < 2; ++a)
#pragma unroll
                for (int r = 0; r < 4; ++r) {
                    const int row = a * 16 + kq * 4 + r;
                    red[(w * 32 + row) * 48 + ti] = c[a][0][r];
                    red[(w * 32 + row) * 48 + 16 + ti] = c[a][1][r];
                    red[(w * 32 + row) * 48 + 32 + ti] = c[a][2][r];
                }
            __syncthreads();
            int* lcnt = (int*)(lds_all + 65536);
            if (t < 64) lcnt[t] = 0;
            __syncthreads();
            int ea = 0, eb = 0, ra = 0, rb = 0; float w1 = 0.f, w2 = 0.f;
            if (t < 32) {
                float gl[4];
#pragma unroll
                for (int j = 0; j < 4; ++j) {
                    float sacc = P.in[I_RGB][j];
#pragma unroll
                    for (int ww = 0; ww < 8; ++ww) sacc += red[(ww * 32 + t) * 48 + 32 + j];
                    gl[j] = sacc;
                }
                int gs = 0; float gm = gl[0];
#pragma unroll
                for (int j = 1; j < 4; ++j) if (gl[j] > gm) { gm = gl[j]; gs = j; }
                float gsum = 0.f;
#pragma unroll
                for (int j = 0; j < 4; ++j) gsum += __expf(gl[j] - gm);
                const float pg = 1.f / gsum;
                float el[8];
#pragma unroll
                for (int j = 0; j < 8; ++j) {
                    float sacc = P.in[I_REB][gs * 8 + j];
#pragma unroll
                    for (int ww = 0; ww < 8; ++ww) sacc += red[(ww * 32 + t) * 48 + gs * 8 + j];
                    el[j] = sacc;
                }
                int i1 = 0; float m1 = el[0];
#pragma unroll
                for (int j = 1; j < 8; ++j) if (el[j] > m1) { m1 = el[j]; i1 = j; }
                int i2 = -1; float m2 = -INFINITY;
#pragma unroll
                for (int j = 0; j < 8; ++j) if (j != i1 && el[j] > m2) { m2 = el[j]; i2 = j; }
                const float e2 = __expf(m2 - m1);
                w1 = pg / (1.f + e2); w2 = pg * e2 / (1.f + e2);
                ea = gs * 8 + i1; eb = gs * 8 + i2;
                ra = atomicAdd(&lcnt[ea], 1);
                rb = atomicAdd(&lcnt[eb], 1);
            }
            __syncthreads();
            if (t < 32) {
                const int n = lcnt[t];
                lcnt[32 + t] = n > 0 ? atomicAdd((int*)(ws + O_CNT) + t * 64, n) : 0;
            }
            __syncthreads();
            if (t < 32) {
                const int tok = tk0 + t;
                int* list = (int*)(ws + O_LIST);
                float* wts = (float*)(ws + O_WTS);
                list[ea * 16384 + lcnt[32 + ea] + ra] = tok * 2;
                wts[tok * 2] = w1;
                list[eb * 16384 + lcnt[32 + eb] + rb] = tok * 2 + 1;
                wts[tok * 2 + 1] = w2;
            }
            __syncthreads();
        }
    }
    const int vb = threadIdx.x >> 8, t = threadIdx.x & 255;
    char* lds = lds_all + vb * VLDS;
    const int NTR = 3072;
    for (int u = blockIdx.x * 2 + vb; u < NTR; u += gridDim.x * 2) {
        {
            const int v = u;
            float* tile = (float*)lds;
            if (v < 2048) {
                const bool up = v >= 1024;
                const int vv = v & 1023, e = vv >> 5, rem = vv & 31, nt = rem >> 4, kt = rem & 15;
                const float* src = P.in[up ? I_WU : I_WG] + (size_t)e * 1024 * 256;
                transpose_tile_w(tile, src, 256, kt * 64, nt * 128, (u16*)(ws + O_WGU) + (size_t)e * 512 * 1024, (up ? 256 : 0) + nt * 128, 1024, nullptr, 0, t);
            } else {
                const int vv = v - 2048, e = vv >> 5, rem = vv & 31, nt = rem >> 2, kt = rem & 3;
                const float* src = P.in[I_WD] + (size_t)e * 256 * 1024;
                transpose_tile_w(tile, src, 1024, kt * 64, nt * 128, (u16*)(ws + O_WD) + (size_t)e * 1024 * 256, nt * 128, 256, nullptr, 0, t);
            }
        }
    }
}

__device__ __forceinline__ void moe_prefix(const unsigned char* ws, int* pre_t, int* pre_c) {
    if (threadIdx.x == 0) {
        const int* cnt = (const int*)(ws + O_CNT);
        int at = 0, ac = 0;
        for (int e = 0; e < 32; ++e) { pre_t[e] = at; pre_c[e] = ac; const int c = cnt[e * 64]; at += (c + 255) >> 8; ac += c; }
        pre_t[32] = at; pre_c[32] = ac;
    }
    __syncthreads();
}
struct MoeUnit { int type, e, mt, pn, cnt, base, mtg; };
struct Moe {
    static constexpr int K = 0; static constexpr bool PERM = true; static constexpr int MIDT = 0;
    typedef MoeUnit Unit;
    const unsigned char* ws; const int* pre_t; const int* pre_c; int G, c;
    __device__ __forceinline__ bool next(int i, Unit& u) const {
        int type, m, pn, e, mt;
        if ((G & 7) == 0) {
            const int x = c & 7, s = c >> 3, nb = G >> 3;
            const int n0 = pre_t[x + 1] - pre_t[x], n1 = pre_t[x + 9] - pre_t[x + 8], n2 = pre_t[x + 17] - pre_t[x + 16], n3 = pre_t[x + 25] - pre_t[x + 24];
            const int MTx = n0 + n1 + n2 + n3;
            const int Lx = i * nb + s;
            if (Lx < MTx * 2) { type = 0; m = Lx >> 1; pn = Lx & 1; }
            else if (Lx < MTx * 6) { const int j = Lx - MTx * 2; type = 1; m = j >> 2; pn = j & 3; }
            else return false;
            if (m < n0) { e = x; mt = m; }
            else if (m < n0 + n1) { e = x + 8; mt = m - n0; }
            else if (m < n0 + n1 + n2) { e = x + 16; mt = m - n0 - n1; }
            else { e = x + 24; mt = m - n0 - n1 - n2; }
        } else {
            const int L = i * G + c, MT = pre_t[32];
            if (L < MT * 2) { type = 0; m = L >> 1; pn = L & 1; }
            else if (L < MT * 6) { const int j = L - MT * 2; type = 1; m = j >> 2; pn = j & 3; }
            else return false;
            e = 0;
            while (pre_t[e + 1] <= m) ++e;
            mt = m - pre_t[e];
        }
        u.e = __builtin_amdgcn_readfirstlane(e); u.mt = __builtin_amdgcn_readfirstlane(mt);
        u.cnt = __builtin_amdgcn_readfirstlane(pre_c[e + 1] - pre_c[e]); u.base = __builtin_amdgcn_readfirstlane(pre_c[e]);
        u.mtg = __builtin_amdgcn_readfirstlane(pre_t[e] + mt); u.pn = __builtin_amdgcn_readfirstlane(pn); u.type = __builtin_amdgcn_readfirstlane(type);
        return true;
    }
    __device__ __forceinline__ int nt(const Unit& u) const { return u.type ? 4 : 16; }
    __device__ __forceinline__ bool brk(const Unit& a, const Unit& b) const { return a.type == 0 && b.type == 1; }
    __device__ __forceinline__ const char* baseA(const Unit& u) const {
        return u.type ? (const char*)(ws + O_H) + (size_t)(u.base + u.mt * 256) * 256 * 2 : (const char*)(ws + O_T);
    }
    __device__ __forceinline__ const char* baseB(const Unit& u) const {
        return u.type ? (const char*)(ws + O_WD) + ((size_t)u.e * 1024 + u.pn * 256) * 256 * 2 : (const char*)(ws + O_WGU) + (size_t)u.e * 512 * 1024 * 2;
    }
    __device__ __forceinline__ void offs(const Unit& u, int tid_, unsigned (&oa)[2][2], unsigned (&ob)[2][2]) const {
        int R[2], C[2];
        { int tq = tid_; asm volatile("" : "+v"(tq)); g8::stage_rc(tq * 16, R[0], C[0]); g8::stage_rc(tq * 16 + 8192, R[1], C[1]); }
        const int* list = (const int*)(ws + O_LIST) + u.e * 16384;
#pragma unroll
        for (int h = 0; h < 2; ++h)
#pragma unroll
            for (int i = 0; i < 2; ++i) {
                const int Rb = (R[i] & ~31) + g8::perm32(R[i] & 31);
                const int idx = u.mt * 256 + h * 128 + R[i];
                const int tok = list[idx < u.cnt ? idx : u.cnt - 1] >> 1;
                if (u.type == 0) {
                    oa[h][i] = (unsigned)(tok * 1024 + C[i]) * 2u;
                    ob[h][i] = (unsigned)((h * 256 + u.pn * 128 + Rb) * 1024 + C[i]) * 2u;
                } else {
                    oa[h][i] = (unsigned)((h * 128 + R[i]) * 256 + C[i]) * 2u;
                    ob[h][i] = (unsigned)((h * 128 + Rb) * 256 + C[i]) * 2u;
                }
            }
    }
    __device__ __forceinline__ void mid(g8::Acc&, const Unit&, int, int) const {}
    __device__ __forceinline__ void a_ready(const Unit& u) const {
        if (u.type == 0) return;
        if (threadIdx.x < 64) {
            unsigned* rdy = (unsigned*)(ws + O_RDY) + u.mtg * 64;
            unsigned spins = 0;
            while ((unsigned)__builtin_amdgcn_readfirstlane(__hip_atomic_load(rdy, __ATOMIC_RELAXED, __HIP_MEMORY_SCOPE_AGENT)) < 16u) {
                __builtin_amdgcn_s_sleep(2);
                if (++spins > (1u << 22)) break;
            }
            __builtin_amdgcn_fence(__ATOMIC_ACQUIRE, "agent");
            asm volatile("s_waitcnt vmcnt(0)" ::: "memory");
        }
        asm volatile("" ::: "memory"); __builtin_amdgcn_s_barrier(); asm volatile("" ::: "memory");
    }
    __device__ __forceinline__ void done(const Unit& u) const {
        if (u.type != 0) return;
        asm volatile("s_waitcnt vmcnt(0)" ::: "memory");
        if ((threadIdx.x & 63) == 0) __hip_atomic_fetch_add((unsigned*)(ws + O_RDY) + u.mtg * 64, 1u, __ATOMIC_RELAXED, __HIP_MEMORY_SCOPE_AGENT);
    }
    __device__ __forceinline__ void epi(g8::Acc& acc, const Unit& u, int wr, int wc, int fr, int fq) const {
        if (u.type == 0) {
            __amdgpu_buffer_rsrc_t rs = __builtin_amdgcn_make_buffer_rsrc((void*)(ws + O_H), 0, (int)((32768 + 256) * 256 * 2), 0x00020000);
#pragma unroll
            for (int ai = 0; ai < 2; ++ai)
#pragma unroll
                for (int m = 0; m < 4; ++m) {
                    const int idx = u.mt * 256 + ai * 128 + wr * 64 + m * 16 + fr;
                    if (idx < u.cnt) {
                        const f32x4 g0 = acc[ai][0][m][0], g1 = acc[ai][0][m][1], u0 = acc[ai][1][m][0], u1 = acc[ai][1][m][1];
                        u32x4 o;
                        o.x = g8::cvt_pk_bf16(siluf(g0[0]) * u0[0], siluf(g0[1]) * u0[1]); o.y = g8::cvt_pk_bf16(siluf(g0[2]) * u0[2], siluf(g0[3]) * u0[3]);
                        o.z = g8::cvt_pk_bf16(siluf(g1[0]) * u1[0], siluf(g1[1]) * u1[1]); o.w = g8::cvt_pk_bf16(siluf(g1[2]) * u1[2], siluf(g1[3]) * u1[3]);
                        const unsigned off = ((unsigned)(u.base + idx) * 256u + (unsigned)(u.pn * 128 + wc * 32 + 8 * fq)) * 2u;
                        __builtin_amdgcn_raw_buffer_store_b128(o, rs, off, 0, 16);
                    }
                }
            return;
        }
        const int* list = (const int*)(ws + O_LIST) + u.e * 16384;
        const float* wts = (const float*)(ws + O_WTS);
        u16* SL = (u16*)((unsigned char*)ws + O_SL);
        int ent[2][4]; float wg[2][4];
#pragma unroll
        for (int ai = 0; ai < 2; ++ai)
#pragma unroll
            for (int m = 0; m < 4; ++m) {
                const int idx = u.mt * 256 + ai * 128 + wr * 64 + m * 16 + fr;
                ent[ai][m] = list[idx < u.cnt ? idx : u.cnt - 1];
            }
#pragma unroll
        for (int ai = 0; ai < 2; ++ai)
#pragma unroll
            for (int m = 0; m < 4; ++m) wg[ai][m] = wts[ent[ai][m]];
#pragma unroll
        for (int ai = 0; ai < 2; ++ai)
#pragma unroll
            for (int m = 0; m < 4; ++m) {
                const int idx = u.mt * 256 + ai * 128 + wr * 64 + m * 16 + fr;
                if (idx < u.cnt) {
                    u16* rowp = SL + (size_t)ent[ai][m] * 1024 + u.pn * 256 + wc * 32 + 8 * fq;
#pragma unroll
                    for (int bj = 0; bj < 2; ++bj) {
                        const f32x4 v0 = acc[ai][bj][m][0] * wg[ai][m], v1 = acc[ai][bj][m][1] * wg[ai][m];
                        u32x4 o; o.x = g8::cvt_pk_bf16(v0[0], v0[1]); o.y = g8::cvt_pk_bf16(v0[2], v0[3]); o.z = g8::cvt_pk_bf16(v1[0], v1[1]); o.w = g8::cvt_pk_bf16(v1[2], v1[3]);
                        *(u32x4*)(rowp + bj * 128) = o;
                    }
                }
            }
    }
};
__device__ void phase9(const Params& P, char* lds) {
    int* pre_t = (int*)(lds + g8::STAGE_BYTES); int* pre_c = pre_t + 40;
    moe_prefix(P.ws, pre_t, pre_c);
    Moe S; S.ws = P.ws; S.pre_t = pre_t; S.pre_c = pre_c; S.G = gridDim.x; S.c = blockIdx.x;
    int i = 0;
    while (i >= 0) i = g8::gemm_phase<Moe>((LAS unsigned char*)lds, S, i);
}

__device__ void phase11(const Params& P) {
    unsigned char* ws = P.ws;
    const int lane = threadIdx.x & 63;
    const int gw = blockIdx.x * 8 + (threadIdx.x >> 6), nw = gridDim.x * 8;
    const float* mod = (const float*)(ws + O_MOD);
    const u16* SL = (const u16*)(ws + O_SL);
    const int r_lo = (int)(((long long)gw * MLAT) / nw), r_hi = (int)(((long long)(gw + 1) * MLAT) / nw);
    float4 g2[4], fw[4];
    int cur_b = -1;
#pragma unroll
    for (int j = 0; j < 4; ++j) fw[j] = *(const float4*)(P.in[I_FNW] + (lane + 64 * j) * 4);
    for (int row = r_lo; row < r_hi; row += 2) {
        const bool two = row + 1 < r_hi;
        const int row1 = two ? row + 1 : row;
        float4 v0[4], v1[4]; uint2 a0[4], a1[4], b0[4], b1[4];
#pragma unroll
        for (int j = 0; j < 4; ++j) {
            const int k = (lane + 64 * j) * 4;
            v0[j] = *(const float4*)(P.out + (size_t)row * 1024 + k);
            v1[j] = *(const float4*)(P.out + (size_t)row1 * 1024 + k);
            a0[j] = *(const uint2*)(SL + (size_t)(row * 2) * 1024 + k);
            a1[j] = *(const uint2*)(SL + (size_t)(row * 2 + 1) * 1024 + k);
            b0[j] = *(const uint2*)(SL + (size_t)(row1 * 2) * 1024 + k);
            b1[j] = *(const uint2*)(SL + (size_t)(row1 * 2 + 1) * 1024 + k);
        }
#pragma unroll 1
        for (int rr = 0; rr < 2; ++rr) {
            const int orow = rr ? row1 : row;
            const int b = orow >> 12;
            if (b != cur_b) {
                cur_b = b;
#pragma unroll
                for (int j = 0; j < 4; ++j) g2[j] = *(const float4*)(mod + b * 6144 + 5120 + (lane + 64 * j) * 4);
            }
            if (rr == 1 && !two) break;
            float4 x[4]; float ss = 0.f;
#pragma unroll
            for (int j = 0; j < 4; ++j) {
                const float4 vv = rr ? v1[j] : v0[j];
                const uint2 s0 = rr ? b0[j] : a0[j], s1 = rr ? b1[j] : a1[j];
                x[j].x = vv.x + g2[j].x * (bflo(s0.x) + bflo(s1.x));
                x[j].y = vv.y + g2[j].y * (bfhi(s0.x) + bfhi(s1.x));
                x[j].z = vv.z + g2[j].z * (bflo(s0.y) + bflo(s1.y));
                x[j].w = vv.w + g2[j].w * (bfhi(s0.y) + bfhi(s1.y));
                ss += x[j].x * x[j].x + x[j].y * x[j].y + x[j].z * x[j].z + x[j].w * x[j].w;
            }
            const float rstd = rsqrtf(wave_sum(ss) * (1.f / 1024.f) + 1e-6f);
#pragma unroll
            for (int j = 0; j < 4; ++j) {
                float4 o; o.x = x[j].x * rstd * fw[j].x; o.y = x[j].y * rstd * fw[j].y; o.z = x[j].z * rstd * fw[j].z; o.w = x[j].w * rstd * fw[j].w;
                *(float4*)(P.out + (size_t)orow * 1024 + (lane + 64 * j) * 4) = o;
            }
        }
    }
}

__global__ void __launch_bounds__(NTB, 2) fwd_kernel(Params P) {
    extern __shared__ __attribute__((aligned(16))) char lds[];
    if (threadIdx.x < 4) ((volatile LAS unsigned*)(lds + LDS_MAIN))[threadIdx.x] = 0u;
    __syncthreads();
    XcdBarrier xbar = xcd_barrier_post((unsigned*)(P.ws + O_BAR), (volatile LAS unsigned*)(lds + LDS_MAIN));
#define SYNC() xcd_barrier(xbar)
#ifdef ONLY_PH
#define RUN_PHASE(k, call) do { if ((k) == ONLY_PH) { call; } } while (0)
#else
#define RUN_PHASE(k, call) do { if (P.lo <= (k) && (k) < P.hi) { call; if ((k) + 1 < P.hi) { SYNC(); } } } while (0)
#endif
    RUN_PHASE(0, phase0(P, lds));
    RUN_PHASE(1, phase1(P));
    RUN_PHASE(2, { InProj S; S.ws = P.ws; S.G = gridDim.x; S.c = blockIdx.x; g8::gemm_phase<InProj>((LAS unsigned char*)lds, S); });
    RUN_PHASE(3, phase3(P, lds));
    RUN_PHASE(4, phase4(P, lds));
    RUN_PHASE(5, phase5(P));
    RUN_PHASE(6, phase6(P, lds));
    RUN_PHASE(7, phase7(P, lds));
    RUN_PHASE(8, phase8(P, lds));
    RUN_PHASE(9, phase9(P, lds));
    RUN_PHASE(11, phase11(P));
}

extern "C" void kernel_launch(void* const* d_in, const int* in_sizes, int n_in, void* d_out, int out_size, void* d_ws, size_t ws_size,
                              hipStream_t stream) {
    static int grid_blocks = 0;
    if (!grid_blocks) {
        int dev = 0, cus = 0, per_cu = 0;
        (void)hipGetDevice(&dev);
        (void)hipDeviceGetAttribute(&cus, hipDeviceAttributeMultiprocessorCount, dev);
        (void)hipFuncSetAttribute((const void*)fwd_kernel, hipFuncAttributeMaxDynamicSharedMemorySize, LDS_BYTES);
        (void)hipOccupancyMaxActiveBlocksPerMultiprocessor(&per_cu, (const void*)fwd_kernel, NTB, LDS_BYTES);
        if (per_cu < 1) fprintf(stderr, "occupancy query says %d blocks per CU\n", per_cu);
        grid_blocks = cus;
        if (ws_size < WS_END) fprintf(stderr, "workspace too small: %zu < %zu\n", ws_size, (size_t)WS_END);
    }
    Params p{};
    for (int i = 0; i < 30; ++i) p.in[i] = (const float*)d_in[i];
    p.out = (float*)d_out; p.ws = (unsigned char*)d_ws;
    p.lo = 0; p.hi = NPHASE;
    (void)hipMemsetAsync((char*)d_ws + O_BAR, 0, 16384 + 40960, stream);
    void* args[] = {&p};
    hipError_t e = hipLaunchCooperativeKernel((const void*)fwd_kernel, dim3(grid_blocks), dim3(NTB), args, LDS_BYTES, stream);
    if (e != hipSuccess) fprintf(stderr, "cooperative launch failed: %s (grid %d)\n", hipGetErrorString(e), grid_blocks);
}
```

```cpp
#include <hip/hip_runtime.h>
#include <cstdio>
#include <cstdint>

typedef unsigned short u16;
typedef __attribute__((ext_vector_type(8))) short bf16x8;
typedef __attribute__((ext_vector_type(4))) float f32x4;
typedef __attribute__((ext_vector_type(4))) unsigned u32x4;
#define LAS __attribute__((address_space(3)))

constexpr int NTB = 512;
constexpr int VLDS = 75776;
constexpr int LDS_MAIN = 2 * VLDS;
constexpr int LDS_BYTES = LDS_MAIN + 256;
constexpr int MLAT = 16384, MALL = 17408;
constexpr int NCH = 34;
constexpr int NPHASE = 12;

enum { I_X = 0, I_C, I_CTX, I_CCTX, I_WMOD, I_BMOD, I_N1W, I_WIN, I_SCW, I_SCB, I_DTB, I_ALOG, I_SSDD, I_SNW, I_MCW, I_MCB, I_WQK, I_GB,
       I_MNW, I_MSKIP, I_WOUT, I_N2W, I_RGW, I_RGB, I_REW, I_REB, I_WG, I_WU, I_WD, I_FNW };

constexpr size_t al(size_t x) { return (x + 255) & ~(size_t)255; }
constexpr size_t O_MOD = 0;
constexpr size_t O_SSQ = O_MOD + al(5 * 6144 * 4);
constexpr size_t O_CNT = O_SSQ + al(16384 * 16 * 4);
constexpr size_t O_BAR = O_CNT + 8192;
constexpr size_t O_RDY = O_BAR + 16384;
constexpr size_t O_PSD = O_RDY + 40960;
constexpr size_t O_PSG = O_PSD + al((size_t)MALL * 16 * 4);
constexpr size_t O_DT = O_PSG + al((size_t)MALL * 16 * 4);
constexpr size_t O_GI = O_DT + al((size_t)MALL * 16 * 4);
constexpr size_t O_GF = O_GI + al((size_t)MALL * 8 * 4);
constexpr size_t O_ACH = O_GF + al((size_t)MALL * 8 * 4);
constexpr size_t O_MLS = O_ACH + 16384;
constexpr size_t O_MLP = O_MLS + 16384;
constexpr size_t O_MLN = O_MLP + 16384;
constexpr size_t O_LIST = O_MLN + al(4 * 34 * 4 * 2 * 128 * 4);
constexpr size_t O_WTS = O_LIST + al(32 * 16384 * 4);
constexpr size_t O_WIN = O_WTS + al(16384 * 2 * 4);
constexpr size_t O_WOUT = O_WIN + al((size_t)3328 * 1024 * 2);
constexpr size_t O_A = O_WOUT + al((size_t)1024 * 1024 * 2);
constexpr size_t SZ_A = (size_t)MALL * 1024 * 2;
constexpr size_t O_PT = O_A + SZ_A;
constexpr size_t SZ_PT = (size_t)MALL * 1536 * 2;
constexpr size_t O_MLC1 = O_PT + SZ_PT;
constexpr size_t SZ_HALF = (size_t)MALL * 512 * 2;
constexpr size_t O_ZO = O_MLC1 + SZ_HALF;
constexpr size_t O_VT = O_ZO + SZ_A;
constexpr size_t O_BM = O_VT + SZ_HALF;
constexpr size_t SZ_Q = (size_t)MALL * 256 * 2;
constexpr size_t O_BT = O_BM + SZ_Q;
constexpr size_t O_CM = O_BT + SZ_Q;
constexpr size_t O_XT = O_CM + SZ_Q;
constexpr size_t O_KT = O_XT + SZ_HALF;
constexpr size_t O_XC = O_KT + SZ_HALF;
constexpr size_t O_DUMP = O_XC + SZ_HALF;
constexpr size_t WS_END = O_DUMP + 256 * 2048;
constexpr size_t O_XN = O_A, O_Q = O_A, O_K = O_A + SZ_HALF, O_T = O_A;
constexpr size_t O_ST = O_PT;
constexpr size_t O_MLC0 = O_PT + (size_t)4 * 34 * 8 * 2 * 8192 * 2;
constexpr size_t O_WGU = O_PT;
constexpr size_t O_WD = O_PT + (size_t)32 * 512 * 1024 * 2;
constexpr size_t O_SL = O_ZO;
constexpr size_t O_H = O_XT;
static_assert(O_WD + (size_t)32 * 1024 * 256 * 2 <= O_MLC1, "moe weights fit PT region");
static_assert(O_SL + (size_t)16384 * 2 * 1024 * 2 <= O_CM, "slots fit");
static_assert((size_t)(32768 + 256) * 256 * 2 <= SZ_HALF, "H fits");
static_assert(WS_END <= (size_t)256 * 1024 * 1024, "workspace");
constexpr size_t TCTX512 = (size_t)4 * 512 * 4096;
constexpr size_t TCTX256 = (size_t)4 * 256 * 4096;

struct Params { const float* in[30]; float* out; unsigned char* ws; int lo, hi; };

#define XB_TMO      128
#define XB_XCNT(j)  (256  + 64 * (j))
#define XB_XSUB(j)  (1280 + 64 * (j))
#define XB_XGEN(j)  (2304 + 64 * (j))
#define XB_TOP      3328
#define XB_TOPGEN   3392
#define XCD_BAR_WORDS 3456
#define XB_SPIN_CAP (1u << 20)
__device__ __forceinline__ unsigned xb_ld(unsigned* p)              { return __hip_atomic_load(p, __ATOMIC_RELAXED, __HIP_MEMORY_SCOPE_AGENT); }
__device__ __forceinline__ unsigned xb_add(unsigned* p, unsigned v) { return __hip_atomic_fetch_add(p, v, __ATOMIC_RELAXED, __HIP_MEMORY_SCOPE_AGENT); }
__device__ __forceinline__ unsigned xb_xcc_id() { return (unsigned)__builtin_amdgcn_s_getreg((3 << 11) | 20) & 0xFu; }
#define XB_SPIN(cond, bar) do { unsigned _sp = 0; while (cond) { __builtin_amdgcn_s_sleep(1); \
    if ((++_sp & 255u) == 0u) { if (xb_ld(&(bar)[XB_TMO])) break; if (_sp > XB_SPIN_CAP) { atomicAdd(&(bar)[XB_TMO], 1u); break; } } } } while (0)
struct XcdBarrier { unsigned* bar; unsigned x; volatile LAS unsigned* st; };
__device__ __forceinline__ XcdBarrier xcd_barrier_post(unsigned* bar, volatile LAS unsigned* st) {
    XcdBarrier b; b.bar = bar; b.x = xb_xcc_id(); b.st = st;
    if (threadIdx.x == 0) (void)xb_add(&bar[XB_XCNT(b.x)], 1u);
    return b;
}
__device__ __forceinline__ void xcd_barrier_complete(unsigned* bar, unsigned x, unsigned& nloc, unsigned& nx) {
    const unsigned G = gridDim.x * gridDim.y * gridDim.z;
    unsigned sum, cnt, mine, sp = 0u;
    for (;;) {
        sum = 0u; cnt = 0u; mine = 0u;
#pragma unroll
        for (unsigned j = 0; j < 16; ++j) { const unsigned c = xb_ld(&bar[XB_XCNT(j)]); sum += c; cnt += (c > 0u) ? 1u : 0u; mine = (j == x) ? c : mine; }
        if (sum == G) break;
        __builtin_amdgcn_s_sleep(1);
        if ((++sp & 255u) == 0u) { if (xb_ld(&bar[XB_TMO])) break; if (sp > XB_SPIN_CAP) { atomicAdd(&bar[XB_TMO], 1u); break; } }
    }
    nloc = mine > 0u ? mine : 1u; nx = cnt > 0u ? cnt : 1u;
}
__device__ __forceinline__ void xcd_barrier(const XcdBarrier& b) {
    asm volatile("s_waitcnt vmcnt(0)" ::: "memory");
    __syncthreads();
    if (threadIdx.x == 0) {
        unsigned* bar = b.bar;
        __builtin_amdgcn_s_waitcnt(0);
        unsigned nloc = b.st[0], nx = b.st[1];
        if (nloc == 0u) { xcd_barrier_complete(bar, b.x, nloc, nx); b.st[0] = nloc; b.st[1] = nx; }
        const unsigned old = xb_add(&bar[XB_XSUB(b.x)], 1u);
        const unsigned gen = old / nloc;
        if (old + 1u == (gen + 1u) * nloc) {
            __builtin_amdgcn_fence(__ATOMIC_RELEASE, "agent");
            asm volatile("s_waitcnt vmcnt(0)" ::: "memory");
            const unsigned og = xb_add(&bar[XB_TOP], 1u);
            const unsigned tg = og / nx;
            if (og + 1u == (tg + 1u) * nx) xb_add(&bar[XB_TOPGEN], 1u);
            else XB_SPIN(xb_ld(&bar[XB_TOPGEN]) == tg, bar);
            __builtin_amdgcn_fence(__ATOMIC_ACQUIRE, "agent");
            xb_add(&bar[XB_XGEN(b.x)], 1u);
            asm volatile("s_waitcnt vmcnt(0)" ::: "memory");
        } else {
            XB_SPIN(xb_ld(&bar[XB_XGEN(b.x)]) == gen, bar);
            __builtin_amdgcn_fence(__ATOMIC_ACQUIRE, "agent");
            asm volatile("s_waitcnt vmcnt(0)" ::: "memory");
        }
    }
    __syncthreads();
}

__device__ __forceinline__ u16 f2bf(float f) { unsigned u = __float_as_uint(f); u += 0x7fffu + ((u >> 16) & 1u); return (u16)(u >> 16); }
__device__ __forceinline__ float bf2f(u16 h) { return __uint_as_float(((unsigned)h) << 16); }
__device__ __forceinline__ unsigned pack2(float a, float b) { return (unsigned)f2bf(a) | ((unsigned)f2bf(b) << 16); }
__device__ __forceinline__ float bflo(unsigned u) { return __uint_as_float(u << 16); }
__device__ __forceinline__ float bfhi(unsigned u) { return __uint_as_float(u & 0xffff0000u); }
__device__ __forceinline__ float siluf(float x) { return x / (1.f + __expf(-x)); }
__device__ __forceinline__ float sigmf(float x) { return 1.f / (1.f + __expf(-x)); }
__device__ __forceinline__ float softplusf(float x) { return x > 20.f ? x : log1pf(__expf(x)); }
__device__ __forceinline__ float wave_sum(float v) {
#pragma unroll
    for (int o = 32; o > 0; o >>= 1) v += __shfl_xor(v, o);
    return v;
}
__device__ __forceinline__ int swz256(int row, int chunk) { return row * 256 + ((chunk ^ (row & 15)) << 4); }
__device__ __forceinline__ int colmajor_src_row(int R) {
    if (R >= MLAT) return R;
    const int b = R >> 12, lp = R & 4095;
    return (b << 12) + ((lp & 63) << 6) + (lp >> 6);
}

__device__ __forceinline__ void load_tile128(char* lds, int lrow0, const u16* __restrict__ g, size_t ld, int rows, int t, int nthr) {
#pragma unroll 4
    for (int q = t; q < rows * 16; q += nthr) {
        const int r = q >> 4, c = q & 15;
        const uint4 v = *(const uint4*)(g + (size_t)r * ld + c * 8);
        *(uint4*)(lds + swz256(lrow0 + r, c)) = v;
    }
}
__device__ __forceinline__ void load_tile128_scaled(char* lds, int lrow0, const u16* __restrict__ g, size_t ld, int rows, const float* w, int t, int nthr) {
#pragma unroll 2
    for (int q = t; q < rows * 16; q += nthr) {
        const int r = q >> 4, c = q & 15;
        const uint4 v = *(const uint4*)(g + (size_t)r * ld + c * 8);
        const float* ww = w + c * 8;
        uint4 o;
        o.x = pack2(bflo(v.x) * ww[0], bfhi(v.x) * ww[1]);
        o.y = pack2(bflo(v.y) * ww[2], bfhi(v.y) * ww[3]);
        o.z = pack2(bflo(v.z) * ww[4], bfhi(v.z) * ww[5]);
        o.w = pack2(bflo(v.w) * ww[6], bfhi(v.w) * ww[7]);
        *(uint4*)(lds + swz256(lrow0 + r, c)) = o;
    }
}
template <int MI, int NJ>
__device__ __forceinline__ void lds_mma(const char* A, const char* B, int arow0, int brow0, f32x4 (&acc)[MI][NJ], int lane) {
#pragma unroll 1
    for (int kk = 0; kk < 4; ++kk) {
        const int chunk = kk * 4 + (lane >> 4);
        bf16x8 a[MI], b[NJ];
#pragma unroll
        for (int i = 0; i < MI; ++i) { const int row = arow0 + i * 16 + (lane & 15); a[i] = *(const bf16x8*)(A + swz256(row, chunk)); }
#pragma unroll
        for (int j = 0; j < NJ; ++j) { const int row = brow0 + j * 16 + (lane & 15); b[j] = *(const bf16x8*)(B + swz256(row, chunk)); }
#pragma unroll
        for (int i = 0; i < MI; ++i)
#pragma unroll
            for (int j = 0; j < NJ; ++j) acc[i][j] = __builtin_amdgcn_mfma_f32_16x16x32_bf16(a[i], b[j], acc[i][j], 0, 0, 0);
    }
}
template <int MI, int NJ>
__device__ __forceinline__ void lds_mma_t(const char* A, const char* B, int arow0, int brow0, f32x4 (&acc)[MI][NJ], int lane) {
#pragma unroll 1
    for (int kk = 0; kk < 4; ++kk) {
        const int chunk = kk * 4 + (lane >> 4);
        bf16x8 a[MI], b[NJ];
#pragma unroll
        for (int i = 0; i < MI; ++i) { const int row = arow0 + i * 16 + (lane & 15); a[i] = *(const bf16x8*)(A + swz256(row, chunk)); }
#pragma unroll
        for (int j = 0; j < NJ; ++j) { const int row = brow0 + j * 16 + (lane & 15); b[j] = *(const bf16x8*)(B + swz256(row, chunk)); }
#pragma unroll
        for (int i = 0; i < MI; ++i)
#pragma unroll
            for (int j = 0; j < NJ; ++j) acc[i][j] = __builtin_amdgcn_mfma_f32_16x16x32_bf16(b[j], a[i], acc[i][j], 0, 0, 0);
    }
}
template <int MI, int NJ>
__device__ __forceinline__ void zero_acc(f32x4 (&acc)[MI][NJ]) {
#pragma unroll
    for (int i = 0; i < MI; ++i)
#pragma unroll
        for (int j = 0; j < NJ; ++j) acc[i][j] = f32x4{0.f, 0.f, 0.f, 0.f};
}
template <int OP>
__device__ __forceinline__ float scan_pair(float v, float* buf, int t) {
    const int idx = t & 127, base = t & 128;
    const bool act = t < 256;
    if (act) buf[t] = v;
    __syncthreads();
#pragma unroll 1
    for (int off = 1; off < 128; off <<= 1) {
        float o = OP ? -INFINITY : 0.f;
        if (act && idx >= off) o = buf[base + idx - off];
        __syncthreads();
        v = OP ? fmaxf(v, o) : v + o;
        if (act) buf[t] = v;
        __syncthreads();
    }
    return v;
}

__device__ __forceinline__ float wave_scan_sum(float v, int lane) {
#pragma unroll
    for (int off = 1; off < 64; off <<= 1) { const float o = __shfl_up(v, off); if (lane >= off) v += o; }
    return v;
}
__device__ __forceinline__ float wave_scan_max(float v, int lane) {
#pragma unroll
    for (int off = 1; off < 64; off <<= 1) { const float o = __shfl_up(v, off); if (lane >= off) v = fmaxf(v, o); }
    return v;
}
__device__ __forceinline__ float wave_max(float v) {
#pragma unroll
    for (int o = 32; o > 0; o >>= 1) v = fmaxf(v, __shfl_xor(v, o));
    return v;
}
__device__ __forceinline__ void transpose_tile(float* tile, const float* __restrict__ src, int ld_src, int k0, int n0, int ncount,
                                               u16* dst, size_t dst_row0, int ld_dst, const float* __restrict__ scale, int scale_kmax, int t) {
    const int n = t & 63, kq = t >> 6;
    const int nc = n < ncount ? n : ncount - 1;
    float vv[16];
#pragma unroll
    for (int i = 0; i < 16; ++i) vv[i] = src[(size_t)(k0 + i * 4 + kq) * ld_src + n0 + nc];
#pragma unroll
    for (int i = 0; i < 16; ++i) {
        const int k = i * 4 + kq;
        float v = vv[i];
        if (scale && (k0 + k) < scale_kmax) v *= scale[k0 + k];
        tile[k * 65 + n] = n < ncount ? v : 0.f;
    }
    __syncthreads();
#pragma unroll
    for (int i = 0; i < 2; ++i) {
        const int q = t + 256 * i, nn = q >> 3, kc = q & 7;
        if (nn < ncount) {
            const float* p = tile + (kc * 8) * 65 + nn;
            uint4 o;
            o.x = pack2(p[0], p[65]); o.y = pack2(p[130], p[195]); o.z = pack2(p[260], p[325]); o.w = pack2(p[390], p[455]);
            *(uint4*)(dst + (dst_row0 + nn) * (size_t)ld_dst + k0 + kc * 8) = o;
        }
    }
    __syncthreads();
}

__device__ __forceinline__ void transpose_tile_w(float* tile, const float* __restrict__ src, int ld_src, int k0, int n0,
                                                 u16* dst, size_t dst_row0, int ld_dst, const float* __restrict__ scale, int scale_kmax, int t) {
    float4 v[8];
#pragma unroll
    for (int i = 0; i < 8; ++i) { const int q = t + 256 * i, kr = q >> 5, nq = q & 31; v[i] = *(const float4*)(src + (size_t)(k0 + kr) * ld_src + n0 + nq * 4); }
#pragma unroll
    for (int i = 0; i < 8; ++i) {
        const int q = t + 256 * i, kr = q >> 5, nq = q & 31;
        float sc = 1.f;
        if (scale && (k0 + kr) < scale_kmax) sc = scale[k0 + kr];
        float* p = tile + kr * 129 + nq * 4;
        p[0] = v[i].x * sc; p[1] = v[i].y * sc; p[2] = v[i].z * sc; p[3] = v[i].w * sc;
    }
    __syncthreads();
#pragma unroll
    for (int i = 0; i < 4; ++i) {
        const int q = t + 256 * i, nn = q >> 3, kc = q & 7;
        const float* p = tile + (kc * 8) * 129 + nn;
        uint4 o;
        o.x = pack2(p[0], p[129]); o.y = pack2(p[258], p[387]); o.z = pack2(p[516], p[645]); o.w = pack2(p[774], p[903]);
        *(uint4*)(dst + (dst_row0 + nn) * (size_t)ld_dst + k0 + kc * 8) = o;
    }
    __syncthreads();
}

namespace g8 {
constexpr int BM = 256, BK = 64, HALF = 128, HTB = HALF * BK * 2, STAGE_BYTES = 8 * HTB;
__device__ __forceinline__ int lds_byte(int r, int c) { const int st = (r >> 4) * 2 + (c >> 5), rr = r & 15, cc = c & 31, ob = rr * 64 + cc * 2; return st * 1024 + (ob ^ (((ob >> 9) & 1) << 5)); }
__device__ __forceinline__ void stage_rc(int b, int& R, int& C) { const int st = b / 1024, sb = b % 1024, swz = sb ^ (((sb >> 9) & 1) << 5); R = (st >> 1) * 16 + swz / 64; C = (st & 1) * 32 + (swz % 64) / 2; }
__device__ __forceinline__ int perm32(int rho) { const int n = rho >> 4, i = rho & 15; return 8 * (i >> 2) + 4 * n + (i & 3); }
__device__ __forceinline__ unsigned cvt_pk_bf16(float lo, float hi) { unsigned r; asm volatile("v_cvt_pk_bf16_f32 %0, %1, %2" : "=v"(r) : "v"(lo), "v"(hi)); return r; }
typedef f32x4 Acc[2][2][4][2];

template <class Prob>
__device__ __forceinline__ int gemm_phase(LAS unsigned char* lds, const Prob& S, int i0 = 0) {
    const int tid = threadIdx.x, wid = __builtin_amdgcn_readfirstlane(tid >> 6), lane = tid & 63, wr = wid >> 2, wc = wid & 3, fr = lane & 15, fq = lane >> 4;
    int nt = 0;
    const size_t kstep = (size_t)(BK * 2);
    const unsigned ldsw = (unsigned)wid * 1024u;
    const int aoff = lds_byte(wr * 64 + fr, fq * 8), boff = lds_byte(wc * 32 + fr, fq * 8);
#define G8_SA(b, h) (((b) * 2 + (h)) * HTB)
#define G8_SB(b, h) ((4 + (b) * 2 + (h)) * HTB)
#define G8_STAGE(bufoff, gbase, voff) do { _Pragma("unroll") for (int _i = 0; _i < 2; ++_i) \
        __builtin_amdgcn_global_load_lds((const unsigned*)((const char*)(gbase) + (voff)[_i]), (LAS unsigned*)(lds + (bufoff) + ldsw + _i * 8192), 16, 0, 0); } while (0)
#define G8_LDA(dst, b, h) do { _Pragma("unroll") for (int m = 0; m < 4; ++m) _Pragma("unroll") for (int k = 0; k < 2; ++k) dst[m][k] = *(const LAS bf16x8*)(lds + G8_SA(b, h) + aoff + m * 2048 + k * 1024); } while (0)
#define G8_LDB(dst, b, h) do { _Pragma("unroll") for (int n = 0; n < 2; ++n) _Pragma("unroll") for (int k = 0; k < 2; ++k) dst[n][k] = *(const LAS bf16x8*)(lds + G8_SB(b, h) + boff + n * 2048 + k * 1024); } while (0)
#define G8_MMA(ai, bj, At, Bt) do { __builtin_amdgcn_s_setprio(1); _Pragma("unroll") for (int m = 0; m < 4; ++m) _Pragma("unroll") for (int n = 0; n < 2; ++n) _Pragma("unroll") for (int k = 0; k < 2; ++k) \
        acc[ai][bj][m][n] = __builtin_amdgcn_mfma_f32_16x16x32_bf16(Bt[n][k], At[m][k], acc[ai][bj][m][n], 0, 0, 0); __builtin_amdgcn_s_setprio(0); } while (0)
#define G8_WAIT_V(n) asm volatile("s_waitcnt vmcnt(" #n ")" ::: "memory")
#define G8_WAIT_L(n) asm volatile("s_waitcnt lgkmcnt(" #n ")" ::: "memory")
#define G8_BAR __builtin_amdgcn_s_barrier()
#define G8_SCHED __builtin_amdgcn_sched_barrier(0)
    typename Prob::Unit cur, nxt; int ui = i0; bool stopped = false;
    if (!S.next(i0, cur)) return -1;
    nt = S.nt(cur);
    S.a_ready(cur);
    Acc acc;
#pragma unroll
    for (int a = 0; a < 2; ++a)
#pragma unroll
        for (int b = 0; b < 2; ++b)
#pragma unroll
            for (int m = 0; m < 4; ++m)
#pragma unroll
                for (int n = 0; n < 2; ++n) acc[a][b][m][n] = (f32x4){0.f, 0.f, 0.f, 0.f};
    bf16x8 At[4][2], B0[2][2], B1[2][2];
    unsigned cOA[2][2], cOB[2][2], nOA[2][2], nOB[2][2];
    S.offs(cur, tid, cOA, cOB);
    const char* cA = S.baseA(cur); const char* cB = S.baseB(cur);
    G8_STAGE(G8_SB(0, 0), cB, cOB[0]); G8_STAGE(G8_SA(0, 0), cA, cOA[0]); G8_STAGE(G8_SB(0, 1), cB, cOB[1]); G8_STAGE(G8_SA(0, 1), cA, cOA[1]);
    if (wr == 1) G8_BAR;
    G8_WAIT_V(4); G8_BAR;
    G8_STAGE(G8_SB(1, 0), cB + kstep, cOB[0]); G8_STAGE(G8_SA(1, 0), cA + kstep, cOA[0]); G8_STAGE(G8_SB(1, 1), cB + kstep, cOB[1]);
    G8_WAIT_V(6); G8_BAR;
    for (;;) {
        bool has_next = S.next(ui + 1, nxt);
        if (has_next && S.brk(cur, nxt)) { has_next = false; stopped = true; }
        const char* nA = cA; const char* nB = cB;
#pragma unroll
        for (int h = 0; h < 2; ++h)
#pragma unroll
            for (int i = 0; i < 2; ++i) { nOA[h][i] = cOA[h][i]; nOB[h][i] = cOB[h][i]; }
        if (has_next) { S.offs(nxt, tid, nOA, nOB); nA = S.baseA(nxt); nB = S.baseB(nxt); }
#pragma unroll 1
        for (int t = 0; t < nt; t += 2) {
            const bool last = (t == nt - 2);
            if (Prob::MIDT > 0 && t == Prob::MIDT) S.mid(acc, cur, wr, fr);
            if (last && has_next) S.a_ready(nxt);
            const char* a1 = cA + (size_t)(t + 1) * kstep;
            const char* a2 = last ? nA : cA + (size_t)(t + 2) * kstep; const char* b2 = last ? nB : cB + (size_t)(t + 2) * kstep;
            const char* a3 = a2 + kstep; const char* b3 = b2 + kstep;
            unsigned xA[2][2], xB[2][2];
#pragma unroll
            for (int h = 0; h < 2; ++h)
#pragma unroll
                for (int i = 0; i < 2; ++i) { xA[h][i] = last ? nOA[h][i] : cOA[h][i]; xB[h][i] = last ? nOB[h][i] : cOB[h][i]; }
            G8_LDB(B0, 0, 0); G8_SCHED; G8_LDA(At, 0, 0); G8_STAGE(G8_SA(1, 1), a1, cOA[1]);
            G8_WAIT_L(8); G8_BAR; G8_WAIT_L(0); G8_MMA(0, 0, At, B0); G8_BAR; G8_SCHED;
            G8_LDB(B1, 0, 1); G8_STAGE(G8_SB(0, 0), b2, xB[0]);
            G8_BAR; G8_WAIT_L(0); G8_MMA(0, 1, At, B1); G8_BAR;
            G8_LDA(At, 0, 1); G8_STAGE(G8_SA(0, 0), a2, xA[0]);
            G8_BAR; G8_WAIT_L(0); G8_MMA(1, 0, At, B0); G8_BAR; G8_SCHED;
            G8_STAGE(G8_SB(0, 1), b2, xB[1]);
            G8_WAIT_V(6); G8_BAR; G8_MMA(1, 1, At, B1); G8_BAR;
            G8_LDB(B0, 1, 0); G8_SCHED; G8_LDA(At, 1, 0); G8_STAGE(G8_SA(0, 1), a2, xA[1]);
            G8_WAIT_L(8); G8_BAR; G8_WAIT_L(0); G8_MMA(0, 0, At, B0); G8_BAR; G8_SCHED;
            G8_LDB(B1, 1, 1); G8_STAGE(G8_SB(1, 0), b3, xB[0]);
            G8_BAR; G8_WAIT_L(0); G8_MMA(0, 1, At, B1); G8_BAR;
            G8_LDA(At, 1, 1); G8_STAGE(G8_SA(1, 0), a3, xA[0]);
            G8_BAR; G8_WAIT_L(0); G8_MMA(1, 0, At, B0); G8_BAR; G8_SCHED;
            G8_STAGE(G8_SB(1, 1), b3, xB[1]);
            G8_WAIT_V(6); G8_BAR; G8_MMA(1, 1, At, B1); G8_BAR;
        }
        S.epi(acc, cur, wr, wc, fr, fq);
        S.done(cur);
        if (!has_next) break;
#pragma unroll
        for (int a = 0; a < 2; ++a)
#pragma unroll
            for (int b = 0; b < 2; ++b)
#pragma unroll
                for (int m = 0; m < 4; ++m)
#pragma unroll
                    for (int n = 0; n < 2; ++n) acc[a][b][m][n] = (f32x4){0.f, 0.f, 0.f, 0.f};
        cur = nxt; cA = nA; cB = nB; ++ui; nt = S.nt(cur);
#pragma unroll
        for (int h = 0; h < 2; ++h)
#pragma unroll
            for (int i = 0; i < 2; ++i) { cOA[h][i] = nOA[h][i]; cOB[h][i] = nOB[h][i]; }
    }
    G8_WAIT_V(0);
    if (wr == 0) G8_BAR;
    G8_BAR;
    const int ret_next = stopped ? ui + 1 : -1;
#undef G8_SA
#undef G8_SB
#undef G8_STAGE
#undef G8_LDA
#undef G8_LDB
#undef G8_MMA
#undef G8_WAIT_V
#undef G8_WAIT_L
#undef G8_BAR
#undef G8_SCHED
    return ret_next;
}
__device__ __forceinline__ void dense_unit(int wgid, int nM, int nN, int& pm, int& pn) {
    const int nwg = nM * nN, NXCD = 8, WGM = 8;
    { const int q = nwg / NXCD, r = nwg % NXCD, xcd = wgid % NXCD, off = wgid / NXCD; wgid = (xcd < r ? xcd * (q + 1) : r * (q + 1) + (xcd - r) * q) + off; }
    const int nig = WGM * nN, gid = wgid / nig, fm = gid * WGM, gsz = (nM - fm) < WGM ? (nM - fm) : WGM;
    pm = fm + ((wgid % nig) % gsz); pn = (wgid % nig) / gsz;
}
}

__device__ void phase0(const Params& P, char* lds_all) {
    unsigned char* ws = P.ws;
    const int vb = threadIdx.x >> 8, t = threadIdx.x & 255;
    char* lds = lds_all + vb * VLDS;
    float* tile = (float*)lds;
    const int NU = 744;
    for (int u = blockIdx.x * 2 + vb; u < NU; u += gridDim.x * 2) {
        if (u < 384) {
            int nt, v, n0b, drb;
            if (u < 192) { v = u; n0b = 0; drb = 0; }
            else if (u < 256) { v = u - 192; n0b = 1552; drb = 1536; }
            else if (u < 320) { v = u - 256; n0b = 2576; drb = 2048; }
            else { v = u - 320; n0b = 2064; drb = 2816; }
            nt = v >> 4;
            transpose_tile_w(tile, P.in[I_WIN], 3104, (v & 15) * 64, n0b + nt * 128, (u16*)(ws + O_WIN), drb + nt * 128, 1024, nullptr, 0, t);
        } else if (u < 416) {
            const int v = u - 384;
            if (v < 16) transpose_tile(tile, P.in[I_WIN], 3104, v * 64, 1536, 16, (u16*)(ws + O_WIN), 2560, 1024, nullptr, 0, t);
            else transpose_tile(tile, P.in[I_WIN], 3104, (v - 16) * 64, 3088, 16, (u16*)(ws + O_WIN), 2576, 1024, nullptr, 0, t);
        } else if (u < 544) {
            const int v = u - 416, nt = v >> 4;
            transpose_tile_w(tile, P.in[I_WOUT], 1024, (v & 15) * 64, nt * 128, (u16*)(ws + O_WOUT), nt * 128, 1024, P.in[I_SNW], 512, t);
        } else if (u < 552) {
            const int base = (u - 544) * 4096;
            for (int i = 0; i < 16; ++i) {
                const int idx = base + t + 256 * i;
                if (idx < 224 * 128) *(uint4*)(ws + O_WIN + ((size_t)(2592 + (idx >> 7)) * 1024 + (idx & 127) * 8) * 2) = make_uint4(0, 0, 0, 0);
            }
        } else {
            const int c0 = (u - 552) * 32;
            float* sc = (float*)lds;
            float* red = sc + 5 * 1024;
            for (int i = t; i < 5 * 1024; i += 256) {
                const int r = i >> 10, k = i & 1023;
                const float v = r < 4 ? P.in[I_C][r * 1024 + k] : P.in[I_CCTX][k];
                sc[i] = siluf(v);
            }
            __syncthreads();
            const int cq = t & 7, kg = t >> 3;
            float4 a0 = {0, 0, 0, 0}, a1 = a0, a2 = a0, a3 = a0, a4 = a0;
            const float* wp = P.in[I_WMOD] + (size_t)(kg * 32) * 6144 + c0 + cq * 4;
#pragma unroll 1
            for (int kb = 0; kb < 32; kb += 16) {
                f32x4 wvv[16];
#pragma unroll
                for (int k = 0; k < 16; ++k) wvv[k] = *(const f32x4*)(wp + (size_t)(kb + k) * 6144);
                __builtin_amdgcn_sched_barrier(0);
#pragma unroll
                for (int k = 0; k < 16; ++k) {
                    const f32x4 wv = wvv[k];
                    const int kk = kg * 32 + kb + k;
                    const float s0 = sc[kk], s1 = sc[1024 + kk], s2 = sc[2048 + kk], s3 = sc[3072 + kk], s4 = sc[4096 + kk];
                    a0.x += s0 * wv[0]; a0.y += s0 * wv[1]; a0.z += s0 * wv[2]; a0.w += s0 * wv[3];
                    a1.x += s1 * wv[0]; a1.y += s1 * wv[1]; a1.z += s1 * wv[2]; a1.w += s1 * wv[3];
                    a2.x += s2 * wv[0]; a2.y += s2 * wv[1]; a2.z += s2 * wv[2]; a2.w += s2 * wv[3];
                    a3.x += s3 * wv[0]; a3.y += s3 * wv[1]; a3.z += s3 * wv[2]; a3.w += s3 * wv[3];
                    a4.x += s4 * wv[0]; a4.y += s4 * wv[1]; a4.z += s4 * wv[2]; a4.w += s4 * wv[3];
                }
                __builtin_amdgcn_sched_barrier(0);
            }
            *(float4*)(red + ((kg * 5 + 0) * 32) + cq * 4) = a0; *(float4*)(red + ((kg * 5 + 1) * 32) + cq * 4) = a1;
            *(float4*)(red + ((kg * 5 + 2) * 32) + cq * 4) = a2; *(float4*)(red + ((kg * 5 + 3) * 32) + cq * 4) = a3;
            *(float4*)(red + ((kg * 5 + 4) * 32) + cq * 4) = a4;
            __syncthreads();
            if (t < 160) {
                const int r = t >> 5, cc = t & 31;
                float s = P.in[I_BMOD][c0 + cc];
#pragma unroll
                for (int g = 0; g < 32; ++g) s += red[(g * 5 + r) * 32 + cc];
                ((float*)(ws + O_MOD))[r * 6144 + c0 + cc] = s;
            }
            __syncthreads();
        }
    }
    if (blockIdx.x == 0 && threadIdx.x < 32) ((int*)(ws + O_CNT))[threadIdx.x * 64] = 0;
}

__device__ void phase1(const Params& P) {
    unsigned char* ws = P.ws;
    const int lane = threadIdx.x & 63;
    const int gw = blockIdx.x * 8 + (threadIdx.x >> 6), nw = gridDim.x * 8;
    const float* mod = (const float*)(ws + O_MOD);
    u16* xn = (u16*)(ws + O_XN);
    const int r_lo = (int)(((long long)gw * MALL) / nw), r_hi = (int)(((long long)(gw + 1) * MALL) / nw);
    float4 mul[4], sh[4];
    int cur_mb = -1;
    for (int row = r_lo; row < r_hi; row += 2) {
        const bool two = row + 1 < r_hi;
        const int row1 = two ? row + 1 : row;
        const float* x0 = row < MLAT ? P.in[I_X] + (size_t)row * 1024 : P.in[I_CTX] + (size_t)(row - MLAT) * 1024;
        const float* x1 = row1 < MLAT ? P.in[I_X] + (size_t)row1 * 1024 : P.in[I_CTX] + (size_t)(row1 - MLAT) * 1024;
        float4 v0[4], v1[4];
#pragma unroll
        for (int j = 0; j < 4; ++j) { v0[j] = ((const float4*)x0)[lane + 64 * j]; v1[j] = ((const float4*)x1)[lane + 64 * j]; }
        const int mb0 = row < MLAT ? (row >> 12) : 4, mb1 = row1 < MLAT ? (row1 >> 12) : 4;
        float s0 = 0.f, s1 = 0.f;
#pragma unroll
        for (int j = 0; j < 4; ++j) {
            s0 += v0[j].x * v0[j].x + v0[j].y * v0[j].y + v0[j].z * v0[j].z + v0[j].w * v0[j].w;
            s1 += v1[j].x * v1[j].x + v1[j].y * v1[j].y + v1[j].z * v1[j].z + v1[j].w * v1[j].w;
        }
        s0 = rsqrtf(wave_sum(s0) * (1.f / 1024.f) + 1e-6f);
        s1 = rsqrtf(wave_sum(s1) * (1.f / 1024.f) + 1e-6f);
#pragma unroll 1
        for (int rr = 0; rr < 2; ++rr) {
            const int mb = rr ? mb1 : mb0;
            if (mb != cur_mb) {
                cur_mb = mb;
#pragma unroll
                for (int j = 0; j < 4; ++j) {
                    const int k = (lane + 64 * j) * 4;
                    const float4 nwv = *(const float4*)(P.in[I_N1W] + k);
                    const float4 sc = *(const float4*)(mod + mb * 6144 + 1024 + k);
                    sh[j] = *(const float4*)(mod + mb * 6144 + k);
                    mul[j].x = nwv.x * (1.f + sc.x); mul[j].y = nwv.y * (1.f + sc.y); mul[j].z = nwv.z * (1.f + sc.z); mul[j].w = nwv.w * (1.f + sc.w);
                }
            }
            if (rr == 1 && !two) break;
            const float rstd = rr ? s1 : s0;
            const int orow = rr ? row1 : row;
#pragma unroll
            for (int j = 0; j < 4; ++j) {
                const int k = (lane + 64 * j) * 4;
                const float4 vv = rr ? v1[j] : v0[j];
                uint2 o;
                o.x = pack2(vv.x * rstd * mul[j].x + sh[j].x, vv.y * rstd * mul[j].y + sh[j].y);
                o.y = pack2(vv.z * rstd * mul[j].z + sh[j].z, vv.w * rstd * mul[j].w + sh[j].w);
                *(uint2*)(xn + (size_t)orow * 1024 + k) = o;
            }
        }
    }
}

struct InProj {
    static constexpr int K = 1024; static constexpr bool PERM = true; static constexpr int MIDT = 0;
    struct Unit { int pm, pn, vt; };
    const unsigned char* ws; int G, c;
    __device__ __forceinline__ bool next(int i, Unit& u) const {
        const int L = i * G + c;
        if (L >= 884) return false;
        if (L < 748) { u.vt = 0; g8::dense_unit(L, 68, 11, u.pm, u.pn); }
        else { const int v = L - 748; u.vt = 1; u.pm = v / 68; u.pn = v % 68; }
        return true;
    }
    __device__ __forceinline__ const char* baseA(const Unit& u) const { return (const char*)(ws + (u.vt ? O_WIN : O_XN)); }
    __device__ __forceinline__ const char* baseB(const Unit& u) const { return (const char*)(ws + (u.vt ? O_XN : O_WIN)); }
    __device__ __forceinline__ void offs(const Unit& u, int tid_, unsigned (&oa)[2][2], unsigned (&ob)[2][2]) const {
        int R[2], C[2];
        { int tq = tid_; asm volatile("" : "+v"(tq)); g8::stage_rc(tq * 16, R[0], C[0]); g8::stage_rc(tq * 16 + 8192, R[1], C[1]); }
#pragma unroll
        for (int h = 0; h < 2; ++h)
#pragma unroll
            for (int i = 0; i < 2; ++i) {
                const int Rb = (R[i] & ~31) + g8::perm32(R[i] & 31);
                if (!u.vt) {
                    int ar = u.pm * 256 + h * 128 + R[i];
                    if (u.pn == 6 || u.pn == 7) ar = colmajor_src_row(ar);
                    oa[h][i] = (unsigned)(ar * 1024 + C[i]) * 2u;
                    ob[h][i] = (unsigned)((u.pn * 256 + h * 128 + Rb) * 1024 + C[i]) * 2u;
                } else {
                    oa[h][i] = (unsigned)((2816 + u.pm * 256 + h * 128 + R[i]) * 1024 + C[i]) * 2u;
                    ob[h][i] = (unsigned)(colmajor_src_row(u.pn * 256 + h * 128 + Rb) * 1024 + C[i]) * 2u;
                }
            }
    }
    __device__ __forceinline__ void mid(g8::Acc&, const Unit&, int, int) const {}
    __device__ __forceinline__ int nt(const Unit&) const { return 16; }
    __device__ __forceinline__ bool brk(const Unit&, const Unit&) const { return false; }
    __device__ __forceinline__ void a_ready(const Unit&) const {}
    __device__ __forceinline__ void done(const Unit&) const {}
    __device__ __forceinline__ void epi(g8::Acc& acc, const Unit& u, int wr, int wc, int fr, int fq) const {
        unsigned char* w = (unsigned char*)ws;
        const int row0 = u.pm * 256 + wr * 64 + fr;
        const int col0 = wc * 32 + 8 * fq;
        if (u.vt) {
            const int tok0 = u.pn * 256 + col0;
#pragma unroll
            for (int ai = 0; ai < 2; ++ai)
#pragma unroll
                for (int m = 0; m < 4; ++m) {
                    const int ch = row0 + ai * 128 + m * 16;
#pragma unroll
                    for (int bj = 0; bj < 2; ++bj) {
                        const int tk = tok0 + bj * 128;
                        u16* d;
                        int ctile, lw;
                        if (tk < MLAT) { ctile = (tk >> 12) * NCH + 2 + ((tk & 4095) >> 7); lw = tk & 127; }
                        else { const int tc = tk - MLAT; ctile = (tc >> 8) * NCH + ((tc & 255) >> 7); lw = tc & 127; }
                        d = (u16*)(w + O_VT) + ((size_t)ctile * 512 + ch) * 128 + lw;
                        const f32x4 v0 = acc[ai][bj][m][0], v1 = acc[ai][bj][m][1];
                        u32x4 o; o.x = g8::cvt_pk_bf16(v0[0], v0[1]); o.y = g8::cvt_pk_bf16(v0[2], v0[3]); o.z = g8::cvt_pk_bf16(v1[0], v1[1]); o.w = g8::cvt_pk_bf16(v1[2], v1[3]);
                        *(u32x4*)d = o;
                    }
                }
            return;
        }
        if (u.pn == 10) {
            if (wc == 0) {
                float* dst = (float*)(w + (fq < 2 ? O_PSD : O_PSG)) + (fq & 1) * 8;
#pragma unroll
                for (int ai = 0; ai < 2; ++ai)
#pragma unroll
                    for (int m = 0; m < 4; ++m) {
                        float* d = dst + (size_t)(row0 + ai * 128 + m * 16) * 16;
                        *(f32x4*)d = acc[ai][0][m][0];
                        *(f32x4*)(d + 4) = acc[ai][0][m][1];
                    }
            }
            return;
        }
        u16* base; size_t ld, bjstep;
        if (u.pn < 2) { base = (u16*)(w + O_ZO) + u.pn * 256 + col0; ld = 1024; bjstep = 128; }
        else if (u.pn < 8) {
            const int cg0 = (u.pn - 2) * 4 + (col0 >> 6);
            base = (u16*)(w + O_PT) + (size_t)cg0 * MALL * 64 + (col0 & 63); ld = 64; bjstep = (size_t)2 * MALL * 64;
        }
        else { base = (u16*)(w + O_ZO) + 512 + (u.pn - 8) * 256 + col0; ld = 1024; bjstep = 128; }
#pragma unroll
        for (int ai = 0; ai < 2; ++ai)
#pragma unroll
            for (int m = 0; m < 4; ++m) {
                u16* rowp = base + (size_t)(row0 + ai * 128 + m * 16) * ld;
#pragma unroll
                for (int bj = 0; bj < 2; ++bj) {
                    const f32x4 v0 = acc[ai][bj][m][0], v1 = acc[ai][bj][m][1];
                    u32x4 o; o.x = g8::cvt_pk_bf16(v0[0], v0[1]); o.y = g8::cvt_pk_bf16(v0[2], v0[3]); o.z = g8::cvt_pk_bf16(v1[0], v1[1]); o.w = g8::cvt_pk_bf16(v1[2], v1[3]);
                    *(u32x4*)(rowp + bj * bjstep) = o;
                }
            }
    }
};

__device__ void phase3(const Params& P, char* lds_all) {
    unsigned char* ws = P.ws;
    const int vb = threadIdx.x >> 8, t = threadIdx.x & 255;
    char* lds = lds_all + vb * VLDS;
    u16* raw = (u16*)lds;
    float* xcl = (float*)(lds + 132 * 128);
    const u16* pt = (const u16*)(ws + O_PT);
    const int NCONV = 136 * 24;
    for (int ct = blockIdx.x * 2 + vb; ct < 136; ct += gridDim.x * 2) {
        const int b = ct / NCH, cc = ct % NCH;
        const int rb = cc < 2 ? MLAT + b * 256 + cc * 128 : b * 4096 + (cc - 2) * 128;
        const int row = rb + (t >> 1), half = t & 1;
        const float* psd = (const float*)(ws + O_PSD) + (size_t)row * 16 + half * 8;
        float* dt = (float*)(ws + O_DT) + (size_t)row * 16 + half * 8;
        const float4 pa = *(const float4*)psd, pb = *(const float4*)(psd + 4);
        const float* psg = (const float*)(ws + O_PSG) + (size_t)colmajor_src_row(row) * 16 + half * 8;
        const float4 ga = *(const float4*)psg, gb = *(const float4*)(psg + 4);
        const float pv[8] = {pa.x, pa.y, pa.z, pa.w, pb.x, pb.y, pb.z, pb.w}, gv[8] = {ga.x, ga.y, ga.z, ga.w, gb.x, gb.y, gb.z, gb.w};
        const float4 db0 = *(const float4*)(P.in[I_DTB] + half * 8), db1 = *(const float4*)(P.in[I_DTB] + half * 8 + 4);
        const float4 gb0 = *(const float4*)(P.in[I_GB] + half * 8), gb1 = *(const float4*)(P.in[I_GB] + half * 8 + 4);
        const float dbv[8] = {db0.x, db0.y, db0.z, db0.w, db1.x, db1.y, db1.z, db1.w}, gbv[8] = {gb0.x, gb0.y, gb0.z, gb0.w, gb1.x, gb1.y, gb1.z, gb1.w};
        float od[8], og[8];
#pragma unroll
        for (int j = 0; j < 8; ++j) {
            od[j] = softplusf(pv[j] + dbv[j]);
            const float xx = gv[j] + gbv[j];
            og[j] = half == 0 ? xx : fminf(xx, 0.f) - log1pf(__expf(-fabsf(xx)));
        }
        *(float4*)dt = make_float4(od[0], od[1], od[2], od[3]); *(float4*)(dt + 4) = make_float4(od[4], od[5], od[6], od[7]);
        float* gout = (float*)(ws + (half == 0 ? O_GI : O_GF)) + (size_t)row * 8;
        *(float4*)gout = make_float4(og[0], og[1], og[2], og[3]); *(float4*)(gout + 4) = make_float4(og[4], og[5], og[6], og[7]);
    }
    u32x4 rr[5];
#define P3_PREFETCH(uu) do { \
        const int _u = (uu), _ct = _u / 24, _cg = _u % 24, _b = _ct / NCH, _cc = _ct % NCH; const bool _ctx = _cc < 2; \
        const int _L = _ctx ? 256 : 4096, _lpos = _ctx ? _cc * 128 : (_cc - 2) * 128, _rb = _ctx ? MLAT + _b * 256 + _cc * 128 : _b * 4096 + (_cc - 2) * 128, _sb = _rb - _lpos; \
        _Pragma("unroll") for (int _i = 0; _i < 5; ++_i) { const int _q = t + 256 * _i, _r = (_q >> 3) < 132 ? (_q >> 3) : 131, _c = _q & 7; \
            const int _l = _lpos - 2 + _r, _lc = _l < 0 ? 0 : (_l >= _L ? _L - 1 : _l); \
            u32x4 _v = *(const u32x4*)(pt + ((size_t)_cg * MALL + _sb + _lc) * 64 + _c * 8); \
            if (_l != _lc) _v = (u32x4){0u, 0u, 0u, 0u}; \
            rr[_i] = _v; } \
    } while (0)
    if ((int)(blockIdx.x * 2 + vb) < NCONV) P3_PREFETCH(blockIdx.x * 2 + vb);
    for (int u = blockIdx.x * 2 + vb; u < NCONV; u += gridDim.x * 2) {
        const int ct = u / 24, cgp = u % 24;
        const int b = ct / NCH, cc = ct % NCH;
        const bool isctx = cc < 2;
        const int rb = isctx ? MLAT + b * 256 + cc * 128 : b * 4096 + (cc - 2) * 128;
        const bool isml = cgp >= 16;
#pragma unroll
        for (int i = 0; i < 5; ++i) { const int q = t + 256 * i; if (q < 132 * 8) *(u32x4*)(raw + (q >> 3) * 64 + (q & 7) * 8) = rr[i]; }
        __syncthreads();
        if (u + (int)gridDim.x * 2 < NCONV) P3_PREFETCH(u + gridDim.x * 2);
        const int ch = t & 63, tg = t >> 6;
        const float* cw = isml ? P.in[I_MCW] + (cgp - 16) * 64 + ch : P.in[I_SCW] + cgp * 64 + ch;
        const int cwld = isml ? 512 : 1024;
        const float w0 = cw[0], w1 = cw[cwld], w2 = cw[2 * cwld], w3 = cw[3 * cwld], w4 = cw[4 * cwld];
        const float bias = isml ? P.in[I_MCB][(cgp - 16) * 64 + ch] : P.in[I_SCB][cgp * 64 + ch];
        const int tok0 = tg * 32;
        float x0 = bf2f(raw[(tok0 + 0) * 64 + ch]), x1 = bf2f(raw[(tok0 + 1) * 64 + ch]), x2 = bf2f(raw[(tok0 + 2) * 64 + ch]), x3 = bf2f(raw[(tok0 + 3) * 64 + ch]);
        if (!isml) {
            float ov[32];
#pragma unroll
            for (int j = 0; j < 32; ++j) {
                const float x4 = bf2f(raw[(tok0 + j + 4) * 64 + ch]);
                const float cv = bias + w0 * x0 + w1 * x1 + w2 * x2 + w3 * x3 + w4 * x4;
                ov[j] = siluf(cv);
                x0 = x1; x1 = x2; x2 = x3; x3 = x4;
            }
            if (cgp < 12) {
                const int chg = cgp < 8 ? cgp * 64 + ch : (cgp - 8) * 64 + ch;
                u16* tdst = cgp < 8 ? (u16*)(ws + O_XT) + ((size_t)ct * 512 + chg) * 128 + tok0 : (u16*)(ws + O_BT) + ((size_t)ct * 256 + chg) * 128 + tok0;
#pragma unroll
                for (int o8 = 0; o8 < 4; ++o8) {
                    u32x4 o; o.x = pack2(ov[o8 * 8 + 0], ov[o8 * 8 + 1]); o.y = pack2(ov[o8 * 8 + 2], ov[o8 * 8 + 3]); o.z = pack2(ov[o8 * 8 + 4], ov[o8 * 8 + 5]); o.w = pack2(ov[o8 * 8 + 6], ov[o8 * 8 + 7]);
                    *(u32x4*)(tdst + o8 * 8) = o;
                }
            }
            if (cgp >= 8) {
                const int gn = (cgp < 12 ? cgp - 8 : cgp - 12) * 64 + ch;
                u16* ndst = (u16*)(ws + (cgp < 12 ? O_BM : O_CM)) + ((size_t)ct * 2 + (gn >> 7)) * 16384 + (size_t)tok0 * 128 + (gn & 127);
#pragma unroll
                for (int j = 0; j < 32; ++j) ndst[(size_t)j * 128] = f2bf(ov[j]);
            }
            __syncthreads();
        } else {
            const int mg = cgp - 16;
            const int n = ch >> 2, kk = ch & 3, ng = mg * 16 + n;
            const float* wq = P.in[I_WQK] + ((size_t)(0 * 128 + ng) * 4) * 4 + kk;
            const float* wk = P.in[I_WQK] + ((size_t)(1 * 128 + ng) * 4) * 4 + kk;
            const float q0 = wq[0], q1 = wq[4], q2 = wq[8], q3 = wq[12];
            const float k0 = wk[0], k1 = wk[4], k2 = wk[8], k3 = wk[12];
            u16* xcd = (u16*)(ws + O_XC) + ((size_t)ct * 4 + (mg >> 1)) * 16384 + (size_t)tok0 * 128 + (mg & 1) * 64 + ch;
#pragma unroll 8
            for (int j = 0; j < 32; ++j) {
                const int tok = tok0 + j;
                const float x4 = bf2f(raw[(tok + 4) * 64 + ch]);
                const float cv = bias + w0 * x0 + w1 * x1 + w2 * x2 + w3 * x3 + w4 * x4;
                const float sv = siluf(cv);
                xcl[tok * 64 + ch] = sv;
                xcd[(size_t)j * 128] = f2bf(sv);
                x0 = x1; x1 = x2; x2 = x3; x3 = x4;
            }
            __syncthreads();
            const int chg = mg * 64 + ch;
            const size_t hoff = ((size_t)ct * 4 + (mg >> 1)) * 16384 + (size_t)tok0 * 128 + (mg & 1) * 64 + ch;
            u16* qd = (u16*)(ws + O_Q) + hoff;
            u16* kd = (u16*)(ws + O_K) + hoff;
            u16* ktd = (u16*)(ws + O_KT) + ((size_t)ct * 512 + chg) * 128 + tok0;
#pragma unroll
            for (int o8 = 0; o8 < 4; ++o8) {
                float kv[8];
#pragma unroll
                for (int j = 0; j < 8; ++j) {
                    const int tok = tok0 + o8 * 8 + j;
                    const float4 xv = *(const float4*)(xcl + tok * 64 + n * 4);
                    const float qv = xv.x * q0 + xv.y * q1 + xv.z * q2 + xv.w * q3;
                    kv[j] = (xv.x * k0 + xv.y * k1 + xv.z * k2 + xv.w * k3) * 0.08838834764831845f;
                    qd[(size_t)(o8 * 8 + j) * 128] = f2bf(qv);
                    kd[(size_t)(o8 * 8 + j) * 128] = f2bf(kv[j]);
                }
                uint4 o; o.x = pack2(kv[0], kv[1]); o.y = pack2(kv[2], kv[3]); o.z = pack2(kv[4], kv[5]); o.w = pack2(kv[6], kv[7]);
                *(uint4*)(ktd + o8 * 8) = o;
            }
            __syncthreads();
        }
    }
}

__device__ __forceinline__ u32x4 scale8(const u32x4 v, const float* ww) {
    u32x4 o;
    o.x = pack2(bflo(v.x) * ww[0], bfhi(v.x) * ww[1]); o.y = pack2(bflo(v.y) * ww[2], bfhi(v.y) * ww[3]);
    o.z = pack2(bflo(v.z) * ww[4], bfhi(v.z) * ww[5]); o.w = pack2(bflo(v.w) * ww[6], bfhi(v.w) * ww[7]);
    return o;
}
__device__ void phase4(const Params& P, char* lds) {
    unsigned char* ws = P.ws;
    char* T0 = lds; char* T1 = lds + 32768;
    float* sc = (float*)(lds + 65536);
    float* wA = sc + 256;
    float* wB = sc + 384;
    const int NSSD = 4 * NCH * 8, NML = 4 * NCH * 4, NU4 = NSSD + NML;
    u32x4 RA[4], RB[4];
    float ps0 = 0.f, ps1 = 0.f, ps2 = 0.f, ps3 = 0.f;
#define P4_PREFETCH(uu) do { \
        const int _u = (uu); const bool _ssd = _u < NSSD; const int _v = _ssd ? _u : _u - NSSD; \
        const int _h = _ssd ? (_v & 7) : (_v & 3), _ct = _ssd ? (_v >> 3) : (_v >> 2), _b = _ct / NCH, _cc = _ct % NCH; \
        const int _rb = _cc < 2 ? MLAT + _b * 256 + _cc * 128 : _b * 4096 + (_cc - 2) * 128; \
        const u16* _pa = _ssd ? (const u16*)(ws + O_XT) + ((size_t)_ct * 512 + _h * 64) * 128 : (const u16*)(ws + O_VT) + ((size_t)_ct * 512 + _h * 128) * 128; \
        const u16* _pb = _ssd ? (const u16*)(ws + O_BT) + ((size_t)_ct * 256 + (_h >> 2) * 128) * 128 : (const u16*)(ws + O_KT) + ((size_t)_ct * 512 + _h * 128) * 128; \
        _Pragma("unroll") for (int _i = 0; _i < 4; ++_i) { const int _q = (int)threadIdx.x + 512 * _i; const size_t _o = (size_t)(_q >> 4) * 128 + (_q & 15) * 8; \
            RA[_i] = *(const u32x4*)(_pa + _o); RB[_i] = *(const u32x4*)(_pb + _o); } \
        if (threadIdx.x < 128) { const int _dir = threadIdx.x >> 6, _ln = threadIdx.x & 63; const int _l0 = _dir ? 127 - 2 * _ln : 2 * _ln, _l1 = _dir ? 126 - 2 * _ln : 2 * _ln + 1; \
            if (_ssd) { const float* _dp = (const float*)(ws + O_DT) + (size_t)_rb * 16 + _dir * 8 + _h; ps0 = _dp[_l0 * 16]; ps1 = _dp[_l1 * 16]; } \
            else { const float* _gf = (const float*)(ws + O_GF) + (size_t)_rb * 8 + _dir * 4 + _h; const float* _gi = (const float*)(ws + O_GI) + (size_t)_rb * 8 + _dir * 4 + _h; \
                   ps0 = _gf[_l0 * 8]; ps1 = _gf[_l1 * 8]; ps2 = _gi[_l0 * 8]; ps3 = _gi[_l1 * 8]; } } \
    } while (0)
    if ((int)blockIdx.x < NU4) P4_PREFETCH(blockIdx.x);
    for (int u = blockIdx.x; u < NU4; u += gridDim.x) {
        int t = threadIdx.x; asm volatile("" : "+v"(t));
        const int lane = t & 63, w = t >> 6, wm = w >> 1, wn = w & 1, lr = lane & 15, lq = lane >> 4;
        const bool isssd = u < NSSD;
        const int v = isssd ? u : u - NSSD;
        const int h = isssd ? (v & 7) : (v & 3), ct = isssd ? (v >> 3) : (v >> 2), b = ct / NCH, cc = ct % NCH;
        const int un = u + (int)gridDim.x;
        if (isssd) {
            if (w < 2) {
                const int dir = w;
                const int l0 = dir ? 127 - 2 * lane : 2 * lane, l1 = dir ? 126 - 2 * lane : 2 * lane + 1;
                const float d0 = ps0, d1 = ps1;
                const float an = -__expf(P.in[I_ALOG][dir * 8 + h]);
                const float p0 = d0 * an, p1 = p0 + d1 * an;
                const float inc = wave_scan_sum(p1, lane);
                const float ex = inc - p1;
                const float tot = __shfl(inc, 63);
                float* wd = dir ? wB : wA;
                wd[l0] = __expf(tot - (ex + p0)) * d0; wd[l1] = __expf(tot - (ex + p1)) * d1;
                if (lane == 0) ((float*)(ws + O_ACH))[((size_t)(b * NCH + cc) * 8 + h) * 2 + dir] = tot;
            }
            __syncthreads();
#pragma unroll
            for (int i = 0; i < 2; ++i) {
                const int q = t + 512 * i, r = q >> 4, c = q & 15;
                *(u32x4*)(T0 + swz256(r, c)) = scale8(RA[i], wA + c * 8); *(u32x4*)(T0 + swz256(64 + r, c)) = scale8(RA[i], wB + c * 8);
            }
#pragma unroll
            for (int i = 0; i < 4; ++i) { const int q = t + 512 * i, r = q >> 4, c = q & 15; *(u32x4*)(T1 + swz256(r, c)) = RB[i]; }
            __syncthreads();
            if (un < NU4) P4_PREFETCH(un);
            f32x4 acc[2][4]; zero_acc(acc);
            lds_mma_t<2, 4>(T0, T1, wm * 32, wn * 64, acc, lane);
            u16* st = (u16*)(ws + O_ST) + (((size_t)(b * NCH + cc) * 8 + h) * 2 + (wm >> 1)) * 8192 + ((wm & 1) * 32 + lr) * 128 + wn * 64 + lq * 4;
#pragma unroll
            for (int i = 0; i < 2; ++i)
#pragma unroll
                for (int j = 0; j < 4; ++j) {
                    uint2 o; o.x = pack2(acc[i][j][0], acc[i][j][1]); o.y = pack2(acc[i][j][2], acc[i][j][3]);
                    *(uint2*)(st + (i * 16) * 128 + j * 16) = o;
                }
            __syncthreads();
        } else {
            if (w < 2) {
                const int dir = w;
                const int s0 = dir ? 127 - 2 * lane : 2 * lane, s1 = dir ? 126 - 2 * lane : 2 * lane + 1;
                const float f0 = ps0, f1 = ps1, i0 = ps2, i1 = ps3;
                const float p1 = f0 + f1;
                const float inc = wave_scan_sum(p1, lane);
                const float ex = inc - p1;
                const float tot = __shfl(inc, 63);
                const float av0 = tot - (ex + f0) + i0, av1 = tot - (ex + p1) + i1;
                const float mloc = wave_max(fmaxf(av0, av1));
                float* wd = dir ? wB : wA;
                wd[s0] = __expf(av0 - mloc); wd[s1] = __expf(av1 - mloc);
                if (lane == 0) {
                    float* mls = (float*)(ws + O_MLS) + (((size_t)(b * NCH + cc) * 4 + h) * 2 + dir) * 2;
                    mls[0] = mloc; mls[1] = tot;
                }
            }
            __syncthreads();
#pragma unroll
            for (int d2 = 0; d2 < 2; ++d2) {
                const float* wsel = d2 ? wB : wA;
#pragma unroll
                for (int i = 0; i < 4; ++i) { const int q = t + 512 * i, r = q >> 4, c = q & 15; *(u32x4*)(T0 + swz256(r, c)) = scale8(RA[i], wsel + c * 8); }
                if (d2 == 0) {
#pragma unroll
                    for (int i = 0; i < 4; ++i) { const int q = t + 512 * i, r = q >> 4, c = q & 15; *(u32x4*)(T1 + swz256(r, c)) = RB[i]; }
                }
                __syncthreads();
                if (d2 == 1 && un < NU4) P4_PREFETCH(un);
                f32x4 acc[2][4]; zero_acc(acc);
                lds_mma_t<2, 4>(T0, T1, wm * 32, wn * 64, acc, lane);
                u16* cst = (u16*)(ws + (d2 ? O_MLC1 : O_MLC0)) + ((size_t)(b * NCH + cc) * 4 + h) * 16384 + (wm * 32 + lr) * 128 + wn * 64 + lq * 4;
#pragma unroll
                for (int i = 0; i < 2; ++i)
#pragma unroll
                    for (int j = 0; j < 4; ++j) {
                        uint2 o; o.x = pack2(acc[i][j][0], acc[i][j][1]); o.y = pack2(acc[i][j][2], acc[i][j][3]);
                        *(uint2*)(cst + (i * 16) * 128 + j * 16) = o;
                    }
                if (d2 == 0 && t < 256) {
                    const int dir = t >> 7, idx = t & 127;
                    const float* wgt = dir ? wB : wA;
                    float nacc = 0.f;
#pragma unroll 4
                    for (int c = 0; c < 16; ++c) {
                        const uint4 kv = *(const uint4*)(T1 + swz256(idx, c));
                        const float* ww = wgt + c * 8;
                        nacc += bflo(kv.x) * ww[0] + bfhi(kv.x) * ww[1] + bflo(kv.y) * ww[2] + bfhi(kv.y) * ww[3]
                              + bflo(kv.z) * ww[4] + bfhi(kv.z) * ww[5] + bflo(kv.w) * ww[6] + bfhi(kv.w) * ww[7];
                    }
                    ((float*)(ws + O_MLN))[(((size_t)(b * NCH + cc) * 4 + h) * 2 + dir) * 128 + idx] = nacc;
                }
                __syncthreads();
            }
        }
    }
}

__device__ __forceinline__ int scan_cc(int dir, int step) { return dir == 0 ? step : (step < 2 ? 1 - step : 35 - step); }
__device__ void phase5(const Params& P) {
    unsigned char* ws = P.ws;
    const int vb = threadIdx.x >> 8, t = threadIdx.x & 255;
    for (int u = blockIdx.x * 2 + vb; u < 256 + 256 + 32; u += gridDim.x * 2) {
        if (u < 256) {
            const int chain = u >> 2, part = u & 3;
            const int b = chain >> 4, h = (chain >> 1) & 7, dir = chain & 1;
            const int off = part * 2048 + t * 8;
            float S[8];
#pragma unroll
            for (int j = 0; j < 8; ++j) S[j] = 0.f;
#pragma unroll 1
            for (int sb = 0; sb < NCH; sb += 17) {
                u32x4 lv[17]; float dc[17];
#pragma unroll
                for (int q = 0; q < 17; ++q) {
                    const int cc = scan_cc(dir, sb + q);
                    lv[q] = *(const u32x4*)((const u16*)(ws + O_ST) + (((size_t)(b * NCH + cc) * 8 + h) * 2 + dir) * 8192 + off);
                    dc[q] = ((const float*)(ws + O_ACH))[((size_t)(b * NCH + cc) * 8 + h) * 2 + dir];
                }
                __builtin_amdgcn_sched_barrier(0);
#pragma unroll
                for (int q = 0; q < 17; ++q) {
                    const int cc = scan_cc(dir, sb + q);
                    u16* p = (u16*)(ws + O_ST) + (((size_t)(b * NCH + cc) * 8 + h) * 2 + dir) * 8192 + off;
                    const float dec = __expf(dc[q]);
                    u32x4 o; o.x = pack2(S[0], S[1]); o.y = pack2(S[2], S[3]); o.z = pack2(S[4], S[5]); o.w = pack2(S[6], S[7]);
                    *(u32x4*)p = o;
                    S[0] = dec * S[0] + bflo(lv[q].x); S[1] = dec * S[1] + bfhi(lv[q].x); S[2] = dec * S[2] + bflo(lv[q].y); S[3] = dec * S[3] + bfhi(lv[q].y);
                    S[4] = dec * S[4] + bflo(lv[q].z); S[5] = dec * S[5] + bfhi(lv[q].z); S[6] = dec * S[6] + bflo(lv[q].w); S[7] = dec * S[7] + bfhi(lv[q].w);
                }
                __builtin_amdgcn_sched_barrier(0);
            }
        } else if (u < 512) {
            const int v = u - 256;
            const int chain = v >> 3, part = v & 7;
            const int b = chain >> 3, h = (chain >> 1) & 3, dir = chain & 1;
            const int off = part * 2048 + t * 8;
            float S[8];
#pragma unroll
            for (int j = 0; j < 8; ++j) S[j] = 0.f;
            float m = -1e30f;
#pragma unroll 1
            for (int sb = 0; sb < NCH; sb += 17) {
                u32x4 lv[17]; float mlv[17], blv[17];
#pragma unroll
                for (int q = 0; q < 17; ++q) {
                    const int cc = scan_cc(dir, sb + q);
                    lv[q] = *(const u32x4*)((const u16*)(ws + (dir ? O_MLC1 : O_MLC0)) + ((size_t)(b * NCH + cc) * 4 + h) * 16384 + off);
                    const float* mls = (const float*)(ws + O_MLS) + (((size_t)(b * NCH + cc) * 4 + h) * 2 + dir) * 2;
                    mlv[q] = mls[0]; blv[q] = mls[1];
                }
                __builtin_amdgcn_sched_barrier(0);
#pragma unroll
                for (int q = 0; q < 17; ++q) {
                    const int cc = scan_cc(dir, sb + q);
                    u16* p = (u16*)(ws + (dir ? O_MLC1 : O_MLC0)) + ((size_t)(b * NCH + cc) * 4 + h) * 16384 + off;
                    const float ml = mlv[q], bl = blv[q];
                    const float mn = fmaxf(bl + m, ml);
                    const float sp = __expf(bl + m - mn), sl = __expf(ml - mn);
                    if (part == 0 && t == 0) ((float*)(ws + O_MLP))[((size_t)(b * NCH + cc) * 4 + h) * 2 + dir] = m;
                    u32x4 o; o.x = pack2(S[0], S[1]); o.y = pack2(S[2], S[3]); o.z = pack2(S[4], S[5]); o.w = pack2(S[6], S[7]);
                    *(u32x4*)p = o;
                    S[0] = sp * S[0] + sl * bflo(lv[q].x); S[1] = sp * S[1] + sl * bfhi(lv[q].x); S[2] = sp * S[2] + sl * bflo(lv[q].y); S[3] = sp * S[3] + sl * bfhi(lv[q].y);
                    S[4] = sp * S[4] + sl * bflo(lv[q].z); S[5] = sp * S[5] + sl * bfhi(lv[q].z); S[6] = sp * S[6] + sl * bflo(lv[q].w); S[7] = sp * S[7] + sl * bfhi(lv[q].w);
                    m = mn;
                }
                __builtin_amdgcn_sched_barrier(0);
            }
        } else {
            const int chain = u - 512;
            const int b = chain >> 3, h = (chain >> 1) & 3, dir = chain & 1;
            if (t < 128) {
                float nS = 0.f, m = -1e30f;
#pragma unroll 1
                for (int sb = 0; sb < NCH; sb += 17) {
                    float lvv[17], mlv[17], blv[17];
#pragma unroll
                    for (int q = 0; q < 17; ++q) {
                        const int cc = scan_cc(dir, sb + q);
                        lvv[q] = ((const float*)(ws + O_MLN))[(((size_t)(b * NCH + cc) * 4 + h) * 2 + dir) * 128 + t];
                        const float* mls = (const float*)(ws + O_MLS) + (((size_t)(b * NCH + cc) * 4 + h) * 2 + dir) * 2;
                        mlv[q] = mls[0]; blv[q] = mls[1];
                    }
                    __builtin_amdgcn_sched_barrier(0);
#pragma unroll
                    for (int q = 0; q < 17; ++q) {
                        const int cc = scan_cc(dir, sb + q);
                        float* p = (float*)(ws + O_MLN) + (((size_t)(b * NCH + cc) * 4 + h) * 2 + dir) * 128 + t;
                        const float mn = fmaxf(blv[q] + m, mlv[q]);
                        const float sp = __expf(blv[q] + m - mn), sl = __expf(mlv[q] - mn);
                        *p = nS;
                        nS = sp * nS + sl * lvv[q];
                        m = mn;
                    }
                    __builtin_amdgcn_sched_barrier(0);
                }
            }
        }
    }
}

__device__ void phase6(const Params& P, char* lds) {
    unsigned char* ws = P.ws;
    char* T0 = lds; char* T1 = lds + 32768; char* T2 = lds + 65536; char* T3 = lds + 98304;
    float* sc = (float*)(lds + 131072);
    float* sbuf = sc;
    float* a0 = sc + 256;
    float* a1 = sc + 384;
    float* a2 = sc + 512;
    float* a3 = sc + 640;
    float* a4 = sc + 768;
    float* a5 = sc + 896;
    float* rsA = sc + 1024;
    float* qn = sc + 1536;
    float* fac = sc + 1792;
    float* wfac = sc + 2048;
    const int NSSD = 4 * 32 * 8, NML = 4 * 32 * 4, NU6 = NSSD + NML;
    u32x4 R0[4], R1[4], R2[4], R3[4];
    float ps0 = 0.f, ps1 = 0.f, ps2 = 0.f, ps3 = 0.f;
#define P6_PREFETCH(uu) do { \
        const int _u = (uu); const bool _ssd = _u < NSSD; const int _v = _ssd ? _u : _u - NSSD; \
        const int _h = _ssd ? (_v & 7) : (_v & 3), _ct = _ssd ? (_v >> 3) : (_v >> 2), _b = _ct >> 5, _c = _ct & 31, _cc = _c + 2; \
        const size_t _ctile = (size_t)(_b * NCH + _cc); const int _rb = _b * 4096 + _c * 128; \
        const u16 *_p0, *_p1, *_p2, *_p3; \
        if (_ssd) { const int _g = _h >> 2; _p0 = (const u16*)(ws + O_CM) + (_ctile * 2 + _g) * 16384; _p1 = (const u16*)(ws + O_BM) + (_ctile * 2 + _g) * 16384; \
                    _p2 = (const u16*)(ws + O_ST) + ((_ctile * 8 + _h) * 2) * 8192; _p3 = (const u16*)(ws + O_XT) + (_ctile * 512 + _h * 64) * 128; } \
        else { _p0 = (const u16*)(ws + O_Q) + (_ctile * 4 + _h) * 16384; _p1 = (const u16*)(ws + O_K) + (_ctile * 4 + _h) * 16384; \
               _p2 = (const u16*)(ws + O_MLC0) + (_ctile * 4 + _h) * 16384; _p3 = (const u16*)(ws + O_MLC1) + (_ctile * 4 + _h) * 16384; } \
        _Pragma("unroll") for (int _i = 0; _i < 4; ++_i) { const int _q = (int)threadIdx.x + 512 * _i; const size_t _o = (size_t)(_q >> 4) * 128 + (_q & 15) * 8; \
            R0[_i] = *(const u32x4*)(_p0 + _o); R1[_i] = *(const u32x4*)(_p1 + _o); R2[_i] = *(const u32x4*)(_p2 + _o); R3[_i] = *(const u32x4*)(_p3 + _o); } \
        if (threadIdx.x < 128) { const int _dir = threadIdx.x >> 6, _ln = threadIdx.x & 63; \
            const int _l0 = _dir ? 127 - 2 * _ln : 2 * _ln, _l1 = _dir ? 126 - 2 * _ln : 2 * _ln + 1; \
            if (_ssd) { const float* _dp = (const float*)(ws + O_DT) + (size_t)_rb * 16 + _dir * 8 + _h; ps0 = _dp[_l0 * 16]; ps1 = _dp[_l1 * 16]; } \
            else { const float* _gf = (const float*)(ws + O_GF) + (size_t)_rb * 8 + _dir * 4 + _h; const float* _gi = (const float*)(ws + O_GI) + (size_t)_rb * 8 + _dir * 4 + _h; \
                   ps0 = _gf[_l0 * 8]; ps1 = _gf[_l1 * 8]; ps2 = _gi[_l0 * 8]; ps3 = _gi[_l1 * 8]; } } \
    } while (0)
    if ((int)blockIdx.x < NU6) P6_PREFETCH(blockIdx.x);
    for (int u = blockIdx.x; u < NU6; u += gridDim.x) {
        int t = threadIdx.x; asm volatile("" : "+v"(t));
        const int lane = t & 63, w = t >> 6, wm = w >> 1, wn = w & 1;
        const bool isssd = u < NSSD;
        const int v = isssd ? u : u - NSSD;
        const int h = isssd ? (v & 7) : (v & 3), ct = isssd ? (v >> 3) : (v >> 2), b = ct >> 5, c = ct & 31, cc = c + 2;
        const int rb = b * 4096 + c * 128, lpos = c * 128;
        const float mp0 = isssd ? 0.f : ((const float*)(ws + O_MLP))[((size_t)(b * NCH + cc) * 4 + h) * 2 + 0];
        const float mp1 = isssd ? 0.f : ((const float*)(ws + O_MLP))[((size_t)(b * NCH + cc) * 4 + h) * 2 + 1];
        if (w < 2) {
            const int dir = w;
            const int l0 = dir ? 127 - 2 * lane : 2 * lane, l1 = dir ? 126 - 2 * lane : 2 * lane + 1;
            if (isssd) {
                const float d0 = ps0, d1 = ps1;
                const float an = -__expf(P.in[I_ALOG][dir * 8 + h]);
                const float p0 = d0 * an, p1 = p0 + d1 * an;
                const float inc = wave_scan_sum(p1, lane);
                const float ex = inc - p1;
                float* ca = dir ? a1 : a0; float* da = dir ? a3 : a2;
                ca[l0] = ex + p0; ca[l1] = ex + p1; da[l0] = d0; da[l1] = d1;
            } else {
                const float f0 = ps0, f1 = ps1, i0 = ps2, i1 = ps3;
                const float p1 = f0 + f1;
                const float inc = wave_scan_sum(p1, lane);
                const float ex = inc - p1;
                const float bc0 = ex + f0, bc1 = ex + p1;
                const float u0 = i0 - bc0, u1 = i1 - bc1;
                const float q1 = fmaxf(u0, u1);
                const float incm = wave_scan_max(q1, lane);
                float exm = __shfl_up(incm, 1); if (lane == 0) exm = -INFINITY;
                const float mp = dir ? mp1 : mp0;
                float* ab = dir ? a1 : a0; float* au = dir ? a3 : a2; float* am = dir ? a5 : a4;
                ab[l0] = bc0; ab[l1] = bc1; au[l0] = u0; au[l1] = u1;
                am[l0] = fmaxf(mp, fmaxf(exm, u0)); am[l1] = fmaxf(mp, fmaxf(exm, q1));
            }
        }
#pragma unroll
        for (int i = 0; i < 4; ++i) {
            const int q = t + 512 * i, r = q >> 4, cq = q & 15;
            *(u32x4*)(T0 + swz256(r, cq)) = R0[i];
            *(u32x4*)(T1 + swz256(r, cq)) = R1[i];
            *(u32x4*)(T2 + swz256(r, cq)) = R2[i];
            if (!isssd || i < 2) *(u32x4*)(T3 + swz256(r, cq)) = R3[i];
        }
        __syncthreads();
        if (u + (int)gridDim.x < NU6) P6_PREFETCH(u + gridDim.x);
        if (isssd) {
            const int g = h >> 2; (void)g;
            const int lr = lane & 15, lq = lane >> 4;
            f32x4 Y[2][2];
            {
                f32x4 aF[2][2], aB[2][2]; zero_acc(aF); zero_acc(aB);
                lds_mma_t<2, 2>(T0, T2, wm * 32, wn * 32, aF, lane);
                lds_mma_t<2, 2>(T0, T2, wm * 32, 64 + wn * 32, aB, lane);
#pragma unroll
                for (int i = 0; i < 2; ++i) {
                    const int l = wm * 32 + i * 16 + lr;
                    const float e0 = __expf(a0[l]), e1 = __expf(a1[l]);
#pragma unroll
                    for (int j = 0; j < 2; ++j) Y[i][j] = e0 * aF[i][j] + e1 * aB[i][j];
                }
            }
            f32x4 G[2][4]; zero_acc(G);
            lds_mma_t<2, 4>(T0, T1, wm * 32, wn * 64, G, lane);
            __syncthreads();
            {
                const float Dh = P.in[I_SSDD][h];
                int dbase = wn * 64 + lq * 4 - wm * 32 - lr; asm volatile("" : "+v"(dbase));
#pragma unroll
                for (int j = 0; j < 4; ++j) {
                    const int s0 = wn * 64 + j * 16 + lq * 4;
                    const float4 c0s = *(const float4*)(a0 + s0), r1s = *(const float4*)(a1 + s0), d0s = *(const float4*)(a2 + s0), d1s = *(const float4*)(a3 + s0);
                    const float c0v[4] = {c0s.x, c0s.y, c0s.z, c0s.w}, r1v[4] = {r1s.x, r1s.y, r1s.z, r1s.w};
                    const float d0v[4] = {d0s.x, d0s.y, d0s.z, d0s.w}, d1v[4] = {d1s.x, d1s.y, d1s.z, d1s.w};
#pragma unroll
                    for (int i = 0; i < 2; ++i) {
                        const int l = wm * 32 + i * 16 + lr;
                        const float c0l = a0[l], r1l = a1[l];
                        float mv[4];
#pragma unroll
                        for (int r = 0; r < 4; ++r) {
                            const int diff = dbase + (j * 16 - i * 16 + r);
                            const float e0 = (diff <= 0) ? (c0l - c0v[r]) : -INFINITY;
                            const float e1 = (diff >= 0) ? (r1l - r1v[r]) : -INFINITY;
                            mv[r] = G[i][j][r] * (__expf(e0) * d0v[r] + __expf(e1) * d1v[r]) + (diff == 0 ? Dh : 0.f);
                        }
                        uint2 o; o.x = pack2(mv[0], mv[1]); o.y = pack2(mv[2], mv[3]);
                        *(uint2*)(T1 + swz256(l, s0 >> 3) + (s0 & 7) * 2) = o;
                    }
                }
            }
            __syncthreads();
            lds_mma_t<2, 2>(T1, T3, wm * 32, wn * 32, Y, lane);
            u16* zo = (u16*)(ws + O_ZO);
            uint2 zvv[2][2];
#pragma unroll
            for (int i = 0; i < 2; ++i)
#pragma unroll
                for (int j = 0; j < 2; ++j) zvv[i][j] = *(const uint2*)(zo + (size_t)(rb + wm * 32 + i * 16 + lr) * 1024 + h * 64 + wn * 32 + j * 16 + lq * 4);
            __builtin_amdgcn_sched_barrier(0);
#pragma unroll
            for (int i = 0; i < 2; ++i) {
                const int l = wm * 32 + i * 16 + lr;
                float ssq = 0.f;
#pragma unroll
                for (int j = 0; j < 2; ++j) {
                    const int p = wn * 32 + j * 16 + lq * 4;
                    u16* zp = zo + (size_t)(rb + l) * 1024 + h * 64 + p;
                    const uint2 zv = zvv[i][j];
                    const float y0 = Y[i][j][0] * siluf(bflo(zv.x)), y1 = Y[i][j][1] * siluf(bfhi(zv.x));
                    const float y2 = Y[i][j][2] * siluf(bflo(zv.y)), y3 = Y[i][j][3] * siluf(bfhi(zv.y));
                    uint2 o; o.x = pack2(y0, y1); o.y = pack2(y2, y3);
                    *(uint2*)zp = o;
                    ssq += y0 * y0 + y1 * y1 + y2 * y2 + y3 * y3;
                }
                ssq += __shfl_xor(ssq, 16); ssq += __shfl_xor(ssq, 32);
                if (lq == 0) ((float*)(ws + O_SSQ))[(size_t)(rb + l) * 16 + h * 2 + wn] = ssq;
            }
            __syncthreads();
        } else {
            const int lr = lane & 15, lq = lane >> 4;
            f32x4 S[2][4]; zero_acc(S);
            lds_mma_t<2, 4>(T0, T1, wm * 32, wn * 64, S, lane);
            if (t < 256) {
                const int dir = t >> 7, idx = t & 127;
                const float* np = (const float*)(ws + O_MLN) + (((size_t)(b * NCH + cc) * 4 + h) * 2 + dir) * 128;
                float acc = 0.f;
#pragma unroll 4
                for (int cch = 0; cch < 16; ++cch) {
                    const uint4 qv = *(const uint4*)(T0 + swz256(idx, cch));
                    const float4 n0 = *(const float4*)(np + cch * 8), n1 = *(const float4*)(np + cch * 8 + 4);
                    acc += bflo(qv.x) * n0.x + bfhi(qv.x) * n0.y + bflo(qv.y) * n0.z + bfhi(qv.y) * n0.w
                         + bflo(qv.z) * n1.x + bfhi(qv.z) * n1.y + bflo(qv.w) * n1.z + bfhi(qv.w) * n1.w;
                }
                qn[dir * 128 + idx] = acc;
            }
            int dbase = wn * 64 + lq * 4 - wm * 32 - lr; asm volatile("" : "+v"(dbase));
            {
                float r0[2] = {0.f, 0.f}, r1[2] = {0.f, 0.f};
#pragma unroll
                for (int j = 0; j < 4; ++j) {
                    const int s0 = wn * 64 + j * 16 + lq * 4;
                    const float4 u0s = *(const float4*)(a2 + s0), u1s = *(const float4*)(a3 + s0);
                    const float u0v[4] = {u0s.x, u0s.y, u0s.z, u0s.w}, u1v[4] = {u1s.x, u1s.y, u1s.z, u1s.w};
#pragma unroll
                    for (int i = 0; i < 2; ++i) {
                        const int tt = wm * 32 + i * 16 + lr;
                        const float m0 = a4[tt], m1 = a5[tt];
#pragma unroll
                        for (int r = 0; r < 4; ++r) {
                            const int diff = dbase + (j * 16 - i * 16 + r);
                            r0[i] += S[i][j][r] * __expf((diff <= 0) ? (u0v[r] - m0) : -INFINITY);
                            r1[i] += S[i][j][r] * __expf((diff >= 0) ? (u1v[r] - m1) : -INFINITY);
                        }
                    }
                }
#pragma unroll
                for (int i = 0; i < 2; ++i) {
                    const int tt = wm * 32 + i * 16 + lr;
                    float x0 = r0[i], x1 = r1[i];
                    x0 += __shfl_xor(x0, 16); x0 += __shfl_xor(x0, 32);
                    x1 += __shfl_xor(x1, 16); x1 += __shfl_xor(x1, 32);
                    if (lq == 0) { rsA[(0 * 2 + wn) * 128 + tt] = x0; rsA[(1 * 2 + wn) * 128 + tt] = x1; }
                }
            }
            __syncthreads();
            if (t < 256) {
                const int dir = t >> 7, tt = t & 127;
                const float rs = rsA[(dir * 2 + 0) * 128 + tt] + rsA[(dir * 2 + 1) * 128 + tt];
                const float mm = dir ? a5[tt] : a4[tt];
                const float wi = __expf((dir ? mp1 : mp0) - mm);
                const float den = rs + wi * qn[dir * 128 + tt];
                const float mout = (dir ? a1[tt] : a0[tt]) + mm;
                const float dn = fmaxf(fabsf(den), __expf(-mout));
                fac[dir * 128 + tt] = 1.f / dn;
                wfac[dir * 128 + tt] = wi / dn;
            }
            __syncthreads();
            f32x4 H[2][4];
            {
                f32x4 A0[2][4]; zero_acc(A0);
                lds_mma_t<2, 4>(T0, T2, wm * 32, wn * 64, A0, lane);
#pragma unroll
                for (int i = 0; i < 2; ++i) {
                    const float f = wfac[wm * 32 + i * 16 + lr];
#pragma unroll
                    for (int j = 0; j < 4; ++j) H[i][j] = f * A0[i][j];
                }
            }
            {
                f32x4 A1[2][4]; zero_acc(A1);
                lds_mma_t<2, 4>(T0, T3, wm * 32, wn * 64, A1, lane);
#pragma unroll
                for (int i = 0; i < 2; ++i) {
                    const float f = wfac[128 + wm * 32 + i * 16 + lr];
#pragma unroll
                    for (int j = 0; j < 4; ++j) H[i][j] += f * A1[i][j];
                }
            }
            __syncthreads();
            asm volatile("" : "+v"(dbase));
#pragma unroll
            for (int j = 0; j < 4; ++j) {
                const int s0 = wn * 64 + j * 16 + lq * 4;
                const float4 u0s = *(const float4*)(a2 + s0), u1s = *(const float4*)(a3 + s0);
                const float u0v[4] = {u0s.x, u0s.y, u0s.z, u0s.w}, u1v[4] = {u1s.x, u1s.y, u1s.z, u1s.w};
#pragma unroll
                for (int i = 0; i < 2; ++i) {
                    const int tt = wm * 32 + i * 16 + lr;
                    const float m0 = a4[tt], m1 = a5[tt], f0 = fac[tt], f1 = fac[128 + tt];
                    float pv[4];
#pragma unroll
                    for (int r = 0; r < 4; ++r) {
                        const int diff = dbase + (j * 16 - i * 16 + r);
                        pv[r] = S[i][j][r] * (__expf((diff <= 0) ? (u0v[r] - m0) : -INFINITY) * f0 + __expf((diff >= 0) ? (u1v[r] - m1) : -INFINITY) * f1);
                    }
                    uint2 o; o.x = pack2(pv[0], pv[1]); o.y = pack2(pv[2], pv[3]);
                    *(uint2*)(T1 + swz256(tt, s0 >> 3) + (s0 & 7) * 2) = o;
                }
            }
            load_tile128(T2, 0, (const u16*)(ws + O_VT) + ((size_t)(b * NCH + cc) * 512 + h * 128) * 128, 128, 128, t, 512);
            __syncthreads();
            lds_mma_t<2, 4>(T1, T2, wm * 32, wn * 64, H, lane);
            u16* zo = (u16*)(ws + O_ZO);
            size_t rown[2];
#pragma unroll
            for (int i = 0; i < 2; ++i) {
                const int tt = wm * 32 + i * 16 + lr;
                const int lp = lpos + tt;
                rown[i] = (size_t)b * 4096 + ((lp & 63) << 6) + (lp >> 6);
                float ssq = 0.f;
#pragma unroll
                for (int j = 0; j < 4; ++j) {
                    const int d = wn * 64 + j * 16 + lq * 4;
                    const uint2 ov = *(const uint2*)(zo + rown[i] * 1024 + 512 + h * 128 + d);
                    H[i][j][0] *= sigmf(bflo(ov.x)); H[i][j][1] *= sigmf(bfhi(ov.x)); H[i][j][2] *= sigmf(bflo(ov.y)); H[i][j][3] *= sigmf(bfhi(ov.y));
                    ssq += H[i][j][0] * H[i][j][0] + H[i][j][1] * H[i][j][1] + H[i][j][2] * H[i][j][2] + H[i][j][3] * H[i][j][3];
                }
                ssq += __shfl_xor(ssq, 16); ssq += __shfl_xor(ssq, 32);
                if (lq == 0) rsA[wn * 128 + tt] = ssq;
            }
            __syncthreads();
            const u16* xc = (const u16*)(ws + O_XC);
            f32x4 nwv[4], skv[4]; uint2 xvv[4][2];
#pragma unroll
            for (int j = 0; j < 4; ++j) {
                const int d = wn * 64 + j * 16 + lq * 4, chg = h * 128 + d;
                nwv[j] = *(const f32x4*)(P.in[I_MNW] + chg); skv[j] = *(const f32x4*)(P.in[I_MSKIP] + chg);
#pragma unroll
                for (int i = 0; i < 2; ++i) xvv[j][i] = *(const uint2*)(xc + ((size_t)(b * NCH + cc) * 4 + h) * 16384 + (size_t)(wm * 32 + i * 16 + lr) * 128 + d);
            }
            __builtin_amdgcn_sched_barrier(0);
#pragma unroll
            for (int j = 0; j < 4; ++j) {
                const int d = wn * 64 + j * 16 + lq * 4, chg = h * 128 + d;
#pragma unroll
                for (int i = 0; i < 2; ++i) {
                    const int tt = wm * 32 + i * 16 + lr;
                    const float rn = rsqrtf((rsA[tt] + rsA[128 + tt]) * (1.f / 128.f) + 1e-6f);
                    const uint2 xv = xvv[j][i];
                    const float y0 = H[i][j][0] * rn * nwv[j][0] + skv[j][0] * bflo(xv.x), y1 = H[i][j][1] * rn * nwv[j][1] + skv[j][1] * bfhi(xv.x);
                    const float y2 = H[i][j][2] * rn * nwv[j][2] + skv[j][2] * bflo(xv.y), y3 = H[i][j][3] * rn * nwv[j][3] + skv[j][3] * bfhi(xv.y);
                    uint2 o; o.x = pack2(y0, y1); o.y = pack2(y2, y3);
                    *(uint2*)(zo + rown[i] * 1024 + 512 + chg) = o;
                }
            }
            __syncthreads();
        }
    }
}

struct OutProj {
    static constexpr int K = 1024; static constexpr bool PERM = false; static constexpr int MIDT = 8;
    struct Unit { int pm, pn, slot; };
    const Params* P; const float* rs; int G, c;
    __device__ __forceinline__ bool next(int i, Unit& u) const {
        const int L = i * G + c;
        if (L >= 256) return false;
        g8::dense_unit(L, 64, 4, u.pm, u.pn); u.slot = i & 3;
        return true;
    }
    __device__ __forceinline__ const char* baseA(const Unit&) const { return (const char*)(P->ws + O_ZO); }
    __device__ __forceinline__ const char* baseB(const Unit&) const { return (const char*)(P->ws + O_WOUT); }
    __device__ __forceinline__ void offs(const Unit& u, int tid_, unsigned (&oa)[2][2], unsigned (&ob)[2][2]) const {
        int R[2], C[2];
        { int tq = tid_; asm volatile("" : "+v"(tq)); g8::stage_rc(tq * 16, R[0], C[0]); g8::stage_rc(tq * 16 + 8192, R[1], C[1]); }
#pragma unroll
        for (int h = 0; h < 2; ++h)
#pragma unroll
            for (int i = 0; i < 2; ++i) {
                oa[h][i] = (unsigned)((u.pm * 256 + h * 128 + R[i]) * 1024 + C[i]) * 2u;
                ob[h][i] = (unsigned)((u.pn * 256 + h * 128 + R[i]) * 1024 + C[i]) * 2u;
            }
    }
    __device__ __forceinline__ int nt(const Unit&) const { return 16; }
    __device__ __forceinline__ bool brk(const Unit&, const Unit&) const { return false; }
    __device__ __forceinline__ void a_ready(const Unit&) const {}
    __device__ __forceinline__ void done(const Unit&) const {}
    __device__ __forceinline__ void mid(g8::Acc& acc, const Unit& u, int wr, int fr) const {
#pragma unroll
        for (int ai = 0; ai < 2; ++ai)
#pragma unroll
            for (int m = 0; m < 4; ++m) {
                const float s = rs[u.slot * 256 + ai * 128 + wr * 64 + m * 16 + fr];
#pragma unroll
                for (int bj = 0; bj < 2; ++bj)
#pragma unroll
                    for (int n = 0; n < 2; ++n) acc[ai][bj][m][n] *= s;
            }
    }
    __device__ __forceinline__ void epi(g8::Acc& acc, const Unit& u, int wr, int wc, int fr, int fq) const {
        const int row0 = u.pm * 256 + wr * 64 + fr, col0 = u.pn * 256 + wc * 32 + 4 * fq;
        const int b = u.pm >> 4;
        const float* mod = (const float*)(P->ws + O_MOD) + b * 6144 + 2048;
        f32x4 g1[2][2];
#pragma unroll
        for (int bj = 0; bj < 2; ++bj)
#pragma unroll
            for (int n = 0; n < 2; ++n) g1[bj][n] = *(const f32x4*)(mod + col0 + bj * 128 + n * 16);
#pragma unroll
        for (int ai = 0; ai < 2; ++ai)
#pragma unroll
            for (int mp = 0; mp < 2; ++mp) {
                f32x4 xv[2][2][2];
#pragma unroll
                for (int mm = 0; mm < 2; ++mm)
#pragma unroll
                    for (int bj = 0; bj < 2; ++bj)
#pragma unroll
                        for (int n = 0; n < 2; ++n)
                            xv[mm][bj][n] = *(const f32x4*)(P->in[I_X] + (size_t)(row0 + ai * 128 + (mp * 2 + mm) * 16) * 1024 + col0 + bj * 128 + n * 16);
                __builtin_amdgcn_sched_barrier(0);
#pragma unroll
                for (int mm = 0; mm < 2; ++mm)
#pragma unroll
                    for (int bj = 0; bj < 2; ++bj)
#pragma unroll
                        for (int n = 0; n < 2; ++n)
                            *(f32x4*)(P->out + (size_t)(row0 + ai * 128 + (mp * 2 + mm) * 16) * 1024 + col0 + bj * 128 + n * 16) = xv[mm][bj][n] + g1[bj][n] * acc[ai][bj][mp * 2 + mm][n];
                __builtin_amdgcn_sched_barrier(0);
            }
    }
};
__device__ void phase7(const Params& P, char* lds) {
    float* rs = (float*)(lds + g8::STAGE_BYTES);
    OutProj S; S.P = &P; S.rs = rs; S.G = gridDim.x; S.c = blockIdx.x;
    for (int i = 0; i < 4; ++i) {
        OutProj::Unit u;
        if (!S.next(i, u)) break;
        if (threadIdx.x < 256) {
            const float* sq = (const float*)(P.ws + O_SSQ) + (size_t)(u.pm * 256 + threadIdx.x) * 16;
            float s = 0.f;
#pragma unroll
            for (int q = 0; q < 16; ++q) s += sq[q];
            rs[i * 256 + threadIdx.x] = rsqrtf(s * (1.f / 512.f) + 1e-6f);
        }
    }
    __syncthreads();
    g8::gemm_phase<OutProj>((LAS unsigned char*)lds, S);
}

__device__ void phase8(const Params& P, char* lds_all) {
    unsigned char* ws = P.ws;
    const float* mod = (const float*)(ws + O_MOD);
    {
        const int t = threadIdx.x, lane = t & 63, w = t >> 6;
        float* tt = (float*)lds_all;
        float bw[32][3];
        {
            const int ti = lane & 15, kq = lane >> 4;
#pragma unroll
            for (int ks = 0; ks < 32; ++ks) {
                const int k = w * 128 + ks * 4 + kq;
                bw[ks][0] = P.in[I_REW][(size_t)k * 32 + ti];
                bw[ks][1] = P.in[I_REW][(size_t)k * 32 + 16 + ti];
                const float b2r = P.in[I_RGW][(size_t)k * 4 + (ti & 3)];
                bw[ks][2] = ti < 4 ? b2r : 0.f;
            }
        }
        for (int u = blockIdx.x; u < 512; u += gridDim.x) {
            const int tk0 = u * 32;
            const int b = tk0 >> 12;
#pragma unroll 1
            for (int qh = 0; qh < 2; ++qh) {
                float4 v[2][4]; float ss[2];
#pragma unroll
                for (int q = 0; q < 2; ++q) {
                    const float* xr = P.out + (size_t)(tk0 + w * 4 + qh * 2 + q) * 1024;
#pragma unroll
                    for (int j = 0; j < 4; ++j) { v[q][j] = ((const float4*)xr)[lane + 64 * j]; }
                }
#pragma unroll
                for (int q = 0; q < 2; ++q) {
                    ss[q] = 0.f;
#pragma unroll
                    for (int j = 0; j < 4; ++j) ss[q] += v[q][j].x * v[q][j].x + v[q][j].y * v[q][j].y + v[q][j].z * v[q][j].z + v[q][j].w * v[q][j].w;
                    ss[q] = rsqrtf(wave_sum(ss[q]) * (1.f / 1024.f) + 1e-6f);
                }
#pragma unroll
                for (int j = 0; j < 4; ++j) {
                    const int k = (lane + 64 * j) * 4;
                    const float4 nwv = *(const float4*)(P.in[I_N2W] + k);
                    const float4 sh = *(const float4*)(mod + b * 6144 + 3072 + k);
                    const float4 sc = *(const float4*)(mod + b * 6144 + 4096 + k);
                    const float m0 = nwv.x * (1.f + sc.x), m1 = nwv.y * (1.f + sc.y), m2 = nwv.z * (1.f + sc.z), m3 = nwv.w * (1.f + sc.w);
#pragma unroll
                    for (int q = 0; q < 2; ++q) {
                        const int tl = w * 4 + qh * 2 + q;
                        float4 hh;
                        hh.x = v[q][j].x * ss[q] * m0 + sh.x; hh.y = v[q][j].y * ss[q] * m1 + sh.y;
                        hh.z = v[q][j].z * ss[q] * m2 + sh.z; hh.w = v[q][j].w * ss[q] * m3 + sh.w;
                        uint2 o; o.x = pack2(hh.x, hh.y); o.y = pack2(hh.z, hh.w);
                        *(uint2*)((u16*)(ws + O_T) + (size_t)(tk0 + tl) * 1024 + k) = o;
                        *(float4*)(tt + tl * 1028 + k) = hh;
                    }
                }
            }
            __syncthreads();
            f32x4 c[2][3];
#pragma unroll
            for (int a = 0; a < 2; ++a)
#pragma unroll
                for (int f = 0; f < 3; ++f) c[a][f] = f32x4{0, 0, 0, 0};
            const int ti = lane & 15, kq = lane >> 4;
#pragma unroll
            for (int ks = 0; ks < 32; ++ks) {
                const int k = w * 128 + ks * 4 + kq;
                const float a0 = tt[ti * 1028 + k], a1 = tt[(16 + ti) * 1028 + k];
                c[0][0] = __builtin_amdgcn_mfma_f32_16x16x4f32(a0, bw[ks][0], c[0][0], 0, 0, 0);
                c[0][1] = __builtin_amdgcn_mfma_f32_16x16x4f32(a0, bw[ks][1], c[0][1], 0, 0, 0);
                c[0][2] = __builtin_amdgcn_mfma_f32_16x16x4f32(a0, bw[ks][2], c[0][2], 0, 0, 0);
                c[1][0] = __builtin_amdgcn_mfma_f32_16x16x4f32(a1, bw[ks][0], c[1][0], 0, 0, 0);
                c[1][1] = __builtin_amdgcn_mfma_f32_16x16x4f32(a1, bw[ks][1], c[1][1], 0, 0, 0);
                c[1][2] = __builtin_amdgcn_mfma_f32_16x16x4f32(a1, bw[ks][2], c[1][2], 0, 0, 0);
            }
            __syncthreads();
            float* red = (float*)lds_all;
#pragma unroll
            for (int a = 0; a < 2; ++a)
#pragma unroll
                for (int r = 0; r < 4; ++r) {
                    const int row = a * 16 + kq * 4 + r;
                    red[(w * 32 + row) * 48 + ti] = c[a][0][r];
                    red[(w * 32 + row) * 48 + 16 + ti] = c[a][1][r];
                    red[(w * 32 + row) * 48 + 32 + ti] = c[a][2][r];
                }
            __syncthreads();
            int* lcnt = (int*)(lds_all + 65536);
            if (t < 64) lcnt[t] = 0;
            __syncthreads();
            int ea = 0, eb = 0, ra = 0, rb = 0; float w1 = 0.f, w2 = 0.f;
            if (t < 32) {
                float gl[4];
#pragma unroll
                for (int j = 0; j < 4; ++j) {
                    float sacc = P.in[I_RGB][j];
#pragma unroll
                    for (int ww = 0; ww < 8; ++ww) sacc += red[(ww * 32 + t) * 48 + 32 + j];
                    gl[j] = sacc;
                }
                int gs = 0; float gm = gl[0];
#pragma unroll
                for (int j = 1; j < 4; ++j) if (gl[j] > gm) { gm = gl[j]; gs = j; }
                float gsum = 0.f;
#pragma unroll
                for (int j = 0; j < 4; ++j) gsum += __expf(gl[j] - gm);
                const float pg = 1.f / gsum;
                float el[8];
#pragma unroll
                for (int j = 0; j < 8; ++j) {
                    float sacc = P.in[I_REB][gs * 8 + j];
#pragma unroll
                    for (int ww = 0; ww < 8; ++ww) sacc += red[(ww * 32 + t) * 48 + gs * 8 + j];
                    el[j] = sacc;
                }
                int i1 = 0; float m1 = el[0];
#pragma unroll
                for (int j = 1; j < 8; ++j) if (el[j] > m1) { m1 = el[j]; i1 = j; }
                int i2 = -1; float m2 = -INFINITY;
#pragma unroll
                for (int j = 0; j < 8; ++j) if (j != i1 && el[j] > m2) { m2 = el[j]; i2 = j; }
                const float e2 = __expf(m2 - m1);
                w1 = pg / (1.f + e2); w2 = pg * e2 / (1.f + e2);
                ea = gs * 8 + i1; eb = gs * 8 + i2;
                ra = atomicAdd(&lcnt[ea], 1);
                rb = atomicAdd(&lcnt[eb], 1);
            }
            __syncthreads();
            if (t < 32) {
                const int n = lcnt[t];
                lcnt[32 + t] = n > 0 ? atomicAdd((int*)(ws + O_CNT) + t * 64, n) : 0;
            }
            __syncthreads();
            if (t < 32) {
                const int tok = tk0 + t;
                int* list = (int*)(ws + O_LIST);
                float* wts = (float*)(ws + O_WTS);
                list[ea * 16384 + lcnt[32 + ea] + ra] = tok * 2;
                wts[tok * 2] = w1;
                list[eb * 16384 + lcnt[32 + eb] + rb] = tok * 2 + 1;
                wts[tok * 2 + 1] = w2;
            }
            __syncthreads();
        }
    }
    const int vb = threadIdx.x >> 8, t = threadIdx.x & 255;
    char* lds = lds_all + vb * VLDS;
    const int NTR = 3072;
    for (int u = blockIdx.x * 2 + vb; u < NTR; u += gridDim.x * 2) {
        {
            const int v = u;
            float* tile = (float*)lds;
            if (v < 2048) {
                const bool up = v >= 1024;
                const int vv = v & 1023, e = vv >> 5, rem = vv & 31, nt = rem >> 4, kt = rem & 15;
                const float* src = P.in[up ? I_WU : I_WG] + (size_t)e * 1024 * 256;
                transpose_tile_w(tile, src, 256, kt * 64, nt * 128, (u16*)(ws + O_WGU) + (size_t)e * 512 * 1024, (up ? 256 : 0) + nt * 128, 1024, nullptr, 0, t);
            } else {
                const int vv = v - 2048, e = vv >> 5, rem = vv & 31, nt = rem >> 2, kt = rem & 3;
                const float* src = P.in[I_WD] + (size_t)e * 256 * 1024;
                transpose_tile_w(tile, src, 1024, kt * 64, nt * 128, (u16*)(ws + O_WD) + (size_t)e * 1024 * 256, nt * 128, 256, nullptr, 0, t);
            }
        }
    }
}

__device__ __forceinline__ void moe_prefix(const unsigned char* ws, int* pre_t, int* pre_c) {
    if (threadIdx.x == 0) {
        const int* cnt = (const int*)(ws + O_CNT);
        int at = 0, ac = 0;
        for (int e = 0; e < 32; ++e) { pre_t[e] = at; pre_c[e] = ac; const int c = cnt[e * 64]; at += (c + 255) >> 8; ac += c; }
        pre_t[32] = at; pre_c[32] = ac;
    }
    __syncthreads();
}
struct MoeUnit { int type, e, mt, pn, cnt, base, mtg; };
struct Moe {
    static constexpr int K = 0; static constexpr bool PERM = true; static constexpr int MIDT = 0;
    typedef MoeUnit Unit;
    const unsigned char* ws; const int* pre_t; const int* pre_c; int G, c;
    __device__ __forceinline__ bool next(int i, Unit& u) const {
        int type, m, pn, e, mt;
        if ((G & 7) == 0) {
            const int x = c & 7, s = c >> 3, nb = G >> 3;
            const int n0 = pre_t[x + 1] - pre_t[x], n1 = pre_t[x + 9] - pre_t[x + 8], n2 = pre_t[x + 17] - pre_t[x + 16], n3 = pre_t[x + 25] - pre_t[x + 24];
            const int MTx = n0 + n1 + n2 + n3;
            const int Lx = i * nb + s;
            if (Lx < MTx * 2) { type = 0; m = Lx >> 1; pn = Lx & 1; }
            else if (Lx < MTx * 6) { const int j = Lx - MTx * 2; type = 1; m = j >> 2; pn = j & 3; }
            else return false;
            if (m < n0) { e = x; mt = m; }
            else if (m < n0 + n1) { e = x + 8; mt = m - n0; }
            else if (m < n0 + n1 + n2) { e = x + 16; mt = m - n0 - n1; }
            else { e = x + 24; mt = m - n0 - n1 - n2; }
        } else {
            const int L = i * G + c, MT = pre_t[32];
            if (L < MT * 2) { type = 0; m = L >> 1; pn = L & 1; }
            else if (L < MT * 6) { const int j = L - MT * 2; type = 1; m = j >> 2; pn = j & 3; }
            else return false;
            e = 0;
            while (pre_t[e + 1] <= m) ++e;
            mt = m - pre_t[e];
        }
        u.e = __builtin_amdgcn_readfirstlane(e); u.mt = __builtin_amdgcn_readfirstlane(mt);
        u.cnt = __builtin_amdgcn_readfirstlane(pre_c[e + 1] - pre_c[e]); u.base = __builtin_amdgcn_readfirstlane(pre_c[e]);
        u.mtg = __builtin_amdgcn_readfirstlane(pre_t[e] + mt); u.pn = __builtin_amdgcn_readfirstlane(pn); u.type = __builtin_amdgcn_readfirstlane(type);
        return true;
    }
    __device__ __forceinline__ int nt(const Unit& u) const { return u.type ? 4 : 16; }
    __device__ __forceinline__ bool brk(const Unit& a, const Unit& b) const { return a.type == 0 && b.type == 1; }
    __device__ __forceinline__ const char* baseA(const Unit& u) const {
        return u.type ? (const char*)(ws + O_H) + (size_t)(u.base + u.mt * 256) * 256 * 2 : (const char*)(ws + O_T);
    }
    __device__ __forceinline__ const char* baseB(const Unit& u) const {
        return u.type ? (const char*)(ws + O_WD) + ((size_t)u.e * 1024 + u.pn * 256) * 256 * 2 : (const char*)(ws + O_WGU) + (size_t)u.e * 512 * 1024 * 2;
    }
    __device__ __forceinline__ void offs(const Unit& u, int tid_, unsigned (&oa)[2][2], unsigned (&ob)[2][2]) const {
        int R[2], C[2];
        { int tq = tid_; asm volatile("" : "+v"(tq)); g8::stage_rc(tq * 16, R[0], C[0]); g8::stage_rc(tq * 16 + 8192, R[1], C[1]); }
        const int* list = (const int*)(ws + O_LIST) + u.e * 16384;
#pragma unroll
        for (int h = 0; h < 2; ++h)
#pragma unroll
            for (int i = 0; i < 2; ++i) {
                const int Rb = (R[i] & ~31) + g8::perm32(R[i] & 31);
                const int idx = u.mt * 256 + h * 128 + R[i];
                const int tok = list[idx < u.cnt ? idx : u.cnt - 1] >> 1;
                if (u.type == 0) {
                    oa[h][i] = (unsigned)(tok * 1024 + C[i]) * 2u;
                    ob[h][i] = (unsigned)((h * 256 + u.pn * 128 + Rb) * 1024 + C[i]) * 2u;
                } else {
                    oa[h][i] = (unsigned)((h * 128 + R[i]) * 256 + C[i]) * 2u;
                    ob[h][i] = (unsigned)((h * 128 + Rb) * 256 + C[i]) * 2u;
                }
            }
    }
    __device__ __forceinline__ void mid(g8::Acc&, const Unit&, int, int) const {}
    __device__ __forceinline__ void a_ready(const Unit& u) const {
        if (u.type == 0) return;
        if (threadIdx.x < 64) {
            unsigned* rdy = (unsigned*)(ws + O_RDY) + u.mtg * 64;
            unsigned spins = 0;
            while ((unsigned)__builtin_amdgcn_readfirstlane(__hip_atomic_load(rdy, __ATOMIC_RELAXED, __HIP_MEMORY_SCOPE_AGENT)) < 16u) {
                __builtin_amdgcn_s_sleep(2);
                if (++spins > (1u << 22)) break;
            }
            __builtin_amdgcn_fence(__ATOMIC_ACQUIRE, "agent");
            asm volatile("s_waitcnt vmcnt(0)" ::: "memory");
        }
        asm volatile("" ::: "memory"); __builtin_amdgcn_s_barrier(); asm volatile("" ::: "memory");
    }
    __device__ __forceinline__ void done(const Unit& u) const {
        if (u.type != 0) return;
        asm volatile("s_waitcnt vmcnt(0)" ::: "memory");
        if ((threadIdx.x & 63) == 0) __hip_atomic_fetch_add((unsigned*)(ws + O_RDY) + u.mtg * 64, 1u, __ATOMIC_RELAXED, __HIP_MEMORY_SCOPE_AGENT);
    }
    __device__ __forceinline__ void epi(g8::Acc& acc, const Unit& u, int wr, int wc, int fr, int fq) const {
        if (u.type == 0) {
            __amdgpu_buffer_rsrc_t rs = __builtin_amdgcn_make_buffer_rsrc((void*)(ws + O_H), 0, (int)((32768 + 256) * 256 * 2), 0x00020000);
#pragma unroll
            for (int ai = 0; ai < 2; ++ai)
#pragma unroll
                for (int m = 0; m < 4; ++m) {
                    const int idx = u.mt * 256 + ai * 128 + wr * 64 + m * 16 + fr;
                    const f32x4 g0 = acc[ai][0][m][0], g1 = acc[ai][0][m][1], u0 = acc[ai][1][m][0], u1 = acc[ai][1][m][1];
                    u32x4 o;
                    o.x = g8::cvt_pk_bf16(siluf(g0[0]) * u0[0], siluf(g0[1]) * u0[1]); o.y = g8::cvt_pk_bf16(siluf(g0[2]) * u0[2], siluf(g0[3]) * u0[3]);
                    o.z = g8::cvt_pk_bf16(siluf(g1[0]) * u1[0], siluf(g1[1]) * u1[1]); o.w = g8::cvt_pk_bf16(siluf(g1[2]) * u1[2], siluf(g1[3]) * u1[3]);
                    const unsigned off = idx < u.cnt ? ((unsigned)(u.base + idx) * 256u + (unsigned)(u.pn * 128 + wc * 32 + 8 * fq)) * 2u : 0xF0000000u;
                    __builtin_amdgcn_raw_buffer_store_b128(o, rs, off, 0, 16);
                    __builtin_amdgcn_sched_barrier(0);
                }
            return;
        }
        const int* list = (const int*)(ws + O_LIST) + u.e * 16384;
        const float* wts = (const float*)(ws + O_WTS);
        __amdgpu_buffer_rsrc_t rsl = __builtin_amdgcn_make_buffer_rsrc((void*)(ws + O_SL), 0, (int)(16384 * 2 * 1024 * 2), 0x00020000);
        int ent[2][4]; float wg[2][4];
#pragma unroll
        for (int ai = 0; ai < 2; ++ai)
#pragma unroll
            for (int m = 0; m < 4; ++m) {
                const int idx = u.mt * 256 + ai * 128 + wr * 64 + m * 16 + fr;
                ent[ai][m] = list[idx < u.cnt ? idx : u.cnt - 1];
            }
#pragma unroll
        for (int ai = 0; ai < 2; ++ai)
#pragma unroll
            for (int m = 0; m < 4; ++m) wg[ai][m] = wts[ent[ai][m]];
#pragma unroll
        for (int ai = 0; ai < 2; ++ai)
#pragma unroll
            for (int m = 0; m < 4; ++m) {
                const int idx = u.mt * 256 + ai * 128 + wr * 64 + m * 16 + fr;
                const unsigned off = idx < u.cnt ? ((unsigned)ent[ai][m] * 1024u + (unsigned)(u.pn * 256 + wc * 32 + 8 * fq)) * 2u : 0xF0000000u;
#pragma unroll
                for (int bj = 0; bj < 2; ++bj) {
                    const f32x4 v0 = acc[ai][bj][m][0] * wg[ai][m], v1 = acc[ai][bj][m][1] * wg[ai][m];
                    u32x4 o; o.x = g8::cvt_pk_bf16(v0[0], v0[1]); o.y = g8::cvt_pk_bf16(v0[2], v0[3]); o.z = g8::cvt_pk_bf16(v1[0], v1[1]); o.w = g8::cvt_pk_bf16(v1[2], v1[3]);
                    __builtin_amdgcn_raw_buffer_store_b128(o, rsl, off + bj * 256u, 0, 0);
                }
            }
    }
};
__device__ void phase9(const Params& P, char* lds) {
    int* pre_t = (int*)(lds + g8::STAGE_BYTES); int* pre_c = pre_t + 40;
    moe_prefix(P.ws, pre_t, pre_c);
    Moe S; S.ws = P.ws; S.pre_t = pre_t; S.pre_c = pre_c; S.G = gridDim.x; S.c = blockIdx.x;
    int i = 0;
    while (i >= 0) i = g8::gemm_phase<Moe>((LAS unsigned char*)lds, S, i);
}

__device__ void phase11(const Params& P) {
    unsigned char* ws = P.ws;
    const int lane = threadIdx.x & 63;
    const int gw = blockIdx.x * 8 + (threadIdx.x >> 6), nw = gridDim.x * 8;
    const float* mod = (const float*)(ws + O_MOD);
    const u16* SL = (const u16*)(ws + O_SL);
    const int r_lo = (int)(((long long)gw * MLAT) / nw), r_hi = (int)(((long long)(gw + 1) * MLAT) / nw);
    float4 g2[4], fw[4];
    int cur_b = -1;
#pragma unroll
    for (int j = 0; j < 4; ++j) fw[j] = *(const float4*)(P.in[I_FNW] + (lane + 64 * j) * 4);
    for (int row = r_lo; row < r_hi; row += 2) {
        const bool two = row + 1 < r_hi;
        const int row1 = two ? row + 1 : row;
        float4 v0[4], v1[4]; uint2 a0[4], a1[4], b0[4], b1[4];
#pragma unroll
        for (int j = 0; j < 4; ++j) {
            const int k = (lane + 64 * j) * 4;
            v0[j] = *(const float4*)(P.out + (size_t)row * 1024 + k);
            v1[j] = *(const float4*)(P.out + (size_t)row1 * 1024 + k);
            a0[j] = *(const uint2*)(SL + (size_t)(row * 2) * 1024 + k);
            a1[j] = *(const uint2*)(SL + (size_t)(row * 2 + 1) * 1024 + k);
            b0[j] = *(const uint2*)(SL + (size_t)(row1 * 2) * 1024 + k);
            b1[j] = *(const uint2*)(SL + (size_t)(row1 * 2 + 1) * 1024 + k);
        }
#pragma unroll 1
        for (int rr = 0; rr < 2; ++rr) {
            const int orow = rr ? row1 : row;
            const int b = orow >> 12;
            if (b != cur_b) {
                cur_b = b;
#pragma unroll
                for (int j = 0; j < 4; ++j) g2[j] = *(const float4*)(mod + b * 6144 + 5120 + (lane + 64 * j) * 4);
            }
            if (rr == 1 && !two) break;
            float4 x[4]; float ss = 0.f;
#pragma unroll
            for (int j = 0; j < 4; ++j) {
                const float4 vv = rr ? v1[j] : v0[j];
                const uint2 s0 = rr ? b0[j] : a0[j], s1 = rr ? b1[j] : a1[j];
                x[j].x = vv.x + g2[j].x * (bflo(s0.x) + bflo(s1.x));
                x[j].y = vv.y + g2[j].y * (bfhi(s0.x) + bfhi(s1.x));
                x[j].z = vv.z + g2[j].z * (bflo(s0.y) + bflo(s1.y));
                x[j].w = vv.w + g2[j].w * (bfhi(s0.y) + bfhi(s1.y));
                ss += x[j].x * x[j].x + x[j].y * x[j].y + x[j].z * x[j].z + x[j].w * x[j].w;
            }
            const float rstd = rsqrtf(wave_sum(ss) * (1.f / 1024.f) + 1e-6f);
#pragma unroll
            for (int j = 0; j < 4; ++j) {
                float4 o; o.x = x[j].x * rstd * fw[j].x; o.y = x[j].y * rstd * fw[j].y; o.z = x[j].z * rstd * fw[j].z; o.w = x[j].w * rstd * fw[j].w;
                *(float4*)(P.out + (size_t)orow * 1024 + (lane + 64 * j) * 4) = o;
            }
        }
    }
}

__global__ void __launch_bounds__(NTB, 2) fwd_kernel(Params P) {
    extern __shared__ __attribute__((aligned(16))) char lds[];
    if (threadIdx.x < 4) ((volatile LAS unsigned*)(lds + LDS_MAIN))[threadIdx.x] = 0u;
    __syncthreads();
    XcdBarrier xbar = xcd_barrier_post((unsigned*)(P.ws + O_BAR), (volatile LAS unsigned*)(lds + LDS_MAIN));
#define SYNC() xcd_barrier(xbar)
#ifdef ONLY_PH
#define RUN_PHASE(k, call) do { if ((k) == ONLY_PH) { call; } } while (0)
#else
#define RUN_PHASE(k, call) do { if (P.lo <= (k) && (k) < P.hi) { call; if ((k) + 1 < P.hi) { SYNC(); } } } while (0)
#endif
    RUN_PHASE(0, phase0(P, lds));
    RUN_PHASE(1, phase1(P));
    RUN_PHASE(2, { InProj S; S.ws = P.ws; S.G = gridDim.x; S.c = blockIdx.x; g8::gemm_phase<InProj>((LAS unsigned char*)lds, S); });
    RUN_PHASE(3, phase3(P, lds));
    RUN_PHASE(4, phase4(P, lds));
    RUN_PHASE(5, phase5(P));
    RUN_PHASE(6, phase6(P, lds));
    RUN_PHASE(7, phase7(P, lds));
    RUN_PHASE(8, phase8(P, lds));
    RUN_PHASE(9, phase9(P, lds));
    RUN_PHASE(11, phase11(P));
}

extern "C" void kernel_launch(void* const* d_in, const int* in_sizes, int n_in, void* d_out, int out_size, void* d_ws, size_t ws_size,
                              hipStream_t stream) {
    static int grid_blocks = 0;
    if (!grid_blocks) {
        int dev = 0, cus = 0, per_cu = 0;
        (void)hipGetDevice(&dev);
        (void)hipDeviceGetAttribute(&cus, hipDeviceAttributeMultiprocessorCount, dev);
        (void)hipFuncSetAttribute((const void*)fwd_kernel, hipFuncAttributeMaxDynamicSharedMemorySize, LDS_BYTES);
        (void)hipOccupancyMaxActiveBlocksPerMultiprocessor(&per_cu, (const void*)fwd_kernel, NTB, LDS_BYTES);
        if (per_cu < 1) fprintf(stderr, "occupancy query says %d blocks per CU\n", per_cu);
        grid_blocks = cus;
        if (ws_size < WS_END) fprintf(stderr, "workspace too small: %zu < %zu\n", ws_size, (size_t)WS_END);
    }
    Params p{};
    for (int i = 0; i < 30; ++i) p.in[i] = (const float*)d_in[i];
    p.out = (float*)d_out; p.ws = (unsigned char*)d_ws;
    p.lo = 0; p.hi = NPHASE;
    (void)hipMemsetAsync((char*)d_ws + O_BAR, 0, 16384 + 40960, stream);
    void* args[] = {&p};
    hipError_t e = hipLaunchCooperativeKernel((const void*)fwd_kernel, dim3(grid_blocks), dim3(NTB), args, LDS_BYTES, stream);
    if (e != hipSuccess) fprintf(stderr, "cooperative launch failed: %s (grid %d)\n", hipGetErrorString(e), grid_blocks);
}
```

```cpp
#include <hip/hip_runtime.h>
#include <cstdio>
#include <cstdint>

typedef unsigned short u16;
typedef __attribute__((ext_vector_type(8))) short bf16x8;
typedef __attribute__((ext_vector_type(4))) float f32x4;
typedef __attribute__((ext_vector_type(4))) unsigned u32x4;
#define LAS __attribute__((address_space(3)))

constexpr int NTB = 512;
constexpr int VLDS = 75776;
constexpr int LDS_MAIN = 2 * VLDS;
constexpr int LDS_BYTES = LDS_MAIN + 256;
constexpr int MLAT = 16384, MALL = 17408;
constexpr int NCH = 34;
constexpr int NPHASE = 12;

enum { I_X = 0, I_C, I_CTX, I_CCTX, I_WMOD, I_BMOD, I_N1W, I_WIN, I_SCW, I_SCB, I_DTB, I_ALOG, I_SSDD, I_SNW, I_MCW, I_MCB, I_WQK, I_GB,
       I_MNW, I_MSKIP, I_WOUT, I_N2W, I_RGW, I_RGB, I_REW, I_REB, I_WG, I_WU, I_WD, I_FNW };

constexpr size_t al(size_t x) { return (x + 255) & ~(size_t)255; }
constexpr size_t O_MOD = 0;
constexpr size_t O_SSQ = O_MOD + al(5 * 6144 * 4);
constexpr size_t O_CNT = O_SSQ + al(16384 * 16 * 4);
constexpr size_t O_BAR = O_CNT + 8192;
constexpr size_t O_RDY = O_BAR + 16384;
constexpr size_t O_PSD = O_RDY + 40960;
constexpr size_t O_PSG = O_PSD + al((size_t)MALL * 16 * 4);
constexpr size_t O_DT = O_PSG + al((size_t)MALL * 16 * 4);
constexpr size_t O_GI = O_DT + al((size_t)MALL * 16 * 4);
constexpr size_t O_GF = O_GI + al((size_t)MALL * 8 * 4);
constexpr size_t O_ACH = O_GF + al((size_t)MALL * 8 * 4);
constexpr size_t O_MLS = O_ACH + 16384;
constexpr size_t O_MLP = O_MLS + 16384;
constexpr size_t O_MLN = O_MLP + 16384;
constexpr size_t O_LIST = O_MLN + al(4 * 34 * 4 * 2 * 128 * 4);
constexpr size_t O_WTS = O_LIST + al(32 * 16384 * 4);
constexpr size_t O_WIN = O_WTS + al(16384 * 2 * 4);
constexpr size_t O_WOUT = O_WIN + al((size_t)3328 * 1024 * 2);
constexpr size_t O_A = O_WOUT + al((size_t)1024 * 1024 * 2);
constexpr size_t SZ_A = (size_t)MALL * 1024 * 2;
constexpr size_t O_PT = O_A + SZ_A;
constexpr size_t SZ_PT = (size_t)MALL * 1536 * 2;
constexpr size_t O_MLC1 = O_PT + SZ_PT;
constexpr size_t SZ_HALF = (size_t)MALL * 512 * 2;
constexpr size_t O_ZO = O_MLC1 + SZ_HALF;
constexpr size_t O_VT = O_ZO + SZ_A;
constexpr size_t O_BM = O_VT + SZ_HALF;
constexpr size_t SZ_Q = (size_t)MALL * 256 * 2;
constexpr size_t O_BT = O_BM + SZ_Q;
constexpr size_t O_CM = O_BT + SZ_Q;
constexpr size_t O_XT = O_CM + SZ_Q;
constexpr size_t O_KT = O_XT + SZ_HALF;
constexpr size_t O_XC = O_KT + SZ_HALF;
constexpr size_t O_DUMP = O_XC + SZ_HALF;
constexpr size_t WS_END = O_DUMP + 256 * 2048;
constexpr size_t O_XN = O_A, O_Q = O_A, O_K = O_A + SZ_HALF, O_T = O_A;
constexpr size_t O_ST = O_PT;
constexpr size_t O_MLC0 = O_PT + (size_t)4 * 34 * 8 * 2 * 8192 * 2;
constexpr size_t O_WGU = O_PT;
constexpr size_t O_WD = O_PT + (size_t)32 * 512 * 1024 * 2;
constexpr size_t O_SL = O_ZO;
constexpr size_t O_H = O_XT;
static_assert(O_WD + (size_t)32 * 1024 * 256 * 2 <= O_MLC1, "moe weights fit PT region");
static_assert(O_SL + (size_t)16384 * 2 * 1024 * 2 <= O_CM, "slots fit");
static_assert((size_t)(32768 + 256) * 256 * 2 <= SZ_HALF, "H fits");
static_assert(WS_END <= (size_t)256 * 1024 * 1024, "workspace");
constexpr size_t TCTX512 = (size_t)4 * 512 * 4096;
constexpr size_t TCTX256 = (size_t)4 * 256 * 4096;

struct Params { const float* in[30]; float* out; unsigned char* ws; int lo, hi; };

#define XB_TMO      128
#define XB_XCNT(j)  (256  + 64 * (j))
#define XB_XSUB(j)  (1280 + 64 * (j))
#define XB_XGEN(j)  (2304 + 64 * (j))
#define XB_TOP      3328
#define XB_TOPGEN   3392
#define XCD_BAR_WORDS 3456
#define XB_SPIN_CAP (1u << 20)
__device__ __forceinline__ unsigned xb_ld(unsigned* p)              { return __hip_atomic_load(p, __ATOMIC_RELAXED, __HIP_MEMORY_SCOPE_AGENT); }
__device__ __forceinline__ unsigned xb_add(unsigned* p, unsigned v) { return __hip_atomic_fetch_add(p, v, __ATOMIC_RELAXED, __HIP_MEMORY_SCOPE_AGENT); }
__device__ __forceinline__ unsigned xb_xcc_id() { return (unsigned)__builtin_amdgcn_s_getreg((3 << 11) | 20) & 0xFu; }
#define XB_SPIN(cond, bar) do { unsigned _sp = 0; while (cond) { __builtin_amdgcn_s_sleep(1); \
    if ((++_sp & 255u) == 0u) { if (xb_ld(&(bar)[XB_TMO])) break; if (_sp > XB_SPIN_CAP) { atomicAdd(&(bar)[XB_TMO], 1u); break; } } } } while (0)
struct XcdBarrier { unsigned* bar; unsigned x; volatile LAS unsigned* st; };
__device__ __forceinline__ XcdBarrier xcd_barrier_post(unsigned* bar, volatile LAS unsigned* st) {
    XcdBarrier b; b.bar = bar; b.x = xb_xcc_id(); b.st = st;
    if (threadIdx.x == 0) (void)xb_add(&bar[XB_XCNT(b.x)], 1u);
    return b;
}
__device__ __forceinline__ void xcd_barrier_complete(unsigned* bar, unsigned x, unsigned& nloc, unsigned& nx) {
    const unsigned G = gridDim.x * gridDim.y * gridDim.z;
    unsigned sum, cnt, mine, sp = 0u;
    for (;;) {
        sum = 0u; cnt = 0u; mine = 0u;
#pragma unroll
        for (unsigned j = 0; j < 16; ++j) { const unsigned c = xb_ld(&bar[XB_XCNT(j)]); sum += c; cnt += (c > 0u) ? 1u : 0u; mine = (j == x) ? c : mine; }
        if (sum == G) break;
        __builtin_amdgcn_s_sleep(1);
        if ((++sp & 255u) == 0u) { if (xb_ld(&bar[XB_TMO])) break; if (sp > XB_SPIN_CAP) { atomicAdd(&bar[XB_TMO], 1u); break; } }
    }
    nloc = mine > 0u ? mine : 1u; nx = cnt > 0u ? cnt : 1u;
}
__device__ __forceinline__ void xcd_barrier(const XcdBarrier& b) {
    asm volatile("s_waitcnt vmcnt(0)" ::: "memory");
    __syncthreads();
    if (threadIdx.x == 0) {
        unsigned* bar = b.bar;
        __builtin_amdgcn_s_waitcnt(0);
        unsigned nloc = b.st[0], nx = b.st[1];
        if (nloc == 0u) { xcd_barrier_complete(bar, b.x, nloc, nx); b.st[0] = nloc; b.st[1] = nx; }
        const unsigned old = xb_add(&bar[XB_XSUB(b.x)], 1u);
        const unsigned gen = old / nloc;
        if (old + 1u == (gen + 1u) * nloc) {
            __builtin_amdgcn_fence(__ATOMIC_RELEASE, "agent");
            asm volatile("s_waitcnt vmcnt(0)" ::: "memory");
            const unsigned og = xb_add(&bar[XB_TOP], 1u);
            const unsigned tg = og / nx;
            if (og + 1u == (tg + 1u) * nx) xb_add(&bar[XB_TOPGEN], 1u);
            else XB_SPIN(xb_ld(&bar[XB_TOPGEN]) == tg, bar);
            __builtin_amdgcn_fence(__ATOMIC_ACQUIRE, "agent");
            xb_add(&bar[XB_XGEN(b.x)], 1u);
            asm volatile("s_waitcnt vmcnt(0)" ::: "memory");
        } else {
            XB_SPIN(xb_ld(&bar[XB_XGEN(b.x)]) == gen, bar);
            __builtin_amdgcn_fence(__ATOMIC_ACQUIRE, "agent");
            asm volatile("s_waitcnt vmcnt(0)" ::: "memory");
        }
    }
    __syncthreads();
}

__device__ __forceinline__ u16 f2bf(float f) { unsigned u = __float_as_uint(f); u += 0x7fffu + ((u >> 16) & 1u); return (u16)(u >> 16); }
__device__ __forceinline__ float bf2f(u16 h) { return __uint_as_float(((unsigned)h) << 16); }
__device__ __forceinline__ unsigned pack2(float a, float b) { return (unsigned)f2bf(a) | ((unsigned)f2bf(b) << 16); }
__device__ __forceinline__ float bflo(unsigned u) { return __uint_as_float(u << 16); }
__device__ __forceinline__ float bfhi(unsigned u) { return __uint_as_float(u & 0xffff0000u); }
__device__ __forceinline__ float siluf(float x) { return x / (1.f + __expf(-x)); }
__device__ __forceinline__ float sigmf(float x) { return 1.f / (1.f + __expf(-x)); }
__device__ __forceinline__ float softplusf(float x) { return x > 20.f ? x : log1pf(__expf(x)); }
__device__ __forceinline__ float wave_sum(float v) {
#pragma unroll
    for (int o = 32; o > 0; o >>= 1) v += __shfl_xor(v, o);
    return v;
}
__device__ __forceinline__ int swz256(int row, int chunk) { return row * 256 + ((chunk ^ (row & 15)) << 4); }
__device__ __forceinline__ int colmajor_src_row(int R) {
    if (R >= MLAT) return R;
    const int b = R >> 12, lp = R & 4095;
    return (b << 12) + ((lp & 63) << 6) + (lp >> 6);
}

__device__ __forceinline__ void load_tile128(char* lds, int lrow0, const u16* __restrict__ g, size_t ld, int rows, int t, int nthr) {
#pragma unroll 4
    for (int q = t; q < rows * 16; q += nthr) {
        const int r = q >> 4, c = q & 15;
        const uint4 v = *(const uint4*)(g + (size_t)r * ld + c * 8);
        *(uint4*)(lds + swz256(lrow0 + r, c)) = v;
    }
}
__device__ __forceinline__ void load_tile128_scaled(char* lds, int lrow0, const u16* __restrict__ g, size_t ld, int rows, const float* w, int t, int nthr) {
#pragma unroll 2
    for (int q = t; q < rows * 16; q += nthr) {
        const int r = q >> 4, c = q & 15;
        const uint4 v = *(const uint4*)(g + (size_t)r * ld + c * 8);
        const float* ww = w + c * 8;
        uint4 o;
        o.x = pack2(bflo(v.x) * ww[0], bfhi(v.x) * ww[1]);
        o.y = pack2(bflo(v.y) * ww[2], bfhi(v.y) * ww[3]);
        o.z = pack2(bflo(v.z) * ww[4], bfhi(v.z) * ww[5]);
        o.w = pack2(bflo(v.w) * ww[6], bfhi(v.w) * ww[7]);
        *(uint4*)(lds + swz256(lrow0 + r, c)) = o;
    }
}
template <int MI, int NJ>
__device__ __forceinline__ void lds_mma(const char* A, const char* B, int arow0, int brow0, f32x4 (&acc)[MI][NJ], int lane) {
#pragma unroll 1
    for (int kk = 0; kk < 4; ++kk) {
        const int chunk = kk * 4 + (lane >> 4);
        bf16x8 a[MI], b[NJ];
#pragma unroll
        for (int i = 0; i < MI; ++i) { const int row = arow0 + i * 16 + (lane & 15); a[i] = *(const bf16x8*)(A + swz256(row, chunk)); }
#pragma unroll
        for (int j = 0; j < NJ; ++j) { const int row = brow0 + j * 16 + (lane & 15); b[j] = *(const bf16x8*)(B + swz256(row, chunk)); }
#pragma unroll
        for (int i = 0; i < MI; ++i)
#pragma unroll
            for (int j = 0; j < NJ; ++j) acc[i][j] = __builtin_amdgcn_mfma_f32_16x16x32_bf16(a[i], b[j], acc[i][j], 0, 0, 0);
    }
}
template <int MI, int NJ>
__device__ __forceinline__ void lds_mma_t(const char* A, const char* B, int arow0, int brow0, f32x4 (&acc)[MI][NJ], int lane) {
#pragma unroll 1
    for (int kk = 0; kk < 4; ++kk) {
        const int chunk = kk * 4 + (lane >> 4);
        bf16x8 a[MI], b[NJ];
#pragma unroll
        for (int i = 0; i < MI; ++i) { const int row = arow0 + i * 16 + (lane & 15); a[i] = *(const bf16x8*)(A + swz256(row, chunk)); }
#pragma unroll
        for (int j = 0; j < NJ; ++j) { const int row = brow0 + j * 16 + (lane & 15); b[j] = *(const bf16x8*)(B + swz256(row, chunk)); }
#pragma unroll
        for (int i = 0; i < MI; ++i)
#pragma unroll
            for (int j = 0; j < NJ; ++j) acc[i][j] = __builtin_amdgcn_mfma_f32_16x16x32_bf16(b[j], a[i], acc[i][j], 0, 0, 0);
    }
}
template <int MI, int NJ>
__device__ __forceinline__ void zero_acc(f32x4 (&acc)[MI][NJ]) {
#pragma unroll
    for (int i = 0; i < MI; ++i)
#pragma unroll
        for (int j = 0; j < NJ; ++j) acc[i][j] = f32x4{0.f, 0.f, 0.f, 0.f};
}
template <int OP>
__device__ __forceinline__ float scan_pair(float v, float* buf, int t) {
    const int idx = t & 127, base = t & 128;
    const bool act = t < 256;
    if (act) buf[t] = v;
    __syncthreads();
#pragma unroll 1
    for (int off = 1; off < 128; off <<= 1) {
        float o = OP ? -INFINITY : 0.f;
        if (act && idx >= off) o = buf[base + idx - off];
        __syncthreads();
        v = OP ? fmaxf(v, o) : v + o;
        if (act) buf[t] = v;
        __syncthreads();
    }
    return v;
}

__device__ __forceinline__ float wave_scan_sum(float v, int lane) {
#pragma unroll
    for (int off = 1; off < 64; off <<= 1) { const float o = __shfl_up(v, off); if (lane >= off) v += o; }
    return v;
}
__device__ __forceinline__ float wave_scan_max(float v, int lane) {
#pragma unroll
    for (int off = 1; off < 64; off <<= 1) { const float o = __shfl_up(v, off); if (lane >= off) v = fmaxf(v, o); }
    return v;
}
__device__ __forceinline__ float wave_max(float v) {
#pragma unroll
    for (int o = 32; o > 0; o >>= 1) v = fmaxf(v, __shfl_xor(v, o));
    return v;
}
__device__ __forceinline__ void transpose_tile(float* tile, const float* __restrict__ src, int ld_src, int k0, int n0, int ncount,
                                               u16* dst, size_t dst_row0, int ld_dst, const float* __restrict__ scale, int scale_kmax, int t) {
    const int n = t & 63, kq = t >> 6;
    const int nc = n < ncount ? n : ncount - 1;
    float vv[16];
#pragma unroll
    for (int i = 0; i < 16; ++i) vv[i] = src[(size_t)(k0 + i * 4 + kq) * ld_src + n0 + nc];
#pragma unroll
    for (int i = 0; i < 16; ++i) {
        const int k = i * 4 + kq;
        float v = vv[i];
        if (scale && (k0 + k) < scale_kmax) v *= scale[k0 + k];
        tile[k * 65 + n] = n < ncount ? v : 0.f;
    }
    __syncthreads();
#pragma unroll
    for (int i = 0; i < 2; ++i) {
        const int q = t + 256 * i, nn = q >> 3, kc = q & 7;
        if (nn < ncount) {
            const float* p = tile + (kc * 8) * 65 + nn;
            uint4 o;
            o.x = pack2(p[0], p[65]); o.y = pack2(p[130], p[195]); o.z = pack2(p[260], p[325]); o.w = pack2(p[390], p[455]);
            *(uint4*)(dst + (dst_row0 + nn) * (size_t)ld_dst + k0 + kc * 8) = o;
        }
    }
    __syncthreads();
}

__device__ __forceinline__ void transpose_tile_w(float* tile, const float* __restrict__ src, int ld_src, int k0, int n0,
                                                 u16* dst, size_t dst_row0, int ld_dst, const float* __restrict__ scale, int scale_kmax, int t) {
    f32x4 v[8]; float scv[8];
#pragma unroll
    for (int i = 0; i < 8; ++i) {
        const int q = t + 256 * i, kr = q >> 5, nq = q & 31;
        v[i] = *(const f32x4*)(src + (size_t)(k0 + kr) * ld_src + n0 + nq * 4);
        scv[i] = 1.f;
        if (scale) { const int kc = (k0 + kr) < scale_kmax ? (k0 + kr) : scale_kmax - 1; const float sv = scale[kc]; scv[i] = (k0 + kr) < scale_kmax ? sv : 1.f; }
    }
    __builtin_amdgcn_sched_barrier(0);
#pragma unroll
    for (int i = 0; i < 8; ++i) {
        const int q = t + 256 * i, kr = q >> 5, nq = q & 31;
        float* p = tile + kr * 129 + nq * 4;
        p[0] = v[i][0] * scv[i]; p[1] = v[i][1] * scv[i]; p[2] = v[i][2] * scv[i]; p[3] = v[i][3] * scv[i];
    }
    __syncthreads();
#pragma unroll
    for (int i = 0; i < 4; ++i) {
        const int q = t + 256 * i, nn = q >> 3, kc = q & 7;
        const float* p = tile + (kc * 8) * 129 + nn;
        uint4 o;
        o.x = pack2(p[0], p[129]); o.y = pack2(p[258], p[387]); o.z = pack2(p[516], p[645]); o.w = pack2(p[774], p[903]);
        *(uint4*)(dst + (dst_row0 + nn) * (size_t)ld_dst + k0 + kc * 8) = o;
    }
    __syncthreads();
}

namespace g8 {
constexpr int BM = 256, BK = 64, HALF = 128, HTB = HALF * BK * 2, STAGE_BYTES = 8 * HTB;
__device__ __forceinline__ int lds_byte(int r, int c) { const int st = (r >> 4) * 2 + (c >> 5), rr = r & 15, cc = c & 31, ob = rr * 64 + cc * 2; return st * 1024 + (ob ^ (((ob >> 9) & 1) << 5)); }
__device__ __forceinline__ void stage_rc(int b, int& R, int& C) { const int st = b / 1024, sb = b % 1024, swz = sb ^ (((sb >> 9) & 1) << 5); R = (st >> 1) * 16 + swz / 64; C = (st & 1) * 32 + (swz % 64) / 2; }
__device__ __forceinline__ int perm32(int rho) { const int n = rho >> 4, i = rho & 15; return 8 * (i >> 2) + 4 * n + (i & 3); }
__device__ __forceinline__ unsigned cvt_pk_bf16(float lo, float hi) { unsigned r; asm volatile("v_cvt_pk_bf16_f32 %0, %1, %2" : "=v"(r) : "v"(lo), "v"(hi)); return r; }
typedef f32x4 Acc[2][2][4][2];

template <class Prob>
__device__ __forceinline__ int gemm_phase(LAS unsigned char* lds, const Prob& S, int i0 = 0) {
    const int tid = threadIdx.x, wid = __builtin_amdgcn_readfirstlane(tid >> 6), lane = tid & 63, wr = wid >> 2, wc = wid & 3, fr = lane & 15, fq = lane >> 4;
    int nt = 0;
    const size_t kstep = (size_t)(BK * 2);
    const unsigned ldsw = (unsigned)wid * 1024u;
    const int aoff = lds_byte(wr * 64 + fr, fq * 8), boff = lds_byte(wc * 32 + fr, fq * 8);
#define G8_SA(b, h) (((b) * 2 + (h)) * HTB)
#define G8_SB(b, h) ((4 + (b) * 2 + (h)) * HTB)
#define G8_STAGE(bufoff, gbase, voff) do { _Pragma("unroll") for (int _i = 0; _i < 2; ++_i) \
        __builtin_amdgcn_global_load_lds((const unsigned*)((const char*)(gbase) + (voff)[_i]), (LAS unsigned*)(lds + (bufoff) + ldsw + _i * 8192), 16, 0, 0); } while (0)
#define G8_LDA(dst, b, h) do { _Pragma("unroll") for (int m = 0; m < 4; ++m) _Pragma("unroll") for (int k = 0; k < 2; ++k) dst[m][k] = *(const LAS bf16x8*)(lds + G8_SA(b, h) + aoff + m * 2048 + k * 1024); } while (0)
#define G8_LDB(dst, b, h) do { _Pragma("unroll") for (int n = 0; n < 2; ++n) _Pragma("unroll") for (int k = 0; k < 2; ++k) dst[n][k] = *(const LAS bf16x8*)(lds + G8_SB(b, h) + boff + n * 2048 + k * 1024); } while (0)
#define G8_MMA(ai, bj, At, Bt) do { __builtin_amdgcn_s_setprio(1); _Pragma("unroll") for (int m = 0; m < 4; ++m) _Pragma("unroll") for (int n = 0; n < 2; ++n) _Pragma("unroll") for (int k = 0; k < 2; ++k) \
        acc[ai][bj][m][n] = __builtin_amdgcn_mfma_f32_16x16x32_bf16(Bt[n][k], At[m][k], acc[ai][bj][m][n], 0, 0, 0); __builtin_amdgcn_s_setprio(0); } while (0)
#define G8_WAIT_V(n) asm volatile("s_waitcnt vmcnt(" #n ")" ::: "memory")
#define G8_WAIT_L(n) asm volatile("s_waitcnt lgkmcnt(" #n ")" ::: "memory")
#define G8_BAR __builtin_amdgcn_s_barrier()
#define G8_SCHED __builtin_amdgcn_sched_barrier(0)
    typename Prob::Unit cur, nxt; int ui = i0; bool stopped = false;
    if (!S.next(i0, cur)) return -1;
    nt = S.nt(cur);
    S.a_ready(cur);
    Acc acc;
#pragma unroll
    for (int a = 0; a < 2; ++a)
#pragma unroll
        for (int b = 0; b < 2; ++b)
#pragma unroll
            for (int m = 0; m < 4; ++m)
#pragma unroll
                for (int n = 0; n < 2; ++n) acc[a][b][m][n] = (f32x4){0.f, 0.f, 0.f, 0.f};
    bf16x8 At[4][2], B0[2][2], B1[2][2];
    unsigned cOA[2][2], cOB[2][2], nOA[2][2], nOB[2][2];
    S.offs(cur, tid, cOA, cOB);
    const char* cA = S.baseA(cur); const char* cB = S.baseB(cur);
    G8_STAGE(G8_SB(0, 0), cB, cOB[0]); G8_STAGE(G8_SA(0, 0), cA, cOA[0]); G8_STAGE(G8_SB(0, 1), cB, cOB[1]); G8_STAGE(G8_SA(0, 1), cA, cOA[1]);
    if (wr == 1) G8_BAR;
    G8_WAIT_V(4); G8_BAR;
    G8_STAGE(G8_SB(1, 0), cB + kstep, cOB[0]); G8_STAGE(G8_SA(1, 0), cA + kstep, cOA[0]); G8_STAGE(G8_SB(1, 1), cB + kstep, cOB[1]);
    G8_WAIT_V(6); G8_BAR;
    for (;;) {
        bool has_next = S.next(ui + 1, nxt);
        if (has_next && S.brk(cur, nxt)) { has_next = false; stopped = true; }
        const char* nA = cA; const char* nB = cB;
#pragma unroll
        for (int h = 0; h < 2; ++h)
#pragma unroll
            for (int i = 0; i < 2; ++i) { nOA[h][i] = cOA[h][i]; nOB[h][i] = cOB[h][i]; }
        if (has_next) { S.offs(nxt, tid, nOA, nOB); nA = S.baseA(nxt); nB = S.baseB(nxt); }
#pragma unroll 1
        for (int t = 0; t < nt; t += 2) {
            const bool last = (t == nt - 2);
            if (Prob::MIDT > 0 && t == Prob::MIDT) S.mid(acc, cur, wr, fr);
            if (last && has_next) S.a_ready(nxt);
            const char* a1 = cA + (size_t)(t + 1) * kstep;
            const char* a2 = last ? nA : cA + (size_t)(t + 2) * kstep; const char* b2 = last ? nB : cB + (size_t)(t + 2) * kstep;
            const char* a3 = a2 + kstep; const char* b3 = b2 + kstep;
            unsigned xA[2][2], xB[2][2];
#pragma unroll
            for (int h = 0; h < 2; ++h)
#pragma unroll
                for (int i = 0; i < 2; ++i) { xA[h][i] = last ? nOA[h][i] : cOA[h][i]; xB[h][i] = last ? nOB[h][i] : cOB[h][i]; }
            G8_LDB(B0, 0, 0); G8_SCHED; G8_LDA(At, 0, 0); G8_STAGE(G8_SA(1, 1), a1, cOA[1]);
            G8_WAIT_L(8); G8_BAR; G8_WAIT_L(0); G8_MMA(0, 0, At, B0); G8_BAR; G8_SCHED;
            G8_LDB(B1, 0, 1); G8_STAGE(G8_SB(0, 0), b2, xB[0]);
            G8_BAR; G8_WAIT_L(0); G8_MMA(0, 1, At, B1); G8_BAR;
            G8_LDA(At, 0, 1); G8_STAGE(G8_SA(0, 0), a2, xA[0]);
            G8_BAR; G8_WAIT_L(0); G8_MMA(1, 0, At, B0); G8_BAR; G8_SCHED;
            G8_STAGE(G8_SB(0, 1), b2, xB[1]);
            G8_WAIT_V(6); G8_BAR; G8_MMA(1, 1, At, B1); G8_BAR;
            G8_LDB(B0, 1, 0); G8_SCHED; G8_LDA(At, 1, 0); G8_STAGE(G8_SA(0, 1), a2, xA[1]);
            G8_WAIT_L(8); G8_BAR; G8_WAIT_L(0); G8_MMA(0, 0, At, B0); G8_BAR; G8_SCHED;
            G8_LDB(B1, 1, 1); G8_STAGE(G8_SB(1, 0), b3, xB[0]);
            G8_BAR; G8_WAIT_L(0); G8_MMA(0, 1, At, B1); G8_BAR;
            G8_LDA(At, 1, 1); G8_STAGE(G8_SA(1, 0), a3, xA[0]);
            G8_BAR; G8_WAIT_L(0); G8_MMA(1, 0, At, B0); G8_BAR; G8_SCHED;
            G8_STAGE(G8_SB(1, 1), b3, xB[1]);
            G8_WAIT_V(6); G8_BAR; G8_MMA(1, 1, At, B1); G8_BAR;
        }
        S.epi(acc, cur, wr, wc, fr, fq);
        S.done(cur);
        if (!has_next) break;
#pragma unroll
        for (int a = 0; a < 2; ++a)
#pragma unroll
            for (int b = 0; b < 2; ++b)
#pragma unroll
                for (int m = 0; m < 4; ++m)
#pragma unroll
                    for (int n = 0; n < 2; ++n) acc[a][b][m][n] = (f32x4){0.f, 0.f, 0.f, 0.f};
        cur = nxt; cA = nA; cB = nB; ++ui; nt = S.nt(cur);
#pragma unroll
        for (int h = 0; h < 2; ++h)
#pragma unroll
            for (int i = 0; i < 2; ++i) { cOA[h][i] = nOA[h][i]; cOB[h][i] = nOB[h][i]; }
    }
    G8_WAIT_V(0);
    if (wr == 0) G8_BAR;
    G8_BAR;
    const int ret_next = stopped ? ui + 1 : -1;
#undef G8_SA
#undef G8_SB
#undef G8_STAGE
#undef G8_LDA
#undef G8_LDB
#undef G8_MMA
#undef G8_WAIT_V
#undef G8_WAIT_L
#undef G8_BAR
#undef G8_SCHED
    return ret_next;
}
__device__ __forceinline__ void dense_unit(int wgid, int nM, int nN, int& pm, int& pn) {
    const int nwg = nM * nN, NXCD = 8, WGM = 8;
    { const int q = nwg / NXCD, r = nwg % NXCD, xcd = wgid % NXCD, off = wgid / NXCD; wgid = (xcd < r ? xcd * (q + 1) : r * (q + 1) + (xcd - r) * q) + off; }
    const int nig = WGM * nN, gid = wgid / nig, fm = gid * WGM, gsz = (nM - fm) < WGM ? (nM - fm) : WGM;
    pm = fm + ((wgid % nig) % gsz); pn = (wgid % nig) / gsz;
}
}

__device__ void phase0(const Params& P, char* lds_all) {
    unsigned char* ws = P.ws;
    const int vb = threadIdx.x >> 8, t = threadIdx.x & 255;
    char* lds = lds_all + vb * VLDS;
    float* tile = (float*)lds;
    const int NU = 744;
    for (int u = blockIdx.x * 2 + vb; u < NU; u += gridDim.x * 2) {
        if (u < 384) {
            int nt, v, n0b, drb;
            if (u < 192) { v = u; n0b = 0; drb = 0; }
            else if (u < 256) { v = u - 192; n0b = 1552; drb = 1536; }
            else if (u < 320) { v = u - 256; n0b = 2576; drb = 2048; }
            else { v = u - 320; n0b = 2064; drb = 2816; }
            nt = v >> 4;
            transpose_tile_w(tile, P.in[I_WIN], 3104, (v & 15) * 64, n0b + nt * 128, (u16*)(ws + O_WIN), drb + nt * 128, 1024, nullptr, 0, t);
        } else if (u < 416) {
            const int v = u - 384;
            if (v < 16) transpose_tile(tile, P.in[I_WIN], 3104, v * 64, 1536, 16, (u16*)(ws + O_WIN), 2560, 1024, nullptr, 0, t);
            else transpose_tile(tile, P.in[I_WIN], 3104, (v - 16) * 64, 3088, 16, (u16*)(ws + O_WIN), 2576, 1024, nullptr, 0, t);
        } else if (u < 544) {
            const int v = u - 416, nt = v >> 4;
            transpose_tile_w(tile, P.in[I_WOUT], 1024, (v & 15) * 64, nt * 128, (u16*)(ws + O_WOUT), nt * 128, 1024, P.in[I_SNW], 512, t);
        } else if (u < 552) {
            const int base = (u - 544) * 4096;
            for (int i = 0; i < 16; ++i) {
                const int idx = base + t + 256 * i;
                if (idx < 224 * 128) *(uint4*)(ws + O_WIN + ((size_t)(2592 + (idx >> 7)) * 1024 + (idx & 127) * 8) * 2) = make_uint4(0, 0, 0, 0);
            }
        } else {
            const int c0 = (u - 552) * 32;
            float* sc = (float*)lds;
            float* red = sc + 5 * 1024;
            {
                float cv[20];
#pragma unroll
                for (int q = 0; q < 20; ++q) cv[q] = q < 16 ? P.in[I_C][t + 256 * q] : P.in[I_CCTX][t + 256 * (q - 16)];
                __builtin_amdgcn_sched_barrier(0);
#pragma unroll
                for (int q = 0; q < 20; ++q) sc[t + 256 * q] = siluf(cv[q]);
            }
            __syncthreads();
            const int cq = t & 7, kg = t >> 3;
            float4 a0 = {0, 0, 0, 0}, a1 = a0, a2 = a0, a3 = a0, a4 = a0;
            const float* wp = P.in[I_WMOD] + (size_t)(kg * 32) * 6144 + c0 + cq * 4;
#pragma unroll 1
            for (int kb = 0; kb < 32; kb += 16) {
                f32x4 wvv[16];
#pragma unroll
                for (int k = 0; k < 16; ++k) wvv[k] = *(const f32x4*)(wp + (size_t)(kb + k) * 6144);
                __builtin_amdgcn_sched_barrier(0);
#pragma unroll
                for (int k = 0; k < 16; ++k) {
                    if ((k & 3) == 0) __builtin_amdgcn_sched_barrier(0);
                    const f32x4 wv = wvv[k];
                    const int kk = kg * 32 + kb + k;
                    const float s0 = sc[kk], s1 = sc[1024 + kk], s2 = sc[2048 + kk], s3 = sc[3072 + kk], s4 = sc[4096 + kk];
                    a0.x += s0 * wv[0]; a0.y += s0 * wv[1]; a0.z += s0 * wv[2]; a0.w += s0 * wv[3];
                    a1.x += s1 * wv[0]; a1.y += s1 * wv[1]; a1.z += s1 * wv[2]; a1.w += s1 * wv[3];
                    a2.x += s2 * wv[0]; a2.y += s2 * wv[1]; a2.z += s2 * wv[2]; a2.w += s2 * wv[3];
                    a3.x += s3 * wv[0]; a3.y += s3 * wv[1]; a3.z += s3 * wv[2]; a3.w += s3 * wv[3];
                    a4.x += s4 * wv[0]; a4.y += s4 * wv[1]; a4.z += s4 * wv[2]; a4.w += s4 * wv[3];
                }
                __builtin_amdgcn_sched_barrier(0);
            }
            *(float4*)(red + ((kg * 5 + 0) * 32) + cq * 4) = a0; *(float4*)(red + ((kg * 5 + 1) * 32) + cq * 4) = a1;
            *(float4*)(red + ((kg * 5 + 2) * 32) + cq * 4) = a2; *(float4*)(red + ((kg * 5 + 3) * 32) + cq * 4) = a3;
            *(float4*)(red + ((kg * 5 + 4) * 32) + cq * 4) = a4;
            __syncthreads();
            if (t < 160) {
                const int r = t >> 5, cc = t & 31;
                float s = P.in[I_BMOD][c0 + cc];
#pragma unroll
                for (int g = 0; g < 32; ++g) s += red[(g * 5 + r) * 32 + cc];
                ((float*)(ws + O_MOD))[r * 6144 + c0 + cc] = s;
            }
            __syncthreads();
        }
    }
    if (blockIdx.x == 0 && threadIdx.x < 32) ((int*)(ws + O_CNT))[threadIdx.x * 64] = 0;
}

__device__ void phase1(const Params& P) {
    unsigned char* ws = P.ws;
    const int lane = threadIdx.x & 63;
    const int gw = blockIdx.x * 8 + (threadIdx.x >> 6), nw = gridDim.x * 8;
    const float* mod = (const float*)(ws + O_MOD);
    u16* xn = (u16*)(ws + O_XN);
    const int r_lo = (int)(((long long)gw * MALL) / nw), r_hi = (int)(((long long)(gw + 1) * MALL) / nw);
    float4 mul[4], sh[4];
    int cur_mb = -1;
    for (int row = r_lo; row < r_hi; row += 2) {
        const bool two = row + 1 < r_hi;
        const int row1 = two ? row + 1 : row;
        const float* x0 = row < MLAT ? P.in[I_X] + (size_t)row * 1024 : P.in[I_CTX] + (size_t)(row - MLAT) * 1024;
        const float* x1 = row1 < MLAT ? P.in[I_X] + (size_t)row1 * 1024 : P.in[I_CTX] + (size_t)(row1 - MLAT) * 1024;
        float4 v0[4], v1[4];
#pragma unroll
        for (int j = 0; j < 4; ++j) { v0[j] = ((const float4*)x0)[lane + 64 * j]; v1[j] = ((const float4*)x1)[lane + 64 * j]; }
        const int mb0 = row < MLAT ? (row >> 12) : 4, mb1 = row1 < MLAT ? (row1 >> 12) : 4;
        float s0 = 0.f, s1 = 0.f;
#pragma unroll
        for (int j = 0; j < 4; ++j) {
            s0 += v0[j].x * v0[j].x + v0[j].y * v0[j].y + v0[j].z * v0[j].z + v0[j].w * v0[j].w;
            s1 += v1[j].x * v1[j].x + v1[j].y * v1[j].y + v1[j].z * v1[j].z + v1[j].w * v1[j].w;
        }
        s0 = rsqrtf(wave_sum(s0) * (1.f / 1024.f) + 1e-6f);
        s1 = rsqrtf(wave_sum(s1) * (1.f / 1024.f) + 1e-6f);
#pragma unroll 1
        for (int rr = 0; rr < 2; ++rr) {
            const int mb = rr ? mb1 : mb0;
            if (mb != cur_mb) {
                cur_mb = mb;
#pragma unroll
                for (int j = 0; j < 4; ++j) {
                    const int k = (lane + 64 * j) * 4;
                    const float4 nwv = *(const float4*)(P.in[I_N1W] + k);
                    const float4 sc = *(const float4*)(mod + mb * 6144 + 1024 + k);
                    sh[j] = *(const float4*)(mod + mb * 6144 + k);
                    mul[j].x = nwv.x * (1.f + sc.x); mul[j].y = nwv.y * (1.f + sc.y); mul[j].z = nwv.z * (1.f + sc.z); mul[j].w = nwv.w * (1.f + sc.w);
                }
            }
            if (rr == 1 && !two) break;
            const float rstd = rr ? s1 : s0;
            const int orow = rr ? row1 : row;
#pragma unroll
            for (int j = 0; j < 4; ++j) {
                const int k = (lane + 64 * j) * 4;
                const float4 vv = rr ? v1[j] : v0[j];
                uint2 o;
                o.x = pack2(vv.x * rstd * mul[j].x + sh[j].x, vv.y * rstd * mul[j].y + sh[j].y);
                o.y = pack2(vv.z * rstd * mul[j].z + sh[j].z, vv.w * rstd * mul[j].w + sh[j].w);
                *(uint2*)(xn + (size_t)orow * 1024 + k) = o;
            }
        }
    }
}

struct InProj {
    static constexpr int K = 1024; static constexpr bool PERM = true; static constexpr int MIDT = 0;
    struct Unit { int pm, pn, vt; };
    const unsigned char* ws; int G, c;
    __device__ __forceinline__ bool next(int i, Unit& u) const {
        const int L = i * G + c;
        if (L >= 884) return false;
        if (L < 748) { u.vt = 0; g8::dense_unit(L, 68, 11, u.pm, u.pn); }
        else { const int v = L - 748; u.vt = 1; u.pm = v / 68; u.pn = v % 68; }
        return true;
    }
    __device__ __forceinline__ const char* baseA(const Unit& u) const { return (const char*)(ws + (u.vt ? O_WIN : O_XN)); }
    __device__ __forceinline__ const char* baseB(const Unit& u) const { return (const char*)(ws + (u.vt ? O_XN : O_WIN)); }
    __device__ __forceinline__ void offs(const Unit& u, int tid_, unsigned (&oa)[2][2], unsigned (&ob)[2][2]) const {
        int R[2], C[2];
        { int tq = tid_; asm volatile("" : "+v"(tq)); g8::stage_rc(tq * 16, R[0], C[0]); g8::stage_rc(tq * 16 + 8192, R[1], C[1]); }
#pragma unroll
        for (int h = 0; h < 2; ++h)
#pragma unroll
            for (int i = 0; i < 2; ++i) {
                const int Rb = (R[i] & ~31) + g8::perm32(R[i] & 31);
                if (!u.vt) {
                    int ar = u.pm * 256 + h * 128 + R[i];
                    if (u.pn == 6 || u.pn == 7) ar = colmajor_src_row(ar);
                    oa[h][i] = (unsigned)(ar * 1024 + C[i]) * 2u;
                    ob[h][i] = (unsigned)((u.pn * 256 + h * 128 + Rb) * 1024 + C[i]) * 2u;
                } else {
                    oa[h][i] = (unsigned)((2816 + u.pm * 256 + h * 128 + R[i]) * 1024 + C[i]) * 2u;
                    ob[h][i] = (unsigned)(colmajor_src_row(u.pn * 256 + h * 128 + Rb) * 1024 + C[i]) * 2u;
                }
            }
    }
    __device__ __forceinline__ void mid(g8::Acc&, const Unit&, int, int) const {}
    __device__ __forceinline__ int nt(const Unit&) const { return 16; }
    __device__ __forceinline__ bool brk(const Unit&, const Unit&) const { return false; }
    __device__ __forceinline__ void a_ready(const Unit&) const {}
    __device__ __forceinline__ void done(const Unit&) const {}
    __device__ __forceinline__ void epi(g8::Acc& acc, const Unit& u, int wr, int wc, int fr, int fq) const {
        unsigned char* w = (unsigned char*)ws;
        const int row0 = u.pm * 256 + wr * 64 + fr;
        const int col0 = wc * 32 + 8 * fq;
        if (u.vt) {
            const int tok0 = u.pn * 256 + col0;
#pragma unroll
            for (int ai = 0; ai < 2; ++ai)
#pragma unroll
                for (int m = 0; m < 4; ++m) {
                    const int ch = row0 + ai * 128 + m * 16;
#pragma unroll
                    for (int bj = 0; bj < 2; ++bj) {
                        const int tk = tok0 + bj * 128;
                        u16* d;
                        int ctile, lw;
                        if (tk < MLAT) { ctile = (tk >> 12) * NCH + 2 + ((tk & 4095) >> 7); lw = tk & 127; }
                        else { const int tc = tk - MLAT; ctile = (tc >> 8) * NCH + ((tc & 255) >> 7); lw = tc & 127; }
                        d = (u16*)(w + O_VT) + ((size_t)ctile * 512 + ch) * 128 + lw;
                        const f32x4 v0 = acc[ai][bj][m][0], v1 = acc[ai][bj][m][1];
                        u32x4 o; o.x = g8::cvt_pk_bf16(v0[0], v0[1]); o.y = g8::cvt_pk_bf16(v0[2], v0[3]); o.z = g8::cvt_pk_bf16(v1[0], v1[1]); o.w = g8::cvt_pk_bf16(v1[2], v1[3]);
                        *(u32x4*)d = o;
                    }
                }
            return;
        }
        if (u.pn == 10) {
            if (wc == 0) {
                float* dst = (float*)(w + (fq < 2 ? O_PSD : O_PSG)) + (fq & 1) * 8;
#pragma unroll
                for (int ai = 0; ai < 2; ++ai)
#pragma unroll
                    for (int m = 0; m < 4; ++m) {
                        float* d = dst + (size_t)(row0 + ai * 128 + m * 16) * 16;
                        *(f32x4*)d = acc[ai][0][m][0];
                        *(f32x4*)(d + 4) = acc[ai][0][m][1];
                    }
            }
            return;
        }
        u16* base; size_t ld, bjstep;
        if (u.pn < 2) { base = (u16*)(w + O_ZO) + u.pn * 256 + col0; ld = 1024; bjstep = 128; }
        else if (u.pn < 8) {
            const int cg0 = (u.pn - 2) * 4 + (col0 >> 6);
            base = (u16*)(w + O_PT) + (size_t)cg0 * MALL * 64 + (col0 & 63); ld = 64; bjstep = (size_t)2 * MALL * 64;
        }
        else { base = (u16*)(w + O_ZO) + 512 + (u.pn - 8) * 256 + col0; ld = 1024; bjstep = 128; }
#pragma unroll
        for (int ai = 0; ai < 2; ++ai)
#pragma unroll
            for (int m = 0; m < 4; ++m) {
                u16* rowp = base + (size_t)(row0 + ai * 128 + m * 16) * ld;
#pragma unroll
                for (int bj = 0; bj < 2; ++bj) {
                    const f32x4 v0 = acc[ai][bj][m][0], v1 = acc[ai][bj][m][1];
                    u32x4 o; o.x = g8::cvt_pk_bf16(v0[0], v0[1]); o.y = g8::cvt_pk_bf16(v0[2], v0[3]); o.z = g8::cvt_pk_bf16(v1[0], v1[1]); o.w = g8::cvt_pk_bf16(v1[2], v1[3]);
                    *(u32x4*)(rowp + bj * bjstep) = o;
                }
            }
    }
};

__device__ void phase3(const Params& P, char* lds_all) {
    unsigned char* ws = P.ws;
    const int vb = threadIdx.x >> 8, t = threadIdx.x & 255;
    char* lds = lds_all + vb * VLDS;
    u16* raw = (u16*)lds;
    float* xcl = (float*)(lds + 132 * 128);
    const u16* pt = (const u16*)(ws + O_PT);
    const int NCONV = 136 * 24;
    for (int ct = blockIdx.x * 2 + vb; ct < 136; ct += gridDim.x * 2) {
        const int b = ct / NCH, cc = ct % NCH;
        const int rb = cc < 2 ? MLAT + b * 256 + cc * 128 : b * 4096 + (cc - 2) * 128;
        const int row = rb + (t >> 1), half = t & 1;
        const float* psd = (const float*)(ws + O_PSD) + (size_t)row * 16 + half * 8;
        float* dt = (float*)(ws + O_DT) + (size_t)row * 16 + half * 8;
        const float4 pa = *(const float4*)psd, pb = *(const float4*)(psd + 4);
        const float* psg = (const float*)(ws + O_PSG) + (size_t)colmajor_src_row(row) * 16 + half * 8;
        const float4 ga = *(const float4*)psg, gb = *(const float4*)(psg + 4);
        const float pv[8] = {pa.x, pa.y, pa.z, pa.w, pb.x, pb.y, pb.z, pb.w}, gv[8] = {ga.x, ga.y, ga.z, ga.w, gb.x, gb.y, gb.z, gb.w};
        const float4 db0 = *(const float4*)(P.in[I_DTB] + half * 8), db1 = *(const float4*)(P.in[I_DTB] + half * 8 + 4);
        const float4 gb0 = *(const float4*)(P.in[I_GB] + half * 8), gb1 = *(const float4*)(P.in[I_GB] + half * 8 + 4);
        const float dbv[8] = {db0.x, db0.y, db0.z, db0.w, db1.x, db1.y, db1.z, db1.w}, gbv[8] = {gb0.x, gb0.y, gb0.z, gb0.w, gb1.x, gb1.y, gb1.z, gb1.w};
        float od[8], og[8];
#pragma unroll
        for (int j = 0; j < 8; ++j) {
            od[j] = softplusf(pv[j] + dbv[j]);
            const float xx = gv[j] + gbv[j];
            og[j] = half == 0 ? xx : fminf(xx, 0.f) - log1pf(__expf(-fabsf(xx)));
        }
        *(float4*)dt = make_float4(od[0], od[1], od[2], od[3]); *(float4*)(dt + 4) = make_float4(od[4], od[5], od[6], od[7]);
        float* gout = (float*)(ws + (half == 0 ? O_GI : O_GF)) + (size_t)row * 8;
        *(float4*)gout = make_float4(og[0], og[1], og[2], og[3]); *(float4*)(gout + 4) = make_float4(og[4], og[5], og[6], og[7]);
    }
    u32x4 rr[5];
#define P3_PREFETCH(uu) do { \
        const int _u = (uu), _ct = _u / 24, _cg = _u % 24, _b = _ct / NCH, _cc = _ct % NCH; const bool _ctx = _cc < 2; \
        const int _L = _ctx ? 256 : 4096, _lpos = _ctx ? _cc * 128 : (_cc - 2) * 128, _rb = _ctx ? MLAT + _b * 256 + _cc * 128 : _b * 4096 + (_cc - 2) * 128, _sb = _rb - _lpos; \
        _Pragma("unroll") for (int _i = 0; _i < 5; ++_i) { const int _q = t + 256 * _i, _r = (_q >> 3) < 132 ? (_q >> 3) : 131, _c = _q & 7; \
            const int _l = _lpos - 2 + _r, _lc = _l < 0 ? 0 : (_l >= _L ? _L - 1 : _l); \
            u32x4 _v = *(const u32x4*)(pt + ((size_t)_cg * MALL + _sb + _lc) * 64 + _c * 8); \
            if (_l != _lc) _v = (u32x4){0u, 0u, 0u, 0u}; \
            rr[_i] = _v; } \
    } while (0)
    if ((int)(blockIdx.x * 2 + vb) < NCONV) P3_PREFETCH(blockIdx.x * 2 + vb);
    for (int u = blockIdx.x * 2 + vb; u < NCONV; u += gridDim.x * 2) {
        const int ct = u / 24, cgp = u % 24;
        const int b = ct / NCH, cc = ct % NCH;
        const bool isctx = cc < 2;
        const int rb = isctx ? MLAT + b * 256 + cc * 128 : b * 4096 + (cc - 2) * 128;
        const bool isml = cgp >= 16;
#pragma unroll
        for (int i = 0; i < 5; ++i) { const int q = t + 256 * i; if (q < 132 * 8) *(u32x4*)(raw + (q >> 3) * 64 + (q & 7) * 8) = rr[i]; }
        __syncthreads();
        if (u + (int)gridDim.x * 2 < NCONV) P3_PREFETCH(u + gridDim.x * 2);
        const int ch = t & 63, tg = t >> 6;
        const float* cw = isml ? P.in[I_MCW] + (cgp - 16) * 64 + ch : P.in[I_SCW] + cgp * 64 + ch;
        const int cwld = isml ? 512 : 1024;
        const float w0 = cw[0], w1 = cw[cwld], w2 = cw[2 * cwld], w3 = cw[3 * cwld], w4 = cw[4 * cwld];
        const float bias = isml ? P.in[I_MCB][(cgp - 16) * 64 + ch] : P.in[I_SCB][cgp * 64 + ch];
        const int tok0 = tg * 32;
        float x0 = bf2f(raw[(tok0 + 0) * 64 + ch]), x1 = bf2f(raw[(tok0 + 1) * 64 + ch]), x2 = bf2f(raw[(tok0 + 2) * 64 + ch]), x3 = bf2f(raw[(tok0 + 3) * 64 + ch]);
        if (!isml) {
            float ov[32];
#pragma unroll
            for (int j = 0; j < 32; ++j) {
                const float x4 = bf2f(raw[(tok0 + j + 4) * 64 + ch]);
                const float cv = bias + w0 * x0 + w1 * x1 + w2 * x2 + w3 * x3 + w4 * x4;
                ov[j] = siluf(cv);
                x0 = x1; x1 = x2; x2 = x3; x3 = x4;
            }
            if (cgp < 12) {
                const int chg = cgp < 8 ? cgp * 64 + ch : (cgp - 8) * 64 + ch;
                u16* tdst = cgp < 8 ? (u16*)(ws + O_XT) + ((size_t)ct * 512 + chg) * 128 + tok0 : (u16*)(ws + O_BT) + ((size_t)ct * 256 + chg) * 128 + tok0;
#pragma unroll
                for (int o8 = 0; o8 < 4; ++o8) {
                    u32x4 o; o.x = pack2(ov[o8 * 8 + 0], ov[o8 * 8 + 1]); o.y = pack2(ov[o8 * 8 + 2], ov[o8 * 8 + 3]); o.z = pack2(ov[o8 * 8 + 4], ov[o8 * 8 + 5]); o.w = pack2(ov[o8 * 8 + 6], ov[o8 * 8 + 7]);
                    *(u32x4*)(tdst + o8 * 8) = o;
                }
            }
            if (cgp >= 8) {
                const int gn = (cgp < 12 ? cgp - 8 : cgp - 12) * 64 + ch;
                u16* ndst = (u16*)(ws + (cgp < 12 ? O_BM : O_CM)) + ((size_t)ct * 2 + (gn >> 7)) * 16384 + (size_t)tok0 * 128 + (gn & 127);
#pragma unroll
                for (int j = 0; j < 32; ++j) ndst[(size_t)j * 128] = f2bf(ov[j]);
            }
            __syncthreads();
        } else {
            const int mg = cgp - 16;
            const int n = ch >> 2, kk = ch & 3, ng = mg * 16 + n;
            const float* wq = P.in[I_WQK] + ((size_t)(0 * 128 + ng) * 4) * 4 + kk;
            const float* wk = P.in[I_WQK] + ((size_t)(1 * 128 + ng) * 4) * 4 + kk;
            const float q0 = wq[0], q1 = wq[4], q2 = wq[8], q3 = wq[12];
            const float k0 = wk[0], k1 = wk[4], k2 = wk[8], k3 = wk[12];
            u16* xcd = (u16*)(ws + O_XC) + ((size_t)ct * 4 + (mg >> 1)) * 16384 + (size_t)tok0 * 128 + (mg & 1) * 64 + ch;
#pragma unroll 8
            for (int j = 0; j < 32; ++j) {
                const int tok = tok0 + j;
                const float x4 = bf2f(raw[(tok + 4) * 64 + ch]);
                const float cv = bias + w0 * x0 + w1 * x1 + w2 * x2 + w3 * x3 + w4 * x4;
                const float sv = siluf(cv);
                xcl[tok * 64 + ch] = sv;
                xcd[(size_t)j * 128] = f2bf(sv);
                x0 = x1; x1 = x2; x2 = x3; x3 = x4;
            }
            __syncthreads();
            const int chg = mg * 64 + ch;
            const size_t hoff = ((size_t)ct * 4 + (mg >> 1)) * 16384 + (size_t)tok0 * 128 + (mg & 1) * 64 + ch;
            u16* qd = (u16*)(ws + O_Q) + hoff;
            u16* kd = (u16*)(ws + O_K) + hoff;
            u16* ktd = (u16*)(ws + O_KT) + ((size_t)ct * 512 + chg) * 128 + tok0;
#pragma unroll
            for (int o8 = 0; o8 < 4; ++o8) {
                float kv[8];
#pragma unroll
                for (int j = 0; j < 8; ++j) {
                    const int tok = tok0 + o8 * 8 + j;
                    const float4 xv = *(const float4*)(xcl + tok * 64 + n * 4);
                    const float qv = xv.x * q0 + xv.y * q1 + xv.z * q2 + xv.w * q3;
                    kv[j] = (xv.x * k0 + xv.y * k1 + xv.z * k2 + xv.w * k3) * 0.08838834764831845f;
                    qd[(size_t)(o8 * 8 + j) * 128] = f2bf(qv);
                    kd[(size_t)(o8 * 8 + j) * 128] = f2bf(kv[j]);
                }
                uint4 o; o.x = pack2(kv[0], kv[1]); o.y = pack2(kv[2], kv[3]); o.z = pack2(kv[4], kv[5]); o.w = pack2(kv[6], kv[7]);
                *(uint4*)(ktd + o8 * 8) = o;
            }
            __syncthreads();
        }
    }
}

__device__ __forceinline__ u32x4 scale8(const u32x4 v, const float* ww) {
    u32x4 o;
    o.x = pack2(bflo(v.x) * ww[0], bfhi(v.x) * ww[1]); o.y = pack2(bflo(v.y) * ww[2], bfhi(v.y) * ww[3]);
    o.z = pack2(bflo(v.z) * ww[4], bfhi(v.z) * ww[5]); o.w = pack2(bflo(v.w) * ww[6], bfhi(v.w) * ww[7]);
    return o;
}
__device__ void phase4(const Params& P, char* lds) {
    unsigned char* ws = P.ws;
    char* T0 = lds; char* T1 = lds + 32768;
    float* sc = (float*)(lds + 65536);
    float* wA = sc + 256;
    float* wB = sc + 384;
    const int NSSD = 4 * NCH * 8, NML = 4 * NCH * 4, NU4 = NSSD + NML;
    u32x4 RA[4], RB[4];
    float ps0 = 0.f, ps1 = 0.f, ps2 = 0.f, ps3 = 0.f;
#define P4_PREFETCH(uu) do { \
        const int _u = (uu); const bool _ssd = _u < NSSD; const int _v = _ssd ? _u : _u - NSSD; \
        const int _h = _ssd ? (_v & 7) : (_v & 3), _ct = _ssd ? (_v >> 3) : (_v >> 2), _b = _ct / NCH, _cc = _ct % NCH; \
        const int _rb = _cc < 2 ? MLAT + _b * 256 + _cc * 128 : _b * 4096 + (_cc - 2) * 128; \
        const u16* _pa = _ssd ? (const u16*)(ws + O_XT) + ((size_t)_ct * 512 + _h * 64) * 128 : (const u16*)(ws + O_VT) + ((size_t)_ct * 512 + _h * 128) * 128; \
        const u16* _pb = _ssd ? (const u16*)(ws + O_BT) + ((size_t)_ct * 256 + (_h >> 2) * 128) * 128 : (const u16*)(ws + O_KT) + ((size_t)_ct * 512 + _h * 128) * 128; \
        _Pragma("unroll") for (int _i = 0; _i < 4; ++_i) { const int _q = (int)threadIdx.x + 512 * _i; const size_t _o = (size_t)(_q >> 4) * 128 + (_q & 15) * 8; \
            RA[_i] = *(const u32x4*)(_pa + _o); RB[_i] = *(const u32x4*)(_pb + _o); } \
        if (threadIdx.x < 128) { const int _dir = threadIdx.x >> 6, _ln = threadIdx.x & 63; const int _l0 = _dir ? 127 - 2 * _ln : 2 * _ln, _l1 = _dir ? 126 - 2 * _ln : 2 * _ln + 1; \
            if (_ssd) { const float* _dp = (const float*)(ws + O_DT) + (size_t)_rb * 16 + _dir * 8 + _h; ps0 = _dp[_l0 * 16]; ps1 = _dp[_l1 * 16]; } \
            else { const float* _gf = (const float*)(ws + O_GF) + (size_t)_rb * 8 + _dir * 4 + _h; const float* _gi = (const float*)(ws + O_GI) + (size_t)_rb * 8 + _dir * 4 + _h; \
                   ps0 = _gf[_l0 * 8]; ps1 = _gf[_l1 * 8]; ps2 = _gi[_l0 * 8]; ps3 = _gi[_l1 * 8]; } } \
    } while (0)
    if ((int)blockIdx.x < NU4) P4_PREFETCH(blockIdx.x);
    for (int u = blockIdx.x; u < NU4; u += gridDim.x) {
        int t = threadIdx.x; asm volatile("" : "+v"(t));
        const int lane = t & 63, w = t >> 6, wm = w >> 1, wn = w & 1, lr = lane & 15, lq = lane >> 4;
        const bool isssd = u < NSSD;
        const int v = isssd ? u : u - NSSD;
        const int h = isssd ? (v & 7) : (v & 3), ct = isssd ? (v >> 3) : (v >> 2), b = ct / NCH, cc = ct % NCH;
        const int un = u + (int)gridDim.x;
        if (isssd) {
            if (w < 2) {
                const int dir = w;
                const int l0 = dir ? 127 - 2 * lane : 2 * lane, l1 = dir ? 126 - 2 * lane : 2 * lane + 1;
                const float d0 = ps0, d1 = ps1;
                const float an = -__expf(P.in[I_ALOG][dir * 8 + h]);
                const float p0 = d0 * an, p1 = p0 + d1 * an;
                const float inc = wave_scan_sum(p1, lane);
                const float ex = inc - p1;
                const float tot = __shfl(inc, 63);
                float* wd = dir ? wB : wA;
                wd[l0] = __expf(tot - (ex + p0)) * d0; wd[l1] = __expf(tot - (ex + p1)) * d1;
                if (lane == 0) ((float*)(ws + O_ACH))[((size_t)(b * NCH + cc) * 8 + h) * 2 + dir] = tot;
            }
            __syncthreads();
#pragma unroll
            for (int i = 0; i < 2; ++i) {
                const int q = t + 512 * i, r = q >> 4, c = q & 15;
                *(u32x4*)(T0 + swz256(r, c)) = scale8(RA[i], wA + c * 8); *(u32x4*)(T0 + swz256(64 + r, c)) = scale8(RA[i], wB + c * 8);
            }
#pragma unroll
            for (int i = 0; i < 4; ++i) { const int q = t + 512 * i, r = q >> 4, c = q & 15; *(u32x4*)(T1 + swz256(r, c)) = RB[i]; }
            __syncthreads();
            if (un < NU4) P4_PREFETCH(un);
            f32x4 acc[2][4]; zero_acc(acc);
            lds_mma_t<2, 4>(T0, T1, wm * 32, wn * 64, acc, lane);
            u16* st = (u16*)(ws + O_ST) + (((size_t)(b * NCH + cc) * 8 + h) * 2 + (wm >> 1)) * 8192 + ((wm & 1) * 32 + lr) * 128 + wn * 64 + lq * 4;
#pragma unroll
            for (int i = 0; i < 2; ++i)
#pragma unroll
                for (int j = 0; j < 4; ++j) {
                    uint2 o; o.x = pack2(acc[i][j][0], acc[i][j][1]); o.y = pack2(acc[i][j][2], acc[i][j][3]);
                    *(uint2*)(st + (i * 16) * 128 + j * 16) = o;
                }
            __syncthreads();
        } else {
            if (w < 2) {
                const int dir = w;
                const int s0 = dir ? 127 - 2 * lane : 2 * lane, s1 = dir ? 126 - 2 * lane : 2 * lane + 1;
                const float f0 = ps0, f1 = ps1, i0 = ps2, i1 = ps3;
                const float p1 = f0 + f1;
                const float inc = wave_scan_sum(p1, lane);
                const float ex = inc - p1;
                const float tot = __shfl(inc, 63);
                const float av0 = tot - (ex + f0) + i0, av1 = tot - (ex + p1) + i1;
                const float mloc = wave_max(fmaxf(av0, av1));
                float* wd = dir ? wB : wA;
                wd[s0] = __expf(av0 - mloc); wd[s1] = __expf(av1 - mloc);
                if (lane == 0) {
                    float* mls = (float*)(ws + O_MLS) + (((size_t)(b * NCH + cc) * 4 + h) * 2 + dir) * 2;
                    mls[0] = mloc; mls[1] = tot;
                }
            }
            __syncthreads();
#pragma unroll
            for (int d2 = 0; d2 < 2; ++d2) {
                const float* wsel = d2 ? wB : wA;
#pragma unroll
                for (int i = 0; i < 4; ++i) { const int q = t + 512 * i, r = q >> 4, c = q & 15; *(u32x4*)(T0 + swz256(r, c)) = scale8(RA[i], wsel + c * 8); }
                if (d2 == 0) {
#pragma unroll
                    for (int i = 0; i < 4; ++i) { const int q = t + 512 * i, r = q >> 4, c = q & 15; *(u32x4*)(T1 + swz256(r, c)) = RB[i]; }
                }
                __syncthreads();
                if (d2 == 1 && un < NU4) P4_PREFETCH(un);
                f32x4 acc[2][4]; zero_acc(acc);
                lds_mma_t<2, 4>(T0, T1, wm * 32, wn * 64, acc, lane);
                u16* cst = (u16*)(ws + (d2 ? O_MLC1 : O_MLC0)) + ((size_t)(b * NCH + cc) * 4 + h) * 16384 + (wm * 32 + lr) * 128 + wn * 64 + lq * 4;
#pragma unroll
                for (int i = 0; i < 2; ++i)
#pragma unroll
                    for (int j = 0; j < 4; ++j) {
                        uint2 o; o.x = pack2(acc[i][j][0], acc[i][j][1]); o.y = pack2(acc[i][j][2], acc[i][j][3]);
                        *(uint2*)(cst + (i * 16) * 128 + j * 16) = o;
                    }
                if (d2 == 0 && t < 256) {
                    const int dir = t >> 7, idx = t & 127;
                    const float* wgt = dir ? wB : wA;
                    float nacc = 0.f;
#pragma unroll 4
                    for (int c = 0; c < 16; ++c) {
                        const uint4 kv = *(const uint4*)(T1 + swz256(idx, c));
                        const float* ww = wgt + c * 8;
                        nacc += bflo(kv.x) * ww[0] + bfhi(kv.x) * ww[1] + bflo(kv.y) * ww[2] + bfhi(kv.y) * ww[3]
                              + bflo(kv.z) * ww[4] + bfhi(kv.z) * ww[5] + bflo(kv.w) * ww[6] + bfhi(kv.w) * ww[7];
                    }
                    ((float*)(ws + O_MLN))[(((size_t)(b * NCH + cc) * 4 + h) * 2 + dir) * 128 + idx] = nacc;
                }
                __syncthreads();
            }
        }
    }
}

__device__ __forceinline__ int scan_cc(int dir, int step) { return dir == 0 ? step : (step < 2 ? 1 - step : 35 - step); }
__device__ void phase5(const Params& P) {
    unsigned char* ws = P.ws;
    const int vb = threadIdx.x >> 8, t = threadIdx.x & 255;
    for (int u = blockIdx.x * 2 + vb; u < 256 + 256 + 32; u += gridDim.x * 2) {
        if (u < 256) {
            const int chain = u >> 2, part = u & 3;
            const int b = chain >> 4, h = (chain >> 1) & 7, dir = chain & 1;
            const int off = part * 2048 + t * 8;
            float S[8];
#pragma unroll
            for (int j = 0; j < 8; ++j) S[j] = 0.f;
#pragma unroll 1
            for (int sb = 0; sb < NCH; sb += 17) {
                u32x4 lv[17]; float dc[17];
#pragma unroll
                for (int q = 0; q < 17; ++q) {
                    const int cc = scan_cc(dir, sb + q);
                    lv[q] = *(const u32x4*)((const u16*)(ws + O_ST) + (((size_t)(b * NCH + cc) * 8 + h) * 2 + dir) * 8192 + off);
                    dc[q] = ((const float*)(ws + O_ACH))[((size_t)(b * NCH + cc) * 8 + h) * 2 + dir];
                }
                __builtin_amdgcn_sched_barrier(0);
#pragma unroll
                for (int q = 0; q < 17; ++q) {
                    const int cc = scan_cc(dir, sb + q);
                    u16* p = (u16*)(ws + O_ST) + (((size_t)(b * NCH + cc) * 8 + h) * 2 + dir) * 8192 + off;
                    const float dec = __expf(dc[q]);
                    u32x4 o; o.x = pack2(S[0], S[1]); o.y = pack2(S[2], S[3]); o.z = pack2(S[4], S[5]); o.w = pack2(S[6], S[7]);
                    *(u32x4*)p = o;
                    S[0] = dec * S[0] + bflo(lv[q].x); S[1] = dec * S[1] + bfhi(lv[q].x); S[2] = dec * S[2] + bflo(lv[q].y); S[3] = dec * S[3] + bfhi(lv[q].y);
                    S[4] = dec * S[4] + bflo(lv[q].z); S[5] = dec * S[5] + bfhi(lv[q].z); S[6] = dec * S[6] + bflo(lv[q].w); S[7] = dec * S[7] + bfhi(lv[q].w);
                }
                __builtin_amdgcn_sched_barrier(0);
            }
        } else if (u < 512) {
            const int v = u - 256;
            const int chain = v >> 3, part = v & 7;
            const int b = chain >> 3, h = (chain >> 1) & 3, dir = chain & 1;
            const int off = part * 2048 + t * 8;
            float S[8];
#pragma unroll
            for (int j = 0; j < 8; ++j) S[j] = 0.f;
            float m = -1e30f;
#pragma unroll 1
            for (int sb = 0; sb < NCH; sb += 17) {
                u32x4 lv[17]; float mlv[17], blv[17];
#pragma unroll
                for (int q = 0; q < 17; ++q) {
                    const int cc = scan_cc(dir, sb + q);
                    lv[q] = *(const u32x4*)((const u16*)(ws + (dir ? O_MLC1 : O_MLC0)) + ((size_t)(b * NCH + cc) * 4 + h) * 16384 + off);
                    const float* mls = (const float*)(ws + O_MLS) + (((size_t)(b * NCH + cc) * 4 + h) * 2 + dir) * 2;
                    mlv[q] = mls[0]; blv[q] = mls[1];
                }
                __builtin_amdgcn_sched_barrier(0);
#pragma unroll
                for (int q = 0; q < 17; ++q) {
                    const int cc = scan_cc(dir, sb + q);
                    u16* p = (u16*)(ws + (dir ? O_MLC1 : O_MLC0)) + ((size_t)(b * NCH + cc) * 4 + h) * 16384 + off;
                    const float ml = mlv[q], bl = blv[q];
                    const float mn = fmaxf(bl + m, ml);
                    const float sp = __expf(bl + m - mn), sl = __expf(ml - mn);
                    if (part == 0 && t == 0) ((float*)(ws + O_MLP))[((size_t)(b * NCH + cc) * 4 + h) * 2 + dir] = m;
                    u32x4 o; o.x = pack2(S[0], S[1]); o.y = pack2(S[2], S[3]); o.z = pack2(S[4], S[5]); o.w = pack2(S[6], S[7]);
                    *(u32x4*)p = o;
                    S[0] = sp * S[0] + sl * bflo(lv[q].x); S[1] = sp * S[1] + sl * bfhi(lv[q].x); S[2] = sp * S[2] + sl * bflo(lv[q].y); S[3] = sp * S[3] + sl * bfhi(lv[q].y);
                    S[4] = sp * S[4] + sl * bflo(lv[q].z); S[5] = sp * S[5] + sl * bfhi(lv[q].z); S[6] = sp * S[6] + sl * bflo(lv[q].w); S[7] = sp * S[7] + sl * bfhi(lv[q].w);
                    m = mn;
                }
                __builtin_amdgcn_sched_barrier(0);
            }
        } else {
            const int chain = u - 512;
            const int b = chain >> 3, h = (chain >> 1) & 3, dir = chain & 1;
            if (t < 128) {
                float nS = 0.f, m = -1e30f;
#pragma unroll 1
                for (int sb = 0; sb < NCH; sb += 17) {
                    float lvv[17], mlv[17], blv[17];
#pragma unroll
                    for (int q = 0; q < 17; ++q) {
                        const int cc = scan_cc(dir, sb + q);
                        lvv[q] = ((const float*)(ws + O_MLN))[(((size_t)(b * NCH + cc) * 4 + h) * 2 + dir) * 128 + t];
                        const float* mls = (const float*)(ws + O_MLS) + (((size_t)(b * NCH + cc) * 4 + h) * 2 + dir) * 2;
                        mlv[q] = mls[0]; blv[q] = mls[1];
                    }
                    __builtin_amdgcn_sched_barrier(0);
#pragma unroll
                    for (int q = 0; q < 17; ++q) {
                        const int cc = scan_cc(dir, sb + q);
                        float* p = (float*)(ws + O_MLN) + (((size_t)(b * NCH + cc) * 4 + h) * 2 + dir) * 128 + t;
                        const float mn = fmaxf(blv[q] + m, mlv[q]);
                        const float sp = __expf(blv[q] + m - mn), sl = __expf(mlv[q] - mn);
                        *p = nS;
                        nS = sp * nS + sl * lvv[q];
                        m = mn;
                    }
                    __builtin_amdgcn_sched_barrier(0);
                }
            }
        }
    }
}

__device__ void phase6(const Params& P, char* lds) {
    unsigned char* ws = P.ws;
    char* T0 = lds; char* T1 = lds + 32768; char* T2 = lds + 65536; char* T3 = lds + 98304;
    float* sc = (float*)(lds + 131072);
    float* sbuf = sc;
    float* a0 = sc + 256;
    float* a1 = sc + 384;
    float* a2 = sc + 512;
    float* a3 = sc + 640;
    float* a4 = sc + 768;
    float* a5 = sc + 896;
    float* rsA = sc + 1024;
    float* qn = sc + 1536;
    float* fac = sc + 1792;
    float* wfac = sc + 2048;
    const int NSSD = 4 * 32 * 8, NML = 4 * 32 * 4, NU6 = NSSD + NML;
    u32x4 R0[4], R1[4], R2[4], R3[4];
    float ps0 = 0.f, ps1 = 0.f, ps2 = 0.f, ps3 = 0.f;
#define P6_PREFETCH(uu) do { \
        const int _u = (uu); const bool _ssd = _u < NSSD; const int _v = _ssd ? _u : _u - NSSD; \
        const int _h = _ssd ? (_v & 7) : (_v & 3), _ct = _ssd ? (_v >> 3) : (_v >> 2), _b = _ct >> 5, _c = _ct & 31, _cc = _c + 2; \
        const size_t _ctile = (size_t)(_b * NCH + _cc); const int _rb = _b * 4096 + _c * 128; \
        const u16 *_p0, *_p1, *_p2, *_p3; \
        if (_ssd) { const int _g = _h >> 2; _p0 = (const u16*)(ws + O_CM) + (_ctile * 2 + _g) * 16384; _p1 = (const u16*)(ws + O_BM) + (_ctile * 2 + _g) * 16384; \
                    _p2 = (const u16*)(ws + O_ST) + ((_ctile * 8 + _h) * 2) * 8192; _p3 = (const u16*)(ws + O_XT) + (_ctile * 512 + _h * 64) * 128; } \
        else { _p0 = (const u16*)(ws + O_Q) + (_ctile * 4 + _h) * 16384; _p1 = (const u16*)(ws + O_K) + (_ctile * 4 + _h) * 16384; \
               _p2 = (const u16*)(ws + O_MLC0) + (_ctile * 4 + _h) * 16384; _p3 = (const u16*)(ws + O_MLC1) + (_ctile * 4 + _h) * 16384; } \
        _Pragma("unroll") for (int _i = 0; _i < 4; ++_i) { const int _q = (int)threadIdx.x + 512 * _i; const size_t _o = (size_t)(_q >> 4) * 128 + (_q & 15) * 8; \
            R0[_i] = *(const u32x4*)(_p0 + _o); R1[_i] = *(const u32x4*)(_p1 + _o); R2[_i] = *(const u32x4*)(_p2 + _o); R3[_i] = *(const u32x4*)(_p3 + _o); } \
        if (threadIdx.x < 128) { const int _dir = threadIdx.x >> 6, _ln = threadIdx.x & 63; \
            const int _l0 = _dir ? 127 - 2 * _ln : 2 * _ln, _l1 = _dir ? 126 - 2 * _ln : 2 * _ln + 1; \
            if (_ssd) { const float* _dp = (const float*)(ws + O_DT) + (size_t)_rb * 16 + _dir * 8 + _h; ps0 = _dp[_l0 * 16]; ps1 = _dp[_l1 * 16]; } \
            else { const float* _gf = (const float*)(ws + O_GF) + (size_t)_rb * 8 + _dir * 4 + _h; const float* _gi = (const float*)(ws + O_GI) + (size_t)_rb * 8 + _dir * 4 + _h; \
                   ps0 = _gf[_l0 * 8]; ps1 = _gf[_l1 * 8]; ps2 = _gi[_l0 * 8]; ps3 = _gi[_l1 * 8]; } } \
    } while (0)
    if ((int)blockIdx.x < NU6) P6_PREFETCH(blockIdx.x);
    for (int u = blockIdx.x; u < NU6; u += gridDim.x) {
        int t = threadIdx.x; asm volatile("" : "+v"(t));
        const int lane = t & 63, w = t >> 6, wm = w >> 1, wn = w & 1;
        const bool isssd = u < NSSD;
        const int v = isssd ? u : u - NSSD;
        const int h = isssd ? (v & 7) : (v & 3), ct = isssd ? (v >> 3) : (v >> 2), b = ct >> 5, c = ct & 31, cc = c + 2;
        const int rb = b * 4096 + c * 128, lpos = c * 128;
        const float mp0 = isssd ? 0.f : ((const float*)(ws + O_MLP))[((size_t)(b * NCH + cc) * 4 + h) * 2 + 0];
        const float mp1 = isssd ? 0.f : ((const float*)(ws + O_MLP))[((size_t)(b * NCH + cc) * 4 + h) * 2 + 1];
        if (w < 2) {
            const int dir = w;
            const int l0 = dir ? 127 - 2 * lane : 2 * lane, l1 = dir ? 126 - 2 * lane : 2 * lane + 1;
            if (isssd) {
                const float d0 = ps0, d1 = ps1;
                const float an = -__expf(P.in[I_ALOG][dir * 8 + h]);
                const float p0 = d0 * an, p1 = p0 + d1 * an;
                const float inc = wave_scan_sum(p1, lane);
                const float ex = inc - p1;
                float* ca = dir ? a1 : a0; float* da = dir ? a3 : a2;
                ca[l0] = ex + p0; ca[l1] = ex + p1; da[l0] = d0; da[l1] = d1;
            } else {
                const float f0 = ps0, f1 = ps1, i0 = ps2, i1 = ps3;
                const float p1 = f0 + f1;
                const float inc = wave_scan_sum(p1, lane);
                const float ex = inc - p1;
                const float bc0 = ex + f0, bc1 = ex + p1;
                const float u0 = i0 - bc0, u1 = i1 - bc1;
                const float q1 = fmaxf(u0, u1);
                const float incm = wave_scan_max(q1, lane);
                float exm = __shfl_up(incm, 1); if (lane == 0) exm = -INFINITY;
                const float mp = dir ? mp1 : mp0;
                float* ab = dir ? a1 : a0; float* au = dir ? a3 : a2; float* am = dir ? a5 : a4;
                ab[l0] = bc0; ab[l1] = bc1; au[l0] = u0; au[l1] = u1;
                am[l0] = fmaxf(mp, fmaxf(exm, u0)); am[l1] = fmaxf(mp, fmaxf(exm, q1));
            }
        }
#pragma unroll
        for (int i = 0; i < 4; ++i) {
            const int q = t + 512 * i, r = q >> 4, cq = q & 15;
            *(u32x4*)(T0 + swz256(r, cq)) = R0[i];
            *(u32x4*)(T1 + swz256(r, cq)) = R1[i];
            *(u32x4*)(T2 + swz256(r, cq)) = R2[i];
            if (!isssd || i < 2) *(u32x4*)(T3 + swz256(r, cq)) = R3[i];
        }
        __syncthreads();
        if (u + (int)gridDim.x < NU6) P6_PREFETCH(u + gridDim.x);
        if (isssd) {
            const int g = h >> 2; (void)g;
            const int lr = lane & 15, lq = lane >> 4;
            f32x4 Y[2][2];
            {
                f32x4 aF[2][2], aB[2][2]; zero_acc(aF); zero_acc(aB);
                lds_mma_t<2, 2>(T0, T2, wm * 32, wn * 32, aF, lane);
                lds_mma_t<2, 2>(T0, T2, wm * 32, 64 + wn * 32, aB, lane);
#pragma unroll
                for (int i = 0; i < 2; ++i) {
                    const int l = wm * 32 + i * 16 + lr;
                    const float e0 = __expf(a0[l]), e1 = __expf(a1[l]);
#pragma unroll
                    for (int j = 0; j < 2; ++j) Y[i][j] = e0 * aF[i][j] + e1 * aB[i][j];
                }
            }
            f32x4 G[2][4]; zero_acc(G);
            lds_mma_t<2, 4>(T0, T1, wm * 32, wn * 64, G, lane);
            __syncthreads();
            {
                const float Dh = P.in[I_SSDD][h];
                int dbase = wn * 64 + lq * 4 - wm * 32 - lr; asm volatile("" : "+v"(dbase));
#pragma unroll
                for (int j = 0; j < 4; ++j) {
                    const int s0 = wn * 64 + j * 16 + lq * 4;
                    const float4 c0s = *(const float4*)(a0 + s0), r1s = *(const float4*)(a1 + s0), d0s = *(const float4*)(a2 + s0), d1s = *(const float4*)(a3 + s0);
                    const float c0v[4] = {c0s.x, c0s.y, c0s.z, c0s.w}, r1v[4] = {r1s.x, r1s.y, r1s.z, r1s.w};
                    const float d0v[4] = {d0s.x, d0s.y, d0s.z, d0s.w}, d1v[4] = {d1s.x, d1s.y, d1s.z, d1s.w};
#pragma unroll
                    for (int i = 0; i < 2; ++i) {
                        const int l = wm * 32 + i * 16 + lr;
                        const float c0l = a0[l], r1l = a1[l];
                        float mv[4];
#pragma unroll
                        for (int r = 0; r < 4; ++r) {
                            const int diff = dbase + (j * 16 - i * 16 + r);
                            const float e0 = (diff <= 0) ? (c0l - c0v[r]) : -INFINITY;
                            const float e1 = (diff >= 0) ? (r1l - r1v[r]) : -INFINITY;
                            mv[r] = G[i][j][r] * (__expf(e0) * d0v[r] + __expf(e1) * d1v[r]) + (diff == 0 ? Dh : 0.f);
                        }
                        uint2 o; o.x = pack2(mv[0], mv[1]); o.y = pack2(mv[2], mv[3]);
                        *(uint2*)(T1 + swz256(l, s0 >> 3) + (s0 & 7) * 2) = o;
                    }
                }
            }
            __syncthreads();
            lds_mma_t<2, 2>(T1, T3, wm * 32, wn * 32, Y, lane);
            u16* zo = (u16*)(ws + O_ZO);
            uint2 zvv[2][2];
#pragma unroll
            for (int i = 0; i < 2; ++i)
#pragma unroll
                for (int j = 0; j < 2; ++j) zvv[i][j] = *(const uint2*)(zo + (size_t)(rb + wm * 32 + i * 16 + lr) * 1024 + h * 64 + wn * 32 + j * 16 + lq * 4);
            __builtin_amdgcn_sched_barrier(0);
#pragma unroll
            for (int i = 0; i < 2; ++i) {
                const int l = wm * 32 + i * 16 + lr;
                float ssq = 0.f;
#pragma unroll
                for (int j = 0; j < 2; ++j) {
                    const int p = wn * 32 + j * 16 + lq * 4;
                    u16* zp = zo + (size_t)(rb + l) * 1024 + h * 64 + p;
                    const uint2 zv = zvv[i][j];
                    const float y0 = Y[i][j][0] * siluf(bflo(zv.x)), y1 = Y[i][j][1] * siluf(bfhi(zv.x));
                    const float y2 = Y[i][j][2] * siluf(bflo(zv.y)), y3 = Y[i][j][3] * siluf(bfhi(zv.y));
                    uint2 o; o.x = pack2(y0, y1); o.y = pack2(y2, y3);
                    *(uint2*)zp = o;
                    ssq += y0 * y0 + y1 * y1 + y2 * y2 + y3 * y3;
                }
                ssq += __shfl_xor(ssq, 16); ssq += __shfl_xor(ssq, 32);
                if (lq == 0) ((float*)(ws + O_SSQ))[(size_t)(rb + l) * 16 + h * 2 + wn] = ssq;
            }
            __syncthreads();
        } else {
            const int lr = lane & 15, lq = lane >> 4;
            f32x4 S[2][4]; zero_acc(S);
            lds_mma_t<2, 4>(T0, T1, wm * 32, wn * 64, S, lane);
            if (t < 256) {
                const int dir = t >> 7, idx = t & 127;
                const float* np = (const float*)(ws + O_MLN) + (((size_t)(b * NCH + cc) * 4 + h) * 2 + dir) * 128;
                float acc = 0.f;
#pragma unroll 4
                for (int cch = 0; cch < 16; ++cch) {
                    const uint4 qv = *(const uint4*)(T0 + swz256(idx, cch));
                    const float4 n0 = *(const float4*)(np + cch * 8), n1 = *(const float4*)(np + cch * 8 + 4);
                    acc += bflo(qv.x) * n0.x + bfhi(qv.x) * n0.y + bflo(qv.y) * n0.z + bfhi(qv.y) * n0.w
                         + bflo(qv.z) * n1.x + bfhi(qv.z) * n1.y + bflo(qv.w) * n1.z + bfhi(qv.w) * n1.w;
                }
                qn[dir * 128 + idx] = acc;
            }
            int dbase = wn * 64 + lq * 4 - wm * 32 - lr; asm volatile("" : "+v"(dbase));
            {
                float r0[2] = {0.f, 0.f}, r1[2] = {0.f, 0.f};
#pragma unroll
                for (int j = 0; j < 4; ++j) {
                    const int s0 = wn * 64 + j * 16 + lq * 4;
                    const float4 u0s = *(const float4*)(a2 + s0), u1s = *(const float4*)(a3 + s0);
                    const float u0v[4] = {u0s.x, u0s.y, u0s.z, u0s.w}, u1v[4] = {u1s.x, u1s.y, u1s.z, u1s.w};
#pragma unroll
                    for (int i = 0; i < 2; ++i) {
                        const int tt = wm * 32 + i * 16 + lr;
                        const float m0 = a4[tt], m1 = a5[tt];
#pragma unroll
                        for (int r = 0; r < 4; ++r) {
                            const int diff = dbase + (j * 16 - i * 16 + r);
                            r0[i] += S[i][j][r] * __expf((diff <= 0) ? (u0v[r] - m0) : -INFINITY);
                            r1[i] += S[i][j][r] * __expf((diff >= 0) ? (u1v[r] - m1) : -INFINITY);
                        }
                    }
                }
#pragma unroll
                for (int i = 0; i < 2; ++i) {
                    const int tt = wm * 32 + i * 16 + lr;
                    float x0 = r0[i], x1 = r1[i];
                    x0 += __shfl_xor(x0, 16); x0 += __shfl_xor(x0, 32);
                    x1 += __shfl_xor(x1, 16); x1 += __shfl_xor(x1, 32);
                    if (lq == 0) { rsA[(0 * 2 + wn) * 128 + tt] = x0; rsA[(1 * 2 + wn) * 128 + tt] = x1; }
                }
            }
            __syncthreads();
            if (t < 256) {
                const int dir = t >> 7, tt = t & 127;
                const float rs = rsA[(dir * 2 + 0) * 128 + tt] + rsA[(dir * 2 + 1) * 128 + tt];
                const float mm = dir ? a5[tt] : a4[tt];
                const float wi = __expf((dir ? mp1 : mp0) - mm);
                const float den = rs + wi * qn[dir * 128 + tt];
                const float mout = (dir ? a1[tt] : a0[tt]) + mm;
                const float dn = fmaxf(fabsf(den), __expf(-mout));
                fac[dir * 128 + tt] = 1.f / dn;
                wfac[dir * 128 + tt] = wi / dn;
            }
            __syncthreads();
            f32x4 H[2][4];
            {
                f32x4 A0[2][4]; zero_acc(A0);
                lds_mma_t<2, 4>(T0, T2, wm * 32, wn * 64, A0, lane);
#pragma unroll
                for (int i = 0; i < 2; ++i) {
                    const float f = wfac[wm * 32 + i * 16 + lr];
#pragma unroll
                    for (int j = 0; j < 4; ++j) H[i][j] = f * A0[i][j];
                }
            }
            {
                f32x4 A1[2][4]; zero_acc(A1);
                lds_mma_t<2, 4>(T0, T3, wm * 32, wn * 64, A1, lane);
#pragma unroll
                for (int i = 0; i < 2; ++i) {
                    const float f = wfac[128 + wm * 32 + i * 16 + lr];
#pragma unroll
                    for (int j = 0; j < 4; ++j) H[i][j] += f * A1[i][j];
                }
            }
            __syncthreads();
            asm volatile("" : "+v"(dbase));
#pragma unroll
            for (int j = 0; j < 4; ++j) {
                const int s0 = wn * 64 + j * 16 + lq * 4;
                const float4 u0s = *(const float4*)(a2 + s0), u1s = *(const float4*)(a3 + s0);
                const float u0v[4] = {u0s.x, u0s.y, u0s.z, u0s.w}, u1v[4] = {u1s.x, u1s.y, u1s.z, u1s.w};
#pragma unroll
                for (int i = 0; i < 2; ++i) {
                    const int tt = wm * 32 + i * 16 + lr;
                    const float m0 = a4[tt], m1 = a5[tt], f0 = fac[tt], f1 = fac[128 + tt];
                    float pv[4];
#pragma unroll
                    for (int r = 0; r < 4; ++r) {
                        const int diff = dbase + (j * 16 - i * 16 + r);
                        pv[r] = S[i][j][r] * (__expf((diff <= 0) ? (u0v[r] - m0) : -INFINITY) * f0 + __expf((diff >= 0) ? (u1v[r] - m1) : -INFINITY) * f1);
                    }
                    uint2 o; o.x = pack2(pv[0], pv[1]); o.y = pack2(pv[2], pv[3]);
                    *(uint2*)(T1 + swz256(tt, s0 >> 3) + (s0 & 7) * 2) = o;
                }
            }
            load_tile128(T2, 0, (const u16*)(ws + O_VT) + ((size_t)(b * NCH + cc) * 512 + h * 128) * 128, 128, 128, t, 512);
            __syncthreads();
            lds_mma_t<2, 4>(T1, T2, wm * 32, wn * 64, H, lane);
            u16* zo = (u16*)(ws + O_ZO);
            size_t rown[2];
#pragma unroll
            for (int i = 0; i < 2; ++i) {
                const int tt = wm * 32 + i * 16 + lr;
                const int lp = lpos + tt;
                rown[i] = (size_t)b * 4096 + ((lp & 63) << 6) + (lp >> 6);
                float ssq = 0.f;
#pragma unroll
                for (int j = 0; j < 4; ++j) {
                    const int d = wn * 64 + j * 16 + lq * 4;
                    const uint2 ov = *(const uint2*)(zo + rown[i] * 1024 + 512 + h * 128 + d);
                    H[i][j][0] *= sigmf(bflo(ov.x)); H[i][j][1] *= sigmf(bfhi(ov.x)); H[i][j][2] *= sigmf(bflo(ov.y)); H[i][j][3] *= sigmf(bfhi(ov.y));
                    ssq += H[i][j][0] * H[i][j][0] + H[i][j][1] * H[i][j][1] + H[i][j][2] * H[i][j][2] + H[i][j][3] * H[i][j][3];
                }
                ssq += __shfl_xor(ssq, 16); ssq += __shfl_xor(ssq, 32);
                if (lq == 0) rsA[wn * 128 + tt] = ssq;
            }
            __syncthreads();
            const u16* xc = (const u16*)(ws + O_XC);
            f32x4 nwv[4], skv[4]; uint2 xvv[4][2];
#pragma unroll
            for (int j = 0; j < 4; ++j) {
                const int d = wn * 64 + j * 16 + lq * 4, chg = h * 128 + d;
                nwv[j] = *(const f32x4*)(P.in[I_MNW] + chg); skv[j] = *(const f32x4*)(P.in[I_MSKIP] + chg);
#pragma unroll
                for (int i = 0; i < 2; ++i) xvv[j][i] = *(const uint2*)(xc + ((size_t)(b * NCH + cc) * 4 + h) * 16384 + (size_t)(wm * 32 + i * 16 + lr) * 128 + d);
            }
            __builtin_amdgcn_sched_barrier(0);
#pragma unroll
            for (int j = 0; j < 4; ++j) {
                const int d = wn * 64 + j * 16 + lq * 4, chg = h * 128 + d;
#pragma unroll
                for (int i = 0; i < 2; ++i) {
                    const int tt = wm * 32 + i * 16 + lr;
                    const float rn = rsqrtf((rsA[tt] + rsA[128 + tt]) * (1.f / 128.f) + 1e-6f);
                    const uint2 xv = xvv[j][i];
                    const float y0 = H[i][j][0] * rn * nwv[j][0] + skv[j][0] * bflo(xv.x), y1 = H[i][j][1] * rn * nwv[j][1] + skv[j][1] * bfhi(xv.x);
                    const float y2 = H[i][j][2] * rn * nwv[j][2] + skv[j][2] * bflo(xv.y), y3 = H[i][j][3] * rn * nwv[j][3] + skv[j][3] * bfhi(xv.y);
                    uint2 o; o.x = pack2(y0, y1); o.y = pack2(y2, y3);
                    *(uint2*)(zo + rown[i] * 1024 + 512 + chg) = o;
                }
            }
            __syncthreads();
        }
    }
}

struct OutProj {
    static constexpr int K = 1024; static constexpr bool PERM = false; static constexpr int MIDT = 8;
    struct Unit { int pm, pn, slot; };
    const Params* P; const float* rs; int G, c;
    __device__ __forceinline__ bool next(int i, Unit& u) const {
        const int L = i * G + c;
        if (L >= 256) return false;
        g8::dense_unit(L, 64, 4, u.pm, u.pn); u.slot = i & 3;
        return true;
    }
    __device__ __forceinline__ const char* baseA(const Unit&) const { return (const char*)(P->ws + O_ZO); }
    __device__ __forceinline__ const char* baseB(const Unit&) const { return (const char*)(P->ws + O_WOUT); }
    __device__ __forceinline__ void offs(const Unit& u, int tid_, unsigned (&oa)[2][2], unsigned (&ob)[2][2]) const {
        int R[2], C[2];
        { int tq = tid_; asm volatile("" : "+v"(tq)); g8::stage_rc(tq * 16, R[0], C[0]); g8::stage_rc(tq * 16 + 8192, R[1], C[1]); }
#pragma unroll
        for (int h = 0; h < 2; ++h)
#pragma unroll
            for (int i = 0; i < 2; ++i) {
                oa[h][i] = (unsigned)((u.pm * 256 + h * 128 + R[i]) * 1024 + C[i]) * 2u;
                ob[h][i] = (unsigned)((u.pn * 256 + h * 128 + R[i]) * 1024 + C[i]) * 2u;
            }
    }
    __device__ __forceinline__ int nt(const Unit&) const { return 16; }
    __device__ __forceinline__ bool brk(const Unit&, const Unit&) const { return false; }
    __device__ __forceinline__ void a_ready(const Unit&) const {}
    __device__ __forceinline__ void done(const Unit&) const {}
    __device__ __forceinline__ void mid(g8::Acc& acc, const Unit& u, int wr, int fr) const {
#pragma unroll
        for (int ai = 0; ai < 2; ++ai)
#pragma unroll
            for (int m = 0; m < 4; ++m) {
                const float s = rs[u.slot * 256 + ai * 128 + wr * 64 + m * 16 + fr];
#pragma unroll
                for (int bj = 0; bj < 2; ++bj)
#pragma unroll
                    for (int n = 0; n < 2; ++n) acc[ai][bj][m][n] *= s;
            }
    }
    __device__ __forceinline__ void epi(g8::Acc& acc, const Unit& u, int wr, int wc, int fr, int fq) const {
        const int row0 = u.pm * 256 + wr * 64 + fr, col0 = u.pn * 256 + wc * 32 + 4 * fq;
        const int b = u.pm >> 4;
        const float* mod = (const float*)(P->ws + O_MOD) + b * 6144 + 2048;
        f32x4 g1[2][2];
#pragma unroll
        for (int bj = 0; bj < 2; ++bj)
#pragma unroll
            for (int n = 0; n < 2; ++n) g1[bj][n] = *(const f32x4*)(mod + col0 + bj * 128 + n * 16);
        f32x4 xa[8], xb[8];
#define OP_LOAD(dst, ai_, mp_) _Pragma("unroll") for (int mm = 0; mm < 2; ++mm) _Pragma("unroll") for (int bj = 0; bj < 2; ++bj) _Pragma("unroll") for (int n = 0; n < 2; ++n) \
            dst[mm * 4 + bj * 2 + n] = *(const f32x4*)(P->in[I_X] + (size_t)(row0 + (ai_) * 128 + ((mp_) * 2 + mm) * 16) * 1024 + col0 + bj * 128 + n * 16)
#define OP_STORE(src, ai_, mp_) _Pragma("unroll") for (int mm = 0; mm < 2; ++mm) _Pragma("unroll") for (int bj = 0; bj < 2; ++bj) _Pragma("unroll") for (int n = 0; n < 2; ++n) \
            *(f32x4*)(P->out + (size_t)(row0 + (ai_) * 128 + ((mp_) * 2 + mm) * 16) * 1024 + col0 + bj * 128 + n * 16) = src[mm * 4 + bj * 2 + n] + g1[bj][n] * acc[ai_][bj][(mp_) * 2 + mm][n]
        OP_LOAD(xa, 0, 0);
        __builtin_amdgcn_sched_barrier(0);
        OP_LOAD(xb, 0, 1);
        __builtin_amdgcn_sched_barrier(0);
        OP_STORE(xa, 0, 0);
        __builtin_amdgcn_sched_barrier(0);
        OP_LOAD(xa, 1, 0);
        __builtin_amdgcn_sched_barrier(0);
        OP_STORE(xb, 0, 1);
        __builtin_amdgcn_sched_barrier(0);
        OP_LOAD(xb, 1, 1);
        __builtin_amdgcn_sched_barrier(0);
        OP_STORE(xa, 1, 0);
        __builtin_amdgcn_sched_barrier(0);
        OP_STORE(xb, 1, 1);
#undef OP_LOAD
#undef OP_STORE
    }
};
__device__ void phase7(const Params& P, char* lds) {
    float* rs = (float*)(lds + g8::STAGE_BYTES);
    OutProj S; S.P = &P; S.rs = rs; S.G = gridDim.x; S.c = blockIdx.x;
    for (int i = 0; i < 4; ++i) {
        OutProj::Unit u;
        if (!S.next(i, u)) break;
        if (threadIdx.x < 256) {
            const f32x4* sq = (const f32x4*)((const float*)(P.ws + O_SSQ) + (size_t)(u.pm * 256 + threadIdx.x) * 16);
            const f32x4 s0 = sq[0], s1 = sq[1], s2 = sq[2], s3 = sq[3];
            const f32x4 sv = (s0 + s1) + (s2 + s3);
            const float s = (sv[0] + sv[1]) + (sv[2] + sv[3]);
            rs[i * 256 + threadIdx.x] = rsqrtf(s * (1.f / 512.f) + 1e-6f);
        }
    }
    __syncthreads();
    g8::gemm_phase<OutProj>((LAS unsigned char*)lds, S);
}

__device__ void phase8(const Params& P, char* lds_all) {
    unsigned char* ws = P.ws;
    const float* mod = (const float*)(ws + O_MOD);
    {
        const int t = threadIdx.x, lane = t & 63, w = t >> 6;
        float* tt = (float*)lds_all;
        float bw[32][3];
        {
            const int ti = lane & 15, kq = lane >> 4;
#pragma unroll
            for (int ks = 0; ks < 32; ++ks) {
                const int k = w * 128 + ks * 4 + kq;
                bw[ks][0] = P.in[I_REW][(size_t)k * 32 + ti];
                bw[ks][1] = P.in[I_REW][(size_t)k * 32 + 16 + ti];
                const float b2r = P.in[I_RGW][(size_t)k * 4 + (ti & 3)];
                bw[ks][2] = ti < 4 ? b2r : 0.f;
            }
        }
        for (int u = blockIdx.x; u < 512; u += gridDim.x) {
            const int tk0 = u * 32;
            const int b = tk0 >> 12;
            f32x4 mulv[4], shv[4];
            {
                f32x4 nwv[4], scv[4];
#pragma unroll
                for (int j = 0; j < 4; ++j) {
                    const int k = (lane + 64 * j) * 4;
                    nwv[j] = *(const f32x4*)(P.in[I_N2W] + k);
                    shv[j] = *(const f32x4*)(mod + b * 6144 + 3072 + k);
                    scv[j] = *(const f32x4*)(mod + b * 6144 + 4096 + k);
                }
#pragma unroll
                for (int j = 0; j < 4; ++j) mulv[j] = nwv[j] * (scv[j] + 1.f);
            }
#pragma unroll 1
            for (int qh = 0; qh < 2; ++qh) {
                f32x4 v[2][4]; float ss[2];
#pragma unroll
                for (int q = 0; q < 2; ++q) {
                    const float* xr = P.out + (size_t)(tk0 + w * 4 + qh * 2 + q) * 1024;
#pragma unroll
                    for (int j = 0; j < 4; ++j) v[q][j] = ((const f32x4*)xr)[lane + 64 * j];
                }
                __builtin_amdgcn_sched_barrier(0);
#pragma unroll
                for (int q = 0; q < 2; ++q) {
                    ss[q] = 0.f;
#pragma unroll
                    for (int j = 0; j < 4; ++j) ss[q] += v[q][j][0] * v[q][j][0] + v[q][j][1] * v[q][j][1] + v[q][j][2] * v[q][j][2] + v[q][j][3] * v[q][j][3];
                    ss[q] = rsqrtf(wave_sum(ss[q]) * (1.f / 1024.f) + 1e-6f);
                }
#pragma unroll
                for (int j = 0; j < 4; ++j) {
                    const int k = (lane + 64 * j) * 4;
#pragma unroll
                    for (int q = 0; q < 2; ++q) {
                        const int tl = w * 4 + qh * 2 + q;
                        const f32x4 hh = v[q][j] * ss[q] * mulv[j] + shv[j];
                        uint2 o; o.x = pack2(hh[0], hh[1]); o.y = pack2(hh[2], hh[3]);
                        *(uint2*)((u16*)(ws + O_T) + (size_t)(tk0 + tl) * 1024 + k) = o;
                        *(f32x4*)(tt + tl * 1028 + k) = hh;
                    }
                }
            }
            __syncthreads();
            f32x4 c[2][3];
#pragma unroll
            for (int a = 0; a < 2; ++a)
#pragma unroll
                for (int f = 0; f < 3; ++f) c[a][f] = f32x4{0, 0, 0, 0};
            const int ti = lane & 15, kq = lane >> 4;
#pragma unroll
            for (int ks = 0; ks < 32; ++ks) {
                const int k = w * 128 + ks * 4 + kq;
                const float a0 = tt[ti * 1028 + k], a1 = tt[(16 + ti) * 1028 + k];
                c[0][0] = __builtin_amdgcn_mfma_f32_16x16x4f32(a0, bw[ks][0], c[0][0], 0, 0, 0);
                c[0][1] = __builtin_amdgcn_mfma_f32_16x16x4f32(a0, bw[ks][1], c[0][1], 0, 0, 0);
                c[0][2] = __builtin_amdgcn_mfma_f32_16x16x4f32(a0, bw[ks][2], c[0][2], 0, 0, 0);
                c[1][0] = __builtin_amdgcn_mfma_f32_16x16x4f32(a1, bw[ks][0], c[1][0], 0, 0, 0);
                c[1][1] = __builtin_amdgcn_mfma_f32_16x16x4f32(a1, bw[ks][1], c[1][1], 0, 0, 0);
                c[1][2] = __builtin_amdgcn_mfma_f32_16x16x4f32(a1, bw[ks][2], c[1][2], 0, 0, 0);
            }
            __syncthreads();
            float* red = (float*)lds_all;
#pragma unroll
            for (int a = 0; a < 2; ++a)
#pragma unroll
                for (int r = 0; r < 4; ++r) {
                    const int row = a * 16 + kq * 4 + r;
                    red[(w * 32 + row) * 48 + ti] = c[a][0][r];
                    red[(w * 32 + row) * 48 + 16 + ti] = c[a][1][r];
                    red[(w * 32 + row) * 48 + 32 + ti] = c[a][2][r];
                }
            __syncthreads();
            int* lcnt = (int*)(lds_all + 65536);
            if (t < 64) lcnt[t] = 0;
            __syncthreads();
            int ea = 0, eb = 0, ra = 0, rb = 0; float w1 = 0.f, w2 = 0.f;
            if (t < 32) {
                float gl[4];
#pragma unroll
                for (int j = 0; j < 4; ++j) {
                    float sacc = P.in[I_RGB][j];
#pragma unroll
                    for (int ww = 0; ww < 8; ++ww) sacc += red[(ww * 32 + t) * 48 + 32 + j];
                    gl[j] = sacc;
                }
                int gs = 0; float gm = gl[0];
#pragma unroll
                for (int j = 1; j < 4; ++j) if (gl[j] > gm) { gm = gl[j]; gs = j; }
                float gsum = 0.f;
#pragma unroll
                for (int j = 0; j < 4; ++j) gsum += __expf(gl[j] - gm);
                const float pg = 1.f / gsum;
                float el[8];
#pragma unroll
                for (int j = 0; j < 8; ++j) {
                    float sacc = P.in[I_REB][gs * 8 + j];
#pragma unroll
                    for (int ww = 0; ww < 8; ++ww) sacc += red[(ww * 32 + t) * 48 + gs * 8 + j];
                    el[j] = sacc;
                }
                int i1 = 0; float m1 = el[0];
#pragma unroll
                for (int j = 1; j < 8; ++j) if (el[j] > m1) { m1 = el[j]; i1 = j; }
                int i2 = -1; float m2 = -INFINITY;
#pragma unroll
                for (int j = 0; j < 8; ++j) if (j != i1 && el[j] > m2) { m2 = el[j]; i2 = j; }
                const float e2 = __expf(m2 - m1);
                w1 = pg / (1.f + e2); w2 = pg * e2 / (1.f + e2);
                ea = gs * 8 + i1; eb = gs * 8 + i2;
                ra = atomicAdd(&lcnt[ea], 1);
                rb = atomicAdd(&lcnt[eb], 1);
            }
            __syncthreads();
            if (t < 32) {
                const int n = lcnt[t];
                lcnt[32 + t] = n > 0 ? atomicAdd((int*)(ws + O_CNT) + t * 64, n) : 0;
            }
            __syncthreads();
            if (t < 32) {
                const int tok = tk0 + t;
                int* list = (int*)(ws + O_LIST);
                float* wts = (float*)(ws + O_WTS);
                list[ea * 16384 + lcnt[32 + ea] + ra] = tok * 2;
                wts[tok * 2] = w1;
                list[eb * 16384 + lcnt[32 + eb] + rb] = tok * 2 + 1;
                wts[tok * 2 + 1] = w2;
            }
            __syncthreads();
        }
    }
    const int vb = threadIdx.x >> 8, t = threadIdx.x & 255;
    char* lds = lds_all + vb * VLDS;
    const int NTR = 3072;
    for (int u = blockIdx.x * 2 + vb; u < NTR; u += gridDim.x * 2) {
        {
            const int v = u;
            float* tile = (float*)lds;
            if (v < 2048) {
                const bool up = v >= 1024;
                const int vv = v & 1023, e = vv >> 5, rem = vv & 31, nt = rem >> 4, kt = rem & 15;
                const float* src = P.in[up ? I_WU : I_WG] + (size_t)e * 1024 * 256;
                transpose_tile_w(tile, src, 256, kt * 64, nt * 128, (u16*)(ws + O_WGU) + (size_t)e * 512 * 1024, (up ? 256 : 0) + nt * 128, 1024, nullptr, 0, t);
            } else {
                const int vv = v - 2048, e = vv >> 5, rem = vv & 31, nt = rem >> 2, kt = rem & 3;
                const float* src = P.in[I_WD] + (size_t)e * 256 * 1024;
                transpose_tile_w(tile, src, 1024, kt * 64, nt * 128, (u16*)(ws + O_WD) + (size_t)e * 1024 * 256, nt * 128, 256, nullptr, 0, t);
            }
        }
    }
}

__device__ __forceinline__ void moe_prefix(const unsigned char* ws, int* pre_t, int* pre_c) {
    if (threadIdx.x == 0) {
        const int* cnt = (const int*)(ws + O_CNT);
        int at = 0, ac = 0;
        for (int e = 0; e < 32; ++e) { pre_t[e] = at; pre_c[e] = ac; const int c = cnt[e * 64]; at += (c + 255) >> 8; ac += c; }
        pre_t[32] = at; pre_c[32] = ac;
    }
    __syncthreads();
}
struct MoeUnit { int type, e, mt, pn, cnt, base, mtg; };
struct Moe {
    static constexpr int K = 0; static constexpr bool PERM = true; static constexpr int MIDT = 0;
    typedef MoeUnit Unit;
    const unsigned char* ws; const int* pre_t; const int* pre_c; int G, c;
    __device__ __forceinline__ bool next(int i, Unit& u) const {
        int type, m, pn, e, mt;
        if ((G & 7) == 0) {
            const int x = c & 7, s = c >> 3, nb = G >> 3;
            const int n0 = pre_t[x + 1] - pre_t[x], n1 = pre_t[x + 9] - pre_t[x + 8], n2 = pre_t[x + 17] - pre_t[x + 16], n3 = pre_t[x + 25] - pre_t[x + 24];
            const int MTx = n0 + n1 + n2 + n3;
            const int Lx = i * nb + s;
            if (Lx < MTx * 2) { type = 0; m = Lx >> 1; pn = Lx & 1; }
            else if (Lx < MTx * 6) { const int j = Lx - MTx * 2; type = 1; m = j >> 2; pn = j & 3; }
            else return false;
            if (m < n0) { e = x; mt = m; }
            else if (m < n0 + n1) { e = x + 8; mt = m - n0; }
            else if (m < n0 + n1 + n2) { e = x + 16; mt = m - n0 - n1; }
            else { e = x + 24; mt = m - n0 - n1 - n2; }
        } else {
            const int L = i * G + c, MT = pre_t[32];
            if (L < MT * 2) { type = 0; m = L >> 1; pn = L & 1; }
            else if (L < MT * 6) { const int j = L - MT * 2; type = 1; m = j >> 2; pn = j & 3; }
            else return false;
            e = 0;
            while (pre_t[e + 1] <= m) ++e;
            mt = m - pre_t[e];
        }
        u.e = __builtin_amdgcn_readfirstlane(e); u.mt = __builtin_amdgcn_readfirstlane(mt);
        u.cnt = __builtin_amdgcn_readfirstlane(pre_c[e + 1] - pre_c[e]); u.base = __builtin_amdgcn_readfirstlane(pre_c[e]);
        u.mtg = __builtin_amdgcn_readfirstlane(pre_t[e] + mt); u.pn = __builtin_amdgcn_readfirstlane(pn); u.type = __builtin_amdgcn_readfirstlane(type);
        return true;
    }
    __device__ __forceinline__ int nt(const Unit& u) const { return u.type ? 4 : 16; }
    __device__ __forceinline__ bool brk(const Unit& a, const Unit& b) const { return a.type == 0 && b.type == 1; }
    __device__ __forceinline__ const char* baseA(const Unit& u) const {
        return u.type ? (const char*)(ws + O_H) + (size_t)(u.base + u.mt * 256) * 256 * 2 : (const char*)(ws + O_T);
    }
    __device__ __forceinline__ const char* baseB(const Unit& u) const {
        return u.type ? (const char*)(ws + O_WD) + ((size_t)u.e * 1024 + u.pn * 256) * 256 * 2 : (const char*)(ws + O_WGU) + (size_t)u.e * 512 * 1024 * 2;
    }
    __device__ __forceinline__ void offs(const Unit& u, int tid_, unsigned (&oa)[2][2], unsigned (&ob)[2][2]) const {
        int R[2], C[2];
        { int tq = tid_; asm volatile("" : "+v"(tq)); g8::stage_rc(tq * 16, R[0], C[0]); g8::stage_rc(tq * 16 + 8192, R[1], C[1]); }
        const int* list = (const int*)(ws + O_LIST) + u.e * 16384;
        int tokv[2][2];
        if (u.type == 0) {
#pragma unroll
            for (int h = 0; h < 2; ++h)
#pragma unroll
                for (int i = 0; i < 2; ++i) { const int idx = u.mt * 256 + h * 128 + R[i]; tokv[h][i] = list[idx < u.cnt ? idx : u.cnt - 1]; }
            __builtin_amdgcn_sched_barrier(0);
        } else {
#pragma unroll
            for (int h = 0; h < 2; ++h)
#pragma unroll
                for (int i = 0; i < 2; ++i) tokv[h][i] = 0;
        }
#pragma unroll
        for (int h = 0; h < 2; ++h)
#pragma unroll
            for (int i = 0; i < 2; ++i) {
                const int Rb = (R[i] & ~31) + g8::perm32(R[i] & 31);
                const int tok = tokv[h][i] >> 1;
                if (u.type == 0) {
                    oa[h][i] = (unsigned)(tok * 1024 + C[i]) * 2u;
                    ob[h][i] = (unsigned)((h * 256 + u.pn * 128 + Rb) * 1024 + C[i]) * 2u;
                } else {
                    oa[h][i] = (unsigned)((h * 128 + R[i]) * 256 + C[i]) * 2u;
                    ob[h][i] = (unsigned)((h * 128 + Rb) * 256 + C[i]) * 2u;
                }
            }
    }
    __device__ __forceinline__ void mid(g8::Acc&, const Unit&, int, int) const {}
    __device__ __forceinline__ void a_ready(const Unit& u) const {
        if (u.type == 0) return;
        if (threadIdx.x < 64) {
            unsigned* rdy = (unsigned*)(ws + O_RDY) + u.mtg * 64;
            unsigned spins = 0;
            while ((unsigned)__builtin_amdgcn_readfirstlane(__hip_atomic_load(rdy, __ATOMIC_RELAXED, __HIP_MEMORY_SCOPE_AGENT)) < 16u) {
                __builtin_amdgcn_s_sleep(2);
                if (++spins > (1u << 22)) break;
            }
            __builtin_amdgcn_fence(__ATOMIC_ACQUIRE, "agent");
            asm volatile("s_waitcnt vmcnt(0)" ::: "memory");
        }
        asm volatile("" ::: "memory"); __builtin_amdgcn_s_barrier(); asm volatile("" ::: "memory");
    }
    __device__ __forceinline__ void done(const Unit& u) const {
        if (u.type != 0) return;
        asm volatile("s_waitcnt vmcnt(0)" ::: "memory");
        if ((threadIdx.x & 63) == 0) __hip_atomic_fetch_add((unsigned*)(ws + O_RDY) + u.mtg * 64, 1u, __ATOMIC_RELAXED, __HIP_MEMORY_SCOPE_AGENT);
    }
    __device__ __forceinline__ void epi(g8::Acc& acc, const Unit& u, int wr, int wc, int fr, int fq) const {
        if (u.type == 0) {
            __amdgpu_buffer_rsrc_t rs = __builtin_amdgcn_make_buffer_rsrc((void*)(ws + O_H), 0, (int)((32768 + 256) * 256 * 2), 0x00020000);
#pragma unroll
            for (int ai = 0; ai < 2; ++ai)
#pragma unroll
                for (int m = 0; m < 4; ++m) {
                    const int idx = u.mt * 256 + ai * 128 + wr * 64 + m * 16 + fr;
                    const f32x4 g0 = acc[ai][0][m][0], g1 = acc[ai][0][m][1], u0 = acc[ai][1][m][0], u1 = acc[ai][1][m][1];
                    u32x4 o;
                    o.x = g8::cvt_pk_bf16(siluf(g0[0]) * u0[0], siluf(g0[1]) * u0[1]); o.y = g8::cvt_pk_bf16(siluf(g0[2]) * u0[2], siluf(g0[3]) * u0[3]);
                    o.z = g8::cvt_pk_bf16(siluf(g1[0]) * u1[0], siluf(g1[1]) * u1[1]); o.w = g8::cvt_pk_bf16(siluf(g1[2]) * u1[2], siluf(g1[3]) * u1[3]);
                    const unsigned off = idx < u.cnt ? ((unsigned)(u.base + idx) * 256u + (unsigned)(u.pn * 128 + wc * 32 + 8 * fq)) * 2u : 0xF0000000u;
                    __builtin_amdgcn_raw_buffer_store_b128(o, rs, off, 0, 16);
                    __builtin_amdgcn_sched_barrier(0);
                }
            return;
        }
        const int* list = (const int*)(ws + O_LIST) + u.e * 16384;
        const float* wts = (const float*)(ws + O_WTS);
        __amdgpu_buffer_rsrc_t rsl = __builtin_amdgcn_make_buffer_rsrc((void*)(ws + O_SL), 0, (int)(16384 * 2 * 1024 * 2), 0x00020000);
        int ent[2][4]; float wg[2][4];
#pragma unroll
        for (int ai = 0; ai < 2; ++ai)
#pragma unroll
            for (int m = 0; m < 4; ++m) {
                const int idx = u.mt * 256 + ai * 128 + wr * 64 + m * 16 + fr;
                ent[ai][m] = list[idx < u.cnt ? idx : u.cnt - 1];
            }
#pragma unroll
        for (int ai = 0; ai < 2; ++ai)
#pragma unroll
            for (int m = 0; m < 4; ++m) wg[ai][m] = wts[ent[ai][m]];
#pragma unroll
        for (int ai = 0; ai < 2; ++ai)
#pragma unroll
            for (int m = 0; m < 4; ++m) {
                const int idx = u.mt * 256 + ai * 128 + wr * 64 + m * 16 + fr;
                const unsigned off = idx < u.cnt ? ((unsigned)ent[ai][m] * 1024u + (unsigned)(u.pn * 256 + wc * 32 + 8 * fq)) * 2u : 0xF0000000u;
#pragma unroll
                for (int bj = 0; bj < 2; ++bj) {
                    const f32x4 v0 = acc[ai][bj][m][0] * wg[ai][m], v1 = acc[ai][bj][m][1] * wg[ai][m];
                    u32x4 o; o.x = g8::cvt_pk_bf16(v0[0], v0[1]); o.y = g8::cvt_pk_bf16(v0[2], v0[3]); o.z = g8::cvt_pk_bf16(v1[0], v1[1]); o.w = g8::cvt_pk_bf16(v1[2], v1[3]);
                    __builtin_amdgcn_raw_buffer_store_b128(o, rsl, off + bj * 256u, 0, 0);
                }
            }
    }
};
__device__ void phase9(const Params& P, char* lds) {
    int* pre_t = (int*)(lds + g8::STAGE_BYTES); int* pre_c = pre_t + 40;
    moe_prefix(P.ws, pre_t, pre_c);
    Moe S; S.ws = P.ws; S.pre_t = pre_t; S.pre_c = pre_c; S.G = gridDim.x; S.c = blockIdx.x;
    int i = 0;
    while (i >= 0) i = g8::gemm_phase<Moe>((LAS unsigned char*)lds, S, i);
}

__device__ void phase11(const Params& P) {
    unsigned char* ws = P.ws;
    const int lane = threadIdx.x & 63;
    const int gw = blockIdx.x * 8 + (threadIdx.x >> 6), nw = gridDim.x * 8;
    const float* mod = (const float*)(ws + O_MOD);
    const u16* SL = (const u16*)(ws + O_SL);
    const int r_lo = (int)(((long long)gw * MLAT) / nw), r_hi = (int)(((long long)(gw + 1) * MLAT) / nw);
    float4 g2[4], fw[4];
    int cur_b = -1;
#pragma unroll
    for (int j = 0; j < 4; ++j) fw[j] = *(const float4*)(P.in[I_FNW] + (lane + 64 * j) * 4);
    for (int row = r_lo; row < r_hi; row += 2) {
        const bool two = row + 1 < r_hi;
        const int row1 = two ? row + 1 : row;
        float4 v0[4], v1[4]; uint2 a0[4], a1[4], b0[4], b1[4];
#pragma unroll
        for (int j = 0; j < 4; ++j) {
            const int k = (lane + 64 * j) * 4;
            v0[j] = *(const float4*)(P.out + (size_t)row * 1024 + k);
            v1[j] = *(const float4*)(P.out + (size_t)row1 * 1024 + k);
            a0[j] = *(const uint2*)(SL + (size_t)(row * 2) * 1024 + k);
            a1[j] = *(const uint2*)(SL + (size_t)(row * 2 + 1) * 1024 + k);
            b0[j] = *(const uint2*)(SL + (size_t)(row1 * 2) * 1024 + k);
            b1[j] = *(const uint2*)(SL + (size_t)(row1 * 2 + 1) * 1024 + k);
        }
#pragma unroll 1
        for (int rr = 0; rr < 2; ++rr) {
            const int orow = rr ? row1 : row;
            const int b = orow >> 12;
            if (b != cur_b) {
                cur_b = b;
#pragma unroll
                for (int j = 0; j < 4; ++j) g2[j] = *(const float4*)(mod + b * 6144 + 5120 + (lane + 64 * j) * 4);
            }
            if (rr == 1 && !two) break;
            float4 x[4]; float ss = 0.f;
#pragma unroll
            for (int j = 0; j < 4; ++j) {
                const float4 vv = rr ? v1[j] : v0[j];
                const uint2 s0 = rr ? b0[j] : a0[j], s1 = rr ? b1[j] : a1[j];
                x[j].x = vv.x + g2[j].x * (bflo(s0.x) + bflo(s1.x));
                x[j].y = vv.y + g2[j].y * (bfhi(s0.x) + bfhi(s1.x));
                x[j].z = vv.z + g2[j].z * (bflo(s0.y) + bflo(s1.y));
                x[j].w = vv.w + g2[j].w * (bfhi(s0.y) + bfhi(s1.y));
                ss += x[j].x * x[j].x + x[j].y * x[j].y + x[j].z * x[j].z + x[j].w * x[j].w;
            }
            const float rstd = rsqrtf(wave_sum(ss) * (1.f / 1024.f) + 1e-6f);
#pragma unroll
            for (int j = 0; j < 4; ++j) {
                float4 o; o.x = x[j].x * rstd * fw[j].x; o.y = x[j].y * rstd * fw[j].y; o.z = x[j].z * rstd * fw[j].z; o.w = x[j].w * rstd * fw[j].w;
                *(float4*)(P.out + (size_t)orow * 1024 + (lane + 64 * j) * 4) = o;
            }
        }
    }
}

__global__ void __launch_bounds__(NTB, 2) fwd_kernel(Params P) {
    extern __shared__ __attribute__((aligned(16))) char lds[];
    if (threadIdx.x < 4) ((volatile LAS unsigned*)(lds + LDS_MAIN))[threadIdx.x] = 0u;
    __syncthreads();
    XcdBarrier xbar = xcd_barrier_post((unsigned*)(P.ws + O_BAR), (volatile LAS unsigned*)(lds + LDS_MAIN));
#define SYNC() xcd_barrier(xbar)
#ifdef ONLY_PH
#define RUN_PHASE(k, call) do { if ((k) == ONLY_PH) { call; } } while (0)
#else
#define RUN_PHASE(k, call) do { if (P.lo <= (k) && (k) < P.hi) { call; if ((k) + 1 < P.hi) { SYNC(); } } } while (0)
#endif
    RUN_PHASE(0, phase0(P, lds));
    RUN_PHASE(1, phase1(P));
    RUN_PHASE(2, { InProj S; S.ws = P.ws; S.G = gridDim.x; S.c = blockIdx.x; g8::gemm_phase<InProj>((LAS unsigned char*)lds, S); });
    RUN_PHASE(3, phase3(P, lds));
    RUN_PHASE(4, phase4(P, lds));
    RUN_PHASE(5, phase5(P));
    RUN_PHASE(6, phase6(P, lds));
    RUN_PHASE(7, phase7(P, lds));
    RUN_PHASE(8, phase8(P, lds));
    RUN_PHASE(9, phase9(P, lds));
    RUN_PHASE(11, phase11(P));
}

extern "C" void kernel_launch(void* const* d_in, const int* in_sizes, int n_in, void* d_out, int out_size, void* d_ws, size_t ws_size,
                              hipStream_t stream) {
    static int grid_blocks = 0;
    if (!grid_blocks) {
        int dev = 0, cus = 0, per_cu = 0;
        (void)hipGetDevice(&dev);
        (void)hipDeviceGetAttribute(&cus, hipDeviceAttributeMultiprocessorCount, dev);
        (void)hipFuncSetAttribute((const void*)fwd_kernel, hipFuncAttributeMaxDynamicSharedMemorySize, LDS_BYTES);
        (void)hipOccupancyMaxActiveBlocksPerMultiprocessor(&per_cu, (const void*)fwd_kernel, NTB, LDS_BYTES);
        if (per_cu < 1) fprintf(stderr, "occupancy query says %d blocks per CU\n", per_cu);
        grid_blocks = cus;
        if (ws_size < WS_END) fprintf(stderr, "workspace too small: %zu < %zu\n", ws_size, (size_t)WS_END);
    }
    Params p{};
    for (int i = 0; i < 30; ++i) p.in[i] = (const float*)d_in[i];
    p.out = (float*)d_out; p.ws = (unsigned char*)d_ws;
    p.lo = 0; p.hi = NPHASE;
    (void)hipMemsetAsync((char*)d_ws + O_BAR, 0, 16384 + 40960, stream);
    void* args[] = {&p};
    hipError_t e = hipLaunchCooperativeKernel((const void*)fwd_kernel, dim3(grid_blocks), dim3(NTB), args, LDS_BYTES, stream);
    if (e != hipSuccess) fprintf(stderr, "cooperative launch failed: %s (grid %d)\n", hipGetErrorString(e), grid_blocks);
}
```

```cpp
#include <hip/hip_runtime.h>
#include <cstdio>
#include <cstdint>

typedef unsigned short u16;
typedef __attribute__((ext_vector_type(8))) short bf16x8;
typedef __attribute__((ext_vector_type(4))) float f32x4;
typedef __attribute__((ext_vector_type(4))) unsigned u32x4;
#define LAS __attribute__((address_space(3)))

constexpr int NTB = 512;
constexpr int VLDS = 75776;
constexpr int LDS_MAIN = 2 * VLDS;
constexpr int LDS_BYTES = LDS_MAIN + 256;
constexpr int MLAT = 16384, MALL = 17408;
constexpr int NCH = 34;
constexpr int NPHASE = 12;

enum { I_X = 0, I_C, I_CTX, I_CCTX, I_WMOD, I_BMOD, I_N1W, I_WIN, I_SCW, I_SCB, I_DTB, I_ALOG, I_SSDD, I_SNW, I_MCW, I_MCB, I_WQK, I_GB,
       I_MNW, I_MSKIP, I_WOUT, I_N2W, I_RGW, I_RGB, I_REW, I_REB, I_WG, I_WU, I_WD, I_FNW };

constexpr size_t al(size_t x) { return (x + 255) & ~(size_t)255; }
constexpr size_t O_MOD = 0;
constexpr size_t O_SSQ = O_MOD + al(5 * 6144 * 4);
constexpr size_t O_CNT = O_SSQ + al(16384 * 16 * 4);
constexpr size_t O_BAR = O_CNT + 8192;
constexpr size_t O_RDY = O_BAR + 16384;
constexpr size_t O_PSD = O_RDY + 40960;
constexpr size_t O_PSG = O_PSD + al((size_t)MALL * 16 * 4);
constexpr size_t O_DT = O_PSG + al((size_t)MALL * 16 * 4);
constexpr size_t O_GI = O_DT + al((size_t)MALL * 16 * 4);
constexpr size_t O_GF = O_GI + al((size_t)MALL * 8 * 4);
constexpr size_t O_ACH = O_GF + al((size_t)MALL * 8 * 4);
constexpr size_t O_MLS = O_ACH + 16384;
constexpr size_t O_MLP = O_MLS + 16384;
constexpr size_t O_MLN = O_MLP + 16384;
constexpr size_t O_LIST = O_MLN + al(4 * 34 * 4 * 2 * 128 * 4);
constexpr size_t O_WTS = O_LIST + al(32 * 16384 * 4);
constexpr size_t O_WIN = O_WTS + al(16384 * 2 * 4);
constexpr size_t O_WOUT = O_WIN + al((size_t)3328 * 1024 * 2);
constexpr size_t O_A = O_WOUT + al((size_t)1024 * 1024 * 2);
constexpr size_t SZ_A = (size_t)MALL * 1024 * 2;
constexpr size_t O_PT = O_A + SZ_A;
constexpr size_t SZ_PT = (size_t)MALL * 1536 * 2;
constexpr size_t O_MLC1 = O_PT + SZ_PT;
constexpr size_t SZ_HALF = (size_t)MALL * 512 * 2;
constexpr size_t O_ZO = O_MLC1 + SZ_HALF;
constexpr size_t O_VT = O_ZO + SZ_A;
constexpr size_t O_BM = O_VT + SZ_HALF;
constexpr size_t SZ_Q = (size_t)MALL * 256 * 2;
constexpr size_t O_BT = O_BM + SZ_Q;
constexpr size_t O_CM = O_BT + SZ_Q;
constexpr size_t O_XT = O_CM + SZ_Q;
constexpr size_t O_KT = O_XT + SZ_HALF;
constexpr size_t O_XC = O_KT + SZ_HALF;
constexpr size_t O_DUMP = O_XC + SZ_HALF;
constexpr size_t WS_END = O_DUMP + 256 * 2048;
constexpr size_t O_XN = O_A, O_Q = O_A, O_K = O_A + SZ_HALF, O_T = O_A;
constexpr size_t O_ST = O_PT;
constexpr size_t O_MLC0 = O_PT + (size_t)4 * 34 * 8 * 2 * 8192 * 2;
constexpr size_t O_WGU = O_PT;
constexpr size_t O_WD = O_PT + (size_t)32 * 512 * 1024 * 2;
constexpr size_t O_SL = O_ZO;
constexpr size_t O_H = O_XT;
static_assert(O_WD + (size_t)32 * 1024 * 256 * 2 <= O_MLC1, "moe weights fit PT region");
static_assert(O_SL + (size_t)16384 * 2 * 1024 * 2 <= O_CM, "slots fit");
static_assert((size_t)(32768 + 256) * 256 * 2 <= SZ_HALF, "H fits");
static_assert(WS_END <= (size_t)256 * 1024 * 1024, "workspace");
constexpr size_t TCTX512 = (size_t)4 * 512 * 4096;
constexpr size_t TCTX256 = (size_t)4 * 256 * 4096;

struct Params { const float* in[30]; float* out; unsigned char* ws; int lo, hi; };

#define XB_TMO      128
#define XB_XCNT(j)  (256  + 64 * (j))
#define XB_XSUB(j)  (1280 + 64 * (j))
#define XB_XGEN(j)  (2304 + 64 * (j))
#define XB_TOP      3328
#define XB_TOPGEN   3392
#define XCD_BAR_WORDS 3456
#define XB_SPIN_CAP (1u << 20)
__device__ __forceinline__ unsigned xb_ld(unsigned* p)              { return __hip_atomic_load(p, __ATOMIC_RELAXED, __HIP_MEMORY_SCOPE_AGENT); }
__device__ __forceinline__ unsigned xb_add(unsigned* p, unsigned v) { return __hip_atomic_fetch_add(p, v, __ATOMIC_RELAXED, __HIP_MEMORY_SCOPE_AGENT); }
__device__ __forceinline__ unsigned xb_xcc_id() { return (unsigned)__builtin_amdgcn_s_getreg((3 << 11) | 20) & 0xFu; }
#define XB_SPIN(cond, bar) do { unsigned _sp = 0; while (cond) { __builtin_amdgcn_s_sleep(1); \
    if ((++_sp & 255u) == 0u) { if (xb_ld(&(bar)[XB_TMO])) break; if (_sp > XB_SPIN_CAP) { atomicAdd(&(bar)[XB_TMO], 1u); break; } } } } while (0)
struct XcdBarrier { unsigned* bar; unsigned x; volatile LAS unsigned* st; };
__device__ __forceinline__ XcdBarrier xcd_barrier_post(unsigned* bar, volatile LAS unsigned* st) {
    XcdBarrier b; b.bar = bar; b.x = xb_xcc_id(); b.st = st;
    if (threadIdx.x == 0) (void)xb_add(&bar[XB_XCNT(b.x)], 1u);
    return b;
}
__device__ __forceinline__ void xcd_barrier_complete(unsigned* bar, unsigned x, unsigned& nloc, unsigned& nx) {
    const unsigned G = gridDim.x * gridDim.y * gridDim.z;
    unsigned sum, cnt, mine, sp = 0u;
    for (;;) {
        sum = 0u; cnt = 0u; mine = 0u;
#pragma unroll
        for (unsigned j = 0; j < 16; ++j) { const unsigned c = xb_ld(&bar[XB_XCNT(j)]); sum += c; cnt += (c > 0u) ? 1u : 0u; mine = (j == x) ? c : mine; }
        if (sum == G) break;
        __builtin_amdgcn_s_sleep(1);
        if ((++sp & 255u) == 0u) { if (xb_ld(&bar[XB_TMO])) break; if (sp > XB_SPIN_CAP) { atomicAdd(&bar[XB_TMO], 1u); break; } }
    }
    nloc = mine > 0u ? mine : 1u; nx = cnt > 0u ? cnt : 1u;
}
__device__ __forceinline__ void xcd_barrier(const XcdBarrier& b) {
    asm volatile("s_waitcnt vmcnt(0)" ::: "memory");
    __syncthreads();
    if (threadIdx.x == 0) {
        unsigned* bar = b.bar;
        __builtin_amdgcn_s_waitcnt(0);
        unsigned nloc = b.st[0], nx = b.st[1];
        if (nloc == 0u) { xcd_barrier_complete(bar, b.x, nloc, nx); b.st[0] = nloc; b.st[1] = nx; }
        const unsigned old = xb_add(&bar[XB_XSUB(b.x)], 1u);
        const unsigned gen = old / nloc;
        if (old + 1u == (gen + 1u) * nloc) {
            __builtin_amdgcn_fence(__ATOMIC_RELEASE, "agent");
            asm volatile("s_waitcnt vmcnt(0)" ::: "memory");
            const unsigned og = xb_add(&bar[XB_TOP], 1u);
            const unsigned tg = og / nx;
            if (og + 1u == (tg + 1u) * nx) xb_add(&bar[XB_TOPGEN], 1u);
            else XB_SPIN(xb_ld(&bar[XB_TOPGEN]) == tg, bar);
            __builtin_amdgcn_fence(__ATOMIC_ACQUIRE, "agent");
            xb_add(&bar[XB_XGEN(b.x)], 1u);
            asm volatile("s_waitcnt vmcnt(0)" ::: "memory");
        } else {
            XB_SPIN(xb_ld(&bar[XB_XGEN(b.x)]) == gen, bar);
            __builtin_amdgcn_fence(__ATOMIC_ACQUIRE, "agent");
            asm volatile("s_waitcnt vmcnt(0)" ::: "memory");
        }
    }
    __syncthreads();
}

__device__ __forceinline__ u16 f2bf(float f) { unsigned u = __float_as_uint(f); u += 0x7fffu + ((u >> 16) & 1u); return (u16)(u >> 16); }
__device__ __forceinline__ float bf2f(u16 h) { return __uint_as_float(((unsigned)h) << 16); }
__device__ __forceinline__ unsigned pack2(float a, float b) { return (unsigned)f2bf(a) | ((unsigned)f2bf(b) << 16); }
__device__ __forceinline__ float bflo(unsigned u) { return __uint_as_float(u << 16); }
__device__ __forceinline__ float bfhi(unsigned u) { return __uint_as_float(u & 0xffff0000u); }
__device__ __forceinline__ float siluf(float x) { return x / (1.f + __expf(-x)); }
__device__ __forceinline__ float sigmf(float x) { return 1.f / (1.f + __expf(-x)); }
__device__ __forceinline__ float softplusf(float x) { return x > 20.f ? x : log1pf(__expf(x)); }
__device__ __forceinline__ float wave_sum(float v) {
#pragma unroll
    for (int o = 32; o > 0; o >>= 1) v += __shfl_xor(v, o);
    return v;
}
__device__ __forceinline__ int swz256(int row, int chunk) { return row * 256 + ((chunk ^ (row & 15)) << 4); }
__device__ __forceinline__ int colmajor_src_row(int R) {
    if (R >= MLAT) return R;
    const int b = R >> 12, lp = R & 4095;
    return (b << 12) + ((lp & 63) << 6) + (lp >> 6);
}

__device__ __forceinline__ void load_tile128(char* lds, int lrow0, const u16* __restrict__ g, size_t ld, int rows, int t, int nthr) {
#pragma unroll 4
    for (int q = t; q < rows * 16; q += nthr) {
        const int r = q >> 4, c = q & 15;
        const uint4 v = *(const uint4*)(g + (size_t)r * ld + c * 8);
        *(uint4*)(lds + swz256(lrow0 + r, c)) = v;
    }
}
__device__ __forceinline__ void load_tile128_scaled(char* lds, int lrow0, const u16* __restrict__ g, size_t ld, int rows, const float* w, int t, int nthr) {
#pragma unroll 2
    for (int q = t; q < rows * 16; q += nthr) {
        const int r = q >> 4, c = q & 15;
        const uint4 v = *(const uint4*)(g + (size_t)r * ld + c * 8);
        const float* ww = w + c * 8;
        uint4 o;
        o.x = pack2(bflo(v.x) * ww[0], bfhi(v.x) * ww[1]);
        o.y = pack2(bflo(v.y) * ww[2], bfhi(v.y) * ww[3]);
        o.z = pack2(bflo(v.z) * ww[4], bfhi(v.z) * ww[5]);
        o.w = pack2(bflo(v.w) * ww[6], bfhi(v.w) * ww[7]);
        *(uint4*)(lds + swz256(lrow0 + r, c)) = o;
    }
}
template <int MI, int NJ>
__device__ __forceinline__ void lds_mma(const char* A, const char* B, int arow0, int brow0, f32x4 (&acc)[MI][NJ], int lane) {
#pragma unroll 1
    for (int kk = 0; kk < 4; ++kk) {
        const int chunk = kk * 4 + (lane >> 4);
        bf16x8 a[MI], b[NJ];
#pragma unroll
        for (int i = 0; i < MI; ++i) { const int row = arow0 + i * 16 + (lane & 15); a[i] = *(const bf16x8*)(A + swz256(row, chunk)); }
#pragma unroll
        for (int j = 0; j < NJ; ++j) { const int row = brow0 + j * 16 + (lane & 15); b[j] = *(const bf16x8*)(B + swz256(row, chunk)); }
#pragma unroll
        for (int i = 0; i < MI; ++i)
#pragma unroll
            for (int j = 0; j < NJ; ++j) acc[i][j] = __builtin_amdgcn_mfma_f32_16x16x32_bf16(a[i], b[j], acc[i][j], 0, 0, 0);
    }
}
template <int MI, int NJ>
__device__ __forceinline__ void lds_mma_t(const char* A, const char* B, int arow0, int brow0, f32x4 (&acc)[MI][NJ], int lane) {
#pragma unroll 1
    for (int kk = 0; kk < 4; ++kk) {
        const int chunk = kk * 4 + (lane >> 4);
        bf16x8 a[MI], b[NJ];
#pragma unroll
        for (int i = 0; i < MI; ++i) { const int row = arow0 + i * 16 + (lane & 15); a[i] = *(const bf16x8*)(A + swz256(row, chunk)); }
#pragma unroll
        for (int j = 0; j < NJ; ++j) { const int row = brow0 + j * 16 + (lane & 15); b[j] = *(const bf16x8*)(B + swz256(row, chunk)); }
#pragma unroll
        for (int i = 0; i < MI; ++i)
#pragma unroll
            for (int j = 0; j < NJ; ++j) acc[i][j] = __builtin_amdgcn_mfma_f32_16x16x32_bf16(b[j], a[i], acc[i][j], 0, 0, 0);
    }
}
template <int MI, int NJ>
__device__ __forceinline__ void zero_acc(f32x4 (&acc)[MI][NJ]) {
#pragma unroll
    for (int i = 0; i < MI; ++i)
#pragma unroll
        for (int j = 0; j < NJ; ++j) acc[i][j] = f32x4{0.f, 0.f, 0.f, 0.f};
}
template <int OP>
__device__ __forceinline__ float scan_pair(float v, float* buf, int t) {
    const int idx = t & 127, base = t & 128;
    const bool act = t < 256;
    if (act) buf[t] = v;
    __syncthreads();
#pragma unroll 1
    for (int off = 1; off < 128; off <<= 1) {
        float o = OP ? -INFINITY : 0.f;
        if (act && idx >= off) o = buf[base + idx - off];
        __syncthreads();
        v = OP ? fmaxf(v, o) : v + o;
        if (act) buf[t] = v;
        __syncthreads();
    }
    return v;
}

__device__ __forceinline__ float wave_scan_sum(float v, int lane) {
#pragma unroll
    for (int off = 1; off < 64; off <<= 1) { const float o = __shfl_up(v, off); if (lane >= off) v += o; }
    return v;
}
__device__ __forceinline__ float wave_scan_max(float v, int lane) {
#pragma unroll
    for (int off = 1; off < 64; off <<= 1) { const float o = __shfl_up(v, off); if (lane >= off) v = fmaxf(v, o); }
    return v;
}
__device__ __forceinline__ float wave_max(float v) {
#pragma unroll
    for (int o = 32; o > 0; o >>= 1) v = fmaxf(v, __shfl_xor(v, o));
    return v;
}
__device__ __forceinline__ void transpose_tile(float* tile, const float* __restrict__ src, int ld_src, int k0, int n0, int ncount,
                                               u16* dst, size_t dst_row0, int ld_dst, const float* __restrict__ scale, int scale_kmax, int t) {
    const int n = t & 63, kq = t >> 6;
    const int nc = n < ncount ? n : ncount - 1;
    float vv[16];
#pragma unroll
    for (int i = 0; i < 16; ++i) vv[i] = src[(size_t)(k0 + i * 4 + kq) * ld_src + n0 + nc];
#pragma unroll
    for (int i = 0; i < 16; ++i) {
        const int k = i * 4 + kq;
        float v = vv[i];
        if (scale && (k0 + k) < scale_kmax) v *= scale[k0 + k];
        tile[k * 65 + n] = n < ncount ? v : 0.f;
    }
    __syncthreads();
#pragma unroll
    for (int i = 0; i < 2; ++i) {
        const int q = t + 256 * i, nn = q >> 3, kc = q & 7;
        if (nn < ncount) {
            const float* p = tile + (kc * 8) * 65 + nn;
            uint4 o;
            o.x = pack2(p[0], p[65]); o.y = pack2(p[130], p[195]); o.z = pack2(p[260], p[325]); o.w = pack2(p[390], p[455]);
            *(uint4*)(dst + (dst_row0 + nn) * (size_t)ld_dst + k0 + kc * 8) = o;
        }
    }
    __syncthreads();
}

__device__ __forceinline__ void transpose_tile_w(float* tile, const float* __restrict__ src, int ld_src, int k0, int n0,
                                                 u16* dst, size_t dst_row0, int ld_dst, const float* __restrict__ scale, int scale_kmax, int t) {
    f32x4 v[8]; float scv[8];
#pragma unroll
    for (int i = 0; i < 8; ++i) {
        const int q = t + 256 * i, kr = q >> 5, nq = q & 31;
        v[i] = __builtin_nontemporal_load((const f32x4*)(src + (size_t)(k0 + kr) * ld_src + n0 + nq * 4));
        scv[i] = 1.f;
        if (scale) { const int kc = (k0 + kr) < scale_kmax ? (k0 + kr) : scale_kmax - 1; const float sv = scale[kc]; scv[i] = (k0 + kr) < scale_kmax ? sv : 1.f; }
    }
    __builtin_amdgcn_sched_barrier(0);
#pragma unroll
    for (int i = 0; i < 8; ++i) {
        const int q = t + 256 * i, kr = q >> 5, nq = q & 31;
        float* p = tile + kr * 129 + nq * 4;
        p[0] = v[i][0] * scv[i]; p[1] = v[i][1] * scv[i]; p[2] = v[i][2] * scv[i]; p[3] = v[i][3] * scv[i];
    }
    __syncthreads();
#pragma unroll
    for (int i = 0; i < 4; ++i) {
        const int q = t + 256 * i, nn = q >> 3, kc = q & 7;
        const float* p = tile + (kc * 8) * 129 + nn;
        uint4 o;
        o.x = pack2(p[0], p[129]); o.y = pack2(p[258], p[387]); o.z = pack2(p[516], p[645]); o.w = pack2(p[774], p[903]);
        *(uint4*)(dst + (dst_row0 + nn) * (size_t)ld_dst + k0 + kc * 8) = o;
    }
    __syncthreads();
}

namespace g8 {
constexpr int BM = 256, BK = 64, HALF = 128, HTB = HALF * BK * 2, STAGE_BYTES = 8 * HTB;
__device__ __forceinline__ int lds_byte(int r, int c) { const int st = (r >> 4) * 2 + (c >> 5), rr = r & 15, cc = c & 31, ob = rr * 64 + cc * 2; return st * 1024 + (ob ^ (((ob >> 9) & 1) << 5)); }
__device__ __forceinline__ void stage_rc(int b, int& R, int& C) { const int st = b / 1024, sb = b % 1024, swz = sb ^ (((sb >> 9) & 1) << 5); R = (st >> 1) * 16 + swz / 64; C = (st & 1) * 32 + (swz % 64) / 2; }
__device__ __forceinline__ int perm32(int rho) { const int n = rho >> 4, i = rho & 15; return 8 * (i >> 2) + 4 * n + (i & 3); }
__device__ __forceinline__ unsigned cvt_pk_bf16(float lo, float hi) { unsigned r; asm volatile("v_cvt_pk_bf16_f32 %0, %1, %2" : "=v"(r) : "v"(lo), "v"(hi)); return r; }
typedef f32x4 Acc[2][2][4][2];

template <class Prob>
__device__ __forceinline__ int gemm_phase(LAS unsigned char* lds, const Prob& S, int i0 = 0) {
    const int tid = threadIdx.x, wid = __builtin_amdgcn_readfirstlane(tid >> 6), lane = tid & 63, wr = wid >> 2, wc = wid & 3, fr = lane & 15, fq = lane >> 4;
    int nt = 0;
    const size_t kstep = (size_t)(BK * 2);
    const unsigned ldsw = (unsigned)wid * 1024u;
    const int aoff = lds_byte(wr * 64 + fr, fq * 8), boff = lds_byte(wc * 32 + fr, fq * 8);
#define G8_SA(b, h) (((b) * 2 + (h)) * HTB)
#define G8_SB(b, h) ((4 + (b) * 2 + (h)) * HTB)
#define G8_STAGE(bufoff, gbase, voff) do { _Pragma("unroll") for (int _i = 0; _i < 2; ++_i) \
        __builtin_amdgcn_global_load_lds((const unsigned*)((const char*)(gbase) + (voff)[_i]), (LAS unsigned*)(lds + (bufoff) + ldsw + _i * 8192), 16, 0, 0); } while (0)
#define G8_LDA(dst, b, h) do { _Pragma("unroll") for (int m = 0; m < 4; ++m) _Pragma("unroll") for (int k = 0; k < 2; ++k) dst[m][k] = *(const LAS bf16x8*)(lds + G8_SA(b, h) + aoff + m * 2048 + k * 1024); } while (0)
#define G8_LDB(dst, b, h) do { _Pragma("unroll") for (int n = 0; n < 2; ++n) _Pragma("unroll") for (int k = 0; k < 2; ++k) dst[n][k] = *(const LAS bf16x8*)(lds + G8_SB(b, h) + boff + n * 2048 + k * 1024); } while (0)
#define G8_MMA(ai, bj, At, Bt) do { __builtin_amdgcn_s_setprio(1); _Pragma("unroll") for (int m = 0; m < 4; ++m) _Pragma("unroll") for (int n = 0; n < 2; ++n) _Pragma("unroll") for (int k = 0; k < 2; ++k) \
        acc[ai][bj][m][n] = __builtin_amdgcn_mfma_f32_16x16x32_bf16(Bt[n][k], At[m][k], acc[ai][bj][m][n], 0, 0, 0); __builtin_amdgcn_s_setprio(0); } while (0)
#define G8_WAIT_V(n) asm volatile("s_waitcnt vmcnt(" #n ")" ::: "memory")
#define G8_WAIT_L(n) asm volatile("s_waitcnt lgkmcnt(" #n ")" ::: "memory")
#define G8_BAR __builtin_amdgcn_s_barrier()
#define G8_SCHED __builtin_amdgcn_sched_barrier(0)
    typename Prob::Unit cur, nxt; int ui = i0; bool stopped = false;
    if (!S.next(i0, cur)) return -1;
    nt = S.nt(cur);
    S.a_ready(cur);
    Acc acc;
#pragma unroll
    for (int a = 0; a < 2; ++a)
#pragma unroll
        for (int b = 0; b < 2; ++b)
#pragma unroll
            for (int m = 0; m < 4; ++m)
#pragma unroll
                for (int n = 0; n < 2; ++n) acc[a][b][m][n] = (f32x4){0.f, 0.f, 0.f, 0.f};
    bf16x8 At[4][2], B0[2][2], B1[2][2];
    unsigned cOA[2][2], cOB[2][2], nOA[2][2], nOB[2][2];
    S.offs(cur, tid, cOA, cOB);
    const char* cA = S.baseA(cur); const char* cB = S.baseB(cur);
    G8_STAGE(G8_SB(0, 0), cB, cOB[0]); G8_STAGE(G8_SA(0, 0), cA, cOA[0]); G8_STAGE(G8_SB(0, 1), cB, cOB[1]); G8_STAGE(G8_SA(0, 1), cA, cOA[1]);
    if (wr == 1) G8_BAR;
    G8_WAIT_V(4); G8_BAR;
    G8_STAGE(G8_SB(1, 0), cB + kstep, cOB[0]); G8_STAGE(G8_SA(1, 0), cA + kstep, cOA[0]); G8_STAGE(G8_SB(1, 1), cB + kstep, cOB[1]);
    G8_WAIT_V(6); G8_BAR;
    for (;;) {
        bool has_next = S.next(ui + 1, nxt);
        if (has_next && S.brk(cur, nxt)) { has_next = false; stopped = true; }
        const char* nA = cA; const char* nB = cB;
#pragma unroll
        for (int h = 0; h < 2; ++h)
#pragma unroll
            for (int i = 0; i < 2; ++i) { nOA[h][i] = cOA[h][i]; nOB[h][i] = cOB[h][i]; }
        if (has_next) { S.offs(nxt, tid, nOA, nOB); nA = S.baseA(nxt); nB = S.baseB(nxt); }
#pragma unroll 1
        for (int t = 0; t < nt; t += 2) {
            const bool last = (t == nt - 2);
            if (Prob::MIDT > 0 && t == Prob::MIDT) S.mid(acc, cur, wr, fr);
            if (last && has_next) S.a_ready(nxt);
            const char* a1 = cA + (size_t)(t + 1) * kstep;
            const char* a2 = last ? nA : cA + (size_t)(t + 2) * kstep; const char* b2 = last ? nB : cB + (size_t)(t + 2) * kstep;
            const char* a3 = a2 + kstep; const char* b3 = b2 + kstep;
            unsigned xA[2][2], xB[2][2];
#pragma unroll
            for (int h = 0; h < 2; ++h)
#pragma unroll
                for (int i = 0; i < 2; ++i) { xA[h][i] = last ? nOA[h][i] : cOA[h][i]; xB[h][i] = last ? nOB[h][i] : cOB[h][i]; }
            G8_LDB(B0, 0, 0); G8_SCHED; G8_LDA(At, 0, 0); G8_STAGE(G8_SA(1, 1), a1, cOA[1]);
            G8_WAIT_L(8); G8_BAR; G8_WAIT_L(0); G8_MMA(0, 0, At, B0); G8_BAR; G8_SCHED;
            G8_LDB(B1, 0, 1); G8_STAGE(G8_SB(0, 0), b2, xB[0]);
            G8_BAR; G8_WAIT_L(0); G8_MMA(0, 1, At, B1); G8_BAR;
            G8_LDA(At, 0, 1); G8_STAGE(G8_SA(0, 0), a2, xA[0]);
            G8_BAR; G8_WAIT_L(0); G8_MMA(1, 0, At, B0); G8_BAR; G8_SCHED;
            G8_STAGE(G8_SB(0, 1), b2, xB[1]);
            G8_WAIT_V(6); G8_BAR; G8_MMA(1, 1, At, B1); G8_BAR;
            G8_LDB(B0, 1, 0); G8_SCHED; G8_LDA(At, 1, 0); G8_STAGE(G8_SA(0, 1), a2, xA[1]);
            G8_WAIT_L(8); G8_BAR; G8_WAIT_L(0); G8_MMA(0, 0, At, B0); G8_BAR; G8_SCHED;
            G8_LDB(B1, 1, 1); G8_STAGE(G8_SB(1, 0), b3, xB[0]);
            G8_BAR; G8_WAIT_L(0); G8_MMA(0, 1, At, B1); G8_BAR;
            G8_LDA(At, 1, 1); G8_STAGE(G8_SA(1, 0), a3, xA[0]);
            G8_BAR; G8_WAIT_L(0); G8_MMA(1, 0, At, B0); G8_BAR; G8_SCHED;
            G8_STAGE(G8_SB(1, 1), b3, xB[1]);
            G8_WAIT_V(6); G8_BAR; G8_MMA(1, 1, At, B1); G8_BAR;
        }
        S.epi(acc, cur, wr, wc, fr, fq);
        S.done(cur);
        if (!has_next) break;
#pragma unroll
        for (int a = 0; a < 2; ++a)
#pragma unroll
            for (int b = 0; b < 2; ++b)
#pragma unroll
                for (int m = 0; m < 4; ++m)
#pragma unroll
                    for (int n = 0; n < 2; ++n) acc[a][b][m][n] = (f32x4){0.f, 0.f, 0.f, 0.f};
        cur = nxt; cA = nA; cB = nB; ++ui; nt = S.nt(cur);
#pragma unroll
        for (int h = 0; h < 2; ++h)
#pragma unroll
            for (int i = 0; i < 2; ++i) { cOA[h][i] = nOA[h][i]; cOB[h][i] = nOB[h][i]; }
    }
    G8_WAIT_V(0);
    if (wr == 0) G8_BAR;
    G8_BAR;
    const int ret_next = stopped ? ui + 1 : -1;
#undef G8_SA
#undef G8_SB
#undef G8_STAGE
#undef G8_LDA
#undef G8_LDB
#undef G8_MMA
#undef G8_WAIT_V
#undef G8_WAIT_L
#undef G8_BAR
#undef G8_SCHED
    return ret_next;
}
__device__ __forceinline__ void dense_unit(int wgid, int nM, int nN, int& pm, int& pn) {
    const int nwg = nM * nN, NXCD = 8, WGM = 8;
    { const int q = nwg / NXCD, r = nwg % NXCD, xcd = wgid % NXCD, off = wgid / NXCD; wgid = (xcd < r ? xcd * (q + 1) : r * (q + 1) + (xcd - r) * q) + off; }
    const int nig = WGM * nN, gid = wgid / nig, fm = gid * WGM, gsz = (nM - fm) < WGM ? (nM - fm) : WGM;
    pm = fm + ((wgid % nig) % gsz); pn = (wgid % nig) / gsz;
}
}

__device__ void phase0(const Params& P, char* lds_all) {
    unsigned char* ws = P.ws;
    const int vb = threadIdx.x >> 8, t = threadIdx.x & 255;
    char* lds = lds_all + vb * VLDS;
    float* tile = (float*)lds;
    const int NU = 744;
    for (int u = blockIdx.x * 2 + vb; u < NU; u += gridDim.x * 2) {
        if (u < 384) {
            int nt, v, n0b, drb;
            if (u < 192) { v = u; n0b = 0; drb = 0; }
            else if (u < 256) { v = u - 192; n0b = 1552; drb = 1536; }
            else if (u < 320) { v = u - 256; n0b = 2576; drb = 2048; }
            else { v = u - 320; n0b = 2064; drb = 2816; }
            nt = v >> 4;
            transpose_tile_w(tile, P.in[I_WIN], 3104, (v & 15) * 64, n0b + nt * 128, (u16*)(ws + O_WIN), drb + nt * 128, 1024, nullptr, 0, t);
        } else if (u < 416) {
            const int v = u - 384;
            if (v < 16) transpose_tile(tile, P.in[I_WIN], 3104, v * 64, 1536, 16, (u16*)(ws + O_WIN), 2560, 1024, nullptr, 0, t);
            else transpose_tile(tile, P.in[I_WIN], 3104, (v - 16) * 64, 3088, 16, (u16*)(ws + O_WIN), 2576, 1024, nullptr, 0, t);
        } else if (u < 544) {
            const int v = u - 416, nt = v >> 4;
            transpose_tile_w(tile, P.in[I_WOUT], 1024, (v & 15) * 64, nt * 128, (u16*)(ws + O_WOUT), nt * 128, 1024, P.in[I_SNW], 512, t);
        } else if (u < 552) {
            const int base = (u - 544) * 4096;
            for (int i = 0; i < 16; ++i) {
                const int idx = base + t + 256 * i;
                if (idx < 224 * 128) *(uint4*)(ws + O_WIN + ((size_t)(2592 + (idx >> 7)) * 1024 + (idx & 127) * 8) * 2) = make_uint4(0, 0, 0, 0);
            }
        } else {
            const int c0 = (u - 552) * 32;
            float* sc = (float*)lds;
            float* red = sc + 5 * 1024;
            {
                float cv[20];
#pragma unroll
                for (int q = 0; q < 20; ++q) cv[q] = q < 16 ? P.in[I_C][t + 256 * q] : P.in[I_CCTX][t + 256 * (q - 16)];
                __builtin_amdgcn_sched_barrier(0);
#pragma unroll
                for (int q = 0; q < 20; ++q) sc[t + 256 * q] = siluf(cv[q]);
            }
            __syncthreads();
            const int cq = t & 7, kg = t >> 3;
            float4 a0 = {0, 0, 0, 0}, a1 = a0, a2 = a0, a3 = a0, a4 = a0;
            const float* wp = P.in[I_WMOD] + (size_t)(kg * 32) * 6144 + c0 + cq * 4;
#pragma unroll 1
            for (int kb = 0; kb < 32; kb += 16) {
                f32x4 wvv[16];
#pragma unroll
                for (int k = 0; k < 16; ++k) wvv[k] = __builtin_nontemporal_load((const f32x4*)(wp + (size_t)(kb + k) * 6144));
                __builtin_amdgcn_sched_barrier(0);
#pragma unroll
                for (int k = 0; k < 16; ++k) {
                    if ((k & 3) == 0) __builtin_amdgcn_sched_barrier(0);
                    const f32x4 wv = wvv[k];
                    const int kk = kg * 32 + kb + k;
                    const float s0 = sc[kk], s1 = sc[1024 + kk], s2 = sc[2048 + kk], s3 = sc[3072 + kk], s4 = sc[4096 + kk];
                    a0.x += s0 * wv[0]; a0.y += s0 * wv[1]; a0.z += s0 * wv[2]; a0.w += s0 * wv[3];
                    a1.x += s1 * wv[0]; a1.y += s1 * wv[1]; a1.z += s1 * wv[2]; a1.w += s1 * wv[3];
                    a2.x += s2 * wv[0]; a2.y += s2 * wv[1]; a2.z += s2 * wv[2]; a2.w += s2 * wv[3];
                    a3.x += s3 * wv[0]; a3.y += s3 * wv[1]; a3.z += s3 * wv[2]; a3.w += s3 * wv[3];
                    a4.x += s4 * wv[0]; a4.y += s4 * wv[1]; a4.z += s4 * wv[2]; a4.w += s4 * wv[3];
                }
                __builtin_amdgcn_sched_barrier(0);
            }
            *(float4*)(red + ((kg * 5 + 0) * 32) + cq * 4) = a0; *(float4*)(red + ((kg * 5 + 1) * 32) + cq * 4) = a1;
            *(float4*)(red + ((kg * 5 + 2) * 32) + cq * 4) = a2; *(float4*)(red + ((kg * 5 + 3) * 32) + cq * 4) = a3;
            *(float4*)(red + ((kg * 5 + 4) * 32) + cq * 4) = a4;
            __syncthreads();
            if (t < 160) {
                const int r = t >> 5, cc = t & 31;
                float s = P.in[I_BMOD][c0 + cc];
#pragma unroll
                for (int g = 0; g < 32; ++g) s += red[(g * 5 + r) * 32 + cc];
                ((float*)(ws + O_MOD))[r * 6144 + c0 + cc] = s;
            }
            __syncthreads();
        }
    }
    if (blockIdx.x == 0 && threadIdx.x < 32) ((int*)(ws + O_CNT))[threadIdx.x * 64] = 0;
}

__device__ void phase1(const Params& P) {
    unsigned char* ws = P.ws;
    const int lane = threadIdx.x & 63;
    const int gw = blockIdx.x * 8 + (threadIdx.x >> 6), nw = gridDim.x * 8;
    const float* mod = (const float*)(ws + O_MOD);
    u16* xn = (u16*)(ws + O_XN);
    const int r_lo = (int)(((long long)gw * MALL) / nw), r_hi = (int)(((long long)(gw + 1) * MALL) / nw);
    float4 mul[4], sh[4];
    int cur_mb = -1;
    for (int row = r_lo; row < r_hi; row += 2) {
        const bool two = row + 1 < r_hi;
        const int row1 = two ? row + 1 : row;
        const float* x0 = row < MLAT ? P.in[I_X] + (size_t)row * 1024 : P.in[I_CTX] + (size_t)(row - MLAT) * 1024;
        const float* x1 = row1 < MLAT ? P.in[I_X] + (size_t)row1 * 1024 : P.in[I_CTX] + (size_t)(row1 - MLAT) * 1024;
        float4 v0[4], v1[4];
#pragma unroll
        for (int j = 0; j < 4; ++j) { const f32x4 a = __builtin_nontemporal_load((const f32x4*)x0 + lane + 64 * j), c = __builtin_nontemporal_load((const f32x4*)x1 + lane + 64 * j);
            v0[j] = make_float4(a[0], a[1], a[2], a[3]); v1[j] = make_float4(c[0], c[1], c[2], c[3]); }
        const int mb0 = row < MLAT ? (row >> 12) : 4, mb1 = row1 < MLAT ? (row1 >> 12) : 4;
        float s0 = 0.f, s1 = 0.f;
#pragma unroll
        for (int j = 0; j < 4; ++j) {
            s0 += v0[j].x * v0[j].x + v0[j].y * v0[j].y + v0[j].z * v0[j].z + v0[j].w * v0[j].w;
            s1 += v1[j].x * v1[j].x + v1[j].y * v1[j].y + v1[j].z * v1[j].z + v1[j].w * v1[j].w;
        }
        s0 = rsqrtf(wave_sum(s0) * (1.f / 1024.f) + 1e-6f);
        s1 = rsqrtf(wave_sum(s1) * (1.f / 1024.f) + 1e-6f);
#pragma unroll 1
        for (int rr = 0; rr < 2; ++rr) {
            const int mb = rr ? mb1 : mb0;
            if (mb != cur_mb) {
                cur_mb = mb;
#pragma unroll
                for (int j = 0; j < 4; ++j) {
                    const int k = (lane + 64 * j) * 4;
                    const float4 nwv = *(const float4*)(P.in[I_N1W] + k);
                    const float4 sc = *(const float4*)(mod + mb * 6144 + 1024 + k);
                    sh[j] = *(const float4*)(mod + mb * 6144 + k);
                    mul[j].x = nwv.x * (1.f + sc.x); mul[j].y = nwv.y * (1.f + sc.y); mul[j].z = nwv.z * (1.f + sc.z); mul[j].w = nwv.w * (1.f + sc.w);
                }
            }
            if (rr == 1 && !two) break;
            const float rstd = rr ? s1 : s0;
            const int orow = rr ? row1 : row;
#pragma unroll
            for (int j = 0; j < 4; ++j) {
                const int k = (lane + 64 * j) * 4;
                const float4 vv = rr ? v1[j] : v0[j];
                uint2 o;
                o.x = pack2(vv.x * rstd * mul[j].x + sh[j].x, vv.y * rstd * mul[j].y + sh[j].y);
                o.y = pack2(vv.z * rstd * mul[j].z + sh[j].z, vv.w * rstd * mul[j].w + sh[j].w);
                *(uint2*)(xn + (size_t)orow * 1024 + k) = o;
            }
        }
    }
}

struct InProj {
    static constexpr int K = 1024; static constexpr bool PERM = true; static constexpr int MIDT = 0;
    struct Unit { int pm, pn, vt; };
    const unsigned char* ws; int G, c;
    __device__ __forceinline__ bool next(int i, Unit& u) const {
        const int L = i * G + c;
        if (L >= 884) return false;
        if (L < 748) { u.vt = 0; g8::dense_unit(L, 68, 11, u.pm, u.pn); }
        else { const int v = L - 748; u.vt = 1; u.pm = v / 68; u.pn = v % 68; }
        return true;
    }
    __device__ __forceinline__ const char* baseA(const Unit& u) const { return (const char*)(ws + (u.vt ? O_WIN : O_XN)); }
    __device__ __forceinline__ const char* baseB(const Unit& u) const { return (const char*)(ws + (u.vt ? O_XN : O_WIN)); }
    __device__ __forceinline__ void offs(const Unit& u, int tid_, unsigned (&oa)[2][2], unsigned (&ob)[2][2]) const {
        int R[2], C[2];
        { int tq = tid_; asm volatile("" : "+v"(tq)); g8::stage_rc(tq * 16, R[0], C[0]); g8::stage_rc(tq * 16 + 8192, R[1], C[1]); }
#pragma unroll
        for (int h = 0; h < 2; ++h)
#pragma unroll
            for (int i = 0; i < 2; ++i) {
                const int Rb = (R[i] & ~31) + g8::perm32(R[i] & 31);
                if (!u.vt) {
                    int ar = u.pm * 256 + h * 128 + R[i];
                    if (u.pn == 6 || u.pn == 7) ar = colmajor_src_row(ar);
                    oa[h][i] = (unsigned)(ar * 1024 + C[i]) * 2u;
                    ob[h][i] = (unsigned)((u.pn * 256 + h * 128 + Rb) * 1024 + C[i]) * 2u;
                } else {
                    oa[h][i] = (unsigned)((2816 + u.pm * 256 + h * 128 + R[i]) * 1024 + C[i]) * 2u;
                    ob[h][i] = (unsigned)(colmajor_src_row(u.pn * 256 + h * 128 + Rb) * 1024 + C[i]) * 2u;
                }
            }
    }
    __device__ __forceinline__ void mid(g8::Acc&, const Unit&, int, int) const {}
    __device__ __forceinline__ int nt(const Unit&) const { return 16; }
    __device__ __forceinline__ bool brk(const Unit&, const Unit&) const { return false; }
    __device__ __forceinline__ void a_ready(const Unit&) const {}
    __device__ __forceinline__ void done(const Unit&) const {}
    __device__ __forceinline__ void epi(g8::Acc& acc, const Unit& u, int wr, int wc, int fr, int fq) const {
        unsigned char* w = (unsigned char*)ws;
        const int row0 = u.pm * 256 + wr * 64 + fr;
        const int col0 = wc * 32 + 8 * fq;
        if (u.vt) {
            const int tok0 = u.pn * 256 + col0;
#pragma unroll
            for (int ai = 0; ai < 2; ++ai)
#pragma unroll
                for (int m = 0; m < 4; ++m) {
                    const int ch = row0 + ai * 128 + m * 16;
#pragma unroll
                    for (int bj = 0; bj < 2; ++bj) {
                        const int tk = tok0 + bj * 128;
                        u16* d;
                        int ctile, lw;
                        if (tk < MLAT) { ctile = (tk >> 12) * NCH + 2 + ((tk & 4095) >> 7); lw = tk & 127; }
                        else { const int tc = tk - MLAT; ctile = (tc >> 8) * NCH + ((tc & 255) >> 7); lw = tc & 127; }
                        d = (u16*)(w + O_VT) + ((size_t)ctile * 512 + ch) * 128 + lw;
                        const f32x4 v0 = acc[ai][bj][m][0], v1 = acc[ai][bj][m][1];
                        u32x4 o; o.x = g8::cvt_pk_bf16(v0[0], v0[1]); o.y = g8::cvt_pk_bf16(v0[2], v0[3]); o.z = g8::cvt_pk_bf16(v1[0], v1[1]); o.w = g8::cvt_pk_bf16(v1[2], v1[3]);
                        *(u32x4*)d = o;
                    }
                }
            return;
        }
        if (u.pn == 10) {
            if (wc == 0) {
                float* dst = (float*)(w + (fq < 2 ? O_PSD : O_PSG)) + (fq & 1) * 8;
#pragma unroll
                for (int ai = 0; ai < 2; ++ai)
#pragma unroll
                    for (int m = 0; m < 4; ++m) {
                        float* d = dst + (size_t)(row0 + ai * 128 + m * 16) * 16;
                        *(f32x4*)d = acc[ai][0][m][0];
                        *(f32x4*)(d + 4) = acc[ai][0][m][1];
                    }
            }
            return;
        }
        u16* base; size_t ld, bjstep;
        if (u.pn < 2) { base = (u16*)(w + O_ZO) + u.pn * 256 + col0; ld = 1024; bjstep = 128; }
        else if (u.pn < 8) {
            const int cg0 = (u.pn - 2) * 4 + (col0 >> 6);
            base = (u16*)(w + O_PT) + (size_t)cg0 * MALL * 64 + (col0 & 63); ld = 64; bjstep = (size_t)2 * MALL * 64;
        }
        else { base = (u16*)(w + O_ZO) + 512 + (u.pn - 8) * 256 + col0; ld = 1024; bjstep = 128; }
#pragma unroll
        for (int ai = 0; ai < 2; ++ai)
#pragma unroll
            for (int m = 0; m < 4; ++m) {
                u16* rowp = base + (size_t)(row0 + ai * 128 + m * 16) * ld;
#pragma unroll
                for (int bj = 0; bj < 2; ++bj) {
                    const f32x4 v0 = acc[ai][bj][m][0], v1 = acc[ai][bj][m][1];
                    u32x4 o; o.x = g8::cvt_pk_bf16(v0[0], v0[1]); o.y = g8::cvt_pk_bf16(v0[2], v0[3]); o.z = g8::cvt_pk_bf16(v1[0], v1[1]); o.w = g8::cvt_pk_bf16(v1[2], v1[3]);
                    *(u32x4*)(rowp + bj * bjstep) = o;
                }
            }
    }
};

__device__ void phase3(const Params& P, char* lds_all) {
    unsigned char* ws = P.ws;
    const int vb = threadIdx.x >> 8, t = threadIdx.x & 255;
    char* lds = lds_all + vb * VLDS;
    u16* raw = (u16*)lds;
    float* xcl = (float*)(lds + 132 * 128);
    const u16* pt = (const u16*)(ws + O_PT);
    const int NCONV = 136 * 24;
    for (int ct = blockIdx.x * 2 + vb; ct < 136; ct += gridDim.x * 2) {
        const int b = ct / NCH, cc = ct % NCH;
        const int rb = cc < 2 ? MLAT + b * 256 + cc * 128 : b * 4096 + (cc - 2) * 128;
        const int row = rb + (t >> 1), half = t & 1;
        const float* psd = (const float*)(ws + O_PSD) + (size_t)row * 16 + half * 8;
        float* dt = (float*)(ws + O_DT) + (size_t)row * 16 + half * 8;
        const float4 pa = *(const float4*)psd, pb = *(const float4*)(psd + 4);
        const float* psg = (const float*)(ws + O_PSG) + (size_t)colmajor_src_row(row) * 16 + half * 8;
        const float4 ga = *(const float4*)psg, gb = *(const float4*)(psg + 4);
        const float pv[8] = {pa.x, pa.y, pa.z, pa.w, pb.x, pb.y, pb.z, pb.w}, gv[8] = {ga.x, ga.y, ga.z, ga.w, gb.x, gb.y, gb.z, gb.w};
        const float4 db0 = *(const float4*)(P.in[I_DTB] + half * 8), db1 = *(const float4*)(P.in[I_DTB] + half * 8 + 4);
        const float4 gb0 = *(const float4*)(P.in[I_GB] + half * 8), gb1 = *(const float4*)(P.in[I_GB] + half * 8 + 4);
        const float dbv[8] = {db0.x, db0.y, db0.z, db0.w, db1.x, db1.y, db1.z, db1.w}, gbv[8] = {gb0.x, gb0.y, gb0.z, gb0.w, gb1.x, gb1.y, gb1.z, gb1.w};
        float od[8], og[8];
#pragma unroll
        for (int j = 0; j < 8; ++j) {
            od[j] = softplusf(pv[j] + dbv[j]);
            const float xx = gv[j] + gbv[j];
            og[j] = half == 0 ? xx : fminf(xx, 0.f) - log1pf(__expf(-fabsf(xx)));
        }
        *(float4*)dt = make_float4(od[0], od[1], od[2], od[3]); *(float4*)(dt + 4) = make_float4(od[4], od[5], od[6], od[7]);
        float* gout = (float*)(ws + (half == 0 ? O_GI : O_GF)) + (size_t)row * 8;
        *(float4*)gout = make_float4(og[0], og[1], og[2], og[3]); *(float4*)(gout + 4) = make_float4(og[4], og[5], og[6], og[7]);
    }
    u32x4 rr[5];
#define P3_PREFETCH(uu) do { \
        const int _u = (uu), _ct = _u / 24, _cg = _u % 24, _b = _ct / NCH, _cc = _ct % NCH; const bool _ctx = _cc < 2; \
        const int _L = _ctx ? 256 : 4096, _lpos = _ctx ? _cc * 128 : (_cc - 2) * 128, _rb = _ctx ? MLAT + _b * 256 + _cc * 128 : _b * 4096 + (_cc - 2) * 128, _sb = _rb - _lpos; \
        _Pragma("unroll") for (int _i = 0; _i < 5; ++_i) { const int _q = t + 256 * _i, _r = (_q >> 3) < 132 ? (_q >> 3) : 131, _c = _q & 7; \
            const int _l = _lpos - 2 + _r, _lc = _l < 0 ? 0 : (_l >= _L ? _L - 1 : _l); \
            u32x4 _v = __builtin_nontemporal_load((const u32x4*)(pt + ((size_t)_cg * MALL + _sb + _lc) * 64 + _c * 8)); \
            if (_l != _lc) _v = (u32x4){0u, 0u, 0u, 0u}; \
            rr[_i] = _v; } \
    } while (0)
    if ((int)(blockIdx.x * 2 + vb) < NCONV) P3_PREFETCH(blockIdx.x * 2 + vb);
    for (int u = blockIdx.x * 2 + vb; u < NCONV; u += gridDim.x * 2) {
        const int ct = u / 24, cgp = u % 24;
        const int b = ct / NCH, cc = ct % NCH;
        const bool isctx = cc < 2;
        const int rb = isctx ? MLAT + b * 256 + cc * 128 : b * 4096 + (cc - 2) * 128;
        const bool isml = cgp >= 16;
#pragma unroll
        for (int i = 0; i < 5; ++i) { const int q = t + 256 * i; if (q < 132 * 8) *(u32x4*)(raw + (q >> 3) * 64 + (q & 7) * 8) = rr[i]; }
        __syncthreads();
        if (u + (int)gridDim.x * 2 < NCONV) P3_PREFETCH(u + gridDim.x * 2);
        const int ch = t & 63, tg = t >> 6;
        const float* cw = isml ? P.in[I_MCW] + (cgp - 16) * 64 + ch : P.in[I_SCW] + cgp * 64 + ch;
        const int cwld = isml ? 512 : 1024;
        const float w0 = cw[0], w1 = cw[cwld], w2 = cw[2 * cwld], w3 = cw[3 * cwld], w4 = cw[4 * cwld];
        const float bias = isml ? P.in[I_MCB][(cgp - 16) * 64 + ch] : P.in[I_SCB][cgp * 64 + ch];
        const int tok0 = tg * 32;
        float x0 = bf2f(raw[(tok0 + 0) * 64 + ch]), x1 = bf2f(raw[(tok0 + 1) * 64 + ch]), x2 = bf2f(raw[(tok0 + 2) * 64 + ch]), x3 = bf2f(raw[(tok0 + 3) * 64 + ch]);
        if (!isml) {
            float ov[32];
#pragma unroll
            for (int j = 0; j < 32; ++j) {
                const float x4 = bf2f(raw[(tok0 + j + 4) * 64 + ch]);
                const float cv = bias + w0 * x0 + w1 * x1 + w2 * x2 + w3 * x3 + w4 * x4;
                ov[j] = siluf(cv);
                x0 = x1; x1 = x2; x2 = x3; x3 = x4;
            }
            if (cgp < 12) {
                const int chg = cgp < 8 ? cgp * 64 + ch : (cgp - 8) * 64 + ch;
                u16* tdst = cgp < 8 ? (u16*)(ws + O_XT) + ((size_t)ct * 512 + chg) * 128 + tok0 : (u16*)(ws + O_BT) + ((size_t)ct * 256 + chg) * 128 + tok0;
#pragma unroll
                for (int o8 = 0; o8 < 4; ++o8) {
                    u32x4 o; o.x = pack2(ov[o8 * 8 + 0], ov[o8 * 8 + 1]); o.y = pack2(ov[o8 * 8 + 2], ov[o8 * 8 + 3]); o.z = pack2(ov[o8 * 8 + 4], ov[o8 * 8 + 5]); o.w = pack2(ov[o8 * 8 + 6], ov[o8 * 8 + 7]);
                    *(u32x4*)(tdst + o8 * 8) = o;
                }
            }
            if (cgp >= 8) {
                const int gn = (cgp < 12 ? cgp - 8 : cgp - 12) * 64 + ch;
                u16* ndst = (u16*)(ws + (cgp < 12 ? O_BM : O_CM)) + ((size_t)ct * 2 + (gn >> 7)) * 16384 + (size_t)tok0 * 128 + (gn & 127);
#pragma unroll
                for (int j = 0; j < 32; ++j) ndst[(size_t)j * 128] = f2bf(ov[j]);
            }
            __syncthreads();
        } else {
            const int mg = cgp - 16;
            const int n = ch >> 2, kk = ch & 3, ng = mg * 16 + n;
            const float* wq = P.in[I_WQK] + ((size_t)(0 * 128 + ng) * 4) * 4 + kk;
            const float* wk = P.in[I_WQK] + ((size_t)(1 * 128 + ng) * 4) * 4 + kk;
            const float q0 = wq[0], q1 = wq[4], q2 = wq[8], q3 = wq[12];
            const float k0 = wk[0], k1 = wk[4], k2 = wk[8], k3 = wk[12];
            u16* xcd = (u16*)(ws + O_XC) + ((size_t)ct * 4 + (mg >> 1)) * 16384 + (size_t)tok0 * 128 + (mg & 1) * 64 + ch;
#pragma unroll 8
            for (int j = 0; j < 32; ++j) {
                const int tok = tok0 + j;
                const float x4 = bf2f(raw[(tok + 4) * 64 + ch]);
                const float cv = bias + w0 * x0 + w1 * x1 + w2 * x2 + w3 * x3 + w4 * x4;
                const float sv = siluf(cv);
                xcl[tok * 64 + ch] = sv;
                xcd[(size_t)j * 128] = f2bf(sv);
                x0 = x1; x1 = x2; x2 = x3; x3 = x4;
            }
            __syncthreads();
            const int chg = mg * 64 + ch;
            const size_t hoff = ((size_t)ct * 4 + (mg >> 1)) * 16384 + (size_t)tok0 * 128 + (mg & 1) * 64 + ch;
            u16* qd = (u16*)(ws + O_Q) + hoff;
            u16* kd = (u16*)(ws + O_K) + hoff;
            u16* ktd = (u16*)(ws + O_KT) + ((size_t)ct * 512 + chg) * 128 + tok0;
#pragma unroll
            for (int o8 = 0; o8 < 4; ++o8) {
                float kv[8];
#pragma unroll
                for (int j = 0; j < 8; ++j) {
                    const int tok = tok0 + o8 * 8 + j;
                    const float4 xv = *(const float4*)(xcl + tok * 64 + n * 4);
                    const float qv = xv.x * q0 + xv.y * q1 + xv.z * q2 + xv.w * q3;
                    kv[j] = (xv.x * k0 + xv.y * k1 + xv.z * k2 + xv.w * k3) * 0.08838834764831845f;
                    qd[(size_t)(o8 * 8 + j) * 128] = f2bf(qv);
                    kd[(size_t)(o8 * 8 + j) * 128] = f2bf(kv[j]);
                }
                uint4 o; o.x = pack2(kv[0], kv[1]); o.y = pack2(kv[2], kv[3]); o.z = pack2(kv[4], kv[5]); o.w = pack2(kv[6], kv[7]);
                *(uint4*)(ktd + o8 * 8) = o;
            }
            __syncthreads();
        }
    }
}

__device__ __forceinline__ u32x4 scale8(const u32x4 v, const float* ww) {
    u32x4 o;
    o.x = pack2(bflo(v.x) * ww[0], bfhi(v.x) * ww[1]); o.y = pack2(bflo(v.y) * ww[2], bfhi(v.y) * ww[3]);
    o.z = pack2(bflo(v.z) * ww[4], bfhi(v.z) * ww[5]); o.w = pack2(bflo(v.w) * ww[6], bfhi(v.w) * ww[7]);
    return o;
}
__device__ void phase4(const Params& P, char* lds) {
    unsigned char* ws = P.ws;
    char* T0 = lds; char* T1 = lds + 32768;
    float* sc = (float*)(lds + 65536);
    float* wA = sc + 256;
    float* wB = sc + 384;
    const int NSSD = 4 * NCH * 8, NML = 4 * NCH * 4, NU4 = NSSD + NML;
    u32x4 RA[4], RB[4];
    float ps0 = 0.f, ps1 = 0.f, ps2 = 0.f, ps3 = 0.f;
#define P4_PREFETCH(uu) do { \
        const int _u = (uu); const bool _ssd = _u < NSSD; const int _v = _ssd ? _u : _u - NSSD; \
        const int _h = _ssd ? (_v & 7) : (_v & 3), _ct = _ssd ? (_v >> 3) : (_v >> 2), _b = _ct / NCH, _cc = _ct % NCH; \
        const int _rb = _cc < 2 ? MLAT + _b * 256 + _cc * 128 : _b * 4096 + (_cc - 2) * 128; \
        const u16* _pa = _ssd ? (const u16*)(ws + O_XT) + ((size_t)_ct * 512 + _h * 64) * 128 : (const u16*)(ws + O_VT) + ((size_t)_ct * 512 + _h * 128) * 128; \
        const u16* _pb = _ssd ? (const u16*)(ws + O_BT) + ((size_t)_ct * 256 + (_h >> 2) * 128) * 128 : (const u16*)(ws + O_KT) + ((size_t)_ct * 512 + _h * 128) * 128; \
        _Pragma("unroll") for (int _i = 0; _i < 4; ++_i) { const int _q = (int)threadIdx.x + 512 * _i; const size_t _o = (size_t)(_q >> 4) * 128 + (_q & 15) * 8; \
            RA[_i] = *(const u32x4*)(_pa + _o); RB[_i] = *(const u32x4*)(_pb + _o); } \
        if (threadIdx.x < 128) { const int _dir = threadIdx.x >> 6, _ln = threadIdx.x & 63; const int _l0 = _dir ? 127 - 2 * _ln : 2 * _ln, _l1 = _dir ? 126 - 2 * _ln : 2 * _ln + 1; \
            if (_ssd) { const float* _dp = (const float*)(ws + O_DT) + (size_t)_rb * 16 + _dir * 8 + _h; ps0 = _dp[_l0 * 16]; ps1 = _dp[_l1 * 16]; } \
            else { const float* _gf = (const float*)(ws + O_GF) + (size_t)_rb * 8 + _dir * 4 + _h; const float* _gi = (const float*)(ws + O_GI) + (size_t)_rb * 8 + _dir * 4 + _h; \
                   ps0 = _gf[_l0 * 8]; ps1 = _gf[_l1 * 8]; ps2 = _gi[_l0 * 8]; ps3 = _gi[_l1 * 8]; } } \
    } while (0)
    if ((int)blockIdx.x < NU4) P4_PREFETCH(blockIdx.x);
    for (int u = blockIdx.x; u < NU4; u += gridDim.x) {
        int t = threadIdx.x; asm volatile("" : "+v"(t));
        const int lane = t & 63, w = t >> 6, wm = w >> 1, wn = w & 1, lr = lane & 15, lq = lane >> 4;
        const bool isssd = u < NSSD;
        const int v = isssd ? u : u - NSSD;
        const int h = isssd ? (v & 7) : (v & 3), ct = isssd ? (v >> 3) : (v >> 2), b = ct / NCH, cc = ct % NCH;
        const int un = u + (int)gridDim.x;
        if (isssd) {
            if (w < 2) {
                const int dir = w;
                const int l0 = dir ? 127 - 2 * lane : 2 * lane, l1 = dir ? 126 - 2 * lane : 2 * lane + 1;
                const float d0 = ps0, d1 = ps1;
                const float an = -__expf(P.in[I_ALOG][dir * 8 + h]);
                const float p0 = d0 * an, p1 = p0 + d1 * an;
                const float inc = wave_scan_sum(p1, lane);
                const float ex = inc - p1;
                const float tot = __shfl(inc, 63);
                float* wd = dir ? wB : wA;
                wd[l0] = __expf(tot - (ex + p0)) * d0; wd[l1] = __expf(tot - (ex + p1)) * d1;
                if (lane == 0) ((float*)(ws + O_ACH))[((size_t)(b * NCH + cc) * 8 + h) * 2 + dir] = tot;
            }
            __syncthreads();
#pragma unroll
            for (int i = 0; i < 2; ++i) {
                const int q = t + 512 * i, r = q >> 4, c = q & 15;
                *(u32x4*)(T0 + swz256(r, c)) = scale8(RA[i], wA + c * 8); *(u32x4*)(T0 + swz256(64 + r, c)) = scale8(RA[i], wB + c * 8);
            }
#pragma unroll
            for (int i = 0; i < 4; ++i) { const int q = t + 512 * i, r = q >> 4, c = q & 15; *(u32x4*)(T1 + swz256(r, c)) = RB[i]; }
            __syncthreads();
            if (un < NU4) P4_PREFETCH(un);
            f32x4 acc[2][4]; zero_acc(acc);
            lds_mma_t<2, 4>(T0, T1, wm * 32, wn * 64, acc, lane);
            u16* st = (u16*)(ws + O_ST) + (((size_t)(b * NCH + cc) * 8 + h) * 2 + (wm >> 1)) * 8192 + ((wm & 1) * 32 + lr) * 128 + wn * 64 + lq * 4;
#pragma unroll
            for (int i = 0; i < 2; ++i)
#pragma unroll
                for (int j = 0; j < 4; ++j) {
                    uint2 o; o.x = pack2(acc[i][j][0], acc[i][j][1]); o.y = pack2(acc[i][j][2], acc[i][j][3]);
                    *(uint2*)(st + (i * 16) * 128 + j * 16) = o;
                }
            __syncthreads();
        } else {
            if (w < 2) {
                const int dir = w;
                const int s0 = dir ? 127 - 2 * lane : 2 * lane, s1 = dir ? 126 - 2 * lane : 2 * lane + 1;
                const float f0 = ps0, f1 = ps1, i0 = ps2, i1 = ps3;
                const float p1 = f0 + f1;
                const float inc = wave_scan_sum(p1, lane);
                const float ex = inc - p1;
                const float tot = __shfl(inc, 63);
                const float av0 = tot - (ex + f0) + i0, av1 = tot - (ex + p1) + i1;
                const float mloc = wave_max(fmaxf(av0, av1));
                float* wd = dir ? wB : wA;
                wd[s0] = __expf(av0 - mloc); wd[s1] = __expf(av1 - mloc);
                if (lane == 0) {
                    float* mls = (float*)(ws + O_MLS) + (((size_t)(b * NCH + cc) * 4 + h) * 2 + dir) * 2;
                    mls[0] = mloc; mls[1] = tot;
                }
            }
            __syncthreads();
#pragma unroll
            for (int d2 = 0; d2 < 2; ++d2) {
                const float* wsel = d2 ? wB : wA;
#pragma unroll
                for (int i = 0; i < 4; ++i) { const int q = t + 512 * i, r = q >> 4, c = q & 15; *(u32x4*)(T0 + swz256(r, c)) = scale8(RA[i], wsel + c * 8); }
                if (d2 == 0) {
#pragma unroll
                    for (int i = 0; i < 4; ++i) { const int q = t + 512 * i, r = q >> 4, c = q & 15; *(u32x4*)(T1 + swz256(r, c)) = RB[i]; }
                }
                __syncthreads();
                if (d2 == 1 && un < NU4) P4_PREFETCH(un);
                f32x4 acc[2][4]; zero_acc(acc);
                lds_mma_t<2, 4>(T0, T1, wm * 32, wn * 64, acc, lane);
                u16* cst = (u16*)(ws + (d2 ? O_MLC1 : O_MLC0)) + ((size_t)(b * NCH + cc) * 4 + h) * 16384 + (wm * 32 + lr) * 128 + wn * 64 + lq * 4;
#pragma unroll
                for (int i = 0; i < 2; ++i)
#pragma unroll
                    for (int j = 0; j < 4; ++j) {
                        uint2 o; o.x = pack2(acc[i][j][0], acc[i][j][1]); o.y = pack2(acc[i][j][2], acc[i][j][3]);
                        *(uint2*)(cst + (i * 16) * 128 + j * 16) = o;
                    }
                if (d2 == 0 && t < 256) {
                    const int dir = t >> 7, idx = t & 127;
                    const float* wgt = dir ? wB : wA;
                    float nacc = 0.f;
#pragma unroll 4
                    for (int c = 0; c < 16; ++c) {
                        const uint4 kv = *(const uint4*)(T1 + swz256(idx, c));
                        const float* ww = wgt + c * 8;
                        nacc += bflo(kv.x) * ww[0] + bfhi(kv.x) * ww[1] + bflo(kv.y) * ww[2] + bfhi(kv.y) * ww[3]
                              + bflo(kv.z) * ww[4] + bfhi(kv.z) * ww[5] + bflo(kv.w) * ww[6] + bfhi(kv.w) * ww[7];
                    }
                    ((float*)(ws + O_MLN))[(((size_t)(b * NCH + cc) * 4 + h) * 2 + dir) * 128 + idx] = nacc;
                }
                __syncthreads();
            }
        }
    }
}

__device__ __forceinline__ int scan_cc(int dir, int step) { return dir == 0 ? step : (step < 2 ? 1 - step : 35 - step); }
__device__ void phase5(const Params& P) {
    unsigned char* ws = P.ws;
    const int vb = threadIdx.x >> 8, t = threadIdx.x & 255;
    for (int u = blockIdx.x * 2 + vb; u < 256 + 256 + 32; u += gridDim.x * 2) {
        if (u < 256) {
            const int chain = u >> 2, part = u & 3;
            const int b = chain >> 4, h = (chain >> 1) & 7, dir = chain & 1;
            const int off = part * 2048 + t * 8;
            float S[8];
#pragma unroll
            for (int j = 0; j < 8; ++j) S[j] = 0.f;
#pragma unroll 1
            for (int sb = 0; sb < NCH; sb += 17) {
                u32x4 lv[17]; float dc[17];
#pragma unroll
                for (int q = 0; q < 17; ++q) {
                    const int cc = scan_cc(dir, sb + q);
                    lv[q] = *(const u32x4*)((const u16*)(ws + O_ST) + (((size_t)(b * NCH + cc) * 8 + h) * 2 + dir) * 8192 + off);
                    dc[q] = ((const float*)(ws + O_ACH))[((size_t)(b * NCH + cc) * 8 + h) * 2 + dir];
                }
                __builtin_amdgcn_sched_barrier(0);
#pragma unroll
                for (int q = 0; q < 17; ++q) {
                    const int cc = scan_cc(dir, sb + q);
                    u16* p = (u16*)(ws + O_ST) + (((size_t)(b * NCH + cc) * 8 + h) * 2 + dir) * 8192 + off;
                    const float dec = __expf(dc[q]);
                    u32x4 o; o.x = pack2(S[0], S[1]); o.y = pack2(S[2], S[3]); o.z = pack2(S[4], S[5]); o.w = pack2(S[6], S[7]);
                    *(u32x4*)p = o;
                    S[0] = dec * S[0] + bflo(lv[q].x); S[1] = dec * S[1] + bfhi(lv[q].x); S[2] = dec * S[2] + bflo(lv[q].y); S[3] = dec * S[3] + bfhi(lv[q].y);
                    S[4] = dec * S[4] + bflo(lv[q].z); S[5] = dec * S[5] + bfhi(lv[q].z); S[6] = dec * S[6] + bflo(lv[q].w); S[7] = dec * S[7] + bfhi(lv[q].w);
                }
                __builtin_amdgcn_sched_barrier(0);
            }
        } else if (u < 512) {
            const int v = u - 256;
            const int chain = v >> 3, part = v & 7;
            const int b = chain >> 3, h = (chain >> 1) & 3, dir = chain & 1;
            const int off = part * 2048 + t * 8;
            float S[8];
#pragma unroll
            for (int j = 0; j < 8; ++j) S[j] = 0.f;
            float m = -1e30f;
#pragma unroll 1
            for (int sb = 0; sb < NCH; sb += 17) {
                u32x4 lv[17]; float mlv[17], blv[17];
#pragma unroll
                for (int q = 0; q < 17; ++q) {
                    const int cc = scan_cc(dir, sb + q);
                    lv[q] = *(const u32x4*)((const u16*)(ws + (dir ? O_MLC1 : O_MLC0)) + ((size_t)(b * NCH + cc) * 4 + h) * 16384 + off);
                    const float* mls = (const float*)(ws + O_MLS) + (((size_t)(b * NCH + cc) * 4 + h) * 2 + dir) * 2;
                    mlv[q] = mls[0]; blv[q] = mls[1];
                }
                __builtin_amdgcn_sched_barrier(0);
#pragma unroll
                for (int q = 0; q < 17; ++q) {
                    const int cc = scan_cc(dir, sb + q);
                    u16* p = (u16*)(ws + (dir ? O_MLC1 : O_MLC0)) + ((size_t)(b * NCH + cc) * 4 + h) * 16384 + off;
                    const float ml = mlv[q], bl = blv[q];
                    const float mn = fmaxf(bl + m, ml);
                    const float sp = __expf(bl + m - mn), sl = __expf(ml - mn);
                    if (part == 0 && t == 0) ((float*)(ws + O_MLP))[((size_t)(b * NCH + cc) * 4 + h) * 2 + dir] = m;
                    u32x4 o; o.x = pack2(S[0], S[1]); o.y = pack2(S[2], S[3]); o.z = pack2(S[4], S[5]); o.w = pack2(S[6], S[7]);
                    *(u32x4*)p = o;
                    S[0] = sp * S[0] + sl * bflo(lv[q].x); S[1] = sp * S[1] + sl * bfhi(lv[q].x); S[2] = sp * S[2] + sl * bflo(lv[q].y); S[3] = sp * S[3] + sl * bfhi(lv[q].y);
                    S[4] = sp * S[4] + sl * bflo(lv[q].z); S[5] = sp * S[5] + sl * bfhi(lv[q].z); S[6] = sp * S[6] + sl * bflo(lv[q].w); S[7] = sp * S[7] + sl * bfhi(lv[q].w);
                    m = mn;
                }
                __builtin_amdgcn_sched_barrier(0);
            }
        } else {
            const int chain = u - 512;
            const int b = chain >> 3, h = (chain >> 1) & 3, dir = chain & 1;
            if (t < 128) {
                float nS = 0.f, m = -1e30f;
#pragma unroll 1
                for (int sb = 0; sb < NCH; sb += 17) {
                    float lvv[17], mlv[17], blv[17];
#pragma unroll
                    for (int q = 0; q < 17; ++q) {
                        const int cc = scan_cc(dir, sb + q);
                        lvv[q] = ((const float*)(ws + O_MLN))[(((size_t)(b * NCH + cc) * 4 + h) * 2 + dir) * 128 + t];
                        const float* mls = (const float*)(ws + O_MLS) + (((size_t)(b * NCH + cc) * 4 + h) * 2 + dir) * 2;
                        mlv[q] = mls[0]; blv[q] = mls[1];
                    }
                    __builtin_amdgcn_sched_barrier(0);
#pragma unroll
                    for (int q = 0; q < 17; ++q) {
                        const int cc = scan_cc(dir, sb + q);
                        float* p = (float*)(ws + O_MLN) + (((size_t)(b * NCH + cc) * 4 + h) * 2 + dir) * 128 + t;
                        const float mn = fmaxf(blv[q] + m, mlv[q]);
                        const float sp = __expf(blv[q] + m - mn), sl = __expf(mlv[q] - mn);
                        *p = nS;
                        nS = sp * nS + sl * lvv[q];
                        m = mn;
                    }
                    __builtin_amdgcn_sched_barrier(0);
                }
            }
        }
    }
}

__device__ void phase6(const Params& P, char* lds) {
    unsigned char* ws = P.ws;
    char* T0 = lds; char* T1 = lds + 32768; char* T2 = lds + 65536; char* T3 = lds + 98304;
    float* sc = (float*)(lds + 131072);
    float* sbuf = sc;
    float* a0 = sc + 256;
    float* a1 = sc + 384;
    float* a2 = sc + 512;
    float* a3 = sc + 640;
    float* a4 = sc + 768;
    float* a5 = sc + 896;
    float* rsA = sc + 1024;
    float* qn = sc + 1536;
    float* fac = sc + 1792;
    float* wfac = sc + 2048;
    const int NSSD = 4 * 32 * 8, NML = 4 * 32 * 4, NU6 = NSSD + NML;
    u32x4 R0[4], R1[4], R2[4], R3[4];
    float ps0 = 0.f, ps1 = 0.f, ps2 = 0.f, ps3 = 0.f;
#define P6_PREFETCH(uu) do { \
        const int _u = (uu); const bool _ssd = _u < NSSD; const int _v = _ssd ? _u : _u - NSSD; \
        const int _h = _ssd ? (_v & 7) : (_v & 3), _ct = _ssd ? (_v >> 3) : (_v >> 2), _b = _ct >> 5, _c = _ct & 31, _cc = _c + 2; \
        const size_t _ctile = (size_t)(_b * NCH + _cc); const int _rb = _b * 4096 + _c * 128; \
        const u16 *_p0, *_p1, *_p2, *_p3; \
        if (_ssd) { const int _g = _h >> 2; _p0 = (const u16*)(ws + O_CM) + (_ctile * 2 + _g) * 16384; _p1 = (const u16*)(ws + O_BM) + (_ctile * 2 + _g) * 16384; \
                    _p2 = (const u16*)(ws + O_ST) + ((_ctile * 8 + _h) * 2) * 8192; _p3 = (const u16*)(ws + O_XT) + (_ctile * 512 + _h * 64) * 128; } \
        else { _p0 = (const u16*)(ws + O_Q) + (_ctile * 4 + _h) * 16384; _p1 = (const u16*)(ws + O_K) + (_ctile * 4 + _h) * 16384; \
               _p2 = (const u16*)(ws + O_MLC0) + (_ctile * 4 + _h) * 16384; _p3 = (const u16*)(ws + O_MLC1) + (_ctile * 4 + _h) * 16384; } \
        _Pragma("unroll") for (int _i = 0; _i < 4; ++_i) { const int _q = (int)threadIdx.x + 512 * _i; const size_t _o = (size_t)(_q >> 4) * 128 + (_q & 15) * 8; \
            R0[_i] = *(const u32x4*)(_p0 + _o); R1[_i] = *(const u32x4*)(_p1 + _o); R2[_i] = *(const u32x4*)(_p2 + _o); R3[_i] = *(const u32x4*)(_p3 + _o); } \
        if (threadIdx.x < 128) { const int _dir = threadIdx.x >> 6, _ln = threadIdx.x & 63; \
            const int _l0 = _dir ? 127 - 2 * _ln : 2 * _ln, _l1 = _dir ? 126 - 2 * _ln : 2 * _ln + 1; \
            if (_ssd) { const float* _dp = (const float*)(ws + O_DT) + (size_t)_rb * 16 + _dir * 8 + _h; ps0 = _dp[_l0 * 16]; ps1 = _dp[_l1 * 16]; } \
            else { const float* _gf = (const float*)(ws + O_GF) + (size_t)_rb * 8 + _dir * 4 + _h; const float* _gi = (const float*)(ws + O_GI) + (size_t)_rb * 8 + _dir * 4 + _h; \
                   ps0 = _gf[_l0 * 8]; ps1 = _gf[_l1 * 8]; ps2 = _gi[_l0 * 8]; ps3 = _gi[_l1 * 8]; } } \
    } while (0)
    if ((int)blockIdx.x < NU6) P6_PREFETCH(blockIdx.x);
    for (int u = blockIdx.x; u < NU6; u += gridDim.x) {
        int t = threadIdx.x; asm volatile("" : "+v"(t));
        const int lane = t & 63, w = t >> 6, wm = w >> 1, wn = w & 1;
        const bool isssd = u < NSSD;
        const int v = isssd ? u : u - NSSD;
        const int h = isssd ? (v & 7) : (v & 3), ct = isssd ? (v >> 3) : (v >> 2), b = ct >> 5, c = ct & 31, cc = c + 2;
        const int rb = b * 4096 + c * 128, lpos = c * 128;
        const float mp0 = isssd ? 0.f : ((const float*)(ws + O_MLP))[((size_t)(b * NCH + cc) * 4 + h) * 2 + 0];
        const float mp1 = isssd ? 0.f : ((const float*)(ws + O_MLP))[((size_t)(b * NCH + cc) * 4 + h) * 2 + 1];
        if (w < 2) {
            const int dir = w;
            const int l0 = dir ? 127 - 2 * lane : 2 * lane, l1 = dir ? 126 - 2 * lane : 2 * lane + 1;
            if (isssd) {
                const float d0 = ps0, d1 = ps1;
                const float an = -__expf(P.in[I_ALOG][dir * 8 + h]);
                const float p0 = d0 * an, p1 = p0 + d1 * an;
                const float inc = wave_scan_sum(p1, lane);
                const float ex = inc - p1;
                float* ca = dir ? a1 : a0; float* da = dir ? a3 : a2;
                ca[l0] = ex + p0; ca[l1] = ex + p1; da[l0] = d0; da[l1] = d1;
            } else {
                const float f0 = ps0, f1 = ps1, i0 = ps2, i1 = ps3;
                const float p1 = f0 + f1;
                const float inc = wave_scan_sum(p1, lane);
                const float ex = inc - p1;
                const float bc0 = ex + f0, bc1 = ex + p1;
                const float u0 = i0 - bc0, u1 = i1 - bc1;
                const float q1 = fmaxf(u0, u1);
                const float incm = wave_scan_max(q1, lane);
                float exm = __shfl_up(incm, 1); if (lane == 0) exm = -INFINITY;
                const float mp = dir ? mp1 : mp0;
                float* ab = dir ? a1 : a0; float* au = dir ? a3 : a2; float* am = dir ? a5 : a4;
                ab[l0] = bc0; ab[l1] = bc1; au[l0] = u0; au[l1] = u1;
                am[l0] = fmaxf(mp, fmaxf(exm, u0)); am[l1] = fmaxf(mp, fmaxf(exm, q1));
            }
        }
#pragma unroll
        for (int i = 0; i < 4; ++i) {
            const int q = t + 512 * i, r = q >> 4, cq = q & 15;
            *(u32x4*)(T0 + swz256(r, cq)) = R0[i];
            *(u32x4*)(T1 + swz256(r, cq)) = R1[i];
            *(u32x4*)(T2 + swz256(r, cq)) = R2[i];
            if (!isssd || i < 2) *(u32x4*)(T3 + swz256(r, cq)) = R3[i];
        }
        __syncthreads();
        if (u + (int)gridDim.x < NU6) P6_PREFETCH(u + gridDim.x);
        if (isssd) {
            const int g = h >> 2; (void)g;
            const int lr = lane & 15, lq = lane >> 4;
            f32x4 Y[2][2];
            {
                f32x4 aF[2][2], aB[2][2]; zero_acc(aF); zero_acc(aB);
                lds_mma_t<2, 2>(T0, T2, wm * 32, wn * 32, aF, lane);
                lds_mma_t<2, 2>(T0, T2, wm * 32, 64 + wn * 32, aB, lane);
#pragma unroll
                for (int i = 0; i < 2; ++i) {
                    const int l = wm * 32 + i * 16 + lr;
                    const float e0 = __expf(a0[l]), e1 = __expf(a1[l]);
#pragma unroll
                    for (int j = 0; j < 2; ++j) Y[i][j] = e0 * aF[i][j] + e1 * aB[i][j];
                }
            }
            f32x4 G[2][4]; zero_acc(G);
            lds_mma_t<2, 4>(T0, T1, wm * 32, wn * 64, G, lane);
            __syncthreads();
            {
                const float Dh = P.in[I_SSDD][h];
                int dbase = wn * 64 + lq * 4 - wm * 32 - lr; asm volatile("" : "+v"(dbase));
#pragma unroll
                for (int j = 0; j < 4; ++j) {
                    const int s0 = wn * 64 + j * 16 + lq * 4;
                    const float4 c0s = *(const float4*)(a0 + s0), r1s = *(const float4*)(a1 + s0), d0s = *(const float4*)(a2 + s0), d1s = *(const float4*)(a3 + s0);
                    const float c0v[4] = {c0s.x, c0s.y, c0s.z, c0s.w}, r1v[4] = {r1s.x, r1s.y, r1s.z, r1s.w};
                    const float d0v[4] = {d0s.x, d0s.y, d0s.z, d0s.w}, d1v[4] = {d1s.x, d1s.y, d1s.z, d1s.w};
#pragma unroll
                    for (int i = 0; i < 2; ++i) {
                        const int l = wm * 32 + i * 16 + lr;
                        const float c0l = a0[l], r1l = a1[l];
                        float mv[4];
#pragma unroll
                        for (int r = 0; r < 4; ++r) {
                            const int diff = dbase + (j * 16 - i * 16 + r);
                            const float e0 = (diff <= 0) ? (c0l - c0v[r]) : -INFINITY;
                            const float e1 = (diff >= 0) ? (r1l - r1v[r]) : -INFINITY;
                            mv[r] = G[i][j][r] * (__expf(e0) * d0v[r] + __expf(e1) * d1v[r]) + (diff == 0 ? Dh : 0.f);
                        }
                        uint2 o; o.x = pack2(mv[0], mv[1]); o.y = pack2(mv[2], mv[3]);
                        *(uint2*)(T1 + swz256(l, s0 >> 3) + (s0 & 7) * 2) = o;
                    }
                }
            }
            __syncthreads();
            lds_mma_t<2, 2>(T1, T3, wm * 32, wn * 32, Y, lane);
            u16* zo = (u16*)(ws + O_ZO);
            uint2 zvv[2][2];
#pragma unroll
            for (int i = 0; i < 2; ++i)
#pragma unroll
                for (int j = 0; j < 2; ++j) zvv[i][j] = *(const uint2*)(zo + (size_t)(rb + wm * 32 + i * 16 + lr) * 1024 + h * 64 + wn * 32 + j * 16 + lq * 4);
            __builtin_amdgcn_sched_barrier(0);
#pragma unroll
            for (int i = 0; i < 2; ++i) {
                const int l = wm * 32 + i * 16 + lr;
                float ssq = 0.f;
#pragma unroll
                for (int j = 0; j < 2; ++j) {
                    const int p = wn * 32 + j * 16 + lq * 4;
                    u16* zp = zo + (size_t)(rb + l) * 1024 + h * 64 + p;
                    const uint2 zv = zvv[i][j];
                    const float y0 = Y[i][j][0] * siluf(bflo(zv.x)), y1 = Y[i][j][1] * siluf(bfhi(zv.x));
                    const float y2 = Y[i][j][2] * siluf(bflo(zv.y)), y3 = Y[i][j][3] * siluf(bfhi(zv.y));
                    uint2 o; o.x = pack2(y0, y1); o.y = pack2(y2, y3);
                    *(uint2*)zp = o;
                    ssq += y0 * y0 + y1 * y1 + y2 * y2 + y3 * y3;
                }
                ssq += __shfl_xor(ssq, 16); ssq += __shfl_xor(ssq, 32);
                if (lq == 0) ((float*)(ws + O_SSQ))[(size_t)(rb + l) * 16 + h * 2 + wn] = ssq;
            }
            __syncthreads();
        } else {
            const int lr = lane & 15, lq = lane >> 4;
            f32x4 S[2][4]; zero_acc(S);
            lds_mma_t<2, 4>(T0, T1, wm * 32, wn * 64, S, lane);
            if (t < 256) {
                const int dir = t >> 7, idx = t & 127;
                const float* np = (const float*)(ws + O_MLN) + (((size_t)(b * NCH + cc) * 4 + h) * 2 + dir) * 128;
                float acc = 0.f;
#pragma unroll 4
                for (int cch = 0; cch < 16; ++cch) {
                    const uint4 qv = *(const uint4*)(T0 + swz256(idx, cch));
                    const float4 n0 = *(const float4*)(np + cch * 8), n1 = *(const float4*)(np + cch * 8 + 4);
                    acc += bflo(qv.x) * n0.x + bfhi(qv.x) * n0.y + bflo(qv.y) * n0.z + bfhi(qv.y) * n0.w
                         + bflo(qv.z) * n1.x + bfhi(qv.z) * n1.y + bflo(qv.w) * n1.z + bfhi(qv.w) * n1.w;
                }
                qn[dir * 128 + idx] = acc;
            }
            int dbase = wn * 64 + lq * 4 - wm * 32 - lr; asm volatile("" : "+v"(dbase));
            {
                float r0[2] = {0.f, 0.f}, r1[2] = {0.f, 0.f};
#pragma unroll
                for (int j = 0; j < 4; ++j) {
                    const int s0 = wn * 64 + j * 16 + lq * 4;
                    const float4 u0s = *(const float4*)(a2 + s0), u1s = *(const float4*)(a3 + s0);
                    const float u0v[4] = {u0s.x, u0s.y, u0s.z, u0s.w}, u1v[4] = {u1s.x, u1s.y, u1s.z, u1s.w};
#pragma unroll
                    for (int i = 0; i < 2; ++i) {
                        const int tt = wm * 32 + i * 16 + lr;
                        const float m0 = a4[tt], m1 = a5[tt];
#pragma unroll
                        for (int r = 0; r < 4; ++r) {
                            const int diff = dbase + (j * 16 - i * 16 + r);
                            r0[i] += S[i][j][r] * __expf((diff <= 0) ? (u0v[r] - m0) : -INFINITY);
                            r1[i] += S[i][j][r] * __expf((diff >= 0) ? (u1v[r] - m1) : -INFINITY);
                        }
                    }
                }
#pragma unroll
                for (int i = 0; i < 2; ++i) {
                    const int tt = wm * 32 + i * 16 + lr;
                    float x0 = r0[i], x1 = r1[i];
                    x0 += __shfl_xor(x0, 16); x0 += __shfl_xor(x0, 32);
                    x1 += __shfl_xor(x1, 16); x1 += __shfl_xor(x1, 32);
                    if (lq == 0) { rsA[(0 * 2 + wn) * 128 + tt] = x0; rsA[(1 * 2 + wn) * 128 + tt] = x1; }
                }
            }
            __syncthreads();
            if (t < 256) {
                const int dir = t >> 7, tt = t & 127;
                const float rs = rsA[(dir * 2 + 0) * 128 + tt] + rsA[(dir * 2 + 1) * 128 + tt];
                const float mm = dir ? a5[tt] : a4[tt];
                const float wi = __expf((dir ? mp1 : mp0) - mm);
                const float den = rs + wi * qn[dir * 128 + tt];
                const float mout = (dir ? a1[tt] : a0[tt]) + mm;
                const float dn = fmaxf(fabsf(den), __expf(-mout));
                fac[dir * 128 + tt] = 1.f / dn;
                wfac[dir * 128 + tt] = wi / dn;
            }
            __syncthreads();
            f32x4 H[2][4];
            {
                f32x4 A0[2][4]; zero_acc(A0);
                lds_mma_t<2, 4>(T0, T2, wm * 32, wn * 64, A0, lane);
#pragma unroll
                for (int i = 0; i < 2; ++i) {
                    const float f = wfac[wm * 32 + i * 16 + lr];
#pragma unroll
                    for (int j = 0; j < 4; ++j) H[i][j] = f * A0[i][j];
                }
            }
            {
                f32x4 A1[2][4]; zero_acc(A1);
                lds_mma_t<2, 4>(T0, T3, wm * 32, wn * 64, A1, lane);
#pragma unroll
                for (int i = 0; i < 2; ++i) {
                    const float f = wfac[128 + wm * 32 + i * 16 + lr];
#pragma unroll
                    for (int j = 0; j < 4; ++j) H[i][j] += f * A1[i][j];
                }
            }
            __syncthreads();
            asm volatile("" : "+v"(dbase));
#pragma unroll
            for (int j = 0; j < 4; ++j) {
                const int s0 = wn * 64 + j * 16 + lq * 4;
                const float4 u0s = *(const float4*)(a2 + s0), u1s = *(const float4*)(a3 + s0);
                const float u0v[4] = {u0s.x, u0s.y, u0s.z, u0s.w}, u1v[4] = {u1s.x, u1s.y, u1s.z, u1s.w};
#pragma unroll
                for (int i = 0; i < 2; ++i) {
                    const int tt = wm * 32 + i * 16 + lr;
                    const float m0 = a4[tt], m1 = a5[tt], f0 = fac[tt], f1 = fac[128 + tt];
                    float pv[4];
#pragma unroll
                    for (int r = 0; r < 4; ++r) {
                        const int diff = dbase + (j * 16 - i * 16 + r);
                        pv[r] = S[i][j][r] * (__expf((diff <= 0) ? (u0v[r] - m0) : -INFINITY) * f0 + __expf((diff >= 0) ? (u1v[r] - m1) : -INFINITY) * f1);
                    }
                    uint2 o; o.x = pack2(pv[0], pv[1]); o.y = pack2(pv[2], pv[3]);
                    *(uint2*)(T1 + swz256(tt, s0 >> 3) + (s0 & 7) * 2) = o;
                }
            }
            load_tile128(T2, 0, (const u16*)(ws + O_VT) + ((size_t)(b * NCH + cc) * 512 + h * 128) * 128, 128, 128, t, 512);
            __syncthreads();
            lds_mma_t<2, 4>(T1, T2, wm * 32, wn * 64, H, lane);
            u16* zo = (u16*)(ws + O_ZO);
            size_t rown[2];
#pragma unroll
            for (int i = 0; i < 2; ++i) {
                const int tt = wm * 32 + i * 16 + lr;
                const int lp = lpos + tt;
                rown[i] = (size_t)b * 4096 + ((lp & 63) << 6) + (lp >> 6);
                float ssq = 0.f;
#pragma unroll
                for (int j = 0; j < 4; ++j) {
                    const int d = wn * 64 + j * 16 + lq * 4;
                    const uint2 ov = *(const uint2*)(zo + rown[i] * 1024 + 512 + h * 128 + d);
                    H[i][j][0] *= sigmf(bflo(ov.x)); H[i][j][1] *= sigmf(bfhi(ov.x)); H[i][j][2] *= sigmf(bflo(ov.y)); H[i][j][3] *= sigmf(bfhi(ov.y));
                    ssq += H[i][j][0] * H[i][j][0] + H[i][j][1] * H[i][j][1] + H[i][j][2] * H[i][j][2] + H[i][j][3] * H[i][j][3];
                }
                ssq += __shfl_xor(ssq, 16); ssq += __shfl_xor(ssq, 32);
                if (lq == 0) rsA[wn * 128 + tt] = ssq;
            }
            __syncthreads();
            const u16* xc = (const u16*)(ws + O_XC);
            f32x4 nwv[4], skv[4]; uint2 xvv[4][2];
#pragma unroll
            for (int j = 0; j < 4; ++j) {
                const int d = wn * 64 + j * 16 + lq * 4, chg = h * 128 + d;
                nwv[j] = *(const f32x4*)(P.in[I_MNW] + chg); skv[j] = *(const f32x4*)(P.in[I_MSKIP] + chg);
#pragma unroll
                for (int i = 0; i < 2; ++i) xvv[j][i] = *(const uint2*)(xc + ((size_t)(b * NCH + cc) * 4 + h) * 16384 + (size_t)(wm * 32 + i * 16 + lr) * 128 + d);
            }
            __builtin_amdgcn_sched_barrier(0);
#pragma unroll
            for (int j = 0; j < 4; ++j) {
                const int d = wn * 64 + j * 16 + lq * 4, chg = h * 128 + d;
#pragma unroll
                for (int i = 0; i < 2; ++i) {
                    const int tt = wm * 32 + i * 16 + lr;
                    const float rn = rsqrtf((rsA[tt] + rsA[128 + tt]) * (1.f / 128.f) + 1e-6f);
                    const uint2 xv = xvv[j][i];
                    const float y0 = H[i][j][0] * rn * nwv[j][0] + skv[j][0] * bflo(xv.x), y1 = H[i][j][1] * rn * nwv[j][1] + skv[j][1] * bfhi(xv.x);
                    const float y2 = H[i][j][2] * rn * nwv[j][2] + skv[j][2] * bflo(xv.y), y3 = H[i][j][3] * rn * nwv[j][3] + skv[j][3] * bfhi(xv.y);
                    uint2 o; o.x = pack2(y0, y1); o.y = pack2(y2, y3);
                    *(uint2*)(zo + rown[i] * 1024 + 512 + chg) = o;
                }
            }
            __syncthreads();
        }
    }
}

struct OutProj {
    static constexpr int K = 1024; static constexpr bool PERM = false; static constexpr int MIDT = 8;
    struct Unit { int pm, pn, slot; };
    const Params* P; const float* rs; int G, c;
    __device__ __forceinline__ bool next(int i, Unit& u) const {
        const int L = i * G + c;
        if (L >= 256) return false;
        g8::dense_unit(L, 64, 4, u.pm, u.pn); u.slot = i & 3;
        return true;
    }
    __device__ __forceinline__ const char* baseA(const Unit&) const { return (const char*)(P->ws + O_ZO); }
    __device__ __forceinline__ const char* baseB(const Unit&) const { return (const char*)(P->ws + O_WOUT); }
    __device__ __forceinline__ void offs(const Unit& u, int tid_, unsigned (&oa)[2][2], unsigned (&ob)[2][2]) const {
        int R[2], C[2];
        { int tq = tid_; asm volatile("" : "+v"(tq)); g8::stage_rc(tq * 16, R[0], C[0]); g8::stage_rc(tq * 16 + 8192, R[1], C[1]); }
#pragma unroll
        for (int h = 0; h < 2; ++h)
#pragma unroll
            for (int i = 0; i < 2; ++i) {
                oa[h][i] = (unsigned)((u.pm * 256 + h * 128 + R[i]) * 1024 + C[i]) * 2u;
                ob[h][i] = (unsigned)((u.pn * 256 + h * 128 + R[i]) * 1024 + C[i]) * 2u;
            }
    }
    __device__ __forceinline__ int nt(const Unit&) const { return 16; }
    __device__ __forceinline__ bool brk(const Unit&, const Unit&) const { return false; }
    __device__ __forceinline__ void a_ready(const Unit&) const {}
    __device__ __forceinline__ void done(const Unit&) const {}
    __device__ __forceinline__ void mid(g8::Acc& acc, const Unit& u, int wr, int fr) const {
#pragma unroll
        for (int ai = 0; ai < 2; ++ai)
#pragma unroll
            for (int m = 0; m < 4; ++m) {
                const float s = rs[u.slot * 256 + ai * 128 + wr * 64 + m * 16 + fr];
#pragma unroll
                for (int bj = 0; bj < 2; ++bj)
#pragma unroll
                    for (int n = 0; n < 2; ++n) acc[ai][bj][m][n] *= s;
            }
    }
    __device__ __forceinline__ void epi(g8::Acc& acc, const Unit& u, int wr, int wc, int fr, int fq) const {
        const int row0 = u.pm * 256 + wr * 64 + fr, col0 = u.pn * 256 + wc * 32 + 4 * fq;
        const int b = u.pm >> 4;
        const float* mod = (const float*)(P->ws + O_MOD) + b * 6144 + 2048;
        f32x4 g1[2][2];
#pragma unroll
        for (int bj = 0; bj < 2; ++bj)
#pragma unroll
            for (int n = 0; n < 2; ++n) g1[bj][n] = *(const f32x4*)(mod + col0 + bj * 128 + n * 16);
        f32x4 xa[8], xb[8];
#define OP_LOAD(dst, ai_, mp_) _Pragma("unroll") for (int mm = 0; mm < 2; ++mm) _Pragma("unroll") for (int bj = 0; bj < 2; ++bj) _Pragma("unroll") for (int n = 0; n < 2; ++n) \
            dst[mm * 4 + bj * 2 + n] = __builtin_nontemporal_load((const f32x4*)(P->in[I_X] + (size_t)(row0 + (ai_) * 128 + ((mp_) * 2 + mm) * 16) * 1024 + col0 + bj * 128 + n * 16))
#define OP_STORE(src, ai_, mp_) _Pragma("unroll") for (int mm = 0; mm < 2; ++mm) _Pragma("unroll") for (int bj = 0; bj < 2; ++bj) _Pragma("unroll") for (int n = 0; n < 2; ++n) \
            *(f32x4*)(P->out + (size_t)(row0 + (ai_) * 128 + ((mp_) * 2 + mm) * 16) * 1024 + col0 + bj * 128 + n * 16) = src[mm * 4 + bj * 2 + n] + g1[bj][n] * acc[ai_][bj][(mp_) * 2 + mm][n]
        OP_LOAD(xa, 0, 0);
        __builtin_amdgcn_sched_barrier(0);
        OP_LOAD(xb, 0, 1);
        __builtin_amdgcn_sched_barrier(0);
        OP_STORE(xa, 0, 0);
        __builtin_amdgcn_sched_barrier(0);
        OP_LOAD(xa, 1, 0);
        __builtin_amdgcn_sched_barrier(0);
        OP_STORE(xb, 0, 1);
        __builtin_amdgcn_sched_barrier(0);
        OP_LOAD(xb, 1, 1);
        __builtin_amdgcn_sched_barrier(0);
        OP_STORE(xa, 1, 0);
        __builtin_amdgcn_sched_barrier(0);
        OP_STORE(xb, 1, 1);
#undef OP_LOAD
#undef OP_STORE
    }
};
__device__ void phase7(const Params& P, char* lds) {
    float* rs = (float*)(lds + g8::STAGE_BYTES);
    OutProj S; S.P = &P; S.rs = rs; S.G = gridDim.x; S.c = blockIdx.x;
    for (int i = 0; i < 4; ++i) {
        OutProj::Unit u;
        if (!S.next(i, u)) break;
        if (threadIdx.x < 256) {
            const f32x4* sq = (const f32x4*)((const float*)(P.ws + O_SSQ) + (size_t)(u.pm * 256 + threadIdx.x) * 16);
            const f32x4 s0 = sq[0], s1 = sq[1], s2 = sq[2], s3 = sq[3];
            const f32x4 sv = (s0 + s1) + (s2 + s3);
            const float s = (sv[0] + sv[1]) + (sv[2] + sv[3]);
            rs[i * 256 + threadIdx.x] = rsqrtf(s * (1.f / 512.f) + 1e-6f);
        }
    }
    __syncthreads();
    g8::gemm_phase<OutProj>((LAS unsigned char*)lds, S);
}

__device__ void phase8(const Params& P, char* lds_all) {
    unsigned char* ws = P.ws;
    const float* mod = (const float*)(ws + O_MOD);
    {
        const int t = threadIdx.x, lane = t & 63, w = t >> 6;
        float* tt = (float*)lds_all;
        float bw[32][3];
        {
            const int ti = lane & 15, kq = lane >> 4;
#pragma unroll
            for (int ks = 0; ks < 32; ++ks) {
                const int k = w * 128 + ks * 4 + kq;
                bw[ks][0] = P.in[I_REW][(size_t)k * 32 + ti];
                bw[ks][1] = P.in[I_REW][(size_t)k * 32 + 16 + ti];
                const float b2r = P.in[I_RGW][(size_t)k * 4 + (ti & 3)];
                bw[ks][2] = ti < 4 ? b2r : 0.f;
            }
        }
        for (int u = blockIdx.x; u < 512; u += gridDim.x) {
            const int tk0 = u * 32;
            const int b = tk0 >> 12;
            f32x4 mulv[4], shv[4];
            {
                f32x4 nwv[4], scv[4];
#pragma unroll
                for (int j = 0; j < 4; ++j) {
                    const int k = (lane + 64 * j) * 4;
                    nwv[j] = *(const f32x4*)(P.in[I_N2W] + k);
                    shv[j] = *(const f32x4*)(mod + b * 6144 + 3072 + k);
                    scv[j] = *(const f32x4*)(mod + b * 6144 + 4096 + k);
                }
#pragma unroll
                for (int j = 0; j < 4; ++j) mulv[j] = nwv[j] * (scv[j] + 1.f);
            }
#pragma unroll 1
            for (int qh = 0; qh < 2; ++qh) {
                f32x4 v[2][4]; float ss[2];
#pragma unroll
                for (int q = 0; q < 2; ++q) {
                    const float* xr = P.out + (size_t)(tk0 + w * 4 + qh * 2 + q) * 1024;
#pragma unroll
                    for (int j = 0; j < 4; ++j) v[q][j] = ((const f32x4*)xr)[lane + 64 * j];
                }
                __builtin_amdgcn_sched_barrier(0);
#pragma unroll
                for (int q = 0; q < 2; ++q) {
                    ss[q] = 0.f;
#pragma unroll
                    for (int j = 0; j < 4; ++j) ss[q] += v[q][j][0] * v[q][j][0] + v[q][j][1] * v[q][j][1] + v[q][j][2] * v[q][j][2] + v[q][j][3] * v[q][j][3];
                    ss[q] = rsqrtf(wave_sum(ss[q]) * (1.f / 1024.f) + 1e-6f);
                }
#pragma unroll
                for (int j = 0; j < 4; ++j) {
                    const int k = (lane + 64 * j) * 4;
#pragma unroll
                    for (int q = 0; q < 2; ++q) {
                        const int tl = w * 4 + qh * 2 + q;
                        const f32x4 hh = v[q][j] * ss[q] * mulv[j] + shv[j];
                        uint2 o; o.x = pack2(hh[0], hh[1]); o.y = pack2(hh[2], hh[3]);
                        *(uint2*)((u16*)(ws + O_T) + (size_t)(tk0 + tl) * 1024 + k) = o;
                        *(f32x4*)(tt + tl * 1028 + k) = hh;
                    }
                }
            }
            __syncthreads();
            f32x4 c[2][3];
#pragma unroll
            for (int a = 0; a < 2; ++a)
#pragma unroll
                for (int f = 0; f < 3; ++f) c[a][f] = f32x4{0, 0, 0, 0};
            const int ti = lane & 15, kq = lane >> 4;
#pragma unroll
            for (int ks = 0; ks < 32; ++ks) {
                const int k = w * 128 + ks * 4 + kq;
                const float a0 = tt[ti * 1028 + k], a1 = tt[(16 + ti) * 1028 + k];
                c[0][0] = __builtin_amdgcn_mfma_f32_16x16x4f32(a0, bw[ks][0], c[0][0], 0, 0, 0);
                c[0][1] = __builtin_amdgcn_mfma_f32_16x16x4f32(a0, bw[ks][1], c[0][1], 0, 0, 0);
                c[0][2] = __builtin_amdgcn_mfma_f32_16x16x4f32(a0, bw[ks][2], c[0][2], 0, 0, 0);
                c[1][0] = __builtin_amdgcn_mfma_f32_16x16x4f32(a1, bw[ks][0], c[1][0], 0, 0, 0);
                c[1][1] = __builtin_amdgcn_mfma_f32_16x16x4f32(a1, bw[ks][1], c[1][1], 0, 0, 0);
                c[1][2] = __builtin_amdgcn_mfma_f32_16x16x4f32(a1, bw[ks][2], c[1][2], 0, 0, 0);
            }
            __syncthreads();
            float* red = (float*)lds_all;
#pragma unroll
            for (int a = 0; a < 2; ++a)
#pragma unroll
                for (int r = 0; r < 4; ++r) {
                    const int row = a * 16 + kq * 4 + r;
                    red[(w * 32 + row) * 48 + ti] = c[a][0][r];
                    red[(w * 32 + row) * 48 + 16 + ti] = c[a][1][r];
                    red[(w * 32 + row) * 48 + 32 + ti] = c[a][2][r];
                }
            __syncthreads();
            int* lcnt = (int*)(lds_all + 65536);
            if (t < 64) lcnt[t] = 0;
            __syncthreads();
            int ea = 0, eb = 0, ra = 0, rb = 0; float w1 = 0.f, w2 = 0.f;
            if (t < 32) {
                float gl[4];
#pragma unroll
                for (int j = 0; j < 4; ++j) {
                    float sacc = P.in[I_RGB][j];
#pragma unroll
                    for (int ww = 0; ww < 8; ++ww) sacc += red[(ww * 32 + t) * 48 + 32 + j];
                    gl[j] = sacc;
                }
                int gs = 0; float gm = gl[0];
#pragma unroll
                for (int j = 1; j < 4; ++j) if (gl[j] > gm) { gm = gl[j]; gs = j; }
                float gsum = 0.f;
#pragma unroll
                for (int j = 0; j < 4; ++j) gsum += __expf(gl[j] - gm);
                const float pg = 1.f / gsum;
                float el[8];
#pragma unroll
                for (int j = 0; j < 8; ++j) {
                    float sacc = P.in[I_REB][gs * 8 + j];
#pragma unroll
                    for (int ww = 0; ww < 8; ++ww) sacc += red[(ww * 32 + t) * 48 + gs * 8 + j];
                    el[j] = sacc;
                }
                int i1 = 0; float m1 = el[0];
#pragma unroll
                for (int j = 1; j < 8; ++j) if (el[j] > m1) { m1 = el[j]; i1 = j; }
                int i2 = -1; float m2 = -INFINITY;
#pragma unroll
                for (int j = 0; j < 8; ++j) if (j != i1 && el[j] > m2) { m2 = el[j]; i2 = j; }
                const float e2 = __expf(m2 - m1);
                w1 = pg / (1.f + e2); w2 = pg * e2 / (1.f + e2);
                ea = gs * 8 + i1; eb = gs * 8 + i2;
                ra = atomicAdd(&lcnt[ea], 1);
                rb = atomicAdd(&lcnt[eb], 1);
            }
            __syncthreads();
            if (t < 32) {
                const int n = lcnt[t];
                lcnt[32 + t] = n > 0 ? atomicAdd((int*)(ws + O_CNT) + t * 64, n) : 0;
            }
            __syncthreads();
            if (t < 32) {
                const int tok = tk0 + t;
                int* list = (int*)(ws + O_LIST);
                float* wts = (float*)(ws + O_WTS);
                list[ea * 16384 + lcnt[32 + ea] + ra] = tok * 2;
                wts[tok * 2] = w1;
                list[eb * 16384 + lcnt[32 + eb] + rb] = tok * 2 + 1;
                wts[tok * 2 + 1] = w2;
            }
            __syncthreads();
        }
    }
    const int vb = threadIdx.x >> 8, t = threadIdx.x & 255;
    char* lds = lds_all + vb * VLDS;
    const int NTR = 3072;
    for (int u = blockIdx.x * 2 + vb; u < NTR; u += gridDim.x * 2) {
        {
            const int v = u;
            float* tile = (float*)lds;
            if (v < 2048) {
                const bool up = v >= 1024;
                const int vv = v & 1023, e = vv >> 5, rem = vv & 31, nt = rem >> 4, kt = rem & 15;
                const float* src = P.in[up ? I_WU : I_WG] + (size_t)e * 1024 * 256;
                transpose_tile_w(tile, src, 256, kt * 64, nt * 128, (u16*)(ws + O_WGU) + (size_t)e * 512 * 1024, (up ? 256 : 0) + nt * 128, 1024, nullptr, 0, t);
            } else {
                const int vv = v - 2048, e = vv >> 5, rem = vv & 31, nt = rem >> 2, kt = rem & 3;
                const float* src = P.in[I_WD] + (size_t)e * 256 * 1024;
                transpose_tile_w(tile, src, 1024, kt * 64, nt * 128, (u16*)(ws + O_WD) + (size_t)e * 1024 * 256, nt * 128, 256, nullptr, 0, t);
            }
        }
    }
}

__device__ __forceinline__ void moe_prefix(const unsigned char* ws, int* pre_t, int* pre_c) {
    if (threadIdx.x == 0) {
        const int* cnt = (const int*)(ws + O_CNT);
        int at = 0, ac = 0;
        for (int e = 0; e < 32; ++e) { pre_t[e] = at; pre_c[e] = ac; const int c = cnt[e * 64]; at += (c + 255) >> 8; ac += c; }
        pre_t[32] = at; pre_c[32] = ac;
    }
    __syncthreads();
}
struct MoeUnit { int type, e, mt, pn, cnt, base, mtg; };
struct Moe {
    static constexpr int K = 0; static constexpr bool PERM = true; static constexpr int MIDT = 0;
    typedef MoeUnit Unit;
    const unsigned char* ws; const int* pre_t; const int* pre_c; int G, c;
    __device__ __forceinline__ bool next(int i, Unit& u) const {
        int type, m, pn, e, mt;
        if ((G & 7) == 0) {
            const int x = c & 7, s = c >> 3, nb = G >> 3;
            const int n0 = pre_t[x + 1] - pre_t[x], n1 = pre_t[x + 9] - pre_t[x + 8], n2 = pre_t[x + 17] - pre_t[x + 16], n3 = pre_t[x + 25] - pre_t[x + 24];
            const int MTx = n0 + n1 + n2 + n3;
            const int Lx = i * nb + s;
            if (Lx < MTx * 2) { type = 0; m = Lx >> 1; pn = Lx & 1; }
            else if (Lx < MTx * 6) { const int j = Lx - MTx * 2; type = 1; m = j >> 2; pn = j & 3; }
            else return false;
            if (m < n0) { e = x; mt = m; }
            else if (m < n0 + n1) { e = x + 8; mt = m - n0; }
            else if (m < n0 + n1 + n2) { e = x + 16; mt = m - n0 - n1; }
            else { e = x + 24; mt = m - n0 - n1 - n2; }
        } else {
            const int L = i * G + c, MT = pre_t[32];
            if (L < MT * 2) { type = 0; m = L >> 1; pn = L & 1; }
            else if (L < MT * 6) { const int j = L - MT * 2; type = 1; m = j >> 2; pn = j & 3; }
            else return false;
            e = 0;
            while (pre_t[e + 1] <= m) ++e;
            mt = m - pre_t[e];
        }
        u.e = __builtin_amdgcn_readfirstlane(e); u.mt = __builtin_amdgcn_readfirstlane(mt);
        u.cnt = __builtin_amdgcn_readfirstlane(pre_c[e + 1] - pre_c[e]); u.base = __builtin_amdgcn_readfirstlane(pre_c[e]);
        u.mtg = __builtin_amdgcn_readfirstlane(pre_t[e] + mt); u.pn = __builtin_amdgcn_readfirstlane(pn); u.type = __builtin_amdgcn_readfirstlane(type);
        return true;
    }
    __device__ __forceinline__ int nt(const Unit& u) const { return u.type ? 4 : 16; }
    __device__ __forceinline__ bool brk(const Unit& a, const Unit& b) const { return a.type == 0 && b.type == 1; }
    __device__ __forceinline__ const char* baseA(const Unit& u) const {
        return u.type ? (const char*)(ws + O_H) + (size_t)(u.base + u.mt * 256) * 256 * 2 : (const char*)(ws + O_T);
    }
    __device__ __forceinline__ const char* baseB(const Unit& u) const {
        return u.type ? (const char*)(ws + O_WD) + ((size_t)u.e * 1024 + u.pn * 256) * 256 * 2 : (const char*)(ws + O_WGU) + (size_t)u.e * 512 * 1024 * 2;
    }
    __device__ __forceinline__ void offs(const Unit& u, int tid_, unsigned (&oa)[2][2], unsigned (&ob)[2][2]) const {
        int R[2], C[2];
        { int tq = tid_; asm volatile("" : "+v"(tq)); g8::stage_rc(tq * 16, R[0], C[0]); g8::stage_rc(tq * 16 + 8192, R[1], C[1]); }
        const int* list = (const int*)(ws + O_LIST) + u.e * 16384;
        int tokv[2][2];
        if (u.type == 0) {
#pragma unroll
            for (int h = 0; h < 2; ++h)
#pragma unroll
                for (int i = 0; i < 2; ++i) { const int idx = u.mt * 256 + h * 128 + R[i]; tokv[h][i] = list[idx < u.cnt ? idx : u.cnt - 1]; }
            __builtin_amdgcn_sched_barrier(0);
        } else {
#pragma unroll
            for (int h = 0; h < 2; ++h)
#pragma unroll
                for (int i = 0; i < 2; ++i) tokv[h][i] = 0;
        }
#pragma unroll
        for (int h = 0; h < 2; ++h)
#pragma unroll
            for (int i = 0; i < 2; ++i) {
                const int Rb = (R[i] & ~31) + g8::perm32(R[i] & 31);
                const int tok = tokv[h][i] >> 1;
                if (u.type == 0) {
                    oa[h][i] = (unsigned)(tok * 1024 + C[i]) * 2u;
                    ob[h][i] = (unsigned)((h * 256 + u.pn * 128 + Rb) * 1024 + C[i]) * 2u;
                } else {
                    oa[h][i] = (unsigned)((h * 128 + R[i]) * 256 + C[i]) * 2u;
                    ob[h][i] = (unsigned)((h * 128 + Rb) * 256 + C[i]) * 2u;
                }
            }
    }
    __device__ __forceinline__ void mid(g8::Acc&, const Unit&, int, int) const {}
    __device__ __forceinline__ void a_ready(const Unit& u) const {
        if (u.type == 0) return;
        if (threadIdx.x < 64) {
            unsigned* rdy = (unsigned*)(ws + O_RDY) + u.mtg * 64;
            unsigned spins = 0;
            while ((unsigned)__builtin_amdgcn_readfirstlane(__hip_atomic_load(rdy, __ATOMIC_RELAXED, __HIP_MEMORY_SCOPE_AGENT)) < 16u) {
                __builtin_amdgcn_s_sleep(2);
                if (++spins > (1u << 22)) break;
            }
            __builtin_amdgcn_fence(__ATOMIC_ACQUIRE, "agent");
            asm volatile("s_waitcnt vmcnt(0)" ::: "memory");
        }
        asm volatile("" ::: "memory"); __builtin_amdgcn_s_barrier(); asm volatile("" ::: "memory");
    }
    __device__ __forceinline__ void done(const Unit& u) const {
        if (u.type != 0) return;
        asm volatile("s_waitcnt vmcnt(0)" ::: "memory");
        if ((threadIdx.x & 63) == 0) __hip_atomic_fetch_add((unsigned*)(ws + O_RDY) + u.mtg * 64, 1u, __ATOMIC_RELAXED, __HIP_MEMORY_SCOPE_AGENT);
    }
    __device__ __forceinline__ void epi(g8::Acc& acc, const Unit& u, int wr, int wc, int fr, int fq) const {
        if (u.type == 0) {
            __amdgpu_buffer_rsrc_t rs = __builtin_amdgcn_make_buffer_rsrc((void*)(ws + O_H), 0, (int)((32768 + 256) * 256 * 2), 0x00020000);
#pragma unroll
            for (int ai = 0; ai < 2; ++ai)
#pragma unroll
                for (int m = 0; m < 4; ++m) {
                    const int idx = u.mt * 256 + ai * 128 + wr * 64 + m * 16 + fr;
                    const f32x4 g0 = acc[ai][0][m][0], g1 = acc[ai][0][m][1], u0 = acc[ai][1][m][0], u1 = acc[ai][1][m][1];
                    u32x4 o;
                    o.x = g8::cvt_pk_bf16(siluf(g0[0]) * u0[0], siluf(g0[1]) * u0[1]); o.y = g8::cvt_pk_bf16(siluf(g0[2]) * u0[2], siluf(g0[3]) * u0[3]);
                    o.z = g8::cvt_pk_bf16(siluf(g1[0]) * u1[0], siluf(g1[1]) * u1[1]); o.w = g8::cvt_pk_bf16(siluf(g1[2]) * u1[2], siluf(g1[3]) * u1[3]);
                    const unsigned off = idx < u.cnt ? ((unsigned)(u.base + idx) * 256u + (unsigned)(u.pn * 128 + wc * 32 + 8 * fq)) * 2u : 0xF0000000u;
                    __builtin_amdgcn_raw_buffer_store_b128(o, rs, off, 0, 16);
                    __builtin_amdgcn_sched_barrier(0);
                }
            return;
        }
        const int* list = (const int*)(ws + O_LIST) + u.e * 16384;
        const float* wts = (const float*)(ws + O_WTS);
        __amdgpu_buffer_rsrc_t rsl = __builtin_amdgcn_make_buffer_rsrc((void*)(ws + O_SL), 0, (int)(16384 * 2 * 1024 * 2), 0x00020000);
        int ent[2][4]; float wg[2][4];
#pragma unroll
        for (int ai = 0; ai < 2; ++ai)
#pragma unroll
            for (int m = 0; m < 4; ++m) {
                const int idx = u.mt * 256 + ai * 128 + wr * 64 + m * 16 + fr;
                ent[ai][m] = list[idx < u.cnt ? idx : u.cnt - 1];
            }
#pragma unroll
        for (int ai = 0; ai < 2; ++ai)
#pragma unroll
            for (int m = 0; m < 4; ++m) wg[ai][m] = wts[ent[ai][m]];
#pragma unroll
        for (int ai = 0; ai < 2; ++ai)
#pragma unroll
            for (int m = 0; m < 4; ++m) {
                const int idx = u.mt * 256 + ai * 128 + wr * 64 + m * 16 + fr;
                const unsigned off = idx < u.cnt ? ((unsigned)ent[ai][m] * 1024u + (unsigned)(u.pn * 256 + wc * 32 + 8 * fq)) * 2u : 0xF0000000u;
#pragma unroll
                for (int bj = 0; bj < 2; ++bj) {
                    const f32x4 v0 = acc[ai][bj][m][0] * wg[ai][m], v1 = acc[ai][bj][m][1] * wg[ai][m];
                    u32x4 o; o.x = g8::cvt_pk_bf16(v0[0], v0[1]); o.y = g8::cvt_pk_bf16(v0[2], v0[3]); o.z = g8::cvt_pk_bf16(v1[0], v1[1]); o.w = g8::cvt_pk_bf16(v1[2], v1[3]);
                    __builtin_amdgcn_raw_buffer_store_b128(o, rsl, off + bj * 256u, 0, 0);
                }
            }
    }
};
__device__ void phase9(const Params& P, char* lds) {
    int* pre_t = (int*)(lds + g8::STAGE_BYTES); int* pre_c = pre_t + 40;
    moe_prefix(P.ws, pre_t, pre_c);
    Moe S; S.ws = P.ws; S.pre_t = pre_t; S.pre_c = pre_c; S.G = gridDim.x; S.c = blockIdx.x;
    int i = 0;
    while (i >= 0) i = g8::gemm_phase<Moe>((LAS unsigned char*)lds, S, i);
}

__device__ void phase11(const Params& P) {
    unsigned char* ws = P.ws;
    const int lane = threadIdx.x & 63;
    const int gw = blockIdx.x * 8 + (threadIdx.x >> 6), nw = gridDim.x * 8;
    const float* mod = (const float*)(ws + O_MOD);
    const u16* SL = (const u16*)(ws + O_SL);
    const int r_lo = (int)(((long long)gw * MLAT) / nw), r_hi = (int)(((long long)(gw + 1) * MLAT) / nw);
    float4 g2[4], fw[4];
    int cur_b = -1;
#pragma unroll
    for (int j = 0; j < 4; ++j) fw[j] = *(const float4*)(P.in[I_FNW] + (lane + 64 * j) * 4);
    for (int row = r_lo; row < r_hi; row += 2) {
        const bool two = row + 1 < r_hi;
        const int row1 = two ? row + 1 : row;
        float4 v0[4], v1[4]; uint2 a0[4], a1[4], b0[4], b1[4];
#pragma unroll
        for (int j = 0; j < 4; ++j) {
            const int k = (lane + 64 * j) * 4;
            { const f32x4 q0 = __builtin_nontemporal_load((const f32x4*)(P.out + (size_t)row * 1024 + k)), q1 = __builtin_nontemporal_load((const f32x4*)(P.out + (size_t)row1 * 1024 + k));
              v0[j] = make_float4(q0[0], q0[1], q0[2], q0[3]); v1[j] = make_float4(q1[0], q1[1], q1[2], q1[3]); }
            typedef __attribute__((ext_vector_type(2))) unsigned u32x2;
            { const u32x2 w0 = __builtin_nontemporal_load((const u32x2*)(SL + (size_t)(row * 2) * 1024 + k)), w1 = __builtin_nontemporal_load((const u32x2*)(SL + (size_t)(row * 2 + 1) * 1024 + k));
              const u32x2 w2 = __builtin_nontemporal_load((const u32x2*)(SL + (size_t)(row1 * 2) * 1024 + k)), w3 = __builtin_nontemporal_load((const u32x2*)(SL + (size_t)(row1 * 2 + 1) * 1024 + k));
              a0[j] = make_uint2(w0[0], w0[1]); a1[j] = make_uint2(w1[0], w1[1]); b0[j] = make_uint2(w2[0], w2[1]); b1[j] = make_uint2(w3[0], w3[1]); }
        }
#pragma unroll 1
        for (int rr = 0; rr < 2; ++rr) {
            const int orow = rr ? row1 : row;
            const int b = orow >> 12;
            if (b != cur_b) {
                cur_b = b;
#pragma unroll
                for (int j = 0; j < 4; ++j) g2[j] = *(const float4*)(mod + b * 6144 + 5120 + (lane + 64 * j) * 4);
            }
            if (rr == 1 && !two) break;
            float4 x[4]; float ss = 0.f;
#pragma unroll
            for (int j = 0; j < 4; ++j) {
                const float4 vv = rr ? v1[j] : v0[j];
                const uint2 s0 = rr ? b0[j] : a0[j], s1 = rr ? b1[j] : a1[j];
                x[j].x = vv.x + g2[j].x * (bflo(s0.x) + bflo(s1.x));
                x[j].y = vv.y + g2[j].y * (bfhi(s0.x) + bfhi(s1.x));
                x[j].z = vv.z + g2[j].z * (bflo(s0.y) + bflo(s1.y));
                x[j].w = vv.w + g2[j].w * (bfhi(s0.y) + bfhi(s1.y));
                ss += x[j].x * x[j].x + x[j].y * x[j].y + x[j].z * x[j].z + x[j].w * x[j].w;
            }
            const float rstd = rsqrtf(wave_sum(ss) * (1.f / 1024.f) + 1e-6f);
#pragma unroll
            for (int j = 0; j < 4; ++j) {
                float4 o; o.x = x[j].x * rstd * fw[j].x; o.y = x[j].y * rstd * fw[j].y; o.z = x[j].z * rstd * fw[j].z; o.w = x[j].w * rstd * fw[j].w;
                __builtin_nontemporal_store((f32x4){o.x, o.y, o.z, o.w}, (f32x4*)(P.out + (size_t)orow * 1024 + (lane + 64 * j) * 4));
            }
        }
    }
}

__global__ void __launch_bounds__(NTB, 2) fwd_kernel(Params P) {
    extern __shared__ __attribute__((aligned(16))) char lds[];
    if (threadIdx.x < 4) ((volatile LAS unsigned*)(lds + LDS_MAIN))[threadIdx.x] = 0u;
    __syncthreads();
    XcdBarrier xbar = xcd_barrier_post((unsigned*)(P.ws + O_BAR), (volatile LAS unsigned*)(lds + LDS_MAIN));
#define SYNC() xcd_barrier(xbar)
#ifdef ONLY_PH
#define RUN_PHASE(k, call) do { if ((k) == ONLY_PH) { call; } } while (0)
#else
#define RUN_PHASE(k, call) do { if (P.lo <= (k) && (k) < P.hi) { call; if ((k) + 1 < P.hi) { SYNC(); } } } while (0)
#endif
    RUN_PHASE(0, phase0(P, lds));
    RUN_PHASE(1, phase1(P));
    RUN_PHASE(2, { InProj S; S.ws = P.ws; S.G = gridDim.x; S.c = blockIdx.x; g8::gemm_phase<InProj>((LAS unsigned char*)lds, S); });
    RUN_PHASE(3, phase3(P, lds));
    RUN_PHASE(4, phase4(P, lds));
    RUN_PHASE(5, phase5(P));
    RUN_PHASE(6, phase6(P, lds));
    RUN_PHASE(7, phase7(P, lds));
    RUN_PHASE(8, phase8(P, lds));
    RUN_PHASE(9, phase9(P, lds));
    RUN_PHASE(11, phase11(P));
}

extern "C" void kernel_launch(void* const* d_in, const int* in_sizes, int n_in, void* d_out, int out_size, void* d_ws, size_t ws_size,
                              hipStream_t stream) {
    static int grid_blocks = 0;
    if (!grid_blocks) {
        int dev = 0, cus = 0, per_cu = 0;
        (void)hipGetDevice(&dev);
        (void)hipDeviceGetAttribute(&cus, hipDeviceAttributeMultiprocessorCount, dev);
        (void)hipFuncSetAttribute((const void*)fwd_kernel, hipFuncAttributeMaxDynamicSharedMemorySize, LDS_BYTES);
        (void)hipOccupancyMaxActiveBlocksPerMultiprocessor(&per_cu, (const void*)fwd_kernel, NTB, LDS_BYTES);
        if (per_cu < 1) fprintf(stderr, "occupancy query says %d blocks per CU\n", per_cu);
        grid_blocks = cus;
        if (ws_size < WS_END) fprintf(stderr, "workspace too small: %zu < %zu\n", ws_size, (size_t)WS_END);
    }
    Params p{};
    for (int i = 0; i < 30; ++i) p.in[i] = (const float*)d_in[i];
    p.out = (float*)d_out; p.ws = (unsigned char*)d_ws;
    p.lo = 0; p.hi = NPHASE;
    (void)hipMemsetAsync((char*)d_ws + O_BAR, 0, 16384 + 40960, stream);
    void* args[] = {&p};
    hipError_t e = hipLaunchCooperativeKernel((const void*)fwd_kernel, dim3(grid_blocks), dim3(NTB), args, LDS_BYTES, stream);
    if (e != hipSuccess) fprintf(stderr, "cooperative launch failed: %s (grid %d)\n", hipGetErrorString(e), grid_blocks);
}
```

```cpp
#include <hip/hip_runtime.h>
#include <cstdio>
#include <cstdint>

typedef unsigned short u16;
typedef __attribute__((ext_vector_type(8))) short bf16x8;
typedef __attribute__((ext_vector_type(4))) float f32x4;
typedef __attribute__((ext_vector_type(4))) unsigned u32x4;
#define LAS __attribute__((address_space(3)))

constexpr int NTB = 512;
constexpr int VLDS = 75776;
constexpr int LDS_MAIN = 2 * VLDS;
constexpr int LDS_BYTES = LDS_MAIN + 256;
constexpr int MLAT = 16384, MALL = 17408;
constexpr int NCH = 34;
constexpr int NPHASE = 12;

enum { I_X = 0, I_C, I_CTX, I_CCTX, I_WMOD, I_BMOD, I_N1W, I_WIN, I_SCW, I_SCB, I_DTB, I_ALOG, I_SSDD, I_SNW, I_MCW, I_MCB, I_WQK, I_GB,
       I_MNW, I_MSKIP, I_WOUT, I_N2W, I_RGW, I_RGB, I_REW, I_REB, I_WG, I_WU, I_WD, I_FNW };

constexpr size_t al(size_t x) { return (x + 255) & ~(size_t)255; }
constexpr size_t O_MOD = 0;
constexpr size_t O_SSQ = O_MOD + al(5 * 6144 * 4);
constexpr size_t O_CNT = O_SSQ + al(16384 * 16 * 4);
constexpr size_t O_BAR = O_CNT + 8192;
constexpr size_t O_RDY = O_BAR + 16384;
constexpr size_t O_PSD = O_RDY + 40960;
constexpr size_t O_PSG = O_PSD + al((size_t)MALL * 16 * 4);
constexpr size_t O_DT = O_PSG + al((size_t)MALL * 16 * 4);
constexpr size_t O_GI = O_DT + al((size_t)MALL * 16 * 4);
constexpr size_t O_GF = O_GI + al((size_t)MALL * 8 * 4);
constexpr size_t O_ACH = O_GF + al((size_t)MALL * 8 * 4);
constexpr size_t O_MLS = O_ACH + 16384;
constexpr size_t O_MLP = O_MLS + 16384;
constexpr size_t O_MLN = O_MLP + 16384;
constexpr size_t O_LIST = O_MLN + al(4 * 34 * 4 * 2 * 128 * 4);
constexpr size_t O_WTS = O_LIST + al(32 * 16384 * 4);
constexpr size_t O_WIN = O_WTS + al(16384 * 2 * 4);
constexpr size_t O_WOUT = O_WIN + al((size_t)3328 * 1024 * 2);
constexpr size_t O_A = O_WOUT + al((size_t)1024 * 1024 * 2);
constexpr size_t SZ_A = (size_t)MALL * 1024 * 2;
constexpr size_t O_PT = O_A + SZ_A;
constexpr size_t SZ_PT = (size_t)MALL * 1536 * 2;
constexpr size_t O_MLC1 = O_PT + SZ_PT;
constexpr size_t SZ_HALF = (size_t)MALL * 512 * 2;
constexpr size_t O_ZO = O_MLC1 + SZ_HALF;
constexpr size_t O_VT = O_ZO + SZ_A;
constexpr size_t O_BM = O_VT + SZ_HALF;
constexpr size_t SZ_Q = (size_t)MALL * 256 * 2;
constexpr size_t O_BT = O_BM + SZ_Q;
constexpr size_t O_CM = O_BT + SZ_Q;
constexpr size_t O_XT = O_CM + SZ_Q;
constexpr size_t O_KT = O_XT + SZ_HALF;
constexpr size_t O_XC = O_KT + SZ_HALF;
constexpr size_t O_DUMP = O_XC + SZ_HALF;
constexpr size_t WS_END = O_DUMP + 256 * 2048;
constexpr size_t O_XN = O_A, O_Q = O_A, O_K = O_A + SZ_HALF, O_T = O_A;
constexpr size_t O_ST = O_PT;
constexpr size_t O_MLC0 = O_PT + (size_t)4 * 34 * 8 * 2 * 8192 * 2;
constexpr size_t O_WGU = O_PT;
constexpr size_t O_WD = O_PT + (size_t)32 * 512 * 1024 * 2;
constexpr size_t O_SL = O_ZO;
constexpr size_t O_H = O_XT;
static_assert(O_WD + (size_t)32 * 1024 * 256 * 2 <= O_MLC1, "moe weights fit PT region");
static_assert(O_SL + (size_t)16384 * 2 * 1024 * 2 <= O_CM, "slots fit");
static_assert((size_t)(32768 + 256) * 256 * 2 <= SZ_HALF, "H fits");
static_assert(WS_END <= (size_t)256 * 1024 * 1024, "workspace");
constexpr size_t TCTX512 = (size_t)4 * 512 * 4096;
constexpr size_t TCTX256 = (size_t)4 * 256 * 4096;

struct Params { const float* in[30]; float* out; unsigned char* ws; int lo, hi; };

#define XB_TMO      128
#define XB_XCNT(j)  (256  + 64 * (j))
#define XB_XSUB(j)  (1280 + 64 * (j))
#define XB_XGEN(j)  (2304 + 64 * (j))
#define XB_TOP      3328
#define XB_TOPGEN   3392
#define XCD_BAR_WORDS 3456
#define XB_SPIN_CAP (1u << 20)
__device__ __forceinline__ unsigned xb_ld(unsigned* p)              { return __hip_atomic_load(p, __ATOMIC_RELAXED, __HIP_MEMORY_SCOPE_AGENT); }
__device__ __forceinline__ unsigned xb_add(unsigned* p, unsigned v) { return __hip_atomic_fetch_add(p, v, __ATOMIC_RELAXED, __HIP_MEMORY_SCOPE_AGENT); }
__device__ __forceinline__ unsigned xb_xcc_id() { return (unsigned)__builtin_amdgcn_s_getreg((3 << 11) | 20) & 0xFu; }
#define XB_SPIN(cond, bar) do { unsigned _sp = 0; while (cond) { __builtin_amdgcn_s_sleep(1); \
    if ((++_sp & 255u) == 0u) { if (xb_ld(&(bar)[XB_TMO])) break; if (_sp > XB_SPIN_CAP) { atomicAdd(&(bar)[XB_TMO], 1u); break; } } } } while (0)
struct XcdBarrier { unsigned* bar; unsigned x; volatile LAS unsigned* st; };
__device__ __forceinline__ XcdBarrier xcd_barrier_post(unsigned* bar, volatile LAS unsigned* st) {
    XcdBarrier b; b.bar = bar; b.x = xb_xcc_id(); b.st = st;
    if (threadIdx.x == 0) (void)xb_add(&bar[XB_XCNT(b.x)], 1u);
    return b;
}
__device__ __forceinline__ void xcd_barrier_complete(unsigned* bar, unsigned x, unsigned& nloc, unsigned& nx) {
    const unsigned G = gridDim.x * gridDim.y * gridDim.z;
    unsigned sum, cnt, mine, sp = 0u;
    for (;;) {
        sum = 0u; cnt = 0u; mine = 0u;
#pragma unroll
        for (unsigned j = 0; j < 16; ++j) { const unsigned c = xb_ld(&bar[XB_XCNT(j)]); sum += c; cnt += (c > 0u) ? 1u : 0u; mine = (j == x) ? c : mine; }
        if (sum == G) break;
        __builtin_amdgcn_s_sleep(1);
        if ((++sp & 255u) == 0u) { if (xb_ld(&bar[XB_TMO])) break; if (sp > XB_SPIN_CAP) { atomicAdd(&bar[XB_TMO], 1u); break; } }
    }
    nloc = mine > 0u ? mine : 1u; nx = cnt > 0u ? cnt : 1u;
}
__device__ __forceinline__ void xcd_barrier(const XcdBarrier& b) {
    asm volatile("s_waitcnt vmcnt(0)" ::: "memory");
    __syncthreads();
    if (threadIdx.x == 0) {
        unsigned* bar = b.bar;
        __builtin_amdgcn_s_waitcnt(0);
        unsigned nloc = b.st[0], nx = b.st[1];
        if (nloc == 0u) { xcd_barrier_complete(bar, b.x, nloc, nx); b.st[0] = nloc; b.st[1] = nx; }
        const unsigned old = xb_add(&bar[XB_XSUB(b.x)], 1u);
        const unsigned gen = old / nloc;
        if (old + 1u == (gen + 1u) * nloc) {
            __builtin_amdgcn_fence(__ATOMIC_RELEASE, "agent");
            asm volatile("s_waitcnt vmcnt(0)" ::: "memory");
            const unsigned og = xb_add(&bar[XB_TOP], 1u);
            const unsigned tg = og / nx;
            if (og + 1u == (tg + 1u) * nx) xb_add(&bar[XB_TOPGEN], 1u);
            else XB_SPIN(xb_ld(&bar[XB_TOPGEN]) == tg, bar);
            __builtin_amdgcn_fence(__ATOMIC_ACQUIRE, "agent");
            xb_add(&bar[XB_XGEN(b.x)], 1u);
            asm volatile("s_waitcnt vmcnt(0)" ::: "memory");
        } else {
            XB_SPIN(xb_ld(&bar[XB_XGEN(b.x)]) == gen, bar);
            __builtin_amdgcn_fence(__ATOMIC_ACQUIRE, "agent");
            asm volatile("s_waitcnt vmcnt(0)" ::: "memory");
        }
    }
    __syncthreads();
}

__device__ __forceinline__ u16 f2bf(float f) { unsigned u = __float_as_uint(f); u += 0x7fffu + ((u >> 16) & 1u); return (u16)(u >> 16); }
__device__ __forceinline__ float bf2f(u16 h) { return __uint_as_float(((unsigned)h) << 16); }
__device__ __forceinline__ unsigned pack2(float a, float b) { return (unsigned)f2bf(a) | ((unsigned)f2bf(b) << 16); }
__device__ __forceinline__ float bflo(unsigned u) { return __uint_as_float(u << 16); }
__device__ __forceinline__ float bfhi(unsigned u) { return __uint_as_float(u & 0xffff0000u); }
__device__ __forceinline__ float siluf(float x) { return x / (1.f + __expf(-x)); }
__device__ __forceinline__ float sigmf(float x) { return 1.f / (1.f + __expf(-x)); }
__device__ __forceinline__ float softplusf(float x) { return x > 20.f ? x : log1pf(__expf(x)); }
__device__ __forceinline__ float wave_sum(float v) {
#pragma unroll
    for (int o = 32; o > 0; o >>= 1) v += __shfl_xor(v, o);
    return v;
}
__device__ __forceinline__ int swz256(int row, int chunk) { return row * 256 + ((chunk ^ (row & 15)) << 4); }
__device__ __forceinline__ int colmajor_src_row(int R) {
    if (R >= MLAT) return R;
    const int b = R >> 12, lp = R & 4095;
    return (b << 12) + ((lp & 63) << 6) + (lp >> 6);
}

__device__ __forceinline__ void load_tile128(char* lds, int lrow0, const u16* __restrict__ g, size_t ld, int rows, int t, int nthr) {
#pragma unroll 4
    for (int q = t; q < rows * 16; q += nthr) {
        const int r = q >> 4, c = q & 15;
        const uint4 v = *(const uint4*)(g + (size_t)r * ld + c * 8);
        *(uint4*)(lds + swz256(lrow0 + r, c)) = v;
    }
}
__device__ __forceinline__ void load_tile128_scaled(char* lds, int lrow0, const u16* __restrict__ g, size_t ld, int rows, const float* w, int t, int nthr) {
#pragma unroll 2
    for (int q = t; q < rows * 16; q += nthr) {
        const int r = q >> 4, c = q & 15;
        const uint4 v = *(const uint4*)(g + (size_t)r * ld + c * 8);
        const float* ww = w + c * 8;
        uint4 o;
        o.x = pack2(bflo(v.x) * ww[0], bfhi(v.x) * ww[1]);
        o.y = pack2(bflo(v.y) * ww[2], bfhi(v.y) * ww[3]);
        o.z = pack2(bflo(v.z) * ww[4], bfhi(v.z) * ww[5]);
        o.w = pack2(bflo(v.w) * ww[6], bfhi(v.w) * ww[7]);
        *(uint4*)(lds + swz256(lrow0 + r, c)) = o;
    }
}
template <int MI, int NJ>
__device__ __forceinline__ void lds_mma(const char* A, const char* B, int arow0, int brow0, f32x4 (&acc)[MI][NJ], int lane) {
#pragma unroll 1
    for (int kk = 0; kk < 4; ++kk) {
        const int chunk = kk * 4 + (lane >> 4);
        bf16x8 a[MI], b[NJ];
#pragma unroll
        for (int i = 0; i < MI; ++i) { const int row = arow0 + i * 16 + (lane & 15); a[i] = *(const bf16x8*)(A + swz256(row, chunk)); }
#pragma unroll
        for (int j = 0; j < NJ; ++j) { const int row = brow0 + j * 16 + (lane & 15); b[j] = *(const bf16x8*)(B + swz256(row, chunk)); }
#pragma unroll
        for (int i = 0; i < MI; ++i)
#pragma unroll
            for (int j = 0; j < NJ; ++j) acc[i][j] = __builtin_amdgcn_mfma_f32_16x16x32_bf16(a[i], b[j], acc[i][j], 0, 0, 0);
    }
}
template <int MI, int NJ>
__device__ __forceinline__ void lds_mma_t(const char* A, const char* B, int arow0, int brow0, f32x4 (&acc)[MI][NJ], int lane) {
#pragma unroll 1
    for (int kk = 0; kk < 4; ++kk) {
        const int chunk = kk * 4 + (lane >> 4);
        bf16x8 a[MI], b[NJ];
#pragma unroll
        for (int i = 0; i < MI; ++i) { const int row = arow0 + i * 16 + (lane & 15); a[i] = *(const bf16x8*)(A + swz256(row, chunk)); }
#pragma unroll
        for (int j = 0; j < NJ; ++j) { const int row = brow0 + j * 16 + (lane & 15); b[j] = *(const bf16x8*)(B + swz256(row, chunk)); }
#pragma unroll
        for (int i = 0; i < MI; ++i)
#pragma unroll
            for (int j = 0; j < NJ; ++j) acc[i][j] = __builtin_amdgcn_mfma_f32_16x16x32_bf16(b[j], a[i], acc[i][j], 0, 0, 0);
    }
}
template <int MI, int NJ>
__device__ __forceinline__ void zero_acc(f32x4 (&acc)[MI][NJ]) {
#pragma unroll
    for (int i = 0; i < MI; ++i)
#pragma unroll
        for (int j = 0; j < NJ; ++j) acc[i][j] = f32x4{0.f, 0.f, 0.f, 0.f};
}
template <int OP>
__device__ __forceinline__ float scan_pair(float v, float* buf, int t) {
    const int idx = t & 127, base = t & 128;
    const bool act = t < 256;
    if (act) buf[t] = v;
    __syncthreads();
#pragma unroll 1
    for (int off = 1; off < 128; off <<= 1) {
        float o = OP ? -INFINITY : 0.f;
        if (act && idx >= off) o = buf[base + idx - off];
        __syncthreads();
        v = OP ? fmaxf(v, o) : v + o;
        if (act) buf[t] = v;
        __syncthreads();
    }
    return v;
}

__device__ __forceinline__ float wave_scan_sum(float v, int lane) {
#pragma unroll
    for (int off = 1; off < 64; off <<= 1) { const float o = __shfl_up(v, off); if (lane >= off) v += o; }
    return v;
}
__device__ __forceinline__ float wave_scan_max(float v, int lane) {
#pragma unroll
    for (int off = 1; off < 64; off <<= 1) { const float o = __shfl_up(v, off); if (lane >= off) v = fmaxf(v, o); }
    return v;
}
__device__ __forceinline__ float wave_max(float v) {
#pragma unroll
    for (int o = 32; o > 0; o >>= 1) v = fmaxf(v, __shfl_xor(v, o));
    return v;
}
__device__ __forceinline__ void transpose_tile(float* tile, const float* __restrict__ src, int ld_src, int k0, int n0, int ncount,
                                               u16* dst, size_t dst_row0, int ld_dst, const float* __restrict__ scale, int scale_kmax, int t) {
    const int n = t & 63, kq = t >> 6;
    const int nc = n < ncount ? n : ncount - 1;
    float vv[16];
#pragma unroll
    for (int i = 0; i < 16; ++i) vv[i] = src[(size_t)(k0 + i * 4 + kq) * ld_src + n0 + nc];
#pragma unroll
    for (int i = 0; i < 16; ++i) {
        const int k = i * 4 + kq;
        float v = vv[i];
        if (scale && (k0 + k) < scale_kmax) v *= scale[k0 + k];
        tile[k * 65 + n] = n < ncount ? v : 0.f;
    }
    __syncthreads();
#pragma unroll
    for (int i = 0; i < 2; ++i) {
        const int q = t + 256 * i, nn = q >> 3, kc = q & 7;
        if (nn < ncount) {
            const float* p = tile + (kc * 8) * 65 + nn;
            uint4 o;
            o.x = pack2(p[0], p[65]); o.y = pack2(p[130], p[195]); o.z = pack2(p[260], p[325]); o.w = pack2(p[390], p[455]);
            *(uint4*)(dst + (dst_row0 + nn) * (size_t)ld_dst + k0 + kc * 8) = o;
        }
    }
    __syncthreads();
}

__device__ __forceinline__ void transpose_tile_w(float* tile, const float* __restrict__ src, int ld_src, int k0, int n0,
                                                 u16* dst, size_t dst_row0, int ld_dst, const float* __restrict__ scale, int scale_kmax, int t) {
    f32x4 v[8]; float scv[8];
#pragma unroll
    for (int i = 0; i < 8; ++i) {
        const int q = t + 256 * i, kr = q >> 5, nq = q & 31;
        v[i] = __builtin_nontemporal_load((const f32x4*)(src + (size_t)(k0 + kr) * ld_src + n0 + nq * 4));
        scv[i] = 1.f;
        if (scale) { const int kc = (k0 + kr) < scale_kmax ? (k0 + kr) : scale_kmax - 1; const float sv = scale[kc]; scv[i] = (k0 + kr) < scale_kmax ? sv : 1.f; }
    }
    __builtin_amdgcn_sched_barrier(0);
#pragma unroll
    for (int i = 0; i < 8; ++i) {
        const int q = t + 256 * i, kr = q >> 5, nq = q & 31;
        float* p = tile + kr * 129 + nq * 4;
        p[0] = v[i][0] * scv[i]; p[1] = v[i][1] * scv[i]; p[2] = v[i][2] * scv[i]; p[3] = v[i][3] * scv[i];
    }
    __syncthreads();
#pragma unroll
    for (int i = 0; i < 4; ++i) {
        const int q = t + 256 * i, nn = q >> 3, kc = q & 7;
        const float* p = tile + (kc * 8) * 129 + nn;
        uint4 o;
        o.x = pack2(p[0], p[129]); o.y = pack2(p[258], p[387]); o.z = pack2(p[516], p[645]); o.w = pack2(p[774], p[903]);
        *(uint4*)(dst + (dst_row0 + nn) * (size_t)ld_dst + k0 + kc * 8) = o;
    }
    __syncthreads();
}

namespace g8 {
constexpr int BM = 256, BK = 64, HALF = 128, HTB = HALF * BK * 2, STAGE_BYTES = 8 * HTB;
__device__ __forceinline__ int lds_byte(int r, int c) { const int st = (r >> 4) * 2 + (c >> 5), rr = r & 15, cc = c & 31, ob = rr * 64 + cc * 2; return st * 1024 + (ob ^ (((ob >> 9) & 1) << 5)); }
__device__ __forceinline__ void stage_rc(int b, int& R, int& C) { const int st = b / 1024, sb = b % 1024, swz = sb ^ (((sb >> 9) & 1) << 5); R = (st >> 1) * 16 + swz / 64; C = (st & 1) * 32 + (swz % 64) / 2; }
__device__ __forceinline__ int perm32(int rho) { const int n = rho >> 4, i = rho & 15; return 8 * (i >> 2) + 4 * n + (i & 3); }
__device__ __forceinline__ unsigned cvt_pk_bf16(float lo, float hi) { unsigned r; asm volatile("v_cvt_pk_bf16_f32 %0, %1, %2" : "=v"(r) : "v"(lo), "v"(hi)); return r; }
typedef f32x4 Acc[2][2][4][2];

template <class Prob>
__device__ __forceinline__ int gemm_phase(LAS unsigned char* lds, const Prob& S, int i0 = 0) {
    const int tid = threadIdx.x, wid = __builtin_amdgcn_readfirstlane(tid >> 6), lane = tid & 63, wr = wid >> 2, wc = wid & 3, fr = lane & 15, fq = lane >> 4;
    int nt = 0;
    const size_t kstep = (size_t)(BK * 2);
    const unsigned ldsw = (unsigned)wid * 1024u;
    const int aoff = lds_byte(wr * 64 + fr, fq * 8), boff = lds_byte(wc * 32 + fr, fq * 8);
#define G8_SA(b, h) (((b) * 2 + (h)) * HTB)
#define G8_SB(b, h) ((4 + (b) * 2 + (h)) * HTB)
#define G8_STAGE(bufoff, gbase, voff) do { _Pragma("unroll") for (int _i = 0; _i < 2; ++_i) \
        __builtin_amdgcn_global_load_lds((const unsigned*)((const char*)(gbase) + (voff)[_i]), (LAS unsigned*)(lds + (bufoff) + ldsw + _i * 8192), 16, 0, 0); } while (0)
#define G8_LDA(dst, b, h) do { _Pragma("unroll") for (int m = 0; m < 4; ++m) _Pragma("unroll") for (int k = 0; k < 2; ++k) dst[m][k] = *(const LAS bf16x8*)(lds + G8_SA(b, h) + aoff + m * 2048 + k * 1024); } while (0)
#define G8_LDB(dst, b, h) do { _Pragma("unroll") for (int n = 0; n < 2; ++n) _Pragma("unroll") for (int k = 0; k < 2; ++k) dst[n][k] = *(const LAS bf16x8*)(lds + G8_SB(b, h) + boff + n * 2048 + k * 1024); } while (0)
#define G8_MMA(ai, bj, At, Bt) do { __builtin_amdgcn_s_setprio(1); _Pragma("unroll") for (int m = 0; m < 4; ++m) _Pragma("unroll") for (int n = 0; n < 2; ++n) _Pragma("unroll") for (int k = 0; k < 2; ++k) \
        acc[ai][bj][m][n] = __builtin_amdgcn_mfma_f32_16x16x32_bf16(Bt[n][k], At[m][k], acc[ai][bj][m][n], 0, 0, 0); __builtin_amdgcn_s_setprio(0); } while (0)
#define G8_WAIT_V(n) asm volatile("s_waitcnt vmcnt(" #n ")" ::: "memory")
#define G8_WAIT_L(n) asm volatile("s_waitcnt lgkmcnt(" #n ")" ::: "memory")
#define G8_BAR __builtin_amdgcn_s_barrier()
#define G8_SCHED __builtin_amdgcn_sched_barrier(0)
    typename Prob::Unit cur, nxt; int ui = i0; bool stopped = false;
    if (!S.next(i0, cur)) return -1;
    nt = S.nt(cur);
    S.a_ready(cur);
    Acc acc;
#pragma unroll
    for (int a = 0; a < 2; ++a)
#pragma unroll
        for (int b = 0; b < 2; ++b)
#pragma unroll
            for (int m = 0; m < 4; ++m)
#pragma unroll
                for (int n = 0; n < 2; ++n) acc[a][b][m][n] = (f32x4){0.f, 0.f, 0.f, 0.f};
    bf16x8 At[4][2], B0[2][2], B1[2][2];
    unsigned cOA[2][2], cOB[2][2], nOA[2][2], nOB[2][2];
    S.offs(cur, tid, cOA, cOB);
    const char* cA = S.baseA(cur); const char* cB = S.baseB(cur);
    G8_STAGE(G8_SB(0, 0), cB, cOB[0]); G8_STAGE(G8_SA(0, 0), cA, cOA[0]); G8_STAGE(G8_SB(0, 1), cB, cOB[1]); G8_STAGE(G8_SA(0, 1), cA, cOA[1]);
    if (wr == 1) G8_BAR;
    G8_WAIT_V(4); G8_BAR;
    G8_STAGE(G8_SB(1, 0), cB + kstep, cOB[0]); G8_STAGE(G8_SA(1, 0), cA + kstep, cOA[0]); G8_STAGE(G8_SB(1, 1), cB + kstep, cOB[1]);
    G8_WAIT_V(6); G8_BAR;
    for (;;) {
        bool has_next = S.next(ui + 1, nxt);
        if (has_next && S.brk(cur, nxt)) { has_next = false; stopped = true; }
        const char* nA = cA; const char* nB = cB;
#pragma unroll
        for (int h = 0; h < 2; ++h)
#pragma unroll
            for (int i = 0; i < 2; ++i) { nOA[h][i] = cOA[h][i]; nOB[h][i] = cOB[h][i]; }
        if (has_next) { S.offs(nxt, tid, nOA, nOB); nA = S.baseA(nxt); nB = S.baseB(nxt); }
#pragma unroll 1
        for (int t = 0; t < nt; t += 2) {
            const bool last = (t == nt - 2);
            if (Prob::MIDT > 0 && t == Prob::MIDT) S.mid(acc, cur, wr, fr);
            if (last && has_next) S.a_ready(nxt);
            const char* a1 = cA + (size_t)(t + 1) * kstep;
            const char* a2 = last ? nA : cA + (size_t)(t + 2) * kstep; const char* b2 = last ? nB : cB + (size_t)(t + 2) * kstep;
            const char* a3 = a2 + kstep; const char* b3 = b2 + kstep;
            unsigned xA[2][2], xB[2][2];
#pragma unroll
            for (int h = 0; h < 2; ++h)
#pragma unroll
                for (int i = 0; i < 2; ++i) { xA[h][i] = last ? nOA[h][i] : cOA[h][i]; xB[h][i] = last ? nOB[h][i] : cOB[h][i]; }
            G8_LDB(B0, 0, 0); G8_SCHED; G8_LDA(At, 0, 0); G8_STAGE(G8_SA(1, 1), a1, cOA[1]);
            G8_WAIT_L(8); G8_BAR; G8_WAIT_L(0); G8_MMA(0, 0, At, B0); G8_BAR; G8_SCHED;
            G8_LDB(B1, 0, 1); G8_STAGE(G8_SB(0, 0), b2, xB[0]);
            G8_BAR; G8_WAIT_L(0); G8_MMA(0, 1, At, B1); G8_BAR;
            G8_LDA(At, 0, 1); G8_STAGE(G8_SA(0, 0), a2, xA[0]);
            G8_BAR; G8_WAIT_L(0); G8_MMA(1, 0, At, B0); G8_BAR; G8_SCHED;
            G8_STAGE(G8_SB(0, 1), b2, xB[1]);
            G8_WAIT_V(6); G8_BAR; G8_MMA(1, 1, At, B1); G8_BAR;
            G8_LDB(B0, 1, 0); G8_SCHED; G8_LDA(At, 1, 0); G8_STAGE(G8_SA(0, 1), a2, xA[1]);
            G8_WAIT_L(8); G8_BAR; G8_WAIT_L(0); G8_MMA(0, 0, At, B0); G8_BAR; G8_SCHED;
            G8_LDB(B1, 1, 1); G8_STAGE(G8_SB(1, 0), b3, xB[0]);
            G8_BAR; G8_WAIT_L(0); G8_MMA(0, 1, At, B1); G8_BAR;
            G8_LDA(At, 1, 1); G8_STAGE(G8_SA(1, 0), a3, xA[0]);
            G8_BAR; G8_WAIT_L(0); G8_MMA(1, 0, At, B0); G8_BAR; G8_SCHED;
            G8_STAGE(G8_SB(1, 1), b3, xB[1]);
            G8_WAIT_V(6); G8_BAR; G8_MMA(1, 1, At, B1); G8_BAR;
        }
        S.epi(acc, cur, wr, wc, fr, fq);
        S.done(cur);
        if (!has_next) break;
#pragma unroll
        for (int a = 0; a < 2; ++a)
#pragma unroll
            for (int b = 0; b < 2; ++b)
#pragma unroll
                for (int m = 0; m < 4; ++m)
#pragma unroll
                    for (int n = 0; n < 2; ++n) acc[a][b][m][n] = (f32x4){0.f, 0.f, 0.f, 0.f};
        cur = nxt; cA = nA; cB = nB; ++ui; nt = S.nt(cur);
#pragma unroll
        for (int h = 0; h < 2; ++h)
#pragma unroll
            for (int i = 0; i < 2; ++i) { cOA[h][i] = nOA[h][i]; cOB[h][i] = nOB[h][i]; }
    }
    G8_WAIT_V(0);
    if (wr == 0) G8_BAR;
    G8_BAR;
    const int ret_next = stopped ? ui + 1 : -1;
#undef G8_SA
#undef G8_SB
#undef G8_STAGE
#undef G8_LDA
#undef G8_LDB
#undef G8_MMA
#undef G8_WAIT_V
#undef G8_WAIT_L
#undef G8_BAR
#undef G8_SCHED
    return ret_next;
}
__device__ __forceinline__ void dense_unit(int wgid, int nM, int nN, int& pm, int& pn) {
    const int nwg = nM * nN, NXCD = 8, WGM = 8;
    { const int q = nwg / NXCD, r = nwg % NXCD, xcd = wgid % NXCD, off = wgid / NXCD; wgid = (xcd < r ? xcd * (q + 1) : r * (q + 1) + (xcd - r) * q) + off; }
    const int nig = WGM * nN, gid = wgid / nig, fm = gid * WGM, gsz = (nM - fm) < WGM ? (nM - fm) : WGM;
    pm = fm + ((wgid % nig) % gsz); pn = (wgid % nig) / gsz;
}
}

__device__ void phase0(const Params& P, char* lds_all) {
    unsigned char* ws = P.ws;
    const int vb = threadIdx.x >> 8, t = threadIdx.x & 255;
    char* lds = lds_all + vb * VLDS;
    float* tile = (float*)lds;
    const int NU = 744;
    for (int u = blockIdx.x * 2 + vb; u < NU; u += gridDim.x * 2) {
        if (u < 384) {
            int nt, v, n0b, drb;
            if (u < 192) { v = u; n0b = 0; drb = 0; }
            else if (u < 256) { v = u - 192; n0b = 1552; drb = 1536; }
            else if (u < 320) { v = u - 256; n0b = 2576; drb = 2048; }
            else { v = u - 320; n0b = 2064; drb = 2816; }
            nt = v >> 4;
            transpose_tile_w(tile, P.in[I_WIN], 3104, (v & 15) * 64, n0b + nt * 128, (u16*)(ws + O_WIN), drb + nt * 128, 1024, nullptr, 0, t);
        } else if (u < 416) {
            const int v = u - 384;
            if (v < 16) transpose_tile(tile, P.in[I_WIN], 3104, v * 64, 1536, 16, (u16*)(ws + O_WIN), 2560, 1024, nullptr, 0, t);
            else transpose_tile(tile, P.in[I_WIN], 3104, (v - 16) * 64, 3088, 16, (u16*)(ws + O_WIN), 2576, 1024, nullptr, 0, t);
        } else if (u < 544) {
            const int v = u - 416, nt = v >> 4;
            transpose_tile_w(tile, P.in[I_WOUT], 1024, (v & 15) * 64, nt * 128, (u16*)(ws + O_WOUT), nt * 128, 1024, P.in[I_SNW], 512, t);
        } else if (u < 552) {
            const int base = (u - 544) * 4096;
            for (int i = 0; i < 16; ++i) {
                const int idx = base + t + 256 * i;
                if (idx < 224 * 128) *(uint4*)(ws + O_WIN + ((size_t)(2592 + (idx >> 7)) * 1024 + (idx & 127) * 8) * 2) = make_uint4(0, 0, 0, 0);
            }
        } else {
            const int c0 = (u - 552) * 32;
            float* sc = (float*)lds;
            float* red = sc + 5 * 1024;
            {
                float cv[20];
#pragma unroll
                for (int q = 0; q < 20; ++q) cv[q] = q < 16 ? P.in[I_C][t + 256 * q] : P.in[I_CCTX][t + 256 * (q - 16)];
                __builtin_amdgcn_sched_barrier(0);
#pragma unroll
                for (int q = 0; q < 20; ++q) sc[t + 256 * q] = siluf(cv[q]);
            }
            __syncthreads();
            const int cq = t & 7, kg = t >> 3;
            float4 a0 = {0, 0, 0, 0}, a1 = a0, a2 = a0, a3 = a0, a4 = a0;
            const float* wp = P.in[I_WMOD] + (size_t)(kg * 32) * 6144 + c0 + cq * 4;
#pragma unroll 1
            for (int kb = 0; kb < 32; kb += 16) {
                f32x4 wvv[16];
#pragma unroll
                for (int k = 0; k < 16; ++k) wvv[k] = __builtin_nontemporal_load((const f32x4*)(wp + (size_t)(kb + k) * 6144));
                __builtin_amdgcn_sched_barrier(0);
#pragma unroll
                for (int k = 0; k < 16; ++k) {
                    if ((k & 3) == 0) __builtin_amdgcn_sched_barrier(0);
                    const f32x4 wv = wvv[k];
                    const int kk = kg * 32 + kb + k;
                    const float s0 = sc[kk], s1 = sc[1024 + kk], s2 = sc[2048 + kk], s3 = sc[3072 + kk], s4 = sc[4096 + kk];
                    a0.x += s0 * wv[0]; a0.y += s0 * wv[1]; a0.z += s0 * wv[2]; a0.w += s0 * wv[3];
                    a1.x += s1 * wv[0]; a1.y += s1 * wv[1]; a1.z += s1 * wv[2]; a1.w += s1 * wv[3];
                    a2.x += s2 * wv[0]; a2.y += s2 * wv[1]; a2.z += s2 * wv[2]; a2.w += s2 * wv[3];
                    a3.x += s3 * wv[0]; a3.y += s3 * wv[1]; a3.z += s3 * wv[2]; a3.w += s3 * wv[3];
                    a4.x += s4 * wv[0]; a4.y += s4 * wv[1]; a4.z += s4 * wv[2]; a4.w += s4 * wv[3];
                }
                __builtin_amdgcn_sched_barrier(0);
            }
            *(float4*)(red + ((kg * 5 + 0) * 32) + cq * 4) = a0; *(float4*)(red + ((kg * 5 + 1) * 32) + cq * 4) = a1;
            *(float4*)(red + ((kg * 5 + 2) * 32) + cq * 4) = a2; *(float4*)(red + ((kg * 5 + 3) * 32) + cq * 4) = a3;
            *(float4*)(red + ((kg * 5 + 4) * 32) + cq * 4) = a4;
            __syncthreads();
            if (t < 160) {
                const int r = t >> 5, cc = t & 31;
                float s = P.in[I_BMOD][c0 + cc];
#pragma unroll
                for (int g = 0; g < 32; ++g) s += red[(g * 5 + r) * 32 + cc];
                ((float*)(ws + O_MOD))[r * 6144 + c0 + cc] = s;
            }
            __syncthreads();
        }
    }
    if (blockIdx.x == 0 && threadIdx.x < 32) ((int*)(ws + O_CNT))[threadIdx.x * 64] = 0;
}

__device__ void phase1(const Params& P) {
    unsigned char* ws = P.ws;
    const int lane = threadIdx.x & 63;
    const int gw = blockIdx.x * 8 + (threadIdx.x >> 6), nw = gridDim.x * 8;
    const float* mod = (const float*)(ws + O_MOD);
    u16* xn = (u16*)(ws + O_XN);
    const int r_lo = (int)(((long long)gw * MALL) / nw), r_hi = (int)(((long long)(gw + 1) * MALL) / nw);
    float4 mul[4], sh[4];
    int cur_mb = -1;
    for (int row = r_lo; row < r_hi; row += 2) {
        const bool two = row + 1 < r_hi;
        const int row1 = two ? row + 1 : row;
        const float* x0 = row < MLAT ? P.in[I_X] + (size_t)row * 1024 : P.in[I_CTX] + (size_t)(row - MLAT) * 1024;
        const float* x1 = row1 < MLAT ? P.in[I_X] + (size_t)row1 * 1024 : P.in[I_CTX] + (size_t)(row1 - MLAT) * 1024;
        float4 v0[4], v1[4];
#pragma unroll
        for (int j = 0; j < 4; ++j) { const f32x4 a = __builtin_nontemporal_load((const f32x4*)x0 + lane + 64 * j), c = __builtin_nontemporal_load((const f32x4*)x1 + lane + 64 * j);
            v0[j] = make_float4(a[0], a[1], a[2], a[3]); v1[j] = make_float4(c[0], c[1], c[2], c[3]); }
        const int mb0 = row < MLAT ? (row >> 12) : 4, mb1 = row1 < MLAT ? (row1 >> 12) : 4;
        float s0 = 0.f, s1 = 0.f;
#pragma unroll
        for (int j = 0; j < 4; ++j) {
            s0 += v0[j].x * v0[j].x + v0[j].y * v0[j].y + v0[j].z * v0[j].z + v0[j].w * v0[j].w;
            s1 += v1[j].x * v1[j].x + v1[j].y * v1[j].y + v1[j].z * v1[j].z + v1[j].w * v1[j].w;
        }
        s0 = rsqrtf(wave_sum(s0) * (1.f / 1024.f) + 1e-6f);
        s1 = rsqrtf(wave_sum(s1) * (1.f / 1024.f) + 1e-6f);
#pragma unroll 1
        for (int rr = 0; rr < 2; ++rr) {
            const int mb = rr ? mb1 : mb0;
            if (mb != cur_mb) {
                cur_mb = mb;
#pragma unroll
                for (int j = 0; j < 4; ++j) {
                    const int k = (lane + 64 * j) * 4;
                    const float4 nwv = *(const float4*)(P.in[I_N1W] + k);
                    const float4 sc = *(const float4*)(mod + mb * 6144 + 1024 + k);
                    sh[j] = *(const float4*)(mod + mb * 6144 + k);
                    mul[j].x = nwv.x * (1.f + sc.x); mul[j].y = nwv.y * (1.f + sc.y); mul[j].z = nwv.z * (1.f + sc.z); mul[j].w = nwv.w * (1.f + sc.w);
                }
            }
            if (rr == 1 && !two) break;
            const float rstd = rr ? s1 : s0;
            const int orow = rr ? row1 : row;
#pragma unroll
            for (int j = 0; j < 4; ++j) {
                const int k = (lane + 64 * j) * 4;
                const float4 vv = rr ? v1[j] : v0[j];
                uint2 o;
                o.x = pack2(vv.x * rstd * mul[j].x + sh[j].x, vv.y * rstd * mul[j].y + sh[j].y);
                o.y = pack2(vv.z * rstd * mul[j].z + sh[j].z, vv.w * rstd * mul[j].w + sh[j].w);
                *(uint2*)(xn + (size_t)orow * 1024 + k) = o;
            }
        }
    }
}

struct InProj {
    static constexpr int K = 1024; static constexpr bool PERM = true; static constexpr int MIDT = 0;
    struct Unit { int pm, pn, vt; };
    const unsigned char* ws; int G, c;
    __device__ __forceinline__ bool next(int i, Unit& u) const {
        const int L = i * G + c;
        if (L >= 884) return false;
        if (L < 748) { u.vt = 0; g8::dense_unit(L, 68, 11, u.pm, u.pn); }
        else { const int v = L - 748; u.vt = 1; u.pm = v / 68; u.pn = v % 68; }
        return true;
    }
    __device__ __forceinline__ const char* baseA(const Unit& u) const { return (const char*)(ws + (u.vt ? O_WIN : O_XN)); }
    __device__ __forceinline__ const char* baseB(const Unit& u) const { return (const char*)(ws + (u.vt ? O_XN : O_WIN)); }
    __device__ __forceinline__ void offs(const Unit& u, int tid_, unsigned (&oa)[2][2], unsigned (&ob)[2][2]) const {
        int R[2], C[2];
        { int tq = tid_; asm volatile("" : "+v"(tq)); g8::stage_rc(tq * 16, R[0], C[0]); g8::stage_rc(tq * 16 + 8192, R[1], C[1]); }
#pragma unroll
        for (int h = 0; h < 2; ++h)
#pragma unroll
            for (int i = 0; i < 2; ++i) {
                const int Rb = (R[i] & ~31) + g8::perm32(R[i] & 31);
                if (!u.vt) {
                    int ar = u.pm * 256 + h * 128 + R[i];
                    if (u.pn == 6 || u.pn == 7) ar = colmajor_src_row(ar);
                    oa[h][i] = (unsigned)(ar * 1024 + C[i]) * 2u;
                    ob[h][i] = (unsigned)((u.pn * 256 + h * 128 + Rb) * 1024 + C[i]) * 2u;
                } else {
                    oa[h][i] = (unsigned)((2816 + u.pm * 256 + h * 128 + R[i]) * 1024 + C[i]) * 2u;
                    ob[h][i] = (unsigned)(colmajor_src_row(u.pn * 256 + h * 128 + Rb) * 1024 + C[i]) * 2u;
                }
            }
    }
    __device__ __forceinline__ void mid(g8::Acc&, const Unit&, int, int) const {}
    __device__ __forceinline__ int nt(const Unit&) const { return 16; }
    __device__ __forceinline__ bool brk(const Unit&, const Unit&) const { return false; }
    __device__ __forceinline__ void a_ready(const Unit&) const {}
    __device__ __forceinline__ void done(const Unit&) const {}
    __device__ __forceinline__ void epi(g8::Acc& acc, const Unit& u, int wr, int wc, int fr, int fq) const {
        unsigned char* w = (unsigned char*)ws;
        const int row0 = u.pm * 256 + wr * 64 + fr;
        const int col0 = wc * 32 + 8 * fq;
        if (u.vt) {
            const int tok0 = u.pn * 256 + col0;
#pragma unroll
            for (int ai = 0; ai < 2; ++ai)
#pragma unroll
                for (int m = 0; m < 4; ++m) {
                    const int ch = row0 + ai * 128 + m * 16;
#pragma unroll
                    for (int bj = 0; bj < 2; ++bj) {
                        const int tk = tok0 + bj * 128;
                        u16* d;
                        int ctile, lw;
                        if (tk < MLAT) { ctile = (tk >> 12) * NCH + 2 + ((tk & 4095) >> 7); lw = tk & 127; }
                        else { const int tc = tk - MLAT; ctile = (tc >> 8) * NCH + ((tc & 255) >> 7); lw = tc & 127; }
                        d = (u16*)(w + O_VT) + ((size_t)ctile * 512 + ch) * 128 + lw;
                        const f32x4 v0 = acc[ai][bj][m][0], v1 = acc[ai][bj][m][1];
                        u32x4 o; o.x = g8::cvt_pk_bf16(v0[0], v0[1]); o.y = g8::cvt_pk_bf16(v0[2], v0[3]); o.z = g8::cvt_pk_bf16(v1[0], v1[1]); o.w = g8::cvt_pk_bf16(v1[2], v1[3]);
                        *(u32x4*)d = o;
                    }
                }
            return;
        }
        if (u.pn == 10) {
            if (wc == 0) {
                float* dst = (float*)(w + (fq < 2 ? O_PSD : O_PSG)) + (fq & 1) * 8;
#pragma unroll
                for (int ai = 0; ai < 2; ++ai)
#pragma unroll
                    for (int m = 0; m < 4; ++m) {
                        float* d = dst + (size_t)(row0 + ai * 128 + m * 16) * 16;
                        *(f32x4*)d = acc[ai][0][m][0];
                        *(f32x4*)(d + 4) = acc[ai][0][m][1];
                    }
            }
            return;
        }
        u16* base; size_t ld, bjstep;
        if (u.pn < 2) { base = (u16*)(w + O_ZO) + u.pn * 256 + col0; ld = 1024; bjstep = 128; }
        else if (u.pn < 8) {
            const int cg0 = (u.pn - 2) * 4 + (col0 >> 6);
            base = (u16*)(w + O_PT) + (size_t)cg0 * MALL * 64 + (col0 & 63); ld = 64; bjstep = (size_t)2 * MALL * 64;
        }
        else { base = (u16*)(w + O_ZO) + 512 + (u.pn - 8) * 256 + col0; ld = 1024; bjstep = 128; }
#pragma unroll
        for (int ai = 0; ai < 2; ++ai)
#pragma unroll
            for (int m = 0; m < 4; ++m) {
                u16* rowp = base + (size_t)(row0 + ai * 128 + m * 16) * ld;
#pragma unroll
                for (int bj = 0; bj < 2; ++bj) {
                    const f32x4 v0 = acc[ai][bj][m][0], v1 = acc[ai][bj][m][1];
                    u32x4 o; o.x = g8::cvt_pk_bf16(v0[0], v0[1]); o.y = g8::cvt_pk_bf16(v0[2], v0[3]); o.z = g8::cvt_pk_bf16(v1[0], v1[1]); o.w = g8::cvt_pk_bf16(v1[2], v1[3]);
                    *(u32x4*)(rowp + bj * bjstep) = o;
                }
            }
    }
};

__device__ void phase3(const Params& P, char* lds_all) {
    unsigned char* ws = P.ws;
    const int vb = threadIdx.x >> 8, t = threadIdx.x & 255;
    char* lds = lds_all + vb * VLDS;
    u16* raw = (u16*)lds;
    float* xcl = (float*)(lds + 132 * 128);
    const u16* pt = (const u16*)(ws + O_PT);
    const int NCONV = 136 * 24;
    for (int ct = blockIdx.x * 2 + vb; ct < 136; ct += gridDim.x * 2) {
        const int b = ct / NCH, cc = ct % NCH;
        const int rb = cc < 2 ? MLAT + b * 256 + cc * 128 : b * 4096 + (cc - 2) * 128;
        const int row = rb + (t >> 1), half = t & 1;
        const float* psd = (const float*)(ws + O_PSD) + (size_t)row * 16 + half * 8;
        float* dt = (float*)(ws + O_DT) + (size_t)row * 16 + half * 8;
        const float4 pa = *(const float4*)psd, pb = *(const float4*)(psd + 4);
        const float* psg = (const float*)(ws + O_PSG) + (size_t)colmajor_src_row(row) * 16 + half * 8;
        const float4 ga = *(const float4*)psg, gb = *(const float4*)(psg + 4);
        const float pv[8] = {pa.x, pa.y, pa.z, pa.w, pb.x, pb.y, pb.z, pb.w}, gv[8] = {ga.x, ga.y, ga.z, ga.w, gb.x, gb.y, gb.z, gb.w};
        const float4 db0 = *(const float4*)(P.in[I_DTB] + half * 8), db1 = *(const float4*)(P.in[I_DTB] + half * 8 + 4);
        const float4 gb0 = *(const float4*)(P.in[I_GB] + half * 8), gb1 = *(const float4*)(P.in[I_GB] + half * 8 + 4);
        const float dbv[8] = {db0.x, db0.y, db0.z, db0.w, db1.x, db1.y, db1.z, db1.w}, gbv[8] = {gb0.x, gb0.y, gb0.z, gb0.w, gb1.x, gb1.y, gb1.z, gb1.w};
        float od[8], og[8];
#pragma unroll
        for (int j = 0; j < 8; ++j) {
            od[j] = softplusf(pv[j] + dbv[j]);
            const float xx = gv[j] + gbv[j];
            og[j] = half == 0 ? xx : fminf(xx, 0.f) - log1pf(__expf(-fabsf(xx)));
        }
        *(float4*)dt = make_float4(od[0], od[1], od[2], od[3]); *(float4*)(dt + 4) = make_float4(od[4], od[5], od[6], od[7]);
        float* gout = (float*)(ws + (half == 0 ? O_GI : O_GF)) + (size_t)row * 8;
        *(float4*)gout = make_float4(og[0], og[1], og[2], og[3]); *(float4*)(gout + 4) = make_float4(og[4], og[5], og[6], og[7]);
    }
    u32x4 rr[5];
#define P3_PREFETCH(uu) do { \
        const int _u = (uu), _ct = _u / 24, _cg = _u % 24, _b = _ct / NCH, _cc = _ct % NCH; const bool _ctx = _cc < 2; \
        const int _L = _ctx ? 256 : 4096, _lpos = _ctx ? _cc * 128 : (_cc - 2) * 128, _rb = _ctx ? MLAT + _b * 256 + _cc * 128 : _b * 4096 + (_cc - 2) * 128, _sb = _rb - _lpos; \
        _Pragma("unroll") for (int _i = 0; _i < 5; ++_i) { const int _q = t + 256 * _i, _r = (_q >> 3) < 132 ? (_q >> 3) : 131, _c = _q & 7; \
            const int _l = _lpos - 2 + _r, _lc = _l < 0 ? 0 : (_l >= _L ? _L - 1 : _l); \
            u32x4 _v = *(const u32x4*)(pt + ((size_t)_cg * MALL + _sb + _lc) * 64 + _c * 8); \
            if (_l != _lc) _v = (u32x4){0u, 0u, 0u, 0u}; \
            rr[_i] = _v; } \
    } while (0)
    if ((int)(blockIdx.x * 2 + vb) < NCONV) P3_PREFETCH(blockIdx.x * 2 + vb);
    for (int u = blockIdx.x * 2 + vb; u < NCONV; u += gridDim.x * 2) {
        const int ct = u / 24, cgp = u % 24;
        const int b = ct / NCH, cc = ct % NCH;
        const bool isctx = cc < 2;
        const int rb = isctx ? MLAT + b * 256 + cc * 128 : b * 4096 + (cc - 2) * 128;
        const bool isml = cgp >= 16;
#pragma unroll
        for (int i = 0; i < 5; ++i) { const int q = t + 256 * i; if (q < 132 * 8) *(u32x4*)(raw + (q >> 3) * 64 + (q & 7) * 8) = rr[i]; }
        __syncthreads();
        if (u + (int)gridDim.x * 2 < NCONV) P3_PREFETCH(u + gridDim.x * 2);
        const int ch = t & 63, tg = t >> 6;
        const float* cw = isml ? P.in[I_MCW] + (cgp - 16) * 64 + ch : P.in[I_SCW] + cgp * 64 + ch;
        const int cwld = isml ? 512 : 1024;
        const float w0 = cw[0], w1 = cw[cwld], w2 = cw[2 * cwld], w3 = cw[3 * cwld], w4 = cw[4 * cwld];
        const float bias = isml ? P.in[I_MCB][(cgp - 16) * 64 + ch] : P.in[I_SCB][cgp * 64 + ch];
        const int tok0 = tg * 32;
        float x0 = bf2f(raw[(tok0 + 0) * 64 + ch]), x1 = bf2f(raw[(tok0 + 1) * 64 + ch]), x2 = bf2f(raw[(tok0 + 2) * 64 + ch]), x3 = bf2f(raw[(tok0 + 3) * 64 + ch]);
        if (!isml) {
            float ov[32];
#pragma unroll
            for (int j = 0; j < 32; ++j) {
                const float x4 = bf2f(raw[(tok0 + j + 4) * 64 + ch]);
                const float cv = bias + w0 * x0 + w1 * x1 + w2 * x2 + w3 * x3 + w4 * x4;
                ov[j] = siluf(cv);
                x0 = x1; x1 = x2; x2 = x3; x3 = x4;
            }
            if (cgp < 12) {
                const int chg = cgp < 8 ? cgp * 64 + ch : (cgp - 8) * 64 + ch;
                u16* tdst = cgp < 8 ? (u16*)(ws + O_XT) + ((size_t)ct * 512 + chg) * 128 + tok0 : (u16*)(ws + O_BT) + ((size_t)ct * 256 + chg) * 128 + tok0;
#pragma unroll
                for (int o8 = 0; o8 < 4; ++o8) {
                    u32x4 o; o.x = pack2(ov[o8 * 8 + 0], ov[o8 * 8 + 1]); o.y = pack2(ov[o8 * 8 + 2], ov[o8 * 8 + 3]); o.z = pack2(ov[o8 * 8 + 4], ov[o8 * 8 + 5]); o.w = pack2(ov[o8 * 8 + 6], ov[o8 * 8 + 7]);
                    *(u32x4*)(tdst + o8 * 8) = o;
                }
            }
            if (cgp >= 8) {
                const int gn = (cgp < 12 ? cgp - 8 : cgp - 12) * 64 + ch;
                u16* ndst = (u16*)(ws + (cgp < 12 ? O_BM : O_CM)) + ((size_t)ct * 2 + (gn >> 7)) * 16384 + (size_t)tok0 * 128 + (gn & 127);
#pragma unroll
                for (int j = 0; j < 32; ++j) ndst[(size_t)j * 128] = f2bf(ov[j]);
            }
            __syncthreads();
        } else {
            const int mg = cgp - 16;
            const int n = ch >> 2, kk = ch & 3, ng = mg * 16 + n;
            const float* wq = P.in[I_WQK] + ((size_t)(0 * 128 + ng) * 4) * 4 + kk;
            const float* wk = P.in[I_WQK] + ((size_t)(1 * 128 + ng) * 4) * 4 + kk;
            const float q0 = wq[0], q1 = wq[4], q2 = wq[8], q3 = wq[12];
            const float k0 = wk[0], k1 = wk[4], k2 = wk[8], k3 = wk[12];
            u16* xcd = (u16*)(ws + O_XC) + ((size_t)ct * 4 + (mg >> 1)) * 16384 + (size_t)tok0 * 128 + (mg & 1) * 64 + ch;
#pragma unroll 8
            for (int j = 0; j < 32; ++j) {
                const int tok = tok0 + j;
                const float x4 = bf2f(raw[(tok + 4) * 64 + ch]);
                const float cv = bias + w0 * x0 + w1 * x1 + w2 * x2 + w3 * x3 + w4 * x4;
                const float sv = siluf(cv);
                xcl[tok * 64 + ch] = sv;
                xcd[(size_t)j * 128] = f2bf(sv);
                x0 = x1; x1 = x2; x2 = x3; x3 = x4;
            }
            __syncthreads();
            const int chg = mg * 64 + ch;
            const size_t hoff = ((size_t)ct * 4 + (mg >> 1)) * 16384 + (size_t)tok0 * 128 + (mg & 1) * 64 + ch;
            u16* qd = (u16*)(ws + O_Q) + hoff;
            u16* kd = (u16*)(ws + O_K) + hoff;
            u16* ktd = (u16*)(ws + O_KT) + ((size_t)ct * 512 + chg) * 128 + tok0;
#pragma unroll
            for (int o8 = 0; o8 < 4; ++o8) {
                float kv[8];
#pragma unroll
                for (int j = 0; j < 8; ++j) {
                    const int tok = tok0 + o8 * 8 + j;
                    const float4 xv = *(const float4*)(xcl + tok * 64 + n * 4);
                    const float qv = xv.x * q0 + xv.y * q1 + xv.z * q2 + xv.w * q3;
                    kv[j] = (xv.x * k0 + xv.y * k1 + xv.z * k2 + xv.w * k3) * 0.08838834764831845f;
                    qd[(size_t)(o8 * 8 + j) * 128] = f2bf(qv);
                    kd[(size_t)(o8 * 8 + j) * 128] = f2bf(kv[j]);
                }
                uint4 o; o.x = pack2(kv[0], kv[1]); o.y = pack2(kv[2], kv[3]); o.z = pack2(kv[4], kv[5]); o.w = pack2(kv[6], kv[7]);
                *(uint4*)(ktd + o8 * 8) = o;
            }
            __syncthreads();
        }
    }
}

__device__ __forceinline__ u32x4 scale8(const u32x4 v, const float* ww) {
    u32x4 o;
    o.x = pack2(bflo(v.x) * ww[0], bfhi(v.x) * ww[1]); o.y = pack2(bflo(v.y) * ww[2], bfhi(v.y) * ww[3]);
    o.z = pack2(bflo(v.z) * ww[4], bfhi(v.z) * ww[5]); o.w = pack2(bflo(v.w) * ww[6], bfhi(v.w) * ww[7]);
    return o;
}
__device__ void phase4(const Params& P, char* lds) {
    unsigned char* ws = P.ws;
    char* T0 = lds; char* T1 = lds + 32768;
    float* sc = (float*)(lds + 65536);
    float* wA = sc + 256;
    float* wB = sc + 384;
    const int NSSD = 4 * NCH * 8, NML = 4 * NCH * 4, NU4 = NSSD + NML;
    u32x4 RA[4], RB[4];
    float ps0 = 0.f, ps1 = 0.f, ps2 = 0.f, ps3 = 0.f;
#define P4_PREFETCH(uu) do { \
        const int _u = (uu); const bool _ssd = _u < NSSD; const int _v = _ssd ? _u : _u - NSSD; \
        const int _h = _ssd ? (_v & 7) : (_v & 3), _ct = _ssd ? (_v >> 3) : (_v >> 2), _b = _ct / NCH, _cc = _ct % NCH; \
        const int _rb = _cc < 2 ? MLAT + _b * 256 + _cc * 128 : _b * 4096 + (_cc - 2) * 128; \
        const u16* _pa = _ssd ? (const u16*)(ws + O_XT) + ((size_t)_ct * 512 + _h * 64) * 128 : (const u16*)(ws + O_VT) + ((size_t)_ct * 512 + _h * 128) * 128; \
        const u16* _pb = _ssd ? (const u16*)(ws + O_BT) + ((size_t)_ct * 256 + (_h >> 2) * 128) * 128 : (const u16*)(ws + O_KT) + ((size_t)_ct * 512 + _h * 128) * 128; \
        _Pragma("unroll") for (int _i = 0; _i < 4; ++_i) { const int _q = (int)threadIdx.x + 512 * _i; const size_t _o = (size_t)(_q >> 4) * 128 + (_q & 15) * 8; \
            RA[_i] = *(const u32x4*)(_pa + _o); RB[_i] = *(const u32x4*)(_pb + _o); } \
        if (threadIdx.x < 128) { const int _dir = threadIdx.x >> 6, _ln = threadIdx.x & 63; const int _l0 = _dir ? 127 - 2 * _ln : 2 * _ln, _l1 = _dir ? 126 - 2 * _ln : 2 * _ln + 1; \
            if (_ssd) { const float* _dp = (const float*)(ws + O_DT) + (size_t)_rb * 16 + _dir * 8 + _h; ps0 = _dp[_l0 * 16]; ps1 = _dp[_l1 * 16]; } \
            else { const float* _gf = (const float*)(ws + O_GF) + (size_t)_rb * 8 + _dir * 4 + _h; const float* _gi = (const float*)(ws + O_GI) + (size_t)_rb * 8 + _dir * 4 + _h; \
                   ps0 = _gf[_l0 * 8]; ps1 = _gf[_l1 * 8]; ps2 = _gi[_l0 * 8]; ps3 = _gi[_l1 * 8]; } } \
    } while (0)
    if ((int)blockIdx.x < NU4) P4_PREFETCH(blockIdx.x);
    for (int u = blockIdx.x; u < NU4; u += gridDim.x) {
        int t = threadIdx.x; asm volatile("" : "+v"(t));
        const int lane = t & 63, w = t >> 6, wm = w >> 1, wn = w & 1, lr = lane & 15, lq = lane >> 4;
        const bool isssd = u < NSSD;
        const int v = isssd ? u : u - NSSD;
        const int h = isssd ? (v & 7) : (v & 3), ct = isssd ? (v >> 3) : (v >> 2), b = ct / NCH, cc = ct % NCH;
        const int un = u + (int)gridDim.x;
        if (isssd) {
            if (w < 2) {
                const int dir = w;
                const int l0 = dir ? 127 - 2 * lane : 2 * lane, l1 = dir ? 126 - 2 * lane : 2 * lane + 1;
                const float d0 = ps0, d1 = ps1;
                const float an = -__expf(P.in[I_ALOG][dir * 8 + h]);
                const float p0 = d0 * an, p1 = p0 + d1 * an;
                const float inc = wave_scan_sum(p1, lane);
                const float ex = inc - p1;
                const float tot = __shfl(inc, 63);
                float* wd = dir ? wB : wA;
                wd[l0] = __expf(tot - (ex + p0)) * d0; wd[l1] = __expf(tot - (ex + p1)) * d1;
                if (lane == 0) ((float*)(ws + O_ACH))[((size_t)(b * NCH + cc) * 8 + h) * 2 + dir] = tot;
            }
            __syncthreads();
#pragma unroll
            for (int i = 0; i < 2; ++i) {
                const int q = t + 512 * i, r = q >> 4, c = q & 15;
                *(u32x4*)(T0 + swz256(r, c)) = scale8(RA[i], wA + c * 8); *(u32x4*)(T0 + swz256(64 + r, c)) = scale8(RA[i], wB + c * 8);
            }
#pragma unroll
            for (int i = 0; i < 4; ++i) { const int q = t + 512 * i, r = q >> 4, c = q & 15; *(u32x4*)(T1 + swz256(r, c)) = RB[i]; }
            __syncthreads();
            if (un < NU4) P4_PREFETCH(un);
            f32x4 acc[2][4]; zero_acc(acc);
            lds_mma_t<2, 4>(T0, T1, wm * 32, wn * 64, acc, lane);
            u16* st = (u16*)(ws + O_ST) + (((size_t)(b * NCH + cc) * 8 + h) * 2 + (wm >> 1)) * 8192 + ((wm & 1) * 32 + lr) * 128 + wn * 64 + lq * 4;
#pragma unroll
            for (int i = 0; i < 2; ++i)
#pragma unroll
                for (int j = 0; j < 4; ++j) {
                    uint2 o; o.x = pack2(acc[i][j][0], acc[i][j][1]); o.y = pack2(acc[i][j][2], acc[i][j][3]);
                    *(uint2*)(st + (i * 16) * 128 + j * 16) = o;
                }
            __syncthreads();
        } else {
            if (w < 2) {
                const int dir = w;
                const int s0 = dir ? 127 - 2 * lane : 2 * lane, s1 = dir ? 126 - 2 * lane : 2 * lane + 1;
                const float f0 = ps0, f1 = ps1, i0 = ps2, i1 = ps3;
                const float p1 = f0 + f1;
                const float inc = wave_scan_sum(p1, lane);
                const float ex = inc - p1;
                const float tot = __shfl(inc, 63);
                const float av0 = tot - (ex + f0) + i0, av1 = tot - (ex + p1) + i1;
                const float mloc = wave_max(fmaxf(av0, av1));
                float* wd = dir ? wB : wA;
                wd[s0] = __expf(av0 - mloc); wd[s1] = __expf(av1 - mloc);
                if (lane == 0) {
                    float* mls = (float*)(ws + O_MLS) + (((size_t)(b * NCH + cc) * 4 + h) * 2 + dir) * 2;
                    mls[0] = mloc; mls[1] = tot;
                }
            }
            __syncthreads();
#pragma unroll
            for (int d2 = 0; d2 < 2; ++d2) {
                const float* wsel = d2 ? wB : wA;
#pragma unroll
                for (int i = 0; i < 4; ++i) { const int q = t + 512 * i, r = q >> 4, c = q & 15; *(u32x4*)(T0 + swz256(r, c)) = scale8(RA[i], wsel + c * 8); }
                if (d2 == 0) {
#pragma unroll
                    for (int i = 0; i < 4; ++i) { const int q = t + 512 * i, r = q >> 4, c = q & 15; *(u32x4*)(T1 + swz256(r, c)) = RB[i]; }
                }
                __syncthreads();
                if (d2 == 1 && un < NU4) P4_PREFETCH(un);
                f32x4 acc[2][4]; zero_acc(acc);
                lds_mma_t<2, 4>(T0, T1, wm * 32, wn * 64, acc, lane);
                u16* cst = (u16*)(ws + (d2 ? O_MLC1 : O_MLC0)) + ((size_t)(b * NCH + cc) * 4 + h) * 16384 + (wm * 32 + lr) * 128 + wn * 64 + lq * 4;
#pragma unroll
                for (int i = 0; i < 2; ++i)
#pragma unroll
                    for (int j = 0; j < 4; ++j) {
                        uint2 o; o.x = pack2(acc[i][j][0], acc[i][j][1]); o.y = pack2(acc[i][j][2], acc[i][j][3]);
                        *(uint2*)(cst + (i * 16) * 128 + j * 16) = o;
                    }
                if (d2 == 0 && t < 256) {
                    const int dir = t >> 7, idx = t & 127;
                    const float* wgt = dir ? wB : wA;
                    float nacc = 0.f;
#pragma unroll 4
                    for (int c = 0; c < 16; ++c) {
                        const uint4 kv = *(const uint4*)(T1 + swz256(idx, c));
                        const float* ww = wgt + c * 8;
                        nacc += bflo(kv.x) * ww[0] + bfhi(kv.x) * ww[1] + bflo(kv.y) * ww[2] + bfhi(kv.y) * ww[3]
                              + bflo(kv.z) * ww[4] + bfhi(kv.z) * ww[5] + bflo(kv.w) * ww[6] + bfhi(kv.w) * ww[7];
                    }
                    ((float*)(ws + O_MLN))[(((size_t)(b * NCH + cc) * 4 + h) * 2 + dir) * 128 + idx] = nacc;
                }
                __syncthreads();
            }
        }
    }
}

__device__ __forceinline__ int scan_cc(int dir, int step) { return dir == 0 ? step : (step < 2 ? 1 - step : 35 - step); }
__device__ void phase5(const Params& P) {
    unsigned char* ws = P.ws;
    const int vb = threadIdx.x >> 8, t = threadIdx.x & 255;
    for (int u = blockIdx.x * 2 + vb; u < 256 + 256 + 32; u += gridDim.x * 2) {
        if (u < 256) {
            const int chain = u >> 2, part = u & 3;
            const int b = chain >> 4, h = (chain >> 1) & 7, dir = chain & 1;
            const int off = part * 2048 + t * 8;
            float S[8];
#pragma unroll
            for (int j = 0; j < 8; ++j) S[j] = 0.f;
#pragma unroll 1
            for (int sb = 0; sb < NCH; sb += 17) {
                u32x4 lv[17]; float dc[17];
#pragma unroll
                for (int q = 0; q < 17; ++q) {
                    const int cc = scan_cc(dir, sb + q);
                    lv[q] = *(const u32x4*)((const u16*)(ws + O_ST) + (((size_t)(b * NCH + cc) * 8 + h) * 2 + dir) * 8192 + off);
                    dc[q] = ((const float*)(ws + O_ACH))[((size_t)(b * NCH + cc) * 8 + h) * 2 + dir];
                }
                __builtin_amdgcn_sched_barrier(0);
#pragma unroll
                for (int q = 0; q < 17; ++q) {
                    const int cc = scan_cc(dir, sb + q);
                    u16* p = (u16*)(ws + O_ST) + (((size_t)(b * NCH + cc) * 8 + h) * 2 + dir) * 8192 + off;
                    const float dec = __expf(dc[q]);
                    u32x4 o; o.x = pack2(S[0], S[1]); o.y = pack2(S[2], S[3]); o.z = pack2(S[4], S[5]); o.w = pack2(S[6], S[7]);
                    *(u32x4*)p = o;
                    S[0] = dec * S[0] + bflo(lv[q].x); S[1] = dec * S[1] + bfhi(lv[q].x); S[2] = dec * S[2] + bflo(lv[q].y); S[3] = dec * S[3] + bfhi(lv[q].y);
                    S[4] = dec * S[4] + bflo(lv[q].z); S[5] = dec * S[5] + bfhi(lv[q].z); S[6] = dec * S[6] + bflo(lv[q].w); S[7] = dec * S[7] + bfhi(lv[q].w);
                }
                __builtin_amdgcn_sched_barrier(0);
            }
        } else if (u < 512) {
            const int v = u - 256;
            const int chain = v >> 3, part = v & 7;
            const int b = chain >> 3, h = (chain >> 1) & 3, dir = chain & 1;
            const int off = part * 2048 + t * 8;
            float S[8];
#pragma unroll
            for (int j = 0; j < 8; ++j) S[j] = 0.f;
            float m = -1e30f;
#pragma unroll 1
            for (int sb = 0; sb < NCH; sb += 17) {
                u32x4 lv[17]; float mlv[17], blv[17];
#pragma unroll
                for (int q = 0; q < 17; ++q) {
                    const int cc = scan_cc(dir, sb + q);
                    lv[q] = *(const u32x4*)((const u16*)(ws + (dir ? O_MLC1 : O_MLC0)) + ((size_t)(b * NCH + cc) * 4 + h) * 16384 + off);
                    const float* mls = (const float*)(ws + O_MLS) + (((size_t)(b * NCH + cc) * 4 + h) * 2 + dir) * 2;
                    mlv[q] = mls[0]; blv[q] = mls[1];
                }
                __builtin_amdgcn_sched_barrier(0);
#pragma unroll
                for (int q = 0; q < 17; ++q) {
                    const int cc = scan_cc(dir, sb + q);
                    u16* p = (u16*)(ws + (dir ? O_MLC1 : O_MLC0)) + ((size_t)(b * NCH + cc) * 4 + h) * 16384 + off;
                    const float ml = mlv[q], bl = blv[q];
                    const float mn = fmaxf(bl + m, ml);
                    const float sp = __expf(bl + m - mn), sl = __expf(ml - mn);
                    if (part == 0 && t == 0) ((float*)(ws + O_MLP))[((size_t)(b * NCH + cc) * 4 + h) * 2 + dir] = m;
                    u32x4 o; o.x = pack2(S[0], S[1]); o.y = pack2(S[2], S[3]); o.z = pack2(S[4], S[5]); o.w = pack2(S[6], S[7]);
                    *(u32x4*)p = o;
                    S[0] = sp * S[0] + sl * bflo(lv[q].x); S[1] = sp * S[1] + sl * bfhi(lv[q].x); S[2] = sp * S[2] + sl * bflo(lv[q].y); S[3] = sp * S[3] + sl * bfhi(lv[q].y);
                    S[4] = sp * S[4] + sl * bflo(lv[q].z); S[5] = sp * S[5] + sl * bfhi(lv[q].z); S[6] = sp * S[6] + sl * bflo(lv[q].w); S[7] = sp * S[7] + sl * bfhi(lv[q].w);
                    m = mn;
                }
                __builtin_amdgcn_sched_barrier(0);
            }
        } else {
            const int chain = u - 512;
            const int b = chain >> 3, h = (chain >> 1) & 3, dir = chain & 1;
            if (t < 128) {
                float nS = 0.f, m = -1e30f;
#pragma unroll 1
                for (int sb = 0; sb < NCH; sb += 17) {
                    float lvv[17], mlv[17], blv[17];
#pragma unroll
                    for (int q = 0; q < 17; ++q) {
                        const int cc = scan_cc(dir, sb + q);
                        lvv[q] = ((const float*)(ws + O_MLN))[(((size_t)(b * NCH + cc) * 4 + h) * 2 + dir) * 128 + t];
                        const float* mls = (const float*)(ws + O_MLS) + (((size_t)(b * NCH + cc) * 4 + h) * 2 + dir) * 2;
                        mlv[q] = mls[0]; blv[q] = mls[1];
                    }
                    __builtin_amdgcn_sched_barrier(0);
#pragma unroll
                    for (int q = 0; q < 17; ++q) {
                        const int cc = scan_cc(dir, sb + q);
                        float* p = (float*)(ws + O_MLN) + (((size_t)(b * NCH + cc) * 4 + h) * 2 + dir) * 128 + t;
                        const float mn = fmaxf(blv[q] + m, mlv[q]);
                        const float sp = __expf(blv[q] + m - mn), sl = __expf(mlv[q] - mn);
                        *p = nS;
                        nS = sp * nS + sl * lvv[q];
                        m = mn;
                    }
                    __builtin_amdgcn_sched_barrier(0);
                }
            }
        }
    }
}

__device__ void phase6(const Params& P, char* lds) {
    unsigned char* ws = P.ws;
    char* T0 = lds; char* T1 = lds + 32768; char* T2 = lds + 65536; char* T3 = lds + 98304;
    float* sc = (float*)(lds + 131072);
    float* sbuf = sc;
    float* a0 = sc + 256;
    float* a1 = sc + 384;
    float* a2 = sc + 512;
    float* a3 = sc + 640;
    float* a4 = sc + 768;
    float* a5 = sc + 896;
    float* rsA = sc + 1024;
    float* qn = sc + 1536;
    float* fac = sc + 1792;
    float* wfac = sc + 2048;
    const int NSSD = 4 * 32 * 8, NML = 4 * 32 * 4, NU6 = NSSD + NML;
    u32x4 R0[4], R1[4], R2[4], R3[4];
    float ps0 = 0.f, ps1 = 0.f, ps2 = 0.f, ps3 = 0.f;
#define P6_PREFETCH(uu) do { \
        const int _u = (uu); const bool _ssd = _u < NSSD; const int _v = _ssd ? _u : _u - NSSD; \
        const int _h = _ssd ? (_v & 7) : (_v & 3), _ct = _ssd ? (_v >> 3) : (_v >> 2), _b = _ct >> 5, _c = _ct & 31, _cc = _c + 2; \
        const size_t _ctile = (size_t)(_b * NCH + _cc); const int _rb = _b * 4096 + _c * 128; \
        const u16 *_p0, *_p1, *_p2, *_p3; \
        if (_ssd) { const int _g = _h >> 2; _p0 = (const u16*)(ws + O_CM) + (_ctile * 2 + _g) * 16384; _p1 = (const u16*)(ws + O_BM) + (_ctile * 2 + _g) * 16384; \
                    _p2 = (const u16*)(ws + O_ST) + ((_ctile * 8 + _h) * 2) * 8192; _p3 = (const u16*)(ws + O_XT) + (_ctile * 512 + _h * 64) * 128; } \
        else { _p0 = (const u16*)(ws + O_Q) + (_ctile * 4 + _h) * 16384; _p1 = (const u16*)(ws + O_K) + (_ctile * 4 + _h) * 16384; \
               _p2 = (const u16*)(ws + O_MLC0) + (_ctile * 4 + _h) * 16384; _p3 = (const u16*)(ws + O_MLC1) + (_ctile * 4 + _h) * 16384; } \
        _Pragma("unroll") for (int _i = 0; _i < 4; ++_i) { const int _q = (int)threadIdx.x + 512 * _i; const size_t _o = (size_t)(_q >> 4) * 128 + (_q & 15) * 8; \
            R0[_i] = *(const u32x4*)(_p0 + _o); R1[_i] = *(const u32x4*)(_p1 + _o); R2[_i] = *(const u32x4*)(_p2 + _o); R3[_i] = *(const u32x4*)(_p3 + _o); } \
        if (threadIdx.x < 128) { const int _dir = threadIdx.x >> 6, _ln = threadIdx.x & 63; \
            const int _l0 = _dir ? 127 - 2 * _ln : 2 * _ln, _l1 = _dir ? 126 - 2 * _ln : 2 * _ln + 1; \
            if (_ssd) { const float* _dp = (const float*)(ws + O_DT) + (size_t)_rb * 16 + _dir * 8 + _h; ps0 = _dp[_l0 * 16]; ps1 = _dp[_l1 * 16]; } \
            else { const float* _gf = (const float*)(ws + O_GF) + (size_t)_rb * 8 + _dir * 4 + _h; const float* _gi = (const float*)(ws + O_GI) + (size_t)_rb * 8 + _dir * 4 + _h; \
                   ps0 = _gf[_l0 * 8]; ps1 = _gf[_l1 * 8]; ps2 = _gi[_l0 * 8]; ps3 = _gi[_l1 * 8]; } } \
    } while (0)
    if ((int)blockIdx.x < NU6) P6_PREFETCH(blockIdx.x);
    for (int u = blockIdx.x; u < NU6; u += gridDim.x) {
        int t = threadIdx.x; asm volatile("" : "+v"(t));
        const int lane = t & 63, w = t >> 6, wm = w >> 1, wn = w & 1;
        const bool isssd = u < NSSD;
        const int v = isssd ? u : u - NSSD;
        const int h = isssd ? (v & 7) : (v & 3), ct = isssd ? (v >> 3) : (v >> 2), b = ct >> 5, c = ct & 31, cc = c + 2;
        const int rb = b * 4096 + c * 128, lpos = c * 128;
        const float mp0 = isssd ? 0.f : ((const float*)(ws + O_MLP))[((size_t)(b * NCH + cc) * 4 + h) * 2 + 0];
        const float mp1 = isssd ? 0.f : ((const float*)(ws + O_MLP))[((size_t)(b * NCH + cc) * 4 + h) * 2 + 1];
        if (w < 2) {
            const int dir = w;
            const int l0 = dir ? 127 - 2 * lane : 2 * lane, l1 = dir ? 126 - 2 * lane : 2 * lane + 1;
            if (isssd) {
                const float d0 = ps0, d1 = ps1;
                const float an = -__expf(P.in[I_ALOG][dir * 8 + h]);
                const float p0 = d0 * an, p1 = p0 + d1 * an;
                const float inc = wave_scan_sum(p1, lane);
                const float ex = inc - p1;
                float* ca = dir ? a1 : a0; float* da = dir ? a3 : a2;
                ca[l0] = ex + p0; ca[l1] = ex + p1; da[l0] = d0; da[l1] = d1;
            } else {
                const float f0 = ps0, f1 = ps1, i0 = ps2, i1 = ps3;
                const float p1 = f0 + f1;
                const float inc = wave_scan_sum(p1, lane);
                const float ex = inc - p1;
                const float bc0 = ex + f0, bc1 = ex + p1;
                const float u0 = i0 - bc0, u1 = i1 - bc1;
                const float q1 = fmaxf(u0, u1);
                const float incm = wave_scan_max(q1, lane);
                float exm = __shfl_up(incm, 1); if (lane == 0) exm = -INFINITY;
                const float mp = dir ? mp1 : mp0;
                float* ab = dir ? a1 : a0; float* au = dir ? a3 : a2; float* am = dir ? a5 : a4;
                ab[l0] = bc0; ab[l1] = bc1; au[l0] = u0; au[l1] = u1;
                am[l0] = fmaxf(mp, fmaxf(exm, u0)); am[l1] = fmaxf(mp, fmaxf(exm, q1));
            }
        }
#pragma unroll
        for (int i = 0; i < 4; ++i) {
            const int q = t + 512 * i, r = q >> 4, cq = q & 15;
            *(u32x4*)(T0 + swz256(r, cq)) = R0[i];
            *(u32x4*)(T1 + swz256(r, cq)) = R1[i];
            *(u32x4*)(T2 + swz256(r, cq)) = R2[i];
            if (!isssd || i < 2) *(u32x4*)(T3 + swz256(r, cq)) = R3[i];
        }
        __syncthreads();
        if (u + (int)gridDim.x < NU6) P6_PREFETCH(u + gridDim.x);
        if (isssd) {
            const int g = h >> 2; (void)g;
            const int lr = lane & 15, lq = lane >> 4;
            f32x4 Y[2][2];
            {
                f32x4 aF[2][2], aB[2][2]; zero_acc(aF); zero_acc(aB);
                lds_mma_t<2, 2>(T0, T2, wm * 32, wn * 32, aF, lane);
                lds_mma_t<2, 2>(T0, T2, wm * 32, 64 + wn * 32, aB, lane);
#pragma unroll
                for (int i = 0; i < 2; ++i) {
                    const int l = wm * 32 + i * 16 + lr;
                    const float e0 = __expf(a0[l]), e1 = __expf(a1[l]);
#pragma unroll
                    for (int j = 0; j < 2; ++j) Y[i][j] = e0 * aF[i][j] + e1 * aB[i][j];
                }
            }
            f32x4 G[2][4]; zero_acc(G);
            lds_mma_t<2, 4>(T0, T1, wm * 32, wn * 64, G, lane);
            __syncthreads();
            {
                const float Dh = P.in[I_SSDD][h];
                int dbase = wn * 64 + lq * 4 - wm * 32 - lr; asm volatile("" : "+v"(dbase));
#pragma unroll
                for (int j = 0; j < 4; ++j) {
                    const int s0 = wn * 64 + j * 16 + lq * 4;
                    const float4 c0s = *(const float4*)(a0 + s0), r1s = *(const float4*)(a1 + s0), d0s = *(const float4*)(a2 + s0), d1s = *(const float4*)(a3 + s0);
                    const float c0v[4] = {c0s.x, c0s.y, c0s.z, c0s.w}, r1v[4] = {r1s.x, r1s.y, r1s.z, r1s.w};
                    const float d0v[4] = {d0s.x, d0s.y, d0s.z, d0s.w}, d1v[4] = {d1s.x, d1s.y, d1s.z, d1s.w};
#pragma unroll
                    for (int i = 0; i < 2; ++i) {
                        const int l = wm * 32 + i * 16 + lr;
                        const float c0l = a0[l], r1l = a1[l];
                        float mv[4];
#pragma unroll
                        for (int r = 0; r < 4; ++r) {
                            const int diff = dbase + (j * 16 - i * 16 + r);
                            const float e0 = (diff <= 0) ? (c0l - c0v[r]) : -INFINITY;
                            const float e1 = (diff >= 0) ? (r1l - r1v[r]) : -INFINITY;
                            mv[r] = G[i][j][r] * (__expf(e0) * d0v[r] + __expf(e1) * d1v[r]) + (diff == 0 ? Dh : 0.f);
                        }
                        uint2 o; o.x = pack2(mv[0], mv[1]); o.y = pack2(mv[2], mv[3]);
                        *(uint2*)(T1 + swz256(l, s0 >> 3) + (s0 & 7) * 2) = o;
                    }
                }
            }
            __syncthreads();
            lds_mma_t<2, 2>(T1, T3, wm * 32, wn * 32, Y, lane);
            u16* zo = (u16*)(ws + O_ZO);
            uint2 zvv[2][2];
#pragma unroll
            for (int i = 0; i < 2; ++i)
#pragma unroll
                for (int j = 0; j < 2; ++j) zvv[i][j] = *(const uint2*)(zo + (size_t)(rb + wm * 32 + i * 16 + lr) * 1024 + h * 64 + wn * 32 + j * 16 + lq * 4);
            __builtin_amdgcn_sched_barrier(0);
#pragma unroll
            for (int i = 0; i < 2; ++i) {
                const int l = wm * 32 + i * 16 + lr;
                float ssq = 0.f;
#pragma unroll
                for (int j = 0; j < 2; ++j) {
                    const int p = wn * 32 + j * 16 + lq * 4;
                    u16* zp = zo + (size_t)(rb + l) * 1024 + h * 64 + p;
                    const uint2 zv = zvv[i][j];
                    const float y0 = Y[i][j][0] * siluf(bflo(zv.x)), y1 = Y[i][j][1] * siluf(bfhi(zv.x));
                    const float y2 = Y[i][j][2] * siluf(bflo(zv.y)), y3 = Y[i][j][3] * siluf(bfhi(zv.y));
                    uint2 o; o.x = pack2(y0, y1); o.y = pack2(y2, y3);
                    *(uint2*)zp = o;
                    ssq += y0 * y0 + y1 * y1 + y2 * y2 + y3 * y3;
                }
                ssq += __shfl_xor(ssq, 16); ssq += __shfl_xor(ssq, 32);
                if (lq == 0) ((float*)(ws + O_SSQ))[(size_t)(rb + l) * 16 + h * 2 + wn] = ssq;
            }
            __syncthreads();
        } else {
            const int lr = lane & 15, lq = lane >> 4;
            f32x4 S[2][4]; zero_acc(S);
            lds_mma_t<2, 4>(T0, T1, wm * 32, wn * 64, S, lane);
            if (t < 256) {
                const int dir = t >> 7, idx = t & 127;
                const float* np = (const float*)(ws + O_MLN) + (((size_t)(b * NCH + cc) * 4 + h) * 2 + dir) * 128;
                float acc = 0.f;
#pragma unroll 4
                for (int cch = 0; cch < 16; ++cch) {
                    const uint4 qv = *(const uint4*)(T0 + swz256(idx, cch));
                    const float4 n0 = *(const float4*)(np + cch * 8), n1 = *(const float4*)(np + cch * 8 + 4);
                    acc += bflo(qv.x) * n0.x + bfhi(qv.x) * n0.y + bflo(qv.y) * n0.z + bfhi(qv.y) * n0.w
                         + bflo(qv.z) * n1.x + bfhi(qv.z) * n1.y + bflo(qv.w) * n1.z + bfhi(qv.w) * n1.w;
                }
                qn[dir * 128 + idx] = acc;
            }
            int dbase = wn * 64 + lq * 4 - wm * 32 - lr; asm volatile("" : "+v"(dbase));
            {
                float r0[2] = {0.f, 0.f}, r1[2] = {0.f, 0.f};
#pragma unroll
                for (int j = 0; j < 4; ++j) {
                    const int s0 = wn * 64 + j * 16 + lq * 4;
                    const float4 u0s = *(const float4*)(a2 + s0), u1s = *(const float4*)(a3 + s0);
                    const float u0v[4] = {u0s.x, u0s.y, u0s.z, u0s.w}, u1v[4] = {u1s.x, u1s.y, u1s.z, u1s.w};
#pragma unroll
                    for (int i = 0; i < 2; ++i) {
                        const int tt = wm * 32 + i * 16 + lr;
                        const float m0 = a4[tt], m1 = a5[tt];
#pragma unroll
                        for (int r = 0; r < 4; ++r) {
                            const int diff = dbase + (j * 16 - i * 16 + r);
                            r0[i] += S[i][j][r] * __expf((diff <= 0) ? (u0v[r] - m0) : -INFINITY);
                            r1[i] += S[i][j][r] * __expf((diff >= 0) ? (u1v[r] - m1) : -INFINITY);
                        }
                    }
                }
#pragma unroll
                for (int i = 0; i < 2; ++i) {
                    const int tt = wm * 32 + i * 16 + lr;
                    float x0 = r0[i], x1 = r1[i];
                    x0 += __shfl_xor(x0, 16); x0 += __shfl_xor(x0, 32);
                    x1 += __shfl_xor(x1, 16); x1 += __shfl_xor(x1, 32);
                    if (lq == 0) { rsA[(0 * 2 + wn) * 128 + tt] = x0; rsA[(1 * 2 + wn) * 128 + tt] = x1; }
                }
            }
            __syncthreads();
            if (t < 256) {
                const int dir = t >> 7, tt = t & 127;
                const float rs = rsA[(dir * 2 + 0) * 128 + tt] + rsA[(dir * 2 + 1) * 128 + tt];
                const float mm = dir ? a5[tt] : a4[tt];
                const float wi = __expf((dir ? mp1 : mp0) - mm);
                const float den = rs + wi * qn[dir * 128 + tt];
                const float mout = (dir ? a1[tt] : a0[tt]) + mm;
                const float dn = fmaxf(fabsf(den), __expf(-mout));
                fac[dir * 128 + tt] = 1.f / dn;
                wfac[dir * 128 + tt] = wi / dn;
            }
            __syncthreads();
            f32x4 H[2][4];
            {
                f32x4 A0[2][4]; zero_acc(A0);
                lds_mma_t<2, 4>(T0, T2, wm * 32, wn * 64, A0, lane);
#pragma unroll
                for (int i = 0; i < 2; ++i) {
                    const float f = wfac[wm * 32 + i * 16 + lr];
#pragma unroll
                    for (int j = 0; j < 4; ++j) H[i][j] = f * A0[i][j];
                }
            }
            {
                f32x4 A1[2][4]; zero_acc(A1);
                lds_mma_t<2, 4>(T0, T3, wm * 32, wn * 64, A1, lane);
#pragma unroll
                for (int i = 0; i < 2; ++i) {
                    const float f = wfac[128 + wm * 32 + i * 16 + lr];
#pragma unroll
                    for (int j = 0; j < 4; ++j) H[i][j] += f * A1[i][j];
                }
            }
            __syncthreads();
            asm volatile("" : "+v"(dbase));
#pragma unroll
            for (int j = 0; j < 4; ++j) {
                const int s0 = wn * 64 + j * 16 + lq * 4;
                const float4 u0s = *(const float4*)(a2 + s0), u1s = *(const float4*)(a3 + s0);
                const float u0v[4] = {u0s.x, u0s.y, u0s.z, u0s.w}, u1v[4] = {u1s.x, u1s.y, u1s.z, u1s.w};
#pragma unroll
                for (int i = 0; i < 2; ++i) {
                    const int tt = wm * 32 + i * 16 + lr;
                    const float m0 = a4[tt], m1 = a5[tt], f0 = fac[tt], f1 = fac[128 + tt];
                    float pv[4];
#pragma unroll
                    for (int r = 0; r < 4; ++r) {
                        const int diff = dbase + (j * 16 - i * 16 + r);
                        pv[r] = S[i][j][r] * (__expf((diff <= 0) ? (u0v[r] - m0) : -INFINITY) * f0 + __expf((diff >= 0) ? (u1v[r] - m1) : -INFINITY) * f1);
                    }
                    uint2 o; o.x = pack2(pv[0], pv[1]); o.y = pack2(pv[2], pv[3]);
                    *(uint2*)(T1 + swz256(tt, s0 >> 3) + (s0 & 7) * 2) = o;
                }
            }
            load_tile128(T2, 0, (const u16*)(ws + O_VT) + ((size_t)(b * NCH + cc) * 512 + h * 128) * 128, 128, 128, t, 512);
            __syncthreads();
            lds_mma_t<2, 4>(T1, T2, wm * 32, wn * 64, H, lane);
            u16* zo = (u16*)(ws + O_ZO);
            size_t rown[2];
#pragma unroll
            for (int i = 0; i < 2; ++i) {
                const int tt = wm * 32 + i * 16 + lr;
                const int lp = lpos + tt;
                rown[i] = (size_t)b * 4096 + ((lp & 63) << 6) + (lp >> 6);
                float ssq = 0.f;
#pragma unroll
                for (int j = 0; j < 4; ++j) {
                    const int d = wn * 64 + j * 16 + lq * 4;
                    const uint2 ov = *(const uint2*)(zo + rown[i] * 1024 + 512 + h * 128 + d);
                    H[i][j][0] *= sigmf(bflo(ov.x)); H[i][j][1] *= sigmf(bfhi(ov.x)); H[i][j][2] *= sigmf(bflo(ov.y)); H[i][j][3] *= sigmf(bfhi(ov.y));
                    ssq += H[i][j][0] * H[i][j][0] + H[i][j][1] * H[i][j][1] + H[i][j][2] * H[i][j][2] + H[i][j][3] * H[i][j][3];
                }
                ssq += __shfl_xor(ssq, 16); ssq += __shfl_xor(ssq, 32);
                if (lq == 0) rsA[wn * 128 + tt] = ssq;
            }
            __syncthreads();
            const u16* xc = (const u16*)(ws + O_XC);
            f32x4 nwv[4], skv[4]; uint2 xvv[4][2];
#pragma unroll
            for (int j = 0; j < 4; ++j) {
                const int d = wn * 64 + j * 16 + lq * 4, chg = h * 128 + d;
                nwv[j] = *(const f32x4*)(P.in[I_MNW] + chg); skv[j] = *(const f32x4*)(P.in[I_MSKIP] + chg);
#pragma unroll
                for (int i = 0; i < 2; ++i) xvv[j][i] = *(const uint2*)(xc + ((size_t)(b * NCH + cc) * 4 + h) * 16384 + (size_t)(wm * 32 + i * 16 + lr) * 128 + d);
            }
            __builtin_amdgcn_sched_barrier(0);
#pragma unroll
            for (int j = 0; j < 4; ++j) {
                const int d = wn * 64 + j * 16 + lq * 4, chg = h * 128 + d;
#pragma unroll
                for (int i = 0; i < 2; ++i) {
                    const int tt = wm * 32 + i * 16 + lr;
                    const float rn = rsqrtf((rsA[tt] + rsA[128 + tt]) * (1.f / 128.f) + 1e-6f);
                    const uint2 xv = xvv[j][i];
                    const float y0 = H[i][j][0] * rn * nwv[j][0] + skv[j][0] * bflo(xv.x), y1 = H[i][j][1] * rn * nwv[j][1] + skv[j][1] * bfhi(xv.x);
                    const float y2 = H[i][j][2] * rn * nwv[j][2] + skv[j][2] * bflo(xv.y), y3 = H[i][j][3] * rn * nwv[j][3] + skv[j][3] * bfhi(xv.y);
                    uint2 o; o.x = pack2(y0, y1); o.y = pack2(y2, y3);
                    *(uint2*)(zo + rown[i] * 1024 + 512 + chg) = o;
                }
            }
            __syncthreads();
        }
    }
}

struct OutProj {
    static constexpr int K = 1024; static constexpr bool PERM = false; static constexpr int MIDT = 8;
    struct Unit { int pm, pn, slot; };
    const Params* P; const float* rs; int G, c;
    __device__ __forceinline__ bool next(int i, Unit& u) const {
        const int L = i * G + c;
        if (L >= 256) return false;
        g8::dense_unit(L, 64, 4, u.pm, u.pn); u.slot = i & 3;
        return true;
    }
    __device__ __forceinline__ const char* baseA(const Unit&) const { return (const char*)(P->ws + O_ZO); }
    __device__ __forceinline__ const char* baseB(const Unit&) const { return (const char*)(P->ws + O_WOUT); }
    __device__ __forceinline__ void offs(const Unit& u, int tid_, unsigned (&oa)[2][2], unsigned (&ob)[2][2]) const {
        int R[2], C[2];
        { int tq = tid_; asm volatile("" : "+v"(tq)); g8::stage_rc(tq * 16, R[0], C[0]); g8::stage_rc(tq * 16 + 8192, R[1], C[1]); }
#pragma unroll
        for (int h = 0; h < 2; ++h)
#pragma unroll
            for (int i = 0; i < 2; ++i) {
                oa[h][i] = (unsigned)((u.pm * 256 + h * 128 + R[i]) * 1024 + C[i]) * 2u;
                ob[h][i] = (unsigned)((u.pn * 256 + h * 128 + R[i]) * 1024 + C[i]) * 2u;
            }
    }
    __device__ __forceinline__ int nt(const Unit&) const { return 16; }
    __device__ __forceinline__ bool brk(const Unit&, const Unit&) const { return false; }
    __device__ __forceinline__ void a_ready(const Unit&) const {}
    __device__ __forceinline__ void done(const Unit&) const {}
    __device__ __forceinline__ void mid(g8::Acc& acc, const Unit& u, int wr, int fr) const {
#pragma unroll
        for (int ai = 0; ai < 2; ++ai)
#pragma unroll
            for (int m = 0; m < 4; ++m) {
                const float s = rs[u.slot * 256 + ai * 128 + wr * 64 + m * 16 + fr];
#pragma unroll
                for (int bj = 0; bj < 2; ++bj)
#pragma unroll
                    for (int n = 0; n < 2; ++n) acc[ai][bj][m][n] *= s;
            }
    }
    __device__ __forceinline__ void epi(g8::Acc& acc, const Unit& u, int wr, int wc, int fr, int fq) const {
        const int row0 = u.pm * 256 + wr * 64 + fr, col0 = u.pn * 256 + wc * 32 + 4 * fq;
        const int b = u.pm >> 4;
        const float* mod = (const float*)(P->ws + O_MOD) + b * 6144 + 2048;
        f32x4 g1[2][2];
#pragma unroll
        for (int bj = 0; bj < 2; ++bj)
#pragma unroll
            for (int n = 0; n < 2; ++n) g1[bj][n] = *(const f32x4*)(mod + col0 + bj * 128 + n * 16);
        f32x4 xa[8], xb[8];
#define OP_LOAD(dst, ai_, mp_) _Pragma("unroll") for (int mm = 0; mm < 2; ++mm) _Pragma("unroll") for (int bj = 0; bj < 2; ++bj) _Pragma("unroll") for (int n = 0; n < 2; ++n) \
            dst[mm * 4 + bj * 2 + n] = __builtin_nontemporal_load((const f32x4*)(P->in[I_X] + (size_t)(row0 + (ai_) * 128 + ((mp_) * 2 + mm) * 16) * 1024 + col0 + bj * 128 + n * 16))
#define OP_STORE(src, ai_, mp_) _Pragma("unroll") for (int mm = 0; mm < 2; ++mm) _Pragma("unroll") for (int bj = 0; bj < 2; ++bj) _Pragma("unroll") for (int n = 0; n < 2; ++n) \
            *(f32x4*)(P->out + (size_t)(row0 + (ai_) * 128 + ((mp_) * 2 + mm) * 16) * 1024 + col0 + bj * 128 + n * 16) = src[mm * 4 + bj * 2 + n] + g1[bj][n] * acc[ai_][bj][(mp_) * 2 + mm][n]
        OP_LOAD(xa, 0, 0);
        __builtin_amdgcn_sched_barrier(0);
        OP_LOAD(xb, 0, 1);
        __builtin_amdgcn_sched_barrier(0);
        OP_STORE(xa, 0, 0);
        __builtin_amdgcn_sched_barrier(0);
        OP_LOAD(xa, 1, 0);
        __builtin_amdgcn_sched_barrier(0);
        OP_STORE(xb, 0, 1);
        __builtin_amdgcn_sched_barrier(0);
        OP_LOAD(xb, 1, 1);
        __builtin_amdgcn_sched_barrier(0);
        OP_STORE(xa, 1, 0);
        __builtin_amdgcn_sched_barrier(0);
        OP_STORE(xb, 1, 1);
#undef OP_LOAD
#undef OP_STORE
    }
};
__device__ void phase7(const Params& P, char* lds) {
    float* rs = (float*)(lds + g8::STAGE_BYTES);
    OutProj S; S.P = &P; S.rs = rs; S.G = gridDim.x; S.c = blockIdx.x;
    for (int i = 0; i < 4; ++i) {
        OutProj::Unit u;
        if (!S.next(i, u)) break;
        if (threadIdx.x < 256) {
            const f32x4* sq = (const f32x4*)((const float*)(P.ws + O_SSQ) + (size_t)(u.pm * 256 + threadIdx.x) * 16);
            const f32x4 s0 = sq[0], s1 = sq[1], s2 = sq[2], s3 = sq[3];
            const f32x4 sv = (s0 + s1) + (s2 + s3);
            const float s = (sv[0] + sv[1]) + (sv[2] + sv[3]);
            rs[i * 256 + threadIdx.x] = rsqrtf(s * (1.f / 512.f) + 1e-6f);
        }
    }
    __syncthreads();
    g8::gemm_phase<OutProj>((LAS unsigned char*)lds, S);
}

__device__ void phase8(const Params& P, char* lds_all) {
    unsigned char* ws = P.ws;
    const float* mod = (const float*)(ws + O_MOD);
    {
        const int t = threadIdx.x, lane = t & 63, w = t >> 6;
        float* tt = (float*)lds_all;
        float bw[32][3];
        {
            const int ti = lane & 15, kq = lane >> 4;
#pragma unroll
            for (int ks = 0; ks < 32; ++ks) {
                const int k = w * 128 + ks * 4 + kq;
                bw[ks][0] = P.in[I_REW][(size_t)k * 32 + ti];
                bw[ks][1] = P.in[I_REW][(size_t)k * 32 + 16 + ti];
                const float b2r = P.in[I_RGW][(size_t)k * 4 + (ti & 3)];
                bw[ks][2] = ti < 4 ? b2r : 0.f;
            }
        }
        for (int u = blockIdx.x; u < 512; u += gridDim.x) {
            const int tk0 = u * 32;
            const int b = tk0 >> 12;
            f32x4 mulv[4], shv[4];
            {
                f32x4 nwv[4], scv[4];
#pragma unroll
                for (int j = 0; j < 4; ++j) {
                    const int k = (lane + 64 * j) * 4;
                    nwv[j] = *(const f32x4*)(P.in[I_N2W] + k);
                    shv[j] = *(const f32x4*)(mod + b * 6144 + 3072 + k);
                    scv[j] = *(const f32x4*)(mod + b * 6144 + 4096 + k);
                }
#pragma unroll
                for (int j = 0; j < 4; ++j) mulv[j] = nwv[j] * (scv[j] + 1.f);
            }
#pragma unroll 1
            for (int qh = 0; qh < 2; ++qh) {
                f32x4 v[2][4]; float ss[2];
#pragma unroll
                for (int q = 0; q < 2; ++q) {
                    const float* xr = P.out + (size_t)(tk0 + w * 4 + qh * 2 + q) * 1024;
#pragma unroll
                    for (int j = 0; j < 4; ++j) v[q][j] = ((const f32x4*)xr)[lane + 64 * j];
                }
                __builtin_amdgcn_sched_barrier(0);
#pragma unroll
                for (int q = 0; q < 2; ++q) {
                    ss[q] = 0.f;
#pragma unroll
                    for (int j = 0; j < 4; ++j) ss[q] += v[q][j][0] * v[q][j][0] + v[q][j][1] * v[q][j][1] + v[q][j][2] * v[q][j][2] + v[q][j][3] * v[q][j][3];
                    ss[q] = rsqrtf(wave_sum(ss[q]) * (1.f / 1024.f) + 1e-6f);
                }
#pragma unroll
                for (int j = 0; j < 4; ++j) {
                    const int k = (lane + 64 * j) * 4;
#pragma unroll
                    for (int q = 0; q < 2; ++q) {
                        const int tl = w * 4 + qh * 2 + q;
                        const f32x4 hh = v[q][j] * ss[q] * mulv[j] + shv[j];
                        uint2 o; o.x = pack2(hh[0], hh[1]); o.y = pack2(hh[2], hh[3]);
                        *(uint2*)((u16*)(ws + O_T) + (size_t)(tk0 + tl) * 1024 + k) = o;
                        *(f32x4*)(tt + tl * 1028 + k) = hh;
                    }
                }
            }
            __syncthreads();
            f32x4 c[2][3];
#pragma unroll
            for (int a = 0; a < 2; ++a)
#pragma unroll
                for (int f = 0; f < 3; ++f) c[a][f] = f32x4{0, 0, 0, 0};
            const int ti = lane & 15, kq = lane >> 4;
#pragma unroll
            for (int ks = 0; ks < 32; ++ks) {
                const int k = w * 128 + ks * 4 + kq;
                const float a0 = tt[ti * 1028 + k], a1 = tt[(16 + ti) * 1028 + k];
                c[0][0] = __builtin_amdgcn_mfma_f32_16x16x4f32(a0, bw[ks][0], c[0][0], 0, 0, 0);
                c[0][1] = __builtin_amdgcn_mfma_f32_16x16x4f32(a0, bw[ks][1], c[0][1], 0, 0, 0);
                c[0][2] = __builtin_amdgcn_mfma_f32_16x16x4f32(a0, bw[ks][2], c[0][2], 0, 0, 0);
                c[1][0] = __builtin_amdgcn_mfma_f32_16x16x4f32(a1, bw[ks][0], c[1][0], 0, 0, 0);
                c[1][1] = __builtin_amdgcn_mfma_f32_16x16x4f32(a1, bw[ks][1], c[1][1], 0, 0, 0);
                c[1][2] = __builtin_amdgcn_mfma_f32_16x16x4f32(a1, bw[ks][2], c[1][2], 0, 0, 0);
            }
            __syncthreads();
            float* red = (float*)lds_all;
#pragma unroll
            for (int a = 0; a < 2; ++a)
#pragma unroll
                for (int r = 0; r < 4; ++r) {
                    const int row = a * 16 + kq * 4 + r;
                    red[(w * 32 + row) * 48 + ti] = c[a][0][r];
                    red[(w * 32 + row) * 48 + 16 + ti] = c[a][1][r];
                    red[(w * 32 + row) * 48 + 32 + ti] = c[a][2][r];
                }
            __syncthreads();
            int* lcnt = (int*)(lds_all + 65536);
            if (t < 64) lcnt[t] = 0;
            __syncthreads();
            int ea = 0, eb = 0, ra = 0, rb = 0; float w1 = 0.f, w2 = 0.f;
            if (t < 32) {
                float gl[4];
#pragma unroll
                for (int j = 0; j < 4; ++j) {
                    float sacc = P.in[I_RGB][j];
#pragma unroll
                    for (int ww = 0; ww < 8; ++ww) sacc += red[(ww * 32 + t) * 48 + 32 + j];
                    gl[j] = sacc;
                }
                int gs = 0; float gm = gl[0];
#pragma unroll
                for (int j = 1; j < 4; ++j) if (gl[j] > gm) { gm = gl[j]; gs = j; }
                float gsum = 0.f;
#pragma unroll
                for (int j = 0; j < 4; ++j) gsum += __expf(gl[j] - gm);
                const float pg = 1.f / gsum;
                float el[8];
#pragma unroll
                for (int j = 0; j < 8; ++j) {
                    float sacc = P.in[I_REB][gs * 8 + j];
#pragma unroll
                    for (int ww = 0; ww < 8; ++ww) sacc += red[(ww * 32 + t) * 48 + gs * 8 + j];
                    el[j] = sacc;
                }
                int i1 = 0; float m1 = el[0];
#pragma unroll
                for (int j = 1; j < 8; ++j) if (el[j] > m1) { m1 = el[j]; i1 = j; }
                int i2 = -1; float m2 = -INFINITY;
#pragma unroll
                for (int j = 0; j < 8; ++j) if (j != i1 && el[j] > m2) { m2 = el[j]; i2 = j; }
                const float e2 = __expf(m2 - m1);
                w1 = pg / (1.f + e2); w2 = pg * e2 / (1.f + e2);
                ea = gs * 8 + i1; eb = gs * 8 + i2;
                ra = atomicAdd(&lcnt[ea], 1);
                rb = atomicAdd(&lcnt[eb], 1);
            }
            __syncthreads();
            if (t < 32) {
                const int n = lcnt[t];
                lcnt[32 + t] = n > 0 ? atomicAdd((int*)(ws + O_CNT) + t * 64, n) : 0;
            }
            __syncthreads();
            if (t < 32) {
                const int tok = tk0 + t;
                int* list = (int*)(ws + O_LIST);
                float* wts = (float*)(ws + O_WTS);
                list[ea * 16384 + lcnt[32 + ea] + ra] = tok * 2;
                wts[tok * 2] = w1;
                list[eb * 16384 + lcnt[32 + eb] + rb] = tok * 2 + 1;
                wts[tok * 2 + 1] = w2;
            }
            __syncthreads();
        }
    }
    const int vb = threadIdx.x >> 8, t = threadIdx.x & 255;
    char* lds = lds_all + vb * VLDS;
    const int NTR = 3072;
    for (int u = blockIdx.x * 2 + vb; u < NTR; u += gridDim.x * 2) {
        {
            const int v = u;
            float* tile = (float*)lds;
            if (v < 2048) {
                const bool up = v >= 1024;
                const int vv = v & 1023, e = vv >> 5, rem = vv & 31, nt = rem >> 4, kt = rem & 15;
                const float* src = P.in[up ? I_WU : I_WG] + (size_t)e * 1024 * 256;
                transpose_tile_w(tile, src, 256, kt * 64, nt * 128, (u16*)(ws + O_WGU) + (size_t)e * 512 * 1024, (up ? 256 : 0) + nt * 128, 1024, nullptr, 0, t);
            } else {
                const int vv = v - 2048, e = vv >> 5, rem = vv & 31, nt = rem >> 2, kt = rem & 3;
                const float* src = P.in[I_WD] + (size_t)e * 256 * 1024;
                transpose_tile_w(tile, src, 1024, kt * 64, nt * 128, (u16*)(ws + O_WD) + (size_t)e * 1024 * 256, nt * 128, 256, nullptr, 0, t);
            }
        }
    }
}

__device__ __forceinline__ void moe_prefix(const unsigned char* ws, int* pre_t, int* pre_c) {
    if (threadIdx.x == 0) {
        const int* cnt = (const int*)(ws + O_CNT);
        int at = 0, ac = 0;
        for (int e = 0; e < 32; ++e) { pre_t[e] = at; pre_c[e] = ac; const int c = cnt[e * 64]; at += (c + 255) >> 8; ac += c; }
        pre_t[32] = at; pre_c[32] = ac;
    }
    __syncthreads();
}
struct MoeUnit { int type, e, mt, pn, cnt, base, mtg; };
struct Moe {
    static constexpr int K = 0; static constexpr bool PERM = true; static constexpr int MIDT = 0;
    typedef MoeUnit Unit;
    const unsigned char* ws; const int* pre_t; const int* pre_c; int G, c;
    __device__ __forceinline__ bool next(int i, Unit& u) const {
        int type, m, pn, e, mt;
        if ((G & 7) == 0) {
            const int x = c & 7, s = c >> 3, nb = G >> 3;
            const int n0 = pre_t[x + 1] - pre_t[x], n1 = pre_t[x + 9] - pre_t[x + 8], n2 = pre_t[x + 17] - pre_t[x + 16], n3 = pre_t[x + 25] - pre_t[x + 24];
            const int MTx = n0 + n1 + n2 + n3;
            const int Lx = i * nb + s;
            if (Lx < MTx * 2) { type = 0; m = Lx >> 1; pn = Lx & 1; }
            else if (Lx < MTx * 6) { const int j = Lx - MTx * 2; type = 1; m = j >> 2; pn = j & 3; }
            else return false;
            if (m < n0) { e = x; mt = m; }
            else if (m < n0 + n1) { e = x + 8; mt = m - n0; }
            else if (m < n0 + n1 + n2) { e = x + 16; mt = m - n0 - n1; }
            else { e = x + 24; mt = m - n0 - n1 - n2; }
        } else {
            const int L = i * G + c, MT = pre_t[32];
            if (L < MT * 2) { type = 0; m = L >> 1; pn = L & 1; }
            else if (L < MT * 6) { const int j = L - MT * 2; type = 1; m = j >> 2; pn = j & 3; }
            else return false;
            e = 0;
            while (pre_t[e + 1] <= m) ++e;
            mt = m - pre_t[e];
        }
        u.e = __builtin_amdgcn_readfirstlane(e); u.mt = __builtin_amdgcn_readfirstlane(mt);
        u.cnt = __builtin_amdgcn_readfirstlane(pre_c[e + 1] - pre_c[e]); u.base = __builtin_amdgcn_readfirstlane(pre_c[e]);
        u.mtg = __builtin_amdgcn_readfirstlane(pre_t[e] + mt); u.pn = __builtin_amdgcn_readfirstlane(pn); u.type = __builtin_amdgcn_readfirstlane(type);
        return true;
    }
    __device__ __forceinline__ int nt(const Unit& u) const { return u.type ? 4 : 16; }
    __device__ __forceinline__ bool brk(const Unit& a, const Unit& b) const { return a.type == 0 && b.type == 1; }
    __device__ __forceinline__ const char* baseA(const Unit& u) const {
        return u.type ? (const char*)(ws + O_H) + (size_t)(u.base + u.mt * 256) * 256 * 2 : (const char*)(ws + O_T);
    }
    __device__ __forceinline__ const char* baseB(const Unit& u) const {
        return u.type ? (const char*)(ws + O_WD) + ((size_t)u.e * 1024 + u.pn * 256) * 256 * 2 : (const char*)(ws + O_WGU) + (size_t)u.e * 512 * 1024 * 2;
    }
    __device__ __forceinline__ void offs(const Unit& u, int tid_, unsigned (&oa)[2][2], unsigned (&ob)[2][2]) const {
        int R[2], C[2];
        { int tq = tid_; asm volatile("" : "+v"(tq)); g8::stage_rc(tq * 16, R[0], C[0]); g8::stage_rc(tq * 16 + 8192, R[1], C[1]); }
        const int* list = (const int*)(ws + O_LIST) + u.e * 16384;
        int tokv[2][2];
        if (u.type == 0) {
#pragma unroll
            for (int h = 0; h < 2; ++h)
#pragma unroll
                for (int i = 0; i < 2; ++i) { const int idx = u.mt * 256 + h * 128 + R[i]; tokv[h][i] = list[idx < u.cnt ? idx : u.cnt - 1]; }
            __builtin_amdgcn_sched_barrier(0);
        } else {
#pragma unroll
            for (int h = 0; h < 2; ++h)
#pragma unroll
                for (int i = 0; i < 2; ++i) tokv[h][i] = 0;
        }
#pragma unroll
        for (int h = 0; h < 2; ++h)
#pragma unroll
            for (int i = 0; i < 2; ++i) {
                const int Rb = (R[i] & ~31) + g8::perm32(R[i] & 31);
                const int tok = tokv[h][i] >> 1;
                if (u.type == 0) {
                    oa[h][i] = (unsigned)(tok * 1024 + C[i]) * 2u;
                    ob[h][i] = (unsigned)((h * 256 + u.pn * 128 + Rb) * 1024 + C[i]) * 2u;
                } else {
                    oa[h][i] = (unsigned)((h * 128 + R[i]) * 256 + C[i]) * 2u;
                    ob[h][i] = (unsigned)((h * 128 + Rb) * 256 + C[i]) * 2u;
                }
            }
    }
    __device__ __forceinline__ void mid(g8::Acc&, const Unit&, int, int) const {}
    __device__ __forceinline__ void a_ready(const Unit& u) const {
        if (u.type == 0) return;
        if (threadIdx.x < 64) {
            unsigned* rdy = (unsigned*)(ws + O_RDY) + u.mtg * 64;
            unsigned spins = 0;
            while ((unsigned)__builtin_amdgcn_readfirstlane(__hip_atomic_load(rdy, __ATOMIC_RELAXED, __HIP_MEMORY_SCOPE_AGENT)) < 16u) {
                __builtin_amdgcn_s_sleep(2);
                if (++spins > (1u << 22)) break;
            }
            __builtin_amdgcn_fence(__ATOMIC_ACQUIRE, "agent");
            asm volatile("s_waitcnt vmcnt(0)" ::: "memory");
        }
        asm volatile("" ::: "memory"); __builtin_amdgcn_s_barrier(); asm volatile("" ::: "memory");
    }
    __device__ __forceinline__ void done(const Unit& u) const {
        if (u.type != 0) return;
        asm volatile("s_waitcnt vmcnt(0)" ::: "memory");
        if ((threadIdx.x & 63) == 0) __hip_atomic_fetch_add((unsigned*)(ws + O_RDY) + u.mtg * 64, 1u, __ATOMIC_RELAXED, __HIP_MEMORY_SCOPE_AGENT);
    }
    __device__ __forceinline__ void epi(g8::Acc& acc, const Unit& u, int wr, int wc, int fr, int fq) const {
        if (u.type == 0) {
            __amdgpu_buffer_rsrc_t rs = __builtin_amdgcn_make_buffer_rsrc((void*)(ws + O_H), 0, (int)((32768 + 256) * 256 * 2), 0x00020000);
#pragma unroll
            for (int ai = 0; ai < 2; ++ai)
#pragma unroll
                for (int m = 0; m < 4; ++m) {
                    const int idx = u.mt * 256 + ai * 128 + wr * 64 + m * 16 + fr;
                    const f32x4 g0 = acc[ai][0][m][0], g1 = acc[ai][0][m][1], u0 = acc[ai][1][m][0], u1 = acc[ai][1][m][1];
                    u32x4 o;
                    o.x = g8::cvt_pk_bf16(siluf(g0[0]) * u0[0], siluf(g0[1]) * u0[1]); o.y = g8::cvt_pk_bf16(siluf(g0[2]) * u0[2], siluf(g0[3]) * u0[3]);
                    o.z = g8::cvt_pk_bf16(siluf(g1[0]) * u1[0], siluf(g1[1]) * u1[1]); o.w = g8::cvt_pk_bf16(siluf(g1[2]) * u1[2], siluf(g1[3]) * u1[3]);
                    const unsigned off = idx < u.cnt ? ((unsigned)(u.base + idx) * 256u + (unsigned)(u.pn * 128 + wc * 32 + 8 * fq)) * 2u : 0xF0000000u;
                    __builtin_amdgcn_raw_buffer_store_b128(o, rs, off, 0, 16);
                    __builtin_amdgcn_sched_barrier(0);
                }
            return;
        }
        const int* list = (const int*)(ws + O_LIST) + u.e * 16384;
        const float* wts = (const float*)(ws + O_WTS);
        __amdgpu_buffer_rsrc_t rsl = __builtin_amdgcn_make_buffer_rsrc((void*)(ws + O_SL), 0, (int)(16384 * 2 * 1024 * 2), 0x00020000);
        int ent[2][4]; float wg[2][4];
#pragma unroll
        for (int ai = 0; ai < 2; ++ai)
#pragma unroll
            for (int m = 0; m < 4; ++m) {
                const int idx = u.mt * 256 + ai * 128 + wr * 64 + m * 16 + fr;
                ent[ai][m] = list[idx < u.cnt ? idx : u.cnt - 1];
            }
#pragma unroll
        for (int ai = 0; ai < 2; ++ai)
#pragma unroll
            for (int m = 0; m < 4; ++m) wg[ai][m] = wts[ent[ai][m]];
#pragma unroll
        for (int ai = 0; ai < 2; ++ai)
#pragma unroll
            for (int m = 0; m < 4; ++m) {
                const int idx = u.mt * 256 + ai * 128 + wr * 64 + m * 16 + fr;
                const unsigned off = idx < u.cnt ? ((unsigned)ent[ai][m] * 1024u + (unsigned)(u.pn * 256 + wc * 32 + 8 * fq)) * 2u : 0xF0000000u;
#pragma unroll
                for (int bj = 0; bj < 2; ++bj) {
                    const f32x4 v0 = acc[ai][bj][m][0] * wg[ai][m], v1 = acc[ai][bj][m][1] * wg[ai][m];
                    u32x4 o; o.x = g8::cvt_pk_bf16(v0[0], v0[1]); o.y = g8::cvt_pk_bf16(v0[2], v0[3]); o.z = g8::cvt_pk_bf16(v1[0], v1[1]); o.w = g8::cvt_pk_bf16(v1[2], v1[3]);
                    __builtin_amdgcn_raw_buffer_store_b128(o, rsl, off + bj * 256u, 0, 0);
                }
            }
    }
};
__device__ void phase9(const Params& P, char* lds) {
    int* pre_t = (int*)(lds + g8::STAGE_BYTES); int* pre_c = pre_t + 40;
    moe_prefix(P.ws, pre_t, pre_c);
    Moe S; S.ws = P.ws; S.pre_t = pre_t; S.pre_c = pre_c; S.G = gridDim.x; S.c = blockIdx.x;
    int i = 0;
    while (i >= 0) i = g8::gemm_phase<Moe>((LAS unsigned char*)lds, S, i);
}

__device__ void phase11(const Params& P) {
    unsigned char* ws = P.ws;
    const int lane = threadIdx.x & 63;
    const int gw = blockIdx.x * 8 + (threadIdx.x >> 6), nw = gridDim.x * 8;
    const float* mod = (const float*)(ws + O_MOD);
    const u16* SL = (const u16*)(ws + O_SL);
    const int r_lo = (int)(((long long)gw * MLAT) / nw), r_hi = (int)(((long long)(gw + 1) * MLAT) / nw);
    float4 g2[4], fw[4];
    int cur_b = -1;
#pragma unroll
    for (int j = 0; j < 4; ++j) fw[j] = *(const float4*)(P.in[I_FNW] + (lane + 64 * j) * 4);
    for (int row = r_lo; row < r_hi; row += 2) {
        const bool two = row + 1 < r_hi;
        const int row1 = two ? row + 1 : row;
        float4 v0[4], v1[4]; uint2 a0[4], a1[4], b0[4], b1[4];
#pragma unroll
        for (int j = 0; j < 4; ++j) {
            const int k = (lane + 64 * j) * 4;
            { const f32x4 q0 = __builtin_nontemporal_load((const f32x4*)(P.out + (size_t)row * 1024 + k)), q1 = __builtin_nontemporal_load((const f32x4*)(P.out + (size_t)row1 * 1024 + k));
              v0[j] = make_float4(q0[0], q0[1], q0[2], q0[3]); v1[j] = make_float4(q1[0], q1[1], q1[2], q1[3]); }
            typedef __attribute__((ext_vector_type(2))) unsigned u32x2;
            { const u32x2 w0 = __builtin_nontemporal_load((const u32x2*)(SL + (size_t)(row * 2) * 1024 + k)), w1 = __builtin_nontemporal_load((const u32x2*)(SL + (size_t)(row * 2 + 1) * 1024 + k));
              const u32x2 w2 = __builtin_nontemporal_load((const u32x2*)(SL + (size_t)(row1 * 2) * 1024 + k)), w3 = __builtin_nontemporal_load((const u32x2*)(SL + (size_t)(row1 * 2 + 1) * 1024 + k));
              a0[j] = make_uint2(w0[0], w0[1]); a1[j] = make_uint2(w1[0], w1[1]); b0[j] = make_uint2(w2[0], w2[1]); b1[j] = make_uint2(w3[0], w3[1]); }
        }
#pragma unroll 1
        for (int rr = 0; rr < 2; ++rr) {
            const int orow = rr ? row1 : row;
            const int b = orow >> 12;
            if (b != cur_b) {
                cur_b = b;
#pragma unroll
                for (int j = 0; j < 4; ++j) g2[j] = *(const float4*)(mod + b * 6144 + 5120 + (lane + 64 * j) * 4);
            }
            if (rr == 1 && !two) break;
            float4 x[4]; float ss = 0.f;
#pragma unroll
            for (int j = 0; j < 4; ++j) {
                const float4 vv = rr ? v1[j] : v0[j];
                const uint2 s0 = rr ? b0[j] : a0[j], s1 = rr ? b1[j] : a1[j];
                x[j].x = vv.x + g2[j].x * (bflo(s0.x) + bflo(s1.x));
                x[j].y = vv.y + g2[j].y * (bfhi(s0.x) + bfhi(s1.x));
                x[j].z = vv.z + g2[j].z * (bflo(s0.y) + bflo(s1.y));
                x[j].w = vv.w + g2[j].w * (bfhi(s0.y) + bfhi(s1.y));
                ss += x[j].x * x[j].x + x[j].y * x[j].y + x[j].z * x[j].z + x[j].w * x[j].w;
            }
            const float rstd = rsqrtf(wave_sum(ss) * (1.f / 1024.f) + 1e-6f);
#pragma unroll
            for (int j = 0; j < 4; ++j) {
                float4 o; o.x = x[j].x * rstd * fw[j].x; o.y = x[j].y * rstd * fw[j].y; o.z = x[j].z * rstd * fw[j].z; o.w = x[j].w * rstd * fw[j].w;
                __builtin_nontemporal_store((f32x4){o.x, o.y, o.z, o.w}, (f32x4*)(P.out + (size_t)orow * 1024 + (lane + 64 * j) * 4));
            }
        }
    }
}

__global__ void __launch_bounds__(NTB, 2) fwd_kernel(Params P) {
    extern __shared__ __attribute__((aligned(16))) char lds[];
    if (threadIdx.x < 4) ((volatile LAS unsigned*)(lds + LDS_MAIN))[threadIdx.x] = 0u;
    __syncthreads();
    XcdBarrier xbar = xcd_barrier_post((unsigned*)(P.ws + O_BAR), (volatile LAS unsigned*)(lds + LDS_MAIN));
#define SYNC() xcd_barrier(xbar)
#ifdef ONLY_PH
#define RUN_PHASE(k, call) do { if ((k) == ONLY_PH) { call; } } while (0)
#else
#define RUN_PHASE(k, call) do { if (P.lo <= (k) && (k) < P.hi) { call; if ((k) + 1 < P.hi) { SYNC(); } } } while (0)
#endif
    RUN_PHASE(0, phase0(P, lds));
    RUN_PHASE(1, phase1(P));
    RUN_PHASE(2, { InProj S; S.ws = P.ws; S.G = gridDim.x; S.c = blockIdx.x; g8::gemm_phase<InProj>((LAS unsigned char*)lds, S); });
    RUN_PHASE(3, phase3(P, lds));
    RUN_PHASE(4, phase4(P, lds));
    RUN_PHASE(5, phase5(P));
    RUN_PHASE(6, phase6(P, lds));
    RUN_PHASE(7, phase7(P, lds));
    RUN_PHASE(8, phase8(P, lds));
    RUN_PHASE(9, phase9(P, lds));
    RUN_PHASE(11, phase11(P));
}

extern "C" void kernel_launch(void* const* d_in, const int* in_sizes, int n_in, void* d_out, int out_size, void* d_ws, size_t ws_size,
                              hipStream_t stream) {
    static int grid_blocks = 0;
    if (!grid_blocks) {
        int dev = 0, cus = 0, per_cu = 0;
        (void)hipGetDevice(&dev);
        (void)hipDeviceGetAttribute(&cus, hipDeviceAttributeMultiprocessorCount, dev);
        (void)hipFuncSetAttribute((const void*)fwd_kernel, hipFuncAttributeMaxDynamicSharedMemorySize, LDS_BYTES);
        (void)hipOccupancyMaxActiveBlocksPerMultiprocessor(&per_cu, (const void*)fwd_kernel, NTB, LDS_BYTES);
        if (per_cu < 1) fprintf(stderr, "occupancy query says %d blocks per CU\n", per_cu);
        grid_blocks = cus;
        if (ws_size < WS_END) fprintf(stderr, "workspace too small: %zu < %zu\n", ws_size, (size_t)WS_END);
    }
    Params p{};
    for (int i = 0; i < 30; ++i) p.in[i] = (const float*)d_in[i];
    p.out = (float*)d_out; p.ws = (unsigned char*)d_ws;
    p.lo = 0; p.hi = NPHASE;
    (void)hipMemsetAsync((char*)d_ws + O_BAR, 0, 16384 + 40960, stream);
    void* args[] = {&p};
    hipError_t e = hipLaunchCooperativeKernel((const void*)fwd_kernel, dim3(grid_blocks), dim3(NTB), args, LDS_BYTES, stream);
    if (e != hipSuccess) fprintf(stderr, "cooperative launch failed: %s (grid %d)\n", hipGetErrorString(e), grid_blocks);
}
```

```cpp
#include <hip/hip_runtime.h>
#include <cstdio>
#include <cstdint>

typedef unsigned short u16;
typedef __attribute__((ext_vector_type(8))) short bf16x8;
typedef __attribute__((ext_vector_type(4))) float f32x4;
typedef __attribute__((ext_vector_type(4))) unsigned u32x4;
#define LAS __attribute__((address_space(3)))

constexpr int NTB = 512;
constexpr int VLDS = 75776;
constexpr int LDS_MAIN = 2 * VLDS;
constexpr int LDS_BYTES = LDS_MAIN + 256;
constexpr int MLAT = 16384, MALL = 17408;
constexpr int NCH = 34;
constexpr int NPHASE = 12;

enum { I_X = 0, I_C, I_CTX, I_CCTX, I_WMOD, I_BMOD, I_N1W, I_WIN, I_SCW, I_SCB, I_DTB, I_ALOG, I_SSDD, I_SNW, I_MCW, I_MCB, I_WQK, I_GB,
       I_MNW, I_MSKIP, I_WOUT, I_N2W, I_RGW, I_RGB, I_REW, I_REB, I_WG, I_WU, I_WD, I_FNW };

constexpr size_t al(size_t x) { return (x + 255) & ~(size_t)255; }
constexpr size_t O_MOD = 0;
constexpr size_t O_SSQ = O_MOD + al(5 * 6144 * 4);
constexpr size_t O_CNT = O_SSQ + al(16384 * 16 * 4);
constexpr size_t O_BAR = O_CNT + 8192;
constexpr size_t O_RDY = O_BAR + 16384;
constexpr size_t O_PSD = O_RDY + 40960;
constexpr size_t O_PSG = O_PSD + al((size_t)MALL * 16 * 4);
constexpr size_t O_DT = O_PSG + al((size_t)MALL * 16 * 4);
constexpr size_t O_GI = O_DT + al((size_t)MALL * 16 * 4);
constexpr size_t O_GF = O_GI + al((size_t)MALL * 8 * 4);
constexpr size_t O_ACH = O_GF + al((size_t)MALL * 8 * 4);
constexpr size_t O_MLS = O_ACH + 16384;
constexpr size_t O_MLP = O_MLS + 16384;
constexpr size_t O_MLN = O_MLP + 16384;
constexpr size_t O_LIST = O_MLN + al(4 * 34 * 4 * 2 * 128 * 4);
constexpr size_t O_WTS = O_LIST + al(32 * 16384 * 4);
constexpr size_t O_WIN = O_WTS + al(16384 * 2 * 4);
constexpr size_t O_WOUT = O_WIN + al((size_t)3328 * 1024 * 2);
constexpr size_t O_A = O_WOUT + al((size_t)1024 * 1024 * 2);
constexpr size_t SZ_A = (size_t)MALL * 1024 * 2;
constexpr size_t O_PT = O_A + SZ_A;
constexpr size_t SZ_PT = (size_t)MALL * 1536 * 2;
constexpr size_t O_MLC1 = O_PT + SZ_PT;
constexpr size_t SZ_HALF = (size_t)MALL * 512 * 2;
constexpr size_t O_ZO = O_MLC1 + SZ_HALF;
constexpr size_t O_VT = O_ZO + SZ_A;
constexpr size_t O_BM = O_VT + SZ_HALF;
constexpr size_t SZ_Q = (size_t)MALL * 256 * 2;
constexpr size_t O_BT = O_BM + SZ_Q;
constexpr size_t O_CM = O_BT + SZ_Q;
constexpr size_t O_XT = O_CM + SZ_Q;
constexpr size_t O_KT = O_XT + SZ_HALF;
constexpr size_t O_XC = O_KT + SZ_HALF;
constexpr size_t O_DUMP = O_XC + SZ_HALF;
constexpr size_t WS_END = O_DUMP + 256 * 2048;
constexpr size_t O_XN = O_A, O_Q = O_A, O_K = O_A + SZ_HALF, O_T = O_A;
constexpr size_t O_ST = O_PT;
constexpr size_t O_MLC0 = O_PT + (size_t)4 * 34 * 8 * 2 * 8192 * 2;
constexpr size_t O_WGU = O_PT;
constexpr size_t O_WD = O_PT + (size_t)32 * 512 * 1024 * 2;
constexpr size_t O_SL = O_ZO;
constexpr size_t O_H = O_XT;
static_assert(O_WD + (size_t)32 * 1024 * 256 * 2 <= O_MLC1, "moe weights fit PT region");
static_assert(O_SL + (size_t)16384 * 2 * 1024 * 2 <= O_CM, "slots fit");
static_assert((size_t)(32768 + 256) * 256 * 2 <= SZ_HALF, "H fits");
static_assert(WS_END <= (size_t)256 * 1024 * 1024, "workspace");
constexpr size_t TCTX512 = (size_t)4 * 512 * 4096;
constexpr size_t TCTX256 = (size_t)4 * 256 * 4096;

struct Params { const float* in[30]; float* out; unsigned char* ws; int lo, hi; };

#define XB_TMO      128
#define XB_XCNT(j)  (256  + 64 * (j))
#define XB_XSUB(j)  (1280 + 64 * (j))
#define XB_XGEN(j)  (2304 + 64 * (j))
#define XB_TOP      3328
#define XB_TOPGEN   3392
#define XCD_BAR_WORDS 3456
#define XB_SPIN_CAP (1u << 20)
__device__ __forceinline__ unsigned xb_ld(unsigned* p)              { return __hip_atomic_load(p, __ATOMIC_RELAXED, __HIP_MEMORY_SCOPE_AGENT); }
__device__ __forceinline__ unsigned xb_add(unsigned* p, unsigned v) { return __hip_atomic_fetch_add(p, v, __ATOMIC_RELAXED, __HIP_MEMORY_SCOPE_AGENT); }
__device__ __forceinline__ unsigned xb_xcc_id() { return (unsigned)__builtin_amdgcn_s_getreg((3 << 11) | 20) & 0xFu; }
#define XB_SPIN(cond, bar) do { unsigned _sp = 0; while (cond) { __builtin_amdgcn_s_sleep(1); \
    if ((++_sp & 255u) == 0u) { if (xb_ld(&(bar)[XB_TMO])) break; if (_sp > XB_SPIN_CAP) { atomicAdd(&(bar)[XB_TMO], 1u); break; } } } } while (0)
struct XcdBarrier { unsigned* bar; unsigned x; volatile LAS unsigned* st; };
__device__ __forceinline__ XcdBarrier xcd_barrier_post(unsigned* bar, volatile LAS unsigned* st) {
    XcdBarrier b; b.bar = bar; b.x = xb_xcc_id(); b.st = st;
    if (threadIdx.x == 0) (void)xb_add(&bar[XB_XCNT(b.x)], 1u);
    return b;
}
__device__ __forceinline__ void xcd_barrier_complete(unsigned* bar, unsigned x, unsigned& nloc, unsigned& nx) {
    const unsigned G = gridDim.x * gridDim.y * gridDim.z;
    unsigned sum, cnt, mine, sp = 0u;
    for (;;) {
        sum = 0u; cnt = 0u; mine = 0u;
#pragma unroll
        for (unsigned j = 0; j < 16; ++j) { const unsigned c = xb_ld(&bar[XB_XCNT(j)]); sum += c; cnt += (c > 0u) ? 1u : 0u; mine = (j == x) ? c : mine; }
        if (sum == G) break;
        __builtin_amdgcn_s_sleep(1);
        if ((++sp & 255u) == 0u) { if (xb_ld(&bar[XB_TMO])) break; if (sp > XB_SPIN_CAP) { atomicAdd(&bar[XB_TMO], 1u); break; } }
    }
    nloc = mine > 0u ? mine : 1u; nx = cnt > 0u ? cnt : 1u;
}
__device__ __forceinline__ void xcd_barrier(const XcdBarrier& b) {
    asm volatile("s_waitcnt vmcnt(0)" ::: "memory");
    __syncthreads();
    if (threadIdx.x == 0) {
        unsigned* bar = b.bar;
        __builtin_amdgcn_s_waitcnt(0);
        unsigned nloc = b.st[0], nx = b.st[1];
        if (nloc == 0u) { xcd_barrier_complete(bar, b.x, nloc, nx); b.st[0] = nloc; b.st[1] = nx; }
        const unsigned old = xb_add(&bar[XB_XSUB(b.x)], 1u);
        const unsigned gen = old / nloc;
        if (old + 1u == (gen + 1u) * nloc) {
            __builtin_amdgcn_fence(__ATOMIC_RELEASE, "agent");
            asm volatile("s_waitcnt vmcnt(0)" ::: "memory");
            const unsigned og = xb_add(&bar[XB_TOP], 1u);
            const unsigned tg = og / nx;
            if (og + 1u == (tg + 1u) * nx) xb_add(&bar[XB_TOPGEN], 1u);
            else XB_SPIN(xb_ld(&bar[XB_TOPGEN]) == tg, bar);
            __builtin_amdgcn_fence(__ATOMIC_ACQUIRE, "agent");
            xb_add(&bar[XB_XGEN(b.x)], 1u);
            asm volatile("s_waitcnt vmcnt(0)" ::: "memory");
        } else {
            XB_SPIN(xb_ld(&bar[XB_XGEN(b.x)]) == gen, bar);
            __builtin_amdgcn_fence(__ATOMIC_ACQUIRE, "agent");
            asm volatile("s_waitcnt vmcnt(0)" ::: "memory");
        }
    }
    __syncthreads();
}

__device__ __forceinline__ u16 f2bf(float f) { unsigned u = __float_as_uint(f); u += 0x7fffu + ((u >> 16) & 1u); return (u16)(u >> 16); }
__device__ __forceinline__ float bf2f(u16 h) { return __uint_as_float(((unsigned)h) << 16); }
__device__ __forceinline__ unsigned pack2(float a, float b) { return (unsigned)f2bf(a) | ((unsigned)f2bf(b) << 16); }
__device__ __forceinline__ float bflo(unsigned u) { return __uint_as_float(u << 16); }
__device__ __forceinline__ float bfhi(unsigned u) { return __uint_as_float(u & 0xffff0000u); }
__device__ __forceinline__ float siluf(float x) { return x / (1.f + __expf(-x)); }
__device__ __forceinline__ float sigmf(float x) { return 1.f / (1.f + __expf(-x)); }
__device__ __forceinline__ float softplusf(float x) { return x > 20.f ? x : log1pf(__expf(x)); }
__device__ __forceinline__ float wave_sum(float v) {
#pragma unroll
    for (int o = 32; o > 0; o >>= 1) v += __shfl_xor(v, o);
    return v;
}
__device__ __forceinline__ int swz256(int row, int chunk) { return row * 256 + ((chunk ^ (row & 15)) << 4); }
__device__ __forceinline__ int colmajor_src_row(int R) {
    if (R >= MLAT) return R;
    const int b = R >> 12, lp = R & 4095;
    return (b << 12) + ((lp & 63) << 6) + (lp >> 6);
}

__device__ __forceinline__ void load_tile128(char* lds, int lrow0, const u16* __restrict__ g, size_t ld, int rows, int t, int nthr) {
#pragma unroll 4
    for (int q = t; q < rows * 16; q += nthr) {
        const int r = q >> 4, c = q & 15;
        const uint4 v = *(const uint4*)(g + (size_t)r * ld + c * 8);
        *(uint4*)(lds + swz256(lrow0 + r, c)) = v;
    }
}
__device__ __forceinline__ void load_tile128_scaled(char* lds, int lrow0, const u16* __restrict__ g, size_t ld, int rows, const float* w, int t, int nthr) {
#pragma unroll 2
    for (int q = t; q < rows * 16; q += nthr) {
        const int r = q >> 4, c = q & 15;
        const uint4 v = *(const uint4*)(g + (size_t)r * ld + c * 8);
        const float* ww = w + c * 8;
        uint4 o;
        o.x = pack2(bflo(v.x) * ww[0], bfhi(v.x) * ww[1]);
        o.y = pack2(bflo(v.y) * ww[2], bfhi(v.y) * ww[3]);
        o.z = pack2(bflo(v.z) * ww[4], bfhi(v.z) * ww[5]);
        o.w = pack2(bflo(v.w) * ww[6], bfhi(v.w) * ww[7]);
        *(uint4*)(lds + swz256(lrow0 + r, c)) = o;
    }
}
template <int MI, int NJ>
__device__ __forceinline__ void lds_mma(const char* A, const char* B, int arow0, int brow0, f32x4 (&acc)[MI][NJ], int lane) {
#pragma unroll 1
    for (int kk = 0; kk < 4; ++kk) {
        const int chunk = kk * 4 + (lane >> 4);
        bf16x8 a[MI], b[NJ];
#pragma unroll
        for (int i = 0; i < MI; ++i) { const int row = arow0 + i * 16 + (lane & 15); a[i] = *(const bf16x8*)(A + swz256(row, chunk)); }
#pragma unroll
        for (int j = 0; j < NJ; ++j) { const int row = brow0 + j * 16 + (lane & 15); b[j] = *(const bf16x8*)(B + swz256(row, chunk)); }
#pragma unroll
        for (int i = 0; i < MI; ++i)
#pragma unroll
            for (int j = 0; j < NJ; ++j) acc[i][j] = __builtin_amdgcn_mfma_f32_16x16x32_bf16(a[i], b[j], acc[i][j], 0, 0, 0);
    }
}
template <int MI, int NJ>
__device__ __forceinline__ void lds_mma_t(const char* A, const char* B, int arow0, int brow0, f32x4 (&acc)[MI][NJ], int lane) {
#pragma unroll 1
    for (int kk = 0; kk < 4; ++kk) {
        const int chunk = kk * 4 + (lane >> 4);
        bf16x8 a[MI], b[NJ];
#pragma unroll
        for (int i = 0; i < MI; ++i) { const int row = arow0 + i * 16 + (lane & 15); a[i] = *(const bf16x8*)(A + swz256(row, chunk)); }
#pragma unroll
        for (int j = 0; j < NJ; ++j) { const int row = brow0 + j * 16 + (lane & 15); b[j] = *(const bf16x8*)(B + swz256(row, chunk)); }
#pragma unroll
        for (int i = 0; i < MI; ++i)
#pragma unroll
            for (int j = 0; j < NJ; ++j) acc[i][j] = __builtin_amdgcn_mfma_f32_16x16x32_bf16(b[j], a[i], acc[i][j], 0, 0, 0);
    }
}
template <int MI, int NJ>
__device__ __forceinline__ void zero_acc(f32x4 (&acc)[MI][NJ]) {
#pragma unroll
    for (int i = 0; i < MI; ++i)
#pragma unroll
        for (int j = 0; j < NJ; ++j) acc[i][j] = f32x4{0.f, 0.f, 0.f, 0.f};
}
template <int OP>
__device__ __forceinline__ float scan_pair(float v, float* buf, int t) {
    const int idx = t & 127, base = t & 128;
    const bool act = t < 256;
    if (act) buf[t] = v;
    __syncthreads();
#pragma unroll 1
    for (int off = 1; off < 128; off <<= 1) {
        float o = OP ? -INFINITY : 0.f;
        if (act && idx >= off) o = buf[base + idx - off];
        __syncthreads();
        v = OP ? fmaxf(v, o) : v + o;
        if (act) buf[t] = v;
        __syncthreads();
    }
    return v;
}

__device__ __forceinline__ float wave_scan_sum(float v, int lane) {
#pragma unroll
    for (int off = 1; off < 64; off <<= 1) { const float o = __shfl_up(v, off); if (lane >= off) v += o; }
    return v;
}
__device__ __forceinline__ float wave_scan_max(float v, int lane) {
#pragma unroll
    for (int off = 1; off < 64; off <<= 1) { const float o = __shfl_up(v, off); if (lane >= off) v = fmaxf(v, o); }
    return v;
}
__device__ __forceinline__ float wave_max(float v) {
#pragma unroll
    for (int o = 32; o > 0; o >>= 1) v = fmaxf(v, __shfl_xor(v, o));
    return v;
}
__device__ __forceinline__ void transpose_tile(float* tile, const float* __restrict__ src, int ld_src, int k0, int n0, int ncount,
                                               u16* dst, size_t dst_row0, int ld_dst, const float* __restrict__ scale, int scale_kmax, int t) {
    const int n = t & 63, kq = t >> 6;
    const int nc = n < ncount ? n : ncount - 1;
    float vv[16];
#pragma unroll
    for (int i = 0; i < 16; ++i) vv[i] = src[(size_t)(k0 + i * 4 + kq) * ld_src + n0 + nc];
#pragma unroll
    for (int i = 0; i < 16; ++i) {
        const int k = i * 4 + kq;
        float v = vv[i];
        if (scale && (k0 + k) < scale_kmax) v *= scale[k0 + k];
        tile[k * 65 + n] = n < ncount ? v : 0.f;
    }
    __syncthreads();
#pragma unroll
    for (int i = 0; i < 2; ++i) {
        const int q = t + 256 * i, nn = q >> 3, kc = q & 7;
        if (nn < ncount) {
            const float* p = tile + (kc * 8) * 65 + nn;
            uint4 o;
            o.x = pack2(p[0], p[65]); o.y = pack2(p[130], p[195]); o.z = pack2(p[260], p[325]); o.w = pack2(p[390], p[455]);
            *(uint4*)(dst + (dst_row0 + nn) * (size_t)ld_dst + k0 + kc * 8) = o;
        }
    }
    __syncthreads();
}

__device__ __forceinline__ void transpose_tile_w(float* tile, const float* __restrict__ src, int ld_src, int k0, int n0,
                                                 u16* dst, size_t dst_row0, int ld_dst, const float* __restrict__ scale, int scale_kmax, int t) {
    f32x4 v[8]; float scv[8];
#pragma unroll
    for (int i = 0; i < 8; ++i) {
        const int q = t + 256 * i, kr = q >> 5, nq = q & 31;
        v[i] = __builtin_nontemporal_load((const f32x4*)(src + (size_t)(k0 + kr) * ld_src + n0 + nq * 4));
        scv[i] = 1.f;
        if (scale) { const int kc = (k0 + kr) < scale_kmax ? (k0 + kr) : scale_kmax - 1; const float sv = scale[kc]; scv[i] = (k0 + kr) < scale_kmax ? sv : 1.f; }
    }
    __builtin_amdgcn_sched_barrier(0);
#pragma unroll
    for (int i = 0; i < 8; ++i) {
        const int q = t + 256 * i, kr = q >> 5, nq = q & 31;
        float* p = tile + kr * 129 + nq * 4;
        p[0] = v[i][0] * scv[i]; p[1] = v[i][1] * scv[i]; p[2] = v[i][2] * scv[i]; p[3] = v[i][3] * scv[i];
    }
    __syncthreads();
#pragma unroll
    for (int i = 0; i < 4; ++i) {
        const int q = t + 256 * i, nn = q >> 3, kc = q & 7;
        const float* p = tile + (kc * 8) * 129 + nn;
        uint4 o;
        o.x = pack2(p[0], p[129]); o.y = pack2(p[258], p[387]); o.z = pack2(p[516], p[645]); o.w = pack2(p[774], p[903]);
        *(uint4*)(dst + (dst_row0 + nn) * (size_t)ld_dst + k0 + kc * 8) = o;
    }
    __syncthreads();
}

namespace g8 {
constexpr int BM = 256, BK = 64, HALF = 128, HTB = HALF * BK * 2, STAGE_BYTES = 8 * HTB;
__device__ __forceinline__ int lds_byte(int r, int c) { const int st = (r >> 4) * 2 + (c >> 5), rr = r & 15, cc = c & 31, ob = rr * 64 + cc * 2; return st * 1024 + (ob ^ (((ob >> 9) & 1) << 5)); }
__device__ __forceinline__ void stage_rc(int b, int& R, int& C) { const int st = b / 1024, sb = b % 1024, swz = sb ^ (((sb >> 9) & 1) << 5); R = (st >> 1) * 16 + swz / 64; C = (st & 1) * 32 + (swz % 64) / 2; }
__device__ __forceinline__ int perm32(int rho) { const int n = rho >> 4, i = rho & 15; return 8 * (i >> 2) + 4 * n + (i & 3); }
__device__ __forceinline__ unsigned cvt_pk_bf16(float lo, float hi) { unsigned r; asm volatile("v_cvt_pk_bf16_f32 %0, %1, %2" : "=v"(r) : "v"(lo), "v"(hi)); return r; }
typedef f32x4 Acc[2][2][4][2];

template <class Prob>
__device__ __forceinline__ int gemm_phase(LAS unsigned char* lds, const Prob& S, int i0 = 0) {
    const int tid = threadIdx.x, wid = __builtin_amdgcn_readfirstlane(tid >> 6), lane = tid & 63, wr = wid >> 2, wc = wid & 3, fr = lane & 15, fq = lane >> 4;
    int nt = 0;
    const size_t kstep = (size_t)(BK * 2);
    const unsigned ldsw = (unsigned)wid * 1024u;
    const int aoff = lds_byte(wr * 64 + fr, fq * 8), boff = lds_byte(wc * 32 + fr, fq * 8);
#define G8_SA(b, h) (((b) * 2 + (h)) * HTB)
#define G8_SB(b, h) ((4 + (b) * 2 + (h)) * HTB)
#define G8_STAGE(bufoff, gbase, voff) do { _Pragma("unroll") for (int _i = 0; _i < 2; ++_i) \
        __builtin_amdgcn_global_load_lds((const unsigned*)((const char*)(gbase) + (voff)[_i]), (LAS unsigned*)(lds + (bufoff) + ldsw + _i * 8192), 16, 0, 0); } while (0)
#define G8_LDA(dst, b, h) do { _Pragma("unroll") for (int m = 0; m < 4; ++m) _Pragma("unroll") for (int k = 0; k < 2; ++k) dst[m][k] = *(const LAS bf16x8*)(lds + G8_SA(b, h) + aoff + m * 2048 + k * 1024); } while (0)
#define G8_LDB(dst, b, h) do { _Pragma("unroll") for (int n = 0; n < 2; ++n) _Pragma("unroll") for (int k = 0; k < 2; ++k) dst[n][k] = *(const LAS bf16x8*)(lds + G8_SB(b, h) + boff + n * 2048 + k * 1024); } while (0)
#define G8_MMA(ai, bj, At, Bt) do { __builtin_amdgcn_s_setprio(1); _Pragma("unroll") for (int m = 0; m < 4; ++m) _Pragma("unroll") for (int n = 0; n < 2; ++n) _Pragma("unroll") for (int k = 0; k < 2; ++k) \
        acc[ai][bj][m][n] = __builtin_amdgcn_mfma_f32_16x16x32_bf16(Bt[n][k], At[m][k], acc[ai][bj][m][n], 0, 0, 0); __builtin_amdgcn_s_setprio(0); } while (0)
#define G8_WAIT_V(n) asm volatile("s_waitcnt vmcnt(" #n ")" ::: "memory")
#define G8_WAIT_L(n) asm volatile("s_waitcnt lgkmcnt(" #n ")" ::: "memory")
#define G8_BAR __builtin_amdgcn_s_barrier()
#define G8_SCHED __builtin_amdgcn_sched_barrier(0)
    typename Prob::Unit cur, nxt; int ui = i0; bool stopped = false;
    if (!S.next(i0, cur)) return -1;
    nt = S.nt(cur);
    S.a_ready(cur);
    Acc acc;
#pragma unroll
    for (int a = 0; a < 2; ++a)
#pragma unroll
        for (int b = 0; b < 2; ++b)
#pragma unroll
            for (int m = 0; m < 4; ++m)
#pragma unroll
                for (int n = 0; n < 2; ++n) acc[a][b][m][n] = (f32x4){0.f, 0.f, 0.f, 0.f};
    bf16x8 At[4][2], B0[2][2], B1[2][2];
    unsigned cOA[2][2], cOB[2][2], nOA[2][2], nOB[2][2];
    S.offs(cur, tid, cOA, cOB);
    const char* cA = S.baseA(cur); const char* cB = S.baseB(cur);
    G8_STAGE(G8_SB(0, 0), cB, cOB[0]); G8_STAGE(G8_SA(0, 0), cA, cOA[0]); G8_STAGE(G8_SB(0, 1), cB, cOB[1]); G8_STAGE(G8_SA(0, 1), cA, cOA[1]);
    if (wr == 1) G8_BAR;
    G8_WAIT_V(4); G8_BAR;
    G8_STAGE(G8_SB(1, 0), cB + kstep, cOB[0]); G8_STAGE(G8_SA(1, 0), cA + kstep, cOA[0]); G8_STAGE(G8_SB(1, 1), cB + kstep, cOB[1]);
    G8_WAIT_V(6); G8_BAR;
    for (;;) {
        bool has_next = S.next(ui + 1, nxt);
        if (has_next && S.brk(cur, nxt)) { has_next = false; stopped = true; }
        const char* nA = cA; const char* nB = cB;
#pragma unroll
        for (int h = 0; h < 2; ++h)
#pragma unroll
            for (int i = 0; i < 2; ++i) { nOA[h][i] = cOA[h][i]; nOB[h][i] = cOB[h][i]; }
        if (has_next) { S.offs(nxt, tid, nOA, nOB); nA = S.baseA(nxt); nB = S.baseB(nxt); }
#pragma unroll 1
        for (int t = 0; t < nt; t += 2) {
            const bool last = (t == nt - 2);
            if (Prob::MIDT > 0 && t == Prob::MIDT) S.mid(acc, cur, wr, fr);
            if (last && has_next) S.a_ready(nxt);
            const char* a1 = cA + (size_t)(t + 1) * kstep;
            const char* a2 = last ? nA : cA + (size_t)(t + 2) * kstep; const char* b2 = last ? nB : cB + (size_t)(t + 2) * kstep;
            const char* a3 = a2 + kstep; const char* b3 = b2 + kstep;
            unsigned xA[2][2], xB[2][2];
#pragma unroll
            for (int h = 0; h < 2; ++h)
#pragma unroll
                for (int i = 0; i < 2; ++i) { xA[h][i] = last ? nOA[h][i] : cOA[h][i]; xB[h][i] = last ? nOB[h][i] : cOB[h][i]; }
            G8_LDB(B0, 0, 0); G8_SCHED; G8_LDA(At, 0, 0); G8_STAGE(G8_SA(1, 1), a1, cOA[1]);
            G8_WAIT_L(8); G8_BAR; G8_WAIT_L(0); G8_MMA(0, 0, At, B0); G8_BAR; G8_SCHED;
            G8_LDB(B1, 0, 1); G8_STAGE(G8_SB(0, 0), b2, xB[0]);
            G8_BAR; G8_WAIT_L(0); G8_MMA(0, 1, At, B1); G8_BAR;
            G8_LDA(At, 0, 1); G8_STAGE(G8_SA(0, 0), a2, xA[0]);
            G8_BAR; G8_WAIT_L(0); G8_MMA(1, 0, At, B0); G8_BAR; G8_SCHED;
            G8_STAGE(G8_SB(0, 1), b2, xB[1]);
            G8_WAIT_V(6); G8_BAR; G8_MMA(1, 1, At, B1); G8_BAR;
            G8_LDB(B0, 1, 0); G8_SCHED; G8_LDA(At, 1, 0); G8_STAGE(G8_SA(0, 1), a2, xA[1]);
            G8_WAIT_L(8); G8_BAR; G8_WAIT_L(0); G8_MMA(0, 0, At, B0); G8_BAR; G8_SCHED;
            G8_LDB(B1, 1, 1); G8_STAGE(G8_SB(1, 0), b3, xB[0]);
            G8_BAR; G8_WAIT_L(0); G8_MMA(0, 1, At, B1); G8_BAR;
            G8_LDA(At, 1, 1); G8_STAGE(G8_SA(1, 0), a3, xA[0]);
            G8_BAR; G8_WAIT_L(0); G8_MMA(1, 0, At, B0); G8_BAR; G8_SCHED;
            G8_STAGE(G8_SB(1, 1), b3, xB[1]);
            G8_WAIT_V(6); G8_BAR; G8_MMA(1, 1, At, B1); G8_BAR;
        }
        S.epi(acc, cur, wr, wc, fr, fq);
        S.done(cur);
        if (!has_next) break;
#pragma unroll
        for (int a = 0; a < 2; ++a)
#pragma unroll
            for (int b = 0; b < 2; ++b)
#pragma unroll
                for (int m = 0; m < 4; ++m)
#pragma unroll
                    for (int n = 0; n < 2; ++n) acc[a][b][m][n] = (f32x4){0.f, 0.f, 0.f, 0.f};
        cur = nxt; cA = nA; cB = nB; ++ui; nt = S.nt(cur);
#pragma unroll
        for (int h = 0; h < 2; ++h)
#pragma unroll
            for (int i = 0; i < 2; ++i) { cOA[h][i] = nOA[h][i]; cOB[h][i] = nOB[h][i]; }
    }
    G8_WAIT_V(0);
    if (wr == 0) G8_BAR;
    G8_BAR;
    const int ret_next = stopped ? ui + 1 : -1;
#undef G8_SA
#undef G8_SB
#undef G8_STAGE
#undef G8_LDA
#undef G8_LDB
#undef G8_MMA
#undef G8_WAIT_V
#undef G8_WAIT_L
#undef G8_BAR
#undef G8_SCHED
    return ret_next;
}
__device__ __forceinline__ void dense_unit(int wgid, int nM, int nN, int& pm, int& pn) {
    const int nwg = nM * nN, NXCD = 8, WGM = 8;
    { const int q = nwg / NXCD, r = nwg % NXCD, xcd = wgid % NXCD, off = wgid / NXCD; wgid = (xcd < r ? xcd * (q + 1) : r * (q + 1) + (xcd - r) * q) + off; }
    const int nig = WGM * nN, gid = wgid / nig, fm = gid * WGM, gsz = (nM - fm) < WGM ? (nM - fm) : WGM;
    pm = fm + ((wgid % nig) % gsz); pn = (wgid % nig) / gsz;
}
}

__device__ void phase0(const Params& P, char* lds_all) {
    unsigned char* ws = P.ws;
    const int vb = threadIdx.x >> 8, t = threadIdx.x & 255;
    char* lds = lds_all + vb * VLDS;
    float* tile = (float*)lds;
    const int NU = 744;
    for (int u = blockIdx.x * 2 + vb; u < NU; u += gridDim.x * 2) {
        if (u < 384) {
            int nt, v, n0b, drb;
            if (u < 192) { v = u; n0b = 0; drb = 0; }
            else if (u < 256) { v = u - 192; n0b = 1552; drb = 1536; }
            else if (u < 320) { v = u - 256; n0b = 2576; drb = 2048; }
            else { v = u - 320; n0b = 2064; drb = 2816; }
            nt = v >> 4;
            transpose_tile_w(tile, P.in[I_WIN], 3104, (v & 15) * 64, n0b + nt * 128, (u16*)(ws + O_WIN), drb + nt * 128, 1024, nullptr, 0, t);
        } else if (u < 416) {
            const int v = u - 384;
            if (v < 16) transpose_tile(tile, P.in[I_WIN], 3104, v * 64, 1536, 16, (u16*)(ws + O_WIN), 2560, 1024, nullptr, 0, t);
            else transpose_tile(tile, P.in[I_WIN], 3104, (v - 16) * 64, 3088, 16, (u16*)(ws + O_WIN), 2576, 1024, nullptr, 0, t);
        } else if (u < 544) {
            const int v = u - 416, nt = v >> 4;
            transpose_tile_w(tile, P.in[I_WOUT], 1024, (v & 15) * 64, nt * 128, (u16*)(ws + O_WOUT), nt * 128, 1024, P.in[I_SNW], 512, t);
        } else if (u < 552) {
            const int base = (u - 544) * 4096;
            for (int i = 0; i < 16; ++i) {
                const int idx = base + t + 256 * i;
                if (idx < 224 * 128) *(uint4*)(ws + O_WIN + ((size_t)(2592 + (idx >> 7)) * 1024 + (idx & 127) * 8) * 2) = make_uint4(0, 0, 0, 0);
            }
        } else {
            const int c0 = (u - 552) * 32;
            float* sc = (float*)lds;
            float* red = sc + 5 * 1024;
            {
                float cv[20];
#pragma unroll
                for (int q = 0; q < 20; ++q) cv[q] = q < 16 ? P.in[I_C][t + 256 * q] : P.in[I_CCTX][t + 256 * (q - 16)];
                __builtin_amdgcn_sched_barrier(0);
#pragma unroll
                for (int q = 0; q < 20; ++q) sc[t + 256 * q] = siluf(cv[q]);
            }
            __syncthreads();
            const int cq = t & 7, kg = t >> 3;
            float4 a0 = {0, 0, 0, 0}, a1 = a0, a2 = a0, a3 = a0, a4 = a0;
            const float* wp = P.in[I_WMOD] + (size_t)(kg * 32) * 6144 + c0 + cq * 4;
#pragma unroll 1
            for (int kb = 0; kb < 32; kb += 16) {
                f32x4 wvv[16];
#pragma unroll
                for (int k = 0; k < 16; ++k) wvv[k] = __builtin_nontemporal_load((const f32x4*)(wp + (size_t)(kb + k) * 6144));
                __builtin_amdgcn_sched_barrier(0);
#pragma unroll
                for (int k = 0; k < 16; ++k) {
                    if ((k & 3) == 0) __builtin_amdgcn_sched_barrier(0);
                    const f32x4 wv = wvv[k];
                    const int kk = kg * 32 + kb + k;
                    const float s0 = sc[kk], s1 = sc[1024 + kk], s2 = sc[2048 + kk], s3 = sc[3072 + kk], s4 = sc[4096 + kk];
                    a0.x += s0 * wv[0]; a0.y += s0 * wv[1]; a0.z += s0 * wv[2]; a0.w += s0 * wv[3];
                    a1.x += s1 * wv[0]; a1.y += s1 * wv[1]; a1.z += s1 * wv[2]; a1.w += s1 * wv[3];
                    a2.x += s2 * wv[0]; a2.y += s2 * wv[1]; a2.z += s2 * wv[2]; a2.w += s2 * wv[3];
                    a3.x += s3 * wv[0]; a3.y += s3 * wv[1]; a3.z += s3 * wv[2]; a3.w += s3 * wv[3];
                    a4.x += s4 * wv[0]; a4.y += s4 * wv[1]; a4.z += s4 * wv[2]; a4.w += s4 * wv[3];
                }
                __builtin_amdgcn_sched_barrier(0);
            }
            *(float4*)(red + ((kg * 5 + 0) * 32) + cq * 4) = a0; *(float4*)(red + ((kg * 5 + 1) * 32) + cq * 4) = a1;
            *(float4*)(red + ((kg * 5 + 2) * 32) + cq * 4) = a2; *(float4*)(red + ((kg * 5 + 3) * 32) + cq * 4) = a3;
            *(float4*)(red + ((kg * 5 + 4) * 32) + cq * 4) = a4;
            __syncthreads();
            if (t < 160) {
                const int r = t >> 5, cc = t & 31;
                float s = P.in[I_BMOD][c0 + cc];
#pragma unroll
                for (int g = 0; g < 32; ++g) s += red[(g * 5 + r) * 32 + cc];
                ((float*)(ws + O_MOD))[r * 6144 + c0 + cc] = s;
            }
            __syncthreads();
        }
    }
    if (blockIdx.x == 0 && threadIdx.x < 32) ((int*)(ws + O_CNT))[threadIdx.x * 64] = 0;
}

__device__ void phase1(const Params& P) {
    unsigned char* ws = P.ws;
    const int lane = threadIdx.x & 63;
    const int gw = blockIdx.x * 8 + (threadIdx.x >> 6), nw = gridDim.x * 8;
    const float* mod = (const float*)(ws + O_MOD);
    u16* xn = (u16*)(ws + O_XN);
    const int r_lo = (int)(((long long)gw * MALL) / nw), r_hi = (int)(((long long)(gw + 1) * MALL) / nw);
    float4 mul[4], sh[4];
    int cur_mb = -1;
    for (int row = r_lo; row < r_hi; row += 2) {
        const bool two = row + 1 < r_hi;
        const int row1 = two ? row + 1 : row;
        const float* x0 = row < MLAT ? P.in[I_X] + (size_t)row * 1024 : P.in[I_CTX] + (size_t)(row - MLAT) * 1024;
        const float* x1 = row1 < MLAT ? P.in[I_X] + (size_t)row1 * 1024 : P.in[I_CTX] + (size_t)(row1 - MLAT) * 1024;
        float4 v0[4], v1[4];
#pragma unroll
        for (int j = 0; j < 4; ++j) { const f32x4 a = __builtin_nontemporal_load((const f32x4*)x0 + lane + 64 * j), c = __builtin_nontemporal_load((const f32x4*)x1 + lane + 64 * j);
            v0[j] = make_float4(a[0], a[1], a[2], a[3]); v1[j] = make_float4(c[0], c[1], c[2], c[3]); }
        const int mb0 = row < MLAT ? (row >> 12) : 4, mb1 = row1 < MLAT ? (row1 >> 12) : 4;
        float s0 = 0.f, s1 = 0.f;
#pragma unroll
        for (int j = 0; j < 4; ++j) {
            s0 += v0[j].x * v0[j].x + v0[j].y * v0[j].y + v0[j].z * v0[j].z + v0[j].w * v0[j].w;
            s1 += v1[j].x * v1[j].x + v1[j].y * v1[j].y + v1[j].z * v1[j].z + v1[j].w * v1[j].w;
        }
        s0 = rsqrtf(wave_sum(s0) * (1.f / 1024.f) + 1e-6f);
        s1 = rsqrtf(wave_sum(s1) * (1.f / 1024.f) + 1e-6f);
#pragma unroll 1
        for (int rr = 0; rr < 2; ++rr) {
            const int mb = rr ? mb1 : mb0;
            if (mb != cur_mb) {
                cur_mb = mb;
#pragma unroll
                for (int j = 0; j < 4; ++j) {
                    const int k = (lane + 64 * j) * 4;
                    const float4 nwv = *(const float4*)(P.in[I_N1W] + k);
                    const float4 sc = *(const float4*)(mod + mb * 6144 + 1024 + k);
                    sh[j] = *(const float4*)(mod + mb * 6144 + k);
                    mul[j].x = nwv.x * (1.f + sc.x); mul[j].y = nwv.y * (1.f + sc.y); mul[j].z = nwv.z * (1.f + sc.z); mul[j].w = nwv.w * (1.f + sc.w);
                }
            }
            if (rr == 1 && !two) break;
            const float rstd = rr ? s1 : s0;
            const int orow = rr ? row1 : row;
#pragma unroll
            for (int j = 0; j < 4; ++j) {
                const int k = (lane + 64 * j) * 4;
                const float4 vv = rr ? v1[j] : v0[j];
                uint2 o;
                o.x = pack2(vv.x * rstd * mul[j].x + sh[j].x, vv.y * rstd * mul[j].y + sh[j].y);
                o.y = pack2(vv.z * rstd * mul[j].z + sh[j].z, vv.w * rstd * mul[j].w + sh[j].w);
                *(uint2*)(xn + (size_t)orow * 1024 + k) = o;
            }
        }
    }
}

struct InProj {
    static constexpr int K = 1024; static constexpr bool PERM = true; static constexpr int MIDT = 0;
    struct Unit { int pm, pn, vt; };
    const unsigned char* ws; int G, c;
    __device__ __forceinline__ bool next(int i, Unit& u) const {
        const int L = i * G + c;
        if (L >= 884) return false;
        if (L < 748) { u.vt = 0; g8::dense_unit(L, 68, 11, u.pm, u.pn); }
        else { const int v = L - 748; u.vt = 1; u.pm = v / 68; u.pn = v % 68; }
        return true;
    }
    __device__ __forceinline__ const char* baseA(const Unit& u) const { return (const char*)(ws + (u.vt ? O_WIN : O_XN)); }
    __device__ __forceinline__ const char* baseB(const Unit& u) const { return (const char*)(ws + (u.vt ? O_XN : O_WIN)); }
    __device__ __forceinline__ void offs(const Unit& u, int tid_, unsigned (&oa)[2][2], unsigned (&ob)[2][2]) const {
        int R[2], C[2];
        { int tq = tid_; asm volatile("" : "+v"(tq)); g8::stage_rc(tq * 16, R[0], C[0]); g8::stage_rc(tq * 16 + 8192, R[1], C[1]); }
#pragma unroll
        for (int h = 0; h < 2; ++h)
#pragma unroll
            for (int i = 0; i < 2; ++i) {
                const int Rb = (R[i] & ~31) + g8::perm32(R[i] & 31);
                if (!u.vt) {
                    int ar = u.pm * 256 + h * 128 + R[i];
                    if (u.pn == 6 || u.pn == 7) ar = colmajor_src_row(ar);
                    oa[h][i] = (unsigned)(ar * 1024 + C[i]) * 2u;
                    ob[h][i] = (unsigned)((u.pn * 256 + h * 128 + Rb) * 1024 + C[i]) * 2u;
                } else {
                    oa[h][i] = (unsigned)((2816 + u.pm * 256 + h * 128 + R[i]) * 1024 + C[i]) * 2u;
                    ob[h][i] = (unsigned)(colmajor_src_row(u.pn * 256 + h * 128 + Rb) * 1024 + C[i]) * 2u;
                }
            }
    }
    __device__ __forceinline__ void mid(g8::Acc&, const Unit&, int, int) const {}
    __device__ __forceinline__ int nt(const Unit&) const { return 16; }
    __device__ __forceinline__ bool brk(const Unit&, const Unit&) const { return false; }
    __device__ __forceinline__ void a_ready(const Unit&) const {}
    __device__ __forceinline__ void done(const Unit&) const {}
    __device__ __forceinline__ void epi(g8::Acc& acc, const Unit& u, int wr, int wc, int fr, int fq) const {
        unsigned char* w = (unsigned char*)ws;
        const int row0 = u.pm * 256 + wr * 64 + fr;
        const int col0 = wc * 32 + 8 * fq;
        if (u.vt) {
            const int tok0 = u.pn * 256 + col0;
#pragma unroll
            for (int ai = 0; ai < 2; ++ai)
#pragma unroll
                for (int m = 0; m < 4; ++m) {
                    const int ch = row0 + ai * 128 + m * 16;
#pragma unroll
                    for (int bj = 0; bj < 2; ++bj) {
                        const int tk = tok0 + bj * 128;
                        u16* d;
                        int ctile, lw;
                        if (tk < MLAT) { ctile = (tk >> 12) * NCH + 2 + ((tk & 4095) >> 7); lw = tk & 127; }
                        else { const int tc = tk - MLAT; ctile = (tc >> 8) * NCH + ((tc & 255) >> 7); lw = tc & 127; }
                        d = (u16*)(w + O_VT) + ((size_t)ctile * 512 + ch) * 128 + lw;
                        const f32x4 v0 = acc[ai][bj][m][0], v1 = acc[ai][bj][m][1];
                        u32x4 o; o.x = g8::cvt_pk_bf16(v0[0], v0[1]); o.y = g8::cvt_pk_bf16(v0[2], v0[3]); o.z = g8::cvt_pk_bf16(v1[0], v1[1]); o.w = g8::cvt_pk_bf16(v1[2], v1[3]);
                        *(u32x4*)d = o;
                    }
                }
            return;
        }
        if (u.pn == 10) {
            if (wc == 0) {
                float* dst = (float*)(w + (fq < 2 ? O_PSD : O_PSG)) + (fq & 1) * 8;
#pragma unroll
                for (int ai = 0; ai < 2; ++ai)
#pragma unroll
                    for (int m = 0; m < 4; ++m) {
                        float* d = dst + (size_t)(row0 + ai * 128 + m * 16) * 16;
                        *(f32x4*)d = acc[ai][0][m][0];
                        *(f32x4*)(d + 4) = acc[ai][0][m][1];
                    }
            }
            return;
        }
        u16* base; size_t ld, bjstep;
        if (u.pn < 2) { base = (u16*)(w + O_ZO) + u.pn * 256 + col0; ld = 1024; bjstep = 128; }
        else if (u.pn < 8) {
            const int cg0 = (u.pn - 2) * 4 + (col0 >> 6);
            base = (u16*)(w + O_PT) + (size_t)cg0 * MALL * 64 + (col0 & 63); ld = 64; bjstep = (size_t)2 * MALL * 64;
        }
        else { base = (u16*)(w + O_ZO) + 512 + (u.pn - 8) * 256 + col0; ld = 1024; bjstep = 128; }
#pragma unroll
        for (int ai = 0; ai < 2; ++ai)
#pragma unroll
            for (int m = 0; m < 4; ++m) {
                u16* rowp = base + (size_t)(row0 + ai * 128 + m * 16) * ld;
#pragma unroll
                for (int bj = 0; bj < 2; ++bj) {
                    const f32x4 v0 = acc[ai][bj][m][0], v1 = acc[ai][bj][m][1];
                    u32x4 o; o.x = g8::cvt_pk_bf16(v0[0], v0[1]); o.y = g8::cvt_pk_bf16(v0[2], v0[3]); o.z = g8::cvt_pk_bf16(v1[0], v1[1]); o.w = g8::cvt_pk_bf16(v1[2], v1[3]);
                    *(u32x4*)(rowp + bj * bjstep) = o;
                }
            }
    }
};

__device__ void phase3(const Params& P, char* lds_all) {
    unsigned char* ws = P.ws;
    const int vb = threadIdx.x >> 8, t = threadIdx.x & 255;
    char* lds = lds_all + vb * VLDS;
    u16* raw = (u16*)lds;
    float* xcl = (float*)(lds + 132 * 128);
    const u16* pt = (const u16*)(ws + O_PT);
    const int NCONV = 136 * 24;
    for (int ct = blockIdx.x * 2 + vb; ct < 136; ct += gridDim.x * 2) {
        const int b = ct / NCH, cc = ct % NCH;
        const int rb = cc < 2 ? MLAT + b * 256 + cc * 128 : b * 4096 + (cc - 2) * 128;
        const int row = rb + (t >> 1), half = t & 1;
        const float* psd = (const float*)(ws + O_PSD) + (size_t)row * 16 + half * 8;
        float* dt = (float*)(ws + O_DT) + (size_t)row * 16 + half * 8;
        const float4 pa = *(const float4*)psd, pb = *(const float4*)(psd + 4);
        const float* psg = (const float*)(ws + O_PSG) + (size_t)colmajor_src_row(row) * 16 + half * 8;
        const float4 ga = *(const float4*)psg, gb = *(const float4*)(psg + 4);
        const float pv[8] = {pa.x, pa.y, pa.z, pa.w, pb.x, pb.y, pb.z, pb.w}, gv[8] = {ga.x, ga.y, ga.z, ga.w, gb.x, gb.y, gb.z, gb.w};
        const float4 db0 = *(const float4*)(P.in[I_DTB] + half * 8), db1 = *(const float4*)(P.in[I_DTB] + half * 8 + 4);
        const float4 gb0 = *(const float4*)(P.in[I_GB] + half * 8), gb1 = *(const float4*)(P.in[I_GB] + half * 8 + 4);
        const float dbv[8] = {db0.x, db0.y, db0.z, db0.w, db1.x, db1.y, db1.z, db1.w}, gbv[8] = {gb0.x, gb0.y, gb0.z, gb0.w, gb1.x, gb1.y, gb1.z, gb1.w};
        float od[8], og[8];
#pragma unroll
        for (int j = 0; j < 8; ++j) {
            od[j] = softplusf(pv[j] + dbv[j]);
            const float xx = gv[j] + gbv[j];
            og[j] = half == 0 ? xx : fminf(xx, 0.f) - log1pf(__expf(-fabsf(xx)));
        }
        *(float4*)dt = make_float4(od[0], od[1], od[2], od[3]); *(float4*)(dt + 4) = make_float4(od[4], od[5], od[6], od[7]);
        float* gout = (float*)(ws + (half == 0 ? O_GI : O_GF)) + (size_t)row * 8;
        *(float4*)gout = make_float4(og[0], og[1], og[2], og[3]); *(float4*)(gout + 4) = make_float4(og[4], og[5], og[6], og[7]);
    }
    u32x4 rr[5];
#define P3_PREFETCH(uu) do { \
        const int _u = (uu), _ct = _u / 24, _cg = _u % 24, _b = _ct / NCH, _cc = _ct % NCH; const bool _ctx = _cc < 2; \
        const int _L = _ctx ? 256 : 4096, _lpos = _ctx ? _cc * 128 : (_cc - 2) * 128, _rb = _ctx ? MLAT + _b * 256 + _cc * 128 : _b * 4096 + (_cc - 2) * 128, _sb = _rb - _lpos; \
        _Pragma("unroll") for (int _i = 0; _i < 5; ++_i) { const int _q = t + 256 * _i, _r = (_q >> 3) < 132 ? (_q >> 3) : 131, _c = _q & 7; \
            const int _l = _lpos - 2 + _r, _lc = _l < 0 ? 0 : (_l >= _L ? _L - 1 : _l); \
            u32x4 _v = *(const u32x4*)(pt + ((size_t)_cg * MALL + _sb + _lc) * 64 + _c * 8); \
            if (_l != _lc) _v = (u32x4){0u, 0u, 0u, 0u}; \
            rr[_i] = _v; } \
    } while (0)
    if ((int)(blockIdx.x * 2 + vb) < NCONV) P3_PREFETCH(blockIdx.x * 2 + vb);
    for (int u = blockIdx.x * 2 + vb; u < NCONV; u += gridDim.x * 2) {
        const int ct = u / 24, cgp = u % 24;
        const int b = ct / NCH, cc = ct % NCH;
        const bool isctx = cc < 2;
        const int rb = isctx ? MLAT + b * 256 + cc * 128 : b * 4096 + (cc - 2) * 128;
        const bool isml = cgp >= 16;
#pragma unroll
        for (int i = 0; i < 5; ++i) { const int q = t + 256 * i; if (q < 132 * 8) *(u32x4*)(raw + (q >> 3) * 64 + (q & 7) * 8) = rr[i]; }
        __syncthreads();
        if (u + (int)gridDim.x * 2 < NCONV) P3_PREFETCH(u + gridDim.x * 2);
        const int ch = t & 63, tg = t >> 6;
        const float* cw = isml ? P.in[I_MCW] + (cgp - 16) * 64 + ch : P.in[I_SCW] + cgp * 64 + ch;
        const int cwld = isml ? 512 : 1024;
        const float w0 = cw[0], w1 = cw[cwld], w2 = cw[2 * cwld], w3 = cw[3 * cwld], w4 = cw[4 * cwld];
        const float bias = isml ? P.in[I_MCB][(cgp - 16) * 64 + ch] : P.in[I_SCB][cgp * 64 + ch];
        const int tok0 = tg * 32;
        float x0 = bf2f(raw[(tok0 + 0) * 64 + ch]), x1 = bf2f(raw[(tok0 + 1) * 64 + ch]), x2 = bf2f(raw[(tok0 + 2) * 64 + ch]), x3 = bf2f(raw[(tok0 + 3) * 64 + ch]);
        if (!isml) {
            float ov[32];
#pragma unroll
            for (int j = 0; j < 32; ++j) {
                const float x4 = bf2f(raw[(tok0 + j + 4) * 64 + ch]);
                const float cv = bias + w0 * x0 + w1 * x1 + w2 * x2 + w3 * x3 + w4 * x4;
                ov[j] = siluf(cv);
                x0 = x1; x1 = x2; x2 = x3; x3 = x4;
            }
            if (cgp < 12) {
                const int chg = cgp < 8 ? cgp * 64 + ch : (cgp - 8) * 64 + ch;
                u16* tdst = cgp < 8 ? (u16*)(ws + O_XT) + ((size_t)ct * 512 + chg) * 128 + tok0 : (u16*)(ws + O_BT) + ((size_t)ct * 256 + chg) * 128 + tok0;
#pragma unroll
                for (int o8 = 0; o8 < 4; ++o8) {
                    u32x4 o; o.x = pack2(ov[o8 * 8 + 0], ov[o8 * 8 + 1]); o.y = pack2(ov[o8 * 8 + 2], ov[o8 * 8 + 3]); o.z = pack2(ov[o8 * 8 + 4], ov[o8 * 8 + 5]); o.w = pack2(ov[o8 * 8 + 6], ov[o8 * 8 + 7]);
                    *(u32x4*)(tdst + o8 * 8) = o;
                }
            }
            if (cgp >= 8) {
                const int gn = (cgp < 12 ? cgp - 8 : cgp - 12) * 64 + ch;
                u16* ndst = (u16*)(ws + (cgp < 12 ? O_BM : O_CM)) + ((size_t)ct * 2 + (gn >> 7)) * 16384 + (size_t)tok0 * 128 + (gn & 127);
#pragma unroll
                for (int j = 0; j < 32; ++j) ndst[(size_t)j * 128] = f2bf(ov[j]);
            }
            __syncthreads();
        } else {
            const int mg = cgp - 16;
            const int n = ch >> 2, kk = ch & 3, ng = mg * 16 + n;
            const float* wq = P.in[I_WQK] + ((size_t)(0 * 128 + ng) * 4) * 4 + kk;
            const float* wk = P.in[I_WQK] + ((size_t)(1 * 128 + ng) * 4) * 4 + kk;
            const float q0 = wq[0], q1 = wq[4], q2 = wq[8], q3 = wq[12];
            const float k0 = wk[0], k1 = wk[4], k2 = wk[8], k3 = wk[12];
            u16* xcd = (u16*)(ws + O_XC) + ((size_t)ct * 4 + (mg >> 1)) * 16384 + (size_t)tok0 * 128 + (mg & 1) * 64 + ch;
#pragma unroll 8
            for (int j = 0; j < 32; ++j) {
                const int tok = tok0 + j;
                const float x4 = bf2f(raw[(tok + 4) * 64 + ch]);
                const float cv = bias + w0 * x0 + w1 * x1 + w2 * x2 + w3 * x3 + w4 * x4;
                const float sv = siluf(cv);
                xcl[tok * 64 + ch] = sv;
                xcd[(size_t)j * 128] = f2bf(sv);
                x0 = x1; x1 = x2; x2 = x3; x3 = x4;
            }
            __syncthreads();
            const int chg = mg * 64 + ch;
            const size_t hoff = ((size_t)ct * 4 + (mg >> 1)) * 16384 + (size_t)tok0 * 128 + (mg & 1) * 64 + ch;
            u16* qd = (u16*)(ws + O_Q) + hoff;
            u16* kd = (u16*)(ws + O_K) + hoff;
            u16* ktd = (u16*)(ws + O_KT) + ((size_t)ct * 512 + chg) * 128 + tok0;
#pragma unroll
            for (int o8 = 0; o8 < 4; ++o8) {
                float kv[8];
#pragma unroll
                for (int j = 0; j < 8; ++j) {
                    const int tok = tok0 + o8 * 8 + j;
                    const float4 xv = *(const float4*)(xcl + tok * 64 + n * 4);
                    const float qv = xv.x * q0 + xv.y * q1 + xv.z * q2 + xv.w * q3;
                    kv[j] = (xv.x * k0 + xv.y * k1 + xv.z * k2 + xv.w * k3) * 0.08838834764831845f;
                    qd[(size_t)(o8 * 8 + j) * 128] = f2bf(qv);
                    kd[(size_t)(o8 * 8 + j) * 128] = f2bf(kv[j]);
                }
                uint4 o; o.x = pack2(kv[0], kv[1]); o.y = pack2(kv[2], kv[3]); o.z = pack2(kv[4], kv[5]); o.w = pack2(kv[6], kv[7]);
                *(uint4*)(ktd + o8 * 8) = o;
            }
            __syncthreads();
        }
    }
}

__device__ __forceinline__ u32x4 scale8(const u32x4 v, const float* ww) {
    u32x4 o;
    o.x = pack2(bflo(v.x) * ww[0], bfhi(v.x) * ww[1]); o.y = pack2(bflo(v.y) * ww[2], bfhi(v.y) * ww[3]);
    o.z = pack2(bflo(v.z) * ww[4], bfhi(v.z) * ww[5]); o.w = pack2(bflo(v.w) * ww[6], bfhi(v.w) * ww[7]);
    return o;
}
__device__ void phase4(const Params& P, char* lds) {
    unsigned char* ws = P.ws;
    char* T0 = lds; char* T1 = lds + 32768;
    float* sc = (float*)(lds + 65536);
    float* wA = sc + 256;
    float* wB = sc + 384;
    const int NSSD = 4 * NCH * 8, NML = 4 * NCH * 4, NU4 = NSSD + NML;
    u32x4 RA[4], RB[4];
    float ps0 = 0.f, ps1 = 0.f, ps2 = 0.f, ps3 = 0.f;
#define P4_PREFETCH(uu) do { \
        const int _u = (uu); const bool _ssd = _u < NSSD; const int _v = _ssd ? _u : _u - NSSD; \
        const int _h = _ssd ? (_v & 7) : (_v & 3), _ct = _ssd ? (_v >> 3) : (_v >> 2), _b = _ct / NCH, _cc = _ct % NCH; \
        const int _rb = _cc < 2 ? MLAT + _b * 256 + _cc * 128 : _b * 4096 + (_cc - 2) * 128; \
        const u16* _pa = _ssd ? (const u16*)(ws + O_XT) + ((size_t)_ct * 512 + _h * 64) * 128 : (const u16*)(ws + O_VT) + ((size_t)_ct * 512 + _h * 128) * 128; \
        const u16* _pb = _ssd ? (const u16*)(ws + O_BT) + ((size_t)_ct * 256 + (_h >> 2) * 128) * 128 : (const u16*)(ws + O_KT) + ((size_t)_ct * 512 + _h * 128) * 128; \
        _Pragma("unroll") for (int _i = 0; _i < 4; ++_i) { const int _q = (int)threadIdx.x + 512 * _i; const size_t _o = (size_t)(_q >> 4) * 128 + (_q & 15) * 8; \
            RA[_i] = *(const u32x4*)(_pa + _o); RB[_i] = *(const u32x4*)(_pb + _o); } \
        if (threadIdx.x < 128) { const int _dir = threadIdx.x >> 6, _ln = threadIdx.x & 63; const int _l0 = _dir ? 127 - 2 * _ln : 2 * _ln, _l1 = _dir ? 126 - 2 * _ln : 2 * _ln + 1; \
            if (_ssd) { const float* _dp = (const float*)(ws + O_DT) + (size_t)_rb * 16 + _dir * 8 + _h; ps0 = _dp[_l0 * 16]; ps1 = _dp[_l1 * 16]; } \
            else { const float* _gf = (const float*)(ws + O_GF) + (size_t)_rb * 8 + _dir * 4 + _h; const float* _gi = (const float*)(ws + O_GI) + (size_t)_rb * 8 + _dir * 4 + _h; \
                   ps0 = _gf[_l0 * 8]; ps1 = _gf[_l1 * 8]; ps2 = _gi[_l0 * 8]; ps3 = _gi[_l1 * 8]; } } \
    } while (0)
    if ((int)blockIdx.x < NU4) P4_PREFETCH(blockIdx.x);
    for (int u = blockIdx.x; u < NU4; u += gridDim.x) {
        int t = threadIdx.x; asm volatile("" : "+v"(t));
        const int lane = t & 63, w = t >> 6, wm = w >> 1, wn = w & 1, lr = lane & 15, lq = lane >> 4;
        const bool isssd = u < NSSD;
        const int v = isssd ? u : u - NSSD;
        const int h = isssd ? (v & 7) : (v & 3), ct = isssd ? (v >> 3) : (v >> 2), b = ct / NCH, cc = ct % NCH;
        const int un = u + (int)gridDim.x;
        if (isssd) {
            if (w < 2) {
                const int dir = w;
                const int l0 = dir ? 127 - 2 * lane : 2 * lane, l1 = dir ? 126 - 2 * lane : 2 * lane + 1;
                const float d0 = ps0, d1 = ps1;
                const float an = -__expf(P.in[I_ALOG][dir * 8 + h]);
                const float p0 = d0 * an, p1 = p0 + d1 * an;
                const float inc = wave_scan_sum(p1, lane);
                const float ex = inc - p1;
                const float tot = __shfl(inc, 63);
                float* wd = dir ? wB : wA;
                wd[l0] = __expf(tot - (ex + p0)) * d0; wd[l1] = __expf(tot - (ex + p1)) * d1;
                if (lane == 0) ((float*)(ws + O_ACH))[((size_t)(b * NCH + cc) * 8 + h) * 2 + dir] = tot;
            }
            __syncthreads();
#pragma unroll
            for (int i = 0; i < 2; ++i) {
                const int q = t + 512 * i, r = q >> 4, c = q & 15;
                *(u32x4*)(T0 + swz256(r, c)) = scale8(RA[i], wA + c * 8); *(u32x4*)(T0 + swz256(64 + r, c)) = scale8(RA[i], wB + c * 8);
            }
#pragma unroll
            for (int i = 0; i < 4; ++i) { const int q = t + 512 * i, r = q >> 4, c = q & 15; *(u32x4*)(T1 + swz256(r, c)) = RB[i]; }
            __syncthreads();
            if (un < NU4) P4_PREFETCH(un);
            f32x4 acc[2][4]; zero_acc(acc);
            lds_mma_t<2, 4>(T0, T1, wm * 32, wn * 64, acc, lane);
            u16* st = (u16*)(ws + O_ST) + (((size_t)(b * NCH + cc) * 8 + h) * 2 + (wm >> 1)) * 8192 + ((wm & 1) * 32 + lr) * 128 + wn * 64 + lq * 4;
#pragma unroll
            for (int i = 0; i < 2; ++i)
#pragma unroll
                for (int j = 0; j < 4; ++j) {
                    uint2 o; o.x = pack2(acc[i][j][0], acc[i][j][1]); o.y = pack2(acc[i][j][2], acc[i][j][3]);
                    *(uint2*)(st + (i * 16) * 128 + j * 16) = o;
                }
            __syncthreads();
        } else {
            if (w < 2) {
                const int dir = w;
                const int s0 = dir ? 127 - 2 * lane : 2 * lane, s1 = dir ? 126 - 2 * lane : 2 * lane + 1;
                const float f0 = ps0, f1 = ps1, i0 = ps2, i1 = ps3;
                const float p1 = f0 + f1;
                const float inc = wave_scan_sum(p1, lane);
                const float ex = inc - p1;
                const float tot = __shfl(inc, 63);
                const float av0 = tot - (ex + f0) + i0, av1 = tot - (ex + p1) + i1;
                const float mloc = wave_max(fmaxf(av0, av1));
                float* wd = dir ? wB : wA;
                wd[s0] = __expf(av0 - mloc); wd[s1] = __expf(av1 - mloc);
                if (lane == 0) {
                    float* mls = (float*)(ws + O_MLS) + (((size_t)(b * NCH + cc) * 4 + h) * 2 + dir) * 2;
                    mls[0] = mloc; mls[1] = tot;
                }
            }
            __syncthreads();
#pragma unroll
            for (int d2 = 0; d2 < 2; ++d2) {
                const float* wsel = d2 ? wB : wA;
#pragma unroll
                for (int i = 0; i < 4; ++i) { const int q = t + 512 * i, r = q >> 4, c = q & 15; *(u32x4*)(T0 + swz256(r, c)) = scale8(RA[i], wsel + c * 8); }
                if (d2 == 0) {
#pragma unroll
                    for (int i = 0; i < 4; ++i) { const int q = t + 512 * i, r = q >> 4, c = q & 15; *(u32x4*)(T1 + swz256(r, c)) = RB[i]; }
                }
                __syncthreads();
                if (d2 == 1 && un < NU4) P4_PREFETCH(un);
                f32x4 acc[2][4]; zero_acc(acc);
                lds_mma_t<2, 4>(T0, T1, wm * 32, wn * 64, acc, lane);
                u16* cst = (u16*)(ws + (d2 ? O_MLC1 : O_MLC0)) + ((size_t)(b * NCH + cc) * 4 + h) * 16384 + (wm * 32 + lr) * 128 + wn * 64 + lq * 4;
#pragma unroll
                for (int i = 0; i < 2; ++i)
#pragma unroll
                    for (int j = 0; j < 4; ++j) {
                        uint2 o; o.x = pack2(acc[i][j][0], acc[i][j][1]); o.y = pack2(acc[i][j][2], acc[i][j][3]);
                        *(uint2*)(cst + (i * 16) * 128 + j * 16) = o;
                    }
                if (d2 == 0 && t < 256) {
                    const int dir = t >> 7, idx = t & 127;
                    const float* wgt = dir ? wB : wA;
                    float nacc = 0.f;
#pragma unroll 4
                    for (int c = 0; c < 16; ++c) {
                        const uint4 kv = *(const uint4*)(T1 + swz256(idx, c));
                        const float* ww = wgt + c * 8;
                        nacc += bflo(kv.x) * ww[0] + bfhi(kv.x) * ww[1] + bflo(kv.y) * ww[2] + bfhi(kv.y) * ww[3]
                              + bflo(kv.z) * ww[4] + bfhi(kv.z) * ww[5] + bflo(kv.w) * ww[6] + bfhi(kv.w) * ww[7];
                    }
                    ((float*)(ws + O_MLN))[(((size_t)(b * NCH + cc) * 4 + h) * 2 + dir) * 128 + idx] = nacc;
                }
                __syncthreads();
            }
        }
    }
}

__device__ __forceinline__ int scan_cc(int dir, int step) { return dir == 0 ? step : (step < 2 ? 1 - step : 35 - step); }
__device__ void phase5(const Params& P) {
    unsigned char* ws = P.ws;
    const int vb = threadIdx.x >> 8, t = threadIdx.x & 255;
    for (int u = blockIdx.x * 2 + vb; u < 256 + 256 + 32; u += gridDim.x * 2) {
        if (u < 256) {
            const int chain = u >> 2, part = u & 3;
            const int b = chain >> 4, h = (chain >> 1) & 7, dir = chain & 1;
            const int off = part * 2048 + t * 8;
            float S[8];
#pragma unroll
            for (int j = 0; j < 8; ++j) S[j] = 0.f;
#pragma unroll 1
            for (int sb = 0; sb < NCH; sb += 17) {
                u32x4 lv[17]; float dc[17];
#pragma unroll
                for (int q = 0; q < 17; ++q) {
                    const int cc = scan_cc(dir, sb + q);
                    lv[q] = *(const u32x4*)((const u16*)(ws + O_ST) + (((size_t)(b * NCH + cc) * 8 + h) * 2 + dir) * 8192 + off);
                    dc[q] = ((const float*)(ws + O_ACH))[((size_t)(b * NCH + cc) * 8 + h) * 2 + dir];
                }
                __builtin_amdgcn_sched_barrier(0);
#pragma unroll
                for (int q = 0; q < 17; ++q) {
                    const int cc = scan_cc(dir, sb + q);
                    u16* p = (u16*)(ws + O_ST) + (((size_t)(b * NCH + cc) * 8 + h) * 2 + dir) * 8192 + off;
                    const float dec = __expf(dc[q]);
                    u32x4 o; o.x = pack2(S[0], S[1]); o.y = pack2(S[2], S[3]); o.z = pack2(S[4], S[5]); o.w = pack2(S[6], S[7]);
                    *(u32x4*)p = o;
                    S[0] = dec * S[0] + bflo(lv[q].x); S[1] = dec * S[1] + bfhi(lv[q].x); S[2] = dec * S[2] + bflo(lv[q].y); S[3] = dec * S[3] + bfhi(lv[q].y);
                    S[4] = dec * S[4] + bflo(lv[q].z); S[5] = dec * S[5] + bfhi(lv[q].z); S[6] = dec * S[6] + bflo(lv[q].w); S[7] = dec * S[7] + bfhi(lv[q].w);
                }
                __builtin_amdgcn_sched_barrier(0);
            }
        } else if (u < 512) {
            const int v = u - 256;
            const int chain = v >> 3, part = v & 7;
            const int b = chain >> 3, h = (chain >> 1) & 3, dir = chain & 1;
            const int off = part * 2048 + t * 8;
            float S[8];
#pragma unroll
            for (int j = 0; j < 8; ++j) S[j] = 0.f;
            float m = -1e30f;
#pragma unroll 1
            for (int sb = 0; sb < NCH; sb += 17) {
                u32x4 lv[17]; float mlv[17], blv[17];
#pragma unroll
                for (int q = 0; q < 17; ++q) {
                    const int cc = scan_cc(dir, sb + q);
                    lv[q] = *(const u32x4*)((const u16*)(ws + (dir ? O_MLC1 : O_MLC0)) + ((size_t)(b * NCH + cc) * 4 + h) * 16384 + off);
                    const float* mls = (const float*)(ws + O_MLS) + (((size_t)(b * NCH + cc) * 4 + h) * 2 + dir) * 2;
                    mlv[q] = mls[0]; blv[q] = mls[1];
                }
                __builtin_amdgcn_sched_barrier(0);
#pragma unroll
                for (int q = 0; q < 17; ++q) {
                    const int cc = scan_cc(dir, sb + q);
                    u16* p = (u16*)(ws + (dir ? O_MLC1 : O_MLC0)) + ((size_t)(b * NCH + cc) * 4 + h) * 16384 + off;
                    const float ml = mlv[q], bl = blv[q];
                    const float mn = fmaxf(bl + m, ml);
                    const float sp = __expf(bl + m - mn), sl = __expf(ml - mn);
                    if (part == 0 && t == 0) ((float*)(ws + O_MLP))[((size_t)(b * NCH + cc) * 4 + h) * 2 + dir] = m;
                    u32x4 o; o.x = pack2(S[0], S[1]); o.y = pack2(S[2], S[3]); o.z = pack2(S[4], S[5]); o.w = pack2(S[6], S[7]);
                    *(u32x4*)p = o;
                    S[0] = sp * S[0] + sl * bflo(lv[q].x); S[1] = sp * S[1] + sl * bfhi(lv[q].x); S[2] = sp * S[2] + sl * bflo(lv[q].y); S[3] = sp * S[3] + sl * bfhi(lv[q].y);
                    S[4] = sp * S[4] + sl * bflo(lv[q].z); S[5] = sp * S[5] + sl * bfhi(lv[q].z); S[6] = sp * S[6] + sl * bflo(lv[q].w); S[7] = sp * S[7] + sl * bfhi(lv[q].w);
                    m = mn;
                }
                __builtin_amdgcn_sched_barrier(0);
            }
        } else {
            const int chain = u - 512;
            const int b = chain >> 3, h = (chain >> 1) & 3, dir = chain & 1;
            if (t < 128) {
                float nS = 0.f, m = -1e30f;
#pragma unroll 1
                for (int sb = 0; sb < NCH; sb += 17) {
                    float lvv[17], mlv[17], blv[17];
#pragma unroll
                    for (int q = 0; q < 17; ++q) {
                        const int cc = scan_cc(dir, sb + q);
                        lvv[q] = ((const float*)(ws + O_MLN))[(((size_t)(b * NCH + cc) * 4 + h) * 2 + dir) * 128 + t];
                        const float* mls = (const float*)(ws + O_MLS) + (((size_t)(b * NCH + cc) * 4 + h) * 2 + dir) * 2;
                        mlv[q] = mls[0]; blv[q] = mls[1];
                    }
                    __builtin_amdgcn_sched_barrier(0);
#pragma unroll
                    for (int q = 0; q < 17; ++q) {
                        const int cc = scan_cc(dir, sb + q);
                        float* p = (float*)(ws + O_MLN) + (((size_t)(b * NCH + cc) * 4 + h) * 2 + dir) * 128 + t;
                        const float mn = fmaxf(blv[q] + m, mlv[q]);
                        const float sp = __expf(blv[q] + m - mn), sl = __expf(mlv[q] - mn);
                        *p = nS;
                        nS = sp * nS + sl * lvv[q];
                        m = mn;
                    }
                    __builtin_amdgcn_sched_barrier(0);
                }
            }
        }
    }
}

__device__ void phase6(const Params& P, char* lds) {
    unsigned char* ws = P.ws;
    char* T0 = lds; char* T1 = lds + 32768; char* T2 = lds + 65536; char* T3 = lds + 98304;
    float* sc = (float*)(lds + 131072);
    float* sbuf = sc;
    float* a0 = sc + 256;
    float* a1 = sc + 384;
    float* a2 = sc + 512;
    float* a3 = sc + 640;
    float* a4 = sc + 768;
    float* a5 = sc + 896;
    float* rsA = sc + 1024;
    float* qn = sc + 1536;
    float* fac = sc + 1792;
    float* wfac = sc + 2048;
    const int NSSD = 4 * 32 * 8, NML = 4 * 32 * 4, NU6 = NSSD + NML;
    u32x4 R0[4], R1[4], R2[4], R3[4];
    float ps0 = 0.f, ps1 = 0.f, ps2 = 0.f, ps3 = 0.f;
#define P6_PREFETCH(uu) do { \
        const int _u = (uu); const bool _ssd = _u < NSSD; const int _v = _ssd ? _u : _u - NSSD; \
        const int _h = _ssd ? (_v & 7) : (_v & 3), _ct = _ssd ? (_v >> 3) : (_v >> 2), _b = _ct >> 5, _c = _ct & 31, _cc = _c + 2; \
        const size_t _ctile = (size_t)(_b * NCH + _cc); const int _rb = _b * 4096 + _c * 128; \
        const u16 *_p0, *_p1, *_p2, *_p3; \
        if (_ssd) { const int _g = _h >> 2; _p0 = (const u16*)(ws + O_CM) + (_ctile * 2 + _g) * 16384; _p1 = (const u16*)(ws + O_BM) + (_ctile * 2 + _g) * 16384; \
                    _p2 = (const u16*)(ws + O_ST) + ((_ctile * 8 + _h) * 2) * 8192; _p3 = (const u16*)(ws + O_XT) + (_ctile * 512 + _h * 64) * 128; } \
        else { _p0 = (const u16*)(ws + O_Q) + (_ctile * 4 + _h) * 16384; _p1 = (const u16*)(ws + O_K) + (_ctile * 4 + _h) * 16384; \
               _p2 = (const u16*)(ws + O_MLC0) + (_ctile * 4 + _h) * 16384; _p3 = (const u16*)(ws + O_MLC1) + (_ctile * 4 + _h) * 16384; } \
        _Pragma("unroll") for (int _i = 0; _i < 4; ++_i) { const int _q = (int)threadIdx.x + 512 * _i; const size_t _o = (size_t)(_q >> 4) * 128 + (_q & 15) * 8; \
            R0[_i] = *(const u32x4*)(_p0 + _o); R1[_i] = *(const u32x4*)(_p1 + _o); R2[_i] = *(const u32x4*)(_p2 + _o); R3[_i] = *(const u32x4*)(_p3 + _o); } \
        if (threadIdx.x < 128) { const int _dir = threadIdx.x >> 6, _ln = threadIdx.x & 63; \
            const int _l0 = _dir ? 127 - 2 * _ln : 2 * _ln, _l1 = _dir ? 126 - 2 * _ln : 2 * _ln + 1; \
            if (_ssd) { const float* _dp = (const float*)(ws + O_DT) + (size_t)_rb * 16 + _dir * 8 + _h; ps0 = _dp[_l0 * 16]; ps1 = _dp[_l1 * 16]; } \
            else { const float* _gf = (const float*)(ws + O_GF) + (size_t)_rb * 8 + _dir * 4 + _h; const float* _gi = (const float*)(ws + O_GI) + (size_t)_rb * 8 + _dir * 4 + _h; \
                   ps0 = _gf[_l0 * 8]; ps1 = _gf[_l1 * 8]; ps2 = _gi[_l0 * 8]; ps3 = _gi[_l1 * 8]; } } \
    } while (0)
    if ((int)blockIdx.x < NU6) P6_PREFETCH(blockIdx.x);
    for (int u = blockIdx.x; u < NU6; u += gridDim.x) {
        int t = threadIdx.x; asm volatile("" : "+v"(t));
        const int lane = t & 63, w = t >> 6, wm = w >> 1, wn = w & 1;
        const bool isssd = u < NSSD;
        const int v = isssd ? u : u - NSSD;
        const int h = isssd ? (v & 7) : (v & 3), ct = isssd ? (v >> 3) : (v >> 2), b = ct >> 5, c = ct & 31, cc = c + 2;
        const int rb = b * 4096 + c * 128, lpos = c * 128;
        const float mp0 = isssd ? 0.f : ((const float*)(ws + O_MLP))[((size_t)(b * NCH + cc) * 4 + h) * 2 + 0];
        const float mp1 = isssd ? 0.f : ((const float*)(ws + O_MLP))[((size_t)(b * NCH + cc) * 4 + h) * 2 + 1];
        if (w < 2) {
            const int dir = w;
            const int l0 = dir ? 127 - 2 * lane : 2 * lane, l1 = dir ? 126 - 2 * lane : 2 * lane + 1;
            if (isssd) {
                const float d0 = ps0, d1 = ps1;
                const float an = -__expf(P.in[I_ALOG][dir * 8 + h]);
                const float p0 = d0 * an, p1 = p0 + d1 * an;
                const float inc = wave_scan_sum(p1, lane);
                const float ex = inc - p1;
                float* ca = dir ? a1 : a0; float* da = dir ? a3 : a2;
                ca[l0] = ex + p0; ca[l1] = ex + p1; da[l0] = d0; da[l1] = d1;
            } else {
                const float f0 = ps0, f1 = ps1, i0 = ps2, i1 = ps3;
                const float p1 = f0 + f1;
                const float inc = wave_scan_sum(p1, lane);
                const float ex = inc - p1;
                const float bc0 = ex + f0, bc1 = ex + p1;
                const float u0 = i0 - bc0, u1 = i1 - bc1;
                const float q1 = fmaxf(u0, u1);
                const float incm = wave_scan_max(q1, lane);
                float exm = __shfl_up(incm, 1); if (lane == 0) exm = -INFINITY;
                const float mp = dir ? mp1 : mp0;
                float* ab = dir ? a1 : a0; float* au = dir ? a3 : a2; float* am = dir ? a5 : a4;
                ab[l0] = bc0; ab[l1] = bc1; au[l0] = u0; au[l1] = u1;
                am[l0] = fmaxf(mp, fmaxf(exm, u0)); am[l1] = fmaxf(mp, fmaxf(exm, q1));
            }
        }
#pragma unroll
        for (int i = 0; i < 4; ++i) {
            const int q = t + 512 * i, r = q >> 4, cq = q & 15;
            *(u32x4*)(T0 + swz256(r, cq)) = R0[i];
            *(u32x4*)(T1 + swz256(r, cq)) = R1[i];
            *(u32x4*)(T2 + swz256(r, cq)) = R2[i];
            if (!isssd || i < 2) *(u32x4*)(T3 + swz256(r, cq)) = R3[i];
        }
        __syncthreads();
        if (u + (int)gridDim.x < NU6) P6_PREFETCH(u + gridDim.x);
        if (isssd) {
            const int g = h >> 2; (void)g;
            const int lr = lane & 15, lq = lane >> 4;
            f32x4 Y[2][2];
            {
                f32x4 aF[2][2], aB[2][2]; zero_acc(aF); zero_acc(aB);
                lds_mma_t<2, 2>(T0, T2, wm * 32, wn * 32, aF, lane);
                lds_mma_t<2, 2>(T0, T2, wm * 32, 64 + wn * 32, aB, lane);
#pragma unroll
                for (int i = 0; i < 2; ++i) {
                    const int l = wm * 32 + i * 16 + lr;
                    const float e0 = __expf(a0[l]), e1 = __expf(a1[l]);
#pragma unroll
                    for (int j = 0; j < 2; ++j) Y[i][j] = e0 * aF[i][j] + e1 * aB[i][j];
                }
            }
            f32x4 G[2][4]; zero_acc(G);
            lds_mma_t<2, 4>(T0, T1, wm * 32, wn * 64, G, lane);
            __syncthreads();
            {
                const float Dh = P.in[I_SSDD][h];
                int dbase = wn * 64 + lq * 4 - wm * 32 - lr; asm volatile("" : "+v"(dbase));
#pragma unroll
                for (int j = 0; j < 4; ++j) {
                    const int s0 = wn * 64 + j * 16 + lq * 4;
                    const float4 c0s = *(const float4*)(a0 + s0), r1s = *(const float4*)(a1 + s0), d0s = *(const float4*)(a2 + s0), d1s = *(const float4*)(a3 + s0);
                    const float c0v[4] = {c0s.x, c0s.y, c0s.z, c0s.w}, r1v[4] = {r1s.x, r1s.y, r1s.z, r1s.w};
                    const float d0v[4] = {d0s.x, d0s.y, d0s.z, d0s.w}, d1v[4] = {d1s.x, d1s.y, d1s.z, d1s.w};
#pragma unroll
                    for (int i = 0; i < 2; ++i) {
                        const int l = wm * 32 + i * 16 + lr;
                        const float c0l = a0[l], r1l = a1[l];
                        float mv[4];
#pragma unroll
                        for (int r = 0; r < 4; ++r) {
                            const int diff = dbase + (j * 16 - i * 16 + r);
                            const float e0 = (diff <= 0) ? (c0l - c0v[r]) : -INFINITY;
                            const float e1 = (diff >= 0) ? (r1l - r1v[r]) : -INFINITY;
                            mv[r] = G[i][j][r] * (__expf(e0) * d0v[r] + __expf(e1) * d1v[r]) + (diff == 0 ? Dh : 0.f);
                        }
                        uint2 o; o.x = pack2(mv[0], mv[1]); o.y = pack2(mv[2], mv[3]);
                        *(uint2*)(T1 + swz256(l, s0 >> 3) + (s0 & 7) * 2) = o;
                    }
                }
            }
            __syncthreads();
            lds_mma_t<2, 2>(T1, T3, wm * 32, wn * 32, Y, lane);
            u16* zo = (u16*)(ws + O_ZO);
            uint2 zvv[2][2];
#pragma unroll
            for (int i = 0; i < 2; ++i)
#pragma unroll
                for (int j = 0; j < 2; ++j) zvv[i][j] = *(const uint2*)(zo + (size_t)(rb + wm * 32 + i * 16 + lr) * 1024 + h * 64 + wn * 32 + j * 16 + lq * 4);
            __builtin_amdgcn_sched_barrier(0);
#pragma unroll
            for (int i = 0; i < 2; ++i) {
                const int l = wm * 32 + i * 16 + lr;
                float ssq = 0.f;
#pragma unroll
                for (int j = 0; j < 2; ++j) {
                    const int p = wn * 32 + j * 16 + lq * 4;
                    u16* zp = zo + (size_t)(rb + l) * 1024 + h * 64 + p;
                    const uint2 zv = zvv[i][j];
                    const float y0 = Y[i][j][0] * siluf(bflo(zv.x)), y1 = Y[i][j][1] * siluf(bfhi(zv.x));
                    const float y2 = Y[i][j][2] * siluf(bflo(zv.y)), y3 = Y[i][j][3] * siluf(bfhi(zv.y));
                    uint2 o; o.x = pack2(y0, y1); o.y = pack2(y2, y3);
                    *(uint2*)zp = o;
                    ssq += y0 * y0 + y1 * y1 + y2 * y2 + y3 * y3;
                }
                ssq += __shfl_xor(ssq, 16); ssq += __shfl_xor(ssq, 32);
                if (lq == 0) ((float*)(ws + O_SSQ))[(size_t)(rb + l) * 16 + h * 2 + wn] = ssq;
            }
            __syncthreads();
        } else {
            const int lr = lane & 15, lq = lane >> 4;
            f32x4 S[2][4]; zero_acc(S);
            lds_mma_t<2, 4>(T0, T1, wm * 32, wn * 64, S, lane);
            if (t < 256) {
                const int dir = t >> 7, idx = t & 127;
                const float* np = (const float*)(ws + O_MLN) + (((size_t)(b * NCH + cc) * 4 + h) * 2 + dir) * 128;
                float acc = 0.f;
#pragma unroll 4
                for (int cch = 0; cch < 16; ++cch) {
                    const uint4 qv = *(const uint4*)(T0 + swz256(idx, cch));
                    const float4 n0 = *(const float4*)(np + cch * 8), n1 = *(const float4*)(np + cch * 8 + 4);
                    acc += bflo(qv.x) * n0.x + bfhi(qv.x) * n0.y + bflo(qv.y) * n0.z + bfhi(qv.y) * n0.w
                         + bflo(qv.z) * n1.x + bfhi(qv.z) * n1.y + bflo(qv.w) * n1.z + bfhi(qv.w) * n1.w;
                }
                qn[dir * 128 + idx] = acc;
            }
            int dbase = wn * 64 + lq * 4 - wm * 32 - lr; asm volatile("" : "+v"(dbase));
            {
                float r0[2] = {0.f, 0.f}, r1[2] = {0.f, 0.f};
#pragma unroll
                for (int j = 0; j < 4; ++j) {
                    const int s0 = wn * 64 + j * 16 + lq * 4;
                    const float4 u0s = *(const float4*)(a2 + s0), u1s = *(const float4*)(a3 + s0);
                    const float u0v[4] = {u0s.x, u0s.y, u0s.z, u0s.w}, u1v[4] = {u1s.x, u1s.y, u1s.z, u1s.w};
#pragma unroll
                    for (int i = 0; i < 2; ++i) {
                        const int tt = wm * 32 + i * 16 + lr;
                        const float m0 = a4[tt], m1 = a5[tt];
#pragma unroll
                        for (int r = 0; r < 4; ++r) {
                            const int diff = dbase + (j * 16 - i * 16 + r);
                            r0[i] += S[i][j][r] * __expf((diff <= 0) ? (u0v[r] - m0) : -INFINITY);
                            r1[i] += S[i][j][r] * __expf((diff >= 0) ? (u1v[r] - m1) : -INFINITY);
                        }
                    }
                }
#pragma unroll
                for (int i = 0; i < 2; ++i) {
                    const int tt = wm * 32 + i * 16 + lr;
                    float x0 = r0[i], x1 = r1[i];
                    x0 += __shfl_xor(x0, 16); x0 += __shfl_xor(x0, 32);
                    x1 += __shfl_xor(x1, 16); x1 += __shfl_xor(x1, 32);
                    if (lq == 0) { rsA[(0 * 2 + wn) * 128 + tt] = x0; rsA[(1 * 2 + wn) * 128 + tt] = x1; }
                }
            }
            __syncthreads();
            if (t < 256) {
                const int dir = t >> 7, tt = t & 127;
                const float rs = rsA[(dir * 2 + 0) * 128 + tt] + rsA[(dir * 2 + 1) * 128 + tt];
                const float mm = dir ? a5[tt] : a4[tt];
                const float wi = __expf((dir ? mp1 : mp0) - mm);
                const float den = rs + wi * qn[dir * 128 + tt];
                const float mout = (dir ? a1[tt] : a0[tt]) + mm;
                const float dn = fmaxf(fabsf(den), __expf(-mout));
                fac[dir * 128 + tt] = 1.f / dn;
                wfac[dir * 128 + tt] = wi / dn;
            }
            __syncthreads();
            f32x4 H[2][4];
            {
                f32x4 A0[2][4]; zero_acc(A0);
                lds_mma_t<2, 4>(T0, T2, wm * 32, wn * 64, A0, lane);
#pragma unroll
                for (int i = 0; i < 2; ++i) {
                    const float f = wfac[wm * 32 + i * 16 + lr];
#pragma unroll
                    for (int j = 0; j < 4; ++j) H[i][j] = f * A0[i][j];
                }
            }
            {
                f32x4 A1[2][4]; zero_acc(A1);
                lds_mma_t<2, 4>(T0, T3, wm * 32, wn * 64, A1, lane);
#pragma unroll
                for (int i = 0; i < 2; ++i) {
                    const float f = wfac[128 + wm * 32 + i * 16 + lr];
#pragma unroll
                    for (int j = 0; j < 4; ++j) H[i][j] += f * A1[i][j];
                }
            }
            __syncthreads();
            asm volatile("" : "+v"(dbase));
#pragma unroll
            for (int j = 0; j < 4; ++j) {
                const int s0 = wn * 64 + j * 16 + lq * 4;
                const float4 u0s = *(const float4*)(a2 + s0), u1s = *(const float4*)(a3 + s0);
                const float u0v[4] = {u0s.x, u0s.y, u0s.z, u0s.w}, u1v[4] = {u1s.x, u1s.y, u1s.z, u1s.w};
#pragma unroll
                for (int i = 0; i < 2; ++i) {
                    const int tt = wm * 32 + i * 16 + lr;
                    const float m0 = a4[tt], m1 = a5[tt], f0 = fac[tt], f1 = fac[128 + tt];
                    float pv[4];
#pragma unroll
                    for (int r = 0; r < 4; ++r) {
                        const int diff = dbase + (j * 16 - i * 16 + r);
                        pv[r] = S[i][j][r] * (__expf((diff <= 0) ? (u0v[r] - m0) : -INFINITY) * f0 + __expf((diff >= 0) ? (u1v[r] - m1) : -INFINITY) * f1);
                    }
                    uint2 o; o.x = pack2(pv[0], pv[1]); o.y = pack2(pv[2], pv[3]);
                    *(uint2*)(T1 + swz256(tt, s0 >> 3) + (s0 & 7) * 2) = o;
                }
            }
            load_tile128(T2, 0, (const u16*)(ws + O_VT) + ((size_t)(b * NCH + cc) * 512 + h * 128) * 128, 128, 128, t, 512);
            __syncthreads();
            lds_mma_t<2, 4>(T1, T2, wm * 32, wn * 64, H, lane);
            u16* zo = (u16*)(ws + O_ZO);
            size_t rown[2];
#pragma unroll
            for (int i = 0; i < 2; ++i) {
                const int tt = wm * 32 + i * 16 + lr;
                const int lp = lpos + tt;
                rown[i] = (size_t)b * 4096 + ((lp & 63) << 6) + (lp >> 6);
                float ssq = 0.f;
#pragma unroll
                for (int j = 0; j < 4; ++j) {
                    const int d = wn * 64 + j * 16 + lq * 4;
                    const uint2 ov = *(const uint2*)(zo + rown[i] * 1024 + 512 + h * 128 + d);
                    H[i][j][0] *= sigmf(bflo(ov.x)); H[i][j][1] *= sigmf(bfhi(ov.x)); H[i][j][2] *= sigmf(bflo(ov.y)); H[i][j][3] *= sigmf(bfhi(ov.y));
                    ssq += H[i][j][0] * H[i][j][0] + H[i][j][1] * H[i][j][1] + H[i][j][2] * H[i][j][2] + H[i][j][3] * H[i][j][3];
                }
                ssq += __shfl_xor(ssq, 16); ssq += __shfl_xor(ssq, 32);
                if (lq == 0) rsA[wn * 128 + tt] = ssq;
            }
            __syncthreads();
            const u16* xc = (const u16*)(ws + O_XC);
            f32x4 nwv[4], skv[4]; uint2 xvv[4][2];
#pragma unroll
            for (int j = 0; j < 4; ++j) {
                const int d = wn * 64 + j * 16 + lq * 4, chg = h * 128 + d;
                nwv[j] = *(const f32x4*)(P.in[I_MNW] + chg); skv[j] = *(const f32x4*)(P.in[I_MSKIP] + chg);
#pragma unroll
                for (int i = 0; i < 2; ++i) xvv[j][i] = *(const uint2*)(xc + ((size_t)(b * NCH + cc) * 4 + h) * 16384 + (size_t)(wm * 32 + i * 16 + lr) * 128 + d);
            }
            __builtin_amdgcn_sched_barrier(0);
#pragma unroll
            for (int j = 0; j < 4; ++j) {
                const int d = wn * 64 + j * 16 + lq * 4, chg = h * 128 + d;
#pragma unroll
                for (int i = 0; i < 2; ++i) {
                    const int tt = wm * 32 + i * 16 + lr;
                    const float rn = rsqrtf((rsA[tt] + rsA[128 + tt]) * (1.f / 128.f) + 1e-6f);
                    const uint2 xv = xvv[j][i];
                    const float y0 = H[i][j][0] * rn * nwv[j][0] + skv[j][0] * bflo(xv.x), y1 = H[i][j][1] * rn * nwv[j][1] + skv[j][1] * bfhi(xv.x);
                    const float y2 = H[i][j][2] * rn * nwv[j][2] + skv[j][2] * bflo(xv.y), y3 = H[i][j][3] * rn * nwv[j][3] + skv[j][3] * bfhi(xv.y);
                    uint2 o; o.x = pack2(y0, y1); o.y = pack2(y2, y3);
                    *(uint2*)(zo + rown[i] * 1024 + 512 + chg) = o;
                }
            }
            __syncthreads();
        }
    }
}

struct OutProj {
    static constexpr int K = 1024; static constexpr bool PERM = false; static constexpr int MIDT = 8;
    struct Unit { int pm, pn, slot; };
    const Params* P; const float* rs; int G, c;
    __device__ __forceinline__ bool next(int i, Unit& u) const {
        const int L = i * G + c;
        if (L >= 256) return false;
        g8::dense_unit(L, 64, 4, u.pm, u.pn); u.slot = i & 3;
        return true;
    }
    __device__ __forceinline__ const char* baseA(const Unit&) const { return (const char*)(P->ws + O_ZO); }
    __device__ __forceinline__ const char* baseB(const Unit&) const { return (const char*)(P->ws + O_WOUT); }
    __device__ __forceinline__ void offs(const Unit& u, int tid_, unsigned (&oa)[2][2], unsigned (&ob)[2][2]) const {
        int R[2], C[2];
        { int tq = tid_; asm volatile("" : "+v"(tq)); g8::stage_rc(tq * 16, R[0], C[0]); g8::stage_rc(tq * 16 + 8192, R[1], C[1]); }
#pragma unroll
        for (int h = 0; h < 2; ++h)
#pragma unroll
            for (int i = 0; i < 2; ++i) {
                oa[h][i] = (unsigned)((u.pm * 256 + h * 128 + R[i]) * 1024 + C[i]) * 2u;
                ob[h][i] = (unsigned)((u.pn * 256 + h * 128 + R[i]) * 1024 + C[i]) * 2u;
            }
    }
    __device__ __forceinline__ int nt(const Unit&) const { return 16; }
    __device__ __forceinline__ bool brk(const Unit&, const Unit&) const { return false; }
    __device__ __forceinline__ void a_ready(const Unit&) const {}
    __device__ __forceinline__ void done(const Unit&) const {}
    __device__ __forceinline__ void mid(g8::Acc& acc, const Unit& u, int wr, int fr) const {
#pragma unroll
        for (int ai = 0; ai < 2; ++ai)
#pragma unroll
            for (int m = 0; m < 4; ++m) {
                const float s = rs[u.slot * 256 + ai * 128 + wr * 64 + m * 16 + fr];
#pragma unroll
                for (int bj = 0; bj < 2; ++bj)
#pragma unroll
                    for (int n = 0; n < 2; ++n) acc[ai][bj][m][n] *= s;
            }
    }
    __device__ __forceinline__ void epi(g8::Acc& acc, const Unit& u, int wr, int wc, int fr, int fq) const {
        const int row0 = u.pm * 256 + wr * 64 + fr, col0 = u.pn * 256 + wc * 32 + 4 * fq;
        const int b = u.pm >> 4;
        const float* mod = (const float*)(P->ws + O_MOD) + b * 6144 + 2048;
        f32x4 g1[2][2];
#pragma unroll
        for (int bj = 0; bj < 2; ++bj)
#pragma unroll
            for (int n = 0; n < 2; ++n) g1[bj][n] = *(const f32x4*)(mod + col0 + bj * 128 + n * 16);
        f32x4 xa[8], xb[8];
#define OP_LOAD(dst, ai_, mp_) _Pragma("unroll") for (int mm = 0; mm < 2; ++mm) _Pragma("unroll") for (int bj = 0; bj < 2; ++bj) _Pragma("unroll") for (int n = 0; n < 2; ++n) \
            dst[mm * 4 + bj * 2 + n] = __builtin_nontemporal_load((const f32x4*)(P->in[I_X] + (size_t)(row0 + (ai_) * 128 + ((mp_) * 2 + mm) * 16) * 1024 + col0 + bj * 128 + n * 16))
#define OP_STORE(src, ai_, mp_) _Pragma("unroll") for (int mm = 0; mm < 2; ++mm) _Pragma("unroll") for (int bj = 0; bj < 2; ++bj) _Pragma("unroll") for (int n = 0; n < 2; ++n) \
            *(f32x4*)(P->out + (size_t)(row0 + (ai_) * 128 + ((mp_) * 2 + mm) * 16) * 1024 + col0 + bj * 128 + n * 16) = src[mm * 4 + bj * 2 + n] + g1[bj][n] * acc[ai_][bj][(mp_) * 2 + mm][n]
        OP_LOAD(xa, 0, 0);
        __builtin_amdgcn_sched_barrier(0);
        OP_LOAD(xb, 0, 1);
        __builtin_amdgcn_sched_barrier(0);
        OP_STORE(xa, 0, 0);
        __builtin_amdgcn_sched_barrier(0);
        OP_LOAD(xa, 1, 0);
        __builtin_amdgcn_sched_barrier(0);
        OP_STORE(xb, 0, 1);
        __builtin_amdgcn_sched_barrier(0);
        OP_LOAD(xb, 1, 1);
        __builtin_amdgcn_sched_barrier(0);
        OP_STORE(xa, 1, 0);
        __builtin_amdgcn_sched_barrier(0);
        OP_STORE(xb, 1, 1);
#undef OP_LOAD
#undef OP_STORE
    }
};
__device__ void phase7(const Params& P, char* lds) {
    float* rs = (float*)(lds + g8::STAGE_BYTES);
    OutProj S; S.P = &P; S.rs = rs; S.G = gridDim.x; S.c = blockIdx.x;
    for (int i = 0; i < 4; ++i) {
        OutProj::Unit u;
        if (!S.next(i, u)) break;
        if (threadIdx.x < 256) {
            const f32x4* sq = (const f32x4*)((const float*)(P.ws + O_SSQ) + (size_t)(u.pm * 256 + threadIdx.x) * 16);
            const f32x4 s0 = sq[0], s1 = sq[1], s2 = sq[2], s3 = sq[3];
            const f32x4 sv = (s0 + s1) + (s2 + s3);
            const float s = (sv[0] + sv[1]) + (sv[2] + sv[3]);
            rs[i * 256 + threadIdx.x] = rsqrtf(s * (1.f / 512.f) + 1e-6f);
        }
    }
    __syncthreads();
    g8::gemm_phase<OutProj>((LAS unsigned char*)lds, S);
}

__device__ void phase8(const Params& P, char* lds_all) {
    unsigned char* ws = P.ws;
    const float* mod = (const float*)(ws + O_MOD);
    {
        const int t = threadIdx.x, lane = t & 63, w = t >> 6;
        float* tt = (float*)lds_all;
        float bw[32][3];
        {
            const int ti = lane & 15, kq = lane >> 4;
#pragma unroll
            for (int ks = 0; ks < 32; ++ks) {
                const int k = w * 128 + ks * 4 + kq;
                bw[ks][0] = P.in[I_REW][(size_t)k * 32 + ti];
                bw[ks][1] = P.in[I_REW][(size_t)k * 32 + 16 + ti];
                const float b2r = P.in[I_RGW][(size_t)k * 4 + (ti & 3)];
                bw[ks][2] = ti < 4 ? b2r : 0.f;
            }
        }
        for (int u = blockIdx.x; u < 512; u += gridDim.x) {
            const int tk0 = u * 32;
            const int b = tk0 >> 12;
            f32x4 mulv[4], shv[4];
            {
                f32x4 nwv[4], scv[4];
#pragma unroll
                for (int j = 0; j < 4; ++j) {
                    const int k = (lane + 64 * j) * 4;
                    nwv[j] = *(const f32x4*)(P.in[I_N2W] + k);
                    shv[j] = *(const f32x4*)(mod + b * 6144 + 3072 + k);
                    scv[j] = *(const f32x4*)(mod + b * 6144 + 4096 + k);
                }
#pragma unroll
                for (int j = 0; j < 4; ++j) mulv[j] = nwv[j] * (scv[j] + 1.f);
            }
#pragma unroll 1
            for (int qh = 0; qh < 2; ++qh) {
                f32x4 v[2][4]; float ss[2];
#pragma unroll
                for (int q = 0; q < 2; ++q) {
                    const float* xr = P.out + (size_t)(tk0 + w * 4 + qh * 2 + q) * 1024;
#pragma unroll
                    for (int j = 0; j < 4; ++j) v[q][j] = ((const f32x4*)xr)[lane + 64 * j];
                }
                __builtin_amdgcn_sched_barrier(0);
#pragma unroll
                for (int q = 0; q < 2; ++q) {
                    ss[q] = 0.f;
#pragma unroll
                    for (int j = 0; j < 4; ++j) ss[q] += v[q][j][0] * v[q][j][0] + v[q][j][1] * v[q][j][1] + v[q][j][2] * v[q][j][2] + v[q][j][3] * v[q][j][3];
                    ss[q] = rsqrtf(wave_sum(ss[q]) * (1.f / 1024.f) + 1e-6f);
                }
#pragma unroll
                for (int j = 0; j < 4; ++j) {
                    const int k = (lane + 64 * j) * 4;
#pragma unroll
                    for (int q = 0; q < 2; ++q) {
                        const int tl = w * 4 + qh * 2 + q;
                        const f32x4 hh = v[q][j] * ss[q] * mulv[j] + shv[j];
                        uint2 o; o.x = pack2(hh[0], hh[1]); o.y = pack2(hh[2], hh[3]);
                        *(uint2*)((u16*)(ws + O_T) + (size_t)(tk0 + tl) * 1024 + k) = o;
                        *(f32x4*)(tt + tl * 1028 + k) = hh;
                    }
                }
            }
            __syncthreads();
            f32x4 c[2][3];
#pragma unroll
            for (int a = 0; a < 2; ++a)
#pragma unroll
                for (int f = 0; f < 3; ++f) c[a][f] = f32x4{0, 0, 0, 0};
            const int ti = lane & 15, kq = lane >> 4;
#pragma unroll
            for (int ks = 0; ks < 32; ++ks) {
                const int k = w * 128 + ks * 4 + kq;
                const float a0 = tt[ti * 1028 + k], a1 = tt[(16 + ti) * 1028 + k];
                c[0][0] = __builtin_amdgcn_mfma_f32_16x16x4f32(a0, bw[ks][0], c[0][0], 0, 0, 0);
                c[0][1] = __builtin_amdgcn_mfma_f32_16x16x4f32(a0, bw[ks][1], c[0][1], 0, 0, 0);
                c[0][2] = __builtin_amdgcn_mfma_f32_16x16x4f32(a0, bw[ks][2], c[0][2], 0, 0, 0);
                c[1][0] = __builtin_amdgcn_mfma_f32_16x16x4f32(a1, bw[ks][0], c[1][0], 0, 0, 0);
                c[1][1] = __builtin_amdgcn_mfma_f32_16x16x4f32(a1, bw[ks][1], c[1][1], 0, 0, 0);
                c[1][2] = __builtin_amdgcn_mfma_f32_16x16x4f32(a1, bw[ks][2], c[1][2], 0, 0, 0);
            }
            __syncthreads();
            float* red = (float*)lds_all;
#pragma unroll
            for (int a = 0; a < 2; ++a)
#pragma unroll
                for (int r = 0; r < 4; ++r) {
                    const int row = a * 16 + kq * 4 + r;
                    red[(w * 32 + row) * 48 + ti] = c[a][0][r];
                    red[(w * 32 + row) * 48 + 16 + ti] = c[a][1][r];
                    red[(w * 32 + row) * 48 + 32 + ti] = c[a][2][r];
                }
            __syncthreads();
            int* lcnt = (int*)(lds_all + 65536);
            if (t < 64) lcnt[t] = 0;
            __syncthreads();
            int ea = 0, eb = 0, ra = 0, rb = 0; float w1 = 0.f, w2 = 0.f;
            if (t < 32) {
                float gl[4];
#pragma unroll
                for (int j = 0; j < 4; ++j) {
                    float sacc = P.in[I_RGB][j];
#pragma unroll
                    for (int ww = 0; ww < 8; ++ww) sacc += red[(ww * 32 + t) * 48 + 32 + j];
                    gl[j] = sacc;
                }
                int gs = 0; float gm = gl[0];
#pragma unroll
                for (int j = 1; j < 4; ++j) if (gl[j] > gm) { gm = gl[j]; gs = j; }
                float gsum = 0.f;
#pragma unroll
                for (int j = 0; j < 4; ++j) gsum += __expf(gl[j] - gm);
                const float pg = 1.f / gsum;
                float el[8];
#pragma unroll
                for (int j = 0; j < 8; ++j) {
                    float sacc = P.in[I_REB][gs * 8 + j];
#pragma unroll
                    for (int ww = 0; ww < 8; ++ww) sacc += red[(ww * 32 + t) * 48 + gs * 8 + j];
                    el[j] = sacc;
                }
                int i1 = 0; float m1 = el[0];
#pragma unroll
                for (int j = 1; j < 8; ++j) if (el[j] > m1) { m1 = el[j]; i1 = j; }
                int i2 = -1; float m2 = -INFINITY;
#pragma unroll
                for (int j = 0; j < 8; ++j) if (j != i1 && el[j] > m2) { m2 = el[j]; i2 = j; }
                const float e2 = __expf(m2 - m1);
                w1 = pg / (1.f + e2); w2 = pg * e2 / (1.f + e2);
                ea = gs * 8 + i1; eb = gs * 8 + i2;
                ra = atomicAdd(&lcnt[ea], 1);
                rb = atomicAdd(&lcnt[eb], 1);
            }
            __syncthreads();
            if (t < 32) {
                const int n = lcnt[t];
                lcnt[32 + t] = n > 0 ? atomicAdd((int*)(ws + O_CNT) + t * 64, n) : 0;
            }
            __syncthreads();
            if (t < 32) {
                const int tok = tk0 + t;
                int* list = (int*)(ws + O_LIST);
                float* wts = (float*)(ws + O_WTS);
                list[ea * 16384 + lcnt[32 + ea] + ra] = tok * 2;
                wts[tok * 2] = w1;
                list[eb * 16384 + lcnt[32 + eb] + rb] = tok * 2 + 1;
                wts[tok * 2 + 1] = w2;
            }
            __syncthreads();
        }
    }
    const int vb = threadIdx.x >> 8, t = threadIdx.x & 255;
    char* lds = lds_all + vb * VLDS;
    const int NTR = 3072;
    for (int u = blockIdx.x * 2 + vb; u < NTR; u += gridDim.x * 2) {
        {
            const int v = u;
            float* tile = (float*)lds;
            if (v < 2048) {
                const bool up = v >= 1024;
                const int vv = v & 1023, e = vv >> 5, rem = vv & 31, nt = rem >> 4, kt = rem & 15;
                const float* src = P.in[up ? I_WU : I_WG] + (size_t)e * 1024 * 256;
                transpose_tile_w(tile, src, 256, kt * 64, nt * 128, (u16*)(ws + O_WGU) + (size_t)e * 512 * 1024, (up ? 256 : 0) + nt * 128, 1024, nullptr, 0, t);
            } else {
                const int vv = v - 2048, e = vv >> 5, rem = vv & 31, nt = rem >> 2, kt = rem & 3;
                const float* src = P.in[I_WD] + (size_t)e * 256 * 1024;
                transpose_tile_w(tile, src, 1024, kt * 64, nt * 128, (u16*)(ws + O_WD) + (size_t)e * 1024 * 256, nt * 128, 256, nullptr, 0, t);
            }
        }
    }
}

__device__ __forceinline__ void moe_prefix(const unsigned char* ws, int* pre_t, int* pre_c) {
    if (threadIdx.x == 0) {
        const int* cnt = (const int*)(ws + O_CNT);
        int at = 0, ac = 0;
        for (int e = 0; e < 32; ++e) { pre_t[e] = at; pre_c[e] = ac; const int c = cnt[e * 64]; at += (c + 255) >> 8; ac += c; }
        pre_t[32] = at; pre_c[32] = ac;
    }
    __syncthreads();
}
struct MoeUnit { int type, e, mt, pn, cnt, base, mtg; };
struct Moe {
    static constexpr int K = 0; static constexpr bool PERM = true; static constexpr int MIDT = 0;
    typedef MoeUnit Unit;
    const unsigned char* ws; const int* pre_t; const int* pre_c; int G, c;
    __device__ __forceinline__ bool next(int i, Unit& u) const {
        int type, m, pn, e, mt;
        if ((G & 7) == 0) {
            const int x = c & 7, s = c >> 3, nb = G >> 3;
            const int n0 = pre_t[x + 1] - pre_t[x], n1 = pre_t[x + 9] - pre_t[x + 8], n2 = pre_t[x + 17] - pre_t[x + 16], n3 = pre_t[x + 25] - pre_t[x + 24];
            const int MTx = n0 + n1 + n2 + n3;
            const int T0 = MTx * 2, T1 = MTx * 4;
            const int qa = T0 / nb, qr = T0 - qa * nb;
            const int k0 = qa + (s < qr ? 1 : 0);
            if (i < k0) { const int Lx = i * nb + s; type = 0; m = Lx >> 1; pn = Lx & 1; }
            else {
                const int tgt = (2 * T0 + T1 + nb - 1) / nb;
                const int kk = i - k0;
                int rA = tgt - 2 * (qa + 1); rA = rA > 0 ? rA : 0;
                int rB = tgt - 2 * qa;       rB = rB > 0 ? rB : 0;
                if (kk >= (s < qr ? rA : rB)) return false;
                int j = qr * (rA < kk ? rA : kk) + (nb - qr) * (rB < kk ? rB : kk);
                if (rA > kk) j += s < qr ? s : qr;
                if (rB > kk) j += s > qr ? s - qr : 0;
                if (j >= T1) return false;
                type = 1; m = j >> 2; pn = j & 3;
            }
            if (m < n0) { e = x; mt = m; }
            else if (m < n0 + n1) { e = x + 8; mt = m - n0; }
            else if (m < n0 + n1 + n2) { e = x + 16; mt = m - n0 - n1; }
            else { e = x + 24; mt = m - n0 - n1 - n2; }
        } else {
            const int L = i * G + c, MT = pre_t[32];
            if (L < MT * 2) { type = 0; m = L >> 1; pn = L & 1; }
            else if (L < MT * 6) { const int j = L - MT * 2; type = 1; m = j >> 2; pn = j & 3; }
            else return false;
            e = 0;
            while (pre_t[e + 1] <= m) ++e;
            mt = m - pre_t[e];
        }
        u.e = __builtin_amdgcn_readfirstlane(e); u.mt = __builtin_amdgcn_readfirstlane(mt);
        u.cnt = __builtin_amdgcn_readfirstlane(pre_c[e + 1] - pre_c[e]); u.base = __builtin_amdgcn_readfirstlane(pre_c[e]);
        u.mtg = __builtin_amdgcn_readfirstlane(pre_t[e] + mt); u.pn = __builtin_amdgcn_readfirstlane(pn); u.type = __builtin_amdgcn_readfirstlane(type);
        return true;
    }
    __device__ __forceinline__ int nt(const Unit& u) const { return u.type ? 4 : 16; }
    __device__ __forceinline__ bool brk(const Unit& a, const Unit& b) const { return a.type == 0 && b.type == 1; }
    __device__ __forceinline__ const char* baseA(const Unit& u) const {
        return u.type ? (const char*)(ws + O_H) + (size_t)(u.base + u.mt * 256) * 256 * 2 : (const char*)(ws + O_T);
    }
    __device__ __forceinline__ const char* baseB(const Unit& u) const {
        return u.type ? (const char*)(ws + O_WD) + ((size_t)u.e * 1024 + u.pn * 256) * 256 * 2 : (const char*)(ws + O_WGU) + (size_t)u.e * 512 * 1024 * 2;
    }
    __device__ __forceinline__ void offs(const Unit& u, int tid_, unsigned (&oa)[2][2], unsigned (&ob)[2][2]) const {
        int R[2], C[2];
        { int tq = tid_; asm volatile("" : "+v"(tq)); g8::stage_rc(tq * 16, R[0], C[0]); g8::stage_rc(tq * 16 + 8192, R[1], C[1]); }
        const int* list = (const int*)(ws + O_LIST) + u.e * 16384;
        int tokv[2][2];
        if (u.type == 0) {
#pragma unroll
            for (int h = 0; h < 2; ++h)
#pragma unroll
                for (int i = 0; i < 2; ++i) { const int idx = u.mt * 256 + h * 128 + R[i]; tokv[h][i] = list[idx < u.cnt ? idx : u.cnt - 1]; }
            __builtin_amdgcn_sched_barrier(0);
        } else {
#pragma unroll
            for (int h = 0; h < 2; ++h)
#pragma unroll
                for (int i = 0; i < 2; ++i) tokv[h][i] = 0;
        }
#pragma unroll
        for (int h = 0; h < 2; ++h)
#pragma unroll
            for (int i = 0; i < 2; ++i) {
                const int Rb = (R[i] & ~31) + g8::perm32(R[i] & 31);
                const int tok = tokv[h][i] >> 1;
                if (u.type == 0) {
                    oa[h][i] = (unsigned)(tok * 1024 + C[i]) * 2u;
                    ob[h][i] = (unsigned)((h * 256 + u.pn * 128 + Rb) * 1024 + C[i]) * 2u;
                } else {
                    oa[h][i] = (unsigned)((h * 128 + R[i]) * 256 + C[i]) * 2u;
                    ob[h][i] = (unsigned)((h * 128 + Rb) * 256 + C[i]) * 2u;
                }
            }
    }
    __device__ __forceinline__ void mid(g8::Acc&, const Unit&, int, int) const {}
    __device__ __forceinline__ void a_ready(const Unit& u) const {
        if (u.type == 0) return;
        if (threadIdx.x < 64) {
            unsigned* rdy = (unsigned*)(ws + O_RDY) + u.mtg * 64;
            unsigned spins = 0;
            while ((unsigned)__builtin_amdgcn_readfirstlane(__hip_atomic_load(rdy, __ATOMIC_RELAXED, __HIP_MEMORY_SCOPE_AGENT)) < 16u) {
                __builtin_amdgcn_s_sleep(2);
                if (++spins > (1u << 22)) break;
            }
            __builtin_amdgcn_fence(__ATOMIC_ACQUIRE, "agent");
            asm volatile("s_waitcnt vmcnt(0)" ::: "memory");
        }
        asm volatile("" ::: "memory"); __builtin_amdgcn_s_barrier(); asm volatile("" ::: "memory");
    }
    __device__ __forceinline__ void done(const Unit& u) const {
        if (u.type != 0) return;
        asm volatile("s_waitcnt vmcnt(0)" ::: "memory");
        if ((threadIdx.x & 63) == 0) __hip_atomic_fetch_add((unsigned*)(ws + O_RDY) + u.mtg * 64, 1u, __ATOMIC_RELAXED, __HIP_MEMORY_SCOPE_AGENT);
    }
    __device__ __forceinline__ void epi(g8::Acc& acc, const Unit& u, int wr, int wc, int fr, int fq) const {
        if (u.type == 0) {
            __amdgpu_buffer_rsrc_t rs = __builtin_amdgcn_make_buffer_rsrc((void*)(ws + O_H), 0, (int)((32768 + 256) * 256 * 2), 0x00020000);
#pragma unroll
            for (int ai = 0; ai < 2; ++ai)
#pragma unroll
                for (int m = 0; m < 4; ++m) {
                    const int idx = u.mt * 256 + ai * 128 + wr * 64 + m * 16 + fr;
                    const f32x4 g0 = acc[ai][0][m][0], g1 = acc[ai][0][m][1], u0 = acc[ai][1][m][0], u1 = acc[ai][1][m][1];
                    u32x4 o;
                    o.x = g8::cvt_pk_bf16(siluf(g0[0]) * u0[0], siluf(g0[1]) * u0[1]); o.y = g8::cvt_pk_bf16(siluf(g0[2]) * u0[2], siluf(g0[3]) * u0[3]);
                    o.z = g8::cvt_pk_bf16(siluf(g1[0]) * u1[0], siluf(g1[1]) * u1[1]); o.w = g8::cvt_pk_bf16(siluf(g1[2]) * u1[2], siluf(g1[3]) * u1[3]);
                    const unsigned off = idx < u.cnt ? ((unsigned)(u.base + idx) * 256u + (unsigned)(u.pn * 128 + wc * 32 + 8 * fq)) * 2u : 0xF0000000u;
                    __builtin_amdgcn_raw_buffer_store_b128(o, rs, off, 0, 16);
                    __builtin_amdgcn_sched_barrier(0);
                }
            return;
        }
        const int* list = (const int*)(ws + O_LIST) + u.e * 16384;
        const float* wts = (const float*)(ws + O_WTS);
        __amdgpu_buffer_rsrc_t rsl = __builtin_amdgcn_make_buffer_rsrc((void*)(ws + O_SL), 0, (int)(16384 * 2 * 1024 * 2), 0x00020000);
        int ent[2][4]; float wg[2][4];
#pragma unroll
        for (int ai = 0; ai < 2; ++ai)
#pragma unroll
            for (int m = 0; m < 4; ++m) {
                const int idx = u.mt * 256 + ai * 128 + wr * 64 + m * 16 + fr;
                ent[ai][m] = list[idx < u.cnt ? idx : u.cnt - 1];
            }
#pragma unroll
        for (int ai = 0; ai < 2; ++ai)
#pragma unroll
            for (int m = 0; m < 4; ++m) wg[ai][m] = wts[ent[ai][m]];
#pragma unroll
        for (int ai = 0; ai < 2; ++ai)
#pragma unroll
            for (int m = 0; m < 4; ++m) {
                const int idx = u.mt * 256 + ai * 128 + wr * 64 + m * 16 + fr;
                const unsigned off = idx < u.cnt ? ((unsigned)ent[ai][m] * 1024u + (unsigned)(u.pn * 256 + wc * 32 + 8 * fq)) * 2u : 0xF0000000u;
#pragma unroll
                for (int bj = 0; bj < 2; ++bj) {
                    const f32x4 v0 = acc[ai][bj][m][0] * wg[ai][m], v1 = acc[ai][bj][m][1] * wg[ai][m];
                    u32x4 o; o.x = g8::cvt_pk_bf16(v0[0], v0[1]); o.y = g8::cvt_pk_bf16(v0[2], v0[3]); o.z = g8::cvt_pk_bf16(v1[0], v1[1]); o.w = g8::cvt_pk_bf16(v1[2], v1[3]);
                    __builtin_amdgcn_raw_buffer_store_b128(o, rsl, off + bj * 256u, 0, 0);
                }
            }
    }
};
__device__ void phase9(const Params& P, char* lds) {
    int* pre_t = (int*)(lds + g8::STAGE_BYTES); int* pre_c = pre_t + 40;
    moe_prefix(P.ws, pre_t, pre_c);
    Moe S; S.ws = P.ws; S.pre_t = pre_t; S.pre_c = pre_c; S.G = gridDim.x; S.c = blockIdx.x;
    int i = 0;
    while (i >= 0) i = g8::gemm_phase<Moe>((LAS unsigned char*)lds, S, i);
}

__device__ void phase11(const Params& P) {
    unsigned char* ws = P.ws;
    const int lane = threadIdx.x & 63;
    const int gw = blockIdx.x * 8 + (threadIdx.x >> 6), nw = gridDim.x * 8;
    const float* mod = (const float*)(ws + O_MOD);
    const u16* SL = (const u16*)(ws + O_SL);
    const int r_lo = (int)(((long long)gw * MLAT) / nw), r_hi = (int)(((long long)(gw + 1) * MLAT) / nw);
    float4 g2[4], fw[4];
    int cur_b = -1;
#pragma unroll
    for (int j = 0; j < 4; ++j) fw[j] = *(const float4*)(P.in[I_FNW] + (lane + 64 * j) * 4);
    for (int row = r_lo; row < r_hi; row += 2) {
        const bool two = row + 1 < r_hi;
        const int row1 = two ? row + 1 : row;
        float4 v0[4], v1[4]; uint2 a0[4], a1[4], b0[4], b1[4];
#pragma unroll
        for (int j = 0; j < 4; ++j) {
            const int k = (lane + 64 * j) * 4;
            { const f32x4 q0 = __builtin_nontemporal_load((const f32x4*)(P.out + (size_t)row * 1024 + k)), q1 = __builtin_nontemporal_load((const f32x4*)(P.out + (size_t)row1 * 1024 + k));
              v0[j] = make_float4(q0[0], q0[1], q0[2], q0[3]); v1[j] = make_float4(q1[0], q1[1], q1[2], q1[3]); }
            typedef __attribute__((ext_vector_type(2))) unsigned u32x2;
            { const u32x2 w0 = __builtin_nontemporal_load((const u32x2*)(SL + (size_t)(row * 2) * 1024 + k)), w1 = __builtin_nontemporal_load((const u32x2*)(SL + (size_t)(row * 2 + 1) * 1024 + k));
              const u32x2 w2 = __builtin_nontemporal_load((const u32x2*)(SL + (size_t)(row1 * 2) * 1024 + k)), w3 = __builtin_nontemporal_load((const u32x2*)(SL + (size_t)(row1 * 2 + 1) * 1024 + k));
              a0[j] = make_uint2(w0[0], w0[1]); a1[j] = make_uint2(w1[0], w1[1]); b0[j] = make_uint2(w2[0], w2[1]); b1[j] = make_uint2(w3[0], w3[1]); }
        }
#pragma unroll 1
        for (int rr = 0; rr < 2; ++rr) {
            const int orow = rr ? row1 : row;
            const int b = orow >> 12;
            if (b != cur_b) {
                cur_b = b;
#pragma unroll
                for (int j = 0; j < 4; ++j) g2[j] = *(const float4*)(mod + b * 6144 + 5120 + (lane + 64 * j) * 4);
            }
            if (rr == 1 && !two) break;
            float4 x[4]; float ss = 0.f;
#pragma unroll
            for (int j = 0; j < 4; ++j) {
                const float4 vv = rr ? v1[j] : v0[j];
                const uint2 s0 = rr ? b0[j] : a0[j], s1 = rr ? b1[j] : a1[j];
                x[j].x = vv.x + g2[j].x * (bflo(s0.x) + bflo(s1.x));
                x[j].y = vv.y + g2[j].y * (bfhi(s0.x) + bfhi(s1.x));
                x[j].z = vv.z + g2[j].z * (bflo(s0.y) + bflo(s1.y));
                x[j].w = vv.w + g2[j].w * (bfhi(s0.y) + bfhi(s1.y));
                ss += x[j].x * x[j].x + x[j].y * x[j].y + x[j].z * x[j].z + x[j].w * x[j].w;
            }
            const float rstd = rsqrtf(wave_sum(ss) * (1.f / 1024.f) + 1e-6f);
#pragma unroll
            for (int j = 0; j < 4; ++j) {
                float4 o; o.x = x[j].x * rstd * fw[j].x; o.y = x[j].y * rstd * fw[j].y; o.z = x[j].z * rstd * fw[j].z; o.w = x[j].w * rstd * fw[j].w;
                __builtin_nontemporal_store((f32x4){o.x, o.y, o.z, o.w}, (f32x4*)(P.out + (size_t)orow * 1024 + (lane + 64 * j) * 4));
            }
        }
    }
}

__global__ void __launch_bounds__(NTB, 2) fwd_kernel(Params P) {
    extern __shared__ __attribute__((aligned(16))) char lds[];
    if (threadIdx.x < 4) ((volatile LAS unsigned*)(lds + LDS_MAIN))[threadIdx.x] = 0u;
    __syncthreads();
    XcdBarrier xbar = xcd_barrier_post((unsigned*)(P.ws + O_BAR), (volatile LAS unsigned*)(lds + LDS_MAIN));
#define SYNC() xcd_barrier(xbar)
#ifdef ONLY_PH
#define RUN_PHASE(k, call) do { if ((k) == ONLY_PH) { call; } } while (0)
#else
#define RUN_PHASE(k, call) do { if (P.lo <= (k) && (k) < P.hi) { call; if ((k) + 1 < P.hi) { SYNC(); } } } while (0)
#endif
    RUN_PHASE(0, phase0(P, lds));
    RUN_PHASE(1, phase1(P));
    RUN_PHASE(2, { InProj S; S.ws = P.ws; S.G = gridDim.x; S.c = blockIdx.x; g8::gemm_phase<InProj>((LAS unsigned char*)lds, S); });
    RUN_PHASE(3, phase3(P, lds));
    RUN_PHASE(4, phase4(P, lds));
    RUN_PHASE(5, phase5(P));
    RUN_PHASE(6, phase6(P, lds));
    RUN_PHASE(7, phase7(P, lds));
    RUN_PHASE(8, phase8(P, lds));
    RUN_PHASE(9, phase9(P, lds));
    RUN_PHASE(11, phase11(P));
}

extern "C" void kernel_launch(void* const* d_in, const int* in_sizes, int n_in, void* d_out, int out_size, void* d_ws, size_t ws_size,
                              hipStream_t stream) {
    static int grid_blocks = 0;
    if (!grid_blocks) {
        int dev = 0, cus = 0, per_cu = 0;
        (void)hipGetDevice(&dev);
        (void)hipDeviceGetAttribute(&cus, hipDeviceAttributeMultiprocessorCount, dev);
        (void)hipFuncSetAttribute((const void*)fwd_kernel, hipFuncAttributeMaxDynamicSharedMemorySize, LDS_BYTES);
        (void)hipOccupancyMaxActiveBlocksPerMultiprocessor(&per_cu, (const void*)fwd_kernel, NTB, LDS_BYTES);
        if (per_cu < 1) fprintf(stderr, "occupancy query says %d blocks per CU\n", per_cu);
        grid_blocks = cus;
        if (ws_size < WS_END) fprintf(stderr, "workspace too small: %zu < %zu\n", ws_size, (size_t)WS_END);
    }
    Params p{};
    for (int i = 0; i < 30; ++i) p.in[i] = (const float*)d_in[i];
    p.out = (float*)d_out; p.ws = (unsigned char*)d_ws;
    p.lo = 0; p.hi = NPHASE;
    (void)hipMemsetAsync((char*)d_ws + O_BAR, 0, 16384 + 40960, stream);
    void* args[] = {&p};
    hipError_t e = hipLaunchCooperativeKernel((const void*)fwd_kernel, dim3(grid_blocks), dim3(NTB), args, LDS_BYTES, stream);
    if (e != hipSuccess) fprintf(stderr, "cooperative launch failed: %s (grid %d)\n", hipGetErrorString(e), grid_blocks);
}
```
